# Optimizing an MI355X kernel written in HIP

```python
import jax, jax.numpy as jnp
from jax import lax
import numpy as np

D_MODEL = 1024
BATCH = 8
SEQ = 4096
DEPTH = 4

HEAD_DIM = 64
N_HEADS = D_MODEL // HEAD_DIM
N_A = max(1, DEPTH // 2)
N_B = DEPTH - N_A
DECAY_LORA = 64
AAA_LORA = 64
MV_LORA = 32
GATE_LORA = 160
N_GROUPS = 4
EXP_PER_GROUP = 8
N_EXPERTS = N_GROUPS * EXP_PER_GROUP
TOP_K = 2
D_EXPERT = 512
EXPERT_BLOCK = 128
Q_BLOCK = 128
DEEPNORM_ALPHA = (2 * DEPTH) ** 0.25
DEEPNORM_BETA = (8 * DEPTH) ** -0.25
LN_EPS = 1e-5
GN_EPS = 64e-5
QK_EPS = 1e-6

kernel_name = 'yoco_rwkv7_fox_hier_moe_deepnorm_adaln'


def layer_norm(x, g, b, eps=LN_EPS):
    xf = x.astype(jnp.float32)
    mu = xf.mean(-1, keepdims=True)
    var = jnp.square(xf - mu).mean(-1, keepdims=True)
    return ((xf - mu) * lax.rsqrt(var + eps)).astype(x.dtype) * g + b


def head_rms(t, g, eps=QK_EPS):
    tf = t.astype(jnp.float32)
    return (tf * lax.rsqrt(jnp.mean(tf * tf, -1, keepdims=True) + eps)).astype(t.dtype) * g


def wkv7_scan(r, w, k, v, a, b):
    B, S, H, N = r.shape

    def step(state, inp):
        r_t, w_t, k_t, v_t, a_t, b_t = inp
        sa = jnp.einsum('bhij,bhj->bhi', state, a_t)
        state = (state * w_t[:, :, None, :] + sa[..., None] * b_t[:, :, None, :]
                 + v_t[..., None] * k_t[:, :, None, :])
        return state, jnp.einsum('bhij,bhj->bhi', state, r_t)

    tm = lambda t: jnp.moveaxis(t, 1, 0)
    state0 = jnp.zeros((B, H, N, N), jnp.float32)
    _, y = lax.scan(step, state0, (tm(r), tm(w), tm(k), tm(v), tm(a), tm(b)))
    return jnp.moveaxis(y, 0, 1)


def rwkv7_time_mix(h, v_first, mu, w_rkv, w0, w1, w2, a0, a1, a2, g1, g2,
                   k_k, k_a, r_k, gn_g, gn_b, w_o, v_mix):
    B, S, D = h.shape
    f32 = jnp.float32
    xx = jnp.pad(h, ((0, 0), (1, 0), (0, 0)))[:, :-1] - h
    xr, xw, xk, xv, xa, xg = [h + xx * mu[i] for i in range(6)]
    r, k, v = jnp.einsum('nbsd,nde->nbse', jnp.stack([xr, xk, xv]), w_rkv)
    w_log = -jnp.exp((-jax.nn.softplus(-(w0 + jnp.tanh(xw @ w1) @ w2)) - 0.5).astype(f32))
    if v_mix is None:
        v_first = v
    else:
        v0, v1, v2 = v_mix
        v = v + (v_first - v) * jax.nn.sigmoid(v0 + (xv @ v1) @ v2)
    a = jax.nn.sigmoid(a0 + (xa @ a1) @ a2)
    g = jax.nn.sigmoid(xg @ g1) @ g2
    heads = lambda t: t.reshape(B, S, N_HEADS, HEAD_DIM).astype(f32)
    kk = heads(k * k_k)
    kk = kk / jnp.maximum(jnp.sqrt(jnp.sum(kk * kk, -1, keepdims=True)), 1e-12)
    k = k * (1 + (a - 1) * k_a)
    rh, kh, vh, ah = heads(r), heads(k), heads(v), heads(a)
    y = wkv7_scan(rh, jnp.exp(heads(w_log)), kh, vh, -kk, kk * ah)
    ym = y.mean(-1, keepdims=True)
    yv = jnp.square(y - ym).mean(-1, keepdims=True)
    y = ((y - ym) * lax.rsqrt(yv + GN_EPS)).reshape(B, S, D).astype(h.dtype) * gn_g + gn_b
    bonus = (jnp.sum(rh * kh * r_k, -1, keepdims=True) * vh).reshape(B, S, D).astype(h.dtype)
    return ((y + bonus) * g) @ w_o, v_first


def shared_kv(x, cs, ada_w, ada_b, w_kvf, b_f, k_norm):
    B, S, D = x.shape
    shift, scale = jnp.split(cs @ ada_w + ada_b, 2, axis=-1)
    hk = x * (1 + scale[:, None]) + shift[:, None]
    kvf = hk @ w_kvf
    k = head_rms(kvf[..., :D].reshape(B, S, N_HEADS, HEAD_DIM), k_norm)
    v = kvf[..., D:2 * D].reshape(B, S, N_HEADS, HEAD_DIM)
    log_f = jax.nn.log_sigmoid((kvf[..., 2 * D:] + b_f).astype(jnp.float32))
    fcum = jnp.cumsum(log_f, axis=1)
    return (k.transpose(0, 2, 1, 3), v.transpose(0, 2, 1, 3), fcum.transpose(0, 2, 1))


def forgetting_attention(q, k, v, fcum):
    S = q.shape[2]
    scale = HEAD_DIM ** -0.5
    outs = []
    for i in range(S // Q_BLOCK):
        lo, hi = i * Q_BLOCK, (i + 1) * Q_BLOCK
        logits = (jnp.einsum('bhqd,bhkd->bhqk', q[:, :, lo:hi], k[:, :, :hi]).astype(jnp.float32) * scale
                  + (fcum[:, :, lo:hi, None] - fcum[:, :, None, :hi]))
        causal = (lo + jnp.arange(Q_BLOCK))[:, None] >= jnp.arange(hi)[None, :]
        logits = jnp.where(causal, logits, -jnp.inf)
        p = jax.nn.softmax(logits, axis=-1).astype(v.dtype)
        outs.append(jnp.einsum('bhqk,bhkd->bhqd', p, v[:, :, :hi]))
    return jnp.concatenate(outs, axis=2)


def fox_layer(h, kv, w_qg, q_norm, w_o):
    B, S, D = h.shape
    k, v, fcum = kv
    qg = h @ w_qg
    q = head_rms(qg[..., :D].reshape(B, S, N_HEADS, HEAD_DIM), q_norm).transpose(0, 2, 1, 3)
    o = forgetting_attention(q, k, v, fcum).transpose(0, 2, 1, 3).reshape(B, S, D)
    return (o * jax.nn.sigmoid(qg[..., D:])) @ w_o


def grouped_experts(xf, expert_idx, gates, w_gate, w_up, w_down):
    T, D = xf.shape
    A = T * TOP_K
    n_blocks = -(-(A + N_EXPERTS * EXPERT_BLOCK) // EXPERT_BLOCK)
    n_slots = n_blocks * EXPERT_BLOCK
    flat_e = expert_idx.reshape(A)
    order = jnp.argsort(flat_e)
    sorted_e = flat_e[order]
    counts = jnp.bincount(flat_e, length=N_EXPERTS)
    padded = (counts + EXPERT_BLOCK - 1) // EXPERT_BLOCK * EXPERT_BLOCK
    pad_end = jnp.cumsum(padded)
    pad_start = pad_end - padded
    start = jnp.cumsum(counts) - counts
    dest_sorted = pad_start[sorted_e] + (jnp.arange(A) - start[sorted_e])
    dest = jnp.zeros((A,), jnp.int32).at[order].set(dest_sorted.astype(jnp.int32))
    slot_tok = jnp.zeros((n_slots,), jnp.int32).at[dest].set(jnp.arange(A, dtype=jnp.int32) // TOP_K)
    block_exp = jnp.minimum(jnp.searchsorted(pad_end, jnp.arange(n_blocks) * EXPERT_BLOCK, side='right'),
                            N_EXPERTS - 1)
    xs = xf[slot_tok].reshape(n_blocks, EXPERT_BLOCK, D)

    def one_block(args):
        xb, e = args
        hb = jax.nn.silu(xb @ w_gate[e]) * (xb @ w_up[e])
        return hb @ w_down[e]

    ys = lax.map(one_block, (xs, block_exp)).reshape(n_slots, D)
    y_assign = ys[dest].reshape(T, TOP_K, D)
    return jnp.einsum('tk,tkd->td', gates, y_assign)


def hier_moe(h, w_grp, b_grp, w_exp, b_exp, w_gate, w_up, w_down):
    B, S, D = h.shape
    T = B * S
    hf = h.reshape(T, D)
    p_grp = jax.nn.softmax((hf @ w_grp).astype(jnp.float32) + b_grp, axis=-1)
    g_sel = jnp.argmax(p_grp, axis=-1)
    p_g = jnp.take_along_axis(p_grp, g_sel[:, None], axis=-1)
    e_logits = ((hf @ w_exp).astype(jnp.float32) + b_exp).reshape(T, N_GROUPS, EXP_PER_GROUP)
    e_logits = jnp.take_along_axis(e_logits, g_sel[:, None, None], axis=1)[:, 0]
    top_p, top_i = lax.top_k(jax.nn.softmax(e_logits, axis=-1), TOP_K)
    gates = (p_g * top_p / jnp.sum(top_p, -1, keepdims=True)).astype(h.dtype)
    expert_idx = (g_sel[:, None] * EXP_PER_GROUP + top_i).astype(jnp.int32)
    return grouped_experts(hf, expert_idx, gates, w_gate, w_up, w_down).reshape(B, S, D)


def setup_inputs(seed: int = 0) -> dict:
    key = jax.random.key(seed)
    ks = iter(jax.random.split(key, 64))
    nrm = lambda shape, s: jax.random.normal(next(ks), shape, jnp.float32) * s
    uni = lambda shape, lo, hi: jax.random.uniform(next(ks), shape, jnp.float32, lo, hi)
    D, H, N = D_MODEL, N_HEADS, HEAD_DIM
    s_in = D ** -0.5
    beta = DEEPNORM_BETA
    nv = N_A - 1
    return {
        'x': nrm((BATCH, SEQ, D), 1.0),
        'c': nrm((BATCH, D), 1.0),
        'ada_w': nrm((DEPTH, D, 6 * D), 0.1 * s_in),
        'ada_b': nrm((DEPTH, 6 * D), 0.01),
        'ln_g': 1.0 + nrm((DEPTH, 2, D), 0.02),
        'ln_b': nrm((DEPTH, 2, D), 0.02),
        'rw_mu': uni((N_A, 6, D), 0.0, 1.0),
        'rw_rkv': nrm((N_A, 3, D, D), s_in) * jnp.array([1.0, 1.0, beta], jnp.float32)[None, :, None, None],
        'rw_w0': uni((N_A, D), -6.0, -1.0),
        'rw_w1': nrm((N_A, D, DECAY_LORA), s_in),
        'rw_w2': nrm((N_A, DECAY_LORA, D), 0.1 * DECAY_LORA ** -0.5),
        'rw_a0': nrm((N_A, D), 0.1),
        'rw_a1': nrm((N_A, D, AAA_LORA), s_in),
        'rw_a2': nrm((N_A, AAA_LORA, D), 0.1 * AAA_LORA ** -0.5),
        'rw_g1': nrm((N_A, D, GATE_LORA), s_in),
        'rw_g2': nrm((N_A, GATE_LORA, D), GATE_LORA ** -0.5),
        'rw_kk': 0.85 + nrm((N_A, D), 0.02),
        'rw_ka': 1.0 + nrm((N_A, D), 0.02),
        'rw_rk': nrm((N_A, H, N), 0.1),
        'rw_gn_g': 1.0 + nrm((N_A, D), 0.02),
        'rw_gn_b': nrm((N_A, D), 0.02),
        'rw_wo': nrm((N_A, D, D), s_in * beta),
        'rw_v0': 1.0 + nrm((nv, D), 0.1),
        'rw_v1': nrm((nv, D, MV_LORA), s_in),
        'rw_v2': nrm((nv, MV_LORA, D), 0.1 * MV_LORA ** -0.5),
        'kv_ada_w': nrm((D, 2 * D), 0.1 * s_in),
        'kv_ada_b': nrm((2 * D,), 0.01),
        'kv_w': jnp.concatenate([nrm((D, D), s_in), nrm((D, D), s_in * beta), nrm((D, H), s_in)], axis=1),
        'kv_fb': uni((H,), 0.0, 5.0),
        'kv_knorm': 1.0 + nrm((N,), 0.02),
        'fx_wqg': nrm((N_B, D, 2 * D), s_in),
        'fx_qnorm': 1.0 + nrm((N_B, N), 0.02),
        'fx_wo': nrm((N_B, D, D), s_in * beta),
        'moe_wgrp': nrm((DEPTH, D, N_GROUPS), s_in),
        'moe_bgrp': nrm((DEPTH, N_GROUPS), 0.01),
        'moe_wexp': nrm((DEPTH, D, N_EXPERTS), s_in),
        'moe_bexp': nrm((DEPTH, N_EXPERTS), 0.01),
        'moe_wgate': nrm((DEPTH, N_EXPERTS, D, D_EXPERT), s_in),
        'moe_wup': nrm((DEPTH, N_EXPERTS, D, D_EXPERT), s_in),
        'moe_wdown': nrm((DEPTH, N_EXPERTS, D_EXPERT, D), D_EXPERT ** -0.5 * beta),
    }


def reference(x, c, ada_w, ada_b, ln_g, ln_b, rw_mu, rw_rkv, rw_w0, rw_w1, rw_w2, rw_a0, rw_a1, rw_a2,
              rw_g1, rw_g2, rw_kk, rw_ka, rw_rk, rw_gn_g, rw_gn_b, rw_wo, rw_v0, rw_v1, rw_v2,
              kv_ada_w, kv_ada_b, kv_w, kv_fb, kv_knorm, fx_wqg, fx_qnorm, fx_wo,
              moe_wgrp, moe_bgrp, moe_wexp, moe_bexp, moe_wgate, moe_wup, moe_wdown):
    cs = jax.nn.silu(c)
    kv = None
    v_first = None
    for l in range(DEPTH):
        mod = cs @ ada_w[l] + ada_b[l]
        sh_m, sc_m, gt_m, sh_f, sc_f, gt_f = [m[:, None, :] for m in jnp.split(mod, 6, axis=-1)]
        h = x * (1 + sc_m) + sh_m
        if l < N_A:
            v_mix = None if l == 0 else (rw_v0[l - 1], rw_v1[l - 1], rw_v2[l - 1])
            y, v_first = rwkv7_time_mix(h, v_first, rw_mu[l], rw_rkv[l], rw_w0[l], rw_w1[l], rw_w2[l],
                                        rw_a0[l], rw_a1[l], rw_a2[l], rw_g1[l], rw_g2[l], rw_kk[l],
                                        rw_ka[l], rw_rk[l], rw_gn_g[l], rw_gn_b[l], rw_wo[l], v_mix)
        else:
            j = l - N_A
            y = fox_layer(h, kv, fx_wqg[j], fx_qnorm[j], fx_wo[j])
        x = layer_norm(DEEPNORM_ALPHA * x + (1 + gt_m) * y, ln_g[l, 0], ln_b[l, 0])
        h = x * (1 + sc_f) + sh_f
        y = hier_moe(h, moe_wgrp[l], moe_bgrp[l], moe_wexp[l], moe_bexp[l],
                     moe_wgate[l], moe_wup[l], moe_wdown[l])
        x = layer_norm(DEEPNORM_ALPHA * x + (1 + gt_f) * y, ln_g[l, 1], ln_b[l, 1])
        if l == N_A - 1:
            kv = shared_kv(x, cs, kv_ada_w, kv_ada_b, kv_w, kv_fb, kv_knorm)
    return x
```

```cpp
#include <hip/hip_runtime.h>
#include <cstdio>
#include <cstdint>
#include <hip/hip_bf16.h>
#include <cmath>

#define GAS __attribute__((address_space(1)))
#define LAS __attribute__((address_space(3)))
typedef unsigned short bf16_t;
typedef short bf16x8 __attribute__((ext_vector_type(8)));
typedef float f32x4 __attribute__((ext_vector_type(4)));
typedef float f32x2 __attribute__((ext_vector_type(2)));
typedef unsigned u32x4 __attribute__((ext_vector_type(4)));
typedef unsigned u32x2 __attribute__((ext_vector_type(2)));
typedef GAS unsigned gu32;

constexpr int NB = 8, SEQ = 4096, T = NB * SEQ, D = 1024, NH = 16, HD = 64;
constexpr int NWAVES = 8, NTHR = NWAVES * 64;
constexpr float ALPHA = 1.681792830507429f;
constexpr float LN_EPS = 1e-5f, GN_EPS = 64e-5f, QK_EPS = 1e-6f;
constexpr float LOG2E = 1.4426950408889634f;
constexpr float QC2 = 0.125f * LOG2E;
constexpr int RWK = 2048;
constexpr int LAW = 512;
constexpr int G2K = 256;
constexpr int XS_ROWS = 73728;

constexpr size_t MiB = 1u << 20;
constexpr size_t WS_CTL = 0, CTL_BYTES = 1 * MiB;
constexpr size_t WS_MOD = 1 * MiB;
constexpr size_t WS_KVMOD = WS_MOD + 4 * 8 * 6144 * 4;
constexpr size_t WS_RT = 2 * MiB;
constexpr size_t WS_WF = WS_RT + 768 * 1024;
constexpr size_t WS_KB = 3 * MiB;
constexpr size_t WS_LF = 5 * MiB;
constexpr size_t WS_ASG = 7 * MiB;
constexpr size_t WS_GATE = WS_ASG + 256 * 1024;
constexpr size_t WS_DEST = WS_GATE + 256 * 1024;
constexpr size_t WS_TEXP = WS_DEST + 256 * 1024;
constexpr size_t WS_T0 = WS_TEXP + 4096;
constexpr size_t WS_RWBIG = 16 * MiB;
constexpr size_t WS_RWLORA = 28 * MiB;
constexpr size_t WS_LORA2 = 44 * MiB;
constexpr size_t L2_G2T = 0, L2_W2T = 512 * 1024, L2_A2T = 640 * 1024, L2_V2T = 768 * 1024;
constexpr size_t WS_RWWO = 50 * MiB;
constexpr size_t WS_KVW = 54 * MiB;
constexpr size_t WS_FXQG = 58 * MiB;
constexpr size_t WS_FXWO = 66 * MiB;
constexpr size_t WS_MOE = 72 * MiB;
constexpr size_t WS_SC = 168 * MiB;
constexpr size_t X3S = (size_t)T * 1024;
constexpr size_t WS_XS = WS_SC + 200 * MiB;
constexpr size_t WS_P = 456 * MiB;
constexpr size_t WS_Y16 = 584 * MiB;
constexpr size_t WS_H2 = 648 * MiB;
constexpr size_t WS_RA = 776 * MiB;
constexpr size_t WS_HM = WS_RA;
constexpr size_t WS_TLIST = WS_RA + 80 * MiB;
constexpr size_t WS_END = 1064 * MiB;
constexpr int CW_BAR = 4096;
constexpr int CW_CNT = 16384;
constexpr int CW_ATT = 16640;

constexpr int LDS_BYTES = 147456;
constexpr int MISC_OFF = 131072 + 320;
constexpr int MOE_LC_OFF = MISC_OFF + 256;
constexpr int MOE_TOKL_OFF = MISC_OFF + 2048;
__device__ __forceinline__ float bf2f(unsigned short b) { return __uint_as_float((unsigned)b << 16); }
typedef float f32x2_cv __attribute__((ext_vector_type(2))); typedef __bf16 bf16x2_cv __attribute__((ext_vector_type(2)));
__device__ __forceinline__ unsigned pk2(float lo, float hi) { const f32x2_cv v = {lo, hi}; return __builtin_bit_cast(unsigned, __builtin_convertvector(v, bf16x2_cv)); }
__device__ __forceinline__ unsigned f2bf(float f) { return pk2(f, 0.f) & 0xffffu; }
__device__ __forceinline__ float lo16(unsigned w) { return __uint_as_float(w << 16); }
__device__ __forceinline__ float hi16(unsigned w) { return __uint_as_float(w & 0xffff0000u); }
__device__ __forceinline__ float sigmoidf_(float x) { return __builtin_amdgcn_rcpf(1.0f + __expf(-x)); }
__device__ __forceinline__ float tanhf_(float x) { const float e = __expf(2.0f * x); return 1.0f - 2.0f * __builtin_amdgcn_rcpf(e + 1.0f); }
__device__ __forceinline__ float wave_sum(float v) {
#pragma unroll
    for (int o = 1; o < 64; o <<= 1) v += __shfl_xor(v, o);
    return v;
}
template <int CTRL> __device__ __forceinline__ float dpp_f(float v) {
    return __builtin_bit_cast(float, __builtin_amdgcn_update_dpp(0, __builtin_bit_cast(int, v), CTRL, 0xF, 0xF, true));
}
__device__ __forceinline__ float quadsum(float v) { v += dpp_f<0xB1>(v); v += dpp_f<0x4E>(v); return v; }
__device__ __forceinline__ float rowsum16(float v) { v += dpp_f<0xB1>(v); v += dpp_f<0x4E>(v); v += dpp_f<0x141>(v); v += dpp_f<0x140>(v); return v; }
#define LDS_WAIT() asm volatile("s_waitcnt lgkmcnt(0)" ::: "memory")
#define LBAR() do { asm volatile("s_waitcnt lgkmcnt(0)" ::: "memory"); __builtin_amdgcn_s_barrier(); asm volatile("" ::: "memory"); } while (0)

#define XB_TMO      128
#define XB_XCNT(j)  (256  + 64 * (j))
#define XB_XSUB(j)  (1280 + 64 * (j))
#define XB_XGEN(j)  (2304 + 64 * (j))
#define XB_TOP      3328
#define XB_TOPGEN   3392
#define XCD_BAR_WORDS 3456
#define XB_SPIN_CAP (1u << 22)
__device__ __forceinline__ unsigned xb_ld(unsigned* p)              { return __hip_atomic_load(p, __ATOMIC_RELAXED, __HIP_MEMORY_SCOPE_AGENT); }
__device__ __forceinline__ unsigned xb_add(unsigned* p, unsigned v) { return __hip_atomic_fetch_add(p, v, __ATOMIC_RELAXED, __HIP_MEMORY_SCOPE_AGENT); }
__device__ __forceinline__ unsigned xb_xcc_id() { return (unsigned)__builtin_amdgcn_s_getreg((3 << 11) | 20) & 0xFu; }
#define XB_SPIN(cond, bar) do { unsigned _sp = 0; while (cond) { __builtin_amdgcn_s_sleep(1); \
    if ((++_sp & 255u) == 0u) { if (xb_ld(&(bar)[XB_TMO])) break; if (_sp > XB_SPIN_CAP) { atomicAdd(&(bar)[XB_TMO], 1u); break; } } } } while (0)
struct XcdBarrier { unsigned* bar; unsigned x; volatile LAS unsigned* st; };
__device__ __forceinline__ XcdBarrier xcd_barrier_post(unsigned* bar, volatile LAS unsigned* st) {
    XcdBarrier b; b.bar = bar; b.x = xb_xcc_id(); b.st = st;
    if (threadIdx.x == 0) (void)xb_add(&bar[XB_XCNT(b.x)], 1u);
    return b;
}
__device__ __forceinline__ void xcd_barrier_complete(unsigned* bar, unsigned x, unsigned& nloc, unsigned& nx) {
    const unsigned G = gridDim.x * gridDim.y * gridDim.z;
    unsigned sum, cnt, mine, sp = 0u;
    for (;;) {
        sum = 0u; cnt = 0u; mine = 0u;
#pragma unroll
        for (unsigned j = 0; j < 16; ++j) { const unsigned c = xb_ld(&bar[XB_XCNT(j)]); sum += c; cnt += (c > 0u) ? 1u : 0u; mine = (j == x) ? c : mine; }
        if (sum == G) break;
        __builtin_amdgcn_s_sleep(1);
        if ((++sp & 255u) == 0u) { if (xb_ld(&bar[XB_TMO])) break; if (sp > XB_SPIN_CAP) { atomicAdd(&bar[XB_TMO], 1u); break; } }
    }
    nloc = mine > 0u ? mine : 1u; nx = cnt > 0u ? cnt : 1u;
}
__device__ __forceinline__ void xcd_barrier_fn(unsigned* bar_, unsigned x_, volatile LAS unsigned* st_, bool is_t0) {
    XcdBarrier b; b.bar = bar_; b.x = x_; b.st = st_;
    asm volatile("s_waitcnt vmcnt(0)" ::: "memory");
    __syncthreads();
    if (is_t0) {
        unsigned* bar = b.bar;
        __builtin_amdgcn_s_waitcnt(0);
        unsigned nloc = b.st[0], nx = b.st[1];
        if (nloc == 0u) { xcd_barrier_complete(bar, b.x, nloc, nx); b.st[0] = nloc; b.st[1] = nx; }
        const unsigned old = xb_add(&bar[XB_XSUB(b.x)], 1u);
        const unsigned gen = old / nloc;
        if (old + 1u == (gen + 1u) * nloc) {
            __builtin_amdgcn_fence(__ATOMIC_RELEASE, "agent");
            asm volatile("s_waitcnt vmcnt(0)" ::: "memory");
            const unsigned og = xb_add(&bar[XB_TOP], 1u);
            const unsigned tg = og / nx;
            if (og + 1u == (tg + 1u) * nx) xb_add(&bar[XB_TOPGEN], 1u);
            else XB_SPIN(xb_ld(&bar[XB_TOPGEN]) == tg, bar);
            __builtin_amdgcn_fence(__ATOMIC_ACQUIRE, "agent");
            xb_add(&bar[XB_XGEN(b.x)], 1u);
            asm volatile("s_waitcnt vmcnt(0)" ::: "memory");
        } else {
            XB_SPIN(xb_ld(&bar[XB_XGEN(b.x)]) == gen, bar);
            __builtin_amdgcn_fence(__ATOMIC_ACQUIRE, "agent");
            asm volatile("s_waitcnt vmcnt(0)" ::: "memory");
        }
    }
    __syncthreads();
}

struct Args { const float* in[40]; float* out; unsigned char* ws; int ph_lo, ph_hi; };
struct InTab { const float* const* p; __device__ __forceinline__ const float* operator[](int i) const { return (const float*)(GAS const float*)p[i]; } };
struct Frame {
    LAS unsigned char* lds; char* ldsg;
    unsigned char* ws; float* xs;
    InTab in;
    int tid, lane, wave, G, bid;
};
enum { I_X = 0, I_C, I_ADAW, I_ADAB, I_LNG, I_LNB, I_MU, I_RKV, I_W0, I_W1, I_W2, I_A0, I_A1, I_A2, I_G1, I_G2, I_KK, I_KA, I_RK, I_GNG, I_GNB, I_RWO, I_V0, I_V1, I_V2,
       I_KVADAW, I_KVADAB, I_KVW, I_KVFB, I_KNORM, I_WQG, I_QNORM, I_FWO, I_WGRP, I_BGRP, I_WEXP, I_BEXP, I_WGATE, I_WUP, I_WDOWN };

__device__ __forceinline__ void tr_item(const float* W, int ldw, int K, int k0, int n0, const float* mu, bf16_t* WT, int ldt, int nd0, int kd0, LAS float* scr, int lane) {
    const int kr = lane >> 3, n4 = 4 * (lane & 7);
    f32x4 v[8];
#pragma unroll
    for (int i = 0; i < 8; ++i) { const int k = k0 + kr + 8 * i; v[i] = (k < K) ? *(const f32x4*)(W + (size_t)k * ldw + n0 + n4) : (f32x4){0.f, 0.f, 0.f, 0.f}; }
    if (mu) {
#pragma unroll
        for (int i = 0; i < 8; ++i) { const int k = k0 + kr + 8 * i; v[i] = v[i] * ((k < K) ? mu[k] : 0.f); }
    }
#pragma unroll
    for (int i = 0; i < 8; ++i) { LAS float* d = scr + (kr + 8 * i) * 33 + n4; d[0] = v[i][0]; d[1] = v[i][1]; d[2] = v[i][2]; d[3] = v[i][3]; }
    LDS_WAIT(); asm volatile("" ::: "memory");
    const int c = lane & 7;
#pragma unroll
    for (int j = 0; j < 4; ++j) {
        const int n = (lane >> 3) + 8 * j; const LAS float* s = scr + (8 * c) * 33 + n;
        u32x4 o; o.x = pk2(s[0 * 33], s[1 * 33]); o.y = pk2(s[2 * 33], s[3 * 33]); o.z = pk2(s[4 * 33], s[5 * 33]); o.w = pk2(s[6 * 33], s[7 * 33]);
        *(u32x4*)(WT + (size_t)(nd0 + n) * ldt + kd0 + 8 * c) = o;
    }
    LDS_WAIT(); asm volatile("" ::: "memory");
}
__device__ __forceinline__ void zero_item(bf16_t* WT, int ldt, int r0, int c0, int c1, int lane) {
    const int cpr = (c1 - c0) >> 3, tot = 32 * cpr;
    for (int i = lane; i < tot; i += 64) { const int r = i / cpr, c = i % cpr; *(u32x4*)(WT + (size_t)(r0 + r) * ldt + c0 + 8 * c) = (u32x4){0u, 0u, 0u, 0u}; }
}

__device__ __forceinline__ void p0_prologue(Frame& F) {
    const InTab in = F.in;
    {
        LAS float* cs = (LAS float*)F.lds;
        LAS float* part = (LAS float*)(F.lds + 32768);
        bool did_cs = false;
        for (int it = F.bid; it < 104; it += F.G) {
            if (!did_cs) { for (int i = F.tid; i < 8 * 1024; i += NTHR) { const float v = in[I_C][i]; cs[i] = v / (1.0f + __expf(-v)); } did_cs = true; }
            __syncthreads();
            const float* W; const float* bias; int ldw, j0; float* dst; int dld;
            if (it < 96) { const int l = it / 24; j0 = (it % 24) * 256; W = in[I_ADAW] + (size_t)l * 1024 * 6144; ldw = 6144; bias = in[I_ADAB] + l * 6144; dst = (float*)(F.ws + WS_MOD) + (size_t)l * 8 * 6144; dld = 6144; }
            else { j0 = (it - 96) * 256; W = in[I_KVADAW]; ldw = 2048; bias = in[I_KVADAB]; dst = (float*)(F.ws + WS_KVMOD); dld = 2048; }
            f32x4 acc[8];
#pragma unroll
            for (int b = 0; b < 8; ++b) acc[b] = (f32x4){0.f, 0.f, 0.f, 0.f};
            const int kbeg = F.wave * 128;
#pragma unroll 4
            for (int kk = 0; kk < 128; ++kk) {
                const int k = kbeg + kk;
                const f32x4 w = *(const f32x4*)(W + (size_t)k * ldw + j0 + 4 * F.lane);
#pragma unroll
                for (int b = 0; b < 8; ++b) acc[b] += w * cs[b * 1024 + k];
            }
#pragma unroll
            for (int b = 0; b < 8; ++b) *(LAS f32x4*)(part + (F.wave * 8 + b) * 256 + 4 * F.lane) = acc[b];
            __syncthreads();
            for (int o = F.tid; o < 8 * 256; o += NTHR) {
                const int b = o >> 8, j = o & 255; float s = 0.f;
#pragma unroll
                for (int w = 0; w < 8; ++w) s += part[(w * 8 + b) * 256 + j];
                dst[(size_t)b * dld + j0 + j] = s + bias[j0 + j];
            }
            __syncthreads();
        }
        __syncthreads();
    }
    {
        const int gt = F.bid * NTHR + F.tid, NGT = F.G * NTHR;
        bf16_t* RTH = (bf16_t*)(F.ws + WS_RT); bf16_t* RTL = RTH + 4 * 48 * 1024; bf16_t* WFH = (bf16_t*)(F.ws + WS_WF); bf16_t* WFL = WFH + 16 * 1024;
        for (int i = gt; i < 4 * 48 * 1024; i += NGT) {
            const int l = i / (48 * 1024), r = i % (48 * 1024), c = r / 1024, k = r % 1024;
            const float w = (c < 4) ? in[I_WGRP][((size_t)l * 1024 + k) * 4 + c] : (c < 36 ? in[I_WEXP][((size_t)l * 1024 + k) * 32 + (c - 4)] : 0.f);
            const unsigned h = f2bf(w); RTH[i] = (bf16_t)h; RTL[i] = (bf16_t)f2bf(w - bf2f((unsigned short)h));
        }
        for (int i = gt; i < 16 * 1024; i += NGT) { const int c = i / 1024, k = i % 1024; const float w = in[I_KVW][(size_t)k * 2064 + 2048 + c];
            const unsigned h = f2bf(w); WFH[i] = (bf16_t)h; WFL[i] = (bf16_t)f2bf(w - bf2f((unsigned short)h)); }
    }
    LAS float* scr = (LAS float*)(F.lds + F.wave * 8704);
    const int gw = F.bid * NWAVES + F.wave, NGW = F.G * NWAVES;
    constexpr int N_S1 = 2 * 3 * 512;
    constexpr int N_S2 = 2 * 17 * 32;
    constexpr int N_S3 = 2 * 128;
    constexpr int N_S4 = 2 * 512 + 1024 + 2 * 1024 + 2 * 512;
    constexpr int N_TOT = N_S1 + N_S2 + N_S3 + N_S4;
    for (int it = gw; it < N_TOT; it += NGW) {
        int r = it;
        if (r < N_S1) {
            const int l = r / 1536; r %= 1536; const int p = r / 512; r %= 512; const int kb = r / 32, nb = r % 32;
            tr_item(in[I_RKV] + (size_t)(l * 3 + p) * 1024 * 1024, 1024, 1024, 64 * kb, 32 * nb, nullptr,
                    (bf16_t*)(F.ws + WS_RWBIG) + (size_t)l * 3072 * 1024, 1024, p * 1024 + 32 * nb, 64 * kb, scr, F.lane);
            continue;
        }
        r -= N_S1;
        if (r < N_S2) {
            const int l = r / (17 * 32); r %= (17 * 32); const int nbk = r / 32, sub = r % 32, half = sub / 16, kb = sub % 16;
            if (nbk >= 16) continue;
            bf16_t* WT = (bf16_t*)(F.ws + WS_RWLORA) + (size_t)l * 512 * RWK;
            const float* W = nullptr; int ldw = 0, n0 = 0, mui = 0;
            if (nbk < 2) { W = in[I_W1] + (size_t)l * 1024 * 64; ldw = 64; n0 = 32 * nbk; mui = 1; }
            else if (nbk < 4) { W = in[I_A1] + (size_t)l * 1024 * 64; ldw = 64; n0 = 32 * (nbk - 2); mui = 4; }
            else if (nbk < 9) { W = in[I_G1] + (size_t)l * 1024 * 160; ldw = 160; n0 = 32 * (nbk - 4); mui = 5; }
            else if (nbk == 9 && l == 1) { W = in[I_V1]; ldw = 32; n0 = 0; mui = 3; }
            if (W) tr_item(W, ldw, 1024, 64 * kb, n0, half ? in[I_MU] + (l * 6 + mui) * 1024 : nullptr, WT, RWK, 32 * nbk, half * 1024 + 64 * kb, scr, F.lane);
            else zero_item(WT, RWK, 32 * nbk, half * 1024 + 64 * kb, half * 1024 + 64 * kb + 64, F.lane);
            continue;
        }
        r -= N_S2;
        if (r < N_S3) {
            const int l = r / 128; r %= 128; const int blk = r / 32, nb = r % 32;
            unsigned char* base = F.ws + WS_LORA2 + (size_t)l * MiB;
            if (blk == 0) { tr_item(in[I_W2] + (size_t)l * 64 * 1024, 1024, 64, 0, 32 * nb, nullptr, (bf16_t*)(base + L2_W2T), 64, 32 * nb, 0, scr, F.lane); }
            else if (blk == 1) { tr_item(in[I_A2] + (size_t)l * 64 * 1024, 1024, 64, 0, 32 * nb, nullptr, (bf16_t*)(base + L2_A2T), 64, 32 * nb, 0, scr, F.lane); }
            else if (blk == 2) { for (int kb = 0; kb < 4; ++kb) tr_item(in[I_G2] + (size_t)l * 160 * 1024, 1024, 160, 64 * kb, 32 * nb, nullptr, (bf16_t*)(base + L2_G2T), G2K, 32 * nb, 64 * kb, scr, F.lane); }
            else { if (l == 1) tr_item(in[I_V2], 1024, 32, 0, 32 * nb, nullptr, (bf16_t*)(base + L2_V2T), 64, 32 * nb, 0, scr, F.lane); }
            continue;
        }
        r -= N_S3;
        if (r < N_S4) {
            if (r < 1024) { const int l = r / 512; r %= 512; tr_item(in[I_RWO] + (size_t)l * 1024 * 1024, 1024, 1024, 64 * (r / 32), 32 * (r % 32), nullptr, (bf16_t*)(F.ws + WS_RWWO) + (size_t)l * 1024 * 1024, 1024, 32 * (r % 32), 64 * (r / 32), scr, F.lane); continue; }
            r -= 1024;
            if (r < 1024) { tr_item(in[I_KVW], 2064, 1024, 64 * (r / 64), 32 * (r % 64), nullptr, (bf16_t*)(F.ws + WS_KVW), 1024, 32 * (r % 64), 64 * (r / 64), scr, F.lane); continue; }
            r -= 1024;
            if (r < 2048) { const int j = r / 1024; r %= 1024; tr_item(in[I_WQG] + (size_t)j * 1024 * 2048, 2048, 1024, 64 * (r / 64), 32 * (r % 64), nullptr, (bf16_t*)(F.ws + WS_FXQG) + (size_t)j * 2048 * 1024, 1024, 32 * (r % 64), 64 * (r / 64), scr, F.lane); continue; }
            r -= 2048;
            { const int j = r / 512; r %= 512; tr_item(in[I_FWO] + (size_t)j * 1024 * 1024, 1024, 1024, 64 * (r / 32), 32 * (r % 32), nullptr, (bf16_t*)(F.ws + WS_FXWO) + (size_t)j * 1024 * 1024, 1024, 32 * (r % 32), 64 * (r / 32), scr, F.lane); continue; }
        }
    }
}
__device__ __forceinline__ void moe_convert(Frame& F, int l, int wg0, int nwg) {
    const InTab in = F.in;
    LAS float* scr = (LAS float*)(F.lds + F.wave * 8704);
    if (F.bid < wg0 || F.bid >= wg0 + nwg) return;
    const int gw = (F.bid - wg0) * NWAVES + F.wave, NGW = nwg * NWAVES;
    bf16_t* base = (bf16_t*)(F.ws + WS_MOE);
    const int kr = F.lane >> 3, n4 = 4 * (F.lane & 7), c = F.lane & 7;
#define MC_DECODE(it_, W_, ldw_, k0_, n0_, WT_, ldt_, nd0_, kd0_) do { const int e_ = (it_) / 768; int r_ = (it_) % 768; const int le_ = l * 32 + e_; \
        if (r_ < 512) { const int kb_ = r_ / 32, nb_ = r_ % 32, s_ = (nb_ % 8) / 4; W_ = (s_ ? in[I_WUP] : in[I_WGATE]) + (size_t)le_ * 1024 * 512; ldw_ = 512; k0_ = 64 * kb_; n0_ = 128 * (nb_ / 8) + 32 * (nb_ % 4); \
            WT_ = base + (size_t)e_ * 1024 * 1024; ldt_ = 1024; nd0_ = 32 * nb_; kd0_ = 64 * kb_; } \
        else { r_ -= 512; const int kb_ = r_ / 32, nb_ = r_ % 32; W_ = in[I_WDOWN] + (size_t)le_ * 512 * 1024; ldw_ = 1024; k0_ = 64 * kb_; n0_ = 32 * nb_; \
            WT_ = base + (size_t)32 * 1024 * 1024 + (size_t)e_ * 1024 * 512; ldt_ = 512; nd0_ = 32 * nb_; kd0_ = 64 * kb_; } } while (0)
    f32x4 v[8];
    { int it = gw; if (it < 32 * 768) { const float* W; int ldw, k0, n0; bf16_t* WT; int ldt, nd0, kd0; MC_DECODE(it, W, ldw, k0, n0, WT, ldt, nd0, kd0);
#pragma unroll
        for (int i = 0; i < 8; ++i) v[i] = *(const f32x4*)(W + (size_t)(k0 + kr + 8 * i) * ldw + n0 + n4); (void)WT; (void)ldt; (void)nd0; (void)kd0; } }
    for (int it = gw; it < 32 * 768; it += NGW) {
        const float* W; int ldw, k0, n0; bf16_t* WT; int ldt, nd0, kd0; MC_DECODE(it, W, ldw, k0, n0, WT, ldt, nd0, kd0);
#pragma unroll
        for (int i = 0; i < 8; ++i) { LAS float* d = scr + (kr + 8 * i) * 33 + n4; d[0] = v[i][0]; d[1] = v[i][1]; d[2] = v[i][2]; d[3] = v[i][3]; }
        if (it + NGW < 32 * 768) { const float* Wn; int ldwn, k0n, n0n; bf16_t* WTn; int ldtn, nd0n, kd0n; MC_DECODE(it + NGW, Wn, ldwn, k0n, n0n, WTn, ldtn, nd0n, kd0n);
#pragma unroll
            for (int i = 0; i < 8; ++i) v[i] = *(const f32x4*)(Wn + (size_t)(k0n + kr + 8 * i) * ldwn + n0n + n4); (void)WTn; (void)ldtn; (void)nd0n; (void)kd0n; }
        LDS_WAIT(); asm volatile("" ::: "memory");
#pragma unroll
        for (int j = 0; j < 4; ++j) {
            const int n = (F.lane >> 3) + 8 * j; const LAS float* sp = scr + (8 * c) * 33 + n;
            u32x4 o; o.x = pk2(sp[0 * 33], sp[1 * 33]); o.y = pk2(sp[2 * 33], sp[3 * 33]); o.z = pk2(sp[4 * 33], sp[5 * 33]); o.w = pk2(sp[6 * 33], sp[7 * 33]);
            *(u32x4*)(WT + (size_t)(nd0 + n) * ldt + kd0 + 8 * c) = o;
        }
        LDS_WAIT(); asm volatile("" ::: "memory");
    }
#undef MC_DECODE
    __syncthreads();
}

struct Unit { int pm, pn; };
struct SchedDense {
    int nM, nN, G, c;
    __device__ __forceinline__ bool next(int i, Unit& u) const {
        const int nwg = nM * nN; const long L = (long)i * G + c; if (L >= nwg) return false;
        int wgid = (int)L; { const int q = nwg / 8, r = nwg % 8, xcd = wgid % 8, off = wgid / 8; wgid = (xcd < r ? xcd * (q + 1) : r * (q + 1) + (xcd - r) * q) + off; }
        const int nig = 8 * nN, gid = wgid / nig, fm = gid * 8, gsz = (nM - fm) < 8 ? (nM - fm) : 8;
        u.pm = fm + ((wgid % nig) % gsz); u.pn = (wgid % nig) / gsz; return true;
    }
    __device__ __forceinline__ size_t boff(const Unit& u, int K) const { return (size_t)u.pn * 256 * K; }
    __device__ __forceinline__ size_t aoff(const Unit&) const { return 0; }
};
struct SchedRKV : SchedDense {
    __device__ __forceinline__ size_t aoff(const Unit& u) const { return (size_t)(u.pn >> 2) * X3S; }
};
struct SchedMoe {
    const LAS int* tt; int ntiles, G, c; size_t estride;
    __device__ __forceinline__ bool next(int i, Unit& u) const { const long L = (long)i * G + c; if (L >= (long)ntiles * 4) return false; u.pm = (int)(L / 4); u.pn = (int)(L % 4); return true; }
    __device__ __forceinline__ size_t boff(const Unit& u, int K) const { return (size_t)(tt[u.pm] >> 16) * estride + (size_t)u.pn * 256 * K; }
    __device__ __forceinline__ size_t aoff(const Unit&) const { return 0; }
};
template <class Epi, class Sched>
__device__ __forceinline__ void gemm_phase(Frame& F, const bf16_t* A, int lda, const bf16_t* Bt, int K, const Sched& S, const Epi& E) {
    const int wr = F.wave >> 2, wc = F.wave & 3, fr = F.lane & 15, fq = F.lane >> 4;
    Unit u;
    for (int i = 0; S.next(i, u); ++i) {
        const bf16_t* Bb = Bt + S.boff(u, K) + (size_t)(wc * 32 + fr) * K + 8 * fq;
        for (int ai = 0; ai < 2; ++ai) {
            f32x4 acc[2][4][2];
#pragma unroll
            for (int b = 0; b < 2; ++b)
#pragma unroll
                for (int m = 0; m < 4; ++m)
#pragma unroll
                    for (int n = 0; n < 2; ++n) acc[b][m][n] = (f32x4){0.f, 0.f, 0.f, 0.f};
            const bf16_t* Ab = A + (size_t)(u.pm * 256 + ai * 128 + wr * 64 + fr) * lda + 8 * fq;
            for (int k0 = 0; k0 < K; k0 += 32) {
                bf16x8 bfr[2][2], af[4];
#pragma unroll
                for (int b = 0; b < 2; ++b)
#pragma unroll
                    for (int n = 0; n < 2; ++n) bfr[b][n] = *(const bf16x8*)(Bb + (size_t)(b * 128 + n * 16) * K + k0);
#pragma unroll
                for (int m = 0; m < 4; ++m) af[m] = *(const bf16x8*)(Ab + (size_t)(m * 16) * lda + k0);
#pragma unroll
                for (int b = 0; b < 2; ++b)
#pragma unroll
                    for (int m = 0; m < 4; ++m)
#pragma unroll
                        for (int n = 0; n < 2; ++n) acc[b][m][n] = __builtin_amdgcn_mfma_f32_16x16x32_bf16(bfr[b][n], af[m], acc[b][m][n], 0, 0, 0);
            }
            E(acc, ai, u, wr, wc, fr, fq);
        }
    }
}
#define PG8_LAS __attribute__((address_space(3)))
constexpr int BM = 256, BK = 64, HALF = 128, HTB = HALF * BK * 2  , STAGE_BYTES = 8 * HTB;

__host__ __device__ __forceinline__ int lds_byte(int r, int c) { const int st = (r >> 4) * 2 + (c >> 5), rr = r & 15, cc = c & 31, ob = rr * 64 + cc * 2; return st * 1024 + (ob ^ (((ob >> 9) & 1) << 5)); }
__host__ __device__ __forceinline__ void stage_rc(int b, int& R, int& C) { const int st = b / 1024, sb = b % 1024, swz = sb ^ (((sb >> 9) & 1) << 5); R = (st >> 1) * 16 + swz / 64; C = (st & 1) * 32 + (swz % 64) / 2; }
__host__ __device__ __forceinline__ int perm32(int rho) { const int n = rho >> 4, i = rho & 15; return 8 * (i >> 2) + 4 * n + (i & 3); }
template <class Epi, class Sched, bool GATHER = false, bool ALIGN_EPI = true, bool SP2 = true>
__device__ __forceinline__ void gemm_fast(Frame& F, const bf16_t* Ag, int lda, const bf16_t* Btg, int Kin, const Sched& S, const Epi& E, const LAS int* tokL = nullptr) {
    static_assert(!GATHER || SP2, "gather mode is written for the SP2 loop");
    PG8_LAS unsigned char* lds = (PG8_LAS unsigned char*)F.lds;
    const int tid = F.tid, wid = F.wave, lane = F.lane, wr = wid >> 2, wc = wid & 3, fr = lane & 15, fq = lane >> 4;
    int K = Kin; asm volatile("" : "+s"(K));
    const int nt = K / BK;
    unsigned voffA[2], voffB[2];
#pragma unroll
    for (int i = 0; i < 2; ++i) { int R, C; stage_rc(tid * 16 + i * 8192, R, C); const int Rb = (Epi::BCONT ? (R >> 5) * 64 : (R & ~31)) + perm32(R & 31);
        voffA[i] = (unsigned)(R * lda + C) * 2u; voffB[i] = (unsigned)(Rb * K + C) * 2u; }
    const size_t kstep = (size_t)(BK * 2);
    const size_t hstepA = (size_t)HALF * lda * 2, hstep = (size_t)(Epi::BCONT ? 32 : HALF) * K * 2;
    const size_t tstepA = 2 * hstepA;
    const unsigned ldsw = (unsigned)wid * 1024u;
    const int aoff = lds_byte(wr * 64 + fr, fq * 8), boff = lds_byte(wc * 32 + fr, fq * 8);
#define PG8_SA(b, h) (((b) * 2 + (h)) * HTB)
#define PG8_SB(b, h) ((4 + (b) * 2 + (h)) * HTB)
    const unsigned ldsb = (unsigned)__builtin_amdgcn_readfirstlane((int)((unsigned)(size_t)lds + ldsw));
#define PG8_STAGE(bufoff, gbase, voff) do { _Pragma("unroll") for (int _i = 0; _i < 2; ++_i) { unsigned keep_; \
        asm volatile("s_mov_b32 %0, m0\n\ts_mov_b32 m0, %3\n\ts_nop 0\n\tglobal_load_lds_dwordx4 %1, %2\n\ts_mov_b32 m0, %0" : "=&s"(keep_) : "v"((voff)[_i]), "s"((const char*)(gbase)), "s"(ldsb + (unsigned)((bufoff) + _i * 8192)) : "memory"); } } while (0)
    unsigned gcu[2][2] = {{0u, 0u}, {0u, 0u}}, gnx[2][2] = {{0u, 0u}, {0u, 0u}};
#define PG8_GOFS(dst, ord) do { int tl_ = tid; asm volatile("" : "+v"(tl_));   _Pragma("unroll") for (int _h = 0; _h < 2; ++_h) _Pragma("unroll") for (int _i = 0; _i < 2; ++_i) { int R_, C_; stage_rc(tl_ * 16 + _i * 8192, R_, C_); \
        dst[_h][_i] = ((unsigned)tokL[(ord) * 256 + _h * 128 + R_] * (unsigned)lda + (unsigned)C_) * 2u; } } while (0)
#define PG8_STAGE_A(bufoff, gptr, half, usenext) do { if constexpr (GATHER) { unsigned vv_[2]; _Pragma("unroll") for (int _j = 0; _j < 2; ++_j) vv_[_j] = (usenext) ? gnx[half][_j] : gcu[half][_j]; PG8_STAGE(bufoff, gptr, vv_); } \
        else { PG8_STAGE(bufoff, (gptr) + ((half) ? hstepA : (size_t)0), voffA); } } while (0)
#define PG8_LDA(dst, b, h) do { _Pragma("unroll") for (int m = 0; m < 4; ++m) _Pragma("unroll") for (int k = 0; k < 2; ++k) dst[m][k] = *(const PG8_LAS bf16x8*)(lds + PG8_SA(b, h) + aoff + m * 2048 + k * 1024); } while (0)
#define PG8_LDB(dst, b, h) do { _Pragma("unroll") for (int n = 0; n < 2; ++n) _Pragma("unroll") for (int k = 0; k < 2; ++k) dst[n][k] = *(const PG8_LAS bf16x8*)(lds + PG8_SB(b, h) + boff + n * 2048 + k * 1024); } while (0)
#define PG8_MMA(ai, bj, At, Bt) do { __builtin_amdgcn_s_setprio(1); _Pragma("unroll") for (int m = 0; m < 4; ++m) _Pragma("unroll") for (int n = 0; n < 2; ++n) _Pragma("unroll") for (int k = 0; k < 2; ++k) \
        acc[ai][bj][m][n] = __builtin_amdgcn_mfma_f32_16x16x32_bf16(Bt[n][k], At[m][k], acc[ai][bj][m][n], 0, 0, 0); __builtin_amdgcn_s_setprio(0); } while (0)
#define PG8_WAIT_V(n) asm volatile("s_waitcnt vmcnt(" #n ")" ::: "memory")
#define PG8_WAIT_R(rel) do { if (rel) asm volatile("s_waitcnt vmcnt(%0)" :: "n"(8 + Epi::NST) : "memory"); else PG8_WAIT_V(8); } while (0)
#define PG8_WAIT_L(n) asm volatile("s_waitcnt lgkmcnt(" #n ")" ::: "memory")
#define PG8_BAR __builtin_amdgcn_s_barrier()
#define PG8_SCHED __builtin_amdgcn_sched_barrier(0)
    Unit cur, nxt; int ui = 0;
    if (!S.next(0, cur)) return;
    f32x4 acc[2][2][4][2];
#pragma unroll
    for (int a = 0; a < 2; ++a)
#pragma unroll
        for (int b = 0; b < 2; ++b)
#pragma unroll
            for (int m = 0; m < 4; ++m)
#pragma unroll
                for (int n = 0; n < 2; ++n) acc[a][b][m][n] = (f32x4){0.f, 0.f, 0.f, 0.f};
    bf16x8 At[4][2], B0[2][2], B1[2][2];
    const char* cA = GATHER ? (const char*)Ag : (const char*)Ag + 2 * S.aoff(cur) + (size_t)cur.pm * tstepA; const char* cB = (const char*)Btg + 2 * S.boff(cur, K);
    if constexpr (GATHER) PG8_GOFS(gcu, 0);
    if constexpr (SP2) {
        PG8_STAGE(PG8_SB(0, 0), cB, voffB); PG8_STAGE(PG8_SB(0, 1), cB + hstep, voffB); PG8_STAGE_A(PG8_SA(0, 0), cA, 0, false); PG8_STAGE_A(PG8_SA(0, 1), cA, 1, false);
        if (wr == 1) PG8_BAR;
        PG8_WAIT_V(2); PG8_BAR;
        PG8_STAGE(PG8_SB(1, 0), cB + kstep, voffB); PG8_STAGE_A(PG8_SA(1, 0), cA + kstep, 0, false); PG8_STAGE(PG8_SB(1, 1), cB + hstep + kstep, voffB);
        PG8_WAIT_V(6); PG8_BAR;
    } else {
        PG8_STAGE(PG8_SB(0, 0), cB, voffB); PG8_STAGE(PG8_SA(0, 0), cA, voffA); PG8_STAGE(PG8_SB(0, 1), cB + hstep, voffB); PG8_STAGE(PG8_SA(0, 1), cA + hstepA, voffA);
        if (wr == 1) PG8_BAR;
        PG8_WAIT_V(4); PG8_BAR;
        PG8_STAGE(PG8_SB(1, 0), cB + kstep, voffB); PG8_STAGE(PG8_SA(1, 0), cA + kstep, voffA); PG8_STAGE(PG8_SB(1, 1), cB + hstep + kstep, voffB);
        PG8_WAIT_V(6); PG8_BAR;
    }
    for (;;) {
        const bool has_next = S.next(ui + 1, nxt);
        const char* nA = GATHER ? cA : (has_next ? (const char*)Ag + 2 * S.aoff(nxt) + (size_t)nxt.pm * tstepA : cA);
        if constexpr (GATHER) { if (has_next) PG8_GOFS(gnx, ui + 1); else { gnx[0][0] = gcu[0][0]; gnx[0][1] = gcu[0][1]; gnx[1][0] = gcu[1][0]; gnx[1][1] = gcu[1][1]; } } const char* nB = has_next ? (const char*)Btg + 2 * S.boff(nxt, K) : cB;
#define PG8_ITER(WAITA, ST11) do { \
            const bool last = (t == nt - 2); \
            const char* a1 = cA + (size_t)(t + 1) * kstep;                                             \
            const char* a2 = last ? nA : cA + (size_t)(t + 2) * kstep; const char* b2 = last ? nB : cB + (size_t)(t + 2) * kstep;     \
            const char* a3 = a2 + kstep; const char* b3 = b2 + kstep;                                \
              \
            PG8_LDB(B0, 0, 0); PG8_LDB(B1, 0, 1); PG8_SCHED; PG8_LDA(At, 0, 0); ST11; \
            WAITA; PG8_WAIT_L(0); PG8_BAR; PG8_MMA(0, 0, At, B0); PG8_MMA(0, 1, At, B1); PG8_BAR; PG8_SCHED; \
              \
            PG8_LDA(At, 0, 1); PG8_STAGE(PG8_SB(0, 0), b2, voffB); PG8_STAGE(PG8_SB(0, 1), b2 + hstep, voffB); PG8_STAGE_A(PG8_SA(0, 0), a2, 0, last); \
            WAITA; PG8_WAIT_L(0); PG8_BAR; PG8_MMA(1, 0, At, B0); PG8_MMA(1, 1, At, B1); PG8_BAR; PG8_SCHED; \
              \
            PG8_LDB(B0, 1, 0); PG8_LDB(B1, 1, 1); PG8_SCHED; PG8_LDA(At, 1, 0); PG8_STAGE_A(PG8_SA(0, 1), a2, 1, last); \
            WAITA; PG8_WAIT_L(0); PG8_BAR; PG8_MMA(0, 0, At, B0); PG8_MMA(0, 1, At, B1); PG8_BAR; PG8_SCHED; \
              \
            PG8_LDA(At, 1, 1); PG8_STAGE(PG8_SB(1, 0), b3, voffB); PG8_STAGE(PG8_SB(1, 1), b3 + hstep, voffB); PG8_STAGE_A(PG8_SA(1, 0), a3, 0, last); \
            PG8_WAIT_V(8); PG8_WAIT_L(0); PG8_BAR; PG8_MMA(1, 0, At, B0); PG8_MMA(1, 1, At, B1); PG8_BAR; PG8_SCHED; } while (0)
        int t = 0;
        if (ui > 0) { PG8_ITER(asm volatile("s_waitcnt vmcnt(%0)" :: "n"(8 + Epi::NST) : "memory"), (void)0); t = 2; }
        for (; t < nt; t += 2) PG8_ITER(PG8_WAIT_V(8), PG8_STAGE_A(PG8_SA(1, 1), a1, 1, false));
#undef PG8_ITER
        if constexpr (SP2) { if (has_next) PG8_STAGE_A(PG8_SA(1, 1), nA + kstep, 1, true); }
        if constexpr (ALIGN_EPI) { if (wr == 0) PG8_BAR; }
        { int fr_ = fr, fq_ = fq; asm volatile("" : "+v"(fr_), "+v"(fq_)); E(acc[0], 0, cur, wr, wc, fr_, fq_); E(acc[1], 1, cur, wr, wc, fr_, fq_); }
        if (!has_next) break;
#pragma unroll
        for (int a = 0; a < 2; ++a)
#pragma unroll
            for (int b = 0; b < 2; ++b)
#pragma unroll
                for (int m = 0; m < 4; ++m)
#pragma unroll
                    for (int n = 0; n < 2; ++n) acc[a][b][m][n] = (f32x4){0.f, 0.f, 0.f, 0.f};
        cur = nxt; cA = nA; cB = nB; ++ui;
        if constexpr (GATHER) { gcu[0][0] = gnx[0][0]; gcu[0][1] = gnx[0][1]; gcu[1][0] = gnx[1][0]; gcu[1][1] = gnx[1][1]; }
        if constexpr (ALIGN_EPI) { if (wr == 1) PG8_BAR; }
    }
    PG8_WAIT_V(0);
    if constexpr (!ALIGN_EPI) { if (wr == 0) PG8_BAR; }
    PG8_BAR;
#undef PG8_SA
#undef PG8_SB
#undef PG8_STAGE
#undef PG8_LDA
#undef PG8_GOFS
#undef PG8_STAGE_A
#undef PG8_LDB
#undef PG8_MMA
#undef PG8_WAIT_V
#undef PG8_WAIT_R
#undef PG8_WAIT_L
#undef PG8_BAR
#undef PG8_SCHED
}
__device__ __forceinline__ void st_bf16x4(bf16_t* p, f32x4 v) { u32x2 w; w.x = pk2(v[0], v[1]); w.y = pk2(v[2], v[3]); *(u32x2*)p = w; }
__device__ __forceinline__ f32x4 ld_bf16x4(const bf16_t* p) { const u32x2 w = *(const u32x2*)p; return (f32x4){lo16(w.x), hi16(w.x), lo16(w.y), hi16(w.y)}; }
__device__ __forceinline__ u32x4 pk8(f32x4 a, f32x4 b) { u32x4 w; w.x = pk2(a[0], a[1]); w.y = pk2(a[2], a[3]); w.z = pk2(b[0], b[1]); w.w = pk2(b[2], b[3]); return w; }
__device__ __forceinline__ u32x4 bperm4(int idx, u32x4 w) { u32x4 r; r.x = (unsigned)__builtin_amdgcn_ds_bpermute(idx, (int)w.x); r.y = (unsigned)__builtin_amdgcn_ds_bpermute(idx, (int)w.y); r.z = (unsigned)__builtin_amdgcn_ds_bpermute(idx, (int)w.z); r.w = (unsigned)__builtin_amdgcn_ds_bpermute(idx, (int)w.w); return r; }
#define EPI_LOOP(ACT, ...) do { const int L_ = fq * 16 + fr, r3_ = L_ >> 3, p3_ = L_ & 7, src4_ = (((p3_ & 3) << 4) | r3_) << 2; const bool hi_ = (p3_ & 4) != 0; \
    _Pragma("unroll") for (int m = 0; m < 4; ++m) { u32x4 wb_[2]; \
        _Pragma("unroll") for (int bj = 0; bj < 2; ++bj) { const int colt0 = wc * 64 + bj * 32 + fq * 8; f32x4 v0 = acc[bj][m][0], v1 = acc[bj][m][1]; (void)colt0; ACT; wb_[bj] = pk8(v0, v1); } \
        _Pragma("unroll") for (int h = 0; h < 2; ++h) { const int row = u.pm * 256 + ai * 128 + wr * 64 + m * 16 + h * 8 + r3_, colt = wc * 64 + p3_ * 8; \
            const u32x4 wa_ = bperm4(src4_ + h * 32, wb_[0]), wc_ = bperm4(src4_ + h * 32, wb_[1]); u32x4 w; w.x = hi_ ? wc_.x : wa_.x; w.y = hi_ ? wc_.y : wa_.y; w.z = hi_ ? wc_.z : wa_.z; w.w = hi_ ? wc_.w : wa_.w; \
            __VA_ARGS__ } asm volatile("" ::: "memory"); } } while (0)

struct EpiPlain {
    bf16_t* O; int ldc; static constexpr int NST = 16; static constexpr bool BCONT = true;
    __device__ __forceinline__ void operator()(const f32x4 (&acc)[2][4][2], int ai, const Unit& u, int wr, int wc, int fr, int fq) const {
        EPI_LOOP(, { __builtin_nontemporal_store(w, (u32x4*)(O + (size_t)row * ldc + u.pn * 256 + colt)); });
    }
};
struct EpiNone { static constexpr int NST = 0; static constexpr bool BCONT = true;
    __device__ __forceinline__ void operator()(const f32x4 (&acc)[2][4][2], int ai, const Unit& u, int wr, int wc, int fr, int fq) const {
        _Pragma("unroll") for (int m = 0; m < 4; ++m) _Pragma("unroll") for (int bj = 0; bj < 2; ++bj) asm volatile("" :: "v"(acc[bj][m][0]), "v"(acc[bj][m][1])); }
};
struct EpiPriv { bf16_t* base; int bid; static constexpr int NST = 16; static constexpr bool BCONT = true;
    __device__ __forceinline__ void operator()(const f32x4 (&acc)[2][4][2], int ai, const Unit& u, int wr, int wc, int fr, int fq) const {
        EPI_LOOP(, { __builtin_nontemporal_store(w, (u32x4*)(base + (size_t)bid * 65536 + (size_t)(row - u.pm * 256) * 256 + colt)); });
    }
};
struct EpiRKV {
    bf16_t* RKV; bf16_t* VF; int l; static constexpr int NST = 16; static constexpr bool BCONT = true;
    __device__ __forceinline__ void operator()(const f32x4 (&acc)[2][4][2], int ai, const Unit& u, int wr, int wc, int fr, int fq) const {
        const bool vf = (l == 0) && (u.pn >= 8);
        EPI_LOOP(, { if (vf) __builtin_nontemporal_store(w, (u32x4*)(VF + (size_t)row * 1024 + (u.pn - 8) * 256 + colt)); else __builtin_nontemporal_store(w, (u32x4*)(RKV + (size_t)row * 3072 + u.pn * 256 + colt)); });
    }
};
struct EpiLA {
    bf16_t* LA; static constexpr int NST = 16; static constexpr bool BCONT = true;
    __device__ __forceinline__ void operator()(const f32x4 (&acc)[2][4][2], int ai, const Unit& u, int wr, int wc, int fr, int fq) const {
        EPI_LOOP({ const int c = u.pn * 256 + colt0;
            if (c < 64) { _Pragma("unroll") for (int q = 0; q < 4; ++q) { v0[q] = tanhf_(v0[q]); v1[q] = tanhf_(v1[q]); } }
            else if (c >= 128 && c < 288) { _Pragma("unroll") for (int q = 0; q < 4; ++q) { v0[q] = sigmoidf_(v0[q]); v1[q] = sigmoidf_(v1[q]); } } },
            { __builtin_nontemporal_store(w, (u32x4*)(LA + (size_t)row * LAW + u.pn * 256 + colt)); });
    }
};
struct EpiSplit2 {
    bf16_t* O0; bf16_t* O1; int sig1; static constexpr int NST = 16; static constexpr bool BCONT = true;
    __device__ __forceinline__ void operator()(const f32x4 (&acc)[2][4][2], int ai, const Unit& u, int wr, int wc, int fr, int fq) const {
        if (u.pn < 4) { EPI_LOOP(, { __builtin_nontemporal_store(w, (u32x4*)(O0 + (size_t)row * 1024 + u.pn * 256 + colt)); }); }
        else { EPI_LOOP({ if (sig1) { _Pragma("unroll") for (int q = 0; q < 4; ++q) { v0[q] = sigmoidf_(v0[q]); v1[q] = sigmoidf_(v1[q]); } } }, { __builtin_nontemporal_store(w, (u32x4*)(O1 + (size_t)row * 1024 + (u.pn - 4) * 256 + colt)); }); }
    }
};
struct EpiMoe1 {
    bf16_t* HM; static constexpr int NST = 8; static constexpr bool BCONT = false;
    __device__ __forceinline__ void operator()(const f32x4 (&acc)[2][4][2], int ai, const Unit& u, int wr, int wc, int fr, int fq) const {
        const int L_ = fq * 16 + fr, src4_ = (((L_ & 3) << 4) | (L_ >> 2)) << 2, r2_ = L_ >> 2, p2_ = L_ & 3;
#pragma unroll
            for (int m = 0; m < 4; ++m) { const int row = u.pm * 256 + ai * 128 + wr * 64 + m * 16 + r2_; f32x4 o[2];
#pragma unroll
                for (int n = 0; n < 2; ++n) { const f32x4 g = acc[0][m][n], up = acc[1][m][n];
#pragma unroll
                    for (int q = 0; q < 4; ++q) o[n][q] = g[q] * sigmoidf_(g[q]) * up[q]; }
                u32x4 w = pk8(o[0], o[1]); w.x = (unsigned)__builtin_amdgcn_ds_bpermute(src4_, (int)w.x); w.y = (unsigned)__builtin_amdgcn_ds_bpermute(src4_, (int)w.y); w.z = (unsigned)__builtin_amdgcn_ds_bpermute(src4_, (int)w.z); w.w = (unsigned)__builtin_amdgcn_ds_bpermute(src4_, (int)w.w);
                __builtin_nontemporal_store(w, (u32x4*)(HM + (size_t)row * 512 + u.pn * 128 + wc * 32 + p2_ * 8)); }
    }
};

struct Row { f32x4 v[4]; };
__device__ __forceinline__ Row ld_row_f32(const float* p, int lane) { Row r;
#pragma unroll
    for (int j = 0; j < 4; ++j) r.v[j] = *(const f32x4*)(p + 256 * j + 4 * lane); return r; }
__device__ __forceinline__ void st_row_f32(float* p, int lane, const Row& r) {
#pragma unroll
    for (int j = 0; j < 4; ++j) *(f32x4*)(p + 256 * j + 4 * lane) = r.v[j]; }
__device__ __forceinline__ Row ld_row_bf16(const bf16_t* p, int lane) { Row r;
#pragma unroll
    for (int j = 0; j < 4; ++j) r.v[j] = ld_bf16x4(p + 256 * j + 4 * lane); return r; }
__device__ __forceinline__ void st_row_bf16(bf16_t* p, int lane, const Row& r) {
#pragma unroll
    for (int j = 0; j < 4; ++j) st_bf16x4(p + 256 * j + 4 * lane, r.v[j]); }
__device__ __forceinline__ Row row_ln(const Row& u, const Row& g, const Row& b) {
    float s = 0.f;
#pragma unroll
    for (int j = 0; j < 4; ++j) s += (u.v[j][0] + u.v[j][1]) + (u.v[j][2] + u.v[j][3]);
    const float mean = wave_sum(s) * (1.0f / 1024.0f); float q = 0.f; Row d;
#pragma unroll
    for (int j = 0; j < 4; ++j) { d.v[j] = u.v[j] - mean; q += (d.v[j][0] * d.v[j][0] + d.v[j][1] * d.v[j][1]) + (d.v[j][2] * d.v[j][2] + d.v[j][3] * d.v[j][3]); }
    const float rstd = 1.0f / sqrtf(wave_sum(q) * (1.0f / 1024.0f) + LN_EPS); Row o;
#pragma unroll
    for (int j = 0; j < 4; ++j) o.v[j] = d.v[j] * rstd * g.v[j] + b.v[j];
    return o;
}
__device__ __forceinline__ float row_dot(const Row& a, const float* w, int lane) {
    float s = 0.f;
#pragma unroll
    for (int j = 0; j < 4; ++j) { const f32x4 x = *(const f32x4*)(w + 256 * j + 4 * lane); s += (a.v[j][0] * x[0] + a.v[j][1] * x[1]) + (a.v[j][2] * x[2] + a.v[j][3] * x[3]); }
    return s;
}

constexpr int APITCH = 1032;
template <int NCB>
__device__ __forceinline__ void skinny_mfma(Frame& F, const LAS bf16_t* AH, const LAS bf16_t* AL, const bf16_t* BH, const bf16_t* BL, LAS float* part) {
    const int fr = F.lane & 15, fq = F.lane >> 4;
    f32x4 acc[NCB];
#pragma unroll
    for (int cb = 0; cb < NCB; ++cb) acc[cb] = (f32x4){0.f, 0.f, 0.f, 0.f};
#pragma unroll
    for (int kb = 0; kb < 4; ++kb) {
        const int k0 = 128 * F.wave + 32 * kb + 8 * fq;
        const bf16x8 ah = *(const LAS bf16x8*)(AH + fr * APITCH + k0), al = *(const LAS bf16x8*)(AL + fr * APITCH + k0);
#pragma unroll
        for (int cb = 0; cb < NCB; ++cb) {
            const bf16x8 bh = *(const bf16x8*)(BH + (size_t)(cb * 16 + fr) * 1024 + k0), bl = *(const bf16x8*)(BL + (size_t)(cb * 16 + fr) * 1024 + k0);
            acc[cb] = __builtin_amdgcn_mfma_f32_16x16x32_bf16(bh, ah, acc[cb], 0, 0, 0);
            acc[cb] = __builtin_amdgcn_mfma_f32_16x16x32_bf16(bl, ah, acc[cb], 0, 0, 0);
            acc[cb] = __builtin_amdgcn_mfma_f32_16x16x32_bf16(bh, al, acc[cb], 0, 0, 0);
        }
    }
#pragma unroll
    for (int cb = 0; cb < NCB; ++cb) *(LAS f32x4*)(part + (F.wave * 16 + fr) * 48 + cb * 16 + 4 * fq) = acc[cb];
}
template <int NCB> struct SkB { bf16x8 h[4][NCB]; };
template <int NCB>
__device__ __forceinline__ void skinny_loadB(Frame& F, const bf16_t* BH, const bf16_t* BL, SkB<NCB>& B) {
    const int fr = F.lane & 15, fq = F.lane >> 4;
#pragma unroll
    for (int kb = 0; kb < 4; ++kb) { const int k0 = 128 * F.wave + 32 * kb + 8 * fq;
#pragma unroll
        for (int cb = 0; cb < NCB; ++cb) B.h[kb][cb] = *(const bf16x8*)(BH + (size_t)(cb * 16 + fr) * 1024 + k0); }
    (void)BL;
}
template <int NCB>
__device__ __forceinline__ void skinny_mma(Frame& F, const LAS bf16_t* AH, const LAS bf16_t* AL, const SkB<NCB>& B, const bf16_t* BL, LAS float* part) {
    const int fr = F.lane & 15, fq = F.lane >> 4;
    f32x4 acc[NCB];
#pragma unroll
    for (int cb = 0; cb < NCB; ++cb) acc[cb] = (f32x4){0.f, 0.f, 0.f, 0.f};
#pragma unroll
    for (int kb = 0; kb < 4; ++kb) {
        const int k0 = 128 * F.wave + 32 * kb + 8 * fq;
        const bf16x8 ah = *(const LAS bf16x8*)(AH + fr * APITCH + k0), al = *(const LAS bf16x8*)(AL + fr * APITCH + k0);
#pragma unroll
        for (int cb = 0; cb < NCB; ++cb) {
            const bf16x8 bl = *(const bf16x8*)(BL + (size_t)(cb * 16 + fr) * 1024 + k0);
            acc[cb] = __builtin_amdgcn_mfma_f32_16x16x32_bf16(B.h[kb][cb], ah, acc[cb], 0, 0, 0);
            acc[cb] = __builtin_amdgcn_mfma_f32_16x16x32_bf16(B.h[kb][cb], al, acc[cb], 0, 0, 0);
            acc[cb] = __builtin_amdgcn_mfma_f32_16x16x32_bf16(bl, ah, acc[cb], 0, 0, 0);
        }
    }
#pragma unroll
    for (int cb = 0; cb < NCB; ++cb) *(LAS f32x4*)(part + (F.wave * 16 + fr) * 48 + cb * 16 + 4 * fq) = acc[cb];
}
struct RowPk { u32x2 v[4]; };
__device__ __forceinline__ RowPk ld_row_pk(const bf16_t* p, int lane) { RowPk r;
#pragma unroll
    for (int j = 0; j < 4; ++j) r.v[j] = *(const u32x2*)(p + 256 * j + 4 * lane); return r; }
__device__ __forceinline__ Row unpk_row(const RowPk& p) { Row r;
#pragma unroll
    for (int j = 0; j < 4; ++j) r.v[j] = (f32x4){lo16(p.v[j].x), hi16(p.v[j].x), lo16(p.v[j].y), hi16(p.v[j].y)}; return r; }
typedef _Float16 h16x2 __attribute__((ext_vector_type(2)));
__device__ __forceinline__ unsigned pkh2(float lo, float hi) { return __builtin_bit_cast(unsigned, __builtin_amdgcn_cvt_pkrtz(lo, hi)); }
__device__ __forceinline__ Row unpk_row_h(const RowPk& p) { Row r;
#pragma unroll
    for (int j = 0; j < 4; ++j) { const unsigned wx = p.v[j].x, wy = p.v[j].y;
        const h16x2 a = __builtin_bit_cast(h16x2, wx), b = __builtin_bit_cast(h16x2, wy); r.v[j] = (f32x4){(float)a[0], (float)a[1], (float)b[0], (float)b[1]}; } return r; }
__device__ __forceinline__ void st_row_h(bf16_t* p, int lane, const Row& r) {
#pragma unroll
    for (int j = 0; j < 4; ++j) { u32x2 w; w.x = pkh2(r.v[j][0], r.v[j][1]); w.y = pkh2(r.v[j][2], r.v[j][3]); *(u32x2*)(p + 256 * j + 4 * lane) = w; } }
__device__ __forceinline__ RowPk split_row(const Row& h, LAS bf16_t* ah, LAS bf16_t* al, int lane) { RowPk hp;
#pragma unroll
    for (int j = 0; j < 4; ++j) { unsigned hb[4], lb[4];
#pragma unroll
        for (int q = 0; q < 4; ++q) { hb[q] = f2bf(h.v[j][q]); lb[q] = f2bf(h.v[j][q] - __uint_as_float(hb[q] << 16)); }
        hp.v[j].x = hb[0] | (hb[1] << 16); hp.v[j].y = hb[2] | (hb[3] << 16);
        *(LAS u32x2*)(ah + 256 * j + 4 * lane) = hp.v[j]; u32x2 lw; lw.x = lb[0] | (lb[1] << 16); lw.y = lb[2] | (lb[3] << 16); *(LAS u32x2*)(al + 256 * j + 4 * lane) = lw; }
    return hp; }

template <bool DRY = false>
__device__ __forceinline__ void tok_a(Frame& F, int l) {
    const InTab in = F.in;
    const bf16_t* Y16 = (const bf16_t*)(F.ws + WS_Y16); bf16_t* Hb = (bf16_t*)(F.ws + WS_H2); bf16_t* XS = (bf16_t*)(F.ws + WS_XS);
    const bf16_t* RTH = (const bf16_t*)(F.ws + WS_RT) + (size_t)l * 48 * 1024; const bf16_t* RTL = RTH + (size_t)4 * 48 * 1024;
    float* gates = (float*)(F.ws + WS_GATE); int* asg = (int*)(F.ws + WS_ASG);
    LAS unsigned* lcnt = (LAS unsigned*)F.lds;
    LAS unsigned* ltab = (LAS unsigned*)(F.lds + 1024);
    LAS float* lgt = (LAS float*)(F.lds + 2048);
    LAS float* part = (LAS float*)(F.lds + 8192);
    LAS bf16_t* AH = (LAS bf16_t*)(F.lds + 32768); LAS bf16_t* AL = AH + 16 * APITCH;
    const Row lng = ld_row_f32(in[I_LNG] + (size_t)(l * 2 + 0) * 1024, F.lane), lnb = ld_row_f32(in[I_LNB] + (size_t)(l * 2 + 0) * 1024, F.lane);
    for (int blk = F.bid; blk < T / 128; blk += F.G) {
        if (F.tid < 64) lcnt[F.tid] = 0u;
        LBAR();
        const int tb = blk * 128, b = tb / SEQ;
        const float* mod = (const float*)(F.ws + WS_MOD) + ((size_t)l * 8 + b) * 6144;
        const Row gt = ld_row_f32(mod + 2 * 1024, F.lane), shf = ld_row_f32(mod + 3 * 1024, F.lane), scf = ld_row_f32(mod + 4 * 1024, F.lane);
        float rb0, rb1;
        { const int c0_ = F.tid % 48, c1_ = (F.tid + NTHR) % 48; rb0 = (c0_ < 4) ? in[I_BGRP][l * 4 + c0_] : (c0_ < 36 ? in[I_BEXP][l * 32 + (c0_ - 4)] : 0.f); rb1 = (c1_ < 4) ? in[I_BGRP][l * 4 + c1_] : (c1_ < 36 ? in[I_BEXP][l * 32 + (c1_ - 4)] : 0.f); }
        RowPk xr[2], yr[2];
#pragma unroll
        for (int q = 0; q < 2; ++q) { const int t = tb + 2 * F.wave + q; xr[q] = ld_row_pk(XS + (size_t)t * 1024, F.lane); yr[q] = ld_row_pk(Y16 + (size_t)t * 1024, F.lane); }
        for (int r = 0; r < 8; ++r) {
#pragma unroll
            for (int q = 0; q < 2; ++q) {
                const int i = 2 * F.wave + q, t = tb + 16 * r + i;
                const Row y = unpk_row(yr[q]), xq = unpk_row_h(xr[q]); Row u;
#pragma unroll
                for (int j = 0; j < 4; ++j) u.v[j] = ALPHA * xq.v[j] + (1.0f + gt.v[j]) * y.v[j];
                const Row x1 = row_ln(u, lng, lnb);
                if (!DRY) st_row_h(XS + (size_t)t * 1024, F.lane, x1);
                Row h;
#pragma unroll
                for (int j = 0; j < 4; ++j) h.v[j] = x1.v[j] * (1.0f + scf.v[j]) + shf.v[j];
                const RowPk hp = split_row(h, AH + i * APITCH, AL + i * APITCH, F.lane);
#pragma unroll
                for (int j = 0; j < 4; ++j) { if (!DRY) *(u32x2*)(Hb + (size_t)t * 1024 + 256 * j + 4 * F.lane) = hp.v[j]; }
            }
            if (r < 7) {
#pragma unroll
                for (int q = 0; q < 2; ++q) { const int t = tb + 16 * (r + 1) + 2 * F.wave + q; xr[q] = ld_row_pk(XS + (size_t)t * 1024, F.lane); yr[q] = ld_row_pk(Y16 + (size_t)t * 1024, F.lane); }
            }
            LBAR();
            skinny_mfma<3>(F, AH, AL, RTH, RTL, part);
            LBAR();
#pragma unroll
            for (int oo = 0; oo < 2; ++oo) { const int o = F.tid + NTHR * oo; if (o < 16 * 48) { const int i = o / 48, c = o % 48; float sm = 0.f;
#pragma unroll
                for (int w = 0; w < 8; ++w) sm += part[(w * 16 + i) * 48 + c];
                lgt[o] = sm + (oo ? rb1 : rb0); } }
            LBAR();
            if (F.tid < 16) {
                const int i = F.tid, t = tb + 16 * r + i; const LAS float* lg = lgt + i * 48;
                const f32x4 lg4 = *(const LAS f32x4*)lg;
                int gs = 0; float gm = lg4[0];
#pragma unroll
                for (int c = 1; c < 4; ++c) if (lg4[c] > gm) { gm = lg4[c]; gs = c; }
                float den = 0.f;
#pragma unroll
                for (int c = 0; c < 4; ++c) den += __expf(lg4[c] - gm);
                const float pg = 1.0f / den;
                const f32x4 le0 = *(const LAS f32x4*)(lg + 4 + gs * 8), le1 = *(const LAS f32x4*)(lg + 8 + gs * 8);
                const float le[8] = {le0[0], le0[1], le0[2], le0[3], le1[0], le1[1], le1[2], le1[3]};
                int i0 = 0; float m0 = le[0];
#pragma unroll
                for (int c = 1; c < 8; ++c) if (le[c] > m0) { m0 = le[c]; i0 = c; }
                int i1 = -1; float m1 = -3.0e38f;
#pragma unroll
                for (int c = 0; c < 8; ++c) if (c != i0 && le[c] > m1) { m1 = le[c]; i1 = c; }
                const float a = __expf(m1 - m0), g0 = pg / (1.0f + a), g1 = pg * a / (1.0f + a);
                const int e0 = gs * 8 + i0, e1 = gs * 8 + i1;
                const unsigned r0 = atomicAdd((unsigned*)&lcnt[e0], 1u), r1 = atomicAdd((unsigned*)&lcnt[e1], 1u);
                ltab[(16 * r + i) * 2] = ((unsigned)e0 << 24) | r0; ltab[(16 * r + i) * 2 + 1] = ((unsigned)e1 << 24) | r1;
                if (!DRY) { gates[(size_t)t * 2] = g0; gates[(size_t)t * 2 + 1] = g1; }
            }
        }
        LBAR();
        if (F.tid < 32) lcnt[32 + F.tid] = DRY ? 0u : __hip_atomic_fetch_add((unsigned*)(F.ws + WS_CTL) + CW_CNT + l * 32 + F.tid, lcnt[F.tid], __ATOMIC_RELAXED, __HIP_MEMORY_SCOPE_AGENT);
        LBAR();
        if (F.tid < 256 && !DRY) { const unsigned w = ltab[F.tid]; const unsigned e = w >> 24; const unsigned rk = (w & 0xffffffu) + lcnt[32 + e]; asg[(size_t)tb * 2 + F.tid] = (int)((e << 24) | rk);
            ((int*)(F.ws + WS_TLIST))[(size_t)e * 65536 + rk] = tb + (F.tid >> 1); }
        LBAR();
    }
}
__device__ __forceinline__ void fgate_phase(Frame& F) {
    const InTab in = F.in;
    const bf16_t* WFH = (const bf16_t*)(F.ws + WS_WF); const bf16_t* WFL = WFH + 16 * 1024; float* LF = (float*)(F.ws + WS_LF); const bf16_t* XS = (const bf16_t*)(F.ws + WS_XS);
    LAS float* part = (LAS float*)(F.lds + 8192);
    LAS bf16_t* AH = (LAS bf16_t*)(F.lds + 32768); LAS bf16_t* AL = AH + 16 * APITCH;
    for (int blk = F.bid; blk < T / 128; blk += F.G) {
        const int tb = blk * 128, b = tb / SEQ;
        const float* kvm = (const float*)(F.ws + WS_KVMOD) + (size_t)b * 2048;
        const Row ksh = ld_row_f32(kvm, F.lane), ksc = ld_row_f32(kvm + 1024, F.lane);
        RowPk xr[2];
#pragma unroll
        for (int q = 0; q < 2; ++q) xr[q] = ld_row_pk(XS + (size_t)(tb + 2 * F.wave + q) * 1024, F.lane);
        LBAR();
        for (int r = 0; r < 8; ++r) {
#pragma unroll
            for (int q = 0; q < 2; ++q) { const int i = 2 * F.wave + q; Row hk; const Row xq = unpk_row_h(xr[q]);
#pragma unroll
                for (int j = 0; j < 4; ++j) hk.v[j] = xq.v[j] * (1.0f + ksc.v[j]) + ksh.v[j];
                (void)split_row(hk, AH + i * APITCH, AL + i * APITCH, F.lane); }
            if (r < 7) {
#pragma unroll
                for (int q = 0; q < 2; ++q) xr[q] = ld_row_pk(XS + (size_t)(tb + 16 * (r + 1) + 2 * F.wave + q) * 1024, F.lane);
            }
            LBAR();
            skinny_mfma<1>(F, AH, AL, WFH, WFL, part);
            LBAR();
            if (F.tid < 256) { const int i = F.tid >> 4, c = F.tid & 15; float sm = 0.f;
#pragma unroll
                for (int w = 0; w < 8; ++w) sm += part[(w * 16 + i) * 48 + c];
                const float z = sm + in[I_KVFB][c]; LF[(size_t)(tb + 16 * r + i) * 16 + c] = fminf(z, 0.f) - log1pf(__expf(-fabsf(z))); }
        }
        LBAR();
    }
}

template <bool DRY = false>
__device__ __forceinline__ void tok_b(Frame& F, int l, int next) {
    const InTab in = F.in;
    bf16_t* Hb = (bf16_t*)(F.ws + WS_H2); bf16_t* HK = (bf16_t*)(F.ws + WS_RA); bf16_t* XS = (bf16_t*)(F.ws + WS_XS);
    const bf16_t* YM = (const bf16_t*)(F.ws + WS_RA + 144 * MiB);
    const int* asg = (const int*)(F.ws + WS_ASG); const float* gates = (const float*)(F.ws + WS_GATE); const LAS int* lc = (const LAS int*)(F.lds + MOE_LC_OFF);
    const Row lng = ld_row_f32(in[I_LNG] + (size_t)(l * 2 + 1) * 1024, F.lane), lnb = ld_row_f32(in[I_LNB] + (size_t)(l * 2 + 1) * 1024, F.lane);
    const int gw = F.bid * NWAVES + F.wave, NGW = F.G * NWAVES;
    for (int run = gw; run < T / 8; run += NGW) {
        const int t0 = run * 8, b = t0 / SEQ;
        const Row gt = ld_row_f32((const float*)(F.ws + WS_MOD) + ((size_t)l * 8 + b) * 6144 + 5 * 1024, F.lane);
        Row shm, scm;
        if (next < 3) { const float* modn = (const float*)(F.ws + WS_MOD) + ((size_t)(l + 1) * 8 + b) * 6144; shm = ld_row_f32(modn, F.lane); scm = ld_row_f32(modn + 1024, F.lane); }
        else { shm = Row{}; scm = Row{}; }
        int dmine = 0; float gmine = 0.f;
        if (F.lane < 16) { const unsigned a = (unsigned)asg[(size_t)t0 * 2 + F.lane]; dmine = lc[32 + (a >> 24)] + (int)(a & 0xffffffu); gmine = gates[(size_t)t0 * 2 + F.lane]; }
        RowPk xc = ld_row_pk(XS + (size_t)t0 * 1024, F.lane);
        RowPk y0c = ld_row_pk(YM + (size_t)__shfl(dmine, 0) * 1024, F.lane), y1c = ld_row_pk(YM + (size_t)__shfl(dmine, 1) * 1024, F.lane);
        for (int tt = 0; tt < 8; ++tt) {
            const int t = t0 + tt, tn = (tt < 7) ? tt + 1 : tt;
            const RowPk xn = ld_row_pk(XS + (size_t)(t0 + tn) * 1024, F.lane);
            const RowPk y0n = ld_row_pk(YM + (size_t)__shfl(dmine, 2 * tn) * 1024, F.lane), y1n = ld_row_pk(YM + (size_t)__shfl(dmine, 2 * tn + 1) * 1024, F.lane);
            const float g0 = __shfl(gmine, 2 * tt), g1 = __shfl(gmine, 2 * tt + 1);
            const Row y0 = unpk_row(y0c), y1 = unpk_row(y1c), xq = unpk_row_h(xc); Row u;
#pragma unroll
            for (int j = 0; j < 4; ++j) u.v[j] = ALPHA * xq.v[j] + (1.0f + gt.v[j]) * (g0 * y0.v[j] + g1 * y1.v[j]);
            const Row x2 = row_ln(u, lng, lnb);
            if (!DRY) { if (l == 3) st_row_f32(F.xs + (size_t)t * 1024, F.lane, x2); else st_row_h(XS + (size_t)t * 1024, F.lane, x2); } else asm volatile("" :: "v"(x2.v[0]), "v"(x2.v[1]), "v"(x2.v[2]), "v"(x2.v[3]));
            if (next != 3) {
                Row h;
#pragma unroll
                for (int j = 0; j < 4; ++j) h.v[j] = x2.v[j] * (1.0f + scm.v[j]) + shm.v[j];
                if (!DRY) st_row_bf16(Hb + (size_t)t * 1024, F.lane, h); else asm volatile("" :: "v"(h.v[0]), "v"(h.v[3]));
                if (next == 1) {
                    const float* kvm = (const float*)(F.ws + WS_KVMOD) + (size_t)b * 2048;
                    const Row ksh = ld_row_f32(kvm, F.lane), ksc = ld_row_f32(kvm + 1024, F.lane); Row hk;
#pragma unroll
                    for (int j = 0; j < 4; ++j) hk.v[j] = x2.v[j] * (1.0f + ksc.v[j]) + ksh.v[j];
                    if (!DRY) st_row_bf16(HK + (size_t)t * 1024, F.lane, hk); else asm volatile("" :: "v"(hk.v[0]), "v"(hk.v[3]));
                }
            }
            xc = xn; y0c = y0n; y1c = y1n;
        }
    }
}

__device__ __forceinline__ void rw_prep(Frame& F, int ln, bool from_input) {
    bf16_t* Hb = (bf16_t*)(F.ws + WS_H2); bf16_t* X3 = (bf16_t*)(F.ws + WS_SC);
    const float* src = F.in[I_X]; bf16_t* XS = (bf16_t*)(F.ws + WS_XS);
    const float* mu = F.in[I_MU] + (size_t)ln * 6 * 1024;
    const Row mur = ld_row_f32(mu, F.lane), muk = ld_row_f32(mu + 2 * 1024, F.lane), muv = ld_row_f32(mu + 3 * 1024, F.lane);
    const int gw = F.bid * NWAVES + F.wave, NGW = F.G * NWAVES;
    for (int run = gw; run < T / 8; run += NGW) {
        const int t0 = run * 8, b = t0 / SEQ;
        const float* modn = (const float*)(F.ws + WS_MOD) + ((size_t)ln * 8 + b) * 6144;
        const Row shm = ld_row_f32(modn, F.lane), scm = ld_row_f32(modn + 1024, F.lane);
        Row hprev;
#pragma unroll
        for (int j = 0; j < 4; ++j) hprev.v[j] = (f32x4){0.f, 0.f, 0.f, 0.f};
        if ((t0 % SEQ) != 0) {
            const Row xp = from_input ? ld_row_f32(src + (size_t)(t0 - 1) * 1024, F.lane) : unpk_row_h(ld_row_pk(XS + (size_t)(t0 - 1) * 1024, F.lane));
#pragma unroll
            for (int j = 0; j < 4; ++j) hprev.v[j] = xp.v[j] * (1.0f + scm.v[j]) + shm.v[j];
        }
        Row xc = Row{}; RowPk xcp = RowPk{};
        if (from_input) xc = ld_row_f32(src + (size_t)t0 * 1024, F.lane); else xcp = ld_row_pk(XS + (size_t)t0 * 1024, F.lane);
        for (int tt = 0; tt < 8; ++tt) {
            const int t = t0 + tt, tnx = t0 + (tt < 7 ? tt + 1 : tt);
            const Row x = from_input ? xc : unpk_row_h(xcp);
            if (from_input) xc = ld_row_f32(src + (size_t)tnx * 1024, F.lane); else xcp = ld_row_pk(XS + (size_t)tnx * 1024, F.lane);
            if (from_input) st_row_h(XS + (size_t)t * 1024, F.lane, x);
            Row h, xx, xr, xk, xv;
#pragma unroll
            for (int j = 0; j < 4; ++j) { h.v[j] = x.v[j] * (1.0f + scm.v[j]) + shm.v[j]; xx.v[j] = hprev.v[j] - h.v[j];
                xr.v[j] = h.v[j] + xx.v[j] * mur.v[j]; xk.v[j] = h.v[j] + xx.v[j] * muk.v[j]; xv.v[j] = h.v[j] + xx.v[j] * muv.v[j]; }
            st_row_bf16(Hb + (size_t)t * 2048, F.lane, h); st_row_bf16(Hb + (size_t)t * 2048 + 1024, F.lane, xx);
            st_row_bf16(X3 + (size_t)t * 1024, F.lane, xr); st_row_bf16(X3 + X3S + (size_t)t * 1024, F.lane, xk); st_row_bf16(X3 + 2 * X3S + (size_t)t * 1024, F.lane, xv);
            hprev = h;
        }
    }
}

__device__ __forceinline__ void moe_tables(Frame& F, int l) {
    LAS int* lc = (LAS int*)(F.lds + MOE_LC_OFF);
    const unsigned* cnt = (const unsigned*)(F.ws + WS_CTL) + CW_CNT + l * 32;
    if (F.tid == 0) {
        int acc = 0, ntt = 0;
        for (int e = 0; e < 32; ++e) { const int c = (int)__hip_atomic_load(cnt + e, __ATOMIC_RELAXED, __HIP_MEMORY_SCOPE_AGENT); lc[e] = c; lc[32 + e] = acc; const int nt = (c + 255) >> 8;
            for (int i = 0; i < nt; ++i) lc[96 + ntt + i] = (e << 16) | i;
            ntt += nt; acc += nt << 8; }
        lc[64] = ntt;
    }
    __syncthreads();
}
template <class Sched> __device__ __forceinline__ void moe_rows(Frame& F, const Sched& S) {
    const LAS int* lc = (const LAS int*)(F.lds + MOE_LC_OFF); LAS int* tokL = (LAS int*)(F.lds + MOE_TOKL_OFF); const int* tlist = (const int*)(F.ws + WS_TLIST);
    Unit u;
    for (int i = 0; i < 6 && S.next(i, u); ++i) {
        if (F.tid < 256) { const int ek = lc[96 + u.pm], e = ek >> 16, rank = ((ek & 0xffff) << 8) + F.tid;
            tokL[i * 256 + F.tid] = tlist[(size_t)e * 65536 + (rank < lc[e] ? rank : 0)]; }
    }
    __syncthreads();
}

__device__ __forceinline__ float octsum(float v) { v += dpp_f<0xB1>(v); v += dpp_f<0x4E>(v); v += dpp_f<0x141>(v); return v; }
constexpr int CP = 72, SLOT = 64 * CP;
#define PX(r_, c_) ((r_) * 64 + (((((c_) >> 3) ^ (((r_) >> 1) & 7))) << 3) + ((c_) & 7))
constexpr size_t WS_MP = WS_SC, WS_QQ = WS_SC + 64 * MiB, WS_NT = WS_SC + 128 * MiB, WS_GL = WS_SC + 192 * MiB;
template <bool SWAP> __device__ __forceinline__ f32x4 tile_mm(const LAS bf16_t* Ap, const LAS bf16_t* Bp, int fr, int fq) {
    const int o0 = PX(fr, 8 * fq), o1 = PX(fr, 8 * fq + 32);
    const bf16x8 a0 = *(const LAS bf16x8*)(Ap + o0), a1 = *(const LAS bf16x8*)(Ap + o1);
    const bf16x8 b0 = *(const LAS bf16x8*)(Bp + o0), b1 = *(const LAS bf16x8*)(Bp + o1);
    f32x4 acc = (f32x4){0.f, 0.f, 0.f, 0.f};
    if (!SWAP) { acc = __builtin_amdgcn_mfma_f32_16x16x32_bf16(a0, b0, acc, 0, 0, 0); acc = __builtin_amdgcn_mfma_f32_16x16x32_bf16(a1, b1, acc, 0, 0, 0); }
    else       { acc = __builtin_amdgcn_mfma_f32_16x16x32_bf16(b0, a0, acc, 0, 0, 0); acc = __builtin_amdgcn_mfma_f32_16x16x32_bf16(b1, a1, acc, 0, 0, 0); }
    return acc;
}
__device__ __forceinline__ void ld8f(const float* p, float (&o)[8]) { const f32x4 a = *(const f32x4*)p, b = *(const f32x4*)(p + 4); o[0] = a[0]; o[1] = a[1]; o[2] = a[2]; o[3] = a[3]; o[4] = b[0]; o[5] = b[1]; o[6] = b[2]; o[7] = b[3]; }
__device__ __forceinline__ void st4_lds(LAS bf16_t* p, f32x4 v) { u32x2 w; w.x = pk2(v[0], v[1]); w.y = pk2(v[2], v[3]); *(LAS u32x2*)p = w; }
__device__ __forceinline__ f32x4 ld4_lds(const LAS bf16_t* p) { const u32x2 w = *(const LAS u32x2*)p; return (f32x4){lo16(w.x), hi16(w.x), lo16(w.y), hi16(w.y)}; }
__device__ __forceinline__ void unpk8(const u32x4 w, float (&o)[8]) { o[0] = lo16(w.x); o[1] = hi16(w.x); o[2] = lo16(w.y); o[3] = hi16(w.y); o[4] = lo16(w.z); o[5] = hi16(w.z); o[6] = lo16(w.w); o[7] = hi16(w.w); }
__device__ __forceinline__ void st8_lds(LAS bf16_t* p, const float (&o)[8]) { u32x4 w; w.x = pk2(o[0], o[1]); w.y = pk2(o[2], o[3]); w.z = pk2(o[4], o[5]); w.w = pk2(o[6], o[7]); *(LAS u32x4*)p = w; }

template <int PROBE = 0>
__device__ __forceinline__ void wkv_chunk_prep(Frame& F, int l) {
    const InTab in = F.in;
    const bf16_t* RKV = (const bf16_t*)(F.ws + WS_RA);
    bf16_t* YS = (bf16_t*)(F.ws + WS_Y16); bf16_t* MP = (bf16_t*)(F.ws + WS_MP); bf16_t* QQ = (bf16_t*)(F.ws + WS_QQ); bf16_t* NTt = (bf16_t*)(F.ws + WS_NT); float* GLB = (float*)(F.ws + WS_GL);
    LAS bf16_t* L0 = (LAS bf16_t*)F.lds;
#define SL(n) (L0 + (n) * 4096)
    LAS float* WLs = (LAS float*)(F.lds + 8 * 8192);
    LAS float* SEG = WLs + 64 * 65;
    const int pt = F.tid >> 3, pc0 = 8 * (F.tid & 7);
    const bf16_t* LAg = (const bf16_t*)(F.ws + WS_RA + 192 * MiB); const bf16_t* VFg = (const bf16_t*)(F.ws + WS_P); float* BON = (float*)(F.ws + WS_LF);
    const bf16_t* W2T = (const bf16_t*)(F.ws + WS_LORA2 + (size_t)l * MiB + L2_W2T); const bf16_t* A2T = (const bf16_t*)(F.ws + WS_LORA2 + (size_t)l * MiB + L2_A2T); const bf16_t* V2T = (const bf16_t*)(F.ws + WS_LORA2 + (size_t)l * MiB + L2_V2T);
    u32x4 gr, gk, gv, glw, gla, glv, gvf, gw2, ga2, gv2;
#define PREP_LOAD(uu) do { const int bh_ = (uu) >> 6, c_ = (uu) & 63; const size_t row = (size_t)(bh_ >> 4) * SEQ + 64 * c_ + pt; const int hh = (bh_ & 15) * 64, hc = hh + pc0; \
        gr = *(const u32x4*)(RKV + row * 3072 + hc); gk = *(const u32x4*)(RKV + row * 3072 + 1024 + hc); gv = (l == 0) ? *(const u32x4*)(VFg + row * 1024 + hc) : *(const u32x4*)(RKV + row * 3072 + 2048 + hc); \
        glw = *(const u32x4*)(LAg + row * LAW + pc0); gla = *(const u32x4*)(LAg + row * LAW + 64 + pc0); \
        gw2 = *(const u32x4*)(W2T + (size_t)(hh + pt) * 64 + pc0); ga2 = *(const u32x4*)(A2T + (size_t)(hh + pt) * 64 + pc0); \
        if (l == 1) { glv = *(const u32x4*)(LAg + row * LAW + 288 + (pc0 & 31)); gvf = *(const u32x4*)(VFg + row * 1024 + hc); gv2 = *(const u32x4*)(V2T + (size_t)(hh + pt) * 64 + pc0); } } while (0)
    glv = (u32x4){0u, 0u, 0u, 0u}; gvf = glv; gv2 = glv;
    if (F.bid < 128 * 64) PREP_LOAD(F.bid);
    for (int u = F.bid; u < 128 * 64; u += F.G) {
        const int bh = u >> 6, c = u & 63, b = bh >> 4, h = bh & 15;
        const size_t row0 = (size_t)b * SEQ + 64 * c;
        int ln_ = F.lane; asm volatile("" : "+v"(ln_));
        const int fr = ln_ & 15, fq = ln_ >> 4;
        *(LAS u32x4*)(SL(0) + PX(pt, pc0)) = glw; *(LAS u32x4*)(SL(1) + PX(pt, pc0)) = gla; *(LAS u32x4*)(SL(3) + PX(pt, pc0)) = gw2; *(LAS u32x4*)(SL(4) + PX(pt, pc0)) = ga2;
        if (l == 1) { *(LAS u32x4*)(SL(2) + PX(pt, pc0)) = (pc0 < 32) ? glv : (u32x4){0u, 0u, 0u, 0u}; *(LAS u32x4*)(SL(5) + PX(pt, pc0)) = gv2; }
        LBAR();
        {
            f32x4 zw[2], za[2], zv[2];
#pragma unroll
            for (int i = 0; i < 2; ++i) { const int tile = F.wave + 8 * i, mt = tile >> 2, nt = tile & 3;
                zw[i] = tile_mm<false>(SL(0) + 16 * mt * 64, SL(3) + 16 * nt * 64, fr, fq);
                za[i] = tile_mm<true>(SL(1) + 16 * mt * 64, SL(4) + 16 * nt * 64, fr, fq);
                if (l == 1) zv[i] = tile_mm<true>(SL(2) + 16 * mt * 64, SL(5) + 16 * nt * 64, fr, fq); }
#pragma unroll
            for (int i = 0; i < 2; ++i) { const int tile = F.wave + 8 * i, mt = tile >> 2, nt = tile & 3; const int rr = 16 * mt + fr, cc = 16 * nt + 4 * fq;
                const float w0s = in[I_W0][l * 1024 + h * 64 + 16 * nt + fr]; const f32x4 a0v = *(const f32x4*)(in[I_A0] + l * 1024 + h * 64 + cc); f32x4 av, wh, wlo;
#pragma unroll
                for (int q = 0; q < 4; ++q) { const float wl_ = -0.6065306597126334f * sigmoidf_(zw[i][q] + w0s); wh[q] = bf2f((unsigned short)f2bf(wl_)); wlo[q] = wl_ - wh[q]; av[q] = sigmoidf_(za[i][q] + a0v[q]); }
                st4_lds(SL(11) + PX(16 * nt + fr, 16 * mt + 4 * fq), wh); st4_lds(SL(12) + PX(16 * nt + fr, 16 * mt + 4 * fq), wlo);
                st4_lds(SL(6) + PX(rr, cc), av);
                if (l == 1) { const f32x4 v0v = *(const f32x4*)(in[I_V0] + h * 64 + cc); f32x4 sv;
#pragma unroll
                    for (int q = 0; q < 4; ++q) sv[q] = sigmoidf_(zv[i][q] + v0v[q]);
                    st4_lds(SL(7) + PX(rr, cc), sv); } }
        }
        LBAR();
        float r[8], k[8], v[8], a[8];
        unpk8(gr, r); unpk8(gk, k); unpk8(gv, v); unpk8(*(const LAS u32x4*)(SL(6) + PX(pt, pc0)), a);
        if (l == 1) { float sv[8], vf[8]; unpk8(*(const LAS u32x4*)(SL(7) + PX(pt, pc0)), sv); unpk8(gvf, vf);
#pragma unroll
            for (int q = 0; q < 8; ++q) v[q] = bf2f((unsigned short)f2bf(v[q] + (vf[q] - v[q]) * sv[q]));
            if (PROBE == 0) { u32x4 w; w.x = pk2(v[0], v[1]); w.y = pk2(v[2], v[3]); w.z = pk2(v[4], v[5]); w.w = pk2(v[6], v[7]); *(u32x4*)((bf16_t*)RKV + (row0 + pt) * 3072 + 2048 + h * 64 + pc0) = w; } }
        {
            f32x4 cs[2];
#pragma unroll
            for (int i = 0; i < 2; ++i) { const int tile = F.wave + 8 * i, mt = tile >> 2, nt = tile & 3;
                bf16x8 l0, l1;
#pragma unroll
                for (int e = 0; e < 8; ++e) { l0[e] = (short)((8 * fq + e <= 16 * mt + fr) ? 0x3F80 : 0); l1[e] = (short)((32 + 8 * fq + e <= 16 * mt + fr) ? 0x3F80 : 0); }
                const int c0_ = PX(16 * nt + fr, 8 * fq), c1_ = PX(16 * nt + fr, 8 * fq + 32); const LAS bf16_t* bh = SL(11); const LAS bf16_t* bl = SL(12);
                f32x4 acc = (f32x4){0.f, 0.f, 0.f, 0.f};
                acc = __builtin_amdgcn_mfma_f32_16x16x32_bf16(*(const LAS bf16x8*)(bh + c0_), l0, acc, 0, 0, 0); acc = __builtin_amdgcn_mfma_f32_16x16x32_bf16(*(const LAS bf16x8*)(bh + c1_), l1, acc, 0, 0, 0);
                acc = __builtin_amdgcn_mfma_f32_16x16x32_bf16(*(const LAS bf16x8*)(bl + c0_), l0, acc, 0, 0, 0); acc = __builtin_amdgcn_mfma_f32_16x16x32_bf16(*(const LAS bf16x8*)(bl + c1_), l1, acc, 0, 0, 0);
                cs[i] = acc; }
#pragma unroll
            for (int i = 0; i < 2; ++i) { const int tile = F.wave + 8 * i, mt = tile >> 2, nt = tile & 3; const int rr = 16 * mt + fr, cc = 16 * nt + 4 * fq;
#pragma unroll
                for (int q = 0; q < 4; ++q) WLs[rr * 65 + cc + q] = cs[i][q]; }
        }
        LBAR();
        {
            float kkw[8], kaw[8], rkw[8]; ld8f(in[I_KK] + l * 1024 + h * 64 + pc0, kkw); ld8f(in[I_KA] + l * 1024 + h * 64 + pc0, kaw); ld8f(in[I_RK] + l * 1024 + h * 64 + pc0, rkw);
            float kr[8], ss = 0.f, bs = 0.f;
#pragma unroll
            for (int q = 0; q < 8; ++q) { kr[q] = k[q] * kkw[q]; ss += kr[q] * kr[q]; }
            ss = octsum(ss);
            const float inv = 1.0f / fmaxf(sqrtf(ss), 1e-12f);
            float At[8], Rt[8], Bt[8], Kt[8], Bb[8], Kb[8], gl[8];
#pragma unroll
            for (int q = 0; q < 8; ++q) {
                const float cum = WLs[pt * 65 + pc0 + q], cl = WLs[63 * 65 + pc0 + q], cex = (pt > 0) ? WLs[(pt - 1) * 65 + pc0 + q] : 0.f;
                const float e_in = __expf(cum), e_ex = __expf(cex), e_ng = __expf(-cum); gl[q] = __expf(cl);
                const float kk = kr[q] * inv, kp = k[q] * (1.0f + (a[q] - 1.0f) * kaw[q]); bs += r[q] * kp * rkw[q];
                At[q] = -kk * e_ex; Rt[q] = r[q] * e_in; Bt[q] = kk * a[q] * e_ng; Kt[q] = kp * e_ng; Bb[q] = Bt[q] * gl[q]; Kb[q] = Kt[q] * gl[q];
            }
            st8_lds(SL(0) + PX(pt, pc0), At); st8_lds(SL(1) + PX(pt, pc0), Rt); st8_lds(SL(2) + PX(pt, pc0), Bt); st8_lds(SL(3) + PX(pt, pc0), Kt);
            st8_lds(SL(11) + PX(pt, pc0), v); st8_lds(SL(12) + PX(pt, pc0), Bb); st8_lds(SL(13) + PX(pt, pc0), Kb);
            bs = octsum(bs); if ((F.tid & 7) == 0 && PROBE == 0) BON[(row0 + pt) * 16 + h] = bs;
            if (pt == 0 && PROBE == 0) { float* g = GLB + (size_t)u * 64 + pc0; *(f32x4*)g = (f32x4){gl[0], gl[1], gl[2], gl[3]}; *(f32x4*)(g + 4) = (f32x4){gl[4], gl[5], gl[6], gl[7]}; }
        }
        LBAR();
        {
            const int j = F.tid & 63, t0 = 8 * (F.tid >> 6);
#define TRANSP(src, dst) do { float e[8]; _Pragma("unroll") for (int q = 0; q < 8; ++q) e[q] = bf2f(SL(src)[PX(t0 + q, j)]); st8_lds(SL(dst) + PX(j, t0), e); } while (0)
            TRANSP(0, 6); TRANSP(12, 7); TRANSP(13, 5); TRANSP(11, 4);
#undef TRANSP
            if (u + F.G < 128 * 64) PREP_LOAD(u + F.G);
        }
        LBAR();
        if (PROBE == 1) continue;
        {
            f32x4 acc[8];
#pragma unroll
            for (int i = 0; i < 8; ++i) acc[i] = tile_mm<true>(SL(0) + 16 * i * 64, SL(2) + 16 * F.wave * 64, fr, fq);
            const int nt = F.wave, sq0 = (nt & 3) * 16 + 4 * fq;
#pragma unroll
            for (int i = 0; i < 8; ++i) {
                const int mt = i, tq = (mt & 3) * 16 + fr; f32x4 o;
#pragma unroll
                for (int q = 0; q < 4; ++q) { const int sq = sq0 + q; const bool keep = (mt < 4) ? (sq < tq) : (sq <= tq); o[q] = keep ? acc[i][q] : 0.f; }
                LAS bf16_t* dst = (mt < 4) ? ((nt < 4) ? SL(8) : SL(10)) : ((nt < 4) ? SL(11) : SL(12));
                st4_lds(dst + PX(tq, sq0), o);
                if (mt < 4 && nt < 4) {
#pragma unroll
                    for (int q = 0; q < 4; ++q) SL(9)[PX(sq0 + q, tq)] = (bf16_t)f2bf(o[q]); }
            }
        }
        LBAR();
        {
            f32x4 x[2], y1[2], nk[2];
#pragma unroll
            for (int i = 0; i < 2; ++i) { const int tile = F.wave + 8 * i, mt = tile >> 2, nt = tile & 3;
                x[i] = tile_mm<false>(SL(10) + 16 * mt * 64, SL(4) + 16 * nt * 64, fr, fq);
                y1[i] = tile_mm<true>(SL(12) + 16 * mt * 64, SL(4) + 16 * nt * 64, fr, fq);
                nk[i] = tile_mm<false>(SL(5) + 16 * mt * 64, SL(4) + 16 * nt * 64, fr, fq); }
#pragma unroll
            for (int i = 0; i < 2; ++i) { const int tile = F.wave + 8 * i, mt = tile >> 2, nt = tile & 3;
                st4_lds(SL(2) + PX(16 * nt + fr, 16 * mt + 4 * fq), x[i]);
                st4_lds(SL(3) + PX(16 * mt + fr, 16 * nt + 4 * fq), y1[i]);
                st4_lds(SL(0) + PX(16 * nt + fr, 16 * mt + 4 * fq), nk[i]); }
        }
        LBAR();
        if (PROBE == 2) continue;
#define NEU_SQ(Xn, Xt, On, Ot, WANT_NAT) do { f32x4 s_[2]; \
            _Pragma("unroll") for (int i = 0; i < 2; ++i) { const int tile = F.wave + 8 * i, mt = tile >> 2, nt = tile & 3; s_[i] = tile_mm<true>(SL(Xn) + 16 * mt * 64, SL(Xt) + 16 * nt * 64, fr, fq); } \
            _Pragma("unroll") for (int i = 0; i < 2; ++i) { const int tile = F.wave + 8 * i, mt = tile >> 2, nt = tile & 3; \
                if (WANT_NAT) st4_lds(SL(On) + PX(16 * mt + fr, 16 * nt + 4 * fq), s_[i]); \
                _Pragma("unroll") for (int q = 0; q < 4; ++q) SL(Ot)[PX(16 * nt + 4 * fq + q, 16 * mt + fr)] = (bf16_t)f2bf(s_[i][q]); } } while (0)
#define NEU_PR(Ti, Yt, To) do { f32x4 p_[2]; \
            _Pragma("unroll") for (int i = 0; i < 2; ++i) { const int tile = F.wave + 8 * i, mt = tile >> 2, nt = tile & 3; \
                p_[i] = tile_mm<true>(SL(Ti) + 16 * mt * 64, SL(Yt) + 16 * nt * 64, fr, fq) + ld4_lds(SL(Ti) + PX(16 * mt + fr, 16 * nt + 4 * fq)); } \
            _Pragma("unroll") for (int i = 0; i < 2; ++i) { const int tile = F.wave + 8 * i, mt = tile >> 2, nt = tile & 3; st4_lds(SL(To) + PX(16 * mt + fr, 16 * nt + 4 * fq), p_[i]); } } while (0)
#define NEU_BOTH(Ti, Yt, To, Xn, Xt, On, Ot, WANT_NAT) do { f32x4 p_[2], s_[2]; \
            _Pragma("unroll") for (int i = 0; i < 2; ++i) { const int tile = F.wave + 8 * i, mt = tile >> 2, nt = tile & 3; \
                p_[i] = tile_mm<true>(SL(Ti) + 16 * mt * 64, SL(Yt) + 16 * nt * 64, fr, fq) + ld4_lds(SL(Ti) + PX(16 * mt + fr, 16 * nt + 4 * fq)); \
                s_[i] = tile_mm<true>(SL(Xn) + 16 * mt * 64, SL(Xt) + 16 * nt * 64, fr, fq); } \
            _Pragma("unroll") for (int i = 0; i < 2; ++i) { const int tile = F.wave + 8 * i, mt = tile >> 2, nt = tile & 3; \
                st4_lds(SL(To) + PX(16 * mt + fr, 16 * nt + 4 * fq), p_[i]); \
                if (WANT_NAT) st4_lds(SL(On) + PX(16 * mt + fr, 16 * nt + 4 * fq), s_[i]); \
                _Pragma("unroll") for (int q = 0; q < 4; ++q) SL(Ot)[PX(16 * nt + 4 * fq + q, 16 * mt + fr)] = (bf16_t)f2bf(s_[i][q]); } } while (0)
        NEU_SQ(8, 9, 10, 12, true);
        LBAR();
        {
            f32x4 p_[2];
#pragma unroll
            for (int i = 0; i < 2; ++i) { const int tile = F.wave + 8 * i, mt = tile >> 2, nt = tile & 3; const int rr = 16 * mt + fr, cc = 16 * nt + 4 * fq;
                p_[i] = tile_mm<true>(SL(8) + 16 * mt * 64, SL(12) + 16 * nt * 64, fr, fq) + ld4_lds(SL(8) + PX(rr, cc)) + ld4_lds(SL(10) + PX(rr, cc));
#pragma unroll
                for (int q = 0; q < 4; ++q) if (cc + q == rr) p_[i][q] += 1.0f; }
            NEU_SQ(10, 12, 5, 13, true);
#pragma unroll
            for (int i = 0; i < 2; ++i) { const int tile = F.wave + 8 * i, mt = tile >> 2, nt = tile & 3; st4_lds(SL(4) + PX(16 * mt + fr, 16 * nt + 4 * fq), p_[i]); }
        }
        LBAR();
        NEU_BOTH(4, 13, 8, 5, 13, 9, 10, true);
        LBAR();
        NEU_BOTH(8, 10, 4, 9, 10, 5, 12, true);
        LBAR();
        NEU_BOTH(4, 12, 8, 5, 12, 5, 13, false);
        LBAR();
        NEU_PR(8, 13, 4);
        LBAR();
#undef NEU_SQ
#undef NEU_PR
#undef NEU_BOTH
        if (PROBE == 3) continue;
        {
            f32x4 p[2], u0[2];
#pragma unroll
            for (int i = 0; i < 2; ++i) { const int tile = F.wave + 8 * i, mt = tile >> 2, nt = tile & 3;
                p[i] = tile_mm<false>(SL(4) + 16 * mt * 64, SL(6) + 16 * nt * 64, fr, fq);
                u0[i] = tile_mm<false>(SL(4) + 16 * mt * 64, SL(2) + 16 * nt * 64, fr, fq); }
#pragma unroll
            for (int i = 0; i < 2; ++i) { const int tile = F.wave + 8 * i, mt = tile >> 2, nt = tile & 3;
                st4_lds(SL(9) + PX(16 * nt + fr, 16 * mt + 4 * fq), p[i]); st4_lds(SL(10) + PX(16 * nt + fr, 16 * mt + 4 * fq), u0[i]); }
        }
        LBAR();
        {
            f32x4 qv[2], y0[2], mp[2], ntv[2];
#pragma unroll
            for (int i = 0; i < 2; ++i) { const int tile = F.wave + 8 * i, mt = tile >> 2, nt = tile & 3; const int rr = 16 * mt + fr, cc = 16 * nt + 4 * fq, ri = 16 * nt + fr, cj = 16 * mt + 4 * fq;
                qv[i] = tile_mm<true>(SL(11) + 16 * mt * 64, SL(9) + 16 * nt * 64, fr, fq) + ld4_lds(SL(1) + PX(rr, cc));
                y0[i] = tile_mm<true>(SL(11) + 16 * mt * 64, SL(10) + 16 * nt * 64, fr, fq) + ld4_lds(SL(3) + PX(rr, cc));
                mp[i] = tile_mm<true>(SL(7) + 16 * mt * 64, SL(9) + 16 * nt * 64, fr, fq);
                ntv[i] = tile_mm<false>(SL(7) + 16 * mt * 64, SL(10) + 16 * nt * 64, fr, fq) + ld4_lds(SL(0) + PX(ri, cj)); }
#pragma unroll
            for (int i = 0; i < 2; ++i) { const int tile = F.wave + 8 * i, mt = tile >> 2, nt = tile & 3; const int rr = 16 * mt + fr, cc = 16 * nt + 4 * fq, ri = 16 * nt + fr, cj = 16 * mt + 4 * fq;
                st4_lds(SL(5) + PX(rr, cc), qv[i]); st4_lds(SL(8) + PX(rr, cc), y0[i]); st4_lds(SL(12) + PX(rr, cc), mp[i]); st4_lds(SL(13) + PX(ri, cj), ntv[i]); }
        }
        LBAR();
        if (PROBE == 0) {
            const int rw = F.tid >> 3, ch = 8 * (F.tid & 7);
            *(u32x4*)(QQ + ((size_t)u * 64 + rw) * 64 + ch) = *(const LAS u32x4*)(SL(5) + PX(rw, ch));
            *(u32x4*)(MP + ((size_t)u * 64 + rw) * 64 + ch) = *(const LAS u32x4*)(SL(12) + PX(rw, ch));
            *(u32x4*)(NTt + ((size_t)u * 64 + rw) * 64 + ch) = *(const LAS u32x4*)(SL(13) + PX(rw, ch));
            *(u32x4*)(YS + (row0 + rw) * 1024 + h * 64 + ch) = *(const LAS u32x4*)(SL(8) + PX(rw, ch));
        }
        LBAR();
    }
#undef PREP_LOAD
#undef SL
}

__device__ __forceinline__ void wkv_chunk_seq(Frame& F, int l) {
    bf16_t* YS = (bf16_t*)(F.ws + WS_Y16); const bf16_t* MP = (const bf16_t*)(F.ws + WS_MP); const bf16_t* QQ = (const bf16_t*)(F.ws + WS_QQ); const bf16_t* NTt = (const bf16_t*)(F.ws + WS_NT); const float* GLB = (const float*)(F.ws + WS_GL);
    LAS bf16_t* Zt = (LAS bf16_t*)F.lds;
    const bf16_t* RKVc = (const bf16_t*)(F.ws + WS_RA); const bf16_t* VFc = (const bf16_t*)(F.ws + WS_P); const bf16_t* G16 = (const bf16_t*)(F.ws + WS_RA + 224 * MiB); const float* BON = (const float*)(F.ws + WS_LF); bf16_t* OG = (bf16_t*)(F.ws + WS_H2);
    LAS bf16_t* Yb = Zt + 2 * SLOT;
    const int fr = F.lane & 15, fq = F.lane >> 4, mt = F.wave >> 1, ntb = 2 * (F.wave & 1);
    struct Ops { bf16x8 m0, m1, q0, q1; f32x4 gl; u32x2 n0, n1, y0, y1; };
    for (int item = F.bid; item < 128; item += F.G) {
        const int bh = item, b = bh >> 4, h = bh & 15; const size_t rowb = (size_t)b * SEQ;
        float gng[8], gnb[8]; ld8f(F.in[I_GNG] + l * 1024 + h * 64 + 8 * (F.tid & 7), gng); ld8f(F.in[I_GNB] + l * 1024 + h * 64 + 8 * (F.tid & 7), gnb);
        for (int i = F.tid; i < 2 * SLOT / 2; i += NTHR) ((LAS unsigned*)Zt)[i] = 0u;
        f32x4 Z0 = (f32x4){0.f, 0.f, 0.f, 0.f}, Z1 = Z0;
        LBAR();
#define SEQ_LOAD(O, cc_) do { const size_t cu = (size_t)bh * 64 + (cc_); \
        const bf16_t* mp = MP + (cu * 64 + 16 * mt + fr) * 64 + 8 * fq; O.m0 = *(const bf16x8*)mp; O.m1 = *(const bf16x8*)(mp + 32); \
        const bf16_t* qp = QQ + (cu * 64 + 16 * mt + fr) * 64 + 8 * fq; O.q0 = *(const bf16x8*)qp; O.q1 = *(const bf16x8*)(qp + 32); \
        O.gl = *(const f32x4*)(GLB + cu * 64 + 16 * mt + 4 * fq); \
        const bf16_t* np_ = NTt + (cu * 64 + 16 * ntb + fr) * 64 + 16 * mt + 4 * fq; O.n0 = *(const u32x2*)np_; O.n1 = *(const u32x2*)(np_ + 16 * 64); \
        const bf16_t* yp = YS + (rowb + 64 * (cc_) + 16 * mt + fr) * 1024 + h * 64 + 16 * ntb + 4 * fq; O.y0 = *(const u32x2*)yp; O.y1 = *(const u32x2*)(yp + 16); } while (0)
#define SEQ_STEP(O, cc_) do { const LAS bf16_t* Zc = Zt + ((cc_) & 1) * SLOT; LAS bf16_t* Zn = Zt + (((cc_) + 1) & 1) * SLOT; \
        const LAS bf16_t* z0p = Zc + (16 * ntb + fr) * CP + 8 * fq; const LAS bf16_t* z1p = z0p + 16 * CP; \
        const bf16x8 b00 = *(const LAS bf16x8*)z0p, b01 = *(const LAS bf16x8*)(z0p + 32), b10 = *(const LAS bf16x8*)z1p, b11 = *(const LAS bf16x8*)(z1p + 32); \
        f32x4 a0 = (f32x4){0.f, 0.f, 0.f, 0.f}, a1 = a0, c0 = a0, c1 = a0; \
        a0 = __builtin_amdgcn_mfma_f32_16x16x32_bf16(O.m0, b00, a0, 0, 0, 0); a0 = __builtin_amdgcn_mfma_f32_16x16x32_bf16(O.m1, b01, a0, 0, 0, 0); \
        a1 = __builtin_amdgcn_mfma_f32_16x16x32_bf16(O.m0, b10, a1, 0, 0, 0); a1 = __builtin_amdgcn_mfma_f32_16x16x32_bf16(O.m1, b11, a1, 0, 0, 0); \
        c0 = __builtin_amdgcn_mfma_f32_16x16x32_bf16(b00, O.q0, c0, 0, 0, 0); c0 = __builtin_amdgcn_mfma_f32_16x16x32_bf16(b01, O.q1, c0, 0, 0, 0); \
        c1 = __builtin_amdgcn_mfma_f32_16x16x32_bf16(b10, O.q0, c1, 0, 0, 0); c1 = __builtin_amdgcn_mfma_f32_16x16x32_bf16(b11, O.q1, c1, 0, 0, 0); \
        Z0 = O.gl * Z0 + a0 + (f32x4){lo16(O.n0.x), hi16(O.n0.x), lo16(O.n0.y), hi16(O.n0.y)}; Z1 = O.gl * Z1 + a1 + (f32x4){lo16(O.n1.x), hi16(O.n1.x), lo16(O.n1.y), hi16(O.n1.y)}; \
        { LAS bf16_t* yl = Yb + (((cc_) & 7) * 64 + 16 * mt + fr) * CP + 16 * ntb + 4 * fq; \
          st4_lds(yl, c0 + (f32x4){lo16(O.y0.x), hi16(O.y0.x), lo16(O.y0.y), hi16(O.y0.y)}); st4_lds(yl + 16, c1 + (f32x4){lo16(O.y1.x), hi16(O.y1.x), lo16(O.y1.y), hi16(O.y1.y)}); } \
        st4_lds(Zn + (16 * ntb + fr) * CP + 16 * mt + 4 * fq, Z0); st4_lds(Zn + (16 * ntb + 16 + fr) * CP + 16 * mt + 4 * fq, Z1); \
        LBAR(); \
        if (((cc_) & 7) == 7) { _Pragma("unroll 2") for (int i_ = 0; i_ < 8; ++i_) { const int o_ = F.tid + NTHR * i_, ck_ = o_ >> 9, rw_ = (o_ >> 3) & 63, ch_ = 8 * (o_ & 7); \
            const size_t tr_ = rowb + 64 * ((cc_) - 7 + ck_) + rw_; float y_[8], v_[8], g_[8]; \
            unpk8(*(const LAS u32x4*)(Yb + (ck_ * 64 + rw_) * CP + ch_), y_); unpk8((l == 0) ? *(const u32x4*)(VFc + tr_ * 1024 + h * 64 + ch_) : *(const u32x4*)(RKVc + tr_ * 3072 + 2048 + h * 64 + ch_), v_); unpk8(*(const u32x4*)(G16 + tr_ * 1024 + h * 64 + ch_), g_); \
            const float bs_ = BON[tr_ * 16 + h]; float s_ = 0.f; _Pragma("unroll") for (int q_ = 0; q_ < 8; ++q_) s_ += y_[q_]; s_ = octsum(s_); const float mean_ = s_ * (1.0f / 64.0f); \
            float qq_ = 0.f; _Pragma("unroll") for (int q_ = 0; q_ < 8; ++q_) { const float d_ = y_[q_] - mean_; qq_ += d_ * d_; } qq_ = octsum(qq_); const float rstd_ = 1.0f / sqrtf(qq_ * (1.0f / 64.0f) + GN_EPS); \
            float o8_[8]; _Pragma("unroll") for (int q_ = 0; q_ < 8; ++q_) o8_[q_] = (((y_[q_] - mean_) * rstd_) * gng[q_] + gnb[q_] + bs_ * v_[q_]) * g_[q_]; \
            u32x4 w_; w_.x = pk2(o8_[0], o8_[1]); w_.y = pk2(o8_[2], o8_[3]); w_.z = pk2(o8_[4], o8_[5]); w_.w = pk2(o8_[6], o8_[7]); *(u32x4*)(OG + tr_ * 1024 + h * 64 + ch_) = w_; } LBAR(); } } while (0)
        Ops A, B, C;
        SEQ_LOAD(A, 0); SEQ_LOAD(B, 1);
#pragma unroll 1
        for (int c = 0; c < 63; c += 3) {
            SEQ_LOAD(C, c + 2); SEQ_STEP(A, c);
            SEQ_LOAD(A, c + 3); SEQ_STEP(B, c + 1);
            if (c + 4 < 64) SEQ_LOAD(B, c + 4);
            SEQ_STEP(C, c + 2);
        }
        SEQ_STEP(A, 63);
#undef SEQ_LOAD
#undef SEQ_STEP
    }
}

__device__ __forceinline__ void ld16(const bf16_t* p, float (&o)[16]) {
    const u32x4 a = *(const u32x4*)p, b = *(const u32x4*)(p + 8);
    o[0] = lo16(a.x); o[1] = hi16(a.x); o[2] = lo16(a.y); o[3] = hi16(a.y); o[4] = lo16(a.z); o[5] = hi16(a.z); o[6] = lo16(a.w); o[7] = hi16(a.w);
    o[8] = lo16(b.x); o[9] = hi16(b.x); o[10] = lo16(b.y); o[11] = hi16(b.y); o[12] = lo16(b.z); o[13] = hi16(b.z); o[14] = lo16(b.w); o[15] = hi16(b.w);
}
__device__ __forceinline__ void st16(bf16_t* p, const float (&o)[16]) {
    u32x4 a, b; a.x = pk2(o[0], o[1]); a.y = pk2(o[2], o[3]); a.z = pk2(o[4], o[5]); a.w = pk2(o[6], o[7]); b.x = pk2(o[8], o[9]); b.y = pk2(o[10], o[11]); b.z = pk2(o[12], o[13]); b.w = pk2(o[14], o[15]);
    *(u32x4*)p = a; *(u32x4*)(p + 8) = b;
}
__device__ __forceinline__ void ld16f(const float* p, float (&o)[16]) {
#pragma unroll
    for (int j = 0; j < 4; ++j) { const f32x4 v = *(const f32x4*)(p + 4 * j); o[4 * j] = v[0]; o[4 * j + 1] = v[1]; o[4 * j + 2] = v[2]; o[4 * j + 3] = v[3]; }
}
__device__ __forceinline__ void wkv_post(Frame& F, int l) {
    const InTab in = F.in;
    const bf16_t* RKV = (const bf16_t*)(F.ws + WS_RA); const bf16_t* G16 = (const bf16_t*)(F.ws + WS_RA + 224 * MiB); const float* BON = (const float*)(F.ws + WS_LF);
    const bf16_t* YS = (const bf16_t*)(F.ws + WS_Y16); bf16_t* OG = (bf16_t*)(F.ws + WS_H2);
    const int c0 = 16 * F.lane;
    float gg[16], gb[16];
    ld16f(in[I_GNG] + l * 1024 + c0, gg); ld16f(in[I_GNB] + l * 1024 + c0, gb);
    const int gw = F.bid * NWAVES + F.wave, NGW = F.G * NWAVES;
    for (int t = gw; t < T; t += NGW) {
        float y[16], v[16], g[16];
        ld16(YS + (size_t)t * 1024 + c0, y); ld16(RKV + (size_t)t * 3072 + 2048 + c0, v); ld16(G16 + (size_t)t * 1024 + c0, g);
        const float bs = BON[(size_t)t * 16 + (F.lane >> 2)];
        float s = 0.f;
#pragma unroll
        for (int i = 0; i < 16; ++i) s += y[i];
        s = quadsum(s);
        const float mean = s * (1.0f / 64.0f); float q = 0.f;
#pragma unroll
        for (int i = 0; i < 16; ++i) { const float d = y[i] - mean; q += d * d; }
        q = quadsum(q);
        const float rstd = 1.0f / sqrtf(q * (1.0f / 64.0f) + GN_EPS);
        float o[16];
#pragma unroll
        for (int i = 0; i < 16; ++i) o[i] = (((y[i] - mean) * rstd) * gg[i] + gb[i] + bs * v[i]) * g[i];
        st16(OG + (size_t)t * 1024 + c0, o);
    }
}

__device__ __forceinline__ void kv_post(Frame& F) {
    const InTab in = F.in;
    bf16_t* Kb = (bf16_t*)(F.ws + WS_P); const float* LF = (const float*)(F.ws + WS_LF); float* KBv = (float*)(F.ws + WS_KB);
    const int c0 = 16 * F.lane;
    float kn[16]; ld16f(in[I_KNORM] + (c0 & 63), kn);
    const int gw = F.bid * NWAVES + F.wave, NGW = F.G * NWAVES;
    for (int t = gw; t < T; t += NGW) {
        float k[16]; ld16(Kb + (size_t)t * 1024 + c0, k);
        float s = 0.f;
#pragma unroll
        for (int i = 0; i < 16; ++i) s += k[i] * k[i];
        s = quadsum(s);
        const float rs = 1.0f / sqrtf(s * (1.0f / 64.0f) + QK_EPS);
#pragma unroll
        for (int i = 0; i < 16; ++i) k[i] = k[i] * rs * kn[i];
        st16(Kb + (size_t)t * 1024 + c0, k);
    }
    for (int bh = gw; bh < 128; bh += NGW) {
        const int b = bh >> 4, h = bh & 15; const size_t base = ((size_t)b * SEQ + 64 * F.lane) * 16 + h;
        float s = 0.f;
        for (int i = 0; i < 64; ++i) s += LF[base + (size_t)i * 16];
        float incl = s;
#pragma unroll
        for (int o = 1; o < 64; o <<= 1) { const float n = __shfl_up(incl, o); if (F.lane >= o) incl += n; }
        float run = incl - s;
        float kfirst = 0.f, klast = 0.f;
        for (int i = 0; i < 64; ++i) { run += LF[base + (size_t)i * 16]; const float kbv = -run * LOG2E; KBv[(size_t)bh * SEQ + 64 * F.lane + i] = kbv; if (i == 0) kfirst = kbv; klast = kbv; }
        int* T0 = (int*)(F.ws + WS_T0) + bh * 16;
        for (int qb = 0; qb < 16; ++qb) {
            const float thr = __shfl(kfirst, 4 * qb) - 70.0f;
            const unsigned long long skip = __ballot(klast < thr);
            int t0 = (skip == ~0ull) ? 64 : __builtin_ctzll(~skip); const int nt = 4 * qb + 4;
            t0 &= ~1; if (t0 > nt - 4) t0 = nt - 4;
            if (F.lane == 0) T0[qb] = t0;
        }
    }
}

namespace attn_body {
using bf16=__hip_bfloat16;
using bf16x8=__attribute__((ext_vector_type(8)))short;
using s16x4=__attribute__((ext_vector_type(4)))short;
using f32x16=__attribute__((ext_vector_type(16)))float;
using u32x4=__attribute__((ext_vector_type(4)))unsigned;
constexpr int BATCH=8,NHEAD=16,SEQ=4096,D=64,DM=NHEAD*D;
constexpr int NW=8,QBLK=32,QB=QBLK*NW,KVBLK=64,NQB=SEQ/QB;
constexpr int ATTN_PITCH=DM, ATTN_UNIT_ROWS=QB;
__device__ __forceinline__ int crow(int r,int hi){return (r&3)+8*(r>>2)+4*hi;}
#define SBAR() __builtin_amdgcn_sched_barrier(0)
__device__ __forceinline__ void cmask(f32x16&p0,f32x16&p1,int jb,int qrel,int hi){
  const float NEG=-INFINITY; int kb=64*jb+4*hi;
  #pragma unroll
  for(int r=0;r<16;++r){int kv=kb+(r&3)+8*(r>>2); if(kv>qrel)p0[r]=NEG; if(kv+32>qrel)p1[r]=NEG;}
}

constexpr int NSLOT=3, SLOTB=8192;
constexpr int LDS_K=0, LDS_V=NSLOT*SLOTB, LDS_WS=2*NSLOT*SLOTB, LDS_OST=LDS_WS+NW*64*4, LDS_KBIAS=LDS_OST+NW*4096, LDS_BYTES=LDS_KBIAS+SEQ*4;
constexpr float C2=0.125f*1.4426950408889634f;
__device__ __forceinline__ void glds16(const void*gsrc,unsigned lds_dst){unsigned keep;
  asm volatile("s_mov_b32 %0, m0\n\ts_mov_b32 m0, %2\n\ts_nop 0\n\tglobal_load_lds_dwordx4 %1, off\n\ts_mov_b32 m0, %0":"=&s"(keep):"v"(gsrc),"s"(lds_dst):"memory");}
__device__ __forceinline__ float max3f(float a,float b,float c){float r;asm("v_max3_f32 %0, %1, %2, %3":"=v"(r):"v"(a),"v"(b),"v"(c));return r;}
__device__ __forceinline__ float max2f(float a,float b){float r;asm("v_max_f32_e32 %0, %1, %2":"=v"(r):"v"(a),"v"(b));return r;}
__device__ __forceinline__ float fadd_s(float a,float b){float r;asm("v_add_f32_e32 %0, %1, %2":"=v"(r):"v"(a),"v"(b));return r;}
__device__ __forceinline__ float fsub_s(float a,float b){float r;asm("v_sub_f32_e32 %0, %1, %2":"=v"(r):"v"(a),"v"(b));return r;}
typedef float f32x2_t __attribute__((ext_vector_type(2))); typedef __bf16 bf16x2_t __attribute__((ext_vector_type(2)));
__device__ __forceinline__ unsigned cvtpk_s(float lo,float hi){f32x2_t v={lo,hi};bf16x2_t b=__builtin_convertvector(v,bf16x2_t);return __builtin_bit_cast(unsigned,b);}
#define WAIT_BAR(N) asm volatile("s_waitcnt vmcnt(" #N ") lgkmcnt(0)\n\ts_barrier":::"memory")

__device__ __forceinline__ void qkt(f32x16&p0,f32x16&p1,const char*Kslot,const bf16x8*qr,const f32x16&negm,int r32,int hi){
  const char*kb=Kslot+hi*1024+r32*16;
  #pragma unroll
  for(int d0=0;d0<4;++d0){
    const bf16x8 b0=*reinterpret_cast<const bf16x8*>(kb+d0*2048);
    const bf16x8 b1=*reinterpret_cast<const bf16x8*>(kb+d0*2048+512);
    if(d0==0){p0=__builtin_amdgcn_mfma_f32_32x32x16_bf16(b0,qr[0],negm,0,0,0);p1=__builtin_amdgcn_mfma_f32_32x32x16_bf16(b1,qr[0],negm,0,0,0);}
    else{p0=__builtin_amdgcn_mfma_f32_32x32x16_bf16(b0,qr[d0],p0,0,0,0);p1=__builtin_amdgcn_mfma_f32_32x32x16_bf16(b1,qr[d0],p1,0,0,0);}}
}
typedef __attribute__((address_space(3))) const char* lds_cptr;
typedef short v4i16_t __attribute__((ext_vector_type(4)));
__device__ __forceinline__ void kload8(bf16x8*kf,lds_cptr kp){
  kf[0]=*(const __attribute__((address_space(3))) bf16x8*)(kp);      kf[1]=*(const __attribute__((address_space(3))) bf16x8*)(kp+512);
  kf[2]=*(const __attribute__((address_space(3))) bf16x8*)(kp+2048); kf[3]=*(const __attribute__((address_space(3))) bf16x8*)(kp+2560);
  kf[4]=*(const __attribute__((address_space(3))) bf16x8*)(kp+4096); kf[5]=*(const __attribute__((address_space(3))) bf16x8*)(kp+4608);
  kf[6]=*(const __attribute__((address_space(3))) bf16x8*)(kp+6144); kf[7]=*(const __attribute__((address_space(3))) bf16x8*)(kp+6656);
}
__device__ __forceinline__ void kload2(bf16x8*kf,lds_cptr kp,int j){ kf[2*j]=*(const __attribute__((address_space(3))) bf16x8*)(kp+j*2048); kf[2*j+1]=*(const __attribute__((address_space(3))) bf16x8*)(kp+j*2048+512); }
__device__ __forceinline__ s16x4 vtr(lds_cptr p){ return __builtin_bit_cast(s16x4,__builtin_amdgcn_ds_read_tr16_b64_v4i16((__attribute__((address_space(3))) v4i16_t*)p)); }
__device__ __forceinline__ float rowmax(const f32x16&p0,const f32x16&p1){
  float a=max3f(p0[0],p0[1],p1[0]),b=max3f(p0[2],p0[3],p1[1]);a=max3f(a,p1[2],p1[3]);
  #pragma unroll
  for(int r=4;r<16;r+=4){a=max3f(a,p0[r],p0[r+1]);b=max3f(b,p0[r+2],p0[r+3]);a=max3f(a,p1[r],p1[r+1]);b=max3f(b,p1[r+2],p1[r+3]);}
  const float m=max2f(a,b);
  auto rr=__builtin_amdgcn_permlane32_swap(__float_as_uint(m),__float_as_uint(m),false,false);
  return max2f(__uint_as_float(rr[0]),__uint_as_float(rr[1]));
}
__device__ __forceinline__ void pv(f32x16*o,int vb,bf16x8 pa0,bf16x8 pa1,bf16x8 pa2,bf16x8 pa3){
  #pragma unroll
  for(int d0=0;d0<2;++d0){s16x4 lo[4],hi[4];
    #pragma unroll
    for(int ks=0;ks<4;++ks){
      asm volatile("ds_read_b64_tr_b16 %0,%1 offset:%c2":"=&v"(lo[ks]):"v"(vb),"i"(d0*4096+ks*1024):"memory");
      asm volatile("ds_read_b64_tr_b16 %0,%1 offset:%c2":"=&v"(hi[ks]):"v"(vb),"i"(d0*4096+ks*1024+512):"memory");}
    asm volatile("s_waitcnt lgkmcnt(0)":::"memory");SBAR();
    #define PK(k) (bf16x8){lo[k][0],lo[k][1],lo[k][2],lo[k][3],hi[k][0],hi[k][1],hi[k][2],hi[k][3]}
    o[d0]=__builtin_amdgcn_mfma_f32_32x32x16_bf16(pa0,PK(0),o[d0],0,0,0);
    o[d0]=__builtin_amdgcn_mfma_f32_32x32x16_bf16(pa1,PK(1),o[d0],0,0,0);
    o[d0]=__builtin_amdgcn_mfma_f32_32x32x16_bf16(pa2,PK(2),o[d0],0,0,0);
    o[d0]=__builtin_amdgcn_mfma_f32_32x32x16_bf16(pa3,PK(3),o[d0],0,0,0);
    #undef PK
  }
}

#ifndef ATTN_STORE16
#define ATTN_STORE16(p,v) (*(u32x4*)(p)=(v))
#endif
template<int THRL> __device__ __forceinline__ void attn_unit(int tid,int wid,int b,int h,int qb,int t0,const bf16*Q,const bf16*__restrict__ K,const bf16*__restrict__ V,bf16*O,const bf16*G,const float*kbrow,const float*qnorm,char*shm){
  int lane=tid&63; asm volatile("":"+v"(lane));
  const int r32=lane&31,hi=lane>>5; wid=__builtin_amdgcn_readfirstlane(wid);
  const long rowbase=(long)b*SEQ; const int q0=qb*QB;
  const bf16*Qw=Q+(rowbase+q0+wid*QBLK)*DM+h*D;
  const bf16*Kh=K+(rowbase+(long)t0*KVBLK)*DM+h*D,*Vh=V+(rowbase+(long)t0*KVBLK)*DM+h*D; kbrow+=t0*KVBLK;
  const unsigned lds0=(unsigned)(uintptr_t)shm;
  float*wsf=(float*)(shm+LDS_WS)+wid*64;
  const bf16*ksrc=Kh+(long)lane*DM+wid*8;
  const bf16*vsrc=Vh+(long)(16*(wid&3)+(lane>>2))*DM+(wid>>2)*32+(lane&3)*8;
  const unsigned kdst=lds0+LDS_K+wid*1024, vdst=lds0+LDS_V+wid*1024;
  #define DMA_K(t,slot) glds16(ksrc+(long)(t)*KVBLK*DM,(unsigned)__builtin_amdgcn_readfirstlane(kdst+(slot)))
  #define DMA_V(t,slot) glds16(vsrc+(long)(t)*KVBLK*DM,(unsigned)__builtin_amdgcn_readfirstlane(vdst+(slot)))
  const int vb0=(int)(lds0+LDS_V)+((lane>>4)&1)*32+(lane&3)*8+(4*hi+((lane&15)>>2))*64;
  const char*Kbase=shm+LDS_K; bf16x8 kf[8];
  const lds_cptr shm3=(lds_cptr)shm; const lds_cptr kp0=shm3+LDS_K+hi*1024+r32*16; const lds_cptr vp0=shm3+LDS_V+((lane>>4)&1)*32+(lane&3)*8+(4*hi+((lane&15)>>2))*64;
  const int NT=(q0+QB)/KVBLK-t0;
  typedef float f32x4_t __attribute__((ext_vector_type(4))); typedef __attribute__((address_space(3))) const float* lds_fptr;
  const lds_fptr kbl=(lds_fptr)(shm3+LDS_KBIAS);
  { __attribute__((address_space(3))) f32x4_t* kw=(__attribute__((address_space(3))) f32x4_t*)(shm3+LDS_KBIAS); const f32x4_t* kg=(const f32x4_t*)kbrow;
    for(int i=tid;i<NT*KVBLK/4;i+=NW*64) kw[i]=kg[i]; }
  DMA_K(0,0);DMA_V(0,0);DMA_K(1,SLOTB);
  bf16x8 qr[4];
  #pragma unroll
  for(int d0=0;d0<4;++d0)qr[d0]=*reinterpret_cast<const bf16x8*>(&Qw[(long)r32*DM+d0*16+hi*8]);
  { float qf[4][8]; float ss=0.f;
    #pragma unroll
    for(int d0=0;d0<4;++d0){
      #pragma unroll
      for(int j=0;j<8;++j){ qf[d0][j]=__uint_as_float(((unsigned)(unsigned short)qr[d0][j])<<16); ss+=qf[d0][j]*qf[d0][j]; } }
    { auto rr=__builtin_amdgcn_permlane32_swap(__float_as_uint(ss),__float_as_uint(ss),false,false); ss=__uint_as_float(rr[0])+__uint_as_float(rr[1]); }
    const float qs=C2/sqrtf(ss*(1.0f/64.0f)+1e-6f);
    #pragma unroll
    for(int d0=0;d0<4;++d0){ const float*qn=qnorm+d0*16+hi*8; u32x4 w;
      w[0]=cvtpk_s(qf[d0][0]*qs*qn[0],qf[d0][1]*qs*qn[1]); w[1]=cvtpk_s(qf[d0][2]*qs*qn[2],qf[d0][3]*qs*qn[3]); w[2]=cvtpk_s(qf[d0][4]*qs*qn[4],qf[d0][5]*qs*qn[5]); w[3]=cvtpk_s(qf[d0][6]*qs*qn[6],qf[d0][7]*qs*qn[7]);
      qr[d0]=__builtin_bit_cast(bf16x8,w); } }
  float mhat=0.f,l_reg=0.f;f32x16 o[2];o[0]=f32x16{};o[1]=f32x16{};const f32x16 negm=f32x16{};
  const int qrel=wid*QBLK+r32;
  #define CMASK(P0,P1,t) do{int jb_=(t)-(NT-4); if(jb_>=0)cmask(P0,P1,jb_,qrel,hi);}while(0)
  #define KBIAS(P0,P1,t) do{ const lds_fptr kp_=kbl+64*(t)+4*hi; \
    _Pragma("unroll") for(int g_=0;g_<4;++g_){ const f32x4_t a_=*(const __attribute__((address_space(3))) f32x4_t*)(kp_+8*g_)-mhat, b_=*(const __attribute__((address_space(3))) f32x4_t*)(kp_+32+8*g_)-mhat; \
      _Pragma("unroll") for(int j_=0;j_<4;++j_){ P0[4*g_+j_]+=a_[j_]; P1[4*g_+j_]+=b_[j_]; } } }while(0)
  bool resc=false;
  #define START(P0,P1) do{ const float rm=rowmax(P0,P1); resc=false; \
    { const float dl=rm; mhat=fadd_s(mhat,dl); \
      _Pragma("unroll") for(int r=0;r<16;++r){P0[r]=fsub_s(P0[r],dl);P1[r]=fsub_s(P1[r],dl);} } \
    _Pragma("unroll") for(int r=0;r<16;++r)P0[r]=__builtin_amdgcn_exp2f(P0[r]); }while(0)
  #define RESC() do{ if(resc){ asm volatile("s_waitcnt lgkmcnt(0)":::"memory"); \
      _Pragma("unroll") for(int d_=0;d_<2;++d_) _Pragma("unroll") for(int r=0;r<16;++r)o[d_][r]*=wsf[crow(r,hi)]; } }while(0)
  f32x16 pA0,pA1,pB0,pB1;
  int sl_prev=0,sl_cur=0,sl_next=SLOTB;
  #define ROT() do{sl_prev=sl_cur;sl_cur=sl_next;sl_next=(sl_next==(NSLOT-1)*SLOTB)?0:sl_next+SLOTB;}while(0)
  DMA_K(2,2*SLOTB);
  WAIT_BAR(3);
  qkt(pA0,pA1,Kbase,qr,negm,r32,hi);asm volatile("s_nop 15\n\ts_nop 7":"+v"(pA0),"+v"(pA1));KBIAS(pA0,pA1,0);CMASK(pA0,pA1,0);
  START(pA0,pA1);
  _Pragma("unroll") for(int r=0;r<16;++r)pA1[r]=__builtin_amdgcn_exp2f(pA1[r]);
  WAIT_BAR(0);
  DMA_K(3,0);DMA_V(1,SLOTB);
  ROT();
  kload8(kf,kp0+sl_cur);
  WAIT_BAR(2);
  s16x4 vlo[8],vhi[8]; u32x4 pw0,pw1,pw2,pw3;
  #define PKW(P,B) cvtpk_s(P[B],P[B+1])
  #define PAF(k) __builtin_bit_cast(bf16x8,pw##k)
  #define VFR(i) (bf16x8){vlo[i][0],vlo[i][1],vlo[i][2],vlo[i][3],vhi[i][0],vhi[i][1],vhi[i][2],vhi[i][3]}
  #define PIN(x) asm volatile("":"+v"(x))
  #define MX3(a,b,c) __builtin_fmaxf(__builtin_fmaxf((a),(b)),(c))
  #define GAPA(MF,A0,A1,A2,A3,W0,W1,PW) do{ MF; sacc+=A0; sacc+=A1; sacc+=A2; sacc+=A3; PIN(sacc); W0; W1; PIN(PW); SBAR(); }while(0)
  #define EX(v) __builtin_amdgcn_exp2f(v)
  #define GAPB(MF,X,B) do{ MF; X[B]=EX(X[B]); X[B+1]=EX(X[B+1]); X[B+2]=EX(X[B+2]); X[B+3]=EX(X[B+3]); PIN(X); SBAR(); }while(0)
  #define VRD(i) do{ vlo[i]=vtr(vp_+(((i)>>2)*4096+((i)&3)*1024)); vhi[i]=vtr(vp_+(((i)>>2)*4096+((i)&3)*1024+512)); }while(0)
  #define KRD(G,j) do{ if(G){ kload2(kf,kp0+sl_next,j); SBAR(); } }while(0)
  #define STEP(C0,C1,P0,P1,t,GK,GV,GL) do{ SBAR(); \
    const lds_cptr vp_=vp0+sl_prev; \
    VRD(0); SBAR(); float sacc=(P0[0]+P0[1]); \
    GAPA(C0=__builtin_amdgcn_mfma_f32_32x32x16_bf16(kf[0],qr[0],negm,0,0,0), P0[2],P0[3],P0[4],P0[5],     pw0[0]=PKW(P0,0), pw0[1]=PKW(P0,2), pw0); \
    VRD(4); SBAR(); GAPA(C1=__builtin_amdgcn_mfma_f32_32x32x16_bf16(kf[1],qr[0],negm,0,0,0), P0[6],P0[7],P0[8],P0[9],     pw0[2]=PKW(P0,4), pw0[3]=PKW(P0,6), pw0); \
    VRD(1); SBAR(); GAPA(C0=__builtin_amdgcn_mfma_f32_32x32x16_bf16(kf[2],qr[1],C0,0,0,0),   P0[10],P0[11],P0[12],P0[13], pw1[0]=PKW(P0,8), pw1[1]=PKW(P0,10), pw1); \
    VRD(5); SBAR(); GAPA(C1=__builtin_amdgcn_mfma_f32_32x32x16_bf16(kf[3],qr[1],C1,0,0,0),   P0[14],P0[15],P1[0],P1[1],   pw1[2]=PKW(P0,12),pw1[3]=PKW(P0,14), pw1); \
    VRD(2); SBAR(); GAPA(C0=__builtin_amdgcn_mfma_f32_32x32x16_bf16(kf[4],qr[2],C0,0,0,0),   P1[2],P1[3],P1[4],P1[5],     pw2[0]=PKW(P1,0), pw2[1]=PKW(P1,2), pw2); \
    VRD(6); SBAR(); GAPA(C1=__builtin_amdgcn_mfma_f32_32x32x16_bf16(kf[5],qr[2],C1,0,0,0),   P1[6],P1[7],P1[8],P1[9],     pw2[2]=PKW(P1,4), pw2[3]=PKW(P1,6), pw2); \
    VRD(3); SBAR(); GAPA(C0=__builtin_amdgcn_mfma_f32_32x32x16_bf16(kf[6],qr[3],C0,0,0,0),   P1[10],P1[11],P1[12],P1[13], pw3[0]=PKW(P1,8), pw3[1]=PKW(P1,10), pw3); \
    VRD(7); SBAR(); GAPA(C1=__builtin_amdgcn_mfma_f32_32x32x16_bf16(kf[7],qr[3],C1,0,0,0),   P1[14],P1[15],0.f,0.f,       pw3[2]=PKW(P1,12),pw3[3]=PKW(P1,14), pw3); \
    l_reg+=sacc; \
    if(GK){DMA_K((t)+3,sl_cur);} if(GV){DMA_V((t)+1,sl_next);} \
    KBIAS(C0,C1,t); CMASK(C0,C1,t); \
    { float a=MX3(C0[0],C0[1],C1[0]),b=MX3(C0[2],C0[3],C1[1]); a=MX3(a,C1[2],C1[3]); \
      _Pragma("unroll") for(int r=4;r<16;r+=4){a=MX3(a,C0[r],C0[r+1]);b=MX3(b,C0[r+2],C0[r+3]);a=MX3(a,C1[r],C1[r+1]);b=MX3(b,C1[r+2],C1[r+3]);} \
      float rm=__builtin_fmaxf(a,b); { auto rr=__builtin_amdgcn_permlane32_swap(__float_as_uint(rm),__float_as_uint(rm),false,false); rm=__builtin_fmaxf(__uint_as_float(rr[0]),__uint_as_float(rr[1])); } \
      resc=false; \
      if(__builtin_expect(__any(rm>(float)THRL),0)){ const float dl=__builtin_fmaxf(rm,0.f); mhat+=dl; \
        _Pragma("unroll") for(int r=0;r<16;++r){C0[r]-=dl;C1[r]-=dl;} \
        const float f=__builtin_amdgcn_exp2f(-dl); l_reg*=f; if(hi==0)wsf[r32]=f; resc=true; } } \
    SBAR(); \
    GAPB(o[0]=__builtin_amdgcn_mfma_f32_32x32x16_bf16(PAF(0),VFR(0),o[0],0,0,0), C0,0); \
    GAPB(o[1]=__builtin_amdgcn_mfma_f32_32x32x16_bf16(PAF(0),VFR(4),o[1],0,0,0), C0,4); \
    KRD(GL,0); GAPB(o[0]=__builtin_amdgcn_mfma_f32_32x32x16_bf16(PAF(1),VFR(1),o[0],0,0,0), C0,8); \
    KRD(GL,1); GAPB(o[1]=__builtin_amdgcn_mfma_f32_32x32x16_bf16(PAF(1),VFR(5),o[1],0,0,0), C0,12); \
    KRD(GL,2); GAPB(o[0]=__builtin_amdgcn_mfma_f32_32x32x16_bf16(PAF(2),VFR(2),o[0],0,0,0), C1,0); \
    KRD(GL,3); GAPB(o[1]=__builtin_amdgcn_mfma_f32_32x32x16_bf16(PAF(2),VFR(6),o[1],0,0,0), C1,4); \
    GAPB(o[0]=__builtin_amdgcn_mfma_f32_32x32x16_bf16(PAF(3),VFR(3),o[0],0,0,0), C1,8); \
    GAPB(o[1]=__builtin_amdgcn_mfma_f32_32x32x16_bf16(PAF(3),VFR(7),o[1],0,0,0), C1,12); \
    }while(0)
  int t=1;
  #undef CMASK
  #define CMASK(P0,P1,t) do{}while(0)
  for(;t+5<NT;t+=2){
    STEP(pB0,pB1,pA0,pA1,t,true,true,true);     WAIT_BAR(2); RESC(); ROT();
    STEP(pA0,pA1,pB0,pB1,t+1,true,true,true);   WAIT_BAR(2); RESC(); ROT();
  }
  #undef CMASK
  #define CMASK(P0,P1,t) do{int jb_=(t)-(NT-4); if(jb_>=0)cmask(P0,P1,jb_,qrel,hi);}while(0)
  #define ENDW(tt) do{ if((tt)+3<NT){WAIT_BAR(2);} else if((tt)+2<NT){WAIT_BAR(1);} else {WAIT_BAR(0);} }while(0)
  for(;t+1<NT;t+=2){
    STEP(pB0,pB1,pA0,pA1,t,(t+3<NT),(t+1<NT),(t+1<NT));       ENDW(t);   RESC(); ROT();
    STEP(pA0,pA1,pB0,pB1,t+1,(t+4<NT),(t+2<NT),(t+2<NT));     ENDW(t+1); RESC(); ROT();
  }
  STEP(pB0,pB1,pA0,pA1,NT-1,false,false,false); RESC();
  { float sacc=pB0[0]+pB0[1]; _Pragma("unroll") for(int r=2;r<16;++r)sacc+=pB0[r]; _Pragma("unroll") for(int r=0;r<16;++r)sacc+=pB1[r]; l_reg+=sacc;
    pw0=(u32x4){PKW(pB0,0),PKW(pB0,2),PKW(pB0,4),PKW(pB0,6)};pw1=(u32x4){PKW(pB0,8),PKW(pB0,10),PKW(pB0,12),PKW(pB0,14)};pw2=(u32x4){PKW(pB1,0),PKW(pB1,2),PKW(pB1,4),PKW(pB1,6)};pw3=(u32x4){PKW(pB1,8),PKW(pB1,10),PKW(pB1,12),PKW(pB1,14)};
    SBAR(); pv(o,vb0+sl_cur,PAF(0),PAF(1),PAF(2),PAF(3)); }
  #undef PKW
  #undef PAF
  #undef VFR
  #undef PIN
  #undef MX3
  #undef GAPA
  #undef GAPB
  #undef EX
  #undef VRD
  #undef KRD
  #undef STEP
  #undef ENDW
  {auto rr=__builtin_amdgcn_permlane32_swap(__float_as_uint(l_reg),__float_as_uint(l_reg),false,false);l_reg=__uint_as_float(rr[0])+__uint_as_float(rr[1]);}
  if(hi==0)wsf[32+r32]=l_reg;asm volatile("s_waitcnt lgkmcnt(0)":::"memory");
  float rli[16];
  #pragma unroll
  for(int r=0;r<16;++r)rli[r]=__builtin_amdgcn_rcpf(wsf[32+crow(r,hi)]);
  bf16*Ow=O+(rowbase+q0+wid*QBLK)*DM+h*D;
  { bf16*stg=(bf16*)(shm+LDS_OST)+wid*2048;
    #pragma unroll
    for(int r=0;r<16;++r){const int orow=crow(r,hi);
      #pragma unroll
      for(int d0=0;d0<2;++d0)stg[orow*64+d0*32+r32]=__float2bfloat16(o[d0][r]*rli[r]);}
    asm volatile("s_waitcnt lgkmcnt(0)":::"memory");
    const bf16*Gw=G+(rowbase+q0+wid*QBLK)*DM+h*D;
    #pragma unroll
    for(int i=0;i<4;++i){const int row=i*8+(lane>>3),ch=lane&7; u32x4 v=*(const u32x4*)(stg+row*64+ch*8); const u32x4 g=*(const u32x4*)(Gw+(long)row*DM+ch*8);
      #pragma unroll
      for(int q=0;q<4;++q) v[q]=cvtpk_s(__uint_as_float(v[q]<<16)*__uint_as_float(g[q]<<16),__uint_as_float(v[q]&0xffff0000u)*__uint_as_float(g[q]&0xffff0000u));
      ATTN_STORE16(Ow+(long)row*DM+ch*8,v);} }
  asm volatile("s_waitcnt lgkmcnt(0)\n\ts_barrier":::"memory");
  #undef DMA_K
  #undef DMA_V
  #undef CMASK
  #undef KBIAS
  #undef START
  #undef RESC
  #undef ROT
}
constexpr int ATTN_LDS_BYTES=LDS_BYTES;
struct AttnTensors { const bf16* Q; const bf16* K; const bf16* V; bf16* O; const bf16* G; const float* KB; const float* qnorm; };
template<int THRL=8> __device__ __forceinline__ void attn_phase(int tid,int wid,unsigned*ctr,const int*t0tab,volatile __attribute__((address_space(3))) int*bc,char*lds,const AttnTensors&T){
  for(;;){
    if(tid==0){ const int n_=(int)__hip_atomic_fetch_add(ctr,1u,__ATOMIC_RELAXED,__HIP_MEMORY_SCOPE_AGENT); bc[0]=n_; }
    asm volatile("s_waitcnt vmcnt(0) lgkmcnt(0)\n\ts_barrier":::"memory");
    const int n=__builtin_amdgcn_readfirstlane(bc[0]);
    if(n>=BATCH*NHEAD*NQB) break;
    const int qb=NQB-1-(n>>7), bh=n&127;
    const int t0=__builtin_amdgcn_readfirstlane(t0tab[bh*16+qb]);
    attn_unit<THRL>(tid,wid,bh/NHEAD,bh%NHEAD,qb,t0,T.Q,T.K,T.V,T.O,T.G,T.KB+(long)bh*SEQ,T.qnorm,lds);
  }
}
#undef SBAR
#undef WAIT_BAR
}
__device__ __forceinline__ void attn_simple(Frame& F, int j) {
    const InTab in = F.in;
    const bf16_t* Q = (const bf16_t*)(F.ws + WS_RA); const bf16_t* Gt = (const bf16_t*)(F.ws + WS_RA + 64 * MiB);
    const bf16_t* Kb = (const bf16_t*)(F.ws + WS_P); const bf16_t* Vb = (const bf16_t*)(F.ws + WS_P + 64 * MiB);
    const float* KBv = (const float*)(F.ws + WS_KB); bf16_t* OG = (bf16_t*)(F.ws + WS_H2 + 64 * MiB);
    const float* qn = in[I_QNORM] + j * 64;
    for (int item = F.bid; item < 1024; item += F.G) {
        const int bh = item >> 3, qb = item & 7, b = bh >> 4, h = bh & 15, t = qb * 512 + F.tid;
        const size_t row = (size_t)b * SEQ + t;
        float q[64];
        { const bf16_t* qp = Q + row * 1024 + h * 64; float ss = 0.f;
#pragma unroll
          for (int i = 0; i < 8; ++i) { const u32x4 w = *(const u32x4*)(qp + 8 * i);
              q[8 * i] = lo16(w.x); q[8 * i + 1] = hi16(w.x); q[8 * i + 2] = lo16(w.y); q[8 * i + 3] = hi16(w.y); q[8 * i + 4] = lo16(w.z); q[8 * i + 5] = hi16(w.z); q[8 * i + 6] = lo16(w.w); q[8 * i + 7] = hi16(w.w); }
#pragma unroll
          for (int i = 0; i < 64; ++i) ss += q[i] * q[i];
          const float rs = QC2 / sqrtf(ss * (1.0f / 64.0f) + QK_EPS);
#pragma unroll
          for (int i = 0; i < 64; ++i) q[i] = q[i] * rs * qn[i]; }
        float o[64];
#pragma unroll
        for (int i = 0; i < 64; ++i) o[i] = 0.f;
        float m = -1.0e30f, lsum = 0.f;
        const int smax = qb * 512 + F.wave * 64 + 63;
        const bf16_t* kp = Kb + ((size_t)b * SEQ) * 1024 + h * 64; const bf16_t* vp = Vb + ((size_t)b * SEQ) * 1024 + h * 64;
        const float* kbp = KBv + (size_t)bh * SEQ;
        for (int s = 0; s <= smax; ++s) {
            float dot = 0.f;
#pragma unroll
            for (int i = 0; i < 8; ++i) { const u32x4 w = *(const u32x4*)(kp + (size_t)s * 1024 + 8 * i);
                dot += q[8 * i] * lo16(w.x) + q[8 * i + 1] * hi16(w.x) + q[8 * i + 2] * lo16(w.y) + q[8 * i + 3] * hi16(w.y) + q[8 * i + 4] * lo16(w.z) + q[8 * i + 5] * hi16(w.z) + q[8 * i + 6] * lo16(w.w) + q[8 * i + 7] * hi16(w.w); }
            float x = dot + kbp[s];
            if (s > t) x = -1.0e30f;
            const float mn = fmaxf(m, x), corr = exp2f(m - mn), p = (s > t) ? 0.f : exp2f(x - mn);
            m = mn; lsum = lsum * corr + p;
#pragma unroll
            for (int i = 0; i < 8; ++i) { const u32x4 w = *(const u32x4*)(vp + (size_t)s * 1024 + 8 * i);
                o[8 * i] = o[8 * i] * corr + p * lo16(w.x); o[8 * i + 1] = o[8 * i + 1] * corr + p * hi16(w.x); o[8 * i + 2] = o[8 * i + 2] * corr + p * lo16(w.y); o[8 * i + 3] = o[8 * i + 3] * corr + p * hi16(w.y);
                o[8 * i + 4] = o[8 * i + 4] * corr + p * lo16(w.z); o[8 * i + 5] = o[8 * i + 5] * corr + p * hi16(w.z); o[8 * i + 6] = o[8 * i + 6] * corr + p * lo16(w.w); o[8 * i + 7] = o[8 * i + 7] * corr + p * hi16(w.w); }
        }
        const float il = 1.0f / lsum;
        const bf16_t* gp = Gt + row * 1024 + h * 64; bf16_t* op = OG + row * 1024 + h * 64;
#pragma unroll
        for (int i = 0; i < 8; ++i) { const u32x4 w = *(const u32x4*)(gp + 8 * i); u32x4 r;
            r.x = pk2(o[8 * i] * il * lo16(w.x), o[8 * i + 1] * il * hi16(w.x)); r.y = pk2(o[8 * i + 2] * il * lo16(w.y), o[8 * i + 3] * il * hi16(w.y));
            r.z = pk2(o[8 * i + 4] * il * lo16(w.z), o[8 * i + 5] * il * hi16(w.z)); r.w = pk2(o[8 * i + 6] * il * lo16(w.w), o[8 * i + 7] * il * hi16(w.w));
            *(u32x4*)(op + 8 * i) = r; }
    }
}

__device__ __forceinline__ void attn_fast(Frame& F, int j) {
    typedef attn_body::bf16 abf;
    const attn_body::AttnTensors AT{(const abf*)(F.ws + WS_RA), (const abf*)(F.ws + WS_P), (const abf*)(F.ws + WS_P + 64 * MiB), (abf*)(F.ws + WS_H2 + 64 * MiB), (const abf*)(F.ws + WS_RA + 64 * MiB),
                                    (const float*)(F.ws + WS_KB), F.in[I_QNORM] + j * 64};
    static_assert(attn_body::ATTN_LDS_BYTES <= 131072, "attention LDS");
    attn_body::attn_phase<8>(F.tid, F.wave, (unsigned*)(F.ws + WS_CTL) + CW_ATT + 64 * j, (const int*)(F.ws + WS_T0), (volatile LAS int*)(F.lds + MISC_OFF + 64), F.ldsg, AT);
}
__device__ __forceinline__ void relane(Frame& F) { int l_; asm volatile("v_mbcnt_lo_u32_b32 %0, -1, 0\n\tv_mbcnt_hi_u32_b32 %0, -1, %0" : "=v"(l_)); int w_ = F.wave; asm volatile("" : "+s"(w_)); F.wave = w_; F.lane = l_; F.tid = w_ * 64 + l_;
    GAS unsigned char* p_ = (GAS unsigned char*)F.ws; asm volatile("" : "+s"(p_)); F.ws = (unsigned char*)p_; GAS float* x_ = (GAS float*)F.xs; asm volatile("" : "+s"(x_)); F.xs = (float*)x_; }
#define GRID_BAR() (relane(F), xcd_barrier_fn(bar.bar, bar.x, bar.st, F.tid == 0))
#ifndef ONLY
#define ONLY (-1)
#endif
#ifndef REP_MASK
#define REP_MASK 0
#endif
#define ON(k) (relane(F), (ONLY < 0 || ONLY == (k)))
#define RUN(k, ...) do { for (int rep_ = 0; rep_ < (((REP_MASK >> (k)) & 1) ? 2 : 1); ++rep_) { if (ON(k)) { __VA_ARGS__; } if (REP_MASK) __syncthreads(); } } while (0)
template <int l> __device__ __forceinline__ void layer_body(Frame& F, const XcdBarrier& bar) {
    unsigned char* ws = F.ws;

        if (l < 2) {
#ifdef GPROBE
            { relane(F); SchedRKV S{{T / 256, 12, F.G, F.bid}};
#if GPROBE == 1
              EpiNone E{};
#else
              EpiPriv E{(bf16_t*)(ws + WS_RA), F.bid};
#endif
              gemm_fast(F, (const bf16_t*)(ws + WS_SC), 1024, (const bf16_t*)(ws + WS_RWBIG) + (size_t)l * 3072 * 1024, 1024, S, E); __syncthreads(); }
#endif
            RUN(2, SchedRKV S{{T / 256, 12, F.G, F.bid}}; EpiRKV E{(bf16_t*)(ws + WS_RA), (bf16_t*)(ws + WS_P), l};
              gemm_fast(F, (const bf16_t*)(ws + WS_SC), 1024, (const bf16_t*)(ws + WS_RWBIG) + (size_t)l * 3072 * 1024, 1024, S, E););
            RUN(21, SchedDense S{T / 256, 2, F.G, F.bid}; EpiLA E{(bf16_t*)(ws + WS_RA + 192 * MiB)};
              gemm_fast(F, (const bf16_t*)(ws + WS_H2), RWK, (const bf16_t*)(ws + WS_RWLORA) + (size_t)l * 512 * RWK, RWK, S, E););
            GRID_BAR();
            RUN(3, SchedDense S{T / 256, 4, F.G, F.bid}; EpiPlain E{(bf16_t*)(ws + WS_RA + 224 * MiB), 1024};
              gemm_fast(F, (const bf16_t*)(ws + WS_RA + 192 * MiB) + 128, LAW, (const bf16_t*)(ws + WS_LORA2 + (size_t)l * MiB + L2_G2T), G2K, S, E););
            RUN(4, wkv_chunk_prep<0>(F, l));
#ifdef PREP_PROBE
            relane(F); __syncthreads(); wkv_chunk_prep<PREP_PROBE>(F, l);
#endif
            GRID_BAR();
            RUN(20, wkv_chunk_seq(F, l)); RUN(19, moe_convert(F, l, 128, F.G - 128));
            GRID_BAR();
            RUN(6, SchedDense S{T / 256, 4, F.G, F.bid}; EpiPlain E{(bf16_t*)(ws + WS_Y16), 1024};
              gemm_fast(F, (const bf16_t*)(ws + WS_H2), 1024, (const bf16_t*)(ws + WS_RWWO) + (size_t)l * 1024 * 1024, 1024, S, E););
            GRID_BAR();
        } else {
            const int j = l - 2;
            RUN(7, SchedDense S{T / 256, 8, F.G, F.bid}; EpiSplit2 E{(bf16_t*)(ws + WS_RA), (bf16_t*)(ws + WS_RA + 64 * MiB), 1};
              gemm_fast(F, (const bf16_t*)(ws + WS_H2), 1024, (const bf16_t*)(ws + WS_FXQG) + (size_t)j * 2048 * 1024, 1024, S, E););
            GRID_BAR();
            RUN(19, moe_convert(F, l, F.G - 64, 64));
            RUN(8, attn_fast(F, j));
            GRID_BAR();
            RUN(9, SchedDense S{T / 256, 4, F.G, F.bid}; EpiPlain E{(bf16_t*)(ws + WS_Y16), 1024};
              gemm_fast(F, (const bf16_t*)(ws + WS_H2 + 64 * MiB), 1024, (const bf16_t*)(ws + WS_FXWO) + (size_t)j * 1024 * 1024, 1024, S, E););
            GRID_BAR();
        }
#ifdef TOKA_PROBE
        relane(F); tok_a<true>(F, l); __syncthreads();
#endif
#ifdef BAR_PROBE
        for (int bi_ = 0; bi_ < 5; ++bi_) GRID_BAR();
#endif
        RUN(10, tok_a<false>(F, l));
        GRID_BAR();
        {
            const LAS int* lc = (const LAS int*)(F.lds + MOE_LC_OFF);
            const bf16_t* W1T = (const bf16_t*)(ws + WS_MOE); const bf16_t* W2T = W1T + (size_t)32 * 1024 * 1024;
            relane(F); moe_tables(F, l);
            { SchedMoe S{lc + 96, lc[64], F.G, F.bid, (size_t)1024 * 1024}; moe_rows(F, S); EpiMoe1 E{(bf16_t*)(ws + WS_HM)};
              RUN(12, gemm_fast<EpiMoe1, SchedMoe, true>(F, (const bf16_t*)(ws + WS_H2), 1024, W1T, 1024, S, E, (const LAS int*)(F.lds + MOE_TOKL_OFF))); }
            GRID_BAR();
            { SchedMoe S{lc + 96, lc[64], F.G, F.bid, (size_t)1024 * 512}; EpiPlain E{(bf16_t*)(ws + WS_RA + 144 * MiB), 1024};
              RUN(13, gemm_fast(F, (const bf16_t*)(ws + WS_HM), 512, W2T, 512, S, E)); }
            GRID_BAR();
        }
#ifdef TOKB_PROBE
        relane(F); tok_b<true>(F, l, l == 1 ? 1 : (l == 2 ? 2 : 3)); __syncthreads();
#endif
        RUN(14, tok_b<false>(F, l, l == 1 ? 1 : (l == 2 ? 2 : 3)));
        if (l == 3) return;
        GRID_BAR();
        if (l == 0) { RUN(1, rw_prep(F, 1, false)); GRID_BAR(); }
        if (l == 1) {
            RUN(18, fgate_phase(F));
            RUN(15, SchedDense S{T / 256, 8, F.G, F.bid}; EpiSplit2 E{(bf16_t*)(ws + WS_P), (bf16_t*)(ws + WS_P + 64 * MiB), 0};
              gemm_fast(F, (const bf16_t*)(ws + WS_RA), 1024, (const bf16_t*)(ws + WS_KVW), 1024, S, E););
            GRID_BAR();
            RUN(16, kv_post(F));
            GRID_BAR();
        }
}
__global__ void __launch_bounds__(NTHR, 2) yoco_fwd(Args args) {
    extern __shared__ __attribute__((aligned(16))) unsigned char lds[];
    Frame F;
    F.lds = (LAS unsigned char*)lds; F.ldsg = (char*)lds; F.ws = args.ws; F.xs = args.out; F.in.p = args.in;
    F.tid = threadIdx.x; F.lane = F.tid & 63; F.wave = __builtin_amdgcn_readfirstlane(F.tid >> 6); F.G = gridDim.x; F.bid = blockIdx.x;
    volatile LAS unsigned* MISC = (volatile LAS unsigned*)(F.lds + MISC_OFF);
    if (F.tid < 32) MISC[F.tid] = 0u;
    __syncthreads();
    XcdBarrier bar = xcd_barrier_post((unsigned*)(F.ws + WS_CTL) + CW_BAR, MISC + 8);
    unsigned char* ws = F.ws;
    RUN(0, p0_prologue(F));
    GRID_BAR();
    RUN(1, rw_prep(F, 0, true));
    GRID_BAR();
    layer_body<0>(F, bar); layer_body<1>(F, bar); layer_body<2>(F, bar); layer_body<3>(F, bar);
}

extern "C" void kernel_launch(void* const* d_in, const int* in_sizes, int n_in, void* d_out, int out_size, void* d_ws, size_t ws_size, hipStream_t stream) {
    static int grid = 0;
    if (grid == 0) {
        if (n_in != 40 || out_size != T * D || ws_size < WS_END) { fprintf(stderr, "kernel_launch: unexpected shapes (n_in %d out %d ws %zu)\n", n_in, out_size, ws_size); grid = -1; return; }
        int dev = 0, cus = 0, per_cu = 0;
        if (hipGetDevice(&dev) != hipSuccess || hipDeviceGetAttribute(&cus, hipDeviceAttributeMultiprocessorCount, dev) != hipSuccess) { grid = -1; return; }
        if (hipFuncSetAttribute((const void*)yoco_fwd, hipFuncAttributeMaxDynamicSharedMemorySize, LDS_BYTES) != hipSuccess) { fprintf(stderr, "kernel_launch: hipFuncSetAttribute failed\n"); grid = -1; return; }
        if (hipOccupancyMaxActiveBlocksPerMultiprocessor(&per_cu, (const void*)yoco_fwd, NTHR, LDS_BYTES) != hipSuccess || per_cu < 1) fprintf(stderr, "kernel_launch: occupancy query reports %d\n", per_cu);
        (void)hipGetLastError();
        grid = cus;
        if (grid != 256) { fprintf(stderr, "kernel_launch: built for 256 CUs, found %d\n", cus); grid = -1; return; }
    }
    if (grid < 0) return;
    (void)hipMemsetAsync((char*)d_ws + WS_CTL, 0, CTL_BYTES, stream);
    Args a{};
    for (int i = 0; i < 40; ++i) a.in[i] = (const float*)d_in[i];
    a.out = (float*)d_out; a.ws = (unsigned char*)d_ws; a.ph_lo = 0; a.ph_hi = 0;
    hipLaunchKernelGGL(yoco_fwd, dim3(grid), dim3(NTHR), LDS_BYTES, stream, a);
}
```

```cpp
#include <hip/hip_runtime.h>
#include <cstdio>
#include <cstdint>
#include <hip/hip_bf16.h>
#include <cmath>

#define GAS __attribute__((address_space(1)))
#define LAS __attribute__((address_space(3)))
typedef unsigned short bf16_t;
typedef short bf16x8 __attribute__((ext_vector_type(8)));
typedef float f32x4 __attribute__((ext_vector_type(4)));
typedef float f32x2 __attribute__((ext_vector_type(2)));
typedef unsigned u32x4 __attribute__((ext_vector_type(4)));
typedef unsigned u32x2 __attribute__((ext_vector_type(2)));
typedef GAS unsigned gu32;

constexpr int NB = 8, SEQ = 4096, T = NB * SEQ, D = 1024, NH = 16, HD = 64;
constexpr int NWAVES = 8, NTHR = NWAVES * 64;
constexpr float ALPHA = 1.681792830507429f;
constexpr float LN_EPS = 1e-5f, GN_EPS = 64e-5f, QK_EPS = 1e-6f;
constexpr float LOG2E = 1.4426950408889634f;
constexpr float QC2 = 0.125f * LOG2E;
constexpr int RWK = 2048;
constexpr int LAW = 512;
constexpr int G2K = 256;
constexpr int XS_ROWS = 73728;

constexpr size_t MiB = 1u << 20;
constexpr size_t WS_CTL = 0, CTL_BYTES = 1 * MiB;
constexpr size_t WS_MOD = 1 * MiB;
constexpr size_t WS_KVMOD = WS_MOD + 4 * 8 * 6144 * 4;
constexpr size_t WS_RT = 2 * MiB;
constexpr size_t WS_WF = WS_RT + 768 * 1024;
constexpr size_t WS_KB = 3 * MiB;
constexpr size_t WS_LF = 5 * MiB;
constexpr size_t WS_ASG = 7 * MiB;
constexpr size_t WS_GATE = WS_ASG + 256 * 1024;
constexpr size_t WS_DEST = WS_GATE + 256 * 1024;
constexpr size_t WS_TEXP = WS_DEST + 256 * 1024;
constexpr size_t WS_T0 = WS_TEXP + 4096;
constexpr size_t WS_RWBIG = 16 * MiB;
constexpr size_t WS_RWLORA = 28 * MiB;
constexpr size_t WS_LORA2 = 44 * MiB;
constexpr size_t L2_G2T = 0, L2_W2T = 512 * 1024, L2_A2T = 640 * 1024, L2_V2T = 768 * 1024;
constexpr size_t WS_RWWO = 50 * MiB;
constexpr size_t WS_KVW = 54 * MiB;
constexpr size_t WS_FXQG = 58 * MiB;
constexpr size_t WS_FXWO = 66 * MiB;
constexpr size_t WS_MOE = 72 * MiB;
constexpr size_t WS_SC = 168 * MiB;
constexpr size_t X3S = (size_t)T * 1024;
constexpr size_t WS_XS = WS_SC + 200 * MiB;
constexpr size_t WS_P = 456 * MiB;
constexpr size_t WS_Y16 = 584 * MiB;
constexpr size_t WS_H2 = 648 * MiB;
constexpr size_t WS_RA = 776 * MiB;
constexpr size_t WS_HM = WS_RA;
constexpr size_t WS_TLIST = WS_RA + 80 * MiB;
constexpr size_t WS_END = 1064 * MiB;
constexpr int CW_BAR = 4096;
constexpr int CW_CNT = 16384;
constexpr int CW_ATT = 16640;

constexpr int LDS_BYTES = 147456;
constexpr int MISC_OFF = 131072 + 320;
constexpr int MOE_LC_OFF = MISC_OFF + 256;
constexpr int MOE_TOKL_OFF = MISC_OFF + 2048;
__device__ __forceinline__ float bf2f(unsigned short b) { return __uint_as_float((unsigned)b << 16); }
typedef float f32x2_cv __attribute__((ext_vector_type(2))); typedef __bf16 bf16x2_cv __attribute__((ext_vector_type(2)));
__device__ __forceinline__ unsigned pk2(float lo, float hi) { const f32x2_cv v = {lo, hi}; return __builtin_bit_cast(unsigned, __builtin_convertvector(v, bf16x2_cv)); }
__device__ __forceinline__ unsigned f2bf(float f) { return pk2(f, 0.f) & 0xffffu; }
__device__ __forceinline__ float lo16(unsigned w) { return __uint_as_float(w << 16); }
__device__ __forceinline__ float hi16(unsigned w) { return __uint_as_float(w & 0xffff0000u); }
__device__ __forceinline__ float sigmoidf_(float x) { return __builtin_amdgcn_rcpf(1.0f + __expf(-x)); }
__device__ __forceinline__ float tanhf_(float x) { const float e = __expf(2.0f * x); return 1.0f - 2.0f * __builtin_amdgcn_rcpf(e + 1.0f); }
template <int CTRL> __device__ __forceinline__ float dpp_f(float v) {
    return __builtin_bit_cast(float, __builtin_amdgcn_update_dpp(0, __builtin_bit_cast(int, v), CTRL, 0xF, 0xF, true));
}
__device__ __forceinline__ float wave_sum(float v) {
    v += dpp_f<0xB1>(v); v += dpp_f<0x4E>(v); v += dpp_f<0x141>(v); v += dpp_f<0x140>(v);
    const int vi = __builtin_bit_cast(int, v);
    const float s0 = __builtin_bit_cast(float, __builtin_amdgcn_readlane(vi, 0)), s1 = __builtin_bit_cast(float, __builtin_amdgcn_readlane(vi, 16)), s2 = __builtin_bit_cast(float, __builtin_amdgcn_readlane(vi, 32)), s3 = __builtin_bit_cast(float, __builtin_amdgcn_readlane(vi, 48));
    return (s0 + s1) + (s2 + s3);
}
__device__ __forceinline__ float quadsum(float v) { v += dpp_f<0xB1>(v); v += dpp_f<0x4E>(v); return v; }
__device__ __forceinline__ float rowsum16(float v) { v += dpp_f<0xB1>(v); v += dpp_f<0x4E>(v); v += dpp_f<0x141>(v); v += dpp_f<0x140>(v); return v; }
#define LDS_WAIT() asm volatile("s_waitcnt lgkmcnt(0)" ::: "memory")
#define LBAR() do { asm volatile("s_waitcnt lgkmcnt(0)" ::: "memory"); __builtin_amdgcn_s_barrier(); asm volatile("" ::: "memory"); } while (0)

#define XB_TMO      128
#define XB_XCNT(j)  (256  + 64 * (j))
#define XB_XSUB(j)  (1280 + 64 * (j))
#define XB_XGEN(j)  (2304 + 64 * (j))
#define XB_TOP      3328
#define XB_TOPGEN   3392
#define XCD_BAR_WORDS 3456
#define XB_SPIN_CAP (1u << 22)
__device__ __forceinline__ unsigned xb_ld(unsigned* p)              { return __hip_atomic_load(p, __ATOMIC_RELAXED, __HIP_MEMORY_SCOPE_AGENT); }
__device__ __forceinline__ unsigned xb_add(unsigned* p, unsigned v) { return __hip_atomic_fetch_add(p, v, __ATOMIC_RELAXED, __HIP_MEMORY_SCOPE_AGENT); }
__device__ __forceinline__ unsigned xb_xcc_id() { return (unsigned)__builtin_amdgcn_s_getreg((3 << 11) | 20) & 0xFu; }
#define XB_SPIN(cond, bar) do { unsigned _sp = 0; while (cond) { __builtin_amdgcn_s_sleep(1); \
    if ((++_sp & 255u) == 0u) { if (xb_ld(&(bar)[XB_TMO])) break; if (_sp > XB_SPIN_CAP) { atomicAdd(&(bar)[XB_TMO], 1u); break; } } } } while (0)
struct XcdBarrier { unsigned* bar; unsigned x; volatile LAS unsigned* st; };
__device__ __forceinline__ XcdBarrier xcd_barrier_post(unsigned* bar, volatile LAS unsigned* st) {
    XcdBarrier b; b.bar = bar; b.x = xb_xcc_id(); b.st = st;
    if (threadIdx.x == 0) (void)xb_add(&bar[XB_XCNT(b.x)], 1u);
    return b;
}
__device__ __forceinline__ void xcd_barrier_complete(unsigned* bar, unsigned x, unsigned& nloc, unsigned& nx) {
    const unsigned G = gridDim.x * gridDim.y * gridDim.z;
    unsigned sum, cnt, mine, sp = 0u;
    for (;;) {
        sum = 0u; cnt = 0u; mine = 0u;
#pragma unroll
        for (unsigned j = 0; j < 16; ++j) { const unsigned c = xb_ld(&bar[XB_XCNT(j)]); sum += c; cnt += (c > 0u) ? 1u : 0u; mine = (j == x) ? c : mine; }
        if (sum == G) break;
        __builtin_amdgcn_s_sleep(1);
        if ((++sp & 255u) == 0u) { if (xb_ld(&bar[XB_TMO])) break; if (sp > XB_SPIN_CAP) { atomicAdd(&bar[XB_TMO], 1u); break; } }
    }
    nloc = mine > 0u ? mine : 1u; nx = cnt > 0u ? cnt : 1u;
}
__device__ __forceinline__ void xcd_barrier_fn(unsigned* bar_, unsigned x_, volatile LAS unsigned* st_, bool is_t0) {
    XcdBarrier b; b.bar = bar_; b.x = x_; b.st = st_;
    asm volatile("s_waitcnt vmcnt(0)" ::: "memory");
    __syncthreads();
    if (is_t0) {
        unsigned* bar = b.bar;
        __builtin_amdgcn_s_waitcnt(0);
        unsigned nloc = b.st[0], nx = b.st[1];
        if (nloc == 0u) { xcd_barrier_complete(bar, b.x, nloc, nx); b.st[0] = nloc; b.st[1] = nx; }
        const unsigned old = xb_add(&bar[XB_XSUB(b.x)], 1u);
        const unsigned gen = old / nloc;
        if (old + 1u == (gen + 1u) * nloc) {
            __builtin_amdgcn_fence(__ATOMIC_RELEASE, "agent");
            asm volatile("s_waitcnt vmcnt(0)" ::: "memory");
            const unsigned og = xb_add(&bar[XB_TOP], 1u);
            const unsigned tg = og / nx;
            if (og + 1u == (tg + 1u) * nx) xb_add(&bar[XB_TOPGEN], 1u);
            else XB_SPIN(xb_ld(&bar[XB_TOPGEN]) == tg, bar);
            __builtin_amdgcn_fence(__ATOMIC_ACQUIRE, "agent");
            xb_add(&bar[XB_XGEN(b.x)], 1u);
            asm volatile("s_waitcnt vmcnt(0)" ::: "memory");
        } else {
            XB_SPIN(xb_ld(&bar[XB_XGEN(b.x)]) == gen, bar);
            __builtin_amdgcn_fence(__ATOMIC_ACQUIRE, "agent");
            asm volatile("s_waitcnt vmcnt(0)" ::: "memory");
        }
    }
    __syncthreads();
}

struct Args { const float* in[40]; float* out; unsigned char* ws; int ph_lo, ph_hi; };
struct InTab { const float* const* p; __device__ __forceinline__ const float* operator[](int i) const { return (const float*)(GAS const float*)p[i]; } };
struct Frame {
    LAS unsigned char* lds; char* ldsg;
    unsigned char* ws; float* xs;
    InTab in;
    int tid, lane, wave, G, bid;
};
enum { I_X = 0, I_C, I_ADAW, I_ADAB, I_LNG, I_LNB, I_MU, I_RKV, I_W0, I_W1, I_W2, I_A0, I_A1, I_A2, I_G1, I_G2, I_KK, I_KA, I_RK, I_GNG, I_GNB, I_RWO, I_V0, I_V1, I_V2,
       I_KVADAW, I_KVADAB, I_KVW, I_KVFB, I_KNORM, I_WQG, I_QNORM, I_FWO, I_WGRP, I_BGRP, I_WEXP, I_BEXP, I_WGATE, I_WUP, I_WDOWN };

__device__ __forceinline__ void tr_item(const float* W, int ldw, int K, int k0, int n0, const float* mu, bf16_t* WT, int ldt, int nd0, int kd0, LAS float* scr, int lane) {
    const int kr = lane >> 3, n4 = 4 * (lane & 7);
    f32x4 v[8];
#pragma unroll
    for (int i = 0; i < 8; ++i) { const int k = k0 + kr + 8 * i; v[i] = (k < K) ? *(const f32x4*)(W + (size_t)k * ldw + n0 + n4) : (f32x4){0.f, 0.f, 0.f, 0.f}; }
    if (mu) {
#pragma unroll
        for (int i = 0; i < 8; ++i) { const int k = k0 + kr + 8 * i; v[i] = v[i] * ((k < K) ? mu[k] : 0.f); }
    }
#pragma unroll
    for (int i = 0; i < 8; ++i) { LAS float* d = scr + (kr + 8 * i) * 33 + n4; d[0] = v[i][0]; d[1] = v[i][1]; d[2] = v[i][2]; d[3] = v[i][3]; }
    LDS_WAIT(); asm volatile("" ::: "memory");
    const int c = lane & 7;
#pragma unroll
    for (int j = 0; j < 4; ++j) {
        const int n = (lane >> 3) + 8 * j; const LAS float* s = scr + (8 * c) * 33 + n;
        u32x4 o; o.x = pk2(s[0 * 33], s[1 * 33]); o.y = pk2(s[2 * 33], s[3 * 33]); o.z = pk2(s[4 * 33], s[5 * 33]); o.w = pk2(s[6 * 33], s[7 * 33]);
        *(u32x4*)(WT + (size_t)(nd0 + n) * ldt + kd0 + 8 * c) = o;
    }
    LDS_WAIT(); asm volatile("" ::: "memory");
}
__device__ __forceinline__ void zero_item(bf16_t* WT, int ldt, int r0, int c0, int c1, int lane) {
    const int cpr = (c1 - c0) >> 3, tot = 32 * cpr;
    for (int i = lane; i < tot; i += 64) { const int r = i / cpr, c = i % cpr; *(u32x4*)(WT + (size_t)(r0 + r) * ldt + c0 + 8 * c) = (u32x4){0u, 0u, 0u, 0u}; }
}

__device__ __forceinline__ void p0_prologue(Frame& F) {
    const InTab in = F.in;
    {
        LAS float* cs = (LAS float*)F.lds;
        LAS float* part = (LAS float*)(F.lds + 32768);
        bool did_cs = false;
        for (int it = F.bid; it < 104; it += F.G) {
            if (!did_cs) { for (int i = F.tid; i < 8 * 1024; i += NTHR) { const float v = in[I_C][i]; cs[i] = v / (1.0f + __expf(-v)); } did_cs = true; }
            __syncthreads();
            const float* W; const float* bias; int ldw, j0; float* dst; int dld;
            if (it < 96) { const int l = it / 24; j0 = (it % 24) * 256; W = in[I_ADAW] + (size_t)l * 1024 * 6144; ldw = 6144; bias = in[I_ADAB] + l * 6144; dst = (float*)(F.ws + WS_MOD) + (size_t)l * 8 * 6144; dld = 6144; }
            else { j0 = (it - 96) * 256; W = in[I_KVADAW]; ldw = 2048; bias = in[I_KVADAB]; dst = (float*)(F.ws + WS_KVMOD); dld = 2048; }
            f32x4 acc[8];
#pragma unroll
            for (int b = 0; b < 8; ++b) acc[b] = (f32x4){0.f, 0.f, 0.f, 0.f};
            const int kbeg = F.wave * 128;
#pragma unroll 4
            for (int kk = 0; kk < 128; ++kk) {
                const int k = kbeg + kk;
                const f32x4 w = *(const f32x4*)(W + (size_t)k * ldw + j0 + 4 * F.lane);
#pragma unroll
                for (int b = 0; b < 8; ++b) acc[b] += w * cs[b * 1024 + k];
            }
#pragma unroll
            for (int b = 0; b < 8; ++b) *(LAS f32x4*)(part + (F.wave * 8 + b) * 256 + 4 * F.lane) = acc[b];
            __syncthreads();
            for (int o = F.tid; o < 8 * 256; o += NTHR) {
                const int b = o >> 8, j = o & 255; float s = 0.f;
#pragma unroll
                for (int w = 0; w < 8; ++w) s += part[(w * 8 + b) * 256 + j];
                dst[(size_t)b * dld + j0 + j] = s + bias[j0 + j];
            }
            __syncthreads();
        }
        __syncthreads();
    }
    {
        const int gt = F.bid * NTHR + F.tid, NGT = F.G * NTHR;
        bf16_t* RTH = (bf16_t*)(F.ws + WS_RT); bf16_t* RTL = RTH + 4 * 48 * 1024; bf16_t* WFH = (bf16_t*)(F.ws + WS_WF); bf16_t* WFL = WFH + 16 * 1024;
        for (int i = gt; i < 4 * 48 * 1024; i += NGT) {
            const int l = i / (48 * 1024), r = i % (48 * 1024), c = r / 1024, k = r % 1024;
            const float w = (c < 4) ? in[I_WGRP][((size_t)l * 1024 + k) * 4 + c] : (c < 36 ? in[I_WEXP][((size_t)l * 1024 + k) * 32 + (c - 4)] : 0.f);
            const unsigned h = f2bf(w); RTH[i] = (bf16_t)h; RTL[i] = (bf16_t)f2bf(w - bf2f((unsigned short)h));
        }
        for (int i = gt; i < 16 * 1024; i += NGT) { const int c = i / 1024, k = i % 1024; const float w = in[I_KVW][(size_t)k * 2064 + 2048 + c];
            const unsigned h = f2bf(w); WFH[i] = (bf16_t)h; WFL[i] = (bf16_t)f2bf(w - bf2f((unsigned short)h)); }
    }
    LAS float* scr = (LAS float*)(F.lds + F.wave * 8704);
    const int gw = F.bid * NWAVES + F.wave, NGW = F.G * NWAVES;
    constexpr int N_S1 = 2 * 3 * 512;
    constexpr int N_S2 = 2 * 17 * 32;
    constexpr int N_S3 = 2 * 128;
    constexpr int N_S4 = 2 * 512 + 1024 + 2 * 1024 + 2 * 512;
    constexpr int N_TOT = N_S1 + N_S2 + N_S3 + N_S4;
    for (int it = gw; it < N_TOT; it += NGW) {
        int r = it;
        if (r < N_S1) {
            const int l = r / 1536; r %= 1536; const int p = r / 512; r %= 512; const int kb = r / 32, nb = r % 32;
            tr_item(in[I_RKV] + (size_t)(l * 3 + p) * 1024 * 1024, 1024, 1024, 64 * kb, 32 * nb, nullptr,
                    (bf16_t*)(F.ws + WS_RWBIG) + (size_t)l * 3072 * 1024, 1024, p * 1024 + 32 * nb, 64 * kb, scr, F.lane);
            continue;
        }
        r -= N_S1;
        if (r < N_S2) {
            const int l = r / (17 * 32); r %= (17 * 32); const int nbk = r / 32, sub = r % 32, half = sub / 16, kb = sub % 16;
            if (nbk >= 16) continue;
            bf16_t* WT = (bf16_t*)(F.ws + WS_RWLORA) + (size_t)l * 512 * RWK;
            const float* W = nullptr; int ldw = 0, n0 = 0, mui = 0;
            if (nbk < 2) { W = in[I_W1] + (size_t)l * 1024 * 64; ldw = 64; n0 = 32 * nbk; mui = 1; }
            else if (nbk < 4) { W = in[I_A1] + (size_t)l * 1024 * 64; ldw = 64; n0 = 32 * (nbk - 2); mui = 4; }
            else if (nbk < 9) { W = in[I_G1] + (size_t)l * 1024 * 160; ldw = 160; n0 = 32 * (nbk - 4); mui = 5; }
            else if (nbk == 9 && l == 1) { W = in[I_V1]; ldw = 32; n0 = 0; mui = 3; }
            if (W) tr_item(W, ldw, 1024, 64 * kb, n0, half ? in[I_MU] + (l * 6 + mui) * 1024 : nullptr, WT, RWK, 32 * nbk, half * 1024 + 64 * kb, scr, F.lane);
            else zero_item(WT, RWK, 32 * nbk, half * 1024 + 64 * kb, half * 1024 + 64 * kb + 64, F.lane);
            continue;
        }
        r -= N_S2;
        if (r < N_S3) {
            const int l = r / 128; r %= 128; const int blk = r / 32, nb = r % 32;
            unsigned char* base = F.ws + WS_LORA2 + (size_t)l * MiB;
            if (blk == 0) { tr_item(in[I_W2] + (size_t)l * 64 * 1024, 1024, 64, 0, 32 * nb, nullptr, (bf16_t*)(base + L2_W2T), 64, 32 * nb, 0, scr, F.lane); }
            else if (blk == 1) { tr_item(in[I_A2] + (size_t)l * 64 * 1024, 1024, 64, 0, 32 * nb, nullptr, (bf16_t*)(base + L2_A2T), 64, 32 * nb, 0, scr, F.lane); }
            else if (blk == 2) { for (int kb = 0; kb < 4; ++kb) tr_item(in[I_G2] + (size_t)l * 160 * 1024, 1024, 160, 64 * kb, 32 * nb, nullptr, (bf16_t*)(base + L2_G2T), G2K, 32 * nb, 64 * kb, scr, F.lane); }
            else { if (l == 1) tr_item(in[I_V2], 1024, 32, 0, 32 * nb, nullptr, (bf16_t*)(base + L2_V2T), 64, 32 * nb, 0, scr, F.lane); }
            continue;
        }
        r -= N_S3;
        if (r < N_S4) {
            if (r < 1024) { const int l = r / 512; r %= 512; tr_item(in[I_RWO] + (size_t)l * 1024 * 1024, 1024, 1024, 64 * (r / 32), 32 * (r % 32), nullptr, (bf16_t*)(F.ws + WS_RWWO) + (size_t)l * 1024 * 1024, 1024, 32 * (r % 32), 64 * (r / 32), scr, F.lane); continue; }
            r -= 1024;
            if (r < 1024) { tr_item(in[I_KVW], 2064, 1024, 64 * (r / 64), 32 * (r % 64), nullptr, (bf16_t*)(F.ws + WS_KVW), 1024, 32 * (r % 64), 64 * (r / 64), scr, F.lane); continue; }
            r -= 1024;
            if (r < 2048) { const int j = r / 1024; r %= 1024; tr_item(in[I_WQG] + (size_t)j * 1024 * 2048, 2048, 1024, 64 * (r / 64), 32 * (r % 64), nullptr, (bf16_t*)(F.ws + WS_FXQG) + (size_t)j * 2048 * 1024, 1024, 32 * (r % 64), 64 * (r / 64), scr, F.lane); continue; }
            r -= 2048;
            { const int j = r / 512; r %= 512; tr_item(in[I_FWO] + (size_t)j * 1024 * 1024, 1024, 1024, 64 * (r / 32), 32 * (r % 32), nullptr, (bf16_t*)(F.ws + WS_FXWO) + (size_t)j * 1024 * 1024, 1024, 32 * (r % 32), 64 * (r / 32), scr, F.lane); continue; }
        }
    }
}
__device__ __forceinline__ void moe_convert(Frame& F, int l, int wg0, int nwg) {
    const InTab in = F.in;
    LAS float* scr = (LAS float*)(F.lds + F.wave * 8704);
    if (F.bid < wg0 || F.bid >= wg0 + nwg) return;
    const int gw = (F.bid - wg0) * NWAVES + F.wave, NGW = nwg * NWAVES;
    bf16_t* base = (bf16_t*)(F.ws + WS_MOE);
    const int kr = F.lane >> 3, n4 = 4 * (F.lane & 7), c = F.lane & 7;
#define MC_DECODE(it_, W_, ldw_, k0_, n0_, WT_, ldt_, nd0_, kd0_) do { const int e_ = (it_) / 768; int r_ = (it_) % 768; const int le_ = l * 32 + e_; \
        if (r_ < 512) { const int kb_ = r_ / 32, nb_ = r_ % 32, s_ = (nb_ % 8) / 4; W_ = (s_ ? in[I_WUP] : in[I_WGATE]) + (size_t)le_ * 1024 * 512; ldw_ = 512; k0_ = 64 * kb_; n0_ = 128 * (nb_ / 8) + 32 * (nb_ % 4); \
            WT_ = base + (size_t)e_ * 1024 * 1024; ldt_ = 1024; nd0_ = 32 * nb_; kd0_ = 64 * kb_; } \
        else { r_ -= 512; const int kb_ = r_ / 32, nb_ = r_ % 32; W_ = in[I_WDOWN] + (size_t)le_ * 512 * 1024; ldw_ = 1024; k0_ = 64 * kb_; n0_ = 32 * nb_; \
            WT_ = base + (size_t)32 * 1024 * 1024 + (size_t)e_ * 1024 * 512; ldt_ = 512; nd0_ = 32 * nb_; kd0_ = 64 * kb_; } } while (0)
    f32x4 v[8];
    { int it = gw; if (it < 32 * 768) { const float* W; int ldw, k0, n0; bf16_t* WT; int ldt, nd0, kd0; MC_DECODE(it, W, ldw, k0, n0, WT, ldt, nd0, kd0);
#pragma unroll
        for (int i = 0; i < 8; ++i) v[i] = *(const f32x4*)(W + (size_t)(k0 + kr + 8 * i) * ldw + n0 + n4); (void)WT; (void)ldt; (void)nd0; (void)kd0; } }
    for (int it = gw; it < 32 * 768; it += NGW) {
        const float* W; int ldw, k0, n0; bf16_t* WT; int ldt, nd0, kd0; MC_DECODE(it, W, ldw, k0, n0, WT, ldt, nd0, kd0);
#pragma unroll
        for (int i = 0; i < 8; ++i) { LAS float* d = scr + (kr + 8 * i) * 33 + n4; d[0] = v[i][0]; d[1] = v[i][1]; d[2] = v[i][2]; d[3] = v[i][3]; }
        if (it + NGW < 32 * 768) { const float* Wn; int ldwn, k0n, n0n; bf16_t* WTn; int ldtn, nd0n, kd0n; MC_DECODE(it + NGW, Wn, ldwn, k0n, n0n, WTn, ldtn, nd0n, kd0n);
#pragma unroll
            for (int i = 0; i < 8; ++i) v[i] = *(const f32x4*)(Wn + (size_t)(k0n + kr + 8 * i) * ldwn + n0n + n4); (void)WTn; (void)ldtn; (void)nd0n; (void)kd0n; }
        LDS_WAIT(); asm volatile("" ::: "memory");
#pragma unroll
        for (int j = 0; j < 4; ++j) {
            const int n = (F.lane >> 3) + 8 * j; const LAS float* sp = scr + (8 * c) * 33 + n;
            u32x4 o; o.x = pk2(sp[0 * 33], sp[1 * 33]); o.y = pk2(sp[2 * 33], sp[3 * 33]); o.z = pk2(sp[4 * 33], sp[5 * 33]); o.w = pk2(sp[6 * 33], sp[7 * 33]);
            *(u32x4*)(WT + (size_t)(nd0 + n) * ldt + kd0 + 8 * c) = o;
        }
        LDS_WAIT(); asm volatile("" ::: "memory");
    }
#undef MC_DECODE
    __syncthreads();
}

struct Unit { int pm, pn; };
struct SchedDense {
    int nM, nN, G, c;
    __device__ __forceinline__ bool next(int i, Unit& u) const {
        const int nwg = nM * nN; const long L = (long)i * G + c; if (L >= nwg) return false;
        int wgid = (int)L; { const int q = nwg / 8, r = nwg % 8, xcd = wgid % 8, off = wgid / 8; wgid = (xcd < r ? xcd * (q + 1) : r * (q + 1) + (xcd - r) * q) + off; }
        const int nig = 8 * nN, gid = wgid / nig, fm = gid * 8, gsz = (nM - fm) < 8 ? (nM - fm) : 8;
        u.pm = fm + ((wgid % nig) % gsz); u.pn = (wgid % nig) / gsz; return true;
    }
    __device__ __forceinline__ size_t boff(const Unit& u, int K) const { return (size_t)u.pn * 256 * K; }
    __device__ __forceinline__ size_t aoff(const Unit&) const { return 0; }
};
struct SchedRKV : SchedDense {
    __device__ __forceinline__ size_t aoff(const Unit& u) const { return (size_t)(u.pn >> 2) * X3S; }
};
struct SchedMoe {
    const LAS int* tt; int ntiles, G, c; size_t estride;
    __device__ __forceinline__ bool next(int i, Unit& u) const { const long L = (long)i * G + c; if (L >= (long)ntiles * 4) return false; u.pm = (int)(L / 4); u.pn = (int)(L % 4); return true; }
    __device__ __forceinline__ size_t boff(const Unit& u, int K) const { return (size_t)(tt[u.pm] >> 16) * estride + (size_t)u.pn * 256 * K; }
    __device__ __forceinline__ size_t aoff(const Unit&) const { return 0; }
};
template <class Epi, class Sched>
__device__ __forceinline__ void gemm_phase(Frame& F, const bf16_t* A, int lda, const bf16_t* Bt, int K, const Sched& S, const Epi& E) {
    const int wr = F.wave >> 2, wc = F.wave & 3, fr = F.lane & 15, fq = F.lane >> 4;
    Unit u;
    for (int i = 0; S.next(i, u); ++i) {
        const bf16_t* Bb = Bt + S.boff(u, K) + (size_t)(wc * 32 + fr) * K + 8 * fq;
        for (int ai = 0; ai < 2; ++ai) {
            f32x4 acc[2][4][2];
#pragma unroll
            for (int b = 0; b < 2; ++b)
#pragma unroll
                for (int m = 0; m < 4; ++m)
#pragma unroll
                    for (int n = 0; n < 2; ++n) acc[b][m][n] = (f32x4){0.f, 0.f, 0.f, 0.f};
            const bf16_t* Ab = A + (size_t)(u.pm * 256 + ai * 128 + wr * 64 + fr) * lda + 8 * fq;
            for (int k0 = 0; k0 < K; k0 += 32) {
                bf16x8 bfr[2][2], af[4];
#pragma unroll
                for (int b = 0; b < 2; ++b)
#pragma unroll
                    for (int n = 0; n < 2; ++n) bfr[b][n] = *(const bf16x8*)(Bb + (size_t)(b * 128 + n * 16) * K + k0);
#pragma unroll
                for (int m = 0; m < 4; ++m) af[m] = *(const bf16x8*)(Ab + (size_t)(m * 16) * lda + k0);
#pragma unroll
                for (int b = 0; b < 2; ++b)
#pragma unroll
                    for (int m = 0; m < 4; ++m)
#pragma unroll
                        for (int n = 0; n < 2; ++n) acc[b][m][n] = __builtin_amdgcn_mfma_f32_16x16x32_bf16(bfr[b][n], af[m], acc[b][m][n], 0, 0, 0);
            }
            E(acc, ai, u, wr, wc, fr, fq);
        }
    }
}
#define PG8_LAS __attribute__((address_space(3)))
constexpr int BM = 256, BK = 64, HALF = 128, HTB = HALF * BK * 2  , STAGE_BYTES = 8 * HTB;

__host__ __device__ __forceinline__ int lds_byte(int r, int c) { const int st = (r >> 4) * 2 + (c >> 5), rr = r & 15, cc = c & 31, ob = rr * 64 + cc * 2; return st * 1024 + (ob ^ (((ob >> 9) & 1) << 5)); }
__host__ __device__ __forceinline__ void stage_rc(int b, int& R, int& C) { const int st = b / 1024, sb = b % 1024, swz = sb ^ (((sb >> 9) & 1) << 5); R = (st >> 1) * 16 + swz / 64; C = (st & 1) * 32 + (swz % 64) / 2; }
__host__ __device__ __forceinline__ int perm32(int rho) { const int n = rho >> 4, i = rho & 15; return 8 * (i >> 2) + 4 * n + (i & 3); }
template <class Epi, class Sched, bool GATHER = false, bool ALIGN_EPI = true, bool SP2 = true>
__device__ __forceinline__ void gemm_fast(Frame& F, const bf16_t* Ag, int lda, const bf16_t* Btg, int Kin, const Sched& S, const Epi& E, const LAS int* tokL = nullptr) {
    static_assert(!GATHER || SP2, "gather mode is written for the SP2 loop");
    PG8_LAS unsigned char* lds = (PG8_LAS unsigned char*)F.lds;
    const int tid = F.tid, wid = F.wave, lane = F.lane, wr = wid >> 2, wc = wid & 3, fr = lane & 15, fq = lane >> 4;
    int K = Kin; asm volatile("" : "+s"(K));
    const int nt = K / BK;
    unsigned voffA[2], voffB[2];
#pragma unroll
    for (int i = 0; i < 2; ++i) { int R, C; stage_rc(tid * 16 + i * 8192, R, C); const int Rb = (Epi::BCONT ? (R >> 5) * 64 : (R & ~31)) + perm32(R & 31);
        voffA[i] = (unsigned)(R * lda + C) * 2u; voffB[i] = (unsigned)(Rb * K + C) * 2u; }
    const size_t kstep = (size_t)(BK * 2);
    const size_t hstepA = (size_t)HALF * lda * 2, hstep = (size_t)(Epi::BCONT ? 32 : HALF) * K * 2;
    const size_t tstepA = 2 * hstepA;
    const unsigned ldsw = (unsigned)wid * 1024u;
    const int aoff = lds_byte(wr * 64 + fr, fq * 8), boff = lds_byte(wc * 32 + fr, fq * 8);
#define PG8_SA(b, h) (((b) * 2 + (h)) * HTB)
#define PG8_SB(b, h) ((4 + (b) * 2 + (h)) * HTB)
    const unsigned ldsb = (unsigned)__builtin_amdgcn_readfirstlane((int)((unsigned)(size_t)lds + ldsw));
#define PG8_STAGE(bufoff, gbase, voff) do { _Pragma("unroll") for (int _i = 0; _i < 2; ++_i) { unsigned keep_; \
        asm volatile("s_mov_b32 %0, m0\n\ts_mov_b32 m0, %3\n\ts_nop 0\n\tglobal_load_lds_dwordx4 %1, %2\n\ts_mov_b32 m0, %0" : "=&s"(keep_) : "v"((voff)[_i]), "s"((const char*)(gbase)), "s"(ldsb + (unsigned)((bufoff) + _i * 8192)) : "memory"); } } while (0)
    unsigned gcu[2][2] = {{0u, 0u}, {0u, 0u}}, gnx[2][2] = {{0u, 0u}, {0u, 0u}};
#define PG8_GOFS(dst, ord) do { int tl_ = tid; asm volatile("" : "+v"(tl_));   _Pragma("unroll") for (int _h = 0; _h < 2; ++_h) _Pragma("unroll") for (int _i = 0; _i < 2; ++_i) { int R_, C_; stage_rc(tl_ * 16 + _i * 8192, R_, C_); \
        dst[_h][_i] = ((unsigned)tokL[(ord) * 256 + _h * 128 + R_] * (unsigned)lda + (unsigned)C_) * 2u; } } while (0)
#define PG8_STAGE_A(bufoff, gptr, half, usenext) do { if constexpr (GATHER) { unsigned vv_[2]; _Pragma("unroll") for (int _j = 0; _j < 2; ++_j) vv_[_j] = (usenext) ? gnx[half][_j] : gcu[half][_j]; PG8_STAGE(bufoff, gptr, vv_); } \
        else { PG8_STAGE(bufoff, (gptr) + ((half) ? hstepA : (size_t)0), voffA); } } while (0)
#define PG8_LDA(dst, b, h) do { _Pragma("unroll") for (int m = 0; m < 4; ++m) _Pragma("unroll") for (int k = 0; k < 2; ++k) dst[m][k] = *(const PG8_LAS bf16x8*)(lds + PG8_SA(b, h) + aoff + m * 2048 + k * 1024); } while (0)
#define PG8_LDB(dst, b, h) do { _Pragma("unroll") for (int n = 0; n < 2; ++n) _Pragma("unroll") for (int k = 0; k < 2; ++k) dst[n][k] = *(const PG8_LAS bf16x8*)(lds + PG8_SB(b, h) + boff + n * 2048 + k * 1024); } while (0)
#define PG8_MMA(ai, bj, At, Bt) do { __builtin_amdgcn_s_setprio(1); _Pragma("unroll") for (int m = 0; m < 4; ++m) _Pragma("unroll") for (int n = 0; n < 2; ++n) _Pragma("unroll") for (int k = 0; k < 2; ++k) \
        acc[ai][bj][m][n] = __builtin_amdgcn_mfma_f32_16x16x32_bf16(Bt[n][k], At[m][k], acc[ai][bj][m][n], 0, 0, 0); __builtin_amdgcn_s_setprio(0); } while (0)
#define PG8_WAIT_V(n) asm volatile("s_waitcnt vmcnt(" #n ")" ::: "memory")
#define PG8_WAIT_R(rel) do { if (rel) asm volatile("s_waitcnt vmcnt(%0)" :: "n"(8 + Epi::NST) : "memory"); else PG8_WAIT_V(8); } while (0)
#define PG8_WAIT_L(n) asm volatile("s_waitcnt lgkmcnt(" #n ")" ::: "memory")
#define PG8_BAR __builtin_amdgcn_s_barrier()
#define PG8_SCHED __builtin_amdgcn_sched_barrier(0)
    Unit cur, nxt; int ui = 0;
    if (!S.next(0, cur)) return;
    f32x4 acc[2][2][4][2];
#pragma unroll
    for (int a = 0; a < 2; ++a)
#pragma unroll
        for (int b = 0; b < 2; ++b)
#pragma unroll
            for (int m = 0; m < 4; ++m)
#pragma unroll
                for (int n = 0; n < 2; ++n) acc[a][b][m][n] = (f32x4){0.f, 0.f, 0.f, 0.f};
    bf16x8 At[4][2], B0[2][2], B1[2][2];
    const char* cA = GATHER ? (const char*)Ag : (const char*)Ag + 2 * S.aoff(cur) + (size_t)cur.pm * tstepA; const char* cB = (const char*)Btg + 2 * S.boff(cur, K);
    if constexpr (GATHER) PG8_GOFS(gcu, 0);
    if constexpr (SP2) {
        PG8_STAGE(PG8_SB(0, 0), cB, voffB); PG8_STAGE(PG8_SB(0, 1), cB + hstep, voffB); PG8_STAGE_A(PG8_SA(0, 0), cA, 0, false); PG8_STAGE_A(PG8_SA(0, 1), cA, 1, false);
        if (wr == 1) PG8_BAR;
        PG8_WAIT_V(2); PG8_BAR;
        PG8_STAGE(PG8_SB(1, 0), cB + kstep, voffB); PG8_STAGE_A(PG8_SA(1, 0), cA + kstep, 0, false); PG8_STAGE(PG8_SB(1, 1), cB + hstep + kstep, voffB);
        PG8_WAIT_V(6); PG8_BAR;
    } else {
        PG8_STAGE(PG8_SB(0, 0), cB, voffB); PG8_STAGE(PG8_SA(0, 0), cA, voffA); PG8_STAGE(PG8_SB(0, 1), cB + hstep, voffB); PG8_STAGE(PG8_SA(0, 1), cA + hstepA, voffA);
        if (wr == 1) PG8_BAR;
        PG8_WAIT_V(4); PG8_BAR;
        PG8_STAGE(PG8_SB(1, 0), cB + kstep, voffB); PG8_STAGE(PG8_SA(1, 0), cA + kstep, voffA); PG8_STAGE(PG8_SB(1, 1), cB + hstep + kstep, voffB);
        PG8_WAIT_V(6); PG8_BAR;
    }
    for (;;) {
        const bool has_next = S.next(ui + 1, nxt);
        const char* nA = GATHER ? cA : (has_next ? (const char*)Ag + 2 * S.aoff(nxt) + (size_t)nxt.pm * tstepA : cA);
        if constexpr (GATHER) { if (has_next) PG8_GOFS(gnx, ui + 1); else { gnx[0][0] = gcu[0][0]; gnx[0][1] = gcu[0][1]; gnx[1][0] = gcu[1][0]; gnx[1][1] = gcu[1][1]; } } const char* nB = has_next ? (const char*)Btg + 2 * S.boff(nxt, K) : cB;
#define PG8_ITER(WAITA, ST11) do { \
            const bool last = (t == nt - 2); \
            const char* a1 = cA + (size_t)(t + 1) * kstep;                                             \
            const char* a2 = last ? nA : cA + (size_t)(t + 2) * kstep; const char* b2 = last ? nB : cB + (size_t)(t + 2) * kstep;     \
            const char* a3 = a2 + kstep; const char* b3 = b2 + kstep;                                \
              \
            PG8_LDB(B0, 0, 0); PG8_LDB(B1, 0, 1); PG8_SCHED; PG8_LDA(At, 0, 0); ST11; \
            WAITA; PG8_WAIT_L(0); PG8_BAR; PG8_MMA(0, 0, At, B0); PG8_MMA(0, 1, At, B1); PG8_BAR; PG8_SCHED; \
              \
            PG8_LDA(At, 0, 1); PG8_STAGE(PG8_SB(0, 0), b2, voffB); PG8_STAGE(PG8_SB(0, 1), b2 + hstep, voffB); PG8_STAGE_A(PG8_SA(0, 0), a2, 0, last); \
            WAITA; PG8_WAIT_L(0); PG8_BAR; PG8_MMA(1, 0, At, B0); PG8_MMA(1, 1, At, B1); PG8_BAR; PG8_SCHED; \
              \
            PG8_LDB(B0, 1, 0); PG8_LDB(B1, 1, 1); PG8_SCHED; PG8_LDA(At, 1, 0); PG8_STAGE_A(PG8_SA(0, 1), a2, 1, last); \
            WAITA; PG8_WAIT_L(0); PG8_BAR; PG8_MMA(0, 0, At, B0); PG8_MMA(0, 1, At, B1); PG8_BAR; PG8_SCHED; \
              \
            PG8_LDA(At, 1, 1); PG8_STAGE(PG8_SB(1, 0), b3, voffB); PG8_STAGE(PG8_SB(1, 1), b3 + hstep, voffB); PG8_STAGE_A(PG8_SA(1, 0), a3, 0, last); \
            PG8_WAIT_V(8); PG8_WAIT_L(0); PG8_BAR; PG8_MMA(1, 0, At, B0); PG8_MMA(1, 1, At, B1); PG8_BAR; PG8_SCHED; } while (0)
        int t = 0;
        if (ui > 0) { PG8_ITER(asm volatile("s_waitcnt vmcnt(%0)" :: "n"(8 + Epi::NST) : "memory"), (void)0); t = 2; }
        for (; t < nt; t += 2) PG8_ITER(PG8_WAIT_V(8), PG8_STAGE_A(PG8_SA(1, 1), a1, 1, false));
#undef PG8_ITER
        if constexpr (SP2) { if (has_next) PG8_STAGE_A(PG8_SA(1, 1), nA + kstep, 1, true); }
        if constexpr (ALIGN_EPI) { if (wr == 0) PG8_BAR; }
        { int fr_ = fr, fq_ = fq; asm volatile("" : "+v"(fr_), "+v"(fq_)); E(acc[0], 0, cur, wr, wc, fr_, fq_); E(acc[1], 1, cur, wr, wc, fr_, fq_); }
        if (!has_next) break;
#pragma unroll
        for (int a = 0; a < 2; ++a)
#pragma unroll
            for (int b = 0; b < 2; ++b)
#pragma unroll
                for (int m = 0; m < 4; ++m)
#pragma unroll
                    for (int n = 0; n < 2; ++n) acc[a][b][m][n] = (f32x4){0.f, 0.f, 0.f, 0.f};
        cur = nxt; cA = nA; cB = nB; ++ui;
        if constexpr (GATHER) { gcu[0][0] = gnx[0][0]; gcu[0][1] = gnx[0][1]; gcu[1][0] = gnx[1][0]; gcu[1][1] = gnx[1][1]; }
        if constexpr (ALIGN_EPI) { if (wr == 1) PG8_BAR; }
    }
    PG8_WAIT_V(0);
    if constexpr (!ALIGN_EPI) { if (wr == 0) PG8_BAR; }
    PG8_BAR;
#undef PG8_SA
#undef PG8_SB
#undef PG8_STAGE
#undef PG8_LDA
#undef PG8_GOFS
#undef PG8_STAGE_A
#undef PG8_LDB
#undef PG8_MMA
#undef PG8_WAIT_V
#undef PG8_WAIT_R
#undef PG8_WAIT_L
#undef PG8_BAR
#undef PG8_SCHED
}
__device__ __forceinline__ void st_bf16x4(bf16_t* p, f32x4 v) { u32x2 w; w.x = pk2(v[0], v[1]); w.y = pk2(v[2], v[3]); *(u32x2*)p = w; }
__device__ __forceinline__ f32x4 ld_bf16x4(const bf16_t* p) { const u32x2 w = *(const u32x2*)p; return (f32x4){lo16(w.x), hi16(w.x), lo16(w.y), hi16(w.y)}; }
__device__ __forceinline__ u32x4 pk8(f32x4 a, f32x4 b) { u32x4 w; w.x = pk2(a[0], a[1]); w.y = pk2(a[2], a[3]); w.z = pk2(b[0], b[1]); w.w = pk2(b[2], b[3]); return w; }
__device__ __forceinline__ u32x4 bperm4(int idx, u32x4 w) { u32x4 r; r.x = (unsigned)__builtin_amdgcn_ds_bpermute(idx, (int)w.x); r.y = (unsigned)__builtin_amdgcn_ds_bpermute(idx, (int)w.y); r.z = (unsigned)__builtin_amdgcn_ds_bpermute(idx, (int)w.z); r.w = (unsigned)__builtin_amdgcn_ds_bpermute(idx, (int)w.w); return r; }
#define EPI_LOOP(ACT, ...) do { const int L_ = fq * 16 + fr, r3_ = L_ >> 3, p3_ = L_ & 7, src4_ = (((p3_ & 3) << 4) | r3_) << 2; const bool hi_ = (p3_ & 4) != 0; \
    _Pragma("unroll") for (int m = 0; m < 4; ++m) { u32x4 wb_[2]; \
        _Pragma("unroll") for (int bj = 0; bj < 2; ++bj) { const int colt0 = wc * 64 + bj * 32 + fq * 8; f32x4 v0 = acc[bj][m][0], v1 = acc[bj][m][1]; (void)colt0; ACT; wb_[bj] = pk8(v0, v1); } \
        _Pragma("unroll") for (int h = 0; h < 2; ++h) { const int row = u.pm * 256 + ai * 128 + wr * 64 + m * 16 + h * 8 + r3_, colt = wc * 64 + p3_ * 8; \
            const u32x4 wa_ = bperm4(src4_ + h * 32, wb_[0]), wc_ = bperm4(src4_ + h * 32, wb_[1]); u32x4 w; w.x = hi_ ? wc_.x : wa_.x; w.y = hi_ ? wc_.y : wa_.y; w.z = hi_ ? wc_.z : wa_.z; w.w = hi_ ? wc_.w : wa_.w; \
            __VA_ARGS__ } asm volatile("" ::: "memory"); } } while (0)

struct EpiPlain {
    bf16_t* O; int ldc; static constexpr int NST = 16; static constexpr bool BCONT = true;
    __device__ __forceinline__ void operator()(const f32x4 (&acc)[2][4][2], int ai, const Unit& u, int wr, int wc, int fr, int fq) const {
        EPI_LOOP(, { __builtin_nontemporal_store(w, (u32x4*)(O + (size_t)row * ldc + u.pn * 256 + colt)); });
    }
};
struct EpiNone { static constexpr int NST = 0; static constexpr bool BCONT = true;
    __device__ __forceinline__ void operator()(const f32x4 (&acc)[2][4][2], int ai, const Unit& u, int wr, int wc, int fr, int fq) const {
        _Pragma("unroll") for (int m = 0; m < 4; ++m) _Pragma("unroll") for (int bj = 0; bj < 2; ++bj) asm volatile("" :: "v"(acc[bj][m][0]), "v"(acc[bj][m][1])); }
};
struct EpiPriv { bf16_t* base; int bid; static constexpr int NST = 16; static constexpr bool BCONT = true;
    __device__ __forceinline__ void operator()(const f32x4 (&acc)[2][4][2], int ai, const Unit& u, int wr, int wc, int fr, int fq) const {
        EPI_LOOP(, { __builtin_nontemporal_store(w, (u32x4*)(base + (size_t)bid * 65536 + (size_t)(row - u.pm * 256) * 256 + colt)); });
    }
};
struct EpiRKV {
    bf16_t* RKV; bf16_t* VF; int l; static constexpr int NST = 16; static constexpr bool BCONT = true;
    __device__ __forceinline__ void operator()(const f32x4 (&acc)[2][4][2], int ai, const Unit& u, int wr, int wc, int fr, int fq) const {
        const bool vf = (l == 0) && (u.pn >= 8);
        EPI_LOOP(, { if (vf) __builtin_nontemporal_store(w, (u32x4*)(VF + (size_t)row * 1024 + (u.pn - 8) * 256 + colt)); else __builtin_nontemporal_store(w, (u32x4*)(RKV + (size_t)row * 3072 + u.pn * 256 + colt)); });
    }
};
struct EpiLA {
    bf16_t* LA; static constexpr int NST = 16; static constexpr bool BCONT = true;
    __device__ __forceinline__ void operator()(const f32x4 (&acc)[2][4][2], int ai, const Unit& u, int wr, int wc, int fr, int fq) const {
        EPI_LOOP({ const int c = u.pn * 256 + colt0;
            if (c < 64) { _Pragma("unroll") for (int q = 0; q < 4; ++q) { v0[q] = tanhf_(v0[q]); v1[q] = tanhf_(v1[q]); } }
            else if (c >= 128 && c < 288) { _Pragma("unroll") for (int q = 0; q < 4; ++q) { v0[q] = sigmoidf_(v0[q]); v1[q] = sigmoidf_(v1[q]); } } },
            { __builtin_nontemporal_store(w, (u32x4*)(LA + (size_t)row * LAW + u.pn * 256 + colt)); });
    }
};
struct EpiSplit2 {
    bf16_t* O0; bf16_t* O1; int sig1; static constexpr int NST = 16; static constexpr bool BCONT = true;
    __device__ __forceinline__ void operator()(const f32x4 (&acc)[2][4][2], int ai, const Unit& u, int wr, int wc, int fr, int fq) const {
        if (u.pn < 4) { EPI_LOOP(, { __builtin_nontemporal_store(w, (u32x4*)(O0 + (size_t)row * 1024 + u.pn * 256 + colt)); }); }
        else { EPI_LOOP({ if (sig1) { _Pragma("unroll") for (int q = 0; q < 4; ++q) { v0[q] = sigmoidf_(v0[q]); v1[q] = sigmoidf_(v1[q]); } } }, { __builtin_nontemporal_store(w, (u32x4*)(O1 + (size_t)row * 1024 + (u.pn - 4) * 256 + colt)); }); }
    }
};
struct EpiMoe1 {
    bf16_t* HM; static constexpr int NST = 8; static constexpr bool BCONT = false;
    __device__ __forceinline__ void operator()(const f32x4 (&acc)[2][4][2], int ai, const Unit& u, int wr, int wc, int fr, int fq) const {
        const int L_ = fq * 16 + fr, src4_ = (((L_ & 3) << 4) | (L_ >> 2)) << 2, r2_ = L_ >> 2, p2_ = L_ & 3;
#pragma unroll
            for (int m = 0; m < 4; ++m) { const int row = u.pm * 256 + ai * 128 + wr * 64 + m * 16 + r2_; f32x4 o[2];
#pragma unroll
                for (int n = 0; n < 2; ++n) { const f32x4 g = acc[0][m][n], up = acc[1][m][n];
#pragma unroll
                    for (int q = 0; q < 4; ++q) o[n][q] = g[q] * sigmoidf_(g[q]) * up[q]; }
                u32x4 w = pk8(o[0], o[1]); w.x = (unsigned)__builtin_amdgcn_ds_bpermute(src4_, (int)w.x); w.y = (unsigned)__builtin_amdgcn_ds_bpermute(src4_, (int)w.y); w.z = (unsigned)__builtin_amdgcn_ds_bpermute(src4_, (int)w.z); w.w = (unsigned)__builtin_amdgcn_ds_bpermute(src4_, (int)w.w);
                __builtin_nontemporal_store(w, (u32x4*)(HM + (size_t)row * 512 + u.pn * 128 + wc * 32 + p2_ * 8)); }
    }
};

struct Row { f32x4 v[4]; };
__device__ __forceinline__ Row ld_row_f32(const float* p, int lane) { Row r;
#pragma unroll
    for (int j = 0; j < 4; ++j) r.v[j] = *(const f32x4*)(p + 256 * j + 4 * lane); return r; }
__device__ __forceinline__ void st_row_f32(float* p, int lane, const Row& r) {
#pragma unroll
    for (int j = 0; j < 4; ++j) *(f32x4*)(p + 256 * j + 4 * lane) = r.v[j]; }
__device__ __forceinline__ Row ld_row_bf16(const bf16_t* p, int lane) { Row r;
#pragma unroll
    for (int j = 0; j < 4; ++j) r.v[j] = ld_bf16x4(p + 256 * j + 4 * lane); return r; }
__device__ __forceinline__ void st_row_bf16(bf16_t* p, int lane, const Row& r) {
#pragma unroll
    for (int j = 0; j < 4; ++j) st_bf16x4(p + 256 * j + 4 * lane, r.v[j]); }
__device__ __forceinline__ Row row_ln(const Row& u, const Row& g, const Row& b) {
    float s = 0.f;
#pragma unroll
    for (int j = 0; j < 4; ++j) s += (u.v[j][0] + u.v[j][1]) + (u.v[j][2] + u.v[j][3]);
    const float mean = wave_sum(s) * (1.0f / 1024.0f); float q = 0.f; Row d;
#pragma unroll
    for (int j = 0; j < 4; ++j) { d.v[j] = u.v[j] - mean; q += (d.v[j][0] * d.v[j][0] + d.v[j][1] * d.v[j][1]) + (d.v[j][2] * d.v[j][2] + d.v[j][3] * d.v[j][3]); }
    const float rstd = 1.0f / sqrtf(wave_sum(q) * (1.0f / 1024.0f) + LN_EPS); Row o;
#pragma unroll
    for (int j = 0; j < 4; ++j) o.v[j] = d.v[j] * rstd * g.v[j] + b.v[j];
    return o;
}
__device__ __forceinline__ float row_dot(const Row& a, const float* w, int lane) {
    float s = 0.f;
#pragma unroll
    for (int j = 0; j < 4; ++j) { const f32x4 x = *(const f32x4*)(w + 256 * j + 4 * lane); s += (a.v[j][0] * x[0] + a.v[j][1] * x[1]) + (a.v[j][2] * x[2] + a.v[j][3] * x[3]); }
    return s;
}

constexpr int APITCH = 1032;
template <int NCB>
__device__ __forceinline__ void skinny_mfma(Frame& F, const LAS bf16_t* AH, const LAS bf16_t* AL, const bf16_t* BH, const bf16_t* BL, LAS float* part) {
    const int fr = F.lane & 15, fq = F.lane >> 4;
    f32x4 acc[NCB];
#pragma unroll
    for (int cb = 0; cb < NCB; ++cb) acc[cb] = (f32x4){0.f, 0.f, 0.f, 0.f};
#pragma unroll
    for (int kb = 0; kb < 4; ++kb) {
        const int k0 = 128 * F.wave + 32 * kb + 8 * fq;
        const bf16x8 ah = *(const LAS bf16x8*)(AH + fr * APITCH + k0), al = *(const LAS bf16x8*)(AL + fr * APITCH + k0);
#pragma unroll
        for (int cb = 0; cb < NCB; ++cb) {
            const bf16x8 bh = *(const bf16x8*)(BH + (size_t)(cb * 16 + fr) * 1024 + k0), bl = *(const bf16x8*)(BL + (size_t)(cb * 16 + fr) * 1024 + k0);
            acc[cb] = __builtin_amdgcn_mfma_f32_16x16x32_bf16(bh, ah, acc[cb], 0, 0, 0);
            acc[cb] = __builtin_amdgcn_mfma_f32_16x16x32_bf16(bl, ah, acc[cb], 0, 0, 0);
            acc[cb] = __builtin_amdgcn_mfma_f32_16x16x32_bf16(bh, al, acc[cb], 0, 0, 0);
        }
    }
#pragma unroll
    for (int cb = 0; cb < NCB; ++cb) *(LAS f32x4*)(part + (F.wave * 16 + fr) * 48 + cb * 16 + 4 * fq) = acc[cb];
}
template <int NCB> struct SkB { bf16x8 h[4][NCB], l[4][NCB]; };
template <int NCB>
__device__ __forceinline__ void skinny_loadB(Frame& F, const bf16_t* BH, const bf16_t* BL, SkB<NCB>& B) {
    int ln_ = F.lane; asm volatile("" : "+v"(ln_));
    const int fr = ln_ & 15, fq = ln_ >> 4;
#pragma unroll
    for (int kb = 0; kb < 4; ++kb) { const int k0 = 128 * F.wave + 32 * kb + 8 * fq;
#pragma unroll
        for (int cb = 0; cb < NCB; ++cb) { B.h[kb][cb] = *(const bf16x8*)(BH + (size_t)(cb * 16 + fr) * 1024 + k0); B.l[kb][cb] = *(const bf16x8*)(BL + (size_t)(cb * 16 + fr) * 1024 + k0); } }
}
template <int NCB>
__device__ __forceinline__ void skinny_mma(Frame& F, const LAS bf16_t* AH, const LAS bf16_t* AL, const SkB<NCB>& B, LAS float* part) {
    const int fr = F.lane & 15, fq = F.lane >> 4;
    f32x4 acc[NCB];
#pragma unroll
    for (int cb = 0; cb < NCB; ++cb) acc[cb] = (f32x4){0.f, 0.f, 0.f, 0.f};
#pragma unroll
    for (int kb = 0; kb < 4; ++kb) {
        const int k0 = 128 * F.wave + 32 * kb + 8 * fq;
        const bf16x8 ah = *(const LAS bf16x8*)(AH + fr * APITCH + k0), al = *(const LAS bf16x8*)(AL + fr * APITCH + k0);
#pragma unroll
        for (int cb = 0; cb < NCB; ++cb) {
            acc[cb] = __builtin_amdgcn_mfma_f32_16x16x32_bf16(B.h[kb][cb], ah, acc[cb], 0, 0, 0);
            acc[cb] = __builtin_amdgcn_mfma_f32_16x16x32_bf16(B.l[kb][cb], ah, acc[cb], 0, 0, 0);
            acc[cb] = __builtin_amdgcn_mfma_f32_16x16x32_bf16(B.h[kb][cb], al, acc[cb], 0, 0, 0);
        }
    }
#pragma unroll
    for (int cb = 0; cb < NCB; ++cb) *(LAS f32x4*)(part + (F.wave * 16 + fr) * 48 + cb * 16 + 4 * fq) = acc[cb];
}
struct RowPk { u32x2 v[4]; };
__device__ __forceinline__ RowPk ld_row_pk(const bf16_t* p, int lane) { RowPk r;
#pragma unroll
    for (int j = 0; j < 4; ++j) r.v[j] = *(const u32x2*)(p + 256 * j + 4 * lane); return r; }
__device__ __forceinline__ Row unpk_row(const RowPk& p) { Row r;
#pragma unroll
    for (int j = 0; j < 4; ++j) r.v[j] = (f32x4){lo16(p.v[j].x), hi16(p.v[j].x), lo16(p.v[j].y), hi16(p.v[j].y)}; return r; }
typedef _Float16 h16x2 __attribute__((ext_vector_type(2)));
__device__ __forceinline__ unsigned pkh2(float lo, float hi) { return __builtin_bit_cast(unsigned, __builtin_amdgcn_cvt_pkrtz(lo, hi)); }
__device__ __forceinline__ Row unpk_row_h(const RowPk& p) { Row r;
#pragma unroll
    for (int j = 0; j < 4; ++j) { const unsigned wx = p.v[j].x, wy = p.v[j].y;
        const h16x2 a = __builtin_bit_cast(h16x2, wx), b = __builtin_bit_cast(h16x2, wy); r.v[j] = (f32x4){(float)a[0], (float)a[1], (float)b[0], (float)b[1]}; } return r; }
__device__ __forceinline__ void st_row_h(bf16_t* p, int lane, const Row& r) {
#pragma unroll
    for (int j = 0; j < 4; ++j) { u32x2 w; w.x = pkh2(r.v[j][0], r.v[j][1]); w.y = pkh2(r.v[j][2], r.v[j][3]); *(u32x2*)(p + 256 * j + 4 * lane) = w; } }
__device__ __forceinline__ RowPk split_row(const Row& h, LAS bf16_t* ah, LAS bf16_t* al, int lane) { RowPk hp;
#pragma unroll
    for (int j = 0; j < 4; ++j) { unsigned hb[4], lb[4];
#pragma unroll
        for (int q = 0; q < 4; ++q) { hb[q] = f2bf(h.v[j][q]); lb[q] = f2bf(h.v[j][q] - __uint_as_float(hb[q] << 16)); }
        hp.v[j].x = hb[0] | (hb[1] << 16); hp.v[j].y = hb[2] | (hb[3] << 16);
        *(LAS u32x2*)(ah + 256 * j + 4 * lane) = hp.v[j]; u32x2 lw; lw.x = lb[0] | (lb[1] << 16); lw.y = lb[2] | (lb[3] << 16); *(LAS u32x2*)(al + 256 * j + 4 * lane) = lw; }
    return hp; }

template <bool DRY = false>
__device__ __forceinline__ void tok_a(Frame& F, int l) {
    const InTab in = F.in;
    const bf16_t* Y16 = (const bf16_t*)(F.ws + WS_Y16); bf16_t* Hb = (bf16_t*)(F.ws + WS_H2); bf16_t* XS = (bf16_t*)(F.ws + WS_XS);
    const bf16_t* RTH = (const bf16_t*)(F.ws + WS_RT) + (size_t)l * 48 * 1024; const bf16_t* RTL = RTH + (size_t)4 * 48 * 1024;
    float* gates = (float*)(F.ws + WS_GATE); int* asg = (int*)(F.ws + WS_ASG);
    LAS unsigned* lcnt = (LAS unsigned*)F.lds;
    LAS unsigned* ltab = (LAS unsigned*)(F.lds + 1024);
    LAS float* lgt = (LAS float*)(F.lds + 2048);
    LAS float* part = (LAS float*)(F.lds + 8192);
    LAS bf16_t* AH = (LAS bf16_t*)(F.lds + 32768); LAS bf16_t* AL = AH + 16 * APITCH;
    const Row lng = ld_row_f32(in[I_LNG] + (size_t)(l * 2 + 0) * 1024, F.lane), lnb = ld_row_f32(in[I_LNB] + (size_t)(l * 2 + 0) * 1024, F.lane);
    LAS f32x4* MODL = (LAS f32x4*)(F.lds + 98816);
    for (int blk = F.bid; blk < T / 128; blk += F.G) {
        if (F.tid < 64) lcnt[F.tid] = 0u;
        const int tb = blk * 128, b = tb / SEQ;
        const float* mod = (const float*)(F.ws + WS_MOD) + ((size_t)l * 8 + b) * 6144;
        if (F.wave < 3) {
#pragma unroll
            for (int j = 0; j < 4; ++j) MODL[(F.wave * 4 + j) * 64 + F.lane] = *(const f32x4*)(mod + (2 + F.wave) * 1024 + 256 * j + 4 * F.lane); }
        LBAR();
#define GT_(j) MODL[(0 * 4 + (j)) * 64 + F.lane]
#define SHF_(j) MODL[(1 * 4 + (j)) * 64 + F.lane]
#define SCF_(j) MODL[(2 * 4 + (j)) * 64 + F.lane]
        float rb0, rb1;
        { const int c0_ = F.tid % 48, c1_ = (F.tid + NTHR) % 48; rb0 = (c0_ < 4) ? in[I_BGRP][l * 4 + c0_] : (c0_ < 36 ? in[I_BEXP][l * 32 + (c0_ - 4)] : 0.f); rb1 = (c1_ < 4) ? in[I_BGRP][l * 4 + c1_] : (c1_ < 36 ? in[I_BEXP][l * 32 + (c1_ - 4)] : 0.f); }
        RowPk xr[2], yr[2];
#pragma unroll
        for (int q = 0; q < 2; ++q) { const int t = tb + 2 * F.wave + q; xr[q] = ld_row_pk(XS + (size_t)t * 1024, F.lane); yr[q] = ld_row_pk(Y16 + (size_t)t * 1024, F.lane); }
        SkB<3> SB; skinny_loadB<3>(F, RTH, RTL, SB);
        for (int r = 0; r < 8; ++r) {
#pragma unroll
            for (int q = 0; q < 2; ++q) {
                const int i = 2 * F.wave + q, t = tb + 16 * r + i;
                const Row y = unpk_row(yr[q]), xq = unpk_row_h(xr[q]); Row u;
#pragma unroll
                for (int j = 0; j < 4; ++j) u.v[j] = ALPHA * xq.v[j] + (1.0f + GT_(j)) * y.v[j];
                const Row x1 = row_ln(u, lng, lnb);
                if (!DRY) st_row_h(XS + (size_t)t * 1024, F.lane, x1);
                Row h;
#pragma unroll
                for (int j = 0; j < 4; ++j) h.v[j] = x1.v[j] * (1.0f + SCF_(j)) + SHF_(j);
                const RowPk hp = split_row(h, AH + i * APITCH, AL + i * APITCH, F.lane);
#pragma unroll
                for (int j = 0; j < 4; ++j) { if (!DRY) *(u32x2*)(Hb + (size_t)t * 1024 + 256 * j + 4 * F.lane) = hp.v[j]; }
            }
#if defined(TOKA_PROBE) && TOKA_PROBE == 2
            if (DRY) { if (r < 7) {
#pragma unroll
                for (int q = 0; q < 2; ++q) { const int t = tb + 16 * (r + 1) + 2 * F.wave + q; xr[q] = ld_row_pk(XS + (size_t)t * 1024, F.lane); yr[q] = ld_row_pk(Y16 + (size_t)t * 1024, F.lane); } }
                LBAR(); continue; }
#endif
            if (r < 7) {
#pragma unroll
                for (int q = 0; q < 2; ++q) { const int t = tb + 16 * (r + 1) + 2 * F.wave + q; xr[q] = ld_row_pk(XS + (size_t)t * 1024, F.lane); yr[q] = ld_row_pk(Y16 + (size_t)t * 1024, F.lane); }
            }
            LBAR();
            skinny_mma<3>(F, AH, AL, SB, part);
            LBAR();
#pragma unroll
            for (int oo = 0; oo < 2; ++oo) { const int o = F.tid + NTHR * oo; if (o < 16 * 48) { const int i = o / 48, c = o % 48; float sm = 0.f;
#pragma unroll
                for (int w = 0; w < 8; ++w) sm += part[(w * 16 + i) * 48 + c];
                lgt[o] = sm + (oo ? rb1 : rb0); } }
            LBAR();
            if (F.tid < 16) {
                const int i = F.tid, t = tb + 16 * r + i; const LAS float* lg = lgt + i * 48;
                const f32x4 lg4 = *(const LAS f32x4*)lg;
                int gs = 0; float gm = lg4[0];
#pragma unroll
                for (int c = 1; c < 4; ++c) if (lg4[c] > gm) { gm = lg4[c]; gs = c; }
                float den = 0.f;
#pragma unroll
                for (int c = 0; c < 4; ++c) den += __expf(lg4[c] - gm);
                const float pg = 1.0f / den;
                const f32x4 le0 = *(const LAS f32x4*)(lg + 4 + gs * 8), le1 = *(const LAS f32x4*)(lg + 8 + gs * 8);
                const float le[8] = {le0[0], le0[1], le0[2], le0[3], le1[0], le1[1], le1[2], le1[3]};
                int i0 = 0; float m0 = le[0];
#pragma unroll
                for (int c = 1; c < 8; ++c) if (le[c] > m0) { m0 = le[c]; i0 = c; }
                int i1 = -1; float m1 = -3.0e38f;
#pragma unroll
                for (int c = 0; c < 8; ++c) if (c != i0 && le[c] > m1) { m1 = le[c]; i1 = c; }
                const float a = __expf(m1 - m0), g0 = pg / (1.0f + a), g1 = pg * a / (1.0f + a);
                const int e0 = gs * 8 + i0, e1 = gs * 8 + i1;
                const unsigned r0 = atomicAdd((unsigned*)&lcnt[e0], 1u), r1 = atomicAdd((unsigned*)&lcnt[e1], 1u);
                ltab[(16 * r + i) * 2] = ((unsigned)e0 << 24) | r0; ltab[(16 * r + i) * 2 + 1] = ((unsigned)e1 << 24) | r1;
                if (!DRY) { gates[(size_t)t * 2] = g0; gates[(size_t)t * 2 + 1] = g1; }
            }
        }
        LBAR();
        if (F.tid < 32) lcnt[32 + F.tid] = DRY ? 0u : __hip_atomic_fetch_add((unsigned*)(F.ws + WS_CTL) + CW_CNT + l * 32 + F.tid, lcnt[F.tid], __ATOMIC_RELAXED, __HIP_MEMORY_SCOPE_AGENT);
        LBAR();
        if (F.tid < 256 && !DRY) { const unsigned w = ltab[F.tid]; const unsigned e = w >> 24; const unsigned rk = (w & 0xffffffu) + lcnt[32 + e]; asg[(size_t)tb * 2 + F.tid] = (int)((e << 24) | rk);
            ((int*)(F.ws + WS_TLIST))[(size_t)e * 65536 + rk] = tb + (F.tid >> 1); }
        LBAR();
    }
}
#undef GT_
#undef SHF_
#undef SCF_
__device__ __forceinline__ void fgate_phase(Frame& F) {
    const InTab in = F.in;
    const bf16_t* WFH = (const bf16_t*)(F.ws + WS_WF); const bf16_t* WFL = WFH + 16 * 1024; float* LF = (float*)(F.ws + WS_LF); const bf16_t* XS = (const bf16_t*)(F.ws + WS_XS);
    LAS float* part = (LAS float*)(F.lds + 8192);
    LAS bf16_t* AH = (LAS bf16_t*)(F.lds + 32768); LAS bf16_t* AL = AH + 16 * APITCH;
    for (int blk = F.bid; blk < T / 128; blk += F.G) {
        const int tb = blk * 128, b = tb / SEQ;
        const float* kvm = (const float*)(F.ws + WS_KVMOD) + (size_t)b * 2048;
        const Row ksh = ld_row_f32(kvm, F.lane), ksc = ld_row_f32(kvm + 1024, F.lane);
        RowPk xr[2];
#pragma unroll
        for (int q = 0; q < 2; ++q) xr[q] = ld_row_pk(XS + (size_t)(tb + 2 * F.wave + q) * 1024, F.lane);
        LBAR();
        for (int r = 0; r < 8; ++r) {
#pragma unroll
            for (int q = 0; q < 2; ++q) { const int i = 2 * F.wave + q; Row hk; const Row xq = unpk_row_h(xr[q]);
#pragma unroll
                for (int j = 0; j < 4; ++j) hk.v[j] = xq.v[j] * (1.0f + ksc.v[j]) + ksh.v[j];
                (void)split_row(hk, AH + i * APITCH, AL + i * APITCH, F.lane); }
            if (r < 7) {
#pragma unroll
                for (int q = 0; q < 2; ++q) xr[q] = ld_row_pk(XS + (size_t)(tb + 16 * (r + 1) + 2 * F.wave + q) * 1024, F.lane);
            }
            LBAR();
            skinny_mfma<1>(F, AH, AL, WFH, WFL, part);
            LBAR();
            if (F.tid < 256) { const int i = F.tid >> 4, c = F.tid & 15; float sm = 0.f;
#pragma unroll
                for (int w = 0; w < 8; ++w) sm += part[(w * 16 + i) * 48 + c];
                const float z = sm + in[I_KVFB][c]; LF[(size_t)(tb + 16 * r + i) * 16 + c] = fminf(z, 0.f) - log1pf(__expf(-fabsf(z))); }
        }
        LBAR();
    }
}

template <bool DRY = false>
__device__ __forceinline__ void tok_b(Frame& F, int l, int next) {
    const InTab in = F.in;
    bf16_t* Hb = (bf16_t*)(F.ws + WS_H2); bf16_t* HK = (bf16_t*)(F.ws + WS_RA); bf16_t* XS = (bf16_t*)(F.ws + WS_XS);
    const bf16_t* YM = (const bf16_t*)(F.ws + WS_RA + 144 * MiB);
    const int* asg = (const int*)(F.ws + WS_ASG); const float* gates = (const float*)(F.ws + WS_GATE); const LAS int* lc = (const LAS int*)(F.lds + MOE_LC_OFF);
    const Row lng = ld_row_f32(in[I_LNG] + (size_t)(l * 2 + 1) * 1024, F.lane), lnb = ld_row_f32(in[I_LNB] + (size_t)(l * 2 + 1) * 1024, F.lane);
    const int gw = F.bid * NWAVES + F.wave, NGW = F.G * NWAVES;
    for (int run = gw; run < T / 8; run += NGW) {
        const int t0 = run * 8, b = t0 / SEQ;
        const Row gt = ld_row_f32((const float*)(F.ws + WS_MOD) + ((size_t)l * 8 + b) * 6144 + 5 * 1024, F.lane);
        Row shm, scm;
        if (next < 3) { const float* modn = (const float*)(F.ws + WS_MOD) + ((size_t)(l + 1) * 8 + b) * 6144; shm = ld_row_f32(modn, F.lane); scm = ld_row_f32(modn + 1024, F.lane); }
        else { shm = Row{}; scm = Row{}; }
        int dmine = 0; float gmine = 0.f;
        if (F.lane < 16) { const unsigned a = (unsigned)asg[(size_t)t0 * 2 + F.lane]; dmine = lc[32 + (a >> 24)] + (int)(a & 0xffffffu); gmine = gates[(size_t)t0 * 2 + F.lane]; }
        RowPk xc = ld_row_pk(XS + (size_t)t0 * 1024, F.lane);
        RowPk y0c = ld_row_pk(YM + (size_t)__shfl(dmine, 0) * 1024, F.lane), y1c = ld_row_pk(YM + (size_t)__shfl(dmine, 1) * 1024, F.lane);
        for (int tt = 0; tt < 8; ++tt) {
            const int t = t0 + tt, tn = (tt < 7) ? tt + 1 : tt;
            const RowPk xn = ld_row_pk(XS + (size_t)(t0 + tn) * 1024, F.lane);
            const RowPk y0n = ld_row_pk(YM + (size_t)__shfl(dmine, 2 * tn) * 1024, F.lane), y1n = ld_row_pk(YM + (size_t)__shfl(dmine, 2 * tn + 1) * 1024, F.lane);
            const float g0 = __shfl(gmine, 2 * tt), g1 = __shfl(gmine, 2 * tt + 1);
            const Row y0 = unpk_row(y0c), y1 = unpk_row(y1c), xq = unpk_row_h(xc); Row u;
#pragma unroll
            for (int j = 0; j < 4; ++j) u.v[j] = ALPHA * xq.v[j] + (1.0f + gt.v[j]) * (g0 * y0.v[j] + g1 * y1.v[j]);
            const Row x2 = row_ln(u, lng, lnb);
            if (!DRY) { if (l == 3) st_row_f32(F.xs + (size_t)t * 1024, F.lane, x2); else st_row_h(XS + (size_t)t * 1024, F.lane, x2); } else asm volatile("" :: "v"(x2.v[0]), "v"(x2.v[1]), "v"(x2.v[2]), "v"(x2.v[3]));
            if (next != 3) {
                Row h;
#pragma unroll
                for (int j = 0; j < 4; ++j) h.v[j] = x2.v[j] * (1.0f + scm.v[j]) + shm.v[j];
                if (!DRY) st_row_bf16(Hb + (size_t)t * 1024, F.lane, h); else asm volatile("" :: "v"(h.v[0]), "v"(h.v[3]));
                if (next == 1) {
                    const float* kvm = (const float*)(F.ws + WS_KVMOD) + (size_t)b * 2048;
                    const Row ksh = ld_row_f32(kvm, F.lane), ksc = ld_row_f32(kvm + 1024, F.lane); Row hk;
#pragma unroll
                    for (int j = 0; j < 4; ++j) hk.v[j] = x2.v[j] * (1.0f + ksc.v[j]) + ksh.v[j];
                    if (!DRY) st_row_bf16(HK + (size_t)t * 1024, F.lane, hk); else asm volatile("" :: "v"(hk.v[0]), "v"(hk.v[3]));
                }
            }
            xc = xn; y0c = y0n; y1c = y1n;
        }
    }
}

__device__ __forceinline__ void rw_prep(Frame& F, int ln, bool from_input) {
    bf16_t* Hb = (bf16_t*)(F.ws + WS_H2); bf16_t* X3 = (bf16_t*)(F.ws + WS_SC);
    const float* src = F.in[I_X]; bf16_t* XS = (bf16_t*)(F.ws + WS_XS);
    const float* mu = F.in[I_MU] + (size_t)ln * 6 * 1024;
    const Row mur = ld_row_f32(mu, F.lane), muk = ld_row_f32(mu + 2 * 1024, F.lane), muv = ld_row_f32(mu + 3 * 1024, F.lane);
    const int gw = F.bid * NWAVES + F.wave, NGW = F.G * NWAVES;
    for (int run = gw; run < T / 8; run += NGW) {
        const int t0 = run * 8, b = t0 / SEQ;
        const float* modn = (const float*)(F.ws + WS_MOD) + ((size_t)ln * 8 + b) * 6144;
        const Row shm = ld_row_f32(modn, F.lane), scm = ld_row_f32(modn + 1024, F.lane);
        Row hprev;
#pragma unroll
        for (int j = 0; j < 4; ++j) hprev.v[j] = (f32x4){0.f, 0.f, 0.f, 0.f};
        if ((t0 % SEQ) != 0) {
            const Row xp = from_input ? ld_row_f32(src + (size_t)(t0 - 1) * 1024, F.lane) : unpk_row_h(ld_row_pk(XS + (size_t)(t0 - 1) * 1024, F.lane));
#pragma unroll
            for (int j = 0; j < 4; ++j) hprev.v[j] = xp.v[j] * (1.0f + scm.v[j]) + shm.v[j];
        }
        Row xc = Row{}; RowPk xcp = RowPk{};
        if (from_input) xc = ld_row_f32(src + (size_t)t0 * 1024, F.lane); else xcp = ld_row_pk(XS + (size_t)t0 * 1024, F.lane);
        for (int tt = 0; tt < 8; ++tt) {
            const int t = t0 + tt, tnx = t0 + (tt < 7 ? tt + 1 : tt);
            const Row x = from_input ? xc : unpk_row_h(xcp);
            if (from_input) xc = ld_row_f32(src + (size_t)tnx * 1024, F.lane); else xcp = ld_row_pk(XS + (size_t)tnx * 1024, F.lane);
            if (from_input) st_row_h(XS + (size_t)t * 1024, F.lane, x);
            Row h, xx, xr, xk, xv;
#pragma unroll
            for (int j = 0; j < 4; ++j) { h.v[j] = x.v[j] * (1.0f + scm.v[j]) + shm.v[j]; xx.v[j] = hprev.v[j] - h.v[j];
                xr.v[j] = h.v[j] + xx.v[j] * mur.v[j]; xk.v[j] = h.v[j] + xx.v[j] * muk.v[j]; xv.v[j] = h.v[j] + xx.v[j] * muv.v[j]; }
            st_row_bf16(Hb + (size_t)t * 2048, F.lane, h); st_row_bf16(Hb + (size_t)t * 2048 + 1024, F.lane, xx);
            st_row_bf16(X3 + (size_t)t * 1024, F.lane, xr); st_row_bf16(X3 + X3S + (size_t)t * 1024, F.lane, xk); st_row_bf16(X3 + 2 * X3S + (size_t)t * 1024, F.lane, xv);
            hprev = h;
        }
    }
}

__device__ __forceinline__ void moe_tables(Frame& F, int l) {
    LAS int* lc = (LAS int*)(F.lds + MOE_LC_OFF);
    const unsigned* cnt = (const unsigned*)(F.ws + WS_CTL) + CW_CNT + l * 32;
    if (F.tid == 0) {
        int acc = 0, ntt = 0;
        for (int e = 0; e < 32; ++e) { const int c = (int)__hip_atomic_load(cnt + e, __ATOMIC_RELAXED, __HIP_MEMORY_SCOPE_AGENT); lc[e] = c; lc[32 + e] = acc; const int nt = (c + 255) >> 8;
            for (int i = 0; i < nt; ++i) lc[96 + ntt + i] = (e << 16) | i;
            ntt += nt; acc += nt << 8; }
        lc[64] = ntt;
    }
    __syncthreads();
}
template <class Sched> __device__ __forceinline__ void moe_rows(Frame& F, const Sched& S) {
    const LAS int* lc = (const LAS int*)(F.lds + MOE_LC_OFF); LAS int* tokL = (LAS int*)(F.lds + MOE_TOKL_OFF); const int* tlist = (const int*)(F.ws + WS_TLIST);
    Unit u;
    for (int i = 0; i < 6 && S.next(i, u); ++i) {
        if (F.tid < 256) { const int ek = lc[96 + u.pm], e = ek >> 16, rank = ((ek & 0xffff) << 8) + F.tid;
            tokL[i * 256 + F.tid] = tlist[(size_t)e * 65536 + (rank < lc[e] ? rank : 0)]; }
    }
    __syncthreads();
}

__device__ __forceinline__ float octsum(float v) { v += dpp_f<0xB1>(v); v += dpp_f<0x4E>(v); v += dpp_f<0x141>(v); return v; }
constexpr int CP = 72, SLOT = 64 * CP;
#define PX(r_, c_) ((r_) * 64 + (((((c_) >> 3) ^ (((r_) >> 1) & 7))) << 3) + ((c_) & 7))
constexpr size_t WS_MP = WS_SC, WS_QQ = WS_SC + 64 * MiB, WS_NT = WS_SC + 128 * MiB, WS_GL = WS_SC + 192 * MiB;
template <bool SWAP> __device__ __forceinline__ f32x4 tile_mm(const LAS bf16_t* Ap, const LAS bf16_t* Bp, int fr, int fq) {
    const int o0 = PX(fr, 8 * fq), o1 = PX(fr, 8 * fq + 32);
    const bf16x8 a0 = *(const LAS bf16x8*)(Ap + o0), a1 = *(const LAS bf16x8*)(Ap + o1);
    const bf16x8 b0 = *(const LAS bf16x8*)(Bp + o0), b1 = *(const LAS bf16x8*)(Bp + o1);
    f32x4 acc = (f32x4){0.f, 0.f, 0.f, 0.f};
    if (!SWAP) { acc = __builtin_amdgcn_mfma_f32_16x16x32_bf16(a0, b0, acc, 0, 0, 0); acc = __builtin_amdgcn_mfma_f32_16x16x32_bf16(a1, b1, acc, 0, 0, 0); }
    else       { acc = __builtin_amdgcn_mfma_f32_16x16x32_bf16(b0, a0, acc, 0, 0, 0); acc = __builtin_amdgcn_mfma_f32_16x16x32_bf16(b1, a1, acc, 0, 0, 0); }
    return acc;
}
__device__ __forceinline__ void ld8f(const float* p, float (&o)[8]) { const f32x4 a = *(const f32x4*)p, b = *(const f32x4*)(p + 4); o[0] = a[0]; o[1] = a[1]; o[2] = a[2]; o[3] = a[3]; o[4] = b[0]; o[5] = b[1]; o[6] = b[2]; o[7] = b[3]; }
__device__ __forceinline__ void st4_lds(LAS bf16_t* p, f32x4 v) { u32x2 w; w.x = pk2(v[0], v[1]); w.y = pk2(v[2], v[3]); *(LAS u32x2*)p = w; }
__device__ __forceinline__ f32x4 ld4_lds(const LAS bf16_t* p) { const u32x2 w = *(const LAS u32x2*)p; return (f32x4){lo16(w.x), hi16(w.x), lo16(w.y), hi16(w.y)}; }
__device__ __forceinline__ void unpk8(const u32x4 w, float (&o)[8]) { o[0] = lo16(w.x); o[1] = hi16(w.x); o[2] = lo16(w.y); o[3] = hi16(w.y); o[4] = lo16(w.z); o[5] = hi16(w.z); o[6] = lo16(w.w); o[7] = hi16(w.w); }
__device__ __forceinline__ void st8_lds(LAS bf16_t* p, const float (&o)[8]) { u32x4 w; w.x = pk2(o[0], o[1]); w.y = pk2(o[2], o[3]); w.z = pk2(o[4], o[5]); w.w = pk2(o[6], o[7]); *(LAS u32x4*)p = w; }

template <int PROBE = 0>
__device__ __forceinline__ void wkv_chunk_prep(Frame& F, int l) {
    const InTab in = F.in;
    const bf16_t* RKV = (const bf16_t*)(F.ws + WS_RA);
    bf16_t* YS = (bf16_t*)(F.ws + WS_Y16); bf16_t* MP = (bf16_t*)(F.ws + WS_MP); bf16_t* QQ = (bf16_t*)(F.ws + WS_QQ); bf16_t* NTt = (bf16_t*)(F.ws + WS_NT); float* GLB = (float*)(F.ws + WS_GL);
    LAS bf16_t* L0 = (LAS bf16_t*)F.lds;
#define SL(n) (L0 + (n) * 4096)
    LAS float* WLs = (LAS float*)(F.lds + 8 * 8192);
    LAS float* SEG = WLs + 64 * 65;
    const int pt = F.tid >> 3, pc0 = 8 * (F.tid & 7);
    const bf16_t* LAg = (const bf16_t*)(F.ws + WS_RA + 192 * MiB); const bf16_t* VFg = (const bf16_t*)(F.ws + WS_P); float* BON = (float*)(F.ws + WS_LF);
    const bf16_t* W2T = (const bf16_t*)(F.ws + WS_LORA2 + (size_t)l * MiB + L2_W2T); const bf16_t* A2T = (const bf16_t*)(F.ws + WS_LORA2 + (size_t)l * MiB + L2_A2T); const bf16_t* V2T = (const bf16_t*)(F.ws + WS_LORA2 + (size_t)l * MiB + L2_V2T);
    u32x4 gr, gk, gv, glw, gla, glv, gvf, gw2, ga2, gv2;
#define PREP_LOAD(uu) do { const int bh_ = (uu) >> 6, c_ = (uu) & 63; const size_t row = (size_t)(bh_ >> 4) * SEQ + 64 * c_ + pt; const int hh = (bh_ & 15) * 64, hc = hh + pc0; \
        gr = *(const u32x4*)(RKV + row * 3072 + hc); gk = *(const u32x4*)(RKV + row * 3072 + 1024 + hc); gv = (l == 0) ? *(const u32x4*)(VFg + row * 1024 + hc) : *(const u32x4*)(RKV + row * 3072 + 2048 + hc); \
        glw = *(const u32x4*)(LAg + row * LAW + pc0); gla = *(const u32x4*)(LAg + row * LAW + 64 + pc0); \
        gw2 = *(const u32x4*)(W2T + (size_t)(hh + pt) * 64 + pc0); ga2 = *(const u32x4*)(A2T + (size_t)(hh + pt) * 64 + pc0); \
        if (l == 1) { glv = *(const u32x4*)(LAg + row * LAW + 288 + (pc0 & 31)); gvf = *(const u32x4*)(VFg + row * 1024 + hc); gv2 = *(const u32x4*)(V2T + (size_t)(hh + pt) * 64 + pc0); } } while (0)
    glv = (u32x4){0u, 0u, 0u, 0u}; gvf = glv; gv2 = glv;
    if (F.bid < 128 * 64) PREP_LOAD(F.bid);
    for (int u = F.bid; u < 128 * 64; u += F.G) {
        const int bh = u >> 6, c = u & 63, b = bh >> 4, h = bh & 15;
        const size_t row0 = (size_t)b * SEQ + 64 * c;
        int ln_ = F.lane; asm volatile("" : "+v"(ln_));
        const int fr = ln_ & 15, fq = ln_ >> 4;
        *(LAS u32x4*)(SL(0) + PX(pt, pc0)) = glw; *(LAS u32x4*)(SL(1) + PX(pt, pc0)) = gla; *(LAS u32x4*)(SL(3) + PX(pt, pc0)) = gw2; *(LAS u32x4*)(SL(4) + PX(pt, pc0)) = ga2;
        if (l == 1) { *(LAS u32x4*)(SL(2) + PX(pt, pc0)) = (pc0 < 32) ? glv : (u32x4){0u, 0u, 0u, 0u}; *(LAS u32x4*)(SL(5) + PX(pt, pc0)) = gv2; }
        LBAR();
        {
            f32x4 zw[2], za[2], zv[2];
#pragma unroll
            for (int i = 0; i < 2; ++i) { const int tile = F.wave + 8 * i, mt = tile >> 2, nt = tile & 3;
                zw[i] = tile_mm<false>(SL(0) + 16 * mt * 64, SL(3) + 16 * nt * 64, fr, fq);
                za[i] = tile_mm<true>(SL(1) + 16 * mt * 64, SL(4) + 16 * nt * 64, fr, fq);
                if (l == 1) zv[i] = tile_mm<true>(SL(2) + 16 * mt * 64, SL(5) + 16 * nt * 64, fr, fq); }
#pragma unroll
            for (int i = 0; i < 2; ++i) { const int tile = F.wave + 8 * i, mt = tile >> 2, nt = tile & 3; const int rr = 16 * mt + fr, cc = 16 * nt + 4 * fq;
                const float w0s = in[I_W0][l * 1024 + h * 64 + 16 * nt + fr]; const f32x4 a0v = *(const f32x4*)(in[I_A0] + l * 1024 + h * 64 + cc); f32x4 av, wh, wlo;
#pragma unroll
                for (int q = 0; q < 4; ++q) { const float wl_ = -0.6065306597126334f * sigmoidf_(zw[i][q] + w0s); wh[q] = bf2f((unsigned short)f2bf(wl_)); wlo[q] = wl_ - wh[q]; av[q] = sigmoidf_(za[i][q] + a0v[q]); }
                st4_lds(SL(11) + PX(16 * nt + fr, 16 * mt + 4 * fq), wh); st4_lds(SL(12) + PX(16 * nt + fr, 16 * mt + 4 * fq), wlo);
                st4_lds(SL(6) + PX(rr, cc), av);
                if (l == 1) { const f32x4 v0v = *(const f32x4*)(in[I_V0] + h * 64 + cc); f32x4 sv;
#pragma unroll
                    for (int q = 0; q < 4; ++q) sv[q] = sigmoidf_(zv[i][q] + v0v[q]);
                    st4_lds(SL(7) + PX(rr, cc), sv); } }
        }
        LBAR();
        float r[8], k[8], v[8], a[8];
        unpk8(gr, r); unpk8(gk, k); unpk8(gv, v); unpk8(*(const LAS u32x4*)(SL(6) + PX(pt, pc0)), a);
        if (l == 1) { float sv[8], vf[8]; unpk8(*(const LAS u32x4*)(SL(7) + PX(pt, pc0)), sv); unpk8(gvf, vf);
#pragma unroll
            for (int q = 0; q < 8; ++q) v[q] = bf2f((unsigned short)f2bf(v[q] + (vf[q] - v[q]) * sv[q]));
            if (PROBE == 0) { u32x4 w; w.x = pk2(v[0], v[1]); w.y = pk2(v[2], v[3]); w.z = pk2(v[4], v[5]); w.w = pk2(v[6], v[7]); *(u32x4*)((bf16_t*)RKV + (row0 + pt) * 3072 + 2048 + h * 64 + pc0) = w; } }
        {
            f32x4 cs[2];
#pragma unroll
            for (int i = 0; i < 2; ++i) { const int tile = F.wave + 8 * i, mt = tile >> 2, nt = tile & 3;
                bf16x8 l0, l1;
#pragma unroll
                for (int e = 0; e < 8; ++e) { l0[e] = (short)((8 * fq + e <= 16 * mt + fr) ? 0x3F80 : 0); l1[e] = (short)((32 + 8 * fq + e <= 16 * mt + fr) ? 0x3F80 : 0); }
                const int c0_ = PX(16 * nt + fr, 8 * fq), c1_ = PX(16 * nt + fr, 8 * fq + 32); const LAS bf16_t* bh = SL(11); const LAS bf16_t* bl = SL(12);
                f32x4 acc = (f32x4){0.f, 0.f, 0.f, 0.f};
                acc = __builtin_amdgcn_mfma_f32_16x16x32_bf16(*(const LAS bf16x8*)(bh + c0_), l0, acc, 0, 0, 0); acc = __builtin_amdgcn_mfma_f32_16x16x32_bf16(*(const LAS bf16x8*)(bh + c1_), l1, acc, 0, 0, 0);
                acc = __builtin_amdgcn_mfma_f32_16x16x32_bf16(*(const LAS bf16x8*)(bl + c0_), l0, acc, 0, 0, 0); acc = __builtin_amdgcn_mfma_f32_16x16x32_bf16(*(const LAS bf16x8*)(bl + c1_), l1, acc, 0, 0, 0);
                cs[i] = acc; }
#pragma unroll
            for (int i = 0; i < 2; ++i) { const int tile = F.wave + 8 * i, mt = tile >> 2, nt = tile & 3; const int rr = 16 * mt + fr, cc = 16 * nt + 4 * fq;
#pragma unroll
                for (int q = 0; q < 4; ++q) WLs[rr * 65 + cc + q] = cs[i][q]; }
        }
        LBAR();
        {
            float kkw[8], kaw[8], rkw[8]; ld8f(in[I_KK] + l * 1024 + h * 64 + pc0, kkw); ld8f(in[I_KA] + l * 1024 + h * 64 + pc0, kaw); ld8f(in[I_RK] + l * 1024 + h * 64 + pc0, rkw);
            float kr[8], ss = 0.f, bs = 0.f;
#pragma unroll
            for (int q = 0; q < 8; ++q) { kr[q] = k[q] * kkw[q]; ss += kr[q] * kr[q]; }
            ss = octsum(ss);
            const float inv = 1.0f / fmaxf(sqrtf(ss), 1e-12f);
            float At[8], Rt[8], Bt[8], Kt[8], Bb[8], Kb[8], gl[8];
#pragma unroll
            for (int q = 0; q < 8; ++q) {
                const float cum = WLs[pt * 65 + pc0 + q], cl = WLs[63 * 65 + pc0 + q], cex = (pt > 0) ? WLs[(pt - 1) * 65 + pc0 + q] : 0.f;
                const float e_in = __expf(cum), e_ex = __expf(cex), e_ng = __expf(-cum); gl[q] = __expf(cl);
                const float kk = kr[q] * inv, kp = k[q] * (1.0f + (a[q] - 1.0f) * kaw[q]); bs += r[q] * kp * rkw[q];
                At[q] = -kk * e_ex; Rt[q] = r[q] * e_in; Bt[q] = kk * a[q] * e_ng; Kt[q] = kp * e_ng; Bb[q] = Bt[q] * gl[q]; Kb[q] = Kt[q] * gl[q];
            }
            st8_lds(SL(0) + PX(pt, pc0), At); st8_lds(SL(1) + PX(pt, pc0), Rt); st8_lds(SL(2) + PX(pt, pc0), Bt); st8_lds(SL(3) + PX(pt, pc0), Kt);
            st8_lds(SL(11) + PX(pt, pc0), v); st8_lds(SL(12) + PX(pt, pc0), Bb); st8_lds(SL(13) + PX(pt, pc0), Kb);
            bs = octsum(bs); if ((F.tid & 7) == 0 && PROBE == 0) BON[(row0 + pt) * 16 + h] = bs;
            if (pt == 0 && PROBE == 0) { float* g = GLB + (size_t)u * 64 + pc0; *(f32x4*)g = (f32x4){gl[0], gl[1], gl[2], gl[3]}; *(f32x4*)(g + 4) = (f32x4){gl[4], gl[5], gl[6], gl[7]}; }
        }
        LBAR();
        {
            const int j = F.tid & 63, t0 = 8 * (F.tid >> 6);
#define TRANSP(src, dst) do { float e[8]; _Pragma("unroll") for (int q = 0; q < 8; ++q) e[q] = bf2f(SL(src)[PX(t0 + q, j)]); st8_lds(SL(dst) + PX(j, t0), e); } while (0)
            TRANSP(0, 6); TRANSP(12, 7); TRANSP(13, 5); TRANSP(11, 4);
#undef TRANSP
            if (u + F.G < 128 * 64) PREP_LOAD(u + F.G);
        }
        LBAR();
        if (PROBE == 1) continue;
        {
            f32x4 acc[8];
#pragma unroll
            for (int i = 0; i < 8; ++i) acc[i] = tile_mm<true>(SL(0) + 16 * i * 64, SL(2) + 16 * F.wave * 64, fr, fq);
            const int nt = F.wave, sq0 = (nt & 3) * 16 + 4 * fq;
#pragma unroll
            for (int i = 0; i < 8; ++i) {
                const int mt = i, tq = (mt & 3) * 16 + fr; f32x4 o;
#pragma unroll
                for (int q = 0; q < 4; ++q) { const int sq = sq0 + q; const bool keep = (mt < 4) ? (sq < tq) : (sq <= tq); o[q] = keep ? acc[i][q] : 0.f; }
                LAS bf16_t* dst = (mt < 4) ? ((nt < 4) ? SL(8) : SL(10)) : ((nt < 4) ? SL(11) : SL(12));
                st4_lds(dst + PX(tq, sq0), o);
                if (mt < 4 && nt < 4) {
#pragma unroll
                    for (int q = 0; q < 4; ++q) SL(9)[PX(sq0 + q, tq)] = (bf16_t)f2bf(o[q]); }
            }
        }
        LBAR();
        {
            f32x4 x[2], y1[2], nk[2];
#pragma unroll
            for (int i = 0; i < 2; ++i) { const int tile = F.wave + 8 * i, mt = tile >> 2, nt = tile & 3;
                x[i] = tile_mm<false>(SL(10) + 16 * mt * 64, SL(4) + 16 * nt * 64, fr, fq);
                y1[i] = tile_mm<true>(SL(12) + 16 * mt * 64, SL(4) + 16 * nt * 64, fr, fq);
                nk[i] = tile_mm<false>(SL(5) + 16 * mt * 64, SL(4) + 16 * nt * 64, fr, fq); }
#pragma unroll
            for (int i = 0; i < 2; ++i) { const int tile = F.wave + 8 * i, mt = tile >> 2, nt = tile & 3;
                st4_lds(SL(2) + PX(16 * nt + fr, 16 * mt + 4 * fq), x[i]);
                st4_lds(SL(3) + PX(16 * mt + fr, 16 * nt + 4 * fq), y1[i]);
                st4_lds(SL(0) + PX(16 * nt + fr, 16 * mt + 4 * fq), nk[i]); }
        }
        LBAR();
        if (PROBE == 2) continue;
#define NEU_SQ(Xn, Xt, On, Ot, WANT_NAT) do { f32x4 s_[2]; \
            _Pragma("unroll") for (int i = 0; i < 2; ++i) { const int tile = F.wave + 8 * i, mt = tile >> 2, nt = tile & 3; s_[i] = tile_mm<true>(SL(Xn) + 16 * mt * 64, SL(Xt) + 16 * nt * 64, fr, fq); } \
            _Pragma("unroll") for (int i = 0; i < 2; ++i) { const int tile = F.wave + 8 * i, mt = tile >> 2, nt = tile & 3; \
                if (WANT_NAT) st4_lds(SL(On) + PX(16 * mt + fr, 16 * nt + 4 * fq), s_[i]); \
                _Pragma("unroll") for (int q = 0; q < 4; ++q) SL(Ot)[PX(16 * nt + 4 * fq + q, 16 * mt + fr)] = (bf16_t)f2bf(s_[i][q]); } } while (0)
#define NEU_PR(Ti, Yt, To) do { f32x4 p_[2]; \
            _Pragma("unroll") for (int i = 0; i < 2; ++i) { const int tile = F.wave + 8 * i, mt = tile >> 2, nt = tile & 3; \
                p_[i] = tile_mm<true>(SL(Ti) + 16 * mt * 64, SL(Yt) + 16 * nt * 64, fr, fq) + ld4_lds(SL(Ti) + PX(16 * mt + fr, 16 * nt + 4 * fq)); } \
            _Pragma("unroll") for (int i = 0; i < 2; ++i) { const int tile = F.wave + 8 * i, mt = tile >> 2, nt = tile & 3; st4_lds(SL(To) + PX(16 * mt + fr, 16 * nt + 4 * fq), p_[i]); } } while (0)
#define NEU_BOTH(Ti, Yt, To, Xn, Xt, On, Ot, WANT_NAT) do { f32x4 p_[2], s_[2]; \
            _Pragma("unroll") for (int i = 0; i < 2; ++i) { const int tile = F.wave + 8 * i, mt = tile >> 2, nt = tile & 3; \
                p_[i] = tile_mm<true>(SL(Ti) + 16 * mt * 64, SL(Yt) + 16 * nt * 64, fr, fq) + ld4_lds(SL(Ti) + PX(16 * mt + fr, 16 * nt + 4 * fq)); \
                s_[i] = tile_mm<true>(SL(Xn) + 16 * mt * 64, SL(Xt) + 16 * nt * 64, fr, fq); } \
            _Pragma("unroll") for (int i = 0; i < 2; ++i) { const int tile = F.wave + 8 * i, mt = tile >> 2, nt = tile & 3; \
                st4_lds(SL(To) + PX(16 * mt + fr, 16 * nt + 4 * fq), p_[i]); \
                if (WANT_NAT) st4_lds(SL(On) + PX(16 * mt + fr, 16 * nt + 4 * fq), s_[i]); \
                _Pragma("unroll") for (int q = 0; q < 4; ++q) SL(Ot)[PX(16 * nt + 4 * fq + q, 16 * mt + fr)] = (bf16_t)f2bf(s_[i][q]); } } while (0)
        NEU_SQ(8, 9, 10, 12, true);
        LBAR();
        {
            f32x4 p_[2];
#pragma unroll
            for (int i = 0; i < 2; ++i) { const int tile = F.wave + 8 * i, mt = tile >> 2, nt = tile & 3; const int rr = 16 * mt + fr, cc = 16 * nt + 4 * fq;
                p_[i] = tile_mm<true>(SL(8) + 16 * mt * 64, SL(12) + 16 * nt * 64, fr, fq) + ld4_lds(SL(8) + PX(rr, cc)) + ld4_lds(SL(10) + PX(rr, cc));
#pragma unroll
                for (int q = 0; q < 4; ++q) if (cc + q == rr) p_[i][q] += 1.0f; }
            NEU_SQ(10, 12, 5, 13, true);
#pragma unroll
            for (int i = 0; i < 2; ++i) { const int tile = F.wave + 8 * i, mt = tile >> 2, nt = tile & 3; st4_lds(SL(4) + PX(16 * mt + fr, 16 * nt + 4 * fq), p_[i]); }
        }
        LBAR();
        NEU_BOTH(4, 13, 8, 5, 13, 9, 10, true);
        LBAR();
        NEU_BOTH(8, 10, 4, 9, 10, 5, 12, true);
        LBAR();
        NEU_BOTH(4, 12, 8, 5, 12, 5, 13, false);
        LBAR();
        NEU_PR(8, 13, 4);
        LBAR();
#undef NEU_SQ
#undef NEU_PR
#undef NEU_BOTH
        if (PROBE == 3) continue;
        {
            f32x4 p[2], u0[2];
#pragma unroll
            for (int i = 0; i < 2; ++i) { const int tile = F.wave + 8 * i, mt = tile >> 2, nt = tile & 3;
                p[i] = tile_mm<false>(SL(4) + 16 * mt * 64, SL(6) + 16 * nt * 64, fr, fq);
                u0[i] = tile_mm<false>(SL(4) + 16 * mt * 64, SL(2) + 16 * nt * 64, fr, fq); }
#pragma unroll
            for (int i = 0; i < 2; ++i) { const int tile = F.wave + 8 * i, mt = tile >> 2, nt = tile & 3;
                st4_lds(SL(9) + PX(16 * nt + fr, 16 * mt + 4 * fq), p[i]); st4_lds(SL(10) + PX(16 * nt + fr, 16 * mt + 4 * fq), u0[i]); }
        }
        LBAR();
        {
            f32x4 qv[2], y0[2], mp[2], ntv[2];
#pragma unroll
            for (int i = 0; i < 2; ++i) { const int tile = F.wave + 8 * i, mt = tile >> 2, nt = tile & 3; const int rr = 16 * mt + fr, cc = 16 * nt + 4 * fq, ri = 16 * nt + fr, cj = 16 * mt + 4 * fq;
                qv[i] = tile_mm<true>(SL(11) + 16 * mt * 64, SL(9) + 16 * nt * 64, fr, fq) + ld4_lds(SL(1) + PX(rr, cc));
                y0[i] = tile_mm<true>(SL(11) + 16 * mt * 64, SL(10) + 16 * nt * 64, fr, fq) + ld4_lds(SL(3) + PX(rr, cc));
                mp[i] = tile_mm<true>(SL(7) + 16 * mt * 64, SL(9) + 16 * nt * 64, fr, fq);
                ntv[i] = tile_mm<false>(SL(7) + 16 * mt * 64, SL(10) + 16 * nt * 64, fr, fq) + ld4_lds(SL(0) + PX(ri, cj)); }
#pragma unroll
            for (int i = 0; i < 2; ++i) { const int tile = F.wave + 8 * i, mt = tile >> 2, nt = tile & 3; const int rr = 16 * mt + fr, cc = 16 * nt + 4 * fq, ri = 16 * nt + fr, cj = 16 * mt + 4 * fq;
                st4_lds(SL(5) + PX(rr, cc), qv[i]); st4_lds(SL(8) + PX(rr, cc), y0[i]); st4_lds(SL(12) + PX(rr, cc), mp[i]); st4_lds(SL(13) + PX(ri, cj), ntv[i]); }
        }
        LBAR();
        if (PROBE == 0) {
            const int rw = F.tid >> 3, ch = 8 * (F.tid & 7);
            *(u32x4*)(QQ + ((size_t)u * 64 + rw) * 64 + ch) = *(const LAS u32x4*)(SL(5) + PX(rw, ch));
            *(u32x4*)(MP + ((size_t)u * 64 + rw) * 64 + ch) = *(const LAS u32x4*)(SL(12) + PX(rw, ch));
            *(u32x4*)(NTt + ((size_t)u * 64 + rw) * 64 + ch) = *(const LAS u32x4*)(SL(13) + PX(rw, ch));
            *(u32x4*)(YS + (row0 + rw) * 1024 + h * 64 + ch) = *(const LAS u32x4*)(SL(8) + PX(rw, ch));
        }
        LBAR();
    }
#undef PREP_LOAD
#undef SL
}

__device__ __forceinline__ void wkv_chunk_seq(Frame& F, int l) {
    bf16_t* YS = (bf16_t*)(F.ws + WS_Y16); const bf16_t* MP = (const bf16_t*)(F.ws + WS_MP); const bf16_t* QQ = (const bf16_t*)(F.ws + WS_QQ); const bf16_t* NTt = (const bf16_t*)(F.ws + WS_NT); const float* GLB = (const float*)(F.ws + WS_GL);
    LAS bf16_t* Zt = (LAS bf16_t*)F.lds;
    const bf16_t* RKVc = (const bf16_t*)(F.ws + WS_RA); const bf16_t* VFc = (const bf16_t*)(F.ws + WS_P); const bf16_t* G16 = (const bf16_t*)(F.ws + WS_RA + 224 * MiB); const float* BON = (const float*)(F.ws + WS_LF); bf16_t* OG = (bf16_t*)(F.ws + WS_H2);
    LAS bf16_t* Yb = Zt + 2 * SLOT;
    const int fr = F.lane & 15, fq = F.lane >> 4, mt = F.wave >> 1, ntb = 2 * (F.wave & 1);
    struct Ops { bf16x8 m0, m1, q0, q1; f32x4 gl; u32x2 n0, n1, y0, y1; };
    for (int item = F.bid; item < 128; item += F.G) {
        const int bh = item, b = bh >> 4, h = bh & 15; const size_t rowb = (size_t)b * SEQ;
        float gng[8], gnb[8]; ld8f(F.in[I_GNG] + l * 1024 + h * 64 + 8 * (F.tid & 7), gng); ld8f(F.in[I_GNB] + l * 1024 + h * 64 + 8 * (F.tid & 7), gnb);
        for (int i = F.tid; i < 2 * SLOT / 2; i += NTHR) ((LAS unsigned*)Zt)[i] = 0u;
        f32x4 Z0 = (f32x4){0.f, 0.f, 0.f, 0.f}, Z1 = Z0;
        LBAR();
#define SEQ_LOAD(O, cc_) do { const size_t cu = (size_t)bh * 64 + (cc_); \
        const bf16_t* mp = MP + (cu * 64 + 16 * mt + fr) * 64 + 8 * fq; O.m0 = *(const bf16x8*)mp; O.m1 = *(const bf16x8*)(mp + 32); \
        const bf16_t* qp = QQ + (cu * 64 + 16 * mt + fr) * 64 + 8 * fq; O.q0 = *(const bf16x8*)qp; O.q1 = *(const bf16x8*)(qp + 32); \
        O.gl = *(const f32x4*)(GLB + cu * 64 + 16 * mt + 4 * fq); \
        const bf16_t* np_ = NTt + (cu * 64 + 16 * ntb + fr) * 64 + 16 * mt + 4 * fq; O.n0 = *(const u32x2*)np_; O.n1 = *(const u32x2*)(np_ + 16 * 64); \
        const bf16_t* yp = YS + (rowb + 64 * (cc_) + 16 * mt + fr) * 1024 + h * 64 + 16 * ntb + 4 * fq; O.y0 = *(const u32x2*)yp; O.y1 = *(const u32x2*)(yp + 16); } while (0)
#define SEQ_STEP(O, cc_) do { const LAS bf16_t* Zc = Zt + ((cc_) & 1) * SLOT; LAS bf16_t* Zn = Zt + (((cc_) + 1) & 1) * SLOT; \
        const LAS bf16_t* z0p = Zc + (16 * ntb + fr) * CP + 8 * fq; const LAS bf16_t* z1p = z0p + 16 * CP; \
        const bf16x8 b00 = *(const LAS bf16x8*)z0p, b01 = *(const LAS bf16x8*)(z0p + 32), b10 = *(const LAS bf16x8*)z1p, b11 = *(const LAS bf16x8*)(z1p + 32); \
        f32x4 a0 = (f32x4){0.f, 0.f, 0.f, 0.f}, a1 = a0, c0 = a0, c1 = a0; \
        a0 = __builtin_amdgcn_mfma_f32_16x16x32_bf16(O.m0, b00, a0, 0, 0, 0); a0 = __builtin_amdgcn_mfma_f32_16x16x32_bf16(O.m1, b01, a0, 0, 0, 0); \
        a1 = __builtin_amdgcn_mfma_f32_16x16x32_bf16(O.m0, b10, a1, 0, 0, 0); a1 = __builtin_amdgcn_mfma_f32_16x16x32_bf16(O.m1, b11, a1, 0, 0, 0); \
        c0 = __builtin_amdgcn_mfma_f32_16x16x32_bf16(b00, O.q0, c0, 0, 0, 0); c0 = __builtin_amdgcn_mfma_f32_16x16x32_bf16(b01, O.q1, c0, 0, 0, 0); \
        c1 = __builtin_amdgcn_mfma_f32_16x16x32_bf16(b10, O.q0, c1, 0, 0, 0); c1 = __builtin_amdgcn_mfma_f32_16x16x32_bf16(b11, O.q1, c1, 0, 0, 0); \
        Z0 = O.gl * Z0 + a0 + (f32x4){lo16(O.n0.x), hi16(O.n0.x), lo16(O.n0.y), hi16(O.n0.y)}; Z1 = O.gl * Z1 + a1 + (f32x4){lo16(O.n1.x), hi16(O.n1.x), lo16(O.n1.y), hi16(O.n1.y)}; \
        { LAS bf16_t* yl = Yb + (((cc_) & 7) * 64 + 16 * mt + fr) * CP + 16 * ntb + 4 * fq; \
          st4_lds(yl, c0 + (f32x4){lo16(O.y0.x), hi16(O.y0.x), lo16(O.y0.y), hi16(O.y0.y)}); st4_lds(yl + 16, c1 + (f32x4){lo16(O.y1.x), hi16(O.y1.x), lo16(O.y1.y), hi16(O.y1.y)}); } \
        st4_lds(Zn + (16 * ntb + fr) * CP + 16 * mt + 4 * fq, Z0); st4_lds(Zn + (16 * ntb + 16 + fr) * CP + 16 * mt + 4 * fq, Z1); \
        LBAR(); \
        if (((cc_) & 7) == 7) { _Pragma("unroll 2") for (int i_ = 0; i_ < 8; ++i_) { const int o_ = F.tid + NTHR * i_, ck_ = o_ >> 9, rw_ = (o_ >> 3) & 63, ch_ = 8 * (o_ & 7); \
            const size_t tr_ = rowb + 64 * ((cc_) - 7 + ck_) + rw_; float y_[8], v_[8], g_[8]; \
            unpk8(*(const LAS u32x4*)(Yb + (ck_ * 64 + rw_) * CP + ch_), y_); unpk8((l == 0) ? *(const u32x4*)(VFc + tr_ * 1024 + h * 64 + ch_) : *(const u32x4*)(RKVc + tr_ * 3072 + 2048 + h * 64 + ch_), v_); unpk8(*(const u32x4*)(G16 + tr_ * 1024 + h * 64 + ch_), g_); \
            const float bs_ = BON[tr_ * 16 + h]; float s_ = 0.f; _Pragma("unroll") for (int q_ = 0; q_ < 8; ++q_) s_ += y_[q_]; s_ = octsum(s_); const float mean_ = s_ * (1.0f / 64.0f); \
            float qq_ = 0.f; _Pragma("unroll") for (int q_ = 0; q_ < 8; ++q_) { const float d_ = y_[q_] - mean_; qq_ += d_ * d_; } qq_ = octsum(qq_); const float rstd_ = 1.0f / sqrtf(qq_ * (1.0f / 64.0f) + GN_EPS); \
            float o8_[8]; _Pragma("unroll") for (int q_ = 0; q_ < 8; ++q_) o8_[q_] = (((y_[q_] - mean_) * rstd_) * gng[q_] + gnb[q_] + bs_ * v_[q_]) * g_[q_]; \
            u32x4 w_; w_.x = pk2(o8_[0], o8_[1]); w_.y = pk2(o8_[2], o8_[3]); w_.z = pk2(o8_[4], o8_[5]); w_.w = pk2(o8_[6], o8_[7]); *(u32x4*)(OG + tr_ * 1024 + h * 64 + ch_) = w_; } LBAR(); } } while (0)
        Ops A, B, C;
        SEQ_LOAD(A, 0); SEQ_LOAD(B, 1);
#pragma unroll 1
        for (int c = 0; c < 63; c += 3) {
            SEQ_LOAD(C, c + 2); SEQ_STEP(A, c);
            SEQ_LOAD(A, c + 3); SEQ_STEP(B, c + 1);
            if (c + 4 < 64) SEQ_LOAD(B, c + 4);
            SEQ_STEP(C, c + 2);
        }
        SEQ_STEP(A, 63);
#undef SEQ_LOAD
#undef SEQ_STEP
    }
}

__device__ __forceinline__ void ld16(const bf16_t* p, float (&o)[16]) {
    const u32x4 a = *(const u32x4*)p, b = *(const u32x4*)(p + 8);
    o[0] = lo16(a.x); o[1] = hi16(a.x); o[2] = lo16(a.y); o[3] = hi16(a.y); o[4] = lo16(a.z); o[5] = hi16(a.z); o[6] = lo16(a.w); o[7] = hi16(a.w);
    o[8] = lo16(b.x); o[9] = hi16(b.x); o[10] = lo16(b.y); o[11] = hi16(b.y); o[12] = lo16(b.z); o[13] = hi16(b.z); o[14] = lo16(b.w); o[15] = hi16(b.w);
}
__device__ __forceinline__ void st16(bf16_t* p, const float (&o)[16]) {
    u32x4 a, b; a.x = pk2(o[0], o[1]); a.y = pk2(o[2], o[3]); a.z = pk2(o[4], o[5]); a.w = pk2(o[6], o[7]); b.x = pk2(o[8], o[9]); b.y = pk2(o[10], o[11]); b.z = pk2(o[12], o[13]); b.w = pk2(o[14], o[15]);
    *(u32x4*)p = a; *(u32x4*)(p + 8) = b;
}
__device__ __forceinline__ void ld16f(const float* p, float (&o)[16]) {
#pragma unroll
    for (int j = 0; j < 4; ++j) { const f32x4 v = *(const f32x4*)(p + 4 * j); o[4 * j] = v[0]; o[4 * j + 1] = v[1]; o[4 * j + 2] = v[2]; o[4 * j + 3] = v[3]; }
}
__device__ __forceinline__ void wkv_post(Frame& F, int l) {
    const InTab in = F.in;
    const bf16_t* RKV = (const bf16_t*)(F.ws + WS_RA); const bf16_t* G16 = (const bf16_t*)(F.ws + WS_RA + 224 * MiB); const float* BON = (const float*)(F.ws + WS_LF);
    const bf16_t* YS = (const bf16_t*)(F.ws + WS_Y16); bf16_t* OG = (bf16_t*)(F.ws + WS_H2);
    const int c0 = 16 * F.lane;
    float gg[16], gb[16];
    ld16f(in[I_GNG] + l * 1024 + c0, gg); ld16f(in[I_GNB] + l * 1024 + c0, gb);
    const int gw = F.bid * NWAVES + F.wave, NGW = F.G * NWAVES;
    for (int t = gw; t < T; t += NGW) {
        float y[16], v[16], g[16];
        ld16(YS + (size_t)t * 1024 + c0, y); ld16(RKV + (size_t)t * 3072 + 2048 + c0, v); ld16(G16 + (size_t)t * 1024 + c0, g);
        const float bs = BON[(size_t)t * 16 + (F.lane >> 2)];
        float s = 0.f;
#pragma unroll
        for (int i = 0; i < 16; ++i) s += y[i];
        s = quadsum(s);
        const float mean = s * (1.0f / 64.0f); float q = 0.f;
#pragma unroll
        for (int i = 0; i < 16; ++i) { const float d = y[i] - mean; q += d * d; }
        q = quadsum(q);
        const float rstd = 1.0f / sqrtf(q * (1.0f / 64.0f) + GN_EPS);
        float o[16];
#pragma unroll
        for (int i = 0; i < 16; ++i) o[i] = (((y[i] - mean) * rstd) * gg[i] + gb[i] + bs * v[i]) * g[i];
        st16(OG + (size_t)t * 1024 + c0, o);
    }
}

__device__ __forceinline__ void kv_post(Frame& F) {
    const InTab in = F.in;
    bf16_t* Kb = (bf16_t*)(F.ws + WS_P); const float* LF = (const float*)(F.ws + WS_LF); float* KBv = (float*)(F.ws + WS_KB);
    const int c0 = 16 * F.lane;
    float kn[16]; ld16f(in[I_KNORM] + (c0 & 63), kn);
    const int gw = F.bid * NWAVES + F.wave, NGW = F.G * NWAVES;
    for (int t = gw; t < T; t += NGW) {
        float k[16]; ld16(Kb + (size_t)t * 1024 + c0, k);
        float s = 0.f;
#pragma unroll
        for (int i = 0; i < 16; ++i) s += k[i] * k[i];
        s = quadsum(s);
        const float rs = 1.0f / sqrtf(s * (1.0f / 64.0f) + QK_EPS);
#pragma unroll
        for (int i = 0; i < 16; ++i) k[i] = k[i] * rs * kn[i];
        st16(Kb + (size_t)t * 1024 + c0, k);
    }
    for (int bh = gw; bh < 128; bh += NGW) {
        const int b = bh >> 4, h = bh & 15; const size_t base = ((size_t)b * SEQ + 64 * F.lane) * 16 + h;
        float s = 0.f;
        for (int i = 0; i < 64; ++i) s += LF[base + (size_t)i * 16];
        float incl = s;
#pragma unroll
        for (int o = 1; o < 64; o <<= 1) { const float n = __shfl_up(incl, o); if (F.lane >= o) incl += n; }
        float run = incl - s;
        float kfirst = 0.f, klast = 0.f;
        for (int i = 0; i < 64; ++i) { run += LF[base + (size_t)i * 16]; const float kbv = -run * LOG2E; KBv[(size_t)bh * SEQ + 64 * F.lane + i] = kbv; if (i == 0) kfirst = kbv; klast = kbv; }
        int* T0 = (int*)(F.ws + WS_T0) + bh * 16;
        for (int qb = 0; qb < 16; ++qb) {
            const float thr = __shfl(kfirst, 4 * qb) - 70.0f;
            const unsigned long long skip = __ballot(klast < thr);
            int t0 = (skip == ~0ull) ? 64 : __builtin_ctzll(~skip); const int nt = 4 * qb + 4;
            t0 &= ~1; if (t0 > nt - 4) t0 = nt - 4;
            if (F.lane == 0) T0[qb] = t0;
        }
    }
}

namespace attn_body {
using bf16=__hip_bfloat16;
using bf16x8=__attribute__((ext_vector_type(8)))short;
using s16x4=__attribute__((ext_vector_type(4)))short;
using f32x16=__attribute__((ext_vector_type(16)))float;
using u32x4=__attribute__((ext_vector_type(4)))unsigned;
constexpr int BATCH=8,NHEAD=16,SEQ=4096,D=64,DM=NHEAD*D;
constexpr int NW=8,QBLK=32,QB=QBLK*NW,KVBLK=64,NQB=SEQ/QB;
constexpr int ATTN_PITCH=DM, ATTN_UNIT_ROWS=QB;
__device__ __forceinline__ int crow(int r,int hi){return (r&3)+8*(r>>2)+4*hi;}
#define SBAR() __builtin_amdgcn_sched_barrier(0)
__device__ __forceinline__ void cmask(f32x16&p0,f32x16&p1,int jb,int qrel,int hi){
  const float NEG=-INFINITY; int kb=64*jb+4*hi;
  #pragma unroll
  for(int r=0;r<16;++r){int kv=kb+(r&3)+8*(r>>2); if(kv>qrel)p0[r]=NEG; if(kv+32>qrel)p1[r]=NEG;}
}

constexpr int NSLOT=3, SLOTB=8192;
constexpr int LDS_K=0, LDS_V=NSLOT*SLOTB, LDS_WS=2*NSLOT*SLOTB, LDS_OST=LDS_WS+NW*64*4, LDS_KBIAS=LDS_OST+NW*4096, LDS_BYTES=LDS_KBIAS+SEQ*4;
constexpr float C2=0.125f*1.4426950408889634f;
__device__ __forceinline__ void glds16(const void*gsrc,unsigned lds_dst){unsigned keep;
  asm volatile("s_mov_b32 %0, m0\n\ts_mov_b32 m0, %2\n\ts_nop 0\n\tglobal_load_lds_dwordx4 %1, off\n\ts_mov_b32 m0, %0":"=&s"(keep):"v"(gsrc),"s"(lds_dst):"memory");}
__device__ __forceinline__ float max3f(float a,float b,float c){float r;asm("v_max3_f32 %0, %1, %2, %3":"=v"(r):"v"(a),"v"(b),"v"(c));return r;}
__device__ __forceinline__ float max2f(float a,float b){float r;asm("v_max_f32_e32 %0, %1, %2":"=v"(r):"v"(a),"v"(b));return r;}
__device__ __forceinline__ float fadd_s(float a,float b){float r;asm("v_add_f32_e32 %0, %1, %2":"=v"(r):"v"(a),"v"(b));return r;}
__device__ __forceinline__ float fsub_s(float a,float b){float r;asm("v_sub_f32_e32 %0, %1, %2":"=v"(r):"v"(a),"v"(b));return r;}
typedef float f32x2_t __attribute__((ext_vector_type(2))); typedef __bf16 bf16x2_t __attribute__((ext_vector_type(2)));
__device__ __forceinline__ unsigned cvtpk_s(float lo,float hi){f32x2_t v={lo,hi};bf16x2_t b=__builtin_convertvector(v,bf16x2_t);return __builtin_bit_cast(unsigned,b);}
#define WAIT_BAR(N) asm volatile("s_waitcnt vmcnt(" #N ") lgkmcnt(0)\n\ts_barrier":::"memory")

__device__ __forceinline__ void qkt(f32x16&p0,f32x16&p1,const char*Kslot,const bf16x8*qr,const f32x16&negm,int r32,int hi){
  const char*kb=Kslot+hi*1024+r32*16;
  #pragma unroll
  for(int d0=0;d0<4;++d0){
    const bf16x8 b0=*reinterpret_cast<const bf16x8*>(kb+d0*2048);
    const bf16x8 b1=*reinterpret_cast<const bf16x8*>(kb+d0*2048+512);
    if(d0==0){p0=__builtin_amdgcn_mfma_f32_32x32x16_bf16(b0,qr[0],negm,0,0,0);p1=__builtin_amdgcn_mfma_f32_32x32x16_bf16(b1,qr[0],negm,0,0,0);}
    else{p0=__builtin_amdgcn_mfma_f32_32x32x16_bf16(b0,qr[d0],p0,0,0,0);p1=__builtin_amdgcn_mfma_f32_32x32x16_bf16(b1,qr[d0],p1,0,0,0);}}
}
typedef __attribute__((address_space(3))) const char* lds_cptr;
typedef short v4i16_t __attribute__((ext_vector_type(4)));
__device__ __forceinline__ void kload8(bf16x8*kf,lds_cptr kp){
  kf[0]=*(const __attribute__((address_space(3))) bf16x8*)(kp);      kf[1]=*(const __attribute__((address_space(3))) bf16x8*)(kp+512);
  kf[2]=*(const __attribute__((address_space(3))) bf16x8*)(kp+2048); kf[3]=*(const __attribute__((address_space(3))) bf16x8*)(kp+2560);
  kf[4]=*(const __attribute__((address_space(3))) bf16x8*)(kp+4096); kf[5]=*(const __attribute__((address_space(3))) bf16x8*)(kp+4608);
  kf[6]=*(const __attribute__((address_space(3))) bf16x8*)(kp+6144); kf[7]=*(const __attribute__((address_space(3))) bf16x8*)(kp+6656);
}
__device__ __forceinline__ void kload2(bf16x8*kf,lds_cptr kp,int j){ kf[2*j]=*(const __attribute__((address_space(3))) bf16x8*)(kp+j*2048); kf[2*j+1]=*(const __attribute__((address_space(3))) bf16x8*)(kp+j*2048+512); }
__device__ __forceinline__ s16x4 vtr(lds_cptr p){ return __builtin_bit_cast(s16x4,__builtin_amdgcn_ds_read_tr16_b64_v4i16((__attribute__((address_space(3))) v4i16_t*)p)); }
__device__ __forceinline__ float rowmax(const f32x16&p0,const f32x16&p1){
  float a=max3f(p0[0],p0[1],p1[0]),b=max3f(p0[2],p0[3],p1[1]);a=max3f(a,p1[2],p1[3]);
  #pragma unroll
  for(int r=4;r<16;r+=4){a=max3f(a,p0[r],p0[r+1]);b=max3f(b,p0[r+2],p0[r+3]);a=max3f(a,p1[r],p1[r+1]);b=max3f(b,p1[r+2],p1[r+3]);}
  const float m=max2f(a,b);
  auto rr=__builtin_amdgcn_permlane32_swap(__float_as_uint(m),__float_as_uint(m),false,false);
  return max2f(__uint_as_float(rr[0]),__uint_as_float(rr[1]));
}
__device__ __forceinline__ void pv(f32x16*o,int vb,bf16x8 pa0,bf16x8 pa1,bf16x8 pa2,bf16x8 pa3){
  #pragma unroll
  for(int d0=0;d0<2;++d0){s16x4 lo[4],hi[4];
    #pragma unroll
    for(int ks=0;ks<4;++ks){
      asm volatile("ds_read_b64_tr_b16 %0,%1 offset:%c2":"=&v"(lo[ks]):"v"(vb),"i"(d0*4096+ks*1024):"memory");
      asm volatile("ds_read_b64_tr_b16 %0,%1 offset:%c2":"=&v"(hi[ks]):"v"(vb),"i"(d0*4096+ks*1024+512):"memory");}
    asm volatile("s_waitcnt lgkmcnt(0)":::"memory");SBAR();
    #define PK(k) (bf16x8){lo[k][0],lo[k][1],lo[k][2],lo[k][3],hi[k][0],hi[k][1],hi[k][2],hi[k][3]}
    o[d0]=__builtin_amdgcn_mfma_f32_32x32x16_bf16(pa0,PK(0),o[d0],0,0,0);
    o[d0]=__builtin_amdgcn_mfma_f32_32x32x16_bf16(pa1,PK(1),o[d0],0,0,0);
    o[d0]=__builtin_amdgcn_mfma_f32_32x32x16_bf16(pa2,PK(2),o[d0],0,0,0);
    o[d0]=__builtin_amdgcn_mfma_f32_32x32x16_bf16(pa3,PK(3),o[d0],0,0,0);
    #undef PK
  }
}

#ifndef ATTN_STORE16
#define ATTN_STORE16(p,v) (*(u32x4*)(p)=(v))
#endif
template<int THRL> __device__ __forceinline__ void attn_unit(int tid,int wid,int b,int h,int qb,int t0,const bf16*Q,const bf16*__restrict__ K,const bf16*__restrict__ V,bf16*O,const bf16*G,const float*kbrow,const float*qnorm,char*shm){
  int lane=tid&63; asm volatile("":"+v"(lane));
  const int r32=lane&31,hi=lane>>5; wid=__builtin_amdgcn_readfirstlane(wid);
  const long rowbase=(long)b*SEQ; const int q0=qb*QB;
  const bf16*Qw=Q+(rowbase+q0+wid*QBLK)*DM+h*D;
  const bf16*Kh=K+(rowbase+(long)t0*KVBLK)*DM+h*D,*Vh=V+(rowbase+(long)t0*KVBLK)*DM+h*D; kbrow+=t0*KVBLK;
  const unsigned lds0=(unsigned)(uintptr_t)shm;
  float*wsf=(float*)(shm+LDS_WS)+wid*64;
  const bf16*ksrc=Kh+(long)lane*DM+wid*8;
  const bf16*vsrc=Vh+(long)(16*(wid&3)+(lane>>2))*DM+(wid>>2)*32+(lane&3)*8;
  const unsigned kdst=lds0+LDS_K+wid*1024, vdst=lds0+LDS_V+wid*1024;
  #define DMA_K(t,slot) glds16(ksrc+(long)(t)*KVBLK*DM,(unsigned)__builtin_amdgcn_readfirstlane(kdst+(slot)))
  #define DMA_V(t,slot) glds16(vsrc+(long)(t)*KVBLK*DM,(unsigned)__builtin_amdgcn_readfirstlane(vdst+(slot)))
  const int vb0=(int)(lds0+LDS_V)+((lane>>4)&1)*32+(lane&3)*8+(4*hi+((lane&15)>>2))*64;
  const char*Kbase=shm+LDS_K; bf16x8 kf[8];
  const lds_cptr shm3=(lds_cptr)shm; const lds_cptr kp0=shm3+LDS_K+hi*1024+r32*16; const lds_cptr vp0=shm3+LDS_V+((lane>>4)&1)*32+(lane&3)*8+(4*hi+((lane&15)>>2))*64;
  const int NT=(q0+QB)/KVBLK-t0;
  typedef float f32x4_t __attribute__((ext_vector_type(4))); typedef __attribute__((address_space(3))) const float* lds_fptr;
  const lds_fptr kbl=(lds_fptr)(shm3+LDS_KBIAS);
  { __attribute__((address_space(3))) f32x4_t* kw=(__attribute__((address_space(3))) f32x4_t*)(shm3+LDS_KBIAS); const f32x4_t* kg=(const f32x4_t*)kbrow;
    for(int i=tid;i<NT*KVBLK/4;i+=NW*64) kw[i]=kg[i]; }
  DMA_K(0,0);DMA_V(0,0);DMA_K(1,SLOTB);
  bf16x8 qr[4];
  #pragma unroll
  for(int d0=0;d0<4;++d0)qr[d0]=*reinterpret_cast<const bf16x8*>(&Qw[(long)r32*DM+d0*16+hi*8]);
  { float qf[4][8]; float ss=0.f;
    #pragma unroll
    for(int d0=0;d0<4;++d0){
      #pragma unroll
      for(int j=0;j<8;++j){ qf[d0][j]=__uint_as_float(((unsigned)(unsigned short)qr[d0][j])<<16); ss+=qf[d0][j]*qf[d0][j]; } }
    { auto rr=__builtin_amdgcn_permlane32_swap(__float_as_uint(ss),__float_as_uint(ss),false,false); ss=__uint_as_float(rr[0])+__uint_as_float(rr[1]); }
    const float qs=C2/sqrtf(ss*(1.0f/64.0f)+1e-6f);
    #pragma unroll
    for(int d0=0;d0<4;++d0){ const float*qn=qnorm+d0*16+hi*8; u32x4 w;
      w[0]=cvtpk_s(qf[d0][0]*qs*qn[0],qf[d0][1]*qs*qn[1]); w[1]=cvtpk_s(qf[d0][2]*qs*qn[2],qf[d0][3]*qs*qn[3]); w[2]=cvtpk_s(qf[d0][4]*qs*qn[4],qf[d0][5]*qs*qn[5]); w[3]=cvtpk_s(qf[d0][6]*qs*qn[6],qf[d0][7]*qs*qn[7]);
      qr[d0]=__builtin_bit_cast(bf16x8,w); } }
  float mhat=0.f,l_reg=0.f;f32x16 o[2];o[0]=f32x16{};o[1]=f32x16{};const f32x16 negm=f32x16{};
  const int qrel=wid*QBLK+r32;
  #define CMASK(P0,P1,t) do{int jb_=(t)-(NT-4); if(jb_>=0)cmask(P0,P1,jb_,qrel,hi);}while(0)
  #define KBIAS(P0,P1,t) do{ const lds_fptr kp_=kbl+64*(t)+4*hi; \
    _Pragma("unroll") for(int g_=0;g_<4;++g_){ const f32x4_t a_=*(const __attribute__((address_space(3))) f32x4_t*)(kp_+8*g_)-mhat, b_=*(const __attribute__((address_space(3))) f32x4_t*)(kp_+32+8*g_)-mhat; \
      _Pragma("unroll") for(int j_=0;j_<4;++j_){ P0[4*g_+j_]+=a_[j_]; P1[4*g_+j_]+=b_[j_]; } } }while(0)
  bool resc=false;
  #define START(P0,P1) do{ const float rm=rowmax(P0,P1); resc=false; \
    { const float dl=rm; mhat=fadd_s(mhat,dl); \
      _Pragma("unroll") for(int r=0;r<16;++r){P0[r]=fsub_s(P0[r],dl);P1[r]=fsub_s(P1[r],dl);} } \
    _Pragma("unroll") for(int r=0;r<16;++r)P0[r]=__builtin_amdgcn_exp2f(P0[r]); }while(0)
  #define RESC() do{ if(resc){ asm volatile("s_waitcnt lgkmcnt(0)":::"memory"); \
      _Pragma("unroll") for(int d_=0;d_<2;++d_) _Pragma("unroll") for(int r=0;r<16;++r)o[d_][r]*=wsf[crow(r,hi)]; } }while(0)
  f32x16 pA0,pA1,pB0,pB1;
  int sl_prev=0,sl_cur=0,sl_next=SLOTB;
  #define ROT() do{sl_prev=sl_cur;sl_cur=sl_next;sl_next=(sl_next==(NSLOT-1)*SLOTB)?0:sl_next+SLOTB;}while(0)
  DMA_K(2,2*SLOTB);
  WAIT_BAR(3);
  qkt(pA0,pA1,Kbase,qr,negm,r32,hi);asm volatile("s_nop 15\n\ts_nop 7":"+v"(pA0),"+v"(pA1));KBIAS(pA0,pA1,0);CMASK(pA0,pA1,0);
  START(pA0,pA1);
  _Pragma("unroll") for(int r=0;r<16;++r)pA1[r]=__builtin_amdgcn_exp2f(pA1[r]);
  WAIT_BAR(0);
  DMA_K(3,0);DMA_V(1,SLOTB);
  ROT();
  kload8(kf,kp0+sl_cur);
  WAIT_BAR(2);
  s16x4 vlo[8],vhi[8]; u32x4 pw0,pw1,pw2,pw3;
  #define PKW(P,B) cvtpk_s(P[B],P[B+1])
  #define PAF(k) __builtin_bit_cast(bf16x8,pw##k)
  #define VFR(i) (bf16x8){vlo[i][0],vlo[i][1],vlo[i][2],vlo[i][3],vhi[i][0],vhi[i][1],vhi[i][2],vhi[i][3]}
  #define PIN(x) asm volatile("":"+v"(x))
  #define MX3(a,b,c) __builtin_fmaxf(__builtin_fmaxf((a),(b)),(c))
  #define GAPA(MF,A0,A1,A2,A3,W0,W1,PW) do{ MF; sacc+=A0; sacc+=A1; sacc+=A2; sacc+=A3; PIN(sacc); W0; W1; PIN(PW); SBAR(); }while(0)
  #define EX(v) __builtin_amdgcn_exp2f(v)
  #define GAPB(MF,X,B) do{ MF; X[B]=EX(X[B]); X[B+1]=EX(X[B+1]); X[B+2]=EX(X[B+2]); X[B+3]=EX(X[B+3]); PIN(X); SBAR(); }while(0)
  #define VRD(i) do{ vlo[i]=vtr(vp_+(((i)>>2)*4096+((i)&3)*1024)); vhi[i]=vtr(vp_+(((i)>>2)*4096+((i)&3)*1024+512)); }while(0)
  #define KRD(G,j) do{ if(G){ kload2(kf,kp0+sl_next,j); SBAR(); } }while(0)
  #define STEP(C0,C1,P0,P1,t,GK,GV,GL) do{ SBAR(); \
    const lds_cptr vp_=vp0+sl_prev; \
    VRD(0); SBAR(); float sacc=(P0[0]+P0[1]); \
    GAPA(C0=__builtin_amdgcn_mfma_f32_32x32x16_bf16(kf[0],qr[0],negm,0,0,0), P0[2],P0[3],P0[4],P0[5],     pw0[0]=PKW(P0,0), pw0[1]=PKW(P0,2), pw0); \
    VRD(4); SBAR(); GAPA(C1=__builtin_amdgcn_mfma_f32_32x32x16_bf16(kf[1],qr[0],negm,0,0,0), P0[6],P0[7],P0[8],P0[9],     pw0[2]=PKW(P0,4), pw0[3]=PKW(P0,6), pw0); \
    VRD(1); SBAR(); GAPA(C0=__builtin_amdgcn_mfma_f32_32x32x16_bf16(kf[2],qr[1],C0,0,0,0),   P0[10],P0[11],P0[12],P0[13], pw1[0]=PKW(P0,8), pw1[1]=PKW(P0,10), pw1); \
    VRD(5); SBAR(); GAPA(C1=__builtin_amdgcn_mfma_f32_32x32x16_bf16(kf[3],qr[1],C1,0,0,0),   P0[14],P0[15],P1[0],P1[1],   pw1[2]=PKW(P0,12),pw1[3]=PKW(P0,14), pw1); \
    VRD(2); SBAR(); GAPA(C0=__builtin_amdgcn_mfma_f32_32x32x16_bf16(kf[4],qr[2],C0,0,0,0),   P1[2],P1[3],P1[4],P1[5],     pw2[0]=PKW(P1,0), pw2[1]=PKW(P1,2), pw2); \
    VRD(6); SBAR(); GAPA(C1=__builtin_amdgcn_mfma_f32_32x32x16_bf16(kf[5],qr[2],C1,0,0,0),   P1[6],P1[7],P1[8],P1[9],     pw2[2]=PKW(P1,4), pw2[3]=PKW(P1,6), pw2); \
    VRD(3); SBAR(); GAPA(C0=__builtin_amdgcn_mfma_f32_32x32x16_bf16(kf[6],qr[3],C0,0,0,0),   P1[10],P1[11],P1[12],P1[13], pw3[0]=PKW(P1,8), pw3[1]=PKW(P1,10), pw3); \
    VRD(7); SBAR(); GAPA(C1=__builtin_amdgcn_mfma_f32_32x32x16_bf16(kf[7],qr[3],C1,0,0,0),   P1[14],P1[15],0.f,0.f,       pw3[2]=PKW(P1,12),pw3[3]=PKW(P1,14), pw3); \
    l_reg+=sacc; \
    if(GK){DMA_K((t)+3,sl_cur);} if(GV){DMA_V((t)+1,sl_next);} \
    KBIAS(C0,C1,t); CMASK(C0,C1,t); \
    { float a=MX3(C0[0],C0[1],C1[0]),b=MX3(C0[2],C0[3],C1[1]); a=MX3(a,C1[2],C1[3]); \
      _Pragma("unroll") for(int r=4;r<16;r+=4){a=MX3(a,C0[r],C0[r+1]);b=MX3(b,C0[r+2],C0[r+3]);a=MX3(a,C1[r],C1[r+1]);b=MX3(b,C1[r+2],C1[r+3]);} \
      float rm=__builtin_fmaxf(a,b); { auto rr=__builtin_amdgcn_permlane32_swap(__float_as_uint(rm),__float_as_uint(rm),false,false); rm=__builtin_fmaxf(__uint_as_float(rr[0]),__uint_as_float(rr[1])); } \
      resc=false; \
      if(__builtin_expect(__any(rm>(float)THRL),0)){ const float dl=__builtin_fmaxf(rm,0.f); mhat+=dl; \
        _Pragma("unroll") for(int r=0;r<16;++r){C0[r]-=dl;C1[r]-=dl;} \
        const float f=__builtin_amdgcn_exp2f(-dl); l_reg*=f; if(hi==0)wsf[r32]=f; resc=true; } } \
    SBAR(); \
    GAPB(o[0]=__builtin_amdgcn_mfma_f32_32x32x16_bf16(PAF(0),VFR(0),o[0],0,0,0), C0,0); \
    GAPB(o[1]=__builtin_amdgcn_mfma_f32_32x32x16_bf16(PAF(0),VFR(4),o[1],0,0,0), C0,4); \
    KRD(GL,0); GAPB(o[0]=__builtin_amdgcn_mfma_f32_32x32x16_bf16(PAF(1),VFR(1),o[0],0,0,0), C0,8); \
    KRD(GL,1); GAPB(o[1]=__builtin_amdgcn_mfma_f32_32x32x16_bf16(PAF(1),VFR(5),o[1],0,0,0), C0,12); \
    KRD(GL,2); GAPB(o[0]=__builtin_amdgcn_mfma_f32_32x32x16_bf16(PAF(2),VFR(2),o[0],0,0,0), C1,0); \
    KRD(GL,3); GAPB(o[1]=__builtin_amdgcn_mfma_f32_32x32x16_bf16(PAF(2),VFR(6),o[1],0,0,0), C1,4); \
    GAPB(o[0]=__builtin_amdgcn_mfma_f32_32x32x16_bf16(PAF(3),VFR(3),o[0],0,0,0), C1,8); \
    GAPB(o[1]=__builtin_amdgcn_mfma_f32_32x32x16_bf16(PAF(3),VFR(7),o[1],0,0,0), C1,12); \
    }while(0)
  int t=1;
  #undef CMASK
  #define CMASK(P0,P1,t) do{}while(0)
  for(;t+5<NT;t+=2){
    STEP(pB0,pB1,pA0,pA1,t,true,true,true);     WAIT_BAR(2); RESC(); ROT();
    STEP(pA0,pA1,pB0,pB1,t+1,true,true,true);   WAIT_BAR(2); RESC(); ROT();
  }
  #undef CMASK
  #define CMASK(P0,P1,t) do{int jb_=(t)-(NT-4); if(jb_>=0)cmask(P0,P1,jb_,qrel,hi);}while(0)
  #define ENDW(tt) do{ if((tt)+3<NT){WAIT_BAR(2);} else if((tt)+2<NT){WAIT_BAR(1);} else {WAIT_BAR(0);} }while(0)
  for(;t+1<NT;t+=2){
    STEP(pB0,pB1,pA0,pA1,t,(t+3<NT),(t+1<NT),(t+1<NT));       ENDW(t);   RESC(); ROT();
    STEP(pA0,pA1,pB0,pB1,t+1,(t+4<NT),(t+2<NT),(t+2<NT));     ENDW(t+1); RESC(); ROT();
  }
  STEP(pB0,pB1,pA0,pA1,NT-1,false,false,false); RESC();
  { float sacc=pB0[0]+pB0[1]; _Pragma("unroll") for(int r=2;r<16;++r)sacc+=pB0[r]; _Pragma("unroll") for(int r=0;r<16;++r)sacc+=pB1[r]; l_reg+=sacc;
    pw0=(u32x4){PKW(pB0,0),PKW(pB0,2),PKW(pB0,4),PKW(pB0,6)};pw1=(u32x4){PKW(pB0,8),PKW(pB0,10),PKW(pB0,12),PKW(pB0,14)};pw2=(u32x4){PKW(pB1,0),PKW(pB1,2),PKW(pB1,4),PKW(pB1,6)};pw3=(u32x4){PKW(pB1,8),PKW(pB1,10),PKW(pB1,12),PKW(pB1,14)};
    SBAR(); pv(o,vb0+sl_cur,PAF(0),PAF(1),PAF(2),PAF(3)); }
  #undef PKW
  #undef PAF
  #undef VFR
  #undef PIN
  #undef MX3
  #undef GAPA
  #undef GAPB
  #undef EX
  #undef VRD
  #undef KRD
  #undef STEP
  #undef ENDW
  {auto rr=__builtin_amdgcn_permlane32_swap(__float_as_uint(l_reg),__float_as_uint(l_reg),false,false);l_reg=__uint_as_float(rr[0])+__uint_as_float(rr[1]);}
  if(hi==0)wsf[32+r32]=l_reg;asm volatile("s_waitcnt lgkmcnt(0)":::"memory");
  float rli[16];
  #pragma unroll
  for(int r=0;r<16;++r)rli[r]=__builtin_amdgcn_rcpf(wsf[32+crow(r,hi)]);
  bf16*Ow=O+(rowbase+q0+wid*QBLK)*DM+h*D;
  { bf16*stg=(bf16*)(shm+LDS_OST)+wid*2048;
    #pragma unroll
    for(int r=0;r<16;++r){const int orow=crow(r,hi);
      #pragma unroll
      for(int d0=0;d0<2;++d0)stg[orow*64+d0*32+r32]=__float2bfloat16(o[d0][r]*rli[r]);}
    asm volatile("s_waitcnt lgkmcnt(0)":::"memory");
    const bf16*Gw=G+(rowbase+q0+wid*QBLK)*DM+h*D;
    #pragma unroll
    for(int i=0;i<4;++i){const int row=i*8+(lane>>3),ch=lane&7; u32x4 v=*(const u32x4*)(stg+row*64+ch*8); const u32x4 g=*(const u32x4*)(Gw+(long)row*DM+ch*8);
      #pragma unroll
      for(int q=0;q<4;++q) v[q]=cvtpk_s(__uint_as_float(v[q]<<16)*__uint_as_float(g[q]<<16),__uint_as_float(v[q]&0xffff0000u)*__uint_as_float(g[q]&0xffff0000u));
      ATTN_STORE16(Ow+(long)row*DM+ch*8,v);} }
  asm volatile("s_waitcnt lgkmcnt(0)\n\ts_barrier":::"memory");
  #undef DMA_K
  #undef DMA_V
  #undef CMASK
  #undef KBIAS
  #undef START
  #undef RESC
  #undef ROT
}
constexpr int ATTN_LDS_BYTES=LDS_BYTES;
struct AttnTensors { const bf16* Q; const bf16* K; const bf16* V; bf16* O; const bf16* G; const float* KB; const float* qnorm; };
template<int THRL=8> __device__ __forceinline__ void attn_phase(int tid,int wid,unsigned*ctr,const int*t0tab,volatile __attribute__((address_space(3))) int*bc,char*lds,const AttnTensors&T){
  for(;;){
    if(tid==0){ const int n_=(int)__hip_atomic_fetch_add(ctr,1u,__ATOMIC_RELAXED,__HIP_MEMORY_SCOPE_AGENT); bc[0]=n_; }
    asm volatile("s_waitcnt vmcnt(0) lgkmcnt(0)\n\ts_barrier":::"memory");
    const int n=__builtin_amdgcn_readfirstlane(bc[0]);
    if(n>=BATCH*NHEAD*NQB) break;
    const int qb=NQB-1-(n>>7), bh=n&127;
    const int t0=__builtin_amdgcn_readfirstlane(t0tab[bh*16+qb]);
    attn_unit<THRL>(tid,wid,bh/NHEAD,bh%NHEAD,qb,t0,T.Q,T.K,T.V,T.O,T.G,T.KB+(long)bh*SEQ,T.qnorm,lds);
  }
}
#undef SBAR
#undef WAIT_BAR
}
__device__ __forceinline__ void attn_simple(Frame& F, int j) {
    const InTab in = F.in;
    const bf16_t* Q = (const bf16_t*)(F.ws + WS_RA); const bf16_t* Gt = (const bf16_t*)(F.ws + WS_RA + 64 * MiB);
    const bf16_t* Kb = (const bf16_t*)(F.ws + WS_P); const bf16_t* Vb = (const bf16_t*)(F.ws + WS_P + 64 * MiB);
    const float* KBv = (const float*)(F.ws + WS_KB); bf16_t* OG = (bf16_t*)(F.ws + WS_H2 + 64 * MiB);
    const float* qn = in[I_QNORM] + j * 64;
    for (int item = F.bid; item < 1024; item += F.G) {
        const int bh = item >> 3, qb = item & 7, b = bh >> 4, h = bh & 15, t = qb * 512 + F.tid;
        const size_t row = (size_t)b * SEQ + t;
        float q[64];
        { const bf16_t* qp = Q + row * 1024 + h * 64; float ss = 0.f;
#pragma unroll
          for (int i = 0; i < 8; ++i) { const u32x4 w = *(const u32x4*)(qp + 8 * i);
              q[8 * i] = lo16(w.x); q[8 * i + 1] = hi16(w.x); q[8 * i + 2] = lo16(w.y); q[8 * i + 3] = hi16(w.y); q[8 * i + 4] = lo16(w.z); q[8 * i + 5] = hi16(w.z); q[8 * i + 6] = lo16(w.w); q[8 * i + 7] = hi16(w.w); }
#pragma unroll
          for (int i = 0; i < 64; ++i) ss += q[i] * q[i];
          const float rs = QC2 / sqrtf(ss * (1.0f / 64.0f) + QK_EPS);
#pragma unroll
          for (int i = 0; i < 64; ++i) q[i] = q[i] * rs * qn[i]; }
        float o[64];
#pragma unroll
        for (int i = 0; i < 64; ++i) o[i] = 0.f;
        float m = -1.0e30f, lsum = 0.f;
        const int smax = qb * 512 + F.wave * 64 + 63;
        const bf16_t* kp = Kb + ((size_t)b * SEQ) * 1024 + h * 64; const bf16_t* vp = Vb + ((size_t)b * SEQ) * 1024 + h * 64;
        const float* kbp = KBv + (size_t)bh * SEQ;
        for (int s = 0; s <= smax; ++s) {
            float dot = 0.f;
#pragma unroll
            for (int i = 0; i < 8; ++i) { const u32x4 w = *(const u32x4*)(kp + (size_t)s * 1024 + 8 * i);
                dot += q[8 * i] * lo16(w.x) + q[8 * i + 1] * hi16(w.x) + q[8 * i + 2] * lo16(w.y) + q[8 * i + 3] * hi16(w.y) + q[8 * i + 4] * lo16(w.z) + q[8 * i + 5] * hi16(w.z) + q[8 * i + 6] * lo16(w.w) + q[8 * i + 7] * hi16(w.w); }
            float x = dot + kbp[s];
            if (s > t) x = -1.0e30f;
            const float mn = fmaxf(m, x), corr = exp2f(m - mn), p = (s > t) ? 0.f : exp2f(x - mn);
            m = mn; lsum = lsum * corr + p;
#pragma unroll
            for (int i = 0; i < 8; ++i) { const u32x4 w = *(const u32x4*)(vp + (size_t)s * 1024 + 8 * i);
                o[8 * i] = o[8 * i] * corr + p * lo16(w.x); o[8 * i + 1] = o[8 * i + 1] * corr + p * hi16(w.x); o[8 * i + 2] = o[8 * i + 2] * corr + p * lo16(w.y); o[8 * i + 3] = o[8 * i + 3] * corr + p * hi16(w.y);
                o[8 * i + 4] = o[8 * i + 4] * corr + p * lo16(w.z); o[8 * i + 5] = o[8 * i + 5] * corr + p * hi16(w.z); o[8 * i + 6] = o[8 * i + 6] * corr + p * lo16(w.w); o[8 * i + 7] = o[8 * i + 7] * corr + p * hi16(w.w); }
        }
        const float il = 1.0f / lsum;
        const bf16_t* gp = Gt + row * 1024 + h * 64; bf16_t* op = OG + row * 1024 + h * 64;
#pragma unroll
        for (int i = 0; i < 8; ++i) { const u32x4 w = *(const u32x4*)(gp + 8 * i); u32x4 r;
            r.x = pk2(o[8 * i] * il * lo16(w.x), o[8 * i + 1] * il * hi16(w.x)); r.y = pk2(o[8 * i + 2] * il * lo16(w.y), o[8 * i + 3] * il * hi16(w.y));
            r.z = pk2(o[8 * i + 4] * il * lo16(w.z), o[8 * i + 5] * il * hi16(w.z)); r.w = pk2(o[8 * i + 6] * il * lo16(w.w), o[8 * i + 7] * il * hi16(w.w));
            *(u32x4*)(op + 8 * i) = r; }
    }
}

__device__ __forceinline__ void attn_fast(Frame& F, int j) {
    typedef attn_body::bf16 abf;
    const attn_body::AttnTensors AT{(const abf*)(F.ws + WS_RA), (const abf*)(F.ws + WS_P), (const abf*)(F.ws + WS_P + 64 * MiB), (abf*)(F.ws + WS_H2 + 64 * MiB), (const abf*)(F.ws + WS_RA + 64 * MiB),
                                    (const float*)(F.ws + WS_KB), F.in[I_QNORM] + j * 64};
    static_assert(attn_body::ATTN_LDS_BYTES <= 131072, "attention LDS");
    attn_body::attn_phase<8>(F.tid, F.wave, (unsigned*)(F.ws + WS_CTL) + CW_ATT + 64 * j, (const int*)(F.ws + WS_T0), (volatile LAS int*)(F.lds + MISC_OFF + 64), F.ldsg, AT);
}
__device__ __forceinline__ void relane(Frame& F) { int l_; asm volatile("v_mbcnt_lo_u32_b32 %0, -1, 0\n\tv_mbcnt_hi_u32_b32 %0, -1, %0" : "=v"(l_)); int w_ = F.wave; asm volatile("" : "+s"(w_)); F.wave = w_; F.lane = l_; F.tid = w_ * 64 + l_;
    GAS unsigned char* p_ = (GAS unsigned char*)F.ws; asm volatile("" : "+s"(p_)); F.ws = (unsigned char*)p_; GAS float* x_ = (GAS float*)F.xs; asm volatile("" : "+s"(x_)); F.xs = (float*)x_; }
#define GRID_BAR() (relane(F), xcd_barrier_fn(bar.bar, bar.x, bar.st, F.tid == 0))
#ifndef ONLY
#define ONLY (-1)
#endif
#ifndef REP_MASK
#define REP_MASK 0
#endif
#define ON(k) (relane(F), (ONLY < 0 || ONLY == (k)))
#define RUN(k, ...) do { for (int rep_ = 0; rep_ < (((REP_MASK >> (k)) & 1) ? 2 : 1); ++rep_) { if (ON(k)) { __VA_ARGS__; } if (REP_MASK) __syncthreads(); } } while (0)
template <int l> __device__ __forceinline__ void layer_body(Frame& F, const XcdBarrier& bar) {
    unsigned char* ws = F.ws;

        if (l < 2) {
#ifdef GPROBE
            { relane(F); SchedRKV S{{T / 256, 12, F.G, F.bid}};
#if GPROBE == 1
              EpiNone E{};
#else
              EpiPriv E{(bf16_t*)(ws + WS_RA), F.bid};
#endif
              gemm_fast(F, (const bf16_t*)(ws + WS_SC), 1024, (const bf16_t*)(ws + WS_RWBIG) + (size_t)l * 3072 * 1024, 1024, S, E); __syncthreads(); }
#endif
            RUN(2, SchedRKV S{{T / 256, 12, F.G, F.bid}}; EpiRKV E{(bf16_t*)(ws + WS_RA), (bf16_t*)(ws + WS_P), l};
              gemm_fast(F, (const bf16_t*)(ws + WS_SC), 1024, (const bf16_t*)(ws + WS_RWBIG) + (size_t)l * 3072 * 1024, 1024, S, E););
            RUN(21, SchedDense S{T / 256, 2, F.G, F.bid}; EpiLA E{(bf16_t*)(ws + WS_RA + 192 * MiB)};
              gemm_fast(F, (const bf16_t*)(ws + WS_H2), RWK, (const bf16_t*)(ws + WS_RWLORA) + (size_t)l * 512 * RWK, RWK, S, E););
            GRID_BAR();
            RUN(3, SchedDense S{T / 256, 4, F.G, F.bid}; EpiPlain E{(bf16_t*)(ws + WS_RA + 224 * MiB), 1024};
              gemm_fast(F, (const bf16_t*)(ws + WS_RA + 192 * MiB) + 128, LAW, (const bf16_t*)(ws + WS_LORA2 + (size_t)l * MiB + L2_G2T), G2K, S, E););
            RUN(4, wkv_chunk_prep<0>(F, l));
#ifdef PREP_PROBE
            relane(F); __syncthreads(); wkv_chunk_prep<PREP_PROBE>(F, l);
#endif
            GRID_BAR();
            RUN(20, wkv_chunk_seq(F, l)); RUN(19, moe_convert(F, l, 128, F.G - 128));
            GRID_BAR();
            RUN(6, SchedDense S{T / 256, 4, F.G, F.bid}; EpiPlain E{(bf16_t*)(ws + WS_Y16), 1024};
              gemm_fast(F, (const bf16_t*)(ws + WS_H2), 1024, (const bf16_t*)(ws + WS_RWWO) + (size_t)l * 1024 * 1024, 1024, S, E););
            GRID_BAR();
        } else {
            const int j = l - 2;
            RUN(7, SchedDense S{T / 256, 8, F.G, F.bid}; EpiSplit2 E{(bf16_t*)(ws + WS_RA), (bf16_t*)(ws + WS_RA + 64 * MiB), 1};
              gemm_fast(F, (const bf16_t*)(ws + WS_H2), 1024, (const bf16_t*)(ws + WS_FXQG) + (size_t)j * 2048 * 1024, 1024, S, E););
            GRID_BAR();
            RUN(19, moe_convert(F, l, F.G - 64, 64));
            RUN(8, attn_fast(F, j));
            GRID_BAR();
            RUN(9, SchedDense S{T / 256, 4, F.G, F.bid}; EpiPlain E{(bf16_t*)(ws + WS_Y16), 1024};
              gemm_fast(F, (const bf16_t*)(ws + WS_H2 + 64 * MiB), 1024, (const bf16_t*)(ws + WS_FXWO) + (size_t)j * 1024 * 1024, 1024, S, E););
            GRID_BAR();
        }
#ifdef TOKA_PROBE
        relane(F); tok_a<true>(F, l); __syncthreads();
#endif
#ifdef BAR_PROBE
        for (int bi_ = 0; bi_ < 5; ++bi_) GRID_BAR();
#endif
        RUN(10, tok_a<false>(F, l));
        GRID_BAR();
        {
            const LAS int* lc = (const LAS int*)(F.lds + MOE_LC_OFF);
            const bf16_t* W1T = (const bf16_t*)(ws + WS_MOE); const bf16_t* W2T = W1T + (size_t)32 * 1024 * 1024;
            relane(F); moe_tables(F, l);
            { SchedMoe S{lc + 96, lc[64], F.G, F.bid, (size_t)1024 * 1024}; moe_rows(F, S); EpiMoe1 E{(bf16_t*)(ws + WS_HM)};
              RUN(12, gemm_fast<EpiMoe1, SchedMoe, true>(F, (const bf16_t*)(ws + WS_H2), 1024, W1T, 1024, S, E, (const LAS int*)(F.lds + MOE_TOKL_OFF))); }
            GRID_BAR();
            { SchedMoe S{lc + 96, lc[64], F.G, F.bid, (size_t)1024 * 512}; EpiPlain E{(bf16_t*)(ws + WS_RA + 144 * MiB), 1024};
              RUN(13, gemm_fast(F, (const bf16_t*)(ws + WS_HM), 512, W2T, 512, S, E)); }
            GRID_BAR();
        }
#ifdef TOKB_PROBE
        relane(F); tok_b<true>(F, l, l == 1 ? 1 : (l == 2 ? 2 : 3)); __syncthreads();
#endif
        RUN(14, tok_b<false>(F, l, l == 1 ? 1 : (l == 2 ? 2 : 3)));
        if (l == 3) return;
        GRID_BAR();
        if (l == 0) { RUN(1, rw_prep(F, 1, false)); GRID_BAR(); }
        if (l == 1) {
            RUN(18, fgate_phase(F));
            RUN(15, SchedDense S{T / 256, 8, F.G, F.bid}; EpiSplit2 E{(bf16_t*)(ws + WS_P), (bf16_t*)(ws + WS_P + 64 * MiB), 0};
              gemm_fast(F, (const bf16_t*)(ws + WS_RA), 1024, (const bf16_t*)(ws + WS_KVW), 1024, S, E););
            GRID_BAR();
            RUN(16, kv_post(F));
            GRID_BAR();
        }
}
__global__ void __launch_bounds__(NTHR, 2) yoco_fwd(Args args) {
    extern __shared__ __attribute__((aligned(16))) unsigned char lds[];
    Frame F;
    F.lds = (LAS unsigned char*)lds; F.ldsg = (char*)lds; F.ws = args.ws; F.xs = args.out; F.in.p = args.in;
    F.tid = threadIdx.x; F.lane = F.tid & 63; F.wave = __builtin_amdgcn_readfirstlane(F.tid >> 6); F.G = gridDim.x; F.bid = blockIdx.x;
    volatile LAS unsigned* MISC = (volatile LAS unsigned*)(F.lds + MISC_OFF);
    if (F.tid < 32) MISC[F.tid] = 0u;
    __syncthreads();
    XcdBarrier bar = xcd_barrier_post((unsigned*)(F.ws + WS_CTL) + CW_BAR, MISC + 8);
    unsigned char* ws = F.ws;
    RUN(0, p0_prologue(F));
    GRID_BAR();
    RUN(1, rw_prep(F, 0, true));
    GRID_BAR();
    layer_body<0>(F, bar); layer_body<1>(F, bar); layer_body<2>(F, bar); layer_body<3>(F, bar);
}

extern "C" void kernel_launch(void* const* d_in, const int* in_sizes, int n_in, void* d_out, int out_size, void* d_ws, size_t ws_size, hipStream_t stream) {
    static int grid = 0;
    if (grid == 0) {
        if (n_in != 40 || out_size != T * D || ws_size < WS_END) { fprintf(stderr, "kernel_launch: unexpected shapes (n_in %d out %d ws %zu)\n", n_in, out_size, ws_size); grid = -1; return; }
        int dev = 0, cus = 0, per_cu = 0;
        if (hipGetDevice(&dev) != hipSuccess || hipDeviceGetAttribute(&cus, hipDeviceAttributeMultiprocessorCount, dev) != hipSuccess) { grid = -1; return; }
        if (hipFuncSetAttribute((const void*)yoco_fwd, hipFuncAttributeMaxDynamicSharedMemorySize, LDS_BYTES) != hipSuccess) { fprintf(stderr, "kernel_launch: hipFuncSetAttribute failed\n"); grid = -1; return; }
        if (hipOccupancyMaxActiveBlocksPerMultiprocessor(&per_cu, (const void*)yoco_fwd, NTHR, LDS_BYTES) != hipSuccess || per_cu < 1) fprintf(stderr, "kernel_launch: occupancy query reports %d\n", per_cu);
        (void)hipGetLastError();
        grid = cus;
        if (grid != 256) { fprintf(stderr, "kernel_launch: built for 256 CUs, found %d\n", cus); grid = -1; return; }
    }
    if (grid < 0) return;
    (void)hipMemsetAsync((char*)d_ws + WS_CTL, 0, CTL_BYTES, stream);
    Args a{};
    for (int i = 0; i < 40; ++i) a.in[i] = (const float*)d_in[i];
    a.out = (float*)d_out; a.ws = (unsigned char*)d_ws; a.ph_lo = 0; a.ph_hi = 0;
    hipLaunchKernelGGL(yoco_fwd, dim3(grid), dim3(NTHR), LDS_BYTES, stream, a);
}
```

```cpp
#include <hip/hip_runtime.h>
#include <cstdio>
#include <cstdint>
#include <hip/hip_bf16.h>
#include <cmath>

#define GAS __attribute__((address_space(1)))
#define LAS __attribute__((address_space(3)))
typedef unsigned short bf16_t;
typedef short bf16x8 __attribute__((ext_vector_type(8)));
typedef float f32x4 __attribute__((ext_vector_type(4)));
typedef float f32x2 __attribute__((ext_vector_type(2)));
typedef unsigned u32x4 __attribute__((ext_vector_type(4)));
typedef unsigned u32x2 __attribute__((ext_vector_type(2)));
typedef GAS unsigned gu32;

constexpr int NB = 8, SEQ = 4096, T = NB * SEQ, D = 1024, NH = 16, HD = 64;
constexpr int NWAVES = 8, NTHR = NWAVES * 64;
constexpr float ALPHA = 1.681792830507429f;
constexpr float LN_EPS = 1e-5f, GN_EPS = 64e-5f, QK_EPS = 1e-6f;
constexpr float LOG2E = 1.4426950408889634f;
constexpr float QC2 = 0.125f * LOG2E;
constexpr int RWK = 2048;
constexpr int LAW = 512;
constexpr int G2K = 256;
constexpr int XS_ROWS = 73728;

constexpr size_t MiB = 1u << 20;
constexpr size_t WS_CTL = 0, CTL_BYTES = 1 * MiB;
constexpr size_t WS_MOD = 1 * MiB;
constexpr size_t WS_KVMOD = WS_MOD + 4 * 8 * 6144 * 4;
constexpr size_t WS_RT = 2 * MiB;
constexpr size_t WS_WF = WS_RT + 768 * 1024;
constexpr size_t WS_KB = 3 * MiB;
constexpr size_t WS_LF = 5 * MiB;
constexpr size_t WS_ASG = 7 * MiB;
constexpr size_t WS_GATE = WS_ASG + 256 * 1024;
constexpr size_t WS_DEST = WS_GATE + 256 * 1024;
constexpr size_t WS_TEXP = WS_DEST + 256 * 1024;
constexpr size_t WS_T0 = WS_TEXP + 4096;
constexpr size_t WS_RWBIG = 16 * MiB;
constexpr size_t WS_RWLORA = 28 * MiB;
constexpr size_t WS_LORA2 = 44 * MiB;
constexpr size_t L2_G2T = 0, L2_W2T = 512 * 1024, L2_A2T = 640 * 1024, L2_V2T = 768 * 1024;
constexpr size_t WS_RWWO = 50 * MiB;
constexpr size_t WS_KVW = 54 * MiB;
constexpr size_t WS_FXQG = 58 * MiB;
constexpr size_t WS_FXWO = 66 * MiB;
constexpr size_t WS_MOE = 72 * MiB;
constexpr size_t WS_SC = 168 * MiB;
constexpr size_t X3S = (size_t)T * 1024;
constexpr size_t WS_XS = WS_SC + 200 * MiB;
constexpr size_t WS_P = 456 * MiB;
constexpr size_t WS_Y16 = 584 * MiB;
constexpr size_t WS_H2 = 648 * MiB;
constexpr size_t WS_RA = 776 * MiB;
constexpr size_t WS_HM = WS_RA;
constexpr size_t WS_TLIST = WS_RA + 80 * MiB;
constexpr size_t WS_END = 1064 * MiB;
constexpr int CW_BAR = 4096;
constexpr int CW_CNT = 16384;
constexpr int CW_ATT = 16640;

constexpr int LDS_BYTES = 147456;
constexpr int MISC_OFF = 131072 + 320;
constexpr int MOE_LC_OFF = MISC_OFF + 256;
constexpr int MOE_TOKL_OFF = MISC_OFF + 2048;
__device__ __forceinline__ float bf2f(unsigned short b) { return __uint_as_float((unsigned)b << 16); }
typedef float f32x2_cv __attribute__((ext_vector_type(2))); typedef __bf16 bf16x2_cv __attribute__((ext_vector_type(2)));
__device__ __forceinline__ unsigned pk2(float lo, float hi) { const f32x2_cv v = {lo, hi}; return __builtin_bit_cast(unsigned, __builtin_convertvector(v, bf16x2_cv)); }
__device__ __forceinline__ unsigned f2bf(float f) { return pk2(f, 0.f) & 0xffffu; }
__device__ __forceinline__ float lo16(unsigned w) { return __uint_as_float(w << 16); }
__device__ __forceinline__ float hi16(unsigned w) { return __uint_as_float(w & 0xffff0000u); }
__device__ __forceinline__ float sigmoidf_(float x) { return __builtin_amdgcn_rcpf(1.0f + __expf(-x)); }
__device__ __forceinline__ float tanhf_(float x) { const float e = __expf(2.0f * x); return 1.0f - 2.0f * __builtin_amdgcn_rcpf(e + 1.0f); }
template <int CTRL> __device__ __forceinline__ float dpp_f(float v) {
    return __builtin_bit_cast(float, __builtin_amdgcn_update_dpp(0, __builtin_bit_cast(int, v), CTRL, 0xF, 0xF, true));
}
__device__ __forceinline__ float wave_sum(float v) {
    v += dpp_f<0xB1>(v); v += dpp_f<0x4E>(v); v += dpp_f<0x141>(v); v += dpp_f<0x140>(v);
    const int vi = __builtin_bit_cast(int, v);
    const float s0 = __builtin_bit_cast(float, __builtin_amdgcn_readlane(vi, 0)), s1 = __builtin_bit_cast(float, __builtin_amdgcn_readlane(vi, 16)), s2 = __builtin_bit_cast(float, __builtin_amdgcn_readlane(vi, 32)), s3 = __builtin_bit_cast(float, __builtin_amdgcn_readlane(vi, 48));
    return (s0 + s1) + (s2 + s3);
}
__device__ __forceinline__ float quadsum(float v) { v += dpp_f<0xB1>(v); v += dpp_f<0x4E>(v); return v; }
__device__ __forceinline__ float rowsum16(float v) { v += dpp_f<0xB1>(v); v += dpp_f<0x4E>(v); v += dpp_f<0x141>(v); v += dpp_f<0x140>(v); return v; }
#define LDS_WAIT() asm volatile("s_waitcnt lgkmcnt(0)" ::: "memory")
#define LBAR() do { asm volatile("s_waitcnt lgkmcnt(0)" ::: "memory"); __builtin_amdgcn_s_barrier(); asm volatile("" ::: "memory"); } while (0)

#define XB_TMO      128
#define XB_XCNT(j)  (256  + 64 * (j))
#define XB_XSUB(j)  (1280 + 64 * (j))
#define XB_XGEN(j)  (2304 + 64 * (j))
#define XB_TOP      3328
#define XB_TOPGEN   3392
#define XCD_BAR_WORDS 3456
#define XB_SPIN_CAP (1u << 22)
__device__ __forceinline__ unsigned xb_ld(unsigned* p)              { return __hip_atomic_load(p, __ATOMIC_RELAXED, __HIP_MEMORY_SCOPE_AGENT); }
__device__ __forceinline__ unsigned xb_add(unsigned* p, unsigned v) { return __hip_atomic_fetch_add(p, v, __ATOMIC_RELAXED, __HIP_MEMORY_SCOPE_AGENT); }
__device__ __forceinline__ unsigned xb_xcc_id() { return (unsigned)__builtin_amdgcn_s_getreg((3 << 11) | 20) & 0xFu; }
#define XB_SPIN(cond, bar) do { unsigned _sp = 0; while (cond) { __builtin_amdgcn_s_sleep(1); \
    if ((++_sp & 255u) == 0u) { if (xb_ld(&(bar)[XB_TMO])) break; if (_sp > XB_SPIN_CAP) { atomicAdd(&(bar)[XB_TMO], 1u); break; } } } } while (0)
struct XcdBarrier { unsigned* bar; unsigned x; volatile LAS unsigned* st; };
__device__ __forceinline__ XcdBarrier xcd_barrier_post(unsigned* bar, volatile LAS unsigned* st) {
    XcdBarrier b; b.bar = bar; b.x = xb_xcc_id(); b.st = st;
    if (threadIdx.x == 0) (void)xb_add(&bar[XB_XCNT(b.x)], 1u);
    return b;
}
__device__ __forceinline__ void xcd_barrier_complete(unsigned* bar, unsigned x, unsigned& nloc, unsigned& nx) {
    const unsigned G = gridDim.x * gridDim.y * gridDim.z;
    unsigned sum, cnt, mine, sp = 0u;
    for (;;) {
        sum = 0u; cnt = 0u; mine = 0u;
#pragma unroll
        for (unsigned j = 0; j < 16; ++j) { const unsigned c = xb_ld(&bar[XB_XCNT(j)]); sum += c; cnt += (c > 0u) ? 1u : 0u; mine = (j == x) ? c : mine; }
        if (sum == G) break;
        __builtin_amdgcn_s_sleep(1);
        if ((++sp & 255u) == 0u) { if (xb_ld(&bar[XB_TMO])) break; if (sp > XB_SPIN_CAP) { atomicAdd(&bar[XB_TMO], 1u); break; } }
    }
    nloc = mine > 0u ? mine : 1u; nx = cnt > 0u ? cnt : 1u;
}
__device__ __forceinline__ void xcd_barrier_fn(unsigned* bar_, unsigned x_, volatile LAS unsigned* st_, bool is_t0) {
    XcdBarrier b; b.bar = bar_; b.x = x_; b.st = st_;
    asm volatile("s_waitcnt vmcnt(0)" ::: "memory");
    __syncthreads();
    if (is_t0) {
        unsigned* bar = b.bar;
        __builtin_amdgcn_s_waitcnt(0);
        unsigned nloc = b.st[0], nx = b.st[1];
        if (nloc == 0u) { xcd_barrier_complete(bar, b.x, nloc, nx); b.st[0] = nloc; b.st[1] = nx; }
        const unsigned old = xb_add(&bar[XB_XSUB(b.x)], 1u);
        const unsigned gen = old / nloc;
        if (old + 1u == (gen + 1u) * nloc) {
            __builtin_amdgcn_fence(__ATOMIC_RELEASE, "agent");
            asm volatile("s_waitcnt vmcnt(0)" ::: "memory");
            const unsigned og = xb_add(&bar[XB_TOP], 1u);
            const unsigned tg = og / nx;
            if (og + 1u == (tg + 1u) * nx) xb_add(&bar[XB_TOPGEN], 1u);
            else XB_SPIN(xb_ld(&bar[XB_TOPGEN]) == tg, bar);
            __builtin_amdgcn_fence(__ATOMIC_ACQUIRE, "agent");
            xb_add(&bar[XB_XGEN(b.x)], 1u);
            asm volatile("s_waitcnt vmcnt(0)" ::: "memory");
        } else {
            XB_SPIN(xb_ld(&bar[XB_XGEN(b.x)]) == gen, bar);
            __builtin_amdgcn_fence(__ATOMIC_ACQUIRE, "agent");
            asm volatile("s_waitcnt vmcnt(0)" ::: "memory");
        }
    }
    __syncthreads();
}

struct Args { const float* in[40]; float* out; unsigned char* ws; int ph_lo, ph_hi; };
struct InTab { const float* const* p; __device__ __forceinline__ const float* operator[](int i) const { return (const float*)(GAS const float*)p[i]; } };
struct Frame {
    LAS unsigned char* lds; char* ldsg;
    unsigned char* ws; float* xs;
    InTab in;
    int tid, lane, wave, G, bid;
};
enum { I_X = 0, I_C, I_ADAW, I_ADAB, I_LNG, I_LNB, I_MU, I_RKV, I_W0, I_W1, I_W2, I_A0, I_A1, I_A2, I_G1, I_G2, I_KK, I_KA, I_RK, I_GNG, I_GNB, I_RWO, I_V0, I_V1, I_V2,
       I_KVADAW, I_KVADAB, I_KVW, I_KVFB, I_KNORM, I_WQG, I_QNORM, I_FWO, I_WGRP, I_BGRP, I_WEXP, I_BEXP, I_WGATE, I_WUP, I_WDOWN };

__device__ __forceinline__ void tr_item(const float* W, int ldw, int K, int k0, int n0, const float* mu, bf16_t* WT, int ldt, int nd0, int kd0, LAS float* scr, int lane) {
    const int kr = lane >> 3, n4 = 4 * (lane & 7);
    f32x4 v[8];
#pragma unroll
    for (int i = 0; i < 8; ++i) { const int k = k0 + kr + 8 * i; v[i] = (k < K) ? *(const f32x4*)(W + (size_t)k * ldw + n0 + n4) : (f32x4){0.f, 0.f, 0.f, 0.f}; }
    if (mu) {
#pragma unroll
        for (int i = 0; i < 8; ++i) { const int k = k0 + kr + 8 * i; v[i] = v[i] * ((k < K) ? mu[k] : 0.f); }
    }
#pragma unroll
    for (int i = 0; i < 8; ++i) { LAS float* d = scr + (kr + 8 * i) * 33 + n4; d[0] = v[i][0]; d[1] = v[i][1]; d[2] = v[i][2]; d[3] = v[i][3]; }
    LDS_WAIT(); asm volatile("" ::: "memory");
    const int c = lane & 7;
#pragma unroll
    for (int j = 0; j < 4; ++j) {
        const int n = (lane >> 3) + 8 * j; const LAS float* s = scr + (8 * c) * 33 + n;
        u32x4 o; o.x = pk2(s[0 * 33], s[1 * 33]); o.y = pk2(s[2 * 33], s[3 * 33]); o.z = pk2(s[4 * 33], s[5 * 33]); o.w = pk2(s[6 * 33], s[7 * 33]);
        *(u32x4*)(WT + (size_t)(nd0 + n) * ldt + kd0 + 8 * c) = o;
    }
    LDS_WAIT(); asm volatile("" ::: "memory");
}
__device__ __forceinline__ void zero_item(bf16_t* WT, int ldt, int r0, int c0, int c1, int lane) {
    const int cpr = (c1 - c0) >> 3, tot = 32 * cpr;
    for (int i = lane; i < tot; i += 64) { const int r = i / cpr, c = i % cpr; *(u32x4*)(WT + (size_t)(r0 + r) * ldt + c0 + 8 * c) = (u32x4){0u, 0u, 0u, 0u}; }
}

__device__ __forceinline__ void p0_prologue(Frame& F) {
    const InTab in = F.in;
    {
        LAS float* cs = (LAS float*)F.lds;
        LAS float* part = (LAS float*)(F.lds + 32768);
        bool did_cs = false;
        for (int it = F.bid; it < 104; it += F.G) {
            if (!did_cs) { for (int i = F.tid; i < 8 * 1024; i += NTHR) { const float v = in[I_C][i]; cs[i] = v / (1.0f + __expf(-v)); } did_cs = true; }
            __syncthreads();
            const float* W; const float* bias; int ldw, j0; float* dst; int dld;
            if (it < 96) { const int l = it / 24; j0 = (it % 24) * 256; W = in[I_ADAW] + (size_t)l * 1024 * 6144; ldw = 6144; bias = in[I_ADAB] + l * 6144; dst = (float*)(F.ws + WS_MOD) + (size_t)l * 8 * 6144; dld = 6144; }
            else { j0 = (it - 96) * 256; W = in[I_KVADAW]; ldw = 2048; bias = in[I_KVADAB]; dst = (float*)(F.ws + WS_KVMOD); dld = 2048; }
            f32x4 acc[8];
#pragma unroll
            for (int b = 0; b < 8; ++b) acc[b] = (f32x4){0.f, 0.f, 0.f, 0.f};
            const int kbeg = F.wave * 128;
#pragma unroll 4
            for (int kk = 0; kk < 128; ++kk) {
                const int k = kbeg + kk;
                const f32x4 w = *(const f32x4*)(W + (size_t)k * ldw + j0 + 4 * F.lane);
#pragma unroll
                for (int b = 0; b < 8; ++b) acc[b] += w * cs[b * 1024 + k];
            }
#pragma unroll
            for (int b = 0; b < 8; ++b) *(LAS f32x4*)(part + (F.wave * 8 + b) * 256 + 4 * F.lane) = acc[b];
            __syncthreads();
            for (int o = F.tid; o < 8 * 256; o += NTHR) {
                const int b = o >> 8, j = o & 255; float s = 0.f;
#pragma unroll
                for (int w = 0; w < 8; ++w) s += part[(w * 8 + b) * 256 + j];
                dst[(size_t)b * dld + j0 + j] = s + bias[j0 + j];
            }
            __syncthreads();
        }
        __syncthreads();
    }
    {
        const int gt = F.bid * NTHR + F.tid, NGT = F.G * NTHR;
        bf16_t* RTH = (bf16_t*)(F.ws + WS_RT); bf16_t* RTL = RTH + 4 * 48 * 1024; bf16_t* WFH = (bf16_t*)(F.ws + WS_WF); bf16_t* WFL = WFH + 16 * 1024;
        for (int i = gt; i < 4 * 48 * 1024; i += NGT) {
            const int l = i / (48 * 1024), r = i % (48 * 1024), c = r / 1024, k = r % 1024;
            const float w = (c < 4) ? in[I_WGRP][((size_t)l * 1024 + k) * 4 + c] : (c < 36 ? in[I_WEXP][((size_t)l * 1024 + k) * 32 + (c - 4)] : 0.f);
            const unsigned h = f2bf(w); RTH[i] = (bf16_t)h; RTL[i] = (bf16_t)f2bf(w - bf2f((unsigned short)h));
        }
        for (int i = gt; i < 16 * 1024; i += NGT) { const int c = i / 1024, k = i % 1024; const float w = in[I_KVW][(size_t)k * 2064 + 2048 + c];
            const unsigned h = f2bf(w); WFH[i] = (bf16_t)h; WFL[i] = (bf16_t)f2bf(w - bf2f((unsigned short)h)); }
    }
    LAS float* scr = (LAS float*)(F.lds + F.wave * 8704);
    const int gw = F.bid * NWAVES + F.wave, NGW = F.G * NWAVES;
    constexpr int N_S1 = 2 * 3 * 512;
    constexpr int N_S2 = 2 * 17 * 32;
    constexpr int N_S3 = 2 * 128;
    constexpr int N_S4 = 2 * 512 + 1024 + 2 * 1024 + 2 * 512;
    constexpr int N_TOT = N_S1 + N_S2 + N_S3 + N_S4;
    for (int it = gw; it < N_TOT; it += NGW) {
        int r = it;
        if (r < N_S1) {
            const int l = r / 1536; r %= 1536; const int p = r / 512; r %= 512; const int kb = r / 32, nb = r % 32;
            tr_item(in[I_RKV] + (size_t)(l * 3 + p) * 1024 * 1024, 1024, 1024, 64 * kb, 32 * nb, nullptr,
                    (bf16_t*)(F.ws + WS_RWBIG) + (size_t)l * 3072 * 1024, 1024, p * 1024 + 32 * nb, 64 * kb, scr, F.lane);
            continue;
        }
        r -= N_S1;
        if (r < N_S2) {
            const int l = r / (17 * 32); r %= (17 * 32); const int nbk = r / 32, sub = r % 32, half = sub / 16, kb = sub % 16;
            if (nbk >= 16) continue;
            bf16_t* WT = (bf16_t*)(F.ws + WS_RWLORA) + (size_t)l * 512 * RWK;
            const float* W = nullptr; int ldw = 0, n0 = 0, mui = 0;
            if (nbk < 2) { W = in[I_W1] + (size_t)l * 1024 * 64; ldw = 64; n0 = 32 * nbk; mui = 1; }
            else if (nbk < 4) { W = in[I_A1] + (size_t)l * 1024 * 64; ldw = 64; n0 = 32 * (nbk - 2); mui = 4; }
            else if (nbk < 9) { W = in[I_G1] + (size_t)l * 1024 * 160; ldw = 160; n0 = 32 * (nbk - 4); mui = 5; }
            else if (nbk == 9 && l == 1) { W = in[I_V1]; ldw = 32; n0 = 0; mui = 3; }
            if (W) tr_item(W, ldw, 1024, 64 * kb, n0, half ? in[I_MU] + (l * 6 + mui) * 1024 : nullptr, WT, RWK, 32 * nbk, half * 1024 + 64 * kb, scr, F.lane);
            else zero_item(WT, RWK, 32 * nbk, half * 1024 + 64 * kb, half * 1024 + 64 * kb + 64, F.lane);
            continue;
        }
        r -= N_S2;
        if (r < N_S3) {
            const int l = r / 128; r %= 128; const int blk = r / 32, nb = r % 32;
            unsigned char* base = F.ws + WS_LORA2 + (size_t)l * MiB;
            if (blk == 0) { tr_item(in[I_W2] + (size_t)l * 64 * 1024, 1024, 64, 0, 32 * nb, nullptr, (bf16_t*)(base + L2_W2T), 64, 32 * nb, 0, scr, F.lane); }
            else if (blk == 1) { tr_item(in[I_A2] + (size_t)l * 64 * 1024, 1024, 64, 0, 32 * nb, nullptr, (bf16_t*)(base + L2_A2T), 64, 32 * nb, 0, scr, F.lane); }
            else if (blk == 2) { for (int kb = 0; kb < 4; ++kb) tr_item(in[I_G2] + (size_t)l * 160 * 1024, 1024, 160, 64 * kb, 32 * nb, nullptr, (bf16_t*)(base + L2_G2T), G2K, 32 * nb, 64 * kb, scr, F.lane); }
            else { if (l == 1) tr_item(in[I_V2], 1024, 32, 0, 32 * nb, nullptr, (bf16_t*)(base + L2_V2T), 64, 32 * nb, 0, scr, F.lane); }
            continue;
        }
        r -= N_S3;
        if (r < N_S4) {
            if (r < 1024) { const int l = r / 512; r %= 512; tr_item(in[I_RWO] + (size_t)l * 1024 * 1024, 1024, 1024, 64 * (r / 32), 32 * (r % 32), nullptr, (bf16_t*)(F.ws + WS_RWWO) + (size_t)l * 1024 * 1024, 1024, 32 * (r % 32), 64 * (r / 32), scr, F.lane); continue; }
            r -= 1024;
            if (r < 1024) { tr_item(in[I_KVW], 2064, 1024, 64 * (r / 64), 32 * (r % 64), nullptr, (bf16_t*)(F.ws + WS_KVW), 1024, 32 * (r % 64), 64 * (r / 64), scr, F.lane); continue; }
            r -= 1024;
            if (r < 2048) { const int j = r / 1024; r %= 1024; tr_item(in[I_WQG] + (size_t)j * 1024 * 2048, 2048, 1024, 64 * (r / 64), 32 * (r % 64), nullptr, (bf16_t*)(F.ws + WS_FXQG) + (size_t)j * 2048 * 1024, 1024, 32 * (r % 64), 64 * (r / 64), scr, F.lane); continue; }
            r -= 2048;
            { const int j = r / 512; r %= 512; tr_item(in[I_FWO] + (size_t)j * 1024 * 1024, 1024, 1024, 64 * (r / 32), 32 * (r % 32), nullptr, (bf16_t*)(F.ws + WS_FXWO) + (size_t)j * 1024 * 1024, 1024, 32 * (r % 32), 64 * (r / 32), scr, F.lane); continue; }
        }
    }
}
__device__ __forceinline__ void moe_convert(Frame& F, int l, int wg0, int nwg) {
    const InTab in = F.in;
    LAS float* scr = (LAS float*)(F.lds + F.wave * 8704);
    if (F.bid < wg0 || F.bid >= wg0 + nwg) return;
    const int gw = (F.bid - wg0) * NWAVES + F.wave, NGW = nwg * NWAVES;
    bf16_t* base = (bf16_t*)(F.ws + WS_MOE);
    const int kr = F.lane >> 3, n4 = 4 * (F.lane & 7), c = F.lane & 7;
#define MC_DECODE(it_, W_, ldw_, k0_, n0_, WT_, ldt_, nd0_, kd0_) do { const int e_ = (it_) / 768; int r_ = (it_) % 768; const int le_ = l * 32 + e_; \
        if (r_ < 512) { const int kb_ = r_ / 32, nb_ = r_ % 32, s_ = (nb_ % 8) / 4; W_ = (s_ ? in[I_WUP] : in[I_WGATE]) + (size_t)le_ * 1024 * 512; ldw_ = 512; k0_ = 64 * kb_; n0_ = 128 * (nb_ / 8) + 32 * (nb_ % 4); \
            WT_ = base + (size_t)e_ * 1024 * 1024; ldt_ = 1024; nd0_ = 32 * nb_; kd0_ = 64 * kb_; } \
        else { r_ -= 512; const int kb_ = r_ / 32, nb_ = r_ % 32; W_ = in[I_WDOWN] + (size_t)le_ * 512 * 1024; ldw_ = 1024; k0_ = 64 * kb_; n0_ = 32 * nb_; \
            WT_ = base + (size_t)32 * 1024 * 1024 + (size_t)e_ * 1024 * 512; ldt_ = 512; nd0_ = 32 * nb_; kd0_ = 64 * kb_; } } while (0)
    f32x4 v[8];
    { int it = gw; if (it < 32 * 768) { const float* W; int ldw, k0, n0; bf16_t* WT; int ldt, nd0, kd0; MC_DECODE(it, W, ldw, k0, n0, WT, ldt, nd0, kd0);
#pragma unroll
        for (int i = 0; i < 8; ++i) v[i] = *(const f32x4*)(W + (size_t)(k0 + kr + 8 * i) * ldw + n0 + n4); (void)WT; (void)ldt; (void)nd0; (void)kd0; } }
    for (int it = gw; it < 32 * 768; it += NGW) {
        const float* W; int ldw, k0, n0; bf16_t* WT; int ldt, nd0, kd0; MC_DECODE(it, W, ldw, k0, n0, WT, ldt, nd0, kd0);
#pragma unroll
        for (int i = 0; i < 8; ++i) { LAS float* d = scr + (kr + 8 * i) * 33 + n4; d[0] = v[i][0]; d[1] = v[i][1]; d[2] = v[i][2]; d[3] = v[i][3]; }
        if (it + NGW < 32 * 768) { const float* Wn; int ldwn, k0n, n0n; bf16_t* WTn; int ldtn, nd0n, kd0n; MC_DECODE(it + NGW, Wn, ldwn, k0n, n0n, WTn, ldtn, nd0n, kd0n);
#pragma unroll
            for (int i = 0; i < 8; ++i) v[i] = *(const f32x4*)(Wn + (size_t)(k0n + kr + 8 * i) * ldwn + n0n + n4); (void)WTn; (void)ldtn; (void)nd0n; (void)kd0n; }
        LDS_WAIT(); asm volatile("" ::: "memory");
#pragma unroll
        for (int j = 0; j < 4; ++j) {
            const int n = (F.lane >> 3) + 8 * j; const LAS float* sp = scr + (8 * c) * 33 + n;
            u32x4 o; o.x = pk2(sp[0 * 33], sp[1 * 33]); o.y = pk2(sp[2 * 33], sp[3 * 33]); o.z = pk2(sp[4 * 33], sp[5 * 33]); o.w = pk2(sp[6 * 33], sp[7 * 33]);
            *(u32x4*)(WT + (size_t)(nd0 + n) * ldt + kd0 + 8 * c) = o;
        }
        LDS_WAIT(); asm volatile("" ::: "memory");
    }
#undef MC_DECODE
    __syncthreads();
}

struct Unit { int pm, pn; };
struct SchedDense {
    int nM, nN, G, c;
    __device__ __forceinline__ bool next(int i, Unit& u) const {
        const int nwg = nM * nN; const long L = (long)i * G + c; if (L >= nwg) return false;
        int wgid = (int)L; { const int q = nwg / 8, r = nwg % 8, xcd = wgid % 8, off = wgid / 8; wgid = (xcd < r ? xcd * (q + 1) : r * (q + 1) + (xcd - r) * q) + off; }
        const int nig = 8 * nN, gid = wgid / nig, fm = gid * 8, gsz = (nM - fm) < 8 ? (nM - fm) : 8;
        u.pm = fm + ((wgid % nig) % gsz); u.pn = (wgid % nig) / gsz; return true;
    }
    __device__ __forceinline__ size_t boff(const Unit& u, int K) const { return (size_t)u.pn * 256 * K; }
    __device__ __forceinline__ size_t aoff(const Unit&) const { return 0; }
};
struct SchedRKV : SchedDense {
    __device__ __forceinline__ size_t aoff(const Unit& u) const { return (size_t)(u.pn >> 2) * X3S; }
};
struct SchedMoe {
    const LAS int* tt; int ntiles, G, c; size_t estride;
    __device__ __forceinline__ bool next(int i, Unit& u) const { const long L = (long)i * G + c; if (L >= (long)ntiles * 4) return false; u.pm = (int)(L / 4); u.pn = (int)(L % 4); return true; }
    __device__ __forceinline__ size_t boff(const Unit& u, int K) const { return (size_t)(tt[u.pm] >> 16) * estride + (size_t)u.pn * 256 * K; }
    __device__ __forceinline__ size_t aoff(const Unit&) const { return 0; }
};
template <class Epi, class Sched>
__device__ __forceinline__ void gemm_phase(Frame& F, const bf16_t* A, int lda, const bf16_t* Bt, int K, const Sched& S, const Epi& E) {
    const int wr = F.wave >> 2, wc = F.wave & 3, fr = F.lane & 15, fq = F.lane >> 4;
    Unit u;
    for (int i = 0; S.next(i, u); ++i) {
        const bf16_t* Bb = Bt + S.boff(u, K) + (size_t)(wc * 32 + fr) * K + 8 * fq;
        for (int ai = 0; ai < 2; ++ai) {
            f32x4 acc[2][4][2];
#pragma unroll
            for (int b = 0; b < 2; ++b)
#pragma unroll
                for (int m = 0; m < 4; ++m)
#pragma unroll
                    for (int n = 0; n < 2; ++n) acc[b][m][n] = (f32x4){0.f, 0.f, 0.f, 0.f};
            const bf16_t* Ab = A + (size_t)(u.pm * 256 + ai * 128 + wr * 64 + fr) * lda + 8 * fq;
            for (int k0 = 0; k0 < K; k0 += 32) {
                bf16x8 bfr[2][2], af[4];
#pragma unroll
                for (int b = 0; b < 2; ++b)
#pragma unroll
                    for (int n = 0; n < 2; ++n) bfr[b][n] = *(const bf16x8*)(Bb + (size_t)(b * 128 + n * 16) * K + k0);
#pragma unroll
                for (int m = 0; m < 4; ++m) af[m] = *(const bf16x8*)(Ab + (size_t)(m * 16) * lda + k0);
#pragma unroll
                for (int b = 0; b < 2; ++b)
#pragma unroll
                    for (int m = 0; m < 4; ++m)
#pragma unroll
                        for (int n = 0; n < 2; ++n) acc[b][m][n] = __builtin_amdgcn_mfma_f32_16x16x32_bf16(bfr[b][n], af[m], acc[b][m][n], 0, 0, 0);
            }
            E(acc, ai, u, wr, wc, fr, fq);
        }
    }
}
#define PG8_LAS __attribute__((address_space(3)))
constexpr int BM = 256, BK = 64, HALF = 128, HTB = HALF * BK * 2  , STAGE_BYTES = 8 * HTB;

__host__ __device__ __forceinline__ int lds_byte(int r, int c) { const int st = (r >> 4) * 2 + (c >> 5), rr = r & 15, cc = c & 31, ob = rr * 64 + cc * 2; return st * 1024 + (ob ^ (((ob >> 9) & 1) << 5)); }
__host__ __device__ __forceinline__ void stage_rc(int b, int& R, int& C) { const int st = b / 1024, sb = b % 1024, swz = sb ^ (((sb >> 9) & 1) << 5); R = (st >> 1) * 16 + swz / 64; C = (st & 1) * 32 + (swz % 64) / 2; }
__host__ __device__ __forceinline__ int perm32(int rho) { const int n = rho >> 4, i = rho & 15; return 8 * (i >> 2) + 4 * n + (i & 3); }
template <class Epi, class Sched, bool GATHER = false, bool ALIGN_EPI = true, bool SP2 = true>
__device__ __forceinline__ void gemm_fast(Frame& F, const bf16_t* Ag, int lda, const bf16_t* Btg, int Kin, const Sched& S, const Epi& E, const LAS int* tokL = nullptr) {
    static_assert(!GATHER || SP2, "gather mode is written for the SP2 loop");
    PG8_LAS unsigned char* lds = (PG8_LAS unsigned char*)F.lds;
    const int tid = F.tid, wid = F.wave, lane = F.lane, wr = wid >> 2, wc = wid & 3, fr = lane & 15, fq = lane >> 4;
    int K = Kin; asm volatile("" : "+s"(K));
    const int nt = K / BK;
    unsigned voffA[2], voffB[2];
#pragma unroll
    for (int i = 0; i < 2; ++i) { int R, C; stage_rc(tid * 16 + i * 8192, R, C); const int Rb = (Epi::BCONT ? (R >> 5) * 64 : (R & ~31)) + perm32(R & 31);
        voffA[i] = (unsigned)(R * lda + C) * 2u; voffB[i] = (unsigned)(Rb * K + C) * 2u; }
    const size_t kstep = (size_t)(BK * 2);
    const size_t hstepA = (size_t)HALF * lda * 2, hstep = (size_t)(Epi::BCONT ? 32 : HALF) * K * 2;
    const size_t tstepA = 2 * hstepA;
    const unsigned ldsw = (unsigned)wid * 1024u;
    const int aoff = lds_byte(wr * 64 + fr, fq * 8), boff = lds_byte(wc * 32 + fr, fq * 8);
#define PG8_SA(b, h) (((b) * 2 + (h)) * HTB)
#define PG8_SB(b, h) ((4 + (b) * 2 + (h)) * HTB)
    const unsigned ldsb = (unsigned)__builtin_amdgcn_readfirstlane((int)((unsigned)(size_t)lds + ldsw));
#define PG8_STAGE(bufoff, gbase, voff) do { _Pragma("unroll") for (int _i = 0; _i < 2; ++_i) { unsigned keep_; \
        asm volatile("s_mov_b32 %0, m0\n\ts_mov_b32 m0, %3\n\ts_nop 0\n\tglobal_load_lds_dwordx4 %1, %2\n\ts_mov_b32 m0, %0" : "=&s"(keep_) : "v"((voff)[_i]), "s"((const char*)(gbase)), "s"(ldsb + (unsigned)((bufoff) + _i * 8192)) : "memory"); } } while (0)
    unsigned gcu[2][2] = {{0u, 0u}, {0u, 0u}}, gnx[2][2] = {{0u, 0u}, {0u, 0u}};
#define PG8_GOFS(dst, ord) do { int tl_ = tid; asm volatile("" : "+v"(tl_));   _Pragma("unroll") for (int _h = 0; _h < 2; ++_h) _Pragma("unroll") for (int _i = 0; _i < 2; ++_i) { int R_, C_; stage_rc(tl_ * 16 + _i * 8192, R_, C_); \
        dst[_h][_i] = ((unsigned)tokL[(ord) * 256 + _h * 128 + R_] * (unsigned)lda + (unsigned)C_) * 2u; } } while (0)
#define PG8_STAGE_A(bufoff, gptr, half, usenext) do { if constexpr (GATHER) { unsigned vv_[2]; _Pragma("unroll") for (int _j = 0; _j < 2; ++_j) vv_[_j] = (usenext) ? gnx[half][_j] : gcu[half][_j]; PG8_STAGE(bufoff, gptr, vv_); } \
        else { PG8_STAGE(bufoff, (gptr) + ((half) ? hstepA : (size_t)0), voffA); } } while (0)
#define PG8_LDA(dst, b, h) do { _Pragma("unroll") for (int m = 0; m < 4; ++m) _Pragma("unroll") for (int k = 0; k < 2; ++k) dst[m][k] = *(const PG8_LAS bf16x8*)(lds + PG8_SA(b, h) + aoff + m * 2048 + k * 1024); } while (0)
#define PG8_LDB(dst, b, h) do { _Pragma("unroll") for (int n = 0; n < 2; ++n) _Pragma("unroll") for (int k = 0; k < 2; ++k) dst[n][k] = *(const PG8_LAS bf16x8*)(lds + PG8_SB(b, h) + boff + n * 2048 + k * 1024); } while (0)
#define PG8_MMA(ai, bj, At, Bt) do { __builtin_amdgcn_s_setprio(1); _Pragma("unroll") for (int m = 0; m < 4; ++m) _Pragma("unroll") for (int n = 0; n < 2; ++n) _Pragma("unroll") for (int k = 0; k < 2; ++k) \
        acc[ai][bj][m][n] = __builtin_amdgcn_mfma_f32_16x16x32_bf16(Bt[n][k], At[m][k], acc[ai][bj][m][n], 0, 0, 0); __builtin_amdgcn_s_setprio(0); } while (0)
#define PG8_WAIT_V(n) asm volatile("s_waitcnt vmcnt(" #n ")" ::: "memory")
#define PG8_WAIT_R(rel) do { if (rel) asm volatile("s_waitcnt vmcnt(%0)" :: "n"(8 + Epi::NST) : "memory"); else PG8_WAIT_V(8); } while (0)
#define PG8_WAIT_L(n) asm volatile("s_waitcnt lgkmcnt(" #n ")" ::: "memory")
#define PG8_BAR __builtin_amdgcn_s_barrier()
#define PG8_SCHED __builtin_amdgcn_sched_barrier(0)
    Unit cur, nxt; int ui = 0;
    if (!S.next(0, cur)) return;
    f32x4 acc[2][2][4][2];
#pragma unroll
    for (int a = 0; a < 2; ++a)
#pragma unroll
        for (int b = 0; b < 2; ++b)
#pragma unroll
            for (int m = 0; m < 4; ++m)
#pragma unroll
                for (int n = 0; n < 2; ++n) acc[a][b][m][n] = (f32x4){0.f, 0.f, 0.f, 0.f};
    bf16x8 At[4][2], B0[2][2], B1[2][2];
    const char* cA = GATHER ? (const char*)Ag : (const char*)Ag + 2 * S.aoff(cur) + (size_t)cur.pm * tstepA; const char* cB = (const char*)Btg + 2 * S.boff(cur, K);
    if constexpr (GATHER) PG8_GOFS(gcu, 0);
    if constexpr (SP2) {
        PG8_STAGE(PG8_SB(0, 0), cB, voffB); PG8_STAGE(PG8_SB(0, 1), cB + hstep, voffB); PG8_STAGE_A(PG8_SA(0, 0), cA, 0, false); PG8_STAGE_A(PG8_SA(0, 1), cA, 1, false);
        if (wr == 1) PG8_BAR;
        PG8_WAIT_V(2); PG8_BAR;
        PG8_STAGE(PG8_SB(1, 0), cB + kstep, voffB); PG8_STAGE_A(PG8_SA(1, 0), cA + kstep, 0, false); PG8_STAGE(PG8_SB(1, 1), cB + hstep + kstep, voffB);
        PG8_WAIT_V(6); PG8_BAR;
    } else {
        PG8_STAGE(PG8_SB(0, 0), cB, voffB); PG8_STAGE(PG8_SA(0, 0), cA, voffA); PG8_STAGE(PG8_SB(0, 1), cB + hstep, voffB); PG8_STAGE(PG8_SA(0, 1), cA + hstepA, voffA);
        if (wr == 1) PG8_BAR;
        PG8_WAIT_V(4); PG8_BAR;
        PG8_STAGE(PG8_SB(1, 0), cB + kstep, voffB); PG8_STAGE(PG8_SA(1, 0), cA + kstep, voffA); PG8_STAGE(PG8_SB(1, 1), cB + hstep + kstep, voffB);
        PG8_WAIT_V(6); PG8_BAR;
    }
    for (;;) {
        const bool has_next = S.next(ui + 1, nxt);
        const char* nA = GATHER ? cA : (has_next ? (const char*)Ag + 2 * S.aoff(nxt) + (size_t)nxt.pm * tstepA : cA);
        if constexpr (GATHER) { if (has_next) PG8_GOFS(gnx, ui + 1); else { gnx[0][0] = gcu[0][0]; gnx[0][1] = gcu[0][1]; gnx[1][0] = gcu[1][0]; gnx[1][1] = gcu[1][1]; } } const char* nB = has_next ? (const char*)Btg + 2 * S.boff(nxt, K) : cB;
#define PG8_ITER(WAITA, ST11) do { \
            const bool last = (t == nt - 2); \
            const char* a1 = cA + (size_t)(t + 1) * kstep;                                             \
            const char* a2 = last ? nA : cA + (size_t)(t + 2) * kstep; const char* b2 = last ? nB : cB + (size_t)(t + 2) * kstep;     \
            const char* a3 = a2 + kstep; const char* b3 = b2 + kstep;                                \
              \
            PG8_LDB(B0, 0, 0); PG8_LDB(B1, 0, 1); PG8_SCHED; PG8_LDA(At, 0, 0); ST11; \
            WAITA; PG8_WAIT_L(0); PG8_BAR; PG8_MMA(0, 0, At, B0); PG8_MMA(0, 1, At, B1); PG8_BAR; PG8_SCHED; \
              \
            PG8_LDA(At, 0, 1); PG8_STAGE(PG8_SB(0, 0), b2, voffB); PG8_STAGE(PG8_SB(0, 1), b2 + hstep, voffB); PG8_STAGE_A(PG8_SA(0, 0), a2, 0, last); \
            WAITA; PG8_WAIT_L(0); PG8_BAR; PG8_MMA(1, 0, At, B0); PG8_MMA(1, 1, At, B1); PG8_BAR; PG8_SCHED; \
              \
            PG8_LDB(B0, 1, 0); PG8_LDB(B1, 1, 1); PG8_SCHED; PG8_LDA(At, 1, 0); PG8_STAGE_A(PG8_SA(0, 1), a2, 1, last); \
            WAITA; PG8_WAIT_L(0); PG8_BAR; PG8_MMA(0, 0, At, B0); PG8_MMA(0, 1, At, B1); PG8_BAR; PG8_SCHED; \
              \
            PG8_LDA(At, 1, 1); PG8_STAGE(PG8_SB(1, 0), b3, voffB); PG8_STAGE(PG8_SB(1, 1), b3 + hstep, voffB); PG8_STAGE_A(PG8_SA(1, 0), a3, 0, last); \
            PG8_WAIT_V(8); PG8_WAIT_L(0); PG8_BAR; PG8_MMA(1, 0, At, B0); PG8_MMA(1, 1, At, B1); PG8_BAR; PG8_SCHED; } while (0)
        int t = 0;
        if (ui > 0) { PG8_ITER(asm volatile("s_waitcnt vmcnt(%0)" :: "n"(8 + Epi::NST) : "memory"), (void)0); t = 2; }
        for (; t < nt; t += 2) PG8_ITER(PG8_WAIT_V(8), PG8_STAGE_A(PG8_SA(1, 1), a1, 1, false));
#undef PG8_ITER
        if constexpr (SP2) { if (has_next) PG8_STAGE_A(PG8_SA(1, 1), nA + kstep, 1, true); }
        if constexpr (ALIGN_EPI) { if (wr == 0) PG8_BAR; }
        { int fr_ = fr, fq_ = fq; asm volatile("" : "+v"(fr_), "+v"(fq_)); E(acc[0], 0, cur, wr, wc, fr_, fq_); E(acc[1], 1, cur, wr, wc, fr_, fq_); }
        if (!has_next) break;
#pragma unroll
        for (int a = 0; a < 2; ++a)
#pragma unroll
            for (int b = 0; b < 2; ++b)
#pragma unroll
                for (int m = 0; m < 4; ++m)
#pragma unroll
                    for (int n = 0; n < 2; ++n) acc[a][b][m][n] = (f32x4){0.f, 0.f, 0.f, 0.f};
        cur = nxt; cA = nA; cB = nB; ++ui;
        if constexpr (GATHER) { gcu[0][0] = gnx[0][0]; gcu[0][1] = gnx[0][1]; gcu[1][0] = gnx[1][0]; gcu[1][1] = gnx[1][1]; }
        if constexpr (ALIGN_EPI) { if (wr == 1) PG8_BAR; }
    }
    PG8_WAIT_V(0);
    if constexpr (!ALIGN_EPI) { if (wr == 0) PG8_BAR; }
    PG8_BAR;
#undef PG8_SA
#undef PG8_SB
#undef PG8_STAGE
#undef PG8_LDA
#undef PG8_GOFS
#undef PG8_STAGE_A
#undef PG8_LDB
#undef PG8_MMA
#undef PG8_WAIT_V
#undef PG8_WAIT_R
#undef PG8_WAIT_L
#undef PG8_BAR
#undef PG8_SCHED
}
__device__ __forceinline__ void st_bf16x4(bf16_t* p, f32x4 v) { u32x2 w; w.x = pk2(v[0], v[1]); w.y = pk2(v[2], v[3]); *(u32x2*)p = w; }
__device__ __forceinline__ f32x4 ld_bf16x4(const bf16_t* p) { const u32x2 w = *(const u32x2*)p; return (f32x4){lo16(w.x), hi16(w.x), lo16(w.y), hi16(w.y)}; }
__device__ __forceinline__ u32x4 pk8(f32x4 a, f32x4 b) { u32x4 w; w.x = pk2(a[0], a[1]); w.y = pk2(a[2], a[3]); w.z = pk2(b[0], b[1]); w.w = pk2(b[2], b[3]); return w; }
__device__ __forceinline__ u32x4 bperm4(int idx, u32x4 w) { u32x4 r; r.x = (unsigned)__builtin_amdgcn_ds_bpermute(idx, (int)w.x); r.y = (unsigned)__builtin_amdgcn_ds_bpermute(idx, (int)w.y); r.z = (unsigned)__builtin_amdgcn_ds_bpermute(idx, (int)w.z); r.w = (unsigned)__builtin_amdgcn_ds_bpermute(idx, (int)w.w); return r; }
#define EPI_LOOP(ACT, ...) do { const int L_ = fq * 16 + fr, r3_ = L_ >> 3, p3_ = L_ & 7, src4_ = (((p3_ & 3) << 4) | r3_) << 2; const bool hi_ = (p3_ & 4) != 0; \
    _Pragma("unroll") for (int m = 0; m < 4; ++m) { u32x4 wb_[2]; \
        _Pragma("unroll") for (int bj = 0; bj < 2; ++bj) { const int colt0 = wc * 64 + bj * 32 + fq * 8; f32x4 v0 = acc[bj][m][0], v1 = acc[bj][m][1]; (void)colt0; ACT; wb_[bj] = pk8(v0, v1); } \
        _Pragma("unroll") for (int h = 0; h < 2; ++h) { const int row = u.pm * 256 + ai * 128 + wr * 64 + m * 16 + h * 8 + r3_, colt = wc * 64 + p3_ * 8; \
            const u32x4 wa_ = bperm4(src4_ + h * 32, wb_[0]), wc_ = bperm4(src4_ + h * 32, wb_[1]); u32x4 w; w.x = hi_ ? wc_.x : wa_.x; w.y = hi_ ? wc_.y : wa_.y; w.z = hi_ ? wc_.z : wa_.z; w.w = hi_ ? wc_.w : wa_.w; \
            __VA_ARGS__ } asm volatile("" ::: "memory"); } } while (0)

struct EpiPlain {
    bf16_t* O; int ldc; static constexpr int NST = 16; static constexpr bool BCONT = true;
    __device__ __forceinline__ void operator()(const f32x4 (&acc)[2][4][2], int ai, const Unit& u, int wr, int wc, int fr, int fq) const {
        EPI_LOOP(, { __builtin_nontemporal_store(w, (u32x4*)(O + (size_t)row * ldc + u.pn * 256 + colt)); });
    }
};
struct EpiNone { static constexpr int NST = 0; static constexpr bool BCONT = true;
    __device__ __forceinline__ void operator()(const f32x4 (&acc)[2][4][2], int ai, const Unit& u, int wr, int wc, int fr, int fq) const {
        _Pragma("unroll") for (int m = 0; m < 4; ++m) _Pragma("unroll") for (int bj = 0; bj < 2; ++bj) asm volatile("" :: "v"(acc[bj][m][0]), "v"(acc[bj][m][1])); }
};
struct EpiPriv { bf16_t* base; int bid; static constexpr int NST = 16; static constexpr bool BCONT = true;
    __device__ __forceinline__ void operator()(const f32x4 (&acc)[2][4][2], int ai, const Unit& u, int wr, int wc, int fr, int fq) const {
        EPI_LOOP(, { __builtin_nontemporal_store(w, (u32x4*)(base + (size_t)bid * 65536 + (size_t)(row - u.pm * 256) * 256 + colt)); });
    }
};
struct EpiRKV {
    bf16_t* RKV; bf16_t* VF; int l; static constexpr int NST = 16; static constexpr bool BCONT = true;
    __device__ __forceinline__ void operator()(const f32x4 (&acc)[2][4][2], int ai, const Unit& u, int wr, int wc, int fr, int fq) const {
        const bool vf = (l == 0) && (u.pn >= 8);
        EPI_LOOP(, { if (vf) __builtin_nontemporal_store(w, (u32x4*)(VF + (size_t)row * 1024 + (u.pn - 8) * 256 + colt)); else __builtin_nontemporal_store(w, (u32x4*)(RKV + (size_t)row * 3072 + u.pn * 256 + colt)); });
    }
};
struct EpiLA {
    bf16_t* LA; static constexpr int NST = 16; static constexpr bool BCONT = true;
    __device__ __forceinline__ void operator()(const f32x4 (&acc)[2][4][2], int ai, const Unit& u, int wr, int wc, int fr, int fq) const {
        EPI_LOOP({ const int c = u.pn * 256 + colt0;
            if (c < 64) { _Pragma("unroll") for (int q = 0; q < 4; ++q) { v0[q] = tanhf_(v0[q]); v1[q] = tanhf_(v1[q]); } }
            else if (c >= 128 && c < 288) { _Pragma("unroll") for (int q = 0; q < 4; ++q) { v0[q] = sigmoidf_(v0[q]); v1[q] = sigmoidf_(v1[q]); } } },
            { __builtin_nontemporal_store(w, (u32x4*)(LA + (size_t)row * LAW + u.pn * 256 + colt)); });
    }
};
struct EpiSplit2 {
    bf16_t* O0; bf16_t* O1; int sig1; static constexpr int NST = 16; static constexpr bool BCONT = true;
    __device__ __forceinline__ void operator()(const f32x4 (&acc)[2][4][2], int ai, const Unit& u, int wr, int wc, int fr, int fq) const {
        if (u.pn < 4) { EPI_LOOP(, { __builtin_nontemporal_store(w, (u32x4*)(O0 + (size_t)row * 1024 + u.pn * 256 + colt)); }); }
        else { EPI_LOOP({ if (sig1) { _Pragma("unroll") for (int q = 0; q < 4; ++q) { v0[q] = sigmoidf_(v0[q]); v1[q] = sigmoidf_(v1[q]); } } }, { __builtin_nontemporal_store(w, (u32x4*)(O1 + (size_t)row * 1024 + (u.pn - 4) * 256 + colt)); }); }
    }
};
struct EpiMoe1 {
    bf16_t* HM; static constexpr int NST = 8; static constexpr bool BCONT = false;
    __device__ __forceinline__ void operator()(const f32x4 (&acc)[2][4][2], int ai, const Unit& u, int wr, int wc, int fr, int fq) const {
        const int L_ = fq * 16 + fr, src4_ = (((L_ & 3) << 4) | (L_ >> 2)) << 2, r2_ = L_ >> 2, p2_ = L_ & 3;
#pragma unroll
            for (int m = 0; m < 4; ++m) { const int row = u.pm * 256 + ai * 128 + wr * 64 + m * 16 + r2_; f32x4 o[2];
#pragma unroll
                for (int n = 0; n < 2; ++n) { const f32x4 g = acc[0][m][n], up = acc[1][m][n];
#pragma unroll
                    for (int q = 0; q < 4; ++q) o[n][q] = g[q] * sigmoidf_(g[q]) * up[q]; }
                u32x4 w = pk8(o[0], o[1]); w.x = (unsigned)__builtin_amdgcn_ds_bpermute(src4_, (int)w.x); w.y = (unsigned)__builtin_amdgcn_ds_bpermute(src4_, (int)w.y); w.z = (unsigned)__builtin_amdgcn_ds_bpermute(src4_, (int)w.z); w.w = (unsigned)__builtin_amdgcn_ds_bpermute(src4_, (int)w.w);
                __builtin_nontemporal_store(w, (u32x4*)(HM + (size_t)row * 512 + u.pn * 128 + wc * 32 + p2_ * 8)); }
    }
};

struct Row { f32x4 v[4]; };
__device__ __forceinline__ Row ld_row_f32(const float* p, int lane) { Row r;
#pragma unroll
    for (int j = 0; j < 4; ++j) r.v[j] = *(const f32x4*)(p + 256 * j + 4 * lane); return r; }
__device__ __forceinline__ void st_row_f32(float* p, int lane, const Row& r) {
#pragma unroll
    for (int j = 0; j < 4; ++j) *(f32x4*)(p + 256 * j + 4 * lane) = r.v[j]; }
__device__ __forceinline__ Row ld_row_bf16(const bf16_t* p, int lane) { Row r;
#pragma unroll
    for (int j = 0; j < 4; ++j) r.v[j] = ld_bf16x4(p + 256 * j + 4 * lane); return r; }
__device__ __forceinline__ void st_row_bf16(bf16_t* p, int lane, const Row& r) {
#pragma unroll
    for (int j = 0; j < 4; ++j) st_bf16x4(p + 256 * j + 4 * lane, r.v[j]); }
__device__ __forceinline__ Row row_ln(const Row& u, const Row& g, const Row& b) {
    float s = 0.f;
#pragma unroll
    for (int j = 0; j < 4; ++j) s += (u.v[j][0] + u.v[j][1]) + (u.v[j][2] + u.v[j][3]);
    const float mean = wave_sum(s) * (1.0f / 1024.0f); float q = 0.f; Row d;
#pragma unroll
    for (int j = 0; j < 4; ++j) { d.v[j] = u.v[j] - mean; q += (d.v[j][0] * d.v[j][0] + d.v[j][1] * d.v[j][1]) + (d.v[j][2] * d.v[j][2] + d.v[j][3] * d.v[j][3]); }
    const float rstd = 1.0f / sqrtf(wave_sum(q) * (1.0f / 1024.0f) + LN_EPS); Row o;
#pragma unroll
    for (int j = 0; j < 4; ++j) o.v[j] = d.v[j] * rstd * g.v[j] + b.v[j];
    return o;
}
__device__ __forceinline__ float row_dot(const Row& a, const float* w, int lane) {
    float s = 0.f;
#pragma unroll
    for (int j = 0; j < 4; ++j) { const f32x4 x = *(const f32x4*)(w + 256 * j + 4 * lane); s += (a.v[j][0] * x[0] + a.v[j][1] * x[1]) + (a.v[j][2] * x[2] + a.v[j][3] * x[3]); }
    return s;
}

constexpr int APITCH = 1032;
template <int NCB>
__device__ __forceinline__ void skinny_mfma(Frame& F, const LAS bf16_t* AH, const LAS bf16_t* AL, const bf16_t* BH, const bf16_t* BL, LAS float* part) {
    const int fr = F.lane & 15, fq = F.lane >> 4;
    f32x4 acc[NCB];
#pragma unroll
    for (int cb = 0; cb < NCB; ++cb) acc[cb] = (f32x4){0.f, 0.f, 0.f, 0.f};
#pragma unroll
    for (int kb = 0; kb < 4; ++kb) {
        const int k0 = 128 * F.wave + 32 * kb + 8 * fq;
        const bf16x8 ah = *(const LAS bf16x8*)(AH + fr * APITCH + k0), al = *(const LAS bf16x8*)(AL + fr * APITCH + k0);
#pragma unroll
        for (int cb = 0; cb < NCB; ++cb) {
            const bf16x8 bh = *(const bf16x8*)(BH + (size_t)(cb * 16 + fr) * 1024 + k0), bl = *(const bf16x8*)(BL + (size_t)(cb * 16 + fr) * 1024 + k0);
            acc[cb] = __builtin_amdgcn_mfma_f32_16x16x32_bf16(bh, ah, acc[cb], 0, 0, 0);
            acc[cb] = __builtin_amdgcn_mfma_f32_16x16x32_bf16(bl, ah, acc[cb], 0, 0, 0);
            acc[cb] = __builtin_amdgcn_mfma_f32_16x16x32_bf16(bh, al, acc[cb], 0, 0, 0);
        }
    }
#pragma unroll
    for (int cb = 0; cb < NCB; ++cb) *(LAS f32x4*)(part + (F.wave * 16 + fr) * 48 + cb * 16 + 4 * fq) = acc[cb];
}
template <int NCB> struct SkB { bf16x8 h[4][NCB], l[4][NCB]; };
template <int NCB>
__device__ __forceinline__ void skinny_loadB(Frame& F, const bf16_t* BH, const bf16_t* BL, SkB<NCB>& B) {
    int ln_ = F.lane; asm volatile("" : "+v"(ln_));
    const int fr = ln_ & 15, fq = ln_ >> 4;
#pragma unroll
    for (int kb = 0; kb < 4; ++kb) { const int k0 = 128 * F.wave + 32 * kb + 8 * fq;
#pragma unroll
        for (int cb = 0; cb < NCB; ++cb) { B.h[kb][cb] = *(const bf16x8*)(BH + (size_t)(cb * 16 + fr) * 1024 + k0); B.l[kb][cb] = *(const bf16x8*)(BL + (size_t)(cb * 16 + fr) * 1024 + k0); } }
}
template <int NCB>
__device__ __forceinline__ void skinny_mma(Frame& F, const LAS bf16_t* AH, const LAS bf16_t* AL, const SkB<NCB>& B, LAS float* part) {
    const int fr = F.lane & 15, fq = F.lane >> 4;
    f32x4 acc[NCB];
#pragma unroll
    for (int cb = 0; cb < NCB; ++cb) acc[cb] = (f32x4){0.f, 0.f, 0.f, 0.f};
#pragma unroll
    for (int kb = 0; kb < 4; ++kb) {
        const int k0 = 128 * F.wave + 32 * kb + 8 * fq;
        const bf16x8 ah = *(const LAS bf16x8*)(AH + fr * APITCH + k0), al = *(const LAS bf16x8*)(AL + fr * APITCH + k0);
#pragma unroll
        for (int cb = 0; cb < NCB; ++cb) {
            acc[cb] = __builtin_amdgcn_mfma_f32_16x16x32_bf16(B.h[kb][cb], ah, acc[cb], 0, 0, 0);
            acc[cb] = __builtin_amdgcn_mfma_f32_16x16x32_bf16(B.l[kb][cb], ah, acc[cb], 0, 0, 0);
            acc[cb] = __builtin_amdgcn_mfma_f32_16x16x32_bf16(B.h[kb][cb], al, acc[cb], 0, 0, 0);
        }
    }
#pragma unroll
    for (int cb = 0; cb < NCB; ++cb) *(LAS f32x4*)(part + (F.wave * 16 + fr) * 48 + cb * 16 + 4 * fq) = acc[cb];
}
struct RowPk { u32x2 v[4]; };
__device__ __forceinline__ RowPk ld_row_pk(const bf16_t* p, int lane) { RowPk r;
#pragma unroll
    for (int j = 0; j < 4; ++j) r.v[j] = *(const u32x2*)(p + 256 * j + 4 * lane); return r; }
__device__ __forceinline__ Row unpk_row(const RowPk& p) { Row r;
#pragma unroll
    for (int j = 0; j < 4; ++j) r.v[j] = (f32x4){lo16(p.v[j].x), hi16(p.v[j].x), lo16(p.v[j].y), hi16(p.v[j].y)}; return r; }
typedef _Float16 h16x2 __attribute__((ext_vector_type(2)));
__device__ __forceinline__ unsigned pkh2(float lo, float hi) { return __builtin_bit_cast(unsigned, __builtin_amdgcn_cvt_pkrtz(lo, hi)); }
__device__ __forceinline__ Row unpk_row_h(const RowPk& p) { Row r;
#pragma unroll
    for (int j = 0; j < 4; ++j) { const unsigned wx = p.v[j].x, wy = p.v[j].y;
        const h16x2 a = __builtin_bit_cast(h16x2, wx), b = __builtin_bit_cast(h16x2, wy); r.v[j] = (f32x4){(float)a[0], (float)a[1], (float)b[0], (float)b[1]}; } return r; }
__device__ __forceinline__ void st_row_h(bf16_t* p, int lane, const Row& r) {
#pragma unroll
    for (int j = 0; j < 4; ++j) { u32x2 w; w.x = pkh2(r.v[j][0], r.v[j][1]); w.y = pkh2(r.v[j][2], r.v[j][3]); *(u32x2*)(p + 256 * j + 4 * lane) = w; } }
__device__ __forceinline__ RowPk split_row(const Row& h, LAS bf16_t* ah, LAS bf16_t* al, int lane) { RowPk hp;
#pragma unroll
    for (int j = 0; j < 4; ++j) { unsigned hb[4], lb[4];
#pragma unroll
        for (int q = 0; q < 4; ++q) { hb[q] = f2bf(h.v[j][q]); lb[q] = f2bf(h.v[j][q] - __uint_as_float(hb[q] << 16)); }
        hp.v[j].x = hb[0] | (hb[1] << 16); hp.v[j].y = hb[2] | (hb[3] << 16);
        *(LAS u32x2*)(ah + 256 * j + 4 * lane) = hp.v[j]; u32x2 lw; lw.x = lb[0] | (lb[1] << 16); lw.y = lb[2] | (lb[3] << 16); *(LAS u32x2*)(al + 256 * j + 4 * lane) = lw; }
    return hp; }

template <bool DRY = false>
__device__ __forceinline__ void tok_a(Frame& F, int l) {
    const InTab in = F.in;
    const bf16_t* Y16 = (const bf16_t*)(F.ws + WS_Y16); bf16_t* Hb = (bf16_t*)(F.ws + WS_H2); bf16_t* XS = (bf16_t*)(F.ws + WS_XS);
    const bf16_t* RTH = (const bf16_t*)(F.ws + WS_RT) + (size_t)l * 48 * 1024; const bf16_t* RTL = RTH + (size_t)4 * 48 * 1024;
    float* gates = (float*)(F.ws + WS_GATE); int* asg = (int*)(F.ws + WS_ASG);
    LAS unsigned* lcnt = (LAS unsigned*)F.lds;
    LAS unsigned* ltab = (LAS unsigned*)(F.lds + 1024);
    LAS float* lgt = (LAS float*)(F.lds + 2048);
    LAS float* part = (LAS float*)(F.lds + 8192);
    LAS bf16_t* AH = (LAS bf16_t*)(F.lds + 32768); LAS bf16_t* AL = AH + 16 * APITCH;
    const Row lng = ld_row_f32(in[I_LNG] + (size_t)(l * 2 + 0) * 1024, F.lane), lnb = ld_row_f32(in[I_LNB] + (size_t)(l * 2 + 0) * 1024, F.lane);
    LAS f32x4* MODL = (LAS f32x4*)(F.lds + 98816);
    for (int blk = F.bid; blk < T / 128; blk += F.G) {
        if (F.tid < 64) lcnt[F.tid] = 0u;
        const int tb = blk * 128, b = tb / SEQ;
        const float* mod = (const float*)(F.ws + WS_MOD) + ((size_t)l * 8 + b) * 6144;
        if (F.wave < 3) {
#pragma unroll
            for (int j = 0; j < 4; ++j) MODL[(F.wave * 4 + j) * 64 + F.lane] = *(const f32x4*)(mod + (2 + F.wave) * 1024 + 256 * j + 4 * F.lane); }
        LBAR();
#define GT_(j) MODL[(0 * 4 + (j)) * 64 + F.lane]
#define SHF_(j) MODL[(1 * 4 + (j)) * 64 + F.lane]
#define SCF_(j) MODL[(2 * 4 + (j)) * 64 + F.lane]
        float rb0, rb1;
        { const int c0_ = F.tid % 48, c1_ = (F.tid + NTHR) % 48; rb0 = (c0_ < 4) ? in[I_BGRP][l * 4 + c0_] : (c0_ < 36 ? in[I_BEXP][l * 32 + (c0_ - 4)] : 0.f); rb1 = (c1_ < 4) ? in[I_BGRP][l * 4 + c1_] : (c1_ < 36 ? in[I_BEXP][l * 32 + (c1_ - 4)] : 0.f); }
        RowPk xr[2], yr[2];
#pragma unroll
        for (int q = 0; q < 2; ++q) { const int t = tb + 2 * F.wave + q; xr[q] = ld_row_pk(XS + (size_t)t * 1024, F.lane); yr[q] = ld_row_pk(Y16 + (size_t)t * 1024, F.lane); }
        SkB<3> SB; skinny_loadB<3>(F, RTH, RTL, SB);
        for (int r = 0; r < 8; ++r) {
#pragma unroll
            for (int q = 0; q < 2; ++q) {
                const int i = 2 * F.wave + q, t = tb + 16 * r + i;
                const Row y = unpk_row(yr[q]), xq = unpk_row_h(xr[q]); Row u;
#pragma unroll
                for (int j = 0; j < 4; ++j) u.v[j] = ALPHA * xq.v[j] + (1.0f + GT_(j)) * y.v[j];
                const Row x1 = row_ln(u, lng, lnb);
                if (!DRY) st_row_h(XS + (size_t)t * 1024, F.lane, x1);
                Row h;
#pragma unroll
                for (int j = 0; j < 4; ++j) h.v[j] = x1.v[j] * (1.0f + SCF_(j)) + SHF_(j);
                const RowPk hp = split_row(h, AH + i * APITCH, AL + i * APITCH, F.lane);
#pragma unroll
                for (int j = 0; j < 4; ++j) { if (!DRY) *(u32x2*)(Hb + (size_t)t * 1024 + 256 * j + 4 * F.lane) = hp.v[j]; }
            }
#if defined(TOKA_PROBE) && TOKA_PROBE == 2
            if (DRY) { if (r < 7) {
#pragma unroll
                for (int q = 0; q < 2; ++q) { const int t = tb + 16 * (r + 1) + 2 * F.wave + q; xr[q] = ld_row_pk(XS + (size_t)t * 1024, F.lane); yr[q] = ld_row_pk(Y16 + (size_t)t * 1024, F.lane); } }
                LBAR(); continue; }
#endif
            if (r < 7) {
#pragma unroll
                for (int q = 0; q < 2; ++q) { const int t = tb + 16 * (r + 1) + 2 * F.wave + q; xr[q] = ld_row_pk(XS + (size_t)t * 1024, F.lane); yr[q] = ld_row_pk(Y16 + (size_t)t * 1024, F.lane); }
            }
            LBAR();
            skinny_mma<3>(F, AH, AL, SB, part);
            LBAR();
#pragma unroll
            for (int oo = 0; oo < 2; ++oo) { const int o = F.tid + NTHR * oo; if (o < 16 * 48) { const int i = o / 48, c = o % 48; float sm = 0.f;
#pragma unroll
                for (int w = 0; w < 8; ++w) sm += part[(w * 16 + i) * 48 + c];
                lgt[o] = sm + (oo ? rb1 : rb0); } }
            LBAR();
            if (F.tid < 16) {
                const int i = F.tid, t = tb + 16 * r + i; const LAS float* lg = lgt + i * 48;
                const f32x4 lg4 = *(const LAS f32x4*)lg;
                int gs = 0; float gm = lg4[0];
#pragma unroll
                for (int c = 1; c < 4; ++c) if (lg4[c] > gm) { gm = lg4[c]; gs = c; }
                float den = 0.f;
#pragma unroll
                for (int c = 0; c < 4; ++c) den += __expf(lg4[c] - gm);
                const float pg = 1.0f / den;
                const f32x4 le0 = *(const LAS f32x4*)(lg + 4 + gs * 8), le1 = *(const LAS f32x4*)(lg + 8 + gs * 8);
                const float le[8] = {le0[0], le0[1], le0[2], le0[3], le1[0], le1[1], le1[2], le1[3]};
                int i0 = 0; float m0 = le[0];
#pragma unroll
                for (int c = 1; c < 8; ++c) if (le[c] > m0) { m0 = le[c]; i0 = c; }
                int i1 = -1; float m1 = -3.0e38f;
#pragma unroll
                for (int c = 0; c < 8; ++c) if (c != i0 && le[c] > m1) { m1 = le[c]; i1 = c; }
                const float a = __expf(m1 - m0), g0 = pg / (1.0f + a), g1 = pg * a / (1.0f + a);
                const int e0 = gs * 8 + i0, e1 = gs * 8 + i1;
                const unsigned r0 = atomicAdd((unsigned*)&lcnt[e0], 1u), r1 = atomicAdd((unsigned*)&lcnt[e1], 1u);
                ltab[(16 * r + i) * 2] = ((unsigned)e0 << 24) | r0; ltab[(16 * r + i) * 2 + 1] = ((unsigned)e1 << 24) | r1;
                if (!DRY) { gates[(size_t)t * 2] = g0; gates[(size_t)t * 2 + 1] = g1; }
            }
        }
        LBAR();
        if (F.tid < 32) lcnt[32 + F.tid] = DRY ? 0u : __hip_atomic_fetch_add((unsigned*)(F.ws + WS_CTL) + CW_CNT + l * 32 + F.tid, lcnt[F.tid], __ATOMIC_RELAXED, __HIP_MEMORY_SCOPE_AGENT);
        LBAR();
        if (F.tid < 256 && !DRY) { const unsigned w = ltab[F.tid]; const unsigned e = w >> 24; const unsigned rk = (w & 0xffffffu) + lcnt[32 + e]; asg[(size_t)tb * 2 + F.tid] = (int)((e << 24) | rk);
            ((int*)(F.ws + WS_TLIST))[(size_t)e * 65536 + rk] = tb + (F.tid >> 1); }
        LBAR();
    }
}
#undef GT_
#undef SHF_
#undef SCF_
__device__ __forceinline__ void fgate_phase(Frame& F) {
    const InTab in = F.in;
    const bf16_t* WFH = (const bf16_t*)(F.ws + WS_WF); const bf16_t* WFL = WFH + 16 * 1024; float* LF = (float*)(F.ws + WS_LF); const bf16_t* XS = (const bf16_t*)(F.ws + WS_XS);
    LAS float* part = (LAS float*)(F.lds + 8192);
    LAS bf16_t* AH = (LAS bf16_t*)(F.lds + 32768); LAS bf16_t* AL = AH + 16 * APITCH;
    for (int blk = F.bid; blk < T / 128; blk += F.G) {
        const int tb = blk * 128, b = tb / SEQ;
        const float* kvm = (const float*)(F.ws + WS_KVMOD) + (size_t)b * 2048;
        const Row ksh = ld_row_f32(kvm, F.lane), ksc = ld_row_f32(kvm + 1024, F.lane);
        RowPk xr[2];
#pragma unroll
        for (int q = 0; q < 2; ++q) xr[q] = ld_row_pk(XS + (size_t)(tb + 2 * F.wave + q) * 1024, F.lane);
        SkB<1> SBF; skinny_loadB<1>(F, WFH, WFL, SBF);
        LBAR();
        for (int r = 0; r < 8; ++r) {
#pragma unroll
            for (int q = 0; q < 2; ++q) { const int i = 2 * F.wave + q; Row hk; const Row xq = unpk_row_h(xr[q]);
#pragma unroll
                for (int j = 0; j < 4; ++j) hk.v[j] = xq.v[j] * (1.0f + ksc.v[j]) + ksh.v[j];
                (void)split_row(hk, AH + i * APITCH, AL + i * APITCH, F.lane); }
            if (r < 7) {
#pragma unroll
                for (int q = 0; q < 2; ++q) xr[q] = ld_row_pk(XS + (size_t)(tb + 16 * (r + 1) + 2 * F.wave + q) * 1024, F.lane);
            }
            LBAR();
            skinny_mma<1>(F, AH, AL, SBF, part);
            LBAR();
            if (F.tid < 256) { const int i = F.tid >> 4, c = F.tid & 15; float sm = 0.f;
#pragma unroll
                for (int w = 0; w < 8; ++w) sm += part[(w * 16 + i) * 48 + c];
                const float z = sm + in[I_KVFB][c]; LF[(size_t)(tb + 16 * r + i) * 16 + c] = fminf(z, 0.f) - log1pf(__expf(-fabsf(z))); }
        }
        LBAR();
    }
}

template <bool DRY = false>
__device__ __forceinline__ void tok_b(Frame& F, int l, int next) {
    const InTab in = F.in;
    bf16_t* Hb = (bf16_t*)(F.ws + WS_H2); bf16_t* HK = (bf16_t*)(F.ws + WS_RA); bf16_t* XS = (bf16_t*)(F.ws + WS_XS);
    const bf16_t* YM = (const bf16_t*)(F.ws + WS_RA + 144 * MiB);
    const int* asg = (const int*)(F.ws + WS_ASG); const float* gates = (const float*)(F.ws + WS_GATE); const LAS int* lc = (const LAS int*)(F.lds + MOE_LC_OFF);
    const Row lng = ld_row_f32(in[I_LNG] + (size_t)(l * 2 + 1) * 1024, F.lane), lnb = ld_row_f32(in[I_LNB] + (size_t)(l * 2 + 1) * 1024, F.lane);
    const int gw = F.bid * NWAVES + F.wave, NGW = F.G * NWAVES;
    for (int run = gw; run < T / 8; run += NGW) {
        const int t0 = run * 8, b = t0 / SEQ;
        const Row gt = ld_row_f32((const float*)(F.ws + WS_MOD) + ((size_t)l * 8 + b) * 6144 + 5 * 1024, F.lane);
        Row shm, scm;
        if (next < 3) { const float* modn = (const float*)(F.ws + WS_MOD) + ((size_t)(l + 1) * 8 + b) * 6144; shm = ld_row_f32(modn, F.lane); scm = ld_row_f32(modn + 1024, F.lane); }
        else { shm = Row{}; scm = Row{}; }
        int dmine = 0; float gmine = 0.f;
        if (F.lane < 16) { const unsigned a = (unsigned)asg[(size_t)t0 * 2 + F.lane]; dmine = lc[32 + (a >> 24)] + (int)(a & 0xffffffu); gmine = gates[(size_t)t0 * 2 + F.lane]; }
        RowPk xc = ld_row_pk(XS + (size_t)t0 * 1024, F.lane);
        RowPk y0c = ld_row_pk(YM + (size_t)__shfl(dmine, 0) * 1024, F.lane), y1c = ld_row_pk(YM + (size_t)__shfl(dmine, 1) * 1024, F.lane);
        for (int tt = 0; tt < 8; ++tt) {
            const int t = t0 + tt, tn = (tt < 7) ? tt + 1 : tt;
            const RowPk xn = ld_row_pk(XS + (size_t)(t0 + tn) * 1024, F.lane);
            const RowPk y0n = ld_row_pk(YM + (size_t)__shfl(dmine, 2 * tn) * 1024, F.lane), y1n = ld_row_pk(YM + (size_t)__shfl(dmine, 2 * tn + 1) * 1024, F.lane);
            const float g0 = __shfl(gmine, 2 * tt), g1 = __shfl(gmine, 2 * tt + 1);
            const Row y0 = unpk_row(y0c), y1 = unpk_row(y1c), xq = unpk_row_h(xc); Row u;
#pragma unroll
            for (int j = 0; j < 4; ++j) u.v[j] = ALPHA * xq.v[j] + (1.0f + gt.v[j]) * (g0 * y0.v[j] + g1 * y1.v[j]);
            const Row x2 = row_ln(u, lng, lnb);
            if (!DRY) { if (l == 3) st_row_f32(F.xs + (size_t)t * 1024, F.lane, x2); else st_row_h(XS + (size_t)t * 1024, F.lane, x2); } else asm volatile("" :: "v"(x2.v[0]), "v"(x2.v[1]), "v"(x2.v[2]), "v"(x2.v[3]));
            if (next != 3) {
                Row h;
#pragma unroll
                for (int j = 0; j < 4; ++j) h.v[j] = x2.v[j] * (1.0f + scm.v[j]) + shm.v[j];
                if (!DRY) st_row_bf16(Hb + (size_t)t * 1024, F.lane, h); else asm volatile("" :: "v"(h.v[0]), "v"(h.v[3]));
                if (next == 1) {
                    const float* kvm = (const float*)(F.ws + WS_KVMOD) + (size_t)b * 2048;
                    const Row ksh = ld_row_f32(kvm, F.lane), ksc = ld_row_f32(kvm + 1024, F.lane); Row hk;
#pragma unroll
                    for (int j = 0; j < 4; ++j) hk.v[j] = x2.v[j] * (1.0f + ksc.v[j]) + ksh.v[j];
                    if (!DRY) st_row_bf16(HK + (size_t)t * 1024, F.lane, hk); else asm volatile("" :: "v"(hk.v[0]), "v"(hk.v[3]));
                }
            }
            xc = xn; y0c = y0n; y1c = y1n;
        }
    }
}

__device__ __forceinline__ void rw_prep(Frame& F, int ln, bool from_input) {
    bf16_t* Hb = (bf16_t*)(F.ws + WS_H2); bf16_t* X3 = (bf16_t*)(F.ws + WS_SC);
    const float* src = F.in[I_X]; bf16_t* XS = (bf16_t*)(F.ws + WS_XS);
    const float* mu = F.in[I_MU] + (size_t)ln * 6 * 1024;
    const Row mur = ld_row_f32(mu, F.lane), muk = ld_row_f32(mu + 2 * 1024, F.lane), muv = ld_row_f32(mu + 3 * 1024, F.lane);
    const int gw = F.bid * NWAVES + F.wave, NGW = F.G * NWAVES;
    for (int run = gw; run < T / 8; run += NGW) {
        const int t0 = run * 8, b = t0 / SEQ;
        const float* modn = (const float*)(F.ws + WS_MOD) + ((size_t)ln * 8 + b) * 6144;
        const Row shm = ld_row_f32(modn, F.lane), scm = ld_row_f32(modn + 1024, F.lane);
        Row hprev;
#pragma unroll
        for (int j = 0; j < 4; ++j) hprev.v[j] = (f32x4){0.f, 0.f, 0.f, 0.f};
        if ((t0 % SEQ) != 0) {
            const Row xp = from_input ? ld_row_f32(src + (size_t)(t0 - 1) * 1024, F.lane) : unpk_row_h(ld_row_pk(XS + (size_t)(t0 - 1) * 1024, F.lane));
#pragma unroll
            for (int j = 0; j < 4; ++j) hprev.v[j] = xp.v[j] * (1.0f + scm.v[j]) + shm.v[j];
        }
        Row xc = Row{}; RowPk xcp = RowPk{};
        if (from_input) xc = ld_row_f32(src + (size_t)t0 * 1024, F.lane); else xcp = ld_row_pk(XS + (size_t)t0 * 1024, F.lane);
        for (int tt = 0; tt < 8; ++tt) {
            const int t = t0 + tt, tnx = t0 + (tt < 7 ? tt + 1 : tt);
            const Row x = from_input ? xc : unpk_row_h(xcp);
            if (from_input) xc = ld_row_f32(src + (size_t)tnx * 1024, F.lane); else xcp = ld_row_pk(XS + (size_t)tnx * 1024, F.lane);
            if (from_input) st_row_h(XS + (size_t)t * 1024, F.lane, x);
            Row h, xx, xr, xk, xv;
#pragma unroll
            for (int j = 0; j < 4; ++j) { h.v[j] = x.v[j] * (1.0f + scm.v[j]) + shm.v[j]; xx.v[j] = hprev.v[j] - h.v[j];
                xr.v[j] = h.v[j] + xx.v[j] * mur.v[j]; xk.v[j] = h.v[j] + xx.v[j] * muk.v[j]; xv.v[j] = h.v[j] + xx.v[j] * muv.v[j]; }
            st_row_bf16(Hb + (size_t)t * 2048, F.lane, h); st_row_bf16(Hb + (size_t)t * 2048 + 1024, F.lane, xx);
            st_row_bf16(X3 + (size_t)t * 1024, F.lane, xr); st_row_bf16(X3 + X3S + (size_t)t * 1024, F.lane, xk); st_row_bf16(X3 + 2 * X3S + (size_t)t * 1024, F.lane, xv);
            hprev = h;
        }
    }
}

__device__ __forceinline__ void moe_tables(Frame& F, int l) {
    LAS int* lc = (LAS int*)(F.lds + MOE_LC_OFF);
    const unsigned* cnt = (const unsigned*)(F.ws + WS_CTL) + CW_CNT + l * 32;
    if (F.tid == 0) {
        int acc = 0, ntt = 0;
        for (int e = 0; e < 32; ++e) { const int c = (int)__hip_atomic_load(cnt + e, __ATOMIC_RELAXED, __HIP_MEMORY_SCOPE_AGENT); lc[e] = c; lc[32 + e] = acc; const int nt = (c + 255) >> 8;
            for (int i = 0; i < nt; ++i) lc[96 + ntt + i] = (e << 16) | i;
            ntt += nt; acc += nt << 8; }
        lc[64] = ntt;
    }
    __syncthreads();
}
template <class Sched> __device__ __forceinline__ void moe_rows(Frame& F, const Sched& S) {
    const LAS int* lc = (const LAS int*)(F.lds + MOE_LC_OFF); LAS int* tokL = (LAS int*)(F.lds + MOE_TOKL_OFF); const int* tlist = (const int*)(F.ws + WS_TLIST);
    Unit u;
    for (int i = 0; i < 6 && S.next(i, u); ++i) {
        if (F.tid < 256) { const int ek = lc[96 + u.pm], e = ek >> 16, rank = ((ek & 0xffff) << 8) + F.tid;
            tokL[i * 256 + F.tid] = tlist[(size_t)e * 65536 + (rank < lc[e] ? rank : 0)]; }
    }
    __syncthreads();
}

__device__ __forceinline__ float octsum(float v) { v += dpp_f<0xB1>(v); v += dpp_f<0x4E>(v); v += dpp_f<0x141>(v); return v; }
constexpr int CP = 72, SLOT = 64 * CP;
#define PX(r_, c_) ((r_) * 64 + (((((c_) >> 3) ^ (((r_) >> 1) & 7))) << 3) + ((c_) & 7))
constexpr size_t WS_MP = WS_SC, WS_QQ = WS_SC + 64 * MiB, WS_NT = WS_SC + 128 * MiB, WS_GL = WS_SC + 192 * MiB;
template <bool SWAP> __device__ __forceinline__ f32x4 tile_mm(const LAS bf16_t* Ap, const LAS bf16_t* Bp, int fr, int fq) {
    const int o0 = PX(fr, 8 * fq), o1 = PX(fr, 8 * fq + 32);
    const bf16x8 a0 = *(const LAS bf16x8*)(Ap + o0), a1 = *(const LAS bf16x8*)(Ap + o1);
    const bf16x8 b0 = *(const LAS bf16x8*)(Bp + o0), b1 = *(const LAS bf16x8*)(Bp + o1);
    f32x4 acc = (f32x4){0.f, 0.f, 0.f, 0.f};
    if (!SWAP) { acc = __builtin_amdgcn_mfma_f32_16x16x32_bf16(a0, b0, acc, 0, 0, 0); acc = __builtin_amdgcn_mfma_f32_16x16x32_bf16(a1, b1, acc, 0, 0, 0); }
    else       { acc = __builtin_amdgcn_mfma_f32_16x16x32_bf16(b0, a0, acc, 0, 0, 0); acc = __builtin_amdgcn_mfma_f32_16x16x32_bf16(b1, a1, acc, 0, 0, 0); }
    return acc;
}
__device__ __forceinline__ void ld8f(const float* p, float (&o)[8]) { const f32x4 a = *(const f32x4*)p, b = *(const f32x4*)(p + 4); o[0] = a[0]; o[1] = a[1]; o[2] = a[2]; o[3] = a[3]; o[4] = b[0]; o[5] = b[1]; o[6] = b[2]; o[7] = b[3]; }
__device__ __forceinline__ void st4_lds(LAS bf16_t* p, f32x4 v) { u32x2 w; w.x = pk2(v[0], v[1]); w.y = pk2(v[2], v[3]); *(LAS u32x2*)p = w; }
__device__ __forceinline__ f32x4 ld4_lds(const LAS bf16_t* p) { const u32x2 w = *(const LAS u32x2*)p; return (f32x4){lo16(w.x), hi16(w.x), lo16(w.y), hi16(w.y)}; }
__device__ __forceinline__ void unpk8(const u32x4 w, float (&o)[8]) { o[0] = lo16(w.x); o[1] = hi16(w.x); o[2] = lo16(w.y); o[3] = hi16(w.y); o[4] = lo16(w.z); o[5] = hi16(w.z); o[6] = lo16(w.w); o[7] = hi16(w.w); }
__device__ __forceinline__ void st8_lds(LAS bf16_t* p, const float (&o)[8]) { u32x4 w; w.x = pk2(o[0], o[1]); w.y = pk2(o[2], o[3]); w.z = pk2(o[4], o[5]); w.w = pk2(o[6], o[7]); *(LAS u32x4*)p = w; }

template <int PROBE = 0>
__device__ __forceinline__ void wkv_chunk_prep(Frame& F, int l) {
    const InTab in = F.in;
    const bf16_t* RKV = (const bf16_t*)(F.ws + WS_RA);
    bf16_t* YS = (bf16_t*)(F.ws + WS_Y16); bf16_t* MP = (bf16_t*)(F.ws + WS_MP); bf16_t* QQ = (bf16_t*)(F.ws + WS_QQ); bf16_t* NTt = (bf16_t*)(F.ws + WS_NT); float* GLB = (float*)(F.ws + WS_GL);
    LAS bf16_t* L0 = (LAS bf16_t*)F.lds;
#define SL(n) (L0 + (n) * 4096)
    LAS float* WLs = (LAS float*)(F.lds + 8 * 8192);
    LAS float* SEG = WLs + 64 * 65;
    const int pt = F.tid >> 3, pc0 = 8 * (F.tid & 7);
    const bf16_t* LAg = (const bf16_t*)(F.ws + WS_RA + 192 * MiB); const bf16_t* VFg = (const bf16_t*)(F.ws + WS_P); float* BON = (float*)(F.ws + WS_LF);
    const bf16_t* W2T = (const bf16_t*)(F.ws + WS_LORA2 + (size_t)l * MiB + L2_W2T); const bf16_t* A2T = (const bf16_t*)(F.ws + WS_LORA2 + (size_t)l * MiB + L2_A2T); const bf16_t* V2T = (const bf16_t*)(F.ws + WS_LORA2 + (size_t)l * MiB + L2_V2T);
    u32x4 gr, gk, gv, glw, gla, glv, gvf, gw2, ga2, gv2;
#define PREP_LOAD(uu) do { const int bh_ = (uu) >> 6, c_ = (uu) & 63; const size_t row = (size_t)(bh_ >> 4) * SEQ + 64 * c_ + pt; const int hh = (bh_ & 15) * 64, hc = hh + pc0; \
        gr = *(const u32x4*)(RKV + row * 3072 + hc); gk = *(const u32x4*)(RKV + row * 3072 + 1024 + hc); gv = (l == 0) ? *(const u32x4*)(VFg + row * 1024 + hc) : *(const u32x4*)(RKV + row * 3072 + 2048 + hc); \
        glw = *(const u32x4*)(LAg + row * LAW + pc0); gla = *(const u32x4*)(LAg + row * LAW + 64 + pc0); \
        gw2 = *(const u32x4*)(W2T + (size_t)(hh + pt) * 64 + pc0); ga2 = *(const u32x4*)(A2T + (size_t)(hh + pt) * 64 + pc0); \
        if (l == 1) { glv = *(const u32x4*)(LAg + row * LAW + 288 + (pc0 & 31)); gvf = *(const u32x4*)(VFg + row * 1024 + hc); gv2 = *(const u32x4*)(V2T + (size_t)(hh + pt) * 64 + pc0); } } while (0)
    glv = (u32x4){0u, 0u, 0u, 0u}; gvf = glv; gv2 = glv;
    if (F.bid < 128 * 64) PREP_LOAD(F.bid);
    for (int u = F.bid; u < 128 * 64; u += F.G) {
        const int bh = u >> 6, c = u & 63, b = bh >> 4, h = bh & 15;
        const size_t row0 = (size_t)b * SEQ + 64 * c;
        int ln_ = F.lane; asm volatile("" : "+v"(ln_));
        const int fr = ln_ & 15, fq = ln_ >> 4;
        *(LAS u32x4*)(SL(0) + PX(pt, pc0)) = glw; *(LAS u32x4*)(SL(1) + PX(pt, pc0)) = gla; *(LAS u32x4*)(SL(3) + PX(pt, pc0)) = gw2; *(LAS u32x4*)(SL(4) + PX(pt, pc0)) = ga2;
        if (l == 1) { *(LAS u32x4*)(SL(2) + PX(pt, pc0)) = (pc0 < 32) ? glv : (u32x4){0u, 0u, 0u, 0u}; *(LAS u32x4*)(SL(5) + PX(pt, pc0)) = gv2; }
        LBAR();
        {
            f32x4 zw[2], za[2], zv[2];
#pragma unroll
            for (int i = 0; i < 2; ++i) { const int tile = F.wave + 8 * i, mt = tile >> 2, nt = tile & 3;
                zw[i] = tile_mm<false>(SL(0) + 16 * mt * 64, SL(3) + 16 * nt * 64, fr, fq);
                za[i] = tile_mm<true>(SL(1) + 16 * mt * 64, SL(4) + 16 * nt * 64, fr, fq);
                if (l == 1) zv[i] = tile_mm<true>(SL(2) + 16 * mt * 64, SL(5) + 16 * nt * 64, fr, fq); }
#pragma unroll
            for (int i = 0; i < 2; ++i) { const int tile = F.wave + 8 * i, mt = tile >> 2, nt = tile & 3; const int rr = 16 * mt + fr, cc = 16 * nt + 4 * fq;
                const float w0s = in[I_W0][l * 1024 + h * 64 + 16 * nt + fr]; const f32x4 a0v = *(const f32x4*)(in[I_A0] + l * 1024 + h * 64 + cc); f32x4 av, wh, wlo;
#pragma unroll
                for (int q = 0; q < 4; ++q) { const float wl_ = -0.6065306597126334f * sigmoidf_(zw[i][q] + w0s); wh[q] = bf2f((unsigned short)f2bf(wl_)); wlo[q] = wl_ - wh[q]; av[q] = sigmoidf_(za[i][q] + a0v[q]); }
                st4_lds(SL(11) + PX(16 * nt + fr, 16 * mt + 4 * fq), wh); st4_lds(SL(12) + PX(16 * nt + fr, 16 * mt + 4 * fq), wlo);
                st4_lds(SL(6) + PX(rr, cc), av);
                if (l == 1) { const f32x4 v0v = *(const f32x4*)(in[I_V0] + h * 64 + cc); f32x4 sv;
#pragma unroll
                    for (int q = 0; q < 4; ++q) sv[q] = sigmoidf_(zv[i][q] + v0v[q]);
                    st4_lds(SL(7) + PX(rr, cc), sv); } }
        }
        LBAR();
        float r[8], k[8], v[8], a[8];
        unpk8(gr, r); unpk8(gk, k); unpk8(gv, v); unpk8(*(const LAS u32x4*)(SL(6) + PX(pt, pc0)), a);
        if (l == 1) { float sv[8], vf[8]; unpk8(*(const LAS u32x4*)(SL(7) + PX(pt, pc0)), sv); unpk8(gvf, vf);
#pragma unroll
            for (int q = 0; q < 8; ++q) v[q] = bf2f((unsigned short)f2bf(v[q] + (vf[q] - v[q]) * sv[q]));
            if (PROBE == 0) { u32x4 w; w.x = pk2(v[0], v[1]); w.y = pk2(v[2], v[3]); w.z = pk2(v[4], v[5]); w.w = pk2(v[6], v[7]); *(u32x4*)((bf16_t*)RKV + (row0 + pt) * 3072 + 2048 + h * 64 + pc0) = w; } }
        {
            f32x4 cs[2];
#pragma unroll
            for (int i = 0; i < 2; ++i) { const int tile = F.wave + 8 * i, mt = tile >> 2, nt = tile & 3;
                bf16x8 l0, l1;
#pragma unroll
                for (int e = 0; e < 8; ++e) { l0[e] = (short)((8 * fq + e <= 16 * mt + fr) ? 0x3F80 : 0); l1[e] = (short)((32 + 8 * fq + e <= 16 * mt + fr) ? 0x3F80 : 0); }
                const int c0_ = PX(16 * nt + fr, 8 * fq), c1_ = PX(16 * nt + fr, 8 * fq + 32); const LAS bf16_t* bh = SL(11); const LAS bf16_t* bl = SL(12);
                f32x4 acc = (f32x4){0.f, 0.f, 0.f, 0.f};
                acc = __builtin_amdgcn_mfma_f32_16x16x32_bf16(*(const LAS bf16x8*)(bh + c0_), l0, acc, 0, 0, 0); acc = __builtin_amdgcn_mfma_f32_16x16x32_bf16(*(const LAS bf16x8*)(bh + c1_), l1, acc, 0, 0, 0);
                acc = __builtin_amdgcn_mfma_f32_16x16x32_bf16(*(const LAS bf16x8*)(bl + c0_), l0, acc, 0, 0, 0); acc = __builtin_amdgcn_mfma_f32_16x16x32_bf16(*(const LAS bf16x8*)(bl + c1_), l1, acc, 0, 0, 0);
                cs[i] = acc; }
#pragma unroll
            for (int i = 0; i < 2; ++i) { const int tile = F.wave + 8 * i, mt = tile >> 2, nt = tile & 3; const int rr = 16 * mt + fr, cc = 16 * nt + 4 * fq;
#pragma unroll
                for (int q = 0; q < 4; ++q) WLs[rr * 65 + cc + q] = cs[i][q]; }
        }
        LBAR();
        {
            float kkw[8], kaw[8], rkw[8]; ld8f(in[I_KK] + l * 1024 + h * 64 + pc0, kkw); ld8f(in[I_KA] + l * 1024 + h * 64 + pc0, kaw); ld8f(in[I_RK] + l * 1024 + h * 64 + pc0, rkw);
            float kr[8], ss = 0.f, bs = 0.f;
#pragma unroll
            for (int q = 0; q < 8; ++q) { kr[q] = k[q] * kkw[q]; ss += kr[q] * kr[q]; }
            ss = octsum(ss);
            const float inv = 1.0f / fmaxf(sqrtf(ss), 1e-12f);
            float At[8], Rt[8], Bt[8], Kt[8], Bb[8], Kb[8], gl[8];
#pragma unroll
            for (int q = 0; q < 8; ++q) {
                const float cum = WLs[pt * 65 + pc0 + q], cl = WLs[63 * 65 + pc0 + q], cex = (pt > 0) ? WLs[(pt - 1) * 65 + pc0 + q] : 0.f;
                const float e_in = __expf(cum), e_ex = __expf(cex), e_ng = __expf(-cum); gl[q] = __expf(cl);
                const float kk = kr[q] * inv, kp = k[q] * (1.0f + (a[q] - 1.0f) * kaw[q]); bs += r[q] * kp * rkw[q];
                At[q] = -kk * e_ex; Rt[q] = r[q] * e_in; Bt[q] = kk * a[q] * e_ng; Kt[q] = kp * e_ng; Bb[q] = Bt[q] * gl[q]; Kb[q] = Kt[q] * gl[q];
            }
            st8_lds(SL(0) + PX(pt, pc0), At); st8_lds(SL(1) + PX(pt, pc0), Rt); st8_lds(SL(2) + PX(pt, pc0), Bt); st8_lds(SL(3) + PX(pt, pc0), Kt);
            st8_lds(SL(11) + PX(pt, pc0), v); st8_lds(SL(12) + PX(pt, pc0), Bb); st8_lds(SL(13) + PX(pt, pc0), Kb);
            bs = octsum(bs); if ((F.tid & 7) == 0 && PROBE == 0) BON[(row0 + pt) * 16 + h] = bs;
            if (pt == 0 && PROBE == 0) { float* g = GLB + (size_t)u * 64 + pc0; *(f32x4*)g = (f32x4){gl[0], gl[1], gl[2], gl[3]}; *(f32x4*)(g + 4) = (f32x4){gl[4], gl[5], gl[6], gl[7]}; }
        }
        LBAR();
        {
            const int j = F.tid & 63, t0 = 8 * (F.tid >> 6);
#define TRANSP(src, dst) do { float e[8]; _Pragma("unroll") for (int q = 0; q < 8; ++q) e[q] = bf2f(SL(src)[PX(t0 + q, j)]); st8_lds(SL(dst) + PX(j, t0), e); } while (0)
            TRANSP(0, 6); TRANSP(12, 7); TRANSP(13, 5); TRANSP(11, 4);
#undef TRANSP
            if (u + F.G < 128 * 64) PREP_LOAD(u + F.G);
        }
        LBAR();
        if (PROBE == 1) continue;
        {
            f32x4 acc[8];
#pragma unroll
            for (int i = 0; i < 8; ++i) acc[i] = tile_mm<true>(SL(0) + 16 * i * 64, SL(2) + 16 * F.wave * 64, fr, fq);
            const int nt = F.wave, sq0 = (nt & 3) * 16 + 4 * fq;
#pragma unroll
            for (int i = 0; i < 8; ++i) {
                const int mt = i, tq = (mt & 3) * 16 + fr; f32x4 o;
#pragma unroll
                for (int q = 0; q < 4; ++q) { const int sq = sq0 + q; const bool keep = (mt < 4) ? (sq < tq) : (sq <= tq); o[q] = keep ? acc[i][q] : 0.f; }
                LAS bf16_t* dst = (mt < 4) ? ((nt < 4) ? SL(8) : SL(10)) : ((nt < 4) ? SL(11) : SL(12));
                st4_lds(dst + PX(tq, sq0), o);
                if (mt < 4 && nt < 4) {
#pragma unroll
                    for (int q = 0; q < 4; ++q) SL(9)[PX(sq0 + q, tq)] = (bf16_t)f2bf(o[q]); }
            }
        }
        LBAR();
        {
            f32x4 x[2], y1[2], nk[2];
#pragma unroll
            for (int i = 0; i < 2; ++i) { const int tile = F.wave + 8 * i, mt = tile >> 2, nt = tile & 3;
                x[i] = tile_mm<false>(SL(10) + 16 * mt * 64, SL(4) + 16 * nt * 64, fr, fq);
                y1[i] = tile_mm<true>(SL(12) + 16 * mt * 64, SL(4) + 16 * nt * 64, fr, fq);
                nk[i] = tile_mm<false>(SL(5) + 16 * mt * 64, SL(4) + 16 * nt * 64, fr, fq); }
#pragma unroll
            for (int i = 0; i < 2; ++i) { const int tile = F.wave + 8 * i, mt = tile >> 2, nt = tile & 3;
                st4_lds(SL(2) + PX(16 * nt + fr, 16 * mt + 4 * fq), x[i]);
                st4_lds(SL(3) + PX(16 * mt + fr, 16 * nt + 4 * fq), y1[i]);
                st4_lds(SL(0) + PX(16 * nt + fr, 16 * mt + 4 * fq), nk[i]); }
        }
        LBAR();
        if (PROBE == 2) continue;
#define NEU_SQ(Xn, Xt, On, Ot, WANT_NAT) do { f32x4 s_[2]; \
            _Pragma("unroll") for (int i = 0; i < 2; ++i) { const int tile = F.wave + 8 * i, mt = tile >> 2, nt = tile & 3; s_[i] = tile_mm<true>(SL(Xn) + 16 * mt * 64, SL(Xt) + 16 * nt * 64, fr, fq); } \
            _Pragma("unroll") for (int i = 0; i < 2; ++i) { const int tile = F.wave + 8 * i, mt = tile >> 2, nt = tile & 3; \
                if (WANT_NAT) st4_lds(SL(On) + PX(16 * mt + fr, 16 * nt + 4 * fq), s_[i]); \
                _Pragma("unroll") for (int q = 0; q < 4; ++q) SL(Ot)[PX(16 * nt + 4 * fq + q, 16 * mt + fr)] = (bf16_t)f2bf(s_[i][q]); } } while (0)
#define NEU_PR(Ti, Yt, To) do { f32x4 p_[2]; \
            _Pragma("unroll") for (int i = 0; i < 2; ++i) { const int tile = F.wave + 8 * i, mt = tile >> 2, nt = tile & 3; \
                p_[i] = tile_mm<true>(SL(Ti) + 16 * mt * 64, SL(Yt) + 16 * nt * 64, fr, fq) + ld4_lds(SL(Ti) + PX(16 * mt + fr, 16 * nt + 4 * fq)); } \
            _Pragma("unroll") for (int i = 0; i < 2; ++i) { const int tile = F.wave + 8 * i, mt = tile >> 2, nt = tile & 3; st4_lds(SL(To) + PX(16 * mt + fr, 16 * nt + 4 * fq), p_[i]); } } while (0)
#define NEU_BOTH(Ti, Yt, To, Xn, Xt, On, Ot, WANT_NAT) do { f32x4 p_[2], s_[2]; \
            _Pragma("unroll") for (int i = 0; i < 2; ++i) { const int tile = F.wave + 8 * i, mt = tile >> 2, nt = tile & 3; \
                p_[i] = tile_mm<true>(SL(Ti) + 16 * mt * 64, SL(Yt) + 16 * nt * 64, fr, fq) + ld4_lds(SL(Ti) + PX(16 * mt + fr, 16 * nt + 4 * fq)); \
                s_[i] = tile_mm<true>(SL(Xn) + 16 * mt * 64, SL(Xt) + 16 * nt * 64, fr, fq); } \
            _Pragma("unroll") for (int i = 0; i < 2; ++i) { const int tile = F.wave + 8 * i, mt = tile >> 2, nt = tile & 3; \
                st4_lds(SL(To) + PX(16 * mt + fr, 16 * nt + 4 * fq), p_[i]); \
                if (WANT_NAT) st4_lds(SL(On) + PX(16 * mt + fr, 16 * nt + 4 * fq), s_[i]); \
                _Pragma("unroll") for (int q = 0; q < 4; ++q) SL(Ot)[PX(16 * nt + 4 * fq + q, 16 * mt + fr)] = (bf16_t)f2bf(s_[i][q]); } } while (0)
        NEU_SQ(8, 9, 10, 12, true);
        LBAR();
        {
            f32x4 p_[2];
#pragma unroll
            for (int i = 0; i < 2; ++i) { const int tile = F.wave + 8 * i, mt = tile >> 2, nt = tile & 3; const int rr = 16 * mt + fr, cc = 16 * nt + 4 * fq;
                p_[i] = tile_mm<true>(SL(8) + 16 * mt * 64, SL(12) + 16 * nt * 64, fr, fq) + ld4_lds(SL(8) + PX(rr, cc)) + ld4_lds(SL(10) + PX(rr, cc));
#pragma unroll
                for (int q = 0; q < 4; ++q) if (cc + q == rr) p_[i][q] += 1.0f; }
            NEU_SQ(10, 12, 5, 13, true);
#pragma unroll
            for (int i = 0; i < 2; ++i) { const int tile = F.wave + 8 * i, mt = tile >> 2, nt = tile & 3; st4_lds(SL(4) + PX(16 * mt + fr, 16 * nt + 4 * fq), p_[i]); }
        }
        LBAR();
        NEU_BOTH(4, 13, 8, 5, 13, 9, 10, true);
        LBAR();
        NEU_BOTH(8, 10, 4, 9, 10, 5, 12, true);
        LBAR();
        NEU_BOTH(4, 12, 8, 5, 12, 5, 13, false);
        LBAR();
        NEU_PR(8, 13, 4);
        LBAR();
#undef NEU_SQ
#undef NEU_PR
#undef NEU_BOTH
        if (PROBE == 3) continue;
        {
            f32x4 p[2], u0[2];
#pragma unroll
            for (int i = 0; i < 2; ++i) { const int tile = F.wave + 8 * i, mt = tile >> 2, nt = tile & 3;
                p[i] = tile_mm<false>(SL(4) + 16 * mt * 64, SL(6) + 16 * nt * 64, fr, fq);
                u0[i] = tile_mm<false>(SL(4) + 16 * mt * 64, SL(2) + 16 * nt * 64, fr, fq); }
#pragma unroll
            for (int i = 0; i < 2; ++i) { const int tile = F.wave + 8 * i, mt = tile >> 2, nt = tile & 3;
                st4_lds(SL(9) + PX(16 * nt + fr, 16 * mt + 4 * fq), p[i]); st4_lds(SL(10) + PX(16 * nt + fr, 16 * mt + 4 * fq), u0[i]); }
        }
        LBAR();
        {
            f32x4 qv[2], y0[2], mp[2], ntv[2];
#pragma unroll
            for (int i = 0; i < 2; ++i) { const int tile = F.wave + 8 * i, mt = tile >> 2, nt = tile & 3; const int rr = 16 * mt + fr, cc = 16 * nt + 4 * fq, ri = 16 * nt + fr, cj = 16 * mt + 4 * fq;
                qv[i] = tile_mm<true>(SL(11) + 16 * mt * 64, SL(9) + 16 * nt * 64, fr, fq) + ld4_lds(SL(1) + PX(rr, cc));
                y0[i] = tile_mm<true>(SL(11) + 16 * mt * 64, SL(10) + 16 * nt * 64, fr, fq) + ld4_lds(SL(3) + PX(rr, cc));
                mp[i] = tile_mm<true>(SL(7) + 16 * mt * 64, SL(9) + 16 * nt * 64, fr, fq);
                ntv[i] = tile_mm<false>(SL(7) + 16 * mt * 64, SL(10) + 16 * nt * 64, fr, fq) + ld4_lds(SL(0) + PX(ri, cj)); }
#pragma unroll
            for (int i = 0; i < 2; ++i) { const int tile = F.wave + 8 * i, mt = tile >> 2, nt = tile & 3; const int rr = 16 * mt + fr, cc = 16 * nt + 4 * fq, ri = 16 * nt + fr, cj = 16 * mt + 4 * fq;
                st4_lds(SL(5) + PX(rr, cc), qv[i]); st4_lds(SL(8) + PX(rr, cc), y0[i]); st4_lds(SL(12) + PX(rr, cc), mp[i]); st4_lds(SL(13) + PX(ri, cj), ntv[i]); }
        }
        LBAR();
        if (PROBE == 0) {
            const int rw = F.tid >> 3, ch = 8 * (F.tid & 7);
            *(u32x4*)(QQ + ((size_t)u * 64 + rw) * 64 + ch) = *(const LAS u32x4*)(SL(5) + PX(rw, ch));
            *(u32x4*)(MP + ((size_t)u * 64 + rw) * 64 + ch) = *(const LAS u32x4*)(SL(12) + PX(rw, ch));
            *(u32x4*)(NTt + ((size_t)u * 64 + rw) * 64 + ch) = *(const LAS u32x4*)(SL(13) + PX(rw, ch));
            *(u32x4*)(YS + (row0 + rw) * 1024 + h * 64 + ch) = *(const LAS u32x4*)(SL(8) + PX(rw, ch));
        }
        LBAR();
    }
#undef PREP_LOAD
#undef SL
}

__device__ __forceinline__ void wkv_chunk_seq(Frame& F, int l) {
    bf16_t* YS = (bf16_t*)(F.ws + WS_Y16); const bf16_t* MP = (const bf16_t*)(F.ws + WS_MP); const bf16_t* QQ = (const bf16_t*)(F.ws + WS_QQ); const bf16_t* NTt = (const bf16_t*)(F.ws + WS_NT); const float* GLB = (const float*)(F.ws + WS_GL);
    LAS bf16_t* Zt = (LAS bf16_t*)F.lds;
    const bf16_t* RKVc = (const bf16_t*)(F.ws + WS_RA); const bf16_t* VFc = (const bf16_t*)(F.ws + WS_P); const bf16_t* G16 = (const bf16_t*)(F.ws + WS_RA + 224 * MiB); const float* BON = (const float*)(F.ws + WS_LF); bf16_t* OG = (bf16_t*)(F.ws + WS_H2);
    LAS bf16_t* Yb = Zt + 2 * SLOT;
    const int fr = F.lane & 15, fq = F.lane >> 4, mt = F.wave >> 1, ntb = 2 * (F.wave & 1);
    struct Ops { bf16x8 m0, m1, q0, q1; f32x4 gl; u32x2 n0, n1, y0, y1; };
    for (int item = F.bid; item < 128; item += F.G) {
        const int bh = item, b = bh >> 4, h = bh & 15; const size_t rowb = (size_t)b * SEQ;
        float gng[8], gnb[8]; ld8f(F.in[I_GNG] + l * 1024 + h * 64 + 8 * (F.tid & 7), gng); ld8f(F.in[I_GNB] + l * 1024 + h * 64 + 8 * (F.tid & 7), gnb);
        for (int i = F.tid; i < 2 * SLOT / 2; i += NTHR) ((LAS unsigned*)Zt)[i] = 0u;
        f32x4 Z0 = (f32x4){0.f, 0.f, 0.f, 0.f}, Z1 = Z0;
        LBAR();
#define SEQ_LOAD(O, cc_) do { const size_t cu = (size_t)bh * 64 + (cc_); \
        const bf16_t* mp = MP + (cu * 64 + 16 * mt + fr) * 64 + 8 * fq; O.m0 = *(const bf16x8*)mp; O.m1 = *(const bf16x8*)(mp + 32); \
        const bf16_t* qp = QQ + (cu * 64 + 16 * mt + fr) * 64 + 8 * fq; O.q0 = *(const bf16x8*)qp; O.q1 = *(const bf16x8*)(qp + 32); \
        O.gl = *(const f32x4*)(GLB + cu * 64 + 16 * mt + 4 * fq); \
        const bf16_t* np_ = NTt + (cu * 64 + 16 * ntb + fr) * 64 + 16 * mt + 4 * fq; O.n0 = *(const u32x2*)np_; O.n1 = *(const u32x2*)(np_ + 16 * 64); \
        const bf16_t* yp = YS + (rowb + 64 * (cc_) + 16 * mt + fr) * 1024 + h * 64 + 16 * ntb + 4 * fq; O.y0 = *(const u32x2*)yp; O.y1 = *(const u32x2*)(yp + 16); } while (0)
#define SEQ_STEP(O, cc_) do { const LAS bf16_t* Zc = Zt + ((cc_) & 1) * SLOT; LAS bf16_t* Zn = Zt + (((cc_) + 1) & 1) * SLOT; \
        const LAS bf16_t* z0p = Zc + (16 * ntb + fr) * CP + 8 * fq; const LAS bf16_t* z1p = z0p + 16 * CP; \
        const bf16x8 b00 = *(const LAS bf16x8*)z0p, b01 = *(const LAS bf16x8*)(z0p + 32), b10 = *(const LAS bf16x8*)z1p, b11 = *(const LAS bf16x8*)(z1p + 32); \
        f32x4 a0 = (f32x4){0.f, 0.f, 0.f, 0.f}, a1 = a0, c0 = a0, c1 = a0; \
        a0 = __builtin_amdgcn_mfma_f32_16x16x32_bf16(O.m0, b00, a0, 0, 0, 0); a0 = __builtin_amdgcn_mfma_f32_16x16x32_bf16(O.m1, b01, a0, 0, 0, 0); \
        a1 = __builtin_amdgcn_mfma_f32_16x16x32_bf16(O.m0, b10, a1, 0, 0, 0); a1 = __builtin_amdgcn_mfma_f32_16x16x32_bf16(O.m1, b11, a1, 0, 0, 0); \
        c0 = __builtin_amdgcn_mfma_f32_16x16x32_bf16(b00, O.q0, c0, 0, 0, 0); c0 = __builtin_amdgcn_mfma_f32_16x16x32_bf16(b01, O.q1, c0, 0, 0, 0); \
        c1 = __builtin_amdgcn_mfma_f32_16x16x32_bf16(b10, O.q0, c1, 0, 0, 0); c1 = __builtin_amdgcn_mfma_f32_16x16x32_bf16(b11, O.q1, c1, 0, 0, 0); \
        Z0 = O.gl * Z0 + a0 + (f32x4){lo16(O.n0.x), hi16(O.n0.x), lo16(O.n0.y), hi16(O.n0.y)}; Z1 = O.gl * Z1 + a1 + (f32x4){lo16(O.n1.x), hi16(O.n1.x), lo16(O.n1.y), hi16(O.n1.y)}; \
        { LAS bf16_t* yl = Yb + (((cc_) & 7) * 64 + 16 * mt + fr) * CP + 16 * ntb + 4 * fq; \
          st4_lds(yl, c0 + (f32x4){lo16(O.y0.x), hi16(O.y0.x), lo16(O.y0.y), hi16(O.y0.y)}); st4_lds(yl + 16, c1 + (f32x4){lo16(O.y1.x), hi16(O.y1.x), lo16(O.y1.y), hi16(O.y1.y)}); } \
        st4_lds(Zn + (16 * ntb + fr) * CP + 16 * mt + 4 * fq, Z0); st4_lds(Zn + (16 * ntb + 16 + fr) * CP + 16 * mt + 4 * fq, Z1); \
        LBAR(); \
        if (((cc_) & 7) == 7) { _Pragma("unroll 2") for (int i_ = 0; i_ < 8; ++i_) { const int o_ = F.tid + NTHR * i_, ck_ = o_ >> 9, rw_ = (o_ >> 3) & 63, ch_ = 8 * (o_ & 7); \
            const size_t tr_ = rowb + 64 * ((cc_) - 7 + ck_) + rw_; float y_[8], v_[8], g_[8]; \
            unpk8(*(const LAS u32x4*)(Yb + (ck_ * 64 + rw_) * CP + ch_), y_); unpk8((l == 0) ? *(const u32x4*)(VFc + tr_ * 1024 + h * 64 + ch_) : *(const u32x4*)(RKVc + tr_ * 3072 + 2048 + h * 64 + ch_), v_); unpk8(*(const u32x4*)(G16 + tr_ * 1024 + h * 64 + ch_), g_); \
            const float bs_ = BON[tr_ * 16 + h]; float s_ = 0.f; _Pragma("unroll") for (int q_ = 0; q_ < 8; ++q_) s_ += y_[q_]; s_ = octsum(s_); const float mean_ = s_ * (1.0f / 64.0f); \
            float qq_ = 0.f; _Pragma("unroll") for (int q_ = 0; q_ < 8; ++q_) { const float d_ = y_[q_] - mean_; qq_ += d_ * d_; } qq_ = octsum(qq_); const float rstd_ = 1.0f / sqrtf(qq_ * (1.0f / 64.0f) + GN_EPS); \
            float o8_[8]; _Pragma("unroll") for (int q_ = 0; q_ < 8; ++q_) o8_[q_] = (((y_[q_] - mean_) * rstd_) * gng[q_] + gnb[q_] + bs_ * v_[q_]) * g_[q_]; \
            u32x4 w_; w_.x = pk2(o8_[0], o8_[1]); w_.y = pk2(o8_[2], o8_[3]); w_.z = pk2(o8_[4], o8_[5]); w_.w = pk2(o8_[6], o8_[7]); *(u32x4*)(OG + tr_ * 1024 + h * 64 + ch_) = w_; } LBAR(); } } while (0)
        Ops A, B, C;
        SEQ_LOAD(A, 0); SEQ_LOAD(B, 1);
#pragma unroll 1
        for (int c = 0; c < 63; c += 3) {
            SEQ_LOAD(C, c + 2); SEQ_STEP(A, c);
            SEQ_LOAD(A, c + 3); SEQ_STEP(B, c + 1);
            if (c + 4 < 64) SEQ_LOAD(B, c + 4);
            SEQ_STEP(C, c + 2);
        }
        SEQ_STEP(A, 63);
#undef SEQ_LOAD
#undef SEQ_STEP
    }
}

__device__ __forceinline__ void ld16(const bf16_t* p, float (&o)[16]) {
    const u32x4 a = *(const u32x4*)p, b = *(const u32x4*)(p + 8);
    o[0] = lo16(a.x); o[1] = hi16(a.x); o[2] = lo16(a.y); o[3] = hi16(a.y); o[4] = lo16(a.z); o[5] = hi16(a.z); o[6] = lo16(a.w); o[7] = hi16(a.w);
    o[8] = lo16(b.x); o[9] = hi16(b.x); o[10] = lo16(b.y); o[11] = hi16(b.y); o[12] = lo16(b.z); o[13] = hi16(b.z); o[14] = lo16(b.w); o[15] = hi16(b.w);
}
__device__ __forceinline__ void st16(bf16_t* p, const float (&o)[16]) {
    u32x4 a, b; a.x = pk2(o[0], o[1]); a.y = pk2(o[2], o[3]); a.z = pk2(o[4], o[5]); a.w = pk2(o[6], o[7]); b.x = pk2(o[8], o[9]); b.y = pk2(o[10], o[11]); b.z = pk2(o[12], o[13]); b.w = pk2(o[14], o[15]);
    *(u32x4*)p = a; *(u32x4*)(p + 8) = b;
}
__device__ __forceinline__ void ld16f(const float* p, float (&o)[16]) {
#pragma unroll
    for (int j = 0; j < 4; ++j) { const f32x4 v = *(const f32x4*)(p + 4 * j); o[4 * j] = v[0]; o[4 * j + 1] = v[1]; o[4 * j + 2] = v[2]; o[4 * j + 3] = v[3]; }
}
__device__ __forceinline__ void wkv_post(Frame& F, int l) {
    const InTab in = F.in;
    const bf16_t* RKV = (const bf16_t*)(F.ws + WS_RA); const bf16_t* G16 = (const bf16_t*)(F.ws + WS_RA + 224 * MiB); const float* BON = (const float*)(F.ws + WS_LF);
    const bf16_t* YS = (const bf16_t*)(F.ws + WS_Y16); bf16_t* OG = (bf16_t*)(F.ws + WS_H2);
    const int c0 = 16 * F.lane;
    float gg[16], gb[16];
    ld16f(in[I_GNG] + l * 1024 + c0, gg); ld16f(in[I_GNB] + l * 1024 + c0, gb);
    const int gw = F.bid * NWAVES + F.wave, NGW = F.G * NWAVES;
    for (int t = gw; t < T; t += NGW) {
        float y[16], v[16], g[16];
        ld16(YS + (size_t)t * 1024 + c0, y); ld16(RKV + (size_t)t * 3072 + 2048 + c0, v); ld16(G16 + (size_t)t * 1024 + c0, g);
        const float bs = BON[(size_t)t * 16 + (F.lane >> 2)];
        float s = 0.f;
#pragma unroll
        for (int i = 0; i < 16; ++i) s += y[i];
        s = quadsum(s);
        const float mean = s * (1.0f / 64.0f); float q = 0.f;
#pragma unroll
        for (int i = 0; i < 16; ++i) { const float d = y[i] - mean; q += d * d; }
        q = quadsum(q);
        const float rstd = 1.0f / sqrtf(q * (1.0f / 64.0f) + GN_EPS);
        float o[16];
#pragma unroll
        for (int i = 0; i < 16; ++i) o[i] = (((y[i] - mean) * rstd) * gg[i] + gb[i] + bs * v[i]) * g[i];
        st16(OG + (size_t)t * 1024 + c0, o);
    }
}

__device__ __forceinline__ void kv_post(Frame& F) {
    const InTab in = F.in;
    bf16_t* Kb = (bf16_t*)(F.ws + WS_P); const float* LF = (const float*)(F.ws + WS_LF); float* KBv = (float*)(F.ws + WS_KB);
    const int c0 = 16 * F.lane;
    float kn[16]; ld16f(in[I_KNORM] + (c0 & 63), kn);
    const int gw = F.bid * NWAVES + F.wave, NGW = F.G * NWAVES;
    for (int t = gw; t < T; t += NGW) {
        float k[16]; ld16(Kb + (size_t)t * 1024 + c0, k);
        float s = 0.f;
#pragma unroll
        for (int i = 0; i < 16; ++i) s += k[i] * k[i];
        s = quadsum(s);
        const float rs = 1.0f / sqrtf(s * (1.0f / 64.0f) + QK_EPS);
#pragma unroll
        for (int i = 0; i < 16; ++i) k[i] = k[i] * rs * kn[i];
        st16(Kb + (size_t)t * 1024 + c0, k);
    }
    for (int bh = gw; bh < 128; bh += NGW) {
        const int b = bh >> 4, h = bh & 15; const size_t base = ((size_t)b * SEQ + 64 * F.lane) * 16 + h;
        float s = 0.f;
        for (int i = 0; i < 64; ++i) s += LF[base + (size_t)i * 16];
        float incl = s;
#pragma unroll
        for (int o = 1; o < 64; o <<= 1) { const float n = __shfl_up(incl, o); if (F.lane >= o) incl += n; }
        float run = incl - s;
        float kfirst = 0.f, klast = 0.f;
        for (int i = 0; i < 64; ++i) { run += LF[base + (size_t)i * 16]; const float kbv = -run * LOG2E; KBv[(size_t)bh * SEQ + 64 * F.lane + i] = kbv; if (i == 0) kfirst = kbv; klast = kbv; }
        int* T0 = (int*)(F.ws + WS_T0) + bh * 16;
        for (int qb = 0; qb < 16; ++qb) {
            const float thr = __shfl(kfirst, 4 * qb) - 70.0f;
            const unsigned long long skip = __ballot(klast < thr);
            int t0 = (skip == ~0ull) ? 64 : __builtin_ctzll(~skip); const int nt = 4 * qb + 4;
            t0 &= ~1; if (t0 > nt - 4) t0 = nt - 4;
            if (F.lane == 0) T0[qb] = t0;
        }
    }
}

namespace attn_body {
using bf16=__hip_bfloat16;
using bf16x8=__attribute__((ext_vector_type(8)))short;
using s16x4=__attribute__((ext_vector_type(4)))short;
using f32x16=__attribute__((ext_vector_type(16)))float;
using u32x4=__attribute__((ext_vector_type(4)))unsigned;
constexpr int BATCH=8,NHEAD=16,SEQ=4096,D=64,DM=NHEAD*D;
constexpr int NW=8,QBLK=32,QB=QBLK*NW,KVBLK=64,NQB=SEQ/QB;
constexpr int ATTN_PITCH=DM, ATTN_UNIT_ROWS=QB;
__device__ __forceinline__ int crow(int r,int hi){return (r&3)+8*(r>>2)+4*hi;}
#define SBAR() __builtin_amdgcn_sched_barrier(0)
__device__ __forceinline__ void cmask(f32x16&p0,f32x16&p1,int jb,int qrel,int hi){
  const float NEG=-INFINITY; int kb=64*jb+4*hi;
  #pragma unroll
  for(int r=0;r<16;++r){int kv=kb+(r&3)+8*(r>>2); if(kv>qrel)p0[r]=NEG; if(kv+32>qrel)p1[r]=NEG;}
}

constexpr int NSLOT=3, SLOTB=8192;
constexpr int LDS_K=0, LDS_V=NSLOT*SLOTB, LDS_WS=2*NSLOT*SLOTB, LDS_OST=LDS_WS+NW*64*4, LDS_KBIAS=LDS_OST+NW*4096, LDS_BYTES=LDS_KBIAS+SEQ*4;
constexpr float C2=0.125f*1.4426950408889634f;
__device__ __forceinline__ void glds16(const void*gsrc,unsigned lds_dst){unsigned keep;
  asm volatile("s_mov_b32 %0, m0\n\ts_mov_b32 m0, %2\n\ts_nop 0\n\tglobal_load_lds_dwordx4 %1, off\n\ts_mov_b32 m0, %0":"=&s"(keep):"v"(gsrc),"s"(lds_dst):"memory");}
__device__ __forceinline__ float max3f(float a,float b,float c){float r;asm("v_max3_f32 %0, %1, %2, %3":"=v"(r):"v"(a),"v"(b),"v"(c));return r;}
__device__ __forceinline__ float max2f(float a,float b){float r;asm("v_max_f32_e32 %0, %1, %2":"=v"(r):"v"(a),"v"(b));return r;}
__device__ __forceinline__ float fadd_s(float a,float b){float r;asm("v_add_f32_e32 %0, %1, %2":"=v"(r):"v"(a),"v"(b));return r;}
__device__ __forceinline__ float fsub_s(float a,float b){float r;asm("v_sub_f32_e32 %0, %1, %2":"=v"(r):"v"(a),"v"(b));return r;}
typedef float f32x2_t __attribute__((ext_vector_type(2))); typedef __bf16 bf16x2_t __attribute__((ext_vector_type(2)));
__device__ __forceinline__ unsigned cvtpk_s(float lo,float hi){f32x2_t v={lo,hi};bf16x2_t b=__builtin_convertvector(v,bf16x2_t);return __builtin_bit_cast(unsigned,b);}
#define WAIT_BAR(N) asm volatile("s_waitcnt vmcnt(" #N ") lgkmcnt(0)\n\ts_barrier":::"memory")

__device__ __forceinline__ void qkt(f32x16&p0,f32x16&p1,const char*Kslot,const bf16x8*qr,const f32x16&negm,int r32,int hi){
  const char*kb=Kslot+hi*1024+r32*16;
  #pragma unroll
  for(int d0=0;d0<4;++d0){
    const bf16x8 b0=*reinterpret_cast<const bf16x8*>(kb+d0*2048);
    const bf16x8 b1=*reinterpret_cast<const bf16x8*>(kb+d0*2048+512);
    if(d0==0){p0=__builtin_amdgcn_mfma_f32_32x32x16_bf16(b0,qr[0],negm,0,0,0);p1=__builtin_amdgcn_mfma_f32_32x32x16_bf16(b1,qr[0],negm,0,0,0);}
    else{p0=__builtin_amdgcn_mfma_f32_32x32x16_bf16(b0,qr[d0],p0,0,0,0);p1=__builtin_amdgcn_mfma_f32_32x32x16_bf16(b1,qr[d0],p1,0,0,0);}}
}
typedef __attribute__((address_space(3))) const char* lds_cptr;
typedef short v4i16_t __attribute__((ext_vector_type(4)));
__device__ __forceinline__ void kload8(bf16x8*kf,lds_cptr kp){
  kf[0]=*(const __attribute__((address_space(3))) bf16x8*)(kp);      kf[1]=*(const __attribute__((address_space(3))) bf16x8*)(kp+512);
  kf[2]=*(const __attribute__((address_space(3))) bf16x8*)(kp+2048); kf[3]=*(const __attribute__((address_space(3))) bf16x8*)(kp+2560);
  kf[4]=*(const __attribute__((address_space(3))) bf16x8*)(kp+4096); kf[5]=*(const __attribute__((address_space(3))) bf16x8*)(kp+4608);
  kf[6]=*(const __attribute__((address_space(3))) bf16x8*)(kp+6144); kf[7]=*(const __attribute__((address_space(3))) bf16x8*)(kp+6656);
}
__device__ __forceinline__ void kload2(bf16x8*kf,lds_cptr kp,int j){ kf[2*j]=*(const __attribute__((address_space(3))) bf16x8*)(kp+j*2048); kf[2*j+1]=*(const __attribute__((address_space(3))) bf16x8*)(kp+j*2048+512); }
__device__ __forceinline__ s16x4 vtr(lds_cptr p){ return __builtin_bit_cast(s16x4,__builtin_amdgcn_ds_read_tr16_b64_v4i16((__attribute__((address_space(3))) v4i16_t*)p)); }
__device__ __forceinline__ float rowmax(const f32x16&p0,const f32x16&p1){
  float a=max3f(p0[0],p0[1],p1[0]),b=max3f(p0[2],p0[3],p1[1]);a=max3f(a,p1[2],p1[3]);
  #pragma unroll
  for(int r=4;r<16;r+=4){a=max3f(a,p0[r],p0[r+1]);b=max3f(b,p0[r+2],p0[r+3]);a=max3f(a,p1[r],p1[r+1]);b=max3f(b,p1[r+2],p1[r+3]);}
  const float m=max2f(a,b);
  auto rr=__builtin_amdgcn_permlane32_swap(__float_as_uint(m),__float_as_uint(m),false,false);
  return max2f(__uint_as_float(rr[0]),__uint_as_float(rr[1]));
}
__device__ __forceinline__ void pv(f32x16*o,int vb,bf16x8 pa0,bf16x8 pa1,bf16x8 pa2,bf16x8 pa3){
  #pragma unroll
  for(int d0=0;d0<2;++d0){s16x4 lo[4],hi[4];
    #pragma unroll
    for(int ks=0;ks<4;++ks){
      asm volatile("ds_read_b64_tr_b16 %0,%1 offset:%c2":"=&v"(lo[ks]):"v"(vb),"i"(d0*4096+ks*1024):"memory");
      asm volatile("ds_read_b64_tr_b16 %0,%1 offset:%c2":"=&v"(hi[ks]):"v"(vb),"i"(d0*4096+ks*1024+512):"memory");}
    asm volatile("s_waitcnt lgkmcnt(0)":::"memory");SBAR();
    #define PK(k) (bf16x8){lo[k][0],lo[k][1],lo[k][2],lo[k][3],hi[k][0],hi[k][1],hi[k][2],hi[k][3]}
    o[d0]=__builtin_amdgcn_mfma_f32_32x32x16_bf16(pa0,PK(0),o[d0],0,0,0);
    o[d0]=__builtin_amdgcn_mfma_f32_32x32x16_bf16(pa1,PK(1),o[d0],0,0,0);
    o[d0]=__builtin_amdgcn_mfma_f32_32x32x16_bf16(pa2,PK(2),o[d0],0,0,0);
    o[d0]=__builtin_amdgcn_mfma_f32_32x32x16_bf16(pa3,PK(3),o[d0],0,0,0);
    #undef PK
  }
}

#ifndef ATTN_STORE16
#define ATTN_STORE16(p,v) (*(u32x4*)(p)=(v))
#endif
template<int THRL> __device__ __forceinline__ void attn_unit(int tid,int wid,int b,int h,int qb,int t0,const bf16*Q,const bf16*__restrict__ K,const bf16*__restrict__ V,bf16*O,const bf16*G,const float*kbrow,const float*qnorm,char*shm){
  int lane=tid&63; asm volatile("":"+v"(lane));
  const int r32=lane&31,hi=lane>>5; wid=__builtin_amdgcn_readfirstlane(wid);
  const long rowbase=(long)b*SEQ; const int q0=qb*QB;
  const bf16*Qw=Q+(rowbase+q0+wid*QBLK)*DM+h*D;
  const bf16*Kh=K+(rowbase+(long)t0*KVBLK)*DM+h*D,*Vh=V+(rowbase+(long)t0*KVBLK)*DM+h*D; kbrow+=t0*KVBLK;
  const unsigned lds0=(unsigned)(uintptr_t)shm;
  float*wsf=(float*)(shm+LDS_WS)+wid*64;
  const bf16*ksrc=Kh+(long)lane*DM+wid*8;
  const bf16*vsrc=Vh+(long)(16*(wid&3)+(lane>>2))*DM+(wid>>2)*32+(lane&3)*8;
  const unsigned kdst=lds0+LDS_K+wid*1024, vdst=lds0+LDS_V+wid*1024;
  #define DMA_K(t,slot) glds16(ksrc+(long)(t)*KVBLK*DM,(unsigned)__builtin_amdgcn_readfirstlane(kdst+(slot)))
  #define DMA_V(t,slot) glds16(vsrc+(long)(t)*KVBLK*DM,(unsigned)__builtin_amdgcn_readfirstlane(vdst+(slot)))
  const int vb0=(int)(lds0+LDS_V)+((lane>>4)&1)*32+(lane&3)*8+(4*hi+((lane&15)>>2))*64;
  const char*Kbase=shm+LDS_K; bf16x8 kf[8];
  const lds_cptr shm3=(lds_cptr)shm; const lds_cptr kp0=shm3+LDS_K+hi*1024+r32*16; const lds_cptr vp0=shm3+LDS_V+((lane>>4)&1)*32+(lane&3)*8+(4*hi+((lane&15)>>2))*64;
  const int NT=(q0+QB)/KVBLK-t0;
  typedef float f32x4_t __attribute__((ext_vector_type(4))); typedef __attribute__((address_space(3))) const float* lds_fptr;
  const lds_fptr kbl=(lds_fptr)(shm3+LDS_KBIAS);
  { __attribute__((address_space(3))) f32x4_t* kw=(__attribute__((address_space(3))) f32x4_t*)(shm3+LDS_KBIAS); const f32x4_t* kg=(const f32x4_t*)kbrow;
    for(int i=tid;i<NT*KVBLK/4;i+=NW*64) kw[i]=kg[i]; }
  DMA_K(0,0);DMA_V(0,0);DMA_K(1,SLOTB);
  bf16x8 qr[4];
  #pragma unroll
  for(int d0=0;d0<4;++d0)qr[d0]=*reinterpret_cast<const bf16x8*>(&Qw[(long)r32*DM+d0*16+hi*8]);
  { float qf[4][8]; float ss=0.f;
    #pragma unroll
    for(int d0=0;d0<4;++d0){
      #pragma unroll
      for(int j=0;j<8;++j){ qf[d0][j]=__uint_as_float(((unsigned)(unsigned short)qr[d0][j])<<16); ss+=qf[d0][j]*qf[d0][j]; } }
    { auto rr=__builtin_amdgcn_permlane32_swap(__float_as_uint(ss),__float_as_uint(ss),false,false); ss=__uint_as_float(rr[0])+__uint_as_float(rr[1]); }
    const float qs=C2/sqrtf(ss*(1.0f/64.0f)+1e-6f);
    #pragma unroll
    for(int d0=0;d0<4;++d0){ const float*qn=qnorm+d0*16+hi*8; u32x4 w;
      w[0]=cvtpk_s(qf[d0][0]*qs*qn[0],qf[d0][1]*qs*qn[1]); w[1]=cvtpk_s(qf[d0][2]*qs*qn[2],qf[d0][3]*qs*qn[3]); w[2]=cvtpk_s(qf[d0][4]*qs*qn[4],qf[d0][5]*qs*qn[5]); w[3]=cvtpk_s(qf[d0][6]*qs*qn[6],qf[d0][7]*qs*qn[7]);
      qr[d0]=__builtin_bit_cast(bf16x8,w); } }
  float mhat=0.f,l_reg=0.f;f32x16 o[2];o[0]=f32x16{};o[1]=f32x16{};const f32x16 negm=f32x16{};
  const int qrel=wid*QBLK+r32;
  #define CMASK(P0,P1,t) do{int jb_=(t)-(NT-4); if(jb_>=0)cmask(P0,P1,jb_,qrel,hi);}while(0)
  #define KBIAS(P0,P1,t) do{ const lds_fptr kp_=kbl+64*(t)+4*hi; \
    _Pragma("unroll") for(int g_=0;g_<4;++g_){ const f32x4_t a_=*(const __attribute__((address_space(3))) f32x4_t*)(kp_+8*g_)-mhat, b_=*(const __attribute__((address_space(3))) f32x4_t*)(kp_+32+8*g_)-mhat; \
      _Pragma("unroll") for(int j_=0;j_<4;++j_){ P0[4*g_+j_]+=a_[j_]; P1[4*g_+j_]+=b_[j_]; } } }while(0)
  bool resc=false;
  #define START(P0,P1) do{ const float rm=rowmax(P0,P1); resc=false; \
    { const float dl=rm; mhat=fadd_s(mhat,dl); \
      _Pragma("unroll") for(int r=0;r<16;++r){P0[r]=fsub_s(P0[r],dl);P1[r]=fsub_s(P1[r],dl);} } \
    _Pragma("unroll") for(int r=0;r<16;++r)P0[r]=__builtin_amdgcn_exp2f(P0[r]); }while(0)
  #define RESC() do{ if(resc){ asm volatile("s_waitcnt lgkmcnt(0)":::"memory"); \
      _Pragma("unroll") for(int d_=0;d_<2;++d_) _Pragma("unroll") for(int r=0;r<16;++r)o[d_][r]*=wsf[crow(r,hi)]; } }while(0)
  f32x16 pA0,pA1,pB0,pB1;
  int sl_prev=0,sl_cur=0,sl_next=SLOTB;
  #define ROT() do{sl_prev=sl_cur;sl_cur=sl_next;sl_next=(sl_next==(NSLOT-1)*SLOTB)?0:sl_next+SLOTB;}while(0)
  DMA_K(2,2*SLOTB);
  WAIT_BAR(3);
  qkt(pA0,pA1,Kbase,qr,negm,r32,hi);asm volatile("s_nop 15\n\ts_nop 7":"+v"(pA0),"+v"(pA1));KBIAS(pA0,pA1,0);CMASK(pA0,pA1,0);
  START(pA0,pA1);
  _Pragma("unroll") for(int r=0;r<16;++r)pA1[r]=__builtin_amdgcn_exp2f(pA1[r]);
  WAIT_BAR(0);
  DMA_K(3,0);DMA_V(1,SLOTB);
  ROT();
  kload8(kf,kp0+sl_cur);
  WAIT_BAR(2);
  s16x4 vlo[8],vhi[8]; u32x4 pw0,pw1,pw2,pw3;
  #define PKW(P,B) cvtpk_s(P[B],P[B+1])
  #define PAF(k) __builtin_bit_cast(bf16x8,pw##k)
  #define VFR(i) (bf16x8){vlo[i][0],vlo[i][1],vlo[i][2],vlo[i][3],vhi[i][0],vhi[i][1],vhi[i][2],vhi[i][3]}
  #define PIN(x) asm volatile("":"+v"(x))
  #define MX3(a,b,c) __builtin_fmaxf(__builtin_fmaxf((a),(b)),(c))
  #define GAPA(MF,A0,A1,A2,A3,W0,W1,PW) do{ MF; sacc+=A0; sacc+=A1; sacc+=A2; sacc+=A3; PIN(sacc); W0; W1; PIN(PW); SBAR(); }while(0)
  #define EX(v) __builtin_amdgcn_exp2f(v)
  #define GAPB(MF,X,B) do{ MF; X[B]=EX(X[B]); X[B+1]=EX(X[B+1]); X[B+2]=EX(X[B+2]); X[B+3]=EX(X[B+3]); PIN(X); SBAR(); }while(0)
  #define VRD(i) do{ vlo[i]=vtr(vp_+(((i)>>2)*4096+((i)&3)*1024)); vhi[i]=vtr(vp_+(((i)>>2)*4096+((i)&3)*1024+512)); }while(0)
  #define KRD(G,j) do{ if(G){ kload2(kf,kp0+sl_next,j); SBAR(); } }while(0)
  #define STEP(C0,C1,P0,P1,t,GK,GV,GL) do{ SBAR(); \
    const lds_cptr vp_=vp0+sl_prev; \
    VRD(0); SBAR(); float sacc=(P0[0]+P0[1]); \
    GAPA(C0=__builtin_amdgcn_mfma_f32_32x32x16_bf16(kf[0],qr[0],negm,0,0,0), P0[2],P0[3],P0[4],P0[5],     pw0[0]=PKW(P0,0), pw0[1]=PKW(P0,2), pw0); \
    VRD(4); SBAR(); GAPA(C1=__builtin_amdgcn_mfma_f32_32x32x16_bf16(kf[1],qr[0],negm,0,0,0), P0[6],P0[7],P0[8],P0[9],     pw0[2]=PKW(P0,4), pw0[3]=PKW(P0,6), pw0); \
    VRD(1); SBAR(); GAPA(C0=__builtin_amdgcn_mfma_f32_32x32x16_bf16(kf[2],qr[1],C0,0,0,0),   P0[10],P0[11],P0[12],P0[13], pw1[0]=PKW(P0,8), pw1[1]=PKW(P0,10), pw1); \
    VRD(5); SBAR(); GAPA(C1=__builtin_amdgcn_mfma_f32_32x32x16_bf16(kf[3],qr[1],C1,0,0,0),   P0[14],P0[15],P1[0],P1[1],   pw1[2]=PKW(P0,12),pw1[3]=PKW(P0,14), pw1); \
    VRD(2); SBAR(); GAPA(C0=__builtin_amdgcn_mfma_f32_32x32x16_bf16(kf[4],qr[2],C0,0,0,0),   P1[2],P1[3],P1[4],P1[5],     pw2[0]=PKW(P1,0), pw2[1]=PKW(P1,2), pw2); \
    VRD(6); SBAR(); GAPA(C1=__builtin_amdgcn_mfma_f32_32x32x16_bf16(kf[5],qr[2],C1,0,0,0),   P1[6],P1[7],P1[8],P1[9],     pw2[2]=PKW(P1,4), pw2[3]=PKW(P1,6), pw2); \
    VRD(3); SBAR(); GAPA(C0=__builtin_amdgcn_mfma_f32_32x32x16_bf16(kf[6],qr[3],C0,0,0,0),   P1[10],P1[11],P1[12],P1[13], pw3[0]=PKW(P1,8), pw3[1]=PKW(P1,10), pw3); \
    VRD(7); SBAR(); GAPA(C1=__builtin_amdgcn_mfma_f32_32x32x16_bf16(kf[7],qr[3],C1,0,0,0),   P1[14],P1[15],0.f,0.f,       pw3[2]=PKW(P1,12),pw3[3]=PKW(P1,14), pw3); \
    l_reg+=sacc; \
    if(GK){DMA_K((t)+3,sl_cur);} if(GV){DMA_V((t)+1,sl_next);} \
    KBIAS(C0,C1,t); CMASK(C0,C1,t); \
    { float a=MX3(C0[0],C0[1],C1[0]),b=MX3(C0[2],C0[3],C1[1]); a=MX3(a,C1[2],C1[3]); \
      _Pragma("unroll") for(int r=4;r<16;r+=4){a=MX3(a,C0[r],C0[r+1]);b=MX3(b,C0[r+2],C0[r+3]);a=MX3(a,C1[r],C1[r+1]);b=MX3(b,C1[r+2],C1[r+3]);} \
      float rm=__builtin_fmaxf(a,b); { auto rr=__builtin_amdgcn_permlane32_swap(__float_as_uint(rm),__float_as_uint(rm),false,false); rm=__builtin_fmaxf(__uint_as_float(rr[0]),__uint_as_float(rr[1])); } \
      resc=false; \
      if(__builtin_expect(__any(rm>(float)THRL),0)){ const float dl=__builtin_fmaxf(rm,0.f); mhat+=dl; \
        _Pragma("unroll") for(int r=0;r<16;++r){C0[r]-=dl;C1[r]-=dl;} \
        const float f=__builtin_amdgcn_exp2f(-dl); l_reg*=f; if(hi==0)wsf[r32]=f; resc=true; } } \
    SBAR(); \
    GAPB(o[0]=__builtin_amdgcn_mfma_f32_32x32x16_bf16(PAF(0),VFR(0),o[0],0,0,0), C0,0); \
    GAPB(o[1]=__builtin_amdgcn_mfma_f32_32x32x16_bf16(PAF(0),VFR(4),o[1],0,0,0), C0,4); \
    KRD(GL,0); GAPB(o[0]=__builtin_amdgcn_mfma_f32_32x32x16_bf16(PAF(1),VFR(1),o[0],0,0,0), C0,8); \
    KRD(GL,1); GAPB(o[1]=__builtin_amdgcn_mfma_f32_32x32x16_bf16(PAF(1),VFR(5),o[1],0,0,0), C0,12); \
    KRD(GL,2); GAPB(o[0]=__builtin_amdgcn_mfma_f32_32x32x16_bf16(PAF(2),VFR(2),o[0],0,0,0), C1,0); \
    KRD(GL,3); GAPB(o[1]=__builtin_amdgcn_mfma_f32_32x32x16_bf16(PAF(2),VFR(6),o[1],0,0,0), C1,4); \
    GAPB(o[0]=__builtin_amdgcn_mfma_f32_32x32x16_bf16(PAF(3),VFR(3),o[0],0,0,0), C1,8); \
    GAPB(o[1]=__builtin_amdgcn_mfma_f32_32x32x16_bf16(PAF(3),VFR(7),o[1],0,0,0), C1,12); \
    }while(0)
  int t=1;
  #undef CMASK
  #define CMASK(P0,P1,t) do{}while(0)
  for(;t+5<NT;t+=2){
    STEP(pB0,pB1,pA0,pA1,t,true,true,true);     WAIT_BAR(2); RESC(); ROT();
    STEP(pA0,pA1,pB0,pB1,t+1,true,true,true);   WAIT_BAR(2); RESC(); ROT();
  }
  #undef CMASK
  #define CMASK(P0,P1,t) do{int jb_=(t)-(NT-4); if(jb_>=0)cmask(P0,P1,jb_,qrel,hi);}while(0)
  #define ENDW(tt) do{ if((tt)+3<NT){WAIT_BAR(2);} else if((tt)+2<NT){WAIT_BAR(1);} else {WAIT_BAR(0);} }while(0)
  for(;t+1<NT;t+=2){
    STEP(pB0,pB1,pA0,pA1,t,(t+3<NT),(t+1<NT),(t+1<NT));       ENDW(t);   RESC(); ROT();
    STEP(pA0,pA1,pB0,pB1,t+1,(t+4<NT),(t+2<NT),(t+2<NT));     ENDW(t+1); RESC(); ROT();
  }
  STEP(pB0,pB1,pA0,pA1,NT-1,false,false,false); RESC();
  { float sacc=pB0[0]+pB0[1]; _Pragma("unroll") for(int r=2;r<16;++r)sacc+=pB0[r]; _Pragma("unroll") for(int r=0;r<16;++r)sacc+=pB1[r]; l_reg+=sacc;
    pw0=(u32x4){PKW(pB0,0),PKW(pB0,2),PKW(pB0,4),PKW(pB0,6)};pw1=(u32x4){PKW(pB0,8),PKW(pB0,10),PKW(pB0,12),PKW(pB0,14)};pw2=(u32x4){PKW(pB1,0),PKW(pB1,2),PKW(pB1,4),PKW(pB1,6)};pw3=(u32x4){PKW(pB1,8),PKW(pB1,10),PKW(pB1,12),PKW(pB1,14)};
    SBAR(); pv(o,vb0+sl_cur,PAF(0),PAF(1),PAF(2),PAF(3)); }
  #undef PKW
  #undef PAF
  #undef VFR
  #undef PIN
  #undef MX3
  #undef GAPA
  #undef GAPB
  #undef EX
  #undef VRD
  #undef KRD
  #undef STEP
  #undef ENDW
  {auto rr=__builtin_amdgcn_permlane32_swap(__float_as_uint(l_reg),__float_as_uint(l_reg),false,false);l_reg=__uint_as_float(rr[0])+__uint_as_float(rr[1]);}
  if(hi==0)wsf[32+r32]=l_reg;asm volatile("s_waitcnt lgkmcnt(0)":::"memory");
  float rli[16];
  #pragma unroll
  for(int r=0;r<16;++r)rli[r]=__builtin_amdgcn_rcpf(wsf[32+crow(r,hi)]);
  bf16*Ow=O+(rowbase+q0+wid*QBLK)*DM+h*D;
  { bf16*stg=(bf16*)(shm+LDS_OST)+wid*2048;
    #pragma unroll
    for(int r=0;r<16;++r){const int orow=crow(r,hi);
      #pragma unroll
      for(int d0=0;d0<2;++d0)stg[orow*64+d0*32+r32]=__float2bfloat16(o[d0][r]*rli[r]);}
    asm volatile("s_waitcnt lgkmcnt(0)":::"memory");
    const bf16*Gw=G+(rowbase+q0+wid*QBLK)*DM+h*D;
    #pragma unroll
    for(int i=0;i<4;++i){const int row=i*8+(lane>>3),ch=lane&7; u32x4 v=*(const u32x4*)(stg+row*64+ch*8); const u32x4 g=*(const u32x4*)(Gw+(long)row*DM+ch*8);
      #pragma unroll
      for(int q=0;q<4;++q) v[q]=cvtpk_s(__uint_as_float(v[q]<<16)*__uint_as_float(g[q]<<16),__uint_as_float(v[q]&0xffff0000u)*__uint_as_float(g[q]&0xffff0000u));
      ATTN_STORE16(Ow+(long)row*DM+ch*8,v);} }
  asm volatile("s_waitcnt lgkmcnt(0)\n\ts_barrier":::"memory");
  #undef DMA_K
  #undef DMA_V
  #undef CMASK
  #undef KBIAS
  #undef START
  #undef RESC
  #undef ROT
}
constexpr int ATTN_LDS_BYTES=LDS_BYTES;
struct AttnTensors { const bf16* Q; const bf16* K; const bf16* V; bf16* O; const bf16* G; const float* KB; const float* qnorm; };
template<int THRL=8> __device__ __forceinline__ void attn_phase(int tid,int wid,unsigned*ctr,const int*t0tab,volatile __attribute__((address_space(3))) int*bc,char*lds,const AttnTensors&T){
  for(;;){
    if(tid==0){ const int n_=(int)__hip_atomic_fetch_add(ctr,1u,__ATOMIC_RELAXED,__HIP_MEMORY_SCOPE_AGENT); bc[0]=n_; }
    asm volatile("s_waitcnt vmcnt(0) lgkmcnt(0)\n\ts_barrier":::"memory");
    const int n=__builtin_amdgcn_readfirstlane(bc[0]);
    if(n>=BATCH*NHEAD*NQB) break;
    const int qb=NQB-1-(n>>7), bh=n&127;
    const int t0=__builtin_amdgcn_readfirstlane(t0tab[bh*16+qb]);
    attn_unit<THRL>(tid,wid,bh/NHEAD,bh%NHEAD,qb,t0,T.Q,T.K,T.V,T.O,T.G,T.KB+(long)bh*SEQ,T.qnorm,lds);
  }
}
#undef SBAR
#undef WAIT_BAR
}
__device__ __forceinline__ void attn_simple(Frame& F, int j) {
    const InTab in = F.in;
    const bf16_t* Q = (const bf16_t*)(F.ws + WS_RA); const bf16_t* Gt = (const bf16_t*)(F.ws + WS_RA + 64 * MiB);
    const bf16_t* Kb = (const bf16_t*)(F.ws + WS_P); const bf16_t* Vb = (const bf16_t*)(F.ws + WS_P + 64 * MiB);
    const float* KBv = (const float*)(F.ws + WS_KB); bf16_t* OG = (bf16_t*)(F.ws + WS_H2 + 64 * MiB);
    const float* qn = in[I_QNORM] + j * 64;
    for (int item = F.bid; item < 1024; item += F.G) {
        const int bh = item >> 3, qb = item & 7, b = bh >> 4, h = bh & 15, t = qb * 512 + F.tid;
        const size_t row = (size_t)b * SEQ + t;
        float q[64];
        { const bf16_t* qp = Q + row * 1024 + h * 64; float ss = 0.f;
#pragma unroll
          for (int i = 0; i < 8; ++i) { const u32x4 w = *(const u32x4*)(qp + 8 * i);
              q[8 * i] = lo16(w.x); q[8 * i + 1] = hi16(w.x); q[8 * i + 2] = lo16(w.y); q[8 * i + 3] = hi16(w.y); q[8 * i + 4] = lo16(w.z); q[8 * i + 5] = hi16(w.z); q[8 * i + 6] = lo16(w.w); q[8 * i + 7] = hi16(w.w); }
#pragma unroll
          for (int i = 0; i < 64; ++i) ss += q[i] * q[i];
          const float rs = QC2 / sqrtf(ss * (1.0f / 64.0f) + QK_EPS);
#pragma unroll
          for (int i = 0; i < 64; ++i) q[i] = q[i] * rs * qn[i]; }
        float o[64];
#pragma unroll
        for (int i = 0; i < 64; ++i) o[i] = 0.f;
        float m = -1.0e30f, lsum = 0.f;
        const int smax = qb * 512 + F.wave * 64 + 63;
        const bf16_t* kp = Kb + ((size_t)b * SEQ) * 1024 + h * 64; const bf16_t* vp = Vb + ((size_t)b * SEQ) * 1024 + h * 64;
        const float* kbp = KBv + (size_t)bh * SEQ;
        for (int s = 0; s <= smax; ++s) {
            float dot = 0.f;
#pragma unroll
            for (int i = 0; i < 8; ++i) { const u32x4 w = *(const u32x4*)(kp + (size_t)s * 1024 + 8 * i);
                dot += q[8 * i] * lo16(w.x) + q[8 * i + 1] * hi16(w.x) + q[8 * i + 2] * lo16(w.y) + q[8 * i + 3] * hi16(w.y) + q[8 * i + 4] * lo16(w.z) + q[8 * i + 5] * hi16(w.z) + q[8 * i + 6] * lo16(w.w) + q[8 * i + 7] * hi16(w.w); }
            float x = dot + kbp[s];
            if (s > t) x = -1.0e30f;
            const float mn = fmaxf(m, x), corr = exp2f(m - mn), p = (s > t) ? 0.f : exp2f(x - mn);
            m = mn; lsum = lsum * corr + p;
#pragma unroll
            for (int i = 0; i < 8; ++i) { const u32x4 w = *(const u32x4*)(vp + (size_t)s * 1024 + 8 * i);
                o[8 * i] = o[8 * i] * corr + p * lo16(w.x); o[8 * i + 1] = o[8 * i + 1] * corr + p * hi16(w.x); o[8 * i + 2] = o[8 * i + 2] * corr + p * lo16(w.y); o[8 * i + 3] = o[8 * i + 3] * corr + p * hi16(w.y);
                o[8 * i + 4] = o[8 * i + 4] * corr + p * lo16(w.z); o[8 * i + 5] = o[8 * i + 5] * corr + p * hi16(w.z); o[8 * i + 6] = o[8 * i + 6] * corr + p * lo16(w.w); o[8 * i + 7] = o[8 * i + 7] * corr + p * hi16(w.w); }
        }
        const float il = 1.0f / lsum;
        const bf16_t* gp = Gt + row * 1024 + h * 64; bf16_t* op = OG + row * 1024 + h * 64;
#pragma unroll
        for (int i = 0; i < 8; ++i) { const u32x4 w = *(const u32x4*)(gp + 8 * i); u32x4 r;
            r.x = pk2(o[8 * i] * il * lo16(w.x), o[8 * i + 1] * il * hi16(w.x)); r.y = pk2(o[8 * i + 2] * il * lo16(w.y), o[8 * i + 3] * il * hi16(w.y));
            r.z = pk2(o[8 * i + 4] * il * lo16(w.z), o[8 * i + 5] * il * hi16(w.z)); r.w = pk2(o[8 * i + 6] * il * lo16(w.w), o[8 * i + 7] * il * hi16(w.w));
            *(u32x4*)(op + 8 * i) = r; }
    }
}

__device__ __forceinline__ void attn_fast(Frame& F, int j) {
    typedef attn_body::bf16 abf;
    const attn_body::AttnTensors AT{(const abf*)(F.ws + WS_RA), (const abf*)(F.ws + WS_P), (const abf*)(F.ws + WS_P + 64 * MiB), (abf*)(F.ws + WS_H2 + 64 * MiB), (const abf*)(F.ws + WS_RA + 64 * MiB),
                                    (const float*)(F.ws + WS_KB), F.in[I_QNORM] + j * 64};
    static_assert(attn_body::ATTN_LDS_BYTES <= 131072, "attention LDS");
    attn_body::attn_phase<8>(F.tid, F.wave, (unsigned*)(F.ws + WS_CTL) + CW_ATT + 64 * j, (const int*)(F.ws + WS_T0), (volatile LAS int*)(F.lds + MISC_OFF + 64), F.ldsg, AT);
}
__device__ __forceinline__ void relane(Frame& F) { int l_; asm volatile("v_mbcnt_lo_u32_b32 %0, -1, 0\n\tv_mbcnt_hi_u32_b32 %0, -1, %0" : "=v"(l_)); int w_ = F.wave; asm volatile("" : "+s"(w_)); F.wave = w_; F.lane = l_; F.tid = w_ * 64 + l_;
    GAS unsigned char* p_ = (GAS unsigned char*)F.ws; asm volatile("" : "+s"(p_)); F.ws = (unsigned char*)p_; GAS float* x_ = (GAS float*)F.xs; asm volatile("" : "+s"(x_)); F.xs = (float*)x_; }
#define GRID_BAR() (relane(F), xcd_barrier_fn(bar.bar, bar.x, bar.st, F.tid == 0))
#ifndef ONLY
#define ONLY (-1)
#endif
#ifndef REP_MASK
#define REP_MASK 0
#endif
#define ON(k) (relane(F), (ONLY < 0 || ONLY == (k)))
#define RUN(k, ...) do { for (int rep_ = 0; rep_ < (((REP_MASK >> (k)) & 1) ? 2 : 1); ++rep_) { if (ON(k)) { __VA_ARGS__; } if (REP_MASK) __syncthreads(); } } while (0)
template <int l> __device__ __forceinline__ void layer_body(Frame& F, const XcdBarrier& bar) {
    unsigned char* ws = F.ws;

        if (l < 2) {
#ifdef GPROBE
            { relane(F); SchedRKV S{{T / 256, 12, F.G, F.bid}};
#if GPROBE == 1
              EpiNone E{};
#else
              EpiPriv E{(bf16_t*)(ws + WS_RA), F.bid};
#endif
              gemm_fast(F, (const bf16_t*)(ws + WS_SC), 1024, (const bf16_t*)(ws + WS_RWBIG) + (size_t)l * 3072 * 1024, 1024, S, E); __syncthreads(); }
#endif
            RUN(2, SchedRKV S{{T / 256, 12, F.G, F.bid}}; EpiRKV E{(bf16_t*)(ws + WS_RA), (bf16_t*)(ws + WS_P), l};
              gemm_fast(F, (const bf16_t*)(ws + WS_SC), 1024, (const bf16_t*)(ws + WS_RWBIG) + (size_t)l * 3072 * 1024, 1024, S, E););
            RUN(21, SchedDense S{T / 256, 2, F.G, F.bid}; EpiLA E{(bf16_t*)(ws + WS_RA + 192 * MiB)};
              gemm_fast(F, (const bf16_t*)(ws + WS_H2), RWK, (const bf16_t*)(ws + WS_RWLORA) + (size_t)l * 512 * RWK, RWK, S, E););
            GRID_BAR();
            RUN(3, SchedDense S{T / 256, 4, F.G, F.bid}; EpiPlain E{(bf16_t*)(ws + WS_RA + 224 * MiB), 1024};
              gemm_fast(F, (const bf16_t*)(ws + WS_RA + 192 * MiB) + 128, LAW, (const bf16_t*)(ws + WS_LORA2 + (size_t)l * MiB + L2_G2T), G2K, S, E););
            RUN(4, wkv_chunk_prep<0>(F, l));
#ifdef PREP_PROBE
            relane(F); __syncthreads(); wkv_chunk_prep<PREP_PROBE>(F, l);
#endif
            GRID_BAR();
            RUN(20, wkv_chunk_seq(F, l)); RUN(19, moe_convert(F, l, 128, F.G - 128));
            GRID_BAR();
            RUN(6, SchedDense S{T / 256, 4, F.G, F.bid}; EpiPlain E{(bf16_t*)(ws + WS_Y16), 1024};
              gemm_fast(F, (const bf16_t*)(ws + WS_H2), 1024, (const bf16_t*)(ws + WS_RWWO) + (size_t)l * 1024 * 1024, 1024, S, E););
            GRID_BAR();
        } else {
            const int j = l - 2;
            RUN(7, SchedDense S{T / 256, 8, F.G, F.bid}; EpiSplit2 E{(bf16_t*)(ws + WS_RA), (bf16_t*)(ws + WS_RA + 64 * MiB), 1};
              gemm_fast(F, (const bf16_t*)(ws + WS_H2), 1024, (const bf16_t*)(ws + WS_FXQG) + (size_t)j * 2048 * 1024, 1024, S, E););
            GRID_BAR();
            RUN(19, moe_convert(F, l, F.G - 64, 64));
            RUN(8, attn_fast(F, j));
            GRID_BAR();
            RUN(9, SchedDense S{T / 256, 4, F.G, F.bid}; EpiPlain E{(bf16_t*)(ws + WS_Y16), 1024};
              gemm_fast(F, (const bf16_t*)(ws + WS_H2 + 64 * MiB), 1024, (const bf16_t*)(ws + WS_FXWO) + (size_t)j * 1024 * 1024, 1024, S, E););
            GRID_BAR();
        }
#ifdef TOKA_PROBE
        relane(F); tok_a<true>(F, l); __syncthreads();
#endif
#ifdef BAR_PROBE
        for (int bi_ = 0; bi_ < 5; ++bi_) GRID_BAR();
#endif
        RUN(10, tok_a<false>(F, l));
        GRID_BAR();
        {
            const LAS int* lc = (const LAS int*)(F.lds + MOE_LC_OFF);
            const bf16_t* W1T = (const bf16_t*)(ws + WS_MOE); const bf16_t* W2T = W1T + (size_t)32 * 1024 * 1024;
            relane(F); moe_tables(F, l);
            { SchedMoe S{lc + 96, lc[64], F.G, F.bid, (size_t)1024 * 1024}; moe_rows(F, S); EpiMoe1 E{(bf16_t*)(ws + WS_HM)};
              RUN(12, gemm_fast<EpiMoe1, SchedMoe, true>(F, (const bf16_t*)(ws + WS_H2), 1024, W1T, 1024, S, E, (const LAS int*)(F.lds + MOE_TOKL_OFF))); }
            GRID_BAR();
            { SchedMoe S{lc + 96, lc[64], F.G, F.bid, (size_t)1024 * 512}; EpiPlain E{(bf16_t*)(ws + WS_RA + 144 * MiB), 1024};
              RUN(13, gemm_fast(F, (const bf16_t*)(ws + WS_HM), 512, W2T, 512, S, E)); }
            GRID_BAR();
        }
#ifdef TOKB_PROBE
        relane(F); tok_b<true>(F, l, l == 1 ? 1 : (l == 2 ? 2 : 3)); __syncthreads();
#endif
        RUN(14, tok_b<false>(F, l, l == 1 ? 1 : (l == 2 ? 2 : 3)));
        if (l == 3) return;
        GRID_BAR();
        if (l == 0) { RUN(1, rw_prep(F, 1, false)); GRID_BAR(); }
        if (l == 1) {
            RUN(18, fgate_phase(F));
            RUN(15, SchedDense S{T / 256, 8, F.G, F.bid}; EpiSplit2 E{(bf16_t*)(ws + WS_P), (bf16_t*)(ws + WS_P + 64 * MiB), 0};
              gemm_fast(F, (const bf16_t*)(ws + WS_RA), 1024, (const bf16_t*)(ws + WS_KVW), 1024, S, E););
            GRID_BAR();
            RUN(16, kv_post(F));
            GRID_BAR();
        }
}
__global__ void __launch_bounds__(NTHR, 2) yoco_fwd(Args args) {
    extern __shared__ __attribute__((aligned(16))) unsigned char lds[];
    Frame F;
    F.lds = (LAS unsigned char*)lds; F.ldsg = (char*)lds; F.ws = args.ws; F.xs = args.out; F.in.p = args.in;
    F.tid = threadIdx.x; F.lane = F.tid & 63; F.wave = __builtin_amdgcn_readfirstlane(F.tid >> 6); F.G = gridDim.x; F.bid = blockIdx.x;
    volatile LAS unsigned* MISC = (volatile LAS unsigned*)(F.lds + MISC_OFF);
    if (F.tid < 32) MISC[F.tid] = 0u;
    __syncthreads();
    XcdBarrier bar = xcd_barrier_post((unsigned*)(F.ws + WS_CTL) + CW_BAR, MISC + 8);
    unsigned char* ws = F.ws;
    RUN(0, p0_prologue(F));
    GRID_BAR();
    RUN(1, rw_prep(F, 0, true));
    GRID_BAR();
    layer_body<0>(F, bar); layer_body<1>(F, bar); layer_body<2>(F, bar); layer_body<3>(F, bar);
}

extern "C" void kernel_launch(void* const* d_in, const int* in_sizes, int n_in, void* d_out, int out_size, void* d_ws, size_t ws_size, hipStream_t stream) {
    static int grid = 0;
    if (grid == 0) {
        if (n_in != 40 || out_size != T * D || ws_size < WS_END) { fprintf(stderr, "kernel_launch: unexpected shapes (n_in %d out %d ws %zu)\n", n_in, out_size, ws_size); grid = -1; return; }
        int dev = 0, cus = 0, per_cu = 0;
        if (hipGetDevice(&dev) != hipSuccess || hipDeviceGetAttribute(&cus, hipDeviceAttributeMultiprocessorCount, dev) != hipSuccess) { grid = -1; return; }
        if (hipFuncSetAttribute((const void*)yoco_fwd, hipFuncAttributeMaxDynamicSharedMemorySize, LDS_BYTES) != hipSuccess) { fprintf(stderr, "kernel_launch: hipFuncSetAttribute failed\n"); grid = -1; return; }
        if (hipOccupancyMaxActiveBlocksPerMultiprocessor(&per_cu, (const void*)yoco_fwd, NTHR, LDS_BYTES) != hipSuccess || per_cu < 1) fprintf(stderr, "kernel_launch: occupancy query reports %d\n", per_cu);
        (void)hipGetLastError();
        grid = cus;
        if (grid != 256) { fprintf(stderr, "kernel_launch: built for 256 CUs, found %d\n", cus); grid = -1; return; }
    }
    if (grid < 0) return;
    (void)hipMemsetAsync((char*)d_ws + WS_CTL, 0, CTL_BYTES, stream);
    Args a{};
    for (int i = 0; i < 40; ++i) a.in[i] = (const float*)d_in[i];
    a.out = (float*)d_out; a.ws = (unsigned char*)d_ws; a.ph_lo = 0; a.ph_hi = 0;
    hipLaunchKernelGGL(yoco_fwd, dim3(grid), dim3(NTHR), LDS_BYTES, stream, a);
}
```

```cpp
#include <hip/hip_runtime.h>
#include <cstdio>
#include <cstdint>
#include <hip/hip_bf16.h>
#include <cmath>

#define GAS __attribute__((address_space(1)))
#define LAS __attribute__((address_space(3)))
typedef unsigned short bf16_t;
typedef short bf16x8 __attribute__((ext_vector_type(8)));
typedef float f32x4 __attribute__((ext_vector_type(4)));
typedef float f32x2 __attribute__((ext_vector_type(2)));
typedef unsigned u32x4 __attribute__((ext_vector_type(4)));
typedef unsigned u32x2 __attribute__((ext_vector_type(2)));
typedef GAS unsigned gu32;

constexpr int NB = 8, SEQ = 4096, T = NB * SEQ, D = 1024, NH = 16, HD = 64;
constexpr int NWAVES = 8, NTHR = NWAVES * 64;
constexpr float ALPHA = 1.681792830507429f;
constexpr float LN_EPS = 1e-5f, GN_EPS = 64e-5f, QK_EPS = 1e-6f;
constexpr float LOG2E = 1.4426950408889634f;
constexpr float QC2 = 0.125f * LOG2E;
constexpr int RWK = 2048;
constexpr int LAW = 512;
constexpr int G2K = 256;
constexpr int XS_ROWS = 73728;

constexpr size_t MiB = 1u << 20;
constexpr size_t WS_CTL = 0, CTL_BYTES = 1 * MiB;
constexpr size_t WS_MOD = 1 * MiB;
constexpr size_t WS_KVMOD = WS_MOD + 4 * 8 * 6144 * 4;
constexpr size_t WS_RT = 2 * MiB;
constexpr size_t WS_WF = WS_RT + 768 * 1024;
constexpr size_t WS_KB = 3 * MiB;
constexpr size_t WS_LF = 5 * MiB;
constexpr size_t WS_ASG = 7 * MiB;
constexpr size_t WS_GATE = WS_ASG + 256 * 1024;
constexpr size_t WS_DEST = WS_GATE + 256 * 1024;
constexpr size_t WS_TEXP = WS_DEST + 256 * 1024;
constexpr size_t WS_T0 = WS_TEXP + 4096;
constexpr size_t WS_RWBIG = 16 * MiB;
constexpr size_t WS_RWLORA = 28 * MiB;
constexpr size_t WS_LORA2 = 44 * MiB;
constexpr size_t L2_G2T = 0, L2_W2T = 512 * 1024, L2_A2T = 640 * 1024, L2_V2T = 768 * 1024;
constexpr size_t WS_RWWO = 50 * MiB;
constexpr size_t WS_KVW = 54 * MiB;
constexpr size_t WS_FXQG = 58 * MiB;
constexpr size_t WS_FXWO = 66 * MiB;
constexpr size_t WS_MOE = 72 * MiB;
constexpr size_t WS_SC = 168 * MiB;
constexpr size_t X3S = (size_t)T * 1024;
constexpr size_t WS_XS = WS_SC + 200 * MiB;
constexpr size_t WS_P = 456 * MiB;
constexpr size_t WS_Y16 = 584 * MiB;
constexpr size_t WS_H2 = 648 * MiB;
constexpr size_t WS_RA = 776 * MiB;
constexpr size_t WS_HM = WS_RA;
constexpr size_t WS_TLIST = WS_RA + 80 * MiB;
constexpr size_t WS_END = 1064 * MiB;
constexpr int CW_BAR = 4096;
constexpr int CW_CNT = 16384;
constexpr int CW_ATT = 16640;

constexpr int LDS_BYTES = 147456;
constexpr int MISC_OFF = 131072 + 320;
constexpr int MOE_LC_OFF = MISC_OFF + 256;
constexpr int MOE_TOKL_OFF = MISC_OFF + 2048;
__device__ __forceinline__ float bf2f(unsigned short b) { return __uint_as_float((unsigned)b << 16); }
typedef float f32x2_cv __attribute__((ext_vector_type(2))); typedef __bf16 bf16x2_cv __attribute__((ext_vector_type(2)));
__device__ __forceinline__ unsigned pk2(float lo, float hi) { const f32x2_cv v = {lo, hi}; return __builtin_bit_cast(unsigned, __builtin_convertvector(v, bf16x2_cv)); }
__device__ __forceinline__ unsigned f2bf(float f) { return pk2(f, 0.f) & 0xffffu; }
__device__ __forceinline__ float lo16(unsigned w) { return __uint_as_float(w << 16); }
__device__ __forceinline__ float hi16(unsigned w) { return __uint_as_float(w & 0xffff0000u); }
__device__ __forceinline__ float sigmoidf_(float x) { return __builtin_amdgcn_rcpf(1.0f + __expf(-x)); }
__device__ __forceinline__ float tanhf_(float x) { const float e = __expf(2.0f * x); return 1.0f - 2.0f * __builtin_amdgcn_rcpf(e + 1.0f); }
template <int CTRL> __device__ __forceinline__ float dpp_f(float v) {
    return __builtin_bit_cast(float, __builtin_amdgcn_update_dpp(0, __builtin_bit_cast(int, v), CTRL, 0xF, 0xF, true));
}
__device__ __forceinline__ float wave_sum(float v) {
    v += dpp_f<0xB1>(v); v += dpp_f<0x4E>(v); v += dpp_f<0x141>(v); v += dpp_f<0x140>(v);
    const int vi = __builtin_bit_cast(int, v);
    const float s0 = __builtin_bit_cast(float, __builtin_amdgcn_readlane(vi, 0)), s1 = __builtin_bit_cast(float, __builtin_amdgcn_readlane(vi, 16)), s2 = __builtin_bit_cast(float, __builtin_amdgcn_readlane(vi, 32)), s3 = __builtin_bit_cast(float, __builtin_amdgcn_readlane(vi, 48));
    return (s0 + s1) + (s2 + s3);
}
__device__ __forceinline__ float quadsum(float v) { v += dpp_f<0xB1>(v); v += dpp_f<0x4E>(v); return v; }
__device__ __forceinline__ float rowsum16(float v) { v += dpp_f<0xB1>(v); v += dpp_f<0x4E>(v); v += dpp_f<0x141>(v); v += dpp_f<0x140>(v); return v; }
#define LDS_WAIT() asm volatile("s_waitcnt lgkmcnt(0)" ::: "memory")
#define LBAR() do { asm volatile("s_waitcnt lgkmcnt(0)" ::: "memory"); __builtin_amdgcn_s_barrier(); asm volatile("" ::: "memory"); } while (0)

#define XB_TMO      128
#define XB_XCNT(j)  (256  + 64 * (j))
#define XB_XSUB(j)  (1280 + 64 * (j))
#define XB_XGEN(j)  (2304 + 64 * (j))
#define XB_TOP      3328
#define XB_TOPGEN   3392
#define XCD_BAR_WORDS 3456
#define XB_SPIN_CAP (1u << 22)
__device__ __forceinline__ unsigned xb_ld(unsigned* p)              { return __hip_atomic_load(p, __ATOMIC_RELAXED, __HIP_MEMORY_SCOPE_AGENT); }
__device__ __forceinline__ unsigned xb_add(unsigned* p, unsigned v) { return __hip_atomic_fetch_add(p, v, __ATOMIC_RELAXED, __HIP_MEMORY_SCOPE_AGENT); }
__device__ __forceinline__ unsigned xb_xcc_id() { return (unsigned)__builtin_amdgcn_s_getreg((3 << 11) | 20) & 0xFu; }
#define XB_SPIN(cond, bar) do { unsigned _sp = 0; while (cond) { __builtin_amdgcn_s_sleep(1); \
    if ((++_sp & 255u) == 0u) { if (xb_ld(&(bar)[XB_TMO])) break; if (_sp > XB_SPIN_CAP) { atomicAdd(&(bar)[XB_TMO], 1u); break; } } } } while (0)
struct XcdBarrier { unsigned* bar; unsigned x; volatile LAS unsigned* st; };
__device__ __forceinline__ XcdBarrier xcd_barrier_post(unsigned* bar, volatile LAS unsigned* st) {
    XcdBarrier b; b.bar = bar; b.x = xb_xcc_id(); b.st = st;
    if (threadIdx.x == 0) (void)xb_add(&bar[XB_XCNT(b.x)], 1u);
    return b;
}
__device__ __forceinline__ void xcd_barrier_complete(unsigned* bar, unsigned x, unsigned& nloc, unsigned& nx) {
    const unsigned G = gridDim.x * gridDim.y * gridDim.z;
    unsigned sum, cnt, mine, sp = 0u;
    for (;;) {
        sum = 0u; cnt = 0u; mine = 0u;
#pragma unroll
        for (unsigned j = 0; j < 16; ++j) { const unsigned c = xb_ld(&bar[XB_XCNT(j)]); sum += c; cnt += (c > 0u) ? 1u : 0u; mine = (j == x) ? c : mine; }
        if (sum == G) break;
        __builtin_amdgcn_s_sleep(1);
        if ((++sp & 255u) == 0u) { if (xb_ld(&bar[XB_TMO])) break; if (sp > XB_SPIN_CAP) { atomicAdd(&bar[XB_TMO], 1u); break; } }
    }
    nloc = mine > 0u ? mine : 1u; nx = cnt > 0u ? cnt : 1u;
}
__device__ __forceinline__ void xcd_barrier_fn(unsigned* bar_, unsigned x_, volatile LAS unsigned* st_, bool is_t0) {
    XcdBarrier b; b.bar = bar_; b.x = x_; b.st = st_;
    asm volatile("s_waitcnt vmcnt(0)" ::: "memory");
    __syncthreads();
    if (is_t0) {
        unsigned* bar = b.bar;
        __builtin_amdgcn_s_waitcnt(0);
        unsigned nloc = b.st[0], nx = b.st[1];
        if (nloc == 0u) { xcd_barrier_complete(bar, b.x, nloc, nx); b.st[0] = nloc; b.st[1] = nx; }
        const unsigned old = xb_add(&bar[XB_XSUB(b.x)], 1u);
        const unsigned gen = old / nloc;
        if (old + 1u == (gen + 1u) * nloc) {
            __builtin_amdgcn_fence(__ATOMIC_RELEASE, "agent");
            asm volatile("s_waitcnt vmcnt(0)" ::: "memory");
            const unsigned og = xb_add(&bar[XB_TOP], 1u);
            const unsigned tg = og / nx;
            if (og + 1u == (tg + 1u) * nx) xb_add(&bar[XB_TOPGEN], 1u);
            else XB_SPIN(xb_ld(&bar[XB_TOPGEN]) == tg, bar);
            __builtin_amdgcn_fence(__ATOMIC_ACQUIRE, "agent");
            xb_add(&bar[XB_XGEN(b.x)], 1u);
            asm volatile("s_waitcnt vmcnt(0)" ::: "memory");
        } else {
            XB_SPIN(xb_ld(&bar[XB_XGEN(b.x)]) == gen, bar);
            __builtin_amdgcn_fence(__ATOMIC_ACQUIRE, "agent");
            asm volatile("s_waitcnt vmcnt(0)" ::: "memory");
        }
    }
    __syncthreads();
}

struct Args { const float* in[40]; float* out; unsigned char* ws; int ph_lo, ph_hi; };
struct InTab { const float* const* p; __device__ __forceinline__ const float* operator[](int i) const { return (const float*)(GAS const float*)p[i]; } };
struct Frame {
    LAS unsigned char* lds; char* ldsg;
    unsigned char* ws; float* xs;
    InTab in;
    int tid, lane, wave, G, bid;
};
enum { I_X = 0, I_C, I_ADAW, I_ADAB, I_LNG, I_LNB, I_MU, I_RKV, I_W0, I_W1, I_W2, I_A0, I_A1, I_A2, I_G1, I_G2, I_KK, I_KA, I_RK, I_GNG, I_GNB, I_RWO, I_V0, I_V1, I_V2,
       I_KVADAW, I_KVADAB, I_KVW, I_KVFB, I_KNORM, I_WQG, I_QNORM, I_FWO, I_WGRP, I_BGRP, I_WEXP, I_BEXP, I_WGATE, I_WUP, I_WDOWN };

__device__ __forceinline__ void tr_item(const float* W, int ldw, int K, int k0, int n0, const float* mu, bf16_t* WT, int ldt, int nd0, int kd0, LAS float* scr, int lane) {
    const int kr = lane >> 3, n4 = 4 * (lane & 7);
    f32x4 v[8];
#pragma unroll
    for (int i = 0; i < 8; ++i) { const int k = k0 + kr + 8 * i; v[i] = (k < K) ? *(const f32x4*)(W + (size_t)k * ldw + n0 + n4) : (f32x4){0.f, 0.f, 0.f, 0.f}; }
    if (mu) {
#pragma unroll
        for (int i = 0; i < 8; ++i) { const int k = k0 + kr + 8 * i; v[i] = v[i] * ((k < K) ? mu[k] : 0.f); }
    }
#pragma unroll
    for (int i = 0; i < 8; ++i) { LAS float* d = scr + (kr + 8 * i) * 33 + n4; d[0] = v[i][0]; d[1] = v[i][1]; d[2] = v[i][2]; d[3] = v[i][3]; }
    LDS_WAIT(); asm volatile("" ::: "memory");
    const int c = lane & 7;
#pragma unroll
    for (int j = 0; j < 4; ++j) {
        const int n = (lane >> 3) + 8 * j; const LAS float* s = scr + (8 * c) * 33 + n;
        u32x4 o; o.x = pk2(s[0 * 33], s[1 * 33]); o.y = pk2(s[2 * 33], s[3 * 33]); o.z = pk2(s[4 * 33], s[5 * 33]); o.w = pk2(s[6 * 33], s[7 * 33]);
        *(u32x4*)(WT + (size_t)(nd0 + n) * ldt + kd0 + 8 * c) = o;
    }
    LDS_WAIT(); asm volatile("" ::: "memory");
}
__device__ __forceinline__ void zero_item(bf16_t* WT, int ldt, int r0, int c0, int c1, int lane) {
    const int cpr = (c1 - c0) >> 3, tot = 32 * cpr;
    for (int i = lane; i < tot; i += 64) { const int r = i / cpr, c = i % cpr; *(u32x4*)(WT + (size_t)(r0 + r) * ldt + c0 + 8 * c) = (u32x4){0u, 0u, 0u, 0u}; }
}

__device__ __forceinline__ void p0_prologue(Frame& F) {
    const InTab in = F.in;
    {
        LAS float* cs = (LAS float*)F.lds;
        LAS float* part = (LAS float*)(F.lds + 32768);
        bool did_cs = false;
        for (int it = F.bid; it < 104; it += F.G) {
            if (!did_cs) { for (int i = F.tid; i < 8 * 1024; i += NTHR) { const float v = in[I_C][i]; cs[i] = v / (1.0f + __expf(-v)); } did_cs = true; }
            __syncthreads();
            const float* W; const float* bias; int ldw, j0; float* dst; int dld;
            if (it < 96) { const int l = it / 24; j0 = (it % 24) * 256; W = in[I_ADAW] + (size_t)l * 1024 * 6144; ldw = 6144; bias = in[I_ADAB] + l * 6144; dst = (float*)(F.ws + WS_MOD) + (size_t)l * 8 * 6144; dld = 6144; }
            else { j0 = (it - 96) * 256; W = in[I_KVADAW]; ldw = 2048; bias = in[I_KVADAB]; dst = (float*)(F.ws + WS_KVMOD); dld = 2048; }
            f32x4 acc[8];
#pragma unroll
            for (int b = 0; b < 8; ++b) acc[b] = (f32x4){0.f, 0.f, 0.f, 0.f};
            const int kbeg = F.wave * 128;
#pragma unroll 4
            for (int kk = 0; kk < 128; ++kk) {
                const int k = kbeg + kk;
                const f32x4 w = *(const f32x4*)(W + (size_t)k * ldw + j0 + 4 * F.lane);
#pragma unroll
                for (int b = 0; b < 8; ++b) acc[b] += w * cs[b * 1024 + k];
            }
#pragma unroll
            for (int b = 0; b < 8; ++b) *(LAS f32x4*)(part + (F.wave * 8 + b) * 256 + 4 * F.lane) = acc[b];
            __syncthreads();
            for (int o = F.tid; o < 8 * 256; o += NTHR) {
                const int b = o >> 8, j = o & 255; float s = 0.f;
#pragma unroll
                for (int w = 0; w < 8; ++w) s += part[(w * 8 + b) * 256 + j];
                dst[(size_t)b * dld + j0 + j] = s + bias[j0 + j];
            }
            __syncthreads();
        }
        __syncthreads();
    }
    {
        const int gt = F.bid * NTHR + F.tid, NGT = F.G * NTHR;
        bf16_t* RTH = (bf16_t*)(F.ws + WS_RT); bf16_t* RTL = RTH + 4 * 48 * 1024; bf16_t* WFH = (bf16_t*)(F.ws + WS_WF); bf16_t* WFL = WFH + 16 * 1024;
        for (int i = gt; i < 4 * 48 * 1024; i += NGT) {
            const int l = i / (48 * 1024), r = i % (48 * 1024), c = r / 1024, k = r % 1024;
            const float w = (c < 4) ? in[I_WGRP][((size_t)l * 1024 + k) * 4 + c] : (c < 36 ? in[I_WEXP][((size_t)l * 1024 + k) * 32 + (c - 4)] : 0.f);
            const unsigned h = f2bf(w); RTH[i] = (bf16_t)h; RTL[i] = (bf16_t)f2bf(w - bf2f((unsigned short)h));
        }
        for (int i = gt; i < 16 * 1024; i += NGT) { const int c = i / 1024, k = i % 1024; const float w = in[I_KVW][(size_t)k * 2064 + 2048 + c];
            const unsigned h = f2bf(w); WFH[i] = (bf16_t)h; WFL[i] = (bf16_t)f2bf(w - bf2f((unsigned short)h)); }
    }
    LAS float* scr = (LAS float*)(F.lds + F.wave * 8704);
    const int gw = F.bid * NWAVES + F.wave, NGW = F.G * NWAVES;
    constexpr int N_S1 = 2 * 3 * 512;
    constexpr int N_S2 = 2 * 17 * 32;
    constexpr int N_S3 = 2 * 128;
    constexpr int N_S4 = 2 * 512 + 1024 + 2 * 1024 + 2 * 512;
    constexpr int N_TOT = N_S1 + N_S2 + N_S3 + N_S4;
    for (int it = gw; it < N_TOT; it += NGW) {
        int r = it;
        if (r < N_S1) {
            const int l = r / 1536; r %= 1536; const int p = r / 512; r %= 512; const int kb = r / 32, nb = r % 32;
            tr_item(in[I_RKV] + (size_t)(l * 3 + p) * 1024 * 1024, 1024, 1024, 64 * kb, 32 * nb, nullptr,
                    (bf16_t*)(F.ws + WS_RWBIG) + (size_t)l * 3072 * 1024, 1024, p * 1024 + 32 * nb, 64 * kb, scr, F.lane);
            continue;
        }
        r -= N_S1;
        if (r < N_S2) {
            const int l = r / (17 * 32); r %= (17 * 32); const int nbk = r / 32, sub = r % 32, half = sub / 16, kb = sub % 16;
            if (nbk >= 16) continue;
            bf16_t* WT = (bf16_t*)(F.ws + WS_RWLORA) + (size_t)l * 512 * RWK;
            const float* W = nullptr; int ldw = 0, n0 = 0, mui = 0;
            if (nbk < 2) { W = in[I_W1] + (size_t)l * 1024 * 64; ldw = 64; n0 = 32 * nbk; mui = 1; }
            else if (nbk < 4) { W = in[I_A1] + (size_t)l * 1024 * 64; ldw = 64; n0 = 32 * (nbk - 2); mui = 4; }
            else if (nbk < 9) { W = in[I_G1] + (size_t)l * 1024 * 160; ldw = 160; n0 = 32 * (nbk - 4); mui = 5; }
            else if (nbk == 9 && l == 1) { W = in[I_V1]; ldw = 32; n0 = 0; mui = 3; }
            if (W) tr_item(W, ldw, 1024, 64 * kb, n0, half ? in[I_MU] + (l * 6 + mui) * 1024 : nullptr, WT, RWK, 32 * nbk, half * 1024 + 64 * kb, scr, F.lane);
            else zero_item(WT, RWK, 32 * nbk, half * 1024 + 64 * kb, half * 1024 + 64 * kb + 64, F.lane);
            continue;
        }
        r -= N_S2;
        if (r < N_S3) {
            const int l = r / 128; r %= 128; const int blk = r / 32, nb = r % 32;
            unsigned char* base = F.ws + WS_LORA2 + (size_t)l * MiB;
            if (blk == 0) { tr_item(in[I_W2] + (size_t)l * 64 * 1024, 1024, 64, 0, 32 * nb, nullptr, (bf16_t*)(base + L2_W2T), 64, 32 * nb, 0, scr, F.lane); }
            else if (blk == 1) { tr_item(in[I_A2] + (size_t)l * 64 * 1024, 1024, 64, 0, 32 * nb, nullptr, (bf16_t*)(base + L2_A2T), 64, 32 * nb, 0, scr, F.lane); }
            else if (blk == 2) { for (int kb = 0; kb < 4; ++kb) tr_item(in[I_G2] + (size_t)l * 160 * 1024, 1024, 160, 64 * kb, 32 * nb, nullptr, (bf16_t*)(base + L2_G2T), G2K, 32 * nb, 64 * kb, scr, F.lane); }
            else { if (l == 1) tr_item(in[I_V2], 1024, 32, 0, 32 * nb, nullptr, (bf16_t*)(base + L2_V2T), 64, 32 * nb, 0, scr, F.lane); }
            continue;
        }
        r -= N_S3;
        if (r < N_S4) {
            if (r < 1024) { const int l = r / 512; r %= 512; tr_item(in[I_RWO] + (size_t)l * 1024 * 1024, 1024, 1024, 64 * (r / 32), 32 * (r % 32), nullptr, (bf16_t*)(F.ws + WS_RWWO) + (size_t)l * 1024 * 1024, 1024, 32 * (r % 32), 64 * (r / 32), scr, F.lane); continue; }
            r -= 1024;
            if (r < 1024) { tr_item(in[I_KVW], 2064, 1024, 64 * (r / 64), 32 * (r % 64), nullptr, (bf16_t*)(F.ws + WS_KVW), 1024, 32 * (r % 64), 64 * (r / 64), scr, F.lane); continue; }
            r -= 1024;
            if (r < 2048) { const int j = r / 1024; r %= 1024; tr_item(in[I_WQG] + (size_t)j * 1024 * 2048, 2048, 1024, 64 * (r / 64), 32 * (r % 64), nullptr, (bf16_t*)(F.ws + WS_FXQG) + (size_t)j * 2048 * 1024, 1024, 32 * (r % 64), 64 * (r / 64), scr, F.lane); continue; }
            r -= 2048;
            { const int j = r / 512; r %= 512; tr_item(in[I_FWO] + (size_t)j * 1024 * 1024, 1024, 1024, 64 * (r / 32), 32 * (r % 32), nullptr, (bf16_t*)(F.ws + WS_FXWO) + (size_t)j * 1024 * 1024, 1024, 32 * (r % 32), 64 * (r / 32), scr, F.lane); continue; }
        }
    }
}
__device__ __forceinline__ void moe_convert(Frame& F, int l, int wg0, int nwg) {
    const InTab in = F.in;
    LAS float* scr = (LAS float*)(F.lds + F.wave * 8704);
    if (F.bid < wg0 || F.bid >= wg0 + nwg) return;
    const int gw = (F.bid - wg0) * NWAVES + F.wave, NGW = nwg * NWAVES;
    bf16_t* base = (bf16_t*)(F.ws + WS_MOE);
    const int kr = F.lane >> 3, n4 = 4 * (F.lane & 7), c = F.lane & 7;
#define MC_DECODE(it_, W_, ldw_, k0_, n0_, WT_, ldt_, nd0_, kd0_) do { const int e_ = (it_) / 768; int r_ = (it_) % 768; const int le_ = l * 32 + e_; \
        if (r_ < 512) { const int kb_ = r_ / 32, nb_ = r_ % 32, s_ = (nb_ % 8) / 4; W_ = (s_ ? in[I_WUP] : in[I_WGATE]) + (size_t)le_ * 1024 * 512; ldw_ = 512; k0_ = 64 * kb_; n0_ = 128 * (nb_ / 8) + 32 * (nb_ % 4); \
            WT_ = base + (size_t)e_ * 1024 * 1024; ldt_ = 1024; nd0_ = 32 * nb_; kd0_ = 64 * kb_; } \
        else { r_ -= 512; const int kb_ = r_ / 32, nb_ = r_ % 32; W_ = in[I_WDOWN] + (size_t)le_ * 512 * 1024; ldw_ = 1024; k0_ = 64 * kb_; n0_ = 32 * nb_; \
            WT_ = base + (size_t)32 * 1024 * 1024 + (size_t)e_ * 1024 * 512; ldt_ = 512; nd0_ = 32 * nb_; kd0_ = 64 * kb_; } } while (0)
    f32x4 v[8];
    { int it = gw; if (it < 32 * 768) { const float* W; int ldw, k0, n0; bf16_t* WT; int ldt, nd0, kd0; MC_DECODE(it, W, ldw, k0, n0, WT, ldt, nd0, kd0);
#pragma unroll
        for (int i = 0; i < 8; ++i) v[i] = *(const f32x4*)(W + (size_t)(k0 + kr + 8 * i) * ldw + n0 + n4); (void)WT; (void)ldt; (void)nd0; (void)kd0; } }
    for (int it = gw; it < 32 * 768; it += NGW) {
        const float* W; int ldw, k0, n0; bf16_t* WT; int ldt, nd0, kd0; MC_DECODE(it, W, ldw, k0, n0, WT, ldt, nd0, kd0);
#pragma unroll
        for (int i = 0; i < 8; ++i) { LAS float* d = scr + (kr + 8 * i) * 33 + n4; d[0] = v[i][0]; d[1] = v[i][1]; d[2] = v[i][2]; d[3] = v[i][3]; }
        if (it + NGW < 32 * 768) { const float* Wn; int ldwn, k0n, n0n; bf16_t* WTn; int ldtn, nd0n, kd0n; MC_DECODE(it + NGW, Wn, ldwn, k0n, n0n, WTn, ldtn, nd0n, kd0n);
#pragma unroll
            for (int i = 0; i < 8; ++i) v[i] = *(const f32x4*)(Wn + (size_t)(k0n + kr + 8 * i) * ldwn + n0n + n4); (void)WTn; (void)ldtn; (void)nd0n; (void)kd0n; }
        LDS_WAIT(); asm volatile("" ::: "memory");
#pragma unroll
        for (int j = 0; j < 4; ++j) {
            const int n = (F.lane >> 3) + 8 * j; const LAS float* sp = scr + (8 * c) * 33 + n;
            u32x4 o; o.x = pk2(sp[0 * 33], sp[1 * 33]); o.y = pk2(sp[2 * 33], sp[3 * 33]); o.z = pk2(sp[4 * 33], sp[5 * 33]); o.w = pk2(sp[6 * 33], sp[7 * 33]);
            *(u32x4*)(WT + (size_t)(nd0 + n) * ldt + kd0 + 8 * c) = o;
        }
        LDS_WAIT(); asm volatile("" ::: "memory");
    }
#undef MC_DECODE
    __syncthreads();
}

struct Unit { int pm, pn; };
struct SchedDense {
    int nM, nN, G, c;
    __device__ __forceinline__ bool next(int i, Unit& u) const {
        const int nwg = nM * nN; const long L = (long)i * G + c; if (L >= nwg) return false;
        int wgid = (int)L; { const int q = nwg / 8, r = nwg % 8, xcd = wgid % 8, off = wgid / 8; wgid = (xcd < r ? xcd * (q + 1) : r * (q + 1) + (xcd - r) * q) + off; }
        const int nig = 8 * nN, gid = wgid / nig, fm = gid * 8, gsz = (nM - fm) < 8 ? (nM - fm) : 8;
        u.pm = fm + ((wgid % nig) % gsz); u.pn = (wgid % nig) / gsz; return true;
    }
    __device__ __forceinline__ size_t boff(const Unit& u, int K) const { return (size_t)u.pn * 256 * K; }
    __device__ __forceinline__ size_t aoff(const Unit&) const { return 0; }
};
struct SchedRKV : SchedDense {
    __device__ __forceinline__ size_t aoff(const Unit& u) const { return (size_t)(u.pn >> 2) * X3S; }
};
struct SchedMoe {
    const LAS int* tt; int ntiles, G, c; size_t estride;
    __device__ __forceinline__ bool next(int i, Unit& u) const { const long L = (long)i * G + c; if (L >= (long)ntiles * 4) return false; u.pm = (int)(L / 4); u.pn = (int)(L % 4); return true; }
    __device__ __forceinline__ size_t boff(const Unit& u, int K) const { return (size_t)(tt[u.pm] >> 16) * estride + (size_t)u.pn * 256 * K; }
    __device__ __forceinline__ size_t aoff(const Unit&) const { return 0; }
};
template <class Epi, class Sched>
__device__ __forceinline__ void gemm_phase(Frame& F, const bf16_t* A, int lda, const bf16_t* Bt, int K, const Sched& S, const Epi& E) {
    const int wr = F.wave >> 2, wc = F.wave & 3, fr = F.lane & 15, fq = F.lane >> 4;
    Unit u;
    for (int i = 0; S.next(i, u); ++i) {
        const bf16_t* Bb = Bt + S.boff(u, K) + (size_t)(wc * 32 + fr) * K + 8 * fq;
        for (int ai = 0; ai < 2; ++ai) {
            f32x4 acc[2][4][2];
#pragma unroll
            for (int b = 0; b < 2; ++b)
#pragma unroll
                for (int m = 0; m < 4; ++m)
#pragma unroll
                    for (int n = 0; n < 2; ++n) acc[b][m][n] = (f32x4){0.f, 0.f, 0.f, 0.f};
            const bf16_t* Ab = A + (size_t)(u.pm * 256 + ai * 128 + wr * 64 + fr) * lda + 8 * fq;
            for (int k0 = 0; k0 < K; k0 += 32) {
                bf16x8 bfr[2][2], af[4];
#pragma unroll
                for (int b = 0; b < 2; ++b)
#pragma unroll
                    for (int n = 0; n < 2; ++n) bfr[b][n] = *(const bf16x8*)(Bb + (size_t)(b * 128 + n * 16) * K + k0);
#pragma unroll
                for (int m = 0; m < 4; ++m) af[m] = *(const bf16x8*)(Ab + (size_t)(m * 16) * lda + k0);
#pragma unroll
                for (int b = 0; b < 2; ++b)
#pragma unroll
                    for (int m = 0; m < 4; ++m)
#pragma unroll
                        for (int n = 0; n < 2; ++n) acc[b][m][n] = __builtin_amdgcn_mfma_f32_16x16x32_bf16(bfr[b][n], af[m], acc[b][m][n], 0, 0, 0);
            }
            E(acc, ai, u, wr, wc, fr, fq);
        }
    }
}
#define PG8_LAS __attribute__((address_space(3)))
constexpr int BM = 256, BK = 64, HALF = 128, HTB = HALF * BK * 2  , STAGE_BYTES = 8 * HTB;

__host__ __device__ __forceinline__ int lds_byte(int r, int c) { const int st = (r >> 4) * 2 + (c >> 5), rr = r & 15, cc = c & 31, ob = rr * 64 + cc * 2; return st * 1024 + (ob ^ (((ob >> 9) & 1) << 5)); }
__host__ __device__ __forceinline__ void stage_rc(int b, int& R, int& C) { const int st = b / 1024, sb = b % 1024, swz = sb ^ (((sb >> 9) & 1) << 5); R = (st >> 1) * 16 + swz / 64; C = (st & 1) * 32 + (swz % 64) / 2; }
__host__ __device__ __forceinline__ int perm32(int rho) { const int n = rho >> 4, i = rho & 15; return 8 * (i >> 2) + 4 * n + (i & 3); }
template <class Epi, class Sched, bool GATHER = false, bool ALIGN_EPI = true, bool SP2 = true>
__device__ __forceinline__ void gemm_fast(Frame& F, const bf16_t* Ag, int lda, const bf16_t* Btg, int Kin, const Sched& S, const Epi& E, const LAS int* tokL = nullptr) {
    static_assert(!GATHER || SP2, "gather mode is written for the SP2 loop");
    PG8_LAS unsigned char* lds = (PG8_LAS unsigned char*)F.lds;
    const int tid = F.tid, wid = F.wave, lane = F.lane, wr = wid >> 2, wc = wid & 3, fr = lane & 15, fq = lane >> 4;
    int K = Kin; asm volatile("" : "+s"(K));
    const int nt = K / BK;
    unsigned voffA[2], voffB[2];
#pragma unroll
    for (int i = 0; i < 2; ++i) { int R, C; stage_rc(tid * 16 + i * 8192, R, C); const int Rb = (Epi::BCONT ? (R >> 5) * 64 : (R & ~31)) + perm32(R & 31);
        voffA[i] = (unsigned)(R * lda + C) * 2u; voffB[i] = (unsigned)(Rb * K + C) * 2u; }
    const size_t kstep = (size_t)(BK * 2);
    const size_t hstepA = (size_t)HALF * lda * 2, hstep = (size_t)(Epi::BCONT ? 32 : HALF) * K * 2;
    const size_t tstepA = 2 * hstepA;
    const unsigned ldsw = (unsigned)wid * 1024u;
    const int aoff = lds_byte(wr * 64 + fr, fq * 8), boff = lds_byte(wc * 32 + fr, fq * 8);
#define PG8_SA(b, h) (((b) * 2 + (h)) * HTB)
#define PG8_SB(b, h) ((4 + (b) * 2 + (h)) * HTB)
    const unsigned ldsb = (unsigned)__builtin_amdgcn_readfirstlane((int)((unsigned)(size_t)lds + ldsw));
#define PG8_STAGE(bufoff, gbase, voff) do { _Pragma("unroll") for (int _i = 0; _i < 2; ++_i) { unsigned keep_; \
        asm volatile("s_mov_b32 %0, m0\n\ts_mov_b32 m0, %3\n\ts_nop 0\n\tglobal_load_lds_dwordx4 %1, %2\n\ts_mov_b32 m0, %0" : "=&s"(keep_) : "v"((voff)[_i]), "s"((const char*)(gbase)), "s"(ldsb + (unsigned)((bufoff) + _i * 8192)) : "memory"); } } while (0)
    unsigned gcu[2][2] = {{0u, 0u}, {0u, 0u}}, gnx[2][2] = {{0u, 0u}, {0u, 0u}};
#define PG8_GOFS(dst, ord) do { int tl_ = tid; asm volatile("" : "+v"(tl_));   _Pragma("unroll") for (int _h = 0; _h < 2; ++_h) _Pragma("unroll") for (int _i = 0; _i < 2; ++_i) { int R_, C_; stage_rc(tl_ * 16 + _i * 8192, R_, C_); \
        dst[_h][_i] = ((unsigned)tokL[(ord) * 256 + _h * 128 + R_] * (unsigned)lda + (unsigned)C_) * 2u; } } while (0)
#define PG8_STAGE_A(bufoff, gptr, half, usenext) do { if constexpr (GATHER) { unsigned vv_[2]; _Pragma("unroll") for (int _j = 0; _j < 2; ++_j) vv_[_j] = (usenext) ? gnx[half][_j] : gcu[half][_j]; PG8_STAGE(bufoff, gptr, vv_); } \
        else { PG8_STAGE(bufoff, (gptr) + ((half) ? hstepA : (size_t)0), voffA); } } while (0)
#define PG8_LDA(dst, b, h) do { _Pragma("unroll") for (int m = 0; m < 4; ++m) _Pragma("unroll") for (int k = 0; k < 2; ++k) dst[m][k] = *(const PG8_LAS bf16x8*)(lds + PG8_SA(b, h) + aoff + m * 2048 + k * 1024); } while (0)
#define PG8_LDB(dst, b, h) do { _Pragma("unroll") for (int n = 0; n < 2; ++n) _Pragma("unroll") for (int k = 0; k < 2; ++k) dst[n][k] = *(const PG8_LAS bf16x8*)(lds + PG8_SB(b, h) + boff + n * 2048 + k * 1024); } while (0)
#define PG8_MMA(ai, bj, At, Bt) do { __builtin_amdgcn_s_setprio(1); _Pragma("unroll") for (int m = 0; m < 4; ++m) _Pragma("unroll") for (int n = 0; n < 2; ++n) _Pragma("unroll") for (int k = 0; k < 2; ++k) \
        acc[ai][bj][m][n] = __builtin_amdgcn_mfma_f32_16x16x32_bf16(Bt[n][k], At[m][k], acc[ai][bj][m][n], 0, 0, 0); __builtin_amdgcn_s_setprio(0); } while (0)
#define PG8_WAIT_V(n) asm volatile("s_waitcnt vmcnt(" #n ")" ::: "memory")
#define PG8_WAIT_R(rel) do { if (rel) asm volatile("s_waitcnt vmcnt(%0)" :: "n"(8 + Epi::NST) : "memory"); else PG8_WAIT_V(8); } while (0)
#define PG8_WAIT_L(n) asm volatile("s_waitcnt lgkmcnt(" #n ")" ::: "memory")
#define PG8_BAR __builtin_amdgcn_s_barrier()
#define PG8_SCHED __builtin_amdgcn_sched_barrier(0)
    Unit cur, nxt; int ui = 0;
    if (!S.next(0, cur)) return;
    f32x4 acc[2][2][4][2];
#pragma unroll
    for (int a = 0; a < 2; ++a)
#pragma unroll
        for (int b = 0; b < 2; ++b)
#pragma unroll
            for (int m = 0; m < 4; ++m)
#pragma unroll
                for (int n = 0; n < 2; ++n) acc[a][b][m][n] = (f32x4){0.f, 0.f, 0.f, 0.f};
    bf16x8 At[4][2], B0[2][2], B1[2][2];
    const char* cA = GATHER ? (const char*)Ag : (const char*)Ag + 2 * S.aoff(cur) + (size_t)cur.pm * tstepA; const char* cB = (const char*)Btg + 2 * S.boff(cur, K);
    if constexpr (GATHER) PG8_GOFS(gcu, 0);
    if constexpr (SP2) {
        PG8_STAGE(PG8_SB(0, 0), cB, voffB); PG8_STAGE(PG8_SB(0, 1), cB + hstep, voffB); PG8_STAGE_A(PG8_SA(0, 0), cA, 0, false); PG8_STAGE_A(PG8_SA(0, 1), cA, 1, false);
        if (wr == 1) PG8_BAR;
        PG8_WAIT_V(2); PG8_BAR;
        PG8_STAGE(PG8_SB(1, 0), cB + kstep, voffB); PG8_STAGE_A(PG8_SA(1, 0), cA + kstep, 0, false); PG8_STAGE(PG8_SB(1, 1), cB + hstep + kstep, voffB);
        PG8_WAIT_V(6); PG8_BAR;
    } else {
        PG8_STAGE(PG8_SB(0, 0), cB, voffB); PG8_STAGE(PG8_SA(0, 0), cA, voffA); PG8_STAGE(PG8_SB(0, 1), cB + hstep, voffB); PG8_STAGE(PG8_SA(0, 1), cA + hstepA, voffA);
        if (wr == 1) PG8_BAR;
        PG8_WAIT_V(4); PG8_BAR;
        PG8_STAGE(PG8_SB(1, 0), cB + kstep, voffB); PG8_STAGE(PG8_SA(1, 0), cA + kstep, voffA); PG8_STAGE(PG8_SB(1, 1), cB + hstep + kstep, voffB);
        PG8_WAIT_V(6); PG8_BAR;
    }
    for (;;) {
        const bool has_next = S.next(ui + 1, nxt);
        const char* nA = GATHER ? cA : (has_next ? (const char*)Ag + 2 * S.aoff(nxt) + (size_t)nxt.pm * tstepA : cA);
        if constexpr (GATHER) { if (has_next) PG8_GOFS(gnx, ui + 1); else { gnx[0][0] = gcu[0][0]; gnx[0][1] = gcu[0][1]; gnx[1][0] = gcu[1][0]; gnx[1][1] = gcu[1][1]; } } const char* nB = has_next ? (const char*)Btg + 2 * S.boff(nxt, K) : cB;
#define PG8_ITER(WAITA, ST11) do { \
            const bool last = (t == nt - 2); \
            const char* a1 = cA + (size_t)(t + 1) * kstep;                                             \
            const char* a2 = last ? nA : cA + (size_t)(t + 2) * kstep; const char* b2 = last ? nB : cB + (size_t)(t + 2) * kstep;     \
            const char* a3 = a2 + kstep; const char* b3 = b2 + kstep;                                \
              \
            PG8_LDB(B0, 0, 0); PG8_LDB(B1, 0, 1); PG8_SCHED; PG8_LDA(At, 0, 0); ST11; \
            WAITA; PG8_WAIT_L(0); PG8_BAR; PG8_MMA(0, 0, At, B0); PG8_MMA(0, 1, At, B1); PG8_BAR; PG8_SCHED; \
              \
            PG8_LDA(At, 0, 1); PG8_STAGE(PG8_SB(0, 0), b2, voffB); PG8_STAGE(PG8_SB(0, 1), b2 + hstep, voffB); PG8_STAGE_A(PG8_SA(0, 0), a2, 0, last); \
            WAITA; PG8_WAIT_L(0); PG8_BAR; PG8_MMA(1, 0, At, B0); PG8_MMA(1, 1, At, B1); PG8_BAR; PG8_SCHED; \
              \
            PG8_LDB(B0, 1, 0); PG8_LDB(B1, 1, 1); PG8_SCHED; PG8_LDA(At, 1, 0); PG8_STAGE_A(PG8_SA(0, 1), a2, 1, last); \
            WAITA; PG8_WAIT_L(0); PG8_BAR; PG8_MMA(0, 0, At, B0); PG8_MMA(0, 1, At, B1); PG8_BAR; PG8_SCHED; \
              \
            PG8_LDA(At, 1, 1); PG8_STAGE(PG8_SB(1, 0), b3, voffB); PG8_STAGE(PG8_SB(1, 1), b3 + hstep, voffB); PG8_STAGE_A(PG8_SA(1, 0), a3, 0, last); \
            PG8_WAIT_V(8); PG8_WAIT_L(0); PG8_BAR; PG8_MMA(1, 0, At, B0); PG8_MMA(1, 1, At, B1); PG8_BAR; PG8_SCHED; } while (0)
        int t = 0;
        if (ui > 0) { PG8_ITER(asm volatile("s_waitcnt vmcnt(%0)" :: "n"(8 + Epi::NST) : "memory"), (void)0); t = 2; }
        for (; t < nt; t += 2) PG8_ITER(PG8_WAIT_V(8), PG8_STAGE_A(PG8_SA(1, 1), a1, 1, false));
#undef PG8_ITER
        if constexpr (SP2) { if (has_next) PG8_STAGE_A(PG8_SA(1, 1), nA + kstep, 1, true); }
        if constexpr (ALIGN_EPI) { if (wr == 0) PG8_BAR; }
        { int fr_ = fr, fq_ = fq; asm volatile("" : "+v"(fr_), "+v"(fq_)); E(acc[0], 0, cur, wr, wc, fr_, fq_); E(acc[1], 1, cur, wr, wc, fr_, fq_); }
        if (!has_next) break;
#pragma unroll
        for (int a = 0; a < 2; ++a)
#pragma unroll
            for (int b = 0; b < 2; ++b)
#pragma unroll
                for (int m = 0; m < 4; ++m)
#pragma unroll
                    for (int n = 0; n < 2; ++n) acc[a][b][m][n] = (f32x4){0.f, 0.f, 0.f, 0.f};
        cur = nxt; cA = nA; cB = nB; ++ui;
        if constexpr (GATHER) { gcu[0][0] = gnx[0][0]; gcu[0][1] = gnx[0][1]; gcu[1][0] = gnx[1][0]; gcu[1][1] = gnx[1][1]; }
        if constexpr (ALIGN_EPI) { if (wr == 1) PG8_BAR; }
    }
    PG8_WAIT_V(0);
    if constexpr (!ALIGN_EPI) { if (wr == 0) PG8_BAR; }
    PG8_BAR;
#undef PG8_SA
#undef PG8_SB
#undef PG8_STAGE
#undef PG8_LDA
#undef PG8_GOFS
#undef PG8_STAGE_A
#undef PG8_LDB
#undef PG8_MMA
#undef PG8_WAIT_V
#undef PG8_WAIT_R
#undef PG8_WAIT_L
#undef PG8_BAR
#undef PG8_SCHED
}
__device__ __forceinline__ void st_bf16x4(bf16_t* p, f32x4 v) { u32x2 w; w.x = pk2(v[0], v[1]); w.y = pk2(v[2], v[3]); *(u32x2*)p = w; }
__device__ __forceinline__ f32x4 ld_bf16x4(const bf16_t* p) { const u32x2 w = *(const u32x2*)p; return (f32x4){lo16(w.x), hi16(w.x), lo16(w.y), hi16(w.y)}; }
__device__ __forceinline__ u32x4 pk8(f32x4 a, f32x4 b) { u32x4 w; w.x = pk2(a[0], a[1]); w.y = pk2(a[2], a[3]); w.z = pk2(b[0], b[1]); w.w = pk2(b[2], b[3]); return w; }
__device__ __forceinline__ u32x4 bperm4(int idx, u32x4 w) { u32x4 r; r.x = (unsigned)__builtin_amdgcn_ds_bpermute(idx, (int)w.x); r.y = (unsigned)__builtin_amdgcn_ds_bpermute(idx, (int)w.y); r.z = (unsigned)__builtin_amdgcn_ds_bpermute(idx, (int)w.z); r.w = (unsigned)__builtin_amdgcn_ds_bpermute(idx, (int)w.w); return r; }
#define EPI_LOOP(ACT, ...) do { const int L_ = fq * 16 + fr, r3_ = L_ >> 3, p3_ = L_ & 7, src4_ = (((p3_ & 3) << 4) | r3_) << 2; const bool hi_ = (p3_ & 4) != 0; \
    _Pragma("unroll") for (int m = 0; m < 4; ++m) { u32x4 wb_[2]; \
        _Pragma("unroll") for (int bj = 0; bj < 2; ++bj) { const int colt0 = wc * 64 + bj * 32 + fq * 8; f32x4 v0 = acc[bj][m][0], v1 = acc[bj][m][1]; (void)colt0; ACT; wb_[bj] = pk8(v0, v1); } \
        _Pragma("unroll") for (int h = 0; h < 2; ++h) { const int row = u.pm * 256 + ai * 128 + wr * 64 + m * 16 + h * 8 + r3_, colt = wc * 64 + p3_ * 8; \
            const u32x4 wa_ = bperm4(src4_ + h * 32, wb_[0]), wc_ = bperm4(src4_ + h * 32, wb_[1]); u32x4 w; w.x = hi_ ? wc_.x : wa_.x; w.y = hi_ ? wc_.y : wa_.y; w.z = hi_ ? wc_.z : wa_.z; w.w = hi_ ? wc_.w : wa_.w; \
            __VA_ARGS__ } asm volatile("" ::: "memory"); } } while (0)

struct EpiPlain {
    bf16_t* O; int ldc; static constexpr int NST = 16; static constexpr bool BCONT = true;
    __device__ __forceinline__ void operator()(const f32x4 (&acc)[2][4][2], int ai, const Unit& u, int wr, int wc, int fr, int fq) const {
        EPI_LOOP(, { __builtin_nontemporal_store(w, (u32x4*)(O + (size_t)row * ldc + u.pn * 256 + colt)); });
    }
};
struct EpiNone { static constexpr int NST = 0; static constexpr bool BCONT = true;
    __device__ __forceinline__ void operator()(const f32x4 (&acc)[2][4][2], int ai, const Unit& u, int wr, int wc, int fr, int fq) const {
        _Pragma("unroll") for (int m = 0; m < 4; ++m) _Pragma("unroll") for (int bj = 0; bj < 2; ++bj) asm volatile("" :: "v"(acc[bj][m][0]), "v"(acc[bj][m][1])); }
};
struct EpiPriv { bf16_t* base; int bid; static constexpr int NST = 16; static constexpr bool BCONT = true;
    __device__ __forceinline__ void operator()(const f32x4 (&acc)[2][4][2], int ai, const Unit& u, int wr, int wc, int fr, int fq) const {
        EPI_LOOP(, { __builtin_nontemporal_store(w, (u32x4*)(base + (size_t)bid * 65536 + (size_t)(row - u.pm * 256) * 256 + colt)); });
    }
};
struct EpiRKV {
    bf16_t* RKV; bf16_t* VF; int l; static constexpr int NST = 16; static constexpr bool BCONT = true;
    __device__ __forceinline__ void operator()(const f32x4 (&acc)[2][4][2], int ai, const Unit& u, int wr, int wc, int fr, int fq) const {
        const bool vf = (l == 0) && (u.pn >= 8);
        EPI_LOOP(, { if (vf) __builtin_nontemporal_store(w, (u32x4*)(VF + (size_t)row * 1024 + (u.pn - 8) * 256 + colt)); else __builtin_nontemporal_store(w, (u32x4*)(RKV + (size_t)row * 3072 + u.pn * 256 + colt)); });
    }
};
struct EpiLA {
    bf16_t* LA; static constexpr int NST = 16; static constexpr bool BCONT = true;
    __device__ __forceinline__ void operator()(const f32x4 (&acc)[2][4][2], int ai, const Unit& u, int wr, int wc, int fr, int fq) const {
        EPI_LOOP({ const int c = u.pn * 256 + colt0;
            if (c < 64) { _Pragma("unroll") for (int q = 0; q < 4; ++q) { v0[q] = tanhf_(v0[q]); v1[q] = tanhf_(v1[q]); } }
            else if (c >= 128 && c < 288) { _Pragma("unroll") for (int q = 0; q < 4; ++q) { v0[q] = sigmoidf_(v0[q]); v1[q] = sigmoidf_(v1[q]); } } },
            { __builtin_nontemporal_store(w, (u32x4*)(LA + (size_t)row * LAW + u.pn * 256 + colt)); });
    }
};
struct EpiSplit2 {
    bf16_t* O0; bf16_t* O1; int sig1; static constexpr int NST = 16; static constexpr bool BCONT = true;
    __device__ __forceinline__ void operator()(const f32x4 (&acc)[2][4][2], int ai, const Unit& u, int wr, int wc, int fr, int fq) const {
        if (u.pn < 4) { EPI_LOOP(, { __builtin_nontemporal_store(w, (u32x4*)(O0 + (size_t)row * 1024 + u.pn * 256 + colt)); }); }
        else { EPI_LOOP({ if (sig1) { _Pragma("unroll") for (int q = 0; q < 4; ++q) { v0[q] = sigmoidf_(v0[q]); v1[q] = sigmoidf_(v1[q]); } } }, { __builtin_nontemporal_store(w, (u32x4*)(O1 + (size_t)row * 1024 + (u.pn - 4) * 256 + colt)); }); }
    }
};
struct EpiMoe1 {
    bf16_t* HM; static constexpr int NST = 8; static constexpr bool BCONT = false;
    __device__ __forceinline__ void operator()(const f32x4 (&acc)[2][4][2], int ai, const Unit& u, int wr, int wc, int fr, int fq) const {
        const int L_ = fq * 16 + fr, src4_ = (((L_ & 3) << 4) | (L_ >> 2)) << 2, r2_ = L_ >> 2, p2_ = L_ & 3;
#pragma unroll
            for (int m = 0; m < 4; ++m) { const int row = u.pm * 256 + ai * 128 + wr * 64 + m * 16 + r2_; f32x4 o[2];
#pragma unroll
                for (int n = 0; n < 2; ++n) { const f32x4 g = acc[0][m][n], up = acc[1][m][n];
#pragma unroll
                    for (int q = 0; q < 4; ++q) o[n][q] = g[q] * sigmoidf_(g[q]) * up[q]; }
                u32x4 w = pk8(o[0], o[1]); w.x = (unsigned)__builtin_amdgcn_ds_bpermute(src4_, (int)w.x); w.y = (unsigned)__builtin_amdgcn_ds_bpermute(src4_, (int)w.y); w.z = (unsigned)__builtin_amdgcn_ds_bpermute(src4_, (int)w.z); w.w = (unsigned)__builtin_amdgcn_ds_bpermute(src4_, (int)w.w);
                __builtin_nontemporal_store(w, (u32x4*)(HM + (size_t)row * 512 + u.pn * 128 + wc * 32 + p2_ * 8)); }
    }
};

struct Row { f32x4 v[4]; };
__device__ __forceinline__ Row ld_row_f32(const float* p, int lane) { Row r;
#pragma unroll
    for (int j = 0; j < 4; ++j) r.v[j] = *(const f32x4*)(p + 256 * j + 4 * lane); return r; }
__device__ __forceinline__ void st_row_f32(float* p, int lane, const Row& r) {
#pragma unroll
    for (int j = 0; j < 4; ++j) __builtin_nontemporal_store(r.v[j], (f32x4*)(p + 256 * j + 4 * lane)); }
__device__ __forceinline__ Row ld_row_bf16(const bf16_t* p, int lane) { Row r;
#pragma unroll
    for (int j = 0; j < 4; ++j) r.v[j] = ld_bf16x4(p + 256 * j + 4 * lane); return r; }
__device__ __forceinline__ void st_row_bf16(bf16_t* p, int lane, const Row& r) {
#pragma unroll
    for (int j = 0; j < 4; ++j) { u32x2 w; w.x = pk2(r.v[j][0], r.v[j][1]); w.y = pk2(r.v[j][2], r.v[j][3]); __builtin_nontemporal_store(w, (u32x2*)(p + 256 * j + 4 * lane)); } }
__device__ __forceinline__ Row row_ln(const Row& u, const Row& g, const Row& b) {
    float s = 0.f;
#pragma unroll
    for (int j = 0; j < 4; ++j) s += (u.v[j][0] + u.v[j][1]) + (u.v[j][2] + u.v[j][3]);
    const float mean = wave_sum(s) * (1.0f / 1024.0f); float q = 0.f; Row d;
#pragma unroll
    for (int j = 0; j < 4; ++j) { d.v[j] = u.v[j] - mean; q += (d.v[j][0] * d.v[j][0] + d.v[j][1] * d.v[j][1]) + (d.v[j][2] * d.v[j][2] + d.v[j][3] * d.v[j][3]); }
    const float rstd = 1.0f / sqrtf(wave_sum(q) * (1.0f / 1024.0f) + LN_EPS); Row o;
#pragma unroll
    for (int j = 0; j < 4; ++j) o.v[j] = d.v[j] * rstd * g.v[j] + b.v[j];
    return o;
}
__device__ __forceinline__ float row_dot(const Row& a, const float* w, int lane) {
    float s = 0.f;
#pragma unroll
    for (int j = 0; j < 4; ++j) { const f32x4 x = *(const f32x4*)(w + 256 * j + 4 * lane); s += (a.v[j][0] * x[0] + a.v[j][1] * x[1]) + (a.v[j][2] * x[2] + a.v[j][3] * x[3]); }
    return s;
}

constexpr int APITCH = 1032;
template <int NCB>
__device__ __forceinline__ void skinny_mfma(Frame& F, const LAS bf16_t* AH, const LAS bf16_t* AL, const bf16_t* BH, const bf16_t* BL, LAS float* part) {
    const int fr = F.lane & 15, fq = F.lane >> 4;
    f32x4 acc[NCB];
#pragma unroll
    for (int cb = 0; cb < NCB; ++cb) acc[cb] = (f32x4){0.f, 0.f, 0.f, 0.f};
#pragma unroll
    for (int kb = 0; kb < 4; ++kb) {
        const int k0 = 128 * F.wave + 32 * kb + 8 * fq;
        const bf16x8 ah = *(const LAS bf16x8*)(AH + fr * APITCH + k0), al = *(const LAS bf16x8*)(AL + fr * APITCH + k0);
#pragma unroll
        for (int cb = 0; cb < NCB; ++cb) {
            const bf16x8 bh = *(const bf16x8*)(BH + (size_t)(cb * 16 + fr) * 1024 + k0), bl = *(const bf16x8*)(BL + (size_t)(cb * 16 + fr) * 1024 + k0);
            acc[cb] = __builtin_amdgcn_mfma_f32_16x16x32_bf16(bh, ah, acc[cb], 0, 0, 0);
            acc[cb] = __builtin_amdgcn_mfma_f32_16x16x32_bf16(bl, ah, acc[cb], 0, 0, 0);
            acc[cb] = __builtin_amdgcn_mfma_f32_16x16x32_bf16(bh, al, acc[cb], 0, 0, 0);
        }
    }
#pragma unroll
    for (int cb = 0; cb < NCB; ++cb) *(LAS f32x4*)(part + (F.wave * 16 + fr) * 48 + cb * 16 + 4 * fq) = acc[cb];
}
template <int NCB> struct SkB { bf16x8 h[4][NCB], l[4][NCB]; };
template <int NCB>
__device__ __forceinline__ void skinny_loadB(Frame& F, const bf16_t* BH, const bf16_t* BL, SkB<NCB>& B) {
    int ln_ = F.lane; asm volatile("" : "+v"(ln_));
    const int fr = ln_ & 15, fq = ln_ >> 4;
#pragma unroll
    for (int kb = 0; kb < 4; ++kb) { const int k0 = 128 * F.wave + 32 * kb + 8 * fq;
#pragma unroll
        for (int cb = 0; cb < NCB; ++cb) { B.h[kb][cb] = *(const bf16x8*)(BH + (size_t)(cb * 16 + fr) * 1024 + k0); B.l[kb][cb] = *(const bf16x8*)(BL + (size_t)(cb * 16 + fr) * 1024 + k0); } }
}
template <int NCB>
__device__ __forceinline__ void skinny_mma(Frame& F, const LAS bf16_t* AH, const LAS bf16_t* AL, const SkB<NCB>& B, LAS float* part) {
    const int fr = F.lane & 15, fq = F.lane >> 4;
    f32x4 acc[NCB];
#pragma unroll
    for (int cb = 0; cb < NCB; ++cb) acc[cb] = (f32x4){0.f, 0.f, 0.f, 0.f};
#pragma unroll
    for (int kb = 0; kb < 4; ++kb) {
        const int k0 = 128 * F.wave + 32 * kb + 8 * fq;
        const bf16x8 ah = *(const LAS bf16x8*)(AH + fr * APITCH + k0), al = *(const LAS bf16x8*)(AL + fr * APITCH + k0);
#pragma unroll
        for (int cb = 0; cb < NCB; ++cb) {
            acc[cb] = __builtin_amdgcn_mfma_f32_16x16x32_bf16(B.h[kb][cb], ah, acc[cb], 0, 0, 0);
            acc[cb] = __builtin_amdgcn_mfma_f32_16x16x32_bf16(B.l[kb][cb], ah, acc[cb], 0, 0, 0);
            acc[cb] = __builtin_amdgcn_mfma_f32_16x16x32_bf16(B.h[kb][cb], al, acc[cb], 0, 0, 0);
        }
    }
#pragma unroll
    for (int cb = 0; cb < NCB; ++cb) *(LAS f32x4*)(part + (F.wave * 16 + fr) * 48 + cb * 16 + 4 * fq) = acc[cb];
}
struct RowPk { u32x2 v[4]; };
__device__ __forceinline__ RowPk ld_row_pk(const bf16_t* p, int lane) { RowPk r;
#pragma unroll
    for (int j = 0; j < 4; ++j) r.v[j] = *(const u32x2*)(p + 256 * j + 4 * lane); return r; }
__device__ __forceinline__ Row unpk_row(const RowPk& p) { Row r;
#pragma unroll
    for (int j = 0; j < 4; ++j) r.v[j] = (f32x4){lo16(p.v[j].x), hi16(p.v[j].x), lo16(p.v[j].y), hi16(p.v[j].y)}; return r; }
typedef _Float16 h16x2 __attribute__((ext_vector_type(2)));
__device__ __forceinline__ unsigned pkh2(float lo, float hi) { return __builtin_bit_cast(unsigned, __builtin_amdgcn_cvt_pkrtz(lo, hi)); }
__device__ __forceinline__ Row unpk_row_h(const RowPk& p) { Row r;
#pragma unroll
    for (int j = 0; j < 4; ++j) { const unsigned wx = p.v[j].x, wy = p.v[j].y;
        const h16x2 a = __builtin_bit_cast(h16x2, wx), b = __builtin_bit_cast(h16x2, wy); r.v[j] = (f32x4){(float)a[0], (float)a[1], (float)b[0], (float)b[1]}; } return r; }
__device__ __forceinline__ void st_row_h(bf16_t* p, int lane, const Row& r) {
#pragma unroll
    for (int j = 0; j < 4; ++j) { u32x2 w; w.x = pkh2(r.v[j][0], r.v[j][1]); w.y = pkh2(r.v[j][2], r.v[j][3]); __builtin_nontemporal_store(w, (u32x2*)(p + 256 * j + 4 * lane)); } }
__device__ __forceinline__ RowPk split_row(const Row& h, LAS bf16_t* ah, LAS bf16_t* al, int lane) { RowPk hp;
#pragma unroll
    for (int j = 0; j < 4; ++j) { unsigned hb[4], lb[4];
#pragma unroll
        for (int q = 0; q < 4; ++q) { hb[q] = f2bf(h.v[j][q]); lb[q] = f2bf(h.v[j][q] - __uint_as_float(hb[q] << 16)); }
        hp.v[j].x = hb[0] | (hb[1] << 16); hp.v[j].y = hb[2] | (hb[3] << 16);
        *(LAS u32x2*)(ah + 256 * j + 4 * lane) = hp.v[j]; u32x2 lw; lw.x = lb[0] | (lb[1] << 16); lw.y = lb[2] | (lb[3] << 16); *(LAS u32x2*)(al + 256 * j + 4 * lane) = lw; }
    return hp; }

template <bool DRY = false>
__device__ __forceinline__ void tok_a(Frame& F, int l) {
    const InTab in = F.in;
    const bf16_t* Y16 = (const bf16_t*)(F.ws + WS_Y16); bf16_t* Hb = (bf16_t*)(F.ws + WS_H2); bf16_t* XS = (bf16_t*)(F.ws + WS_XS);
    const bf16_t* RTH = (const bf16_t*)(F.ws + WS_RT) + (size_t)l * 48 * 1024; const bf16_t* RTL = RTH + (size_t)4 * 48 * 1024;
    float* gates = (float*)(F.ws + WS_GATE); int* asg = (int*)(F.ws + WS_ASG);
    LAS unsigned* lcnt = (LAS unsigned*)F.lds;
    LAS unsigned* ltab = (LAS unsigned*)(F.lds + 1024);
    LAS float* lgt = (LAS float*)(F.lds + 2048);
    LAS float* part = (LAS float*)(F.lds + 8192);
    LAS bf16_t* AH = (LAS bf16_t*)(F.lds + 32768); LAS bf16_t* AL = AH + 16 * APITCH;
    const Row lng = ld_row_f32(in[I_LNG] + (size_t)(l * 2 + 0) * 1024, F.lane), lnb = ld_row_f32(in[I_LNB] + (size_t)(l * 2 + 0) * 1024, F.lane);
    LAS f32x4* MODL = (LAS f32x4*)(F.lds + 98816);
    for (int blk = F.bid; blk < T / 128; blk += F.G) {
        if (F.tid < 64) lcnt[F.tid] = 0u;
        const int tb = blk * 128, b = tb / SEQ;
        const float* mod = (const float*)(F.ws + WS_MOD) + ((size_t)l * 8 + b) * 6144;
        if (F.wave < 3) {
#pragma unroll
            for (int j = 0; j < 4; ++j) MODL[(F.wave * 4 + j) * 64 + F.lane] = *(const f32x4*)(mod + (2 + F.wave) * 1024 + 256 * j + 4 * F.lane); }
        LBAR();
#define GT_(j) MODL[(0 * 4 + (j)) * 64 + F.lane]
#define SHF_(j) MODL[(1 * 4 + (j)) * 64 + F.lane]
#define SCF_(j) MODL[(2 * 4 + (j)) * 64 + F.lane]
        float rb0, rb1;
        { const int c0_ = F.tid % 48, c1_ = (F.tid + NTHR) % 48; rb0 = (c0_ < 4) ? in[I_BGRP][l * 4 + c0_] : (c0_ < 36 ? in[I_BEXP][l * 32 + (c0_ - 4)] : 0.f); rb1 = (c1_ < 4) ? in[I_BGRP][l * 4 + c1_] : (c1_ < 36 ? in[I_BEXP][l * 32 + (c1_ - 4)] : 0.f); }
        RowPk xr[2], yr[2];
#pragma unroll
        for (int q = 0; q < 2; ++q) { const int t = tb + 2 * F.wave + q; xr[q] = ld_row_pk(XS + (size_t)t * 1024, F.lane); yr[q] = ld_row_pk(Y16 + (size_t)t * 1024, F.lane); }
        SkB<3> SB; skinny_loadB<3>(F, RTH, RTL, SB);
        for (int r = 0; r < 8; ++r) {
#pragma unroll
            for (int q = 0; q < 2; ++q) {
                const int i = 2 * F.wave + q, t = tb + 16 * r + i;
                const Row y = unpk_row(yr[q]), xq = unpk_row_h(xr[q]); Row u;
#pragma unroll
                for (int j = 0; j < 4; ++j) u.v[j] = ALPHA * xq.v[j] + (1.0f + GT_(j)) * y.v[j];
                const Row x1 = row_ln(u, lng, lnb);
                if (!DRY) st_row_h(XS + (size_t)t * 1024, F.lane, x1);
                Row h;
#pragma unroll
                for (int j = 0; j < 4; ++j) h.v[j] = x1.v[j] * (1.0f + SCF_(j)) + SHF_(j);
                const RowPk hp = split_row(h, AH + i * APITCH, AL + i * APITCH, F.lane);
#pragma unroll
                for (int j = 0; j < 4; ++j) { if (!DRY) __builtin_nontemporal_store(hp.v[j], (u32x2*)(Hb + (size_t)t * 1024 + 256 * j + 4 * F.lane)); }
            }
#if defined(TOKA_PROBE) && TOKA_PROBE == 2
            if (DRY) { if (r < 7) {
#pragma unroll
                for (int q = 0; q < 2; ++q) { const int t = tb + 16 * (r + 1) + 2 * F.wave + q; xr[q] = ld_row_pk(XS + (size_t)t * 1024, F.lane); yr[q] = ld_row_pk(Y16 + (size_t)t * 1024, F.lane); } }
                LBAR(); continue; }
#endif
            if (r < 7) {
#pragma unroll
                for (int q = 0; q < 2; ++q) { const int t = tb + 16 * (r + 1) + 2 * F.wave + q; xr[q] = ld_row_pk(XS + (size_t)t * 1024, F.lane); yr[q] = ld_row_pk(Y16 + (size_t)t * 1024, F.lane); }
            }
            LBAR();
            skinny_mma<3>(F, AH, AL, SB, part);
            LBAR();
#pragma unroll
            for (int oo = 0; oo < 2; ++oo) { const int o = F.tid + NTHR * oo; if (o < 16 * 48) { const int i = o / 48, c = o % 48; float sm = 0.f;
#pragma unroll
                for (int w = 0; w < 8; ++w) sm += part[(w * 16 + i) * 48 + c];
                lgt[o] = sm + (oo ? rb1 : rb0); } }
            LBAR();
            if (F.tid < 16) {
                const int i = F.tid, t = tb + 16 * r + i; const LAS float* lg = lgt + i * 48;
                const f32x4 lg4 = *(const LAS f32x4*)lg;
                int gs = 0; float gm = lg4[0];
#pragma unroll
                for (int c = 1; c < 4; ++c) if (lg4[c] > gm) { gm = lg4[c]; gs = c; }
                float den = 0.f;
#pragma unroll
                for (int c = 0; c < 4; ++c) den += __expf(lg4[c] - gm);
                const float pg = 1.0f / den;
                const f32x4 le0 = *(const LAS f32x4*)(lg + 4 + gs * 8), le1 = *(const LAS f32x4*)(lg + 8 + gs * 8);
                const float le[8] = {le0[0], le0[1], le0[2], le0[3], le1[0], le1[1], le1[2], le1[3]};
                int i0 = 0; float m0 = le[0];
#pragma unroll
                for (int c = 1; c < 8; ++c) if (le[c] > m0) { m0 = le[c]; i0 = c; }
                int i1 = -1; float m1 = -3.0e38f;
#pragma unroll
                for (int c = 0; c < 8; ++c) if (c != i0 && le[c] > m1) { m1 = le[c]; i1 = c; }
                const float a = __expf(m1 - m0), g0 = pg / (1.0f + a), g1 = pg * a / (1.0f + a);
                const int e0 = gs * 8 + i0, e1 = gs * 8 + i1;
                const unsigned r0 = atomicAdd((unsigned*)&lcnt[e0], 1u), r1 = atomicAdd((unsigned*)&lcnt[e1], 1u);
                ltab[(16 * r + i) * 2] = ((unsigned)e0 << 24) | r0; ltab[(16 * r + i) * 2 + 1] = ((unsigned)e1 << 24) | r1;
                if (!DRY) { gates[(size_t)t * 2] = g0; gates[(size_t)t * 2 + 1] = g1; }
            }
        }
        LBAR();
        if (F.tid < 32) lcnt[32 + F.tid] = DRY ? 0u : __hip_atomic_fetch_add((unsigned*)(F.ws + WS_CTL) + CW_CNT + l * 32 + F.tid, lcnt[F.tid], __ATOMIC_RELAXED, __HIP_MEMORY_SCOPE_AGENT);
        LBAR();
        if (F.tid < 256 && !DRY) { const unsigned w = ltab[F.tid]; const unsigned e = w >> 24; const unsigned rk = (w & 0xffffffu) + lcnt[32 + e]; asg[(size_t)tb * 2 + F.tid] = (int)((e << 24) | rk);
            ((int*)(F.ws + WS_TLIST))[(size_t)e * 65536 + rk] = tb + (F.tid >> 1); }
        LBAR();
    }
}
#undef GT_
#undef SHF_
#undef SCF_
__device__ __forceinline__ void fgate_phase(Frame& F) {
    const InTab in = F.in;
    const bf16_t* WFH = (const bf16_t*)(F.ws + WS_WF); const bf16_t* WFL = WFH + 16 * 1024; float* LF = (float*)(F.ws + WS_LF); const bf16_t* XS = (const bf16_t*)(F.ws + WS_XS);
    LAS float* part = (LAS float*)(F.lds + 8192);
    LAS bf16_t* AH = (LAS bf16_t*)(F.lds + 32768); LAS bf16_t* AL = AH + 16 * APITCH;
    for (int blk = F.bid; blk < T / 128; blk += F.G) {
        const int tb = blk * 128, b = tb / SEQ;
        const float* kvm = (const float*)(F.ws + WS_KVMOD) + (size_t)b * 2048;
        const Row ksh = ld_row_f32(kvm, F.lane), ksc = ld_row_f32(kvm + 1024, F.lane);
        RowPk xr[2];
#pragma unroll
        for (int q = 0; q < 2; ++q) xr[q] = ld_row_pk(XS + (size_t)(tb + 2 * F.wave + q) * 1024, F.lane);
        SkB<1> SBF; skinny_loadB<1>(F, WFH, WFL, SBF);
        LBAR();
        for (int r = 0; r < 8; ++r) {
#pragma unroll
            for (int q = 0; q < 2; ++q) { const int i = 2 * F.wave + q; Row hk; const Row xq = unpk_row_h(xr[q]);
#pragma unroll
                for (int j = 0; j < 4; ++j) hk.v[j] = xq.v[j] * (1.0f + ksc.v[j]) + ksh.v[j];
                (void)split_row(hk, AH + i * APITCH, AL + i * APITCH, F.lane); }
            if (r < 7) {
#pragma unroll
                for (int q = 0; q < 2; ++q) xr[q] = ld_row_pk(XS + (size_t)(tb + 16 * (r + 1) + 2 * F.wave + q) * 1024, F.lane);
            }
            LBAR();
            skinny_mma<1>(F, AH, AL, SBF, part);
            LBAR();
            if (F.tid < 256) { const int i = F.tid >> 4, c = F.tid & 15; float sm = 0.f;
#pragma unroll
                for (int w = 0; w < 8; ++w) sm += part[(w * 16 + i) * 48 + c];
                const float z = sm + in[I_KVFB][c]; LF[(size_t)(tb + 16 * r + i) * 16 + c] = fminf(z, 0.f) - log1pf(__expf(-fabsf(z))); }
        }
        LBAR();
    }
}

template <bool DRY = false>
__device__ __forceinline__ void tok_b(Frame& F, int l, int next) {
    const InTab in = F.in;
    bf16_t* Hb = (bf16_t*)(F.ws + WS_H2); bf16_t* HK = (bf16_t*)(F.ws + WS_RA); bf16_t* XS = (bf16_t*)(F.ws + WS_XS);
    const bf16_t* YM = (const bf16_t*)(F.ws + WS_RA + 144 * MiB);
    const int* asg = (const int*)(F.ws + WS_ASG); const float* gates = (const float*)(F.ws + WS_GATE); const LAS int* lc = (const LAS int*)(F.lds + MOE_LC_OFF);
    const Row lng = ld_row_f32(in[I_LNG] + (size_t)(l * 2 + 1) * 1024, F.lane), lnb = ld_row_f32(in[I_LNB] + (size_t)(l * 2 + 1) * 1024, F.lane);
    const int gw = F.bid * NWAVES + F.wave, NGW = F.G * NWAVES;
    for (int run = gw; run < T / 8; run += NGW) {
        const int t0 = run * 8, b = t0 / SEQ;
        const Row gt = ld_row_f32((const float*)(F.ws + WS_MOD) + ((size_t)l * 8 + b) * 6144 + 5 * 1024, F.lane);
        Row shm, scm;
        if (next < 3) { const float* modn = (const float*)(F.ws + WS_MOD) + ((size_t)(l + 1) * 8 + b) * 6144; shm = ld_row_f32(modn, F.lane); scm = ld_row_f32(modn + 1024, F.lane); }
        else { shm = Row{}; scm = Row{}; }
        int dmine = 0; float gmine = 0.f;
        if (F.lane < 16) { const unsigned a = (unsigned)asg[(size_t)t0 * 2 + F.lane]; dmine = lc[32 + (a >> 24)] + (int)(a & 0xffffffu); gmine = gates[(size_t)t0 * 2 + F.lane]; }
        RowPk xc = ld_row_pk(XS + (size_t)t0 * 1024, F.lane);
        RowPk y0c = ld_row_pk(YM + (size_t)__shfl(dmine, 0) * 1024, F.lane), y1c = ld_row_pk(YM + (size_t)__shfl(dmine, 1) * 1024, F.lane);
        for (int tt = 0; tt < 8; ++tt) {
            const int t = t0 + tt, tn = (tt < 7) ? tt + 1 : tt;
            const RowPk xn = ld_row_pk(XS + (size_t)(t0 + tn) * 1024, F.lane);
            const RowPk y0n = ld_row_pk(YM + (size_t)__shfl(dmine, 2 * tn) * 1024, F.lane), y1n = ld_row_pk(YM + (size_t)__shfl(dmine, 2 * tn + 1) * 1024, F.lane);
            const float g0 = __shfl(gmine, 2 * tt), g1 = __shfl(gmine, 2 * tt + 1);
            const Row y0 = unpk_row(y0c), y1 = unpk_row(y1c), xq = unpk_row_h(xc); Row u;
#pragma unroll
            for (int j = 0; j < 4; ++j) u.v[j] = ALPHA * xq.v[j] + (1.0f + gt.v[j]) * (g0 * y0.v[j] + g1 * y1.v[j]);
            const Row x2 = row_ln(u, lng, lnb);
            if (!DRY) { if (l == 3) st_row_f32(F.xs + (size_t)t * 1024, F.lane, x2); else st_row_h(XS + (size_t)t * 1024, F.lane, x2); } else asm volatile("" :: "v"(x2.v[0]), "v"(x2.v[1]), "v"(x2.v[2]), "v"(x2.v[3]));
            if (next != 3) {
                Row h;
#pragma unroll
                for (int j = 0; j < 4; ++j) h.v[j] = x2.v[j] * (1.0f + scm.v[j]) + shm.v[j];
                if (!DRY) st_row_bf16(Hb + (size_t)t * 1024, F.lane, h); else asm volatile("" :: "v"(h.v[0]), "v"(h.v[3]));
                if (next == 1) {
                    const float* kvm = (const float*)(F.ws + WS_KVMOD) + (size_t)b * 2048;
                    const Row ksh = ld_row_f32(kvm, F.lane), ksc = ld_row_f32(kvm + 1024, F.lane); Row hk;
#pragma unroll
                    for (int j = 0; j < 4; ++j) hk.v[j] = x2.v[j] * (1.0f + ksc.v[j]) + ksh.v[j];
                    if (!DRY) st_row_bf16(HK + (size_t)t * 1024, F.lane, hk); else asm volatile("" :: "v"(hk.v[0]), "v"(hk.v[3]));
                }
            }
            xc = xn; y0c = y0n; y1c = y1n;
        }
    }
}

__device__ __forceinline__ void rw_prep(Frame& F, int ln, bool from_input) {
    bf16_t* Hb = (bf16_t*)(F.ws + WS_H2); bf16_t* X3 = (bf16_t*)(F.ws + WS_SC);
    const float* src = F.in[I_X]; bf16_t* XS = (bf16_t*)(F.ws + WS_XS);
    const float* mu = F.in[I_MU] + (size_t)ln * 6 * 1024;
    const Row mur = ld_row_f32(mu, F.lane), muk = ld_row_f32(mu + 2 * 1024, F.lane), muv = ld_row_f32(mu + 3 * 1024, F.lane);
    const int gw = F.bid * NWAVES + F.wave, NGW = F.G * NWAVES;
    for (int run = gw; run < T / 8; run += NGW) {
        const int t0 = run * 8, b = t0 / SEQ;
        const float* modn = (const float*)(F.ws + WS_MOD) + ((size_t)ln * 8 + b) * 6144;
        const Row shm = ld_row_f32(modn, F.lane), scm = ld_row_f32(modn + 1024, F.lane);
        Row hprev;
#pragma unroll
        for (int j = 0; j < 4; ++j) hprev.v[j] = (f32x4){0.f, 0.f, 0.f, 0.f};
        if ((t0 % SEQ) != 0) {
            const Row xp = from_input ? ld_row_f32(src + (size_t)(t0 - 1) * 1024, F.lane) : unpk_row_h(ld_row_pk(XS + (size_t)(t0 - 1) * 1024, F.lane));
#pragma unroll
            for (int j = 0; j < 4; ++j) hprev.v[j] = xp.v[j] * (1.0f + scm.v[j]) + shm.v[j];
        }
        Row xc = Row{}; RowPk xcp = RowPk{};
        if (from_input) xc = ld_row_f32(src + (size_t)t0 * 1024, F.lane); else xcp = ld_row_pk(XS + (size_t)t0 * 1024, F.lane);
        for (int tt = 0; tt < 8; ++tt) {
            const int t = t0 + tt, tnx = t0 + (tt < 7 ? tt + 1 : tt);
            const Row x = from_input ? xc : unpk_row_h(xcp);
            if (from_input) xc = ld_row_f32(src + (size_t)tnx * 1024, F.lane); else xcp = ld_row_pk(XS + (size_t)tnx * 1024, F.lane);
            if (from_input) st_row_h(XS + (size_t)t * 1024, F.lane, x);
            Row h, xx, xr, xk, xv;
#pragma unroll
            for (int j = 0; j < 4; ++j) { h.v[j] = x.v[j] * (1.0f + scm.v[j]) + shm.v[j]; xx.v[j] = hprev.v[j] - h.v[j];
                xr.v[j] = h.v[j] + xx.v[j] * mur.v[j]; xk.v[j] = h.v[j] + xx.v[j] * muk.v[j]; xv.v[j] = h.v[j] + xx.v[j] * muv.v[j]; }
            st_row_bf16(Hb + (size_t)t * 2048, F.lane, h); st_row_bf16(Hb + (size_t)t * 2048 + 1024, F.lane, xx);
            st_row_bf16(X3 + (size_t)t * 1024, F.lane, xr); st_row_bf16(X3 + X3S + (size_t)t * 1024, F.lane, xk); st_row_bf16(X3 + 2 * X3S + (size_t)t * 1024, F.lane, xv);
            hprev = h;
        }
    }
}

__device__ __forceinline__ void moe_tables(Frame& F, int l) {
    LAS int* lc = (LAS int*)(F.lds + MOE_LC_OFF);
    const unsigned* cnt = (const unsigned*)(F.ws + WS_CTL) + CW_CNT + l * 32;
    if (F.tid == 0) {
        int acc = 0, ntt = 0;
        for (int e = 0; e < 32; ++e) { const int c = (int)__hip_atomic_load(cnt + e, __ATOMIC_RELAXED, __HIP_MEMORY_SCOPE_AGENT); lc[e] = c; lc[32 + e] = acc; const int nt = (c + 255) >> 8;
            for (int i = 0; i < nt; ++i) lc[96 + ntt + i] = (e << 16) | i;
            ntt += nt; acc += nt << 8; }
        lc[64] = ntt;
    }
    __syncthreads();
}
template <class Sched> __device__ __forceinline__ void moe_rows(Frame& F, const Sched& S) {
    const LAS int* lc = (const LAS int*)(F.lds + MOE_LC_OFF); LAS int* tokL = (LAS int*)(F.lds + MOE_TOKL_OFF); const int* tlist = (const int*)(F.ws + WS_TLIST);
    Unit u;
    for (int i = 0; i < 6 && S.next(i, u); ++i) {
        if (F.tid < 256) { const int ek = lc[96 + u.pm], e = ek >> 16, rank = ((ek & 0xffff) << 8) + F.tid;
            tokL[i * 256 + F.tid] = tlist[(size_t)e * 65536 + (rank < lc[e] ? rank : 0)]; }
    }
    __syncthreads();
}

__device__ __forceinline__ float octsum(float v) { v += dpp_f<0xB1>(v); v += dpp_f<0x4E>(v); v += dpp_f<0x141>(v); return v; }
constexpr int CP = 72, SLOT = 64 * CP;
#define PX(r_, c_) ((r_) * 64 + (((((c_) >> 3) ^ (((r_) >> 1) & 7))) << 3) + ((c_) & 7))
constexpr size_t WS_MP = WS_SC, WS_QQ = WS_SC + 64 * MiB, WS_NT = WS_SC + 128 * MiB, WS_GL = WS_SC + 192 * MiB;
template <bool SWAP> __device__ __forceinline__ f32x4 tile_mm(const LAS bf16_t* Ap, const LAS bf16_t* Bp, int fr, int fq) {
    const int o0 = PX(fr, 8 * fq), o1 = PX(fr, 8 * fq + 32);
    const bf16x8 a0 = *(const LAS bf16x8*)(Ap + o0), a1 = *(const LAS bf16x8*)(Ap + o1);
    const bf16x8 b0 = *(const LAS bf16x8*)(Bp + o0), b1 = *(const LAS bf16x8*)(Bp + o1);
    f32x4 acc = (f32x4){0.f, 0.f, 0.f, 0.f};
    if (!SWAP) { acc = __builtin_amdgcn_mfma_f32_16x16x32_bf16(a0, b0, acc, 0, 0, 0); acc = __builtin_amdgcn_mfma_f32_16x16x32_bf16(a1, b1, acc, 0, 0, 0); }
    else       { acc = __builtin_amdgcn_mfma_f32_16x16x32_bf16(b0, a0, acc, 0, 0, 0); acc = __builtin_amdgcn_mfma_f32_16x16x32_bf16(b1, a1, acc, 0, 0, 0); }
    return acc;
}
__device__ __forceinline__ void ld8f(const float* p, float (&o)[8]) { const f32x4 a = *(const f32x4*)p, b = *(const f32x4*)(p + 4); o[0] = a[0]; o[1] = a[1]; o[2] = a[2]; o[3] = a[3]; o[4] = b[0]; o[5] = b[1]; o[6] = b[2]; o[7] = b[3]; }
__device__ __forceinline__ void st4_lds(LAS bf16_t* p, f32x4 v) { u32x2 w; w.x = pk2(v[0], v[1]); w.y = pk2(v[2], v[3]); *(LAS u32x2*)p = w; }
__device__ __forceinline__ f32x4 ld4_lds(const LAS bf16_t* p) { const u32x2 w = *(const LAS u32x2*)p; return (f32x4){lo16(w.x), hi16(w.x), lo16(w.y), hi16(w.y)}; }
__device__ __forceinline__ void unpk8(const u32x4 w, float (&o)[8]) { o[0] = lo16(w.x); o[1] = hi16(w.x); o[2] = lo16(w.y); o[3] = hi16(w.y); o[4] = lo16(w.z); o[5] = hi16(w.z); o[6] = lo16(w.w); o[7] = hi16(w.w); }
__device__ __forceinline__ void st8_lds(LAS bf16_t* p, const float (&o)[8]) { u32x4 w; w.x = pk2(o[0], o[1]); w.y = pk2(o[2], o[3]); w.z = pk2(o[4], o[5]); w.w = pk2(o[6], o[7]); *(LAS u32x4*)p = w; }

template <int PROBE = 0>
__device__ __forceinline__ void wkv_chunk_prep(Frame& F, int l) {
    const InTab in = F.in;
    const bf16_t* RKV = (const bf16_t*)(F.ws + WS_RA);
    bf16_t* YS = (bf16_t*)(F.ws + WS_Y16); bf16_t* MP = (bf16_t*)(F.ws + WS_MP); bf16_t* QQ = (bf16_t*)(F.ws + WS_QQ); bf16_t* NTt = (bf16_t*)(F.ws + WS_NT); float* GLB = (float*)(F.ws + WS_GL);
    LAS bf16_t* L0 = (LAS bf16_t*)F.lds;
#define SL(n) (L0 + (n) * 4096)
    LAS float* WLs = (LAS float*)(F.lds + 8 * 8192);
    LAS float* SEG = WLs + 64 * 65;
    const int pt = F.tid >> 3, pc0 = 8 * (F.tid & 7);
    const bf16_t* LAg = (const bf16_t*)(F.ws + WS_RA + 192 * MiB); const bf16_t* VFg = (const bf16_t*)(F.ws + WS_P); float* BON = (float*)(F.ws + WS_LF);
    const bf16_t* W2T = (const bf16_t*)(F.ws + WS_LORA2 + (size_t)l * MiB + L2_W2T); const bf16_t* A2T = (const bf16_t*)(F.ws + WS_LORA2 + (size_t)l * MiB + L2_A2T); const bf16_t* V2T = (const bf16_t*)(F.ws + WS_LORA2 + (size_t)l * MiB + L2_V2T);
    u32x4 gr, gk, gv, glw, gla, glv, gvf, gw2, ga2, gv2;
#define PREP_LOAD(uu) do { const int bh_ = (uu) >> 6, c_ = (uu) & 63; const size_t row = (size_t)(bh_ >> 4) * SEQ + 64 * c_ + pt; const int hh = (bh_ & 15) * 64, hc = hh + pc0; \
        gr = *(const u32x4*)(RKV + row * 3072 + hc); gk = *(const u32x4*)(RKV + row * 3072 + 1024 + hc); gv = (l == 0) ? *(const u32x4*)(VFg + row * 1024 + hc) : *(const u32x4*)(RKV + row * 3072 + 2048 + hc); \
        glw = *(const u32x4*)(LAg + row * LAW + pc0); gla = *(const u32x4*)(LAg + row * LAW + 64 + pc0); \
        gw2 = *(const u32x4*)(W2T + (size_t)(hh + pt) * 64 + pc0); ga2 = *(const u32x4*)(A2T + (size_t)(hh + pt) * 64 + pc0); \
        if (l == 1) { glv = *(const u32x4*)(LAg + row * LAW + 288 + (pc0 & 31)); gvf = *(const u32x4*)(VFg + row * 1024 + hc); gv2 = *(const u32x4*)(V2T + (size_t)(hh + pt) * 64 + pc0); } } while (0)
    glv = (u32x4){0u, 0u, 0u, 0u}; gvf = glv; gv2 = glv;
    if (F.bid < 128 * 64) PREP_LOAD(F.bid);
    for (int u = F.bid; u < 128 * 64; u += F.G) {
        const int bh = u >> 6, c = u & 63, b = bh >> 4, h = bh & 15;
        const size_t row0 = (size_t)b * SEQ + 64 * c;
        int ln_ = F.lane; asm volatile("" : "+v"(ln_));
        const int fr = ln_ & 15, fq = ln_ >> 4;
        *(LAS u32x4*)(SL(0) + PX(pt, pc0)) = glw; *(LAS u32x4*)(SL(1) + PX(pt, pc0)) = gla; *(LAS u32x4*)(SL(3) + PX(pt, pc0)) = gw2; *(LAS u32x4*)(SL(4) + PX(pt, pc0)) = ga2;
        if (l == 1) { *(LAS u32x4*)(SL(2) + PX(pt, pc0)) = (pc0 < 32) ? glv : (u32x4){0u, 0u, 0u, 0u}; *(LAS u32x4*)(SL(5) + PX(pt, pc0)) = gv2; }
        LBAR();
        {
            f32x4 zw[2], za[2], zv[2];
#pragma unroll
            for (int i = 0; i < 2; ++i) { const int tile = F.wave + 8 * i, mt = tile >> 2, nt = tile & 3;
                zw[i] = tile_mm<false>(SL(0) + 16 * mt * 64, SL(3) + 16 * nt * 64, fr, fq);
                za[i] = tile_mm<true>(SL(1) + 16 * mt * 64, SL(4) + 16 * nt * 64, fr, fq);
                if (l == 1) zv[i] = tile_mm<true>(SL(2) + 16 * mt * 64, SL(5) + 16 * nt * 64, fr, fq); }
#pragma unroll
            for (int i = 0; i < 2; ++i) { const int tile = F.wave + 8 * i, mt = tile >> 2, nt = tile & 3; const int rr = 16 * mt + fr, cc = 16 * nt + 4 * fq;
                const float w0s = in[I_W0][l * 1024 + h * 64 + 16 * nt + fr]; const f32x4 a0v = *(const f32x4*)(in[I_A0] + l * 1024 + h * 64 + cc); f32x4 av, wh, wlo;
#pragma unroll
                for (int q = 0; q < 4; ++q) { const float wl_ = -0.6065306597126334f * sigmoidf_(zw[i][q] + w0s); wh[q] = bf2f((unsigned short)f2bf(wl_)); wlo[q] = wl_ - wh[q]; av[q] = sigmoidf_(za[i][q] + a0v[q]); }
                st4_lds(SL(11) + PX(16 * nt + fr, 16 * mt + 4 * fq), wh); st4_lds(SL(12) + PX(16 * nt + fr, 16 * mt + 4 * fq), wlo);
                st4_lds(SL(6) + PX(rr, cc), av);
                if (l == 1) { const f32x4 v0v = *(const f32x4*)(in[I_V0] + h * 64 + cc); f32x4 sv;
#pragma unroll
                    for (int q = 0; q < 4; ++q) sv[q] = sigmoidf_(zv[i][q] + v0v[q]);
                    st4_lds(SL(7) + PX(rr, cc), sv); } }
        }
        LBAR();
        float r[8], k[8], v[8], a[8];
        unpk8(gr, r); unpk8(gk, k); unpk8(gv, v); unpk8(*(const LAS u32x4*)(SL(6) + PX(pt, pc0)), a);
        if (l == 1) { float sv[8], vf[8]; unpk8(*(const LAS u32x4*)(SL(7) + PX(pt, pc0)), sv); unpk8(gvf, vf);
#pragma unroll
            for (int q = 0; q < 8; ++q) v[q] = bf2f((unsigned short)f2bf(v[q] + (vf[q] - v[q]) * sv[q]));
            if (PROBE == 0) { u32x4 w; w.x = pk2(v[0], v[1]); w.y = pk2(v[2], v[3]); w.z = pk2(v[4], v[5]); w.w = pk2(v[6], v[7]); *(u32x4*)((bf16_t*)RKV + (row0 + pt) * 3072 + 2048 + h * 64 + pc0) = w; } }
        {
            f32x4 cs[2];
#pragma unroll
            for (int i = 0; i < 2; ++i) { const int tile = F.wave + 8 * i, mt = tile >> 2, nt = tile & 3;
                bf16x8 l0, l1;
#pragma unroll
                for (int e = 0; e < 8; ++e) { l0[e] = (short)((8 * fq + e <= 16 * mt + fr) ? 0x3F80 : 0); l1[e] = (short)((32 + 8 * fq + e <= 16 * mt + fr) ? 0x3F80 : 0); }
                const int c0_ = PX(16 * nt + fr, 8 * fq), c1_ = PX(16 * nt + fr, 8 * fq + 32); const LAS bf16_t* bh = SL(11); const LAS bf16_t* bl = SL(12);
                f32x4 acc = (f32x4){0.f, 0.f, 0.f, 0.f};
                acc = __builtin_amdgcn_mfma_f32_16x16x32_bf16(*(const LAS bf16x8*)(bh + c0_), l0, acc, 0, 0, 0); acc = __builtin_amdgcn_mfma_f32_16x16x32_bf16(*(const LAS bf16x8*)(bh + c1_), l1, acc, 0, 0, 0);
                acc = __builtin_amdgcn_mfma_f32_16x16x32_bf16(*(const LAS bf16x8*)(bl + c0_), l0, acc, 0, 0, 0); acc = __builtin_amdgcn_mfma_f32_16x16x32_bf16(*(const LAS bf16x8*)(bl + c1_), l1, acc, 0, 0, 0);
                cs[i] = acc; }
#pragma unroll
            for (int i = 0; i < 2; ++i) { const int tile = F.wave + 8 * i, mt = tile >> 2, nt = tile & 3; const int rr = 16 * mt + fr, cc = 16 * nt + 4 * fq;
#pragma unroll
                for (int q = 0; q < 4; ++q) WLs[rr * 65 + cc + q] = cs[i][q]; }
        }
        LBAR();
        {
            float kkw[8], kaw[8], rkw[8]; ld8f(in[I_KK] + l * 1024 + h * 64 + pc0, kkw); ld8f(in[I_KA] + l * 1024 + h * 64 + pc0, kaw); ld8f(in[I_RK] + l * 1024 + h * 64 + pc0, rkw);
            float kr[8], ss = 0.f, bs = 0.f;
#pragma unroll
            for (int q = 0; q < 8; ++q) { kr[q] = k[q] * kkw[q]; ss += kr[q] * kr[q]; }
            ss = octsum(ss);
            const float inv = 1.0f / fmaxf(sqrtf(ss), 1e-12f);
            float At[8], Rt[8], Bt[8], Kt[8], Bb[8], Kb[8], gl[8];
#pragma unroll
            for (int q = 0; q < 8; ++q) {
                const float cum = WLs[pt * 65 + pc0 + q], cl = WLs[63 * 65 + pc0 + q], cex = (pt > 0) ? WLs[(pt - 1) * 65 + pc0 + q] : 0.f;
                const float e_in = __expf(cum), e_ex = __expf(cex), e_ng = __expf(-cum); gl[q] = __expf(cl);
                const float kk = kr[q] * inv, kp = k[q] * (1.0f + (a[q] - 1.0f) * kaw[q]); bs += r[q] * kp * rkw[q];
                At[q] = -kk * e_ex; Rt[q] = r[q] * e_in; Bt[q] = kk * a[q] * e_ng; Kt[q] = kp * e_ng; Bb[q] = Bt[q] * gl[q]; Kb[q] = Kt[q] * gl[q];
            }
            st8_lds(SL(0) + PX(pt, pc0), At); st8_lds(SL(1) + PX(pt, pc0), Rt); st8_lds(SL(2) + PX(pt, pc0), Bt); st8_lds(SL(3) + PX(pt, pc0), Kt);
            st8_lds(SL(11) + PX(pt, pc0), v); st8_lds(SL(12) + PX(pt, pc0), Bb); st8_lds(SL(13) + PX(pt, pc0), Kb);
            bs = octsum(bs); if ((F.tid & 7) == 0 && PROBE == 0) BON[(row0 + pt) * 16 + h] = bs;
            if (pt == 0 && PROBE == 0) { float* g = GLB + (size_t)u * 64 + pc0; *(f32x4*)g = (f32x4){gl[0], gl[1], gl[2], gl[3]}; *(f32x4*)(g + 4) = (f32x4){gl[4], gl[5], gl[6], gl[7]}; }
        }
        LBAR();
        {
            const int j = F.tid & 63, t0 = 8 * (F.tid >> 6);
#define TRANSP(src, dst) do { float e[8]; _Pragma("unroll") for (int q = 0; q < 8; ++q) e[q] = bf2f(SL(src)[PX(t0 + q, j)]); st8_lds(SL(dst) + PX(j, t0), e); } while (0)
            TRANSP(0, 6); TRANSP(12, 7); TRANSP(13, 5); TRANSP(11, 4);
#undef TRANSP
            if (u + F.G < 128 * 64) PREP_LOAD(u + F.G);
        }
        LBAR();
        if (PROBE == 1) continue;
        {
            f32x4 acc[8];
#pragma unroll
            for (int i = 0; i < 8; ++i) acc[i] = tile_mm<true>(SL(0) + 16 * i * 64, SL(2) + 16 * F.wave * 64, fr, fq);
            const int nt = F.wave, sq0 = (nt & 3) * 16 + 4 * fq;
#pragma unroll
            for (int i = 0; i < 8; ++i) {
                const int mt = i, tq = (mt & 3) * 16 + fr; f32x4 o;
#pragma unroll
                for (int q = 0; q < 4; ++q) { const int sq = sq0 + q; const bool keep = (mt < 4) ? (sq < tq) : (sq <= tq); o[q] = keep ? acc[i][q] : 0.f; }
                LAS bf16_t* dst = (mt < 4) ? ((nt < 4) ? SL(8) : SL(10)) : ((nt < 4) ? SL(11) : SL(12));
                st4_lds(dst + PX(tq, sq0), o);
                if (mt < 4 && nt < 4) {
#pragma unroll
                    for (int q = 0; q < 4; ++q) SL(9)[PX(sq0 + q, tq)] = (bf16_t)f2bf(o[q]); }
            }
        }
        LBAR();
        {
            f32x4 x[2], y1[2], nk[2];
#pragma unroll
            for (int i = 0; i < 2; ++i) { const int tile = F.wave + 8 * i, mt = tile >> 2, nt = tile & 3;
                x[i] = tile_mm<false>(SL(10) + 16 * mt * 64, SL(4) + 16 * nt * 64, fr, fq);
                y1[i] = tile_mm<true>(SL(12) + 16 * mt * 64, SL(4) + 16 * nt * 64, fr, fq);
                nk[i] = tile_mm<false>(SL(5) + 16 * mt * 64, SL(4) + 16 * nt * 64, fr, fq); }
#pragma unroll
            for (int i = 0; i < 2; ++i) { const int tile = F.wave + 8 * i, mt = tile >> 2, nt = tile & 3;
                st4_lds(SL(2) + PX(16 * nt + fr, 16 * mt + 4 * fq), x[i]);
                st4_lds(SL(3) + PX(16 * mt + fr, 16 * nt + 4 * fq), y1[i]);
                st4_lds(SL(0) + PX(16 * nt + fr, 16 * mt + 4 * fq), nk[i]); }
        }
        LBAR();
        if (PROBE == 2) continue;
#define NEU_SQ(Xn, Xt, On, Ot, WANT_NAT) do { f32x4 s_[2]; \
            _Pragma("unroll") for (int i = 0; i < 2; ++i) { const int tile = F.wave + 8 * i, mt = tile >> 2, nt = tile & 3; s_[i] = tile_mm<true>(SL(Xn) + 16 * mt * 64, SL(Xt) + 16 * nt * 64, fr, fq); } \
            _Pragma("unroll") for (int i = 0; i < 2; ++i) { const int tile = F.wave + 8 * i, mt = tile >> 2, nt = tile & 3; \
                if (WANT_NAT) st4_lds(SL(On) + PX(16 * mt + fr, 16 * nt + 4 * fq), s_[i]); \
                _Pragma("unroll") for (int q = 0; q < 4; ++q) SL(Ot)[PX(16 * nt + 4 * fq + q, 16 * mt + fr)] = (bf16_t)f2bf(s_[i][q]); } } while (0)
#define NEU_PR(Ti, Yt, To) do { f32x4 p_[2]; \
            _Pragma("unroll") for (int i = 0; i < 2; ++i) { const int tile = F.wave + 8 * i, mt = tile >> 2, nt = tile & 3; \
                p_[i] = tile_mm<true>(SL(Ti) + 16 * mt * 64, SL(Yt) + 16 * nt * 64, fr, fq) + ld4_lds(SL(Ti) + PX(16 * mt + fr, 16 * nt + 4 * fq)); } \
            _Pragma("unroll") for (int i = 0; i < 2; ++i) { const int tile = F.wave + 8 * i, mt = tile >> 2, nt = tile & 3; st4_lds(SL(To) + PX(16 * mt + fr, 16 * nt + 4 * fq), p_[i]); } } while (0)
#define NEU_BOTH(Ti, Yt, To, Xn, Xt, On, Ot, WANT_NAT) do { f32x4 p_[2], s_[2]; \
            _Pragma("unroll") for (int i = 0; i < 2; ++i) { const int tile = F.wave + 8 * i, mt = tile >> 2, nt = tile & 3; \
                p_[i] = tile_mm<true>(SL(Ti) + 16 * mt * 64, SL(Yt) + 16 * nt * 64, fr, fq) + ld4_lds(SL(Ti) + PX(16 * mt + fr, 16 * nt + 4 * fq)); \
                s_[i] = tile_mm<true>(SL(Xn) + 16 * mt * 64, SL(Xt) + 16 * nt * 64, fr, fq); } \
            _Pragma("unroll") for (int i = 0; i < 2; ++i) { const int tile = F.wave + 8 * i, mt = tile >> 2, nt = tile & 3; \
                st4_lds(SL(To) + PX(16 * mt + fr, 16 * nt + 4 * fq), p_[i]); \
                if (WANT_NAT) st4_lds(SL(On) + PX(16 * mt + fr, 16 * nt + 4 * fq), s_[i]); \
                _Pragma("unroll") for (int q = 0; q < 4; ++q) SL(Ot)[PX(16 * nt + 4 * fq + q, 16 * mt + fr)] = (bf16_t)f2bf(s_[i][q]); } } while (0)
        NEU_SQ(8, 9, 10, 12, true);
        LBAR();
        {
            f32x4 p_[2];
#pragma unroll
            for (int i = 0; i < 2; ++i) { const int tile = F.wave + 8 * i, mt = tile >> 2, nt = tile & 3; const int rr = 16 * mt + fr, cc = 16 * nt + 4 * fq;
                p_[i] = tile_mm<true>(SL(8) + 16 * mt * 64, SL(12) + 16 * nt * 64, fr, fq) + ld4_lds(SL(8) + PX(rr, cc)) + ld4_lds(SL(10) + PX(rr, cc));
#pragma unroll
                for (int q = 0; q < 4; ++q) if (cc + q == rr) p_[i][q] += 1.0f; }
            NEU_SQ(10, 12, 5, 13, true);
#pragma unroll
            for (int i = 0; i < 2; ++i) { const int tile = F.wave + 8 * i, mt = tile >> 2, nt = tile & 3; st4_lds(SL(4) + PX(16 * mt + fr, 16 * nt + 4 * fq), p_[i]); }
        }
        LBAR();
        NEU_BOTH(4, 13, 8, 5, 13, 9, 10, true);
        LBAR();
        NEU_BOTH(8, 10, 4, 9, 10, 5, 12, true);
        LBAR();
        NEU_BOTH(4, 12, 8, 5, 12, 5, 13, false);
        LBAR();
        NEU_PR(8, 13, 4);
        LBAR();
#undef NEU_SQ
#undef NEU_PR
#undef NEU_BOTH
        if (PROBE == 3) continue;
        {
            f32x4 p[2], u0[2];
#pragma unroll
            for (int i = 0; i < 2; ++i) { const int tile = F.wave + 8 * i, mt = tile >> 2, nt = tile & 3;
                p[i] = tile_mm<false>(SL(4) + 16 * mt * 64, SL(6) + 16 * nt * 64, fr, fq);
                u0[i] = tile_mm<false>(SL(4) + 16 * mt * 64, SL(2) + 16 * nt * 64, fr, fq); }
#pragma unroll
            for (int i = 0; i < 2; ++i) { const int tile = F.wave + 8 * i, mt = tile >> 2, nt = tile & 3;
                st4_lds(SL(9) + PX(16 * nt + fr, 16 * mt + 4 * fq), p[i]); st4_lds(SL(10) + PX(16 * nt + fr, 16 * mt + 4 * fq), u0[i]); }
        }
        LBAR();
        {
            f32x4 qv[2], y0[2], mp[2], ntv[2];
#pragma unroll
            for (int i = 0; i < 2; ++i) { const int tile = F.wave + 8 * i, mt = tile >> 2, nt = tile & 3; const int rr = 16 * mt + fr, cc = 16 * nt + 4 * fq, ri = 16 * nt + fr, cj = 16 * mt + 4 * fq;
                qv[i] = tile_mm<true>(SL(11) + 16 * mt * 64, SL(9) + 16 * nt * 64, fr, fq) + ld4_lds(SL(1) + PX(rr, cc));
                y0[i] = tile_mm<true>(SL(11) + 16 * mt * 64, SL(10) + 16 * nt * 64, fr, fq) + ld4_lds(SL(3) + PX(rr, cc));
                mp[i] = tile_mm<true>(SL(7) + 16 * mt * 64, SL(9) + 16 * nt * 64, fr, fq);
                ntv[i] = tile_mm<false>(SL(7) + 16 * mt * 64, SL(10) + 16 * nt * 64, fr, fq) + ld4_lds(SL(0) + PX(ri, cj)); }
#pragma unroll
            for (int i = 0; i < 2; ++i) { const int tile = F.wave + 8 * i, mt = tile >> 2, nt = tile & 3; const int rr = 16 * mt + fr, cc = 16 * nt + 4 * fq, ri = 16 * nt + fr, cj = 16 * mt + 4 * fq;
                st4_lds(SL(5) + PX(rr, cc), qv[i]); st4_lds(SL(8) + PX(rr, cc), y0[i]); st4_lds(SL(12) + PX(rr, cc), mp[i]); st4_lds(SL(13) + PX(ri, cj), ntv[i]); }
        }
        LBAR();
        if (PROBE == 0) {
            const int rw = F.tid >> 3, ch = 8 * (F.tid & 7);
            *(u32x4*)(QQ + ((size_t)u * 64 + rw) * 64 + ch) = *(const LAS u32x4*)(SL(5) + PX(rw, ch));
            *(u32x4*)(MP + ((size_t)u * 64 + rw) * 64 + ch) = *(const LAS u32x4*)(SL(12) + PX(rw, ch));
            *(u32x4*)(NTt + ((size_t)u * 64 + rw) * 64 + ch) = *(const LAS u32x4*)(SL(13) + PX(rw, ch));
            *(u32x4*)(YS + (row0 + rw) * 1024 + h * 64 + ch) = *(const LAS u32x4*)(SL(8) + PX(rw, ch));
        }
        LBAR();
    }
#undef PREP_LOAD
#undef SL
}

__device__ __forceinline__ void wkv_chunk_seq(Frame& F, int l) {
    bf16_t* YS = (bf16_t*)(F.ws + WS_Y16); const bf16_t* MP = (const bf16_t*)(F.ws + WS_MP); const bf16_t* QQ = (const bf16_t*)(F.ws + WS_QQ); const bf16_t* NTt = (const bf16_t*)(F.ws + WS_NT); const float* GLB = (const float*)(F.ws + WS_GL);
    LAS bf16_t* Zt = (LAS bf16_t*)F.lds;
    const bf16_t* RKVc = (const bf16_t*)(F.ws + WS_RA); const bf16_t* VFc = (const bf16_t*)(F.ws + WS_P); const bf16_t* G16 = (const bf16_t*)(F.ws + WS_RA + 224 * MiB); const float* BON = (const float*)(F.ws + WS_LF); bf16_t* OG = (bf16_t*)(F.ws + WS_H2);
    LAS bf16_t* Yb = Zt + 2 * SLOT;
    const int fr = F.lane & 15, fq = F.lane >> 4, mt = F.wave >> 1, ntb = 2 * (F.wave & 1);
    struct Ops { bf16x8 m0, m1, q0, q1; f32x4 gl; u32x2 n0, n1, y0, y1; };
    for (int item = F.bid; item < 128; item += F.G) {
        const int bh = item, b = bh >> 4, h = bh & 15; const size_t rowb = (size_t)b * SEQ;
        float gng[8], gnb[8]; ld8f(F.in[I_GNG] + l * 1024 + h * 64 + 8 * (F.tid & 7), gng); ld8f(F.in[I_GNB] + l * 1024 + h * 64 + 8 * (F.tid & 7), gnb);
        for (int i = F.tid; i < 2 * SLOT / 2; i += NTHR) ((LAS unsigned*)Zt)[i] = 0u;
        f32x4 Z0 = (f32x4){0.f, 0.f, 0.f, 0.f}, Z1 = Z0;
        LBAR();
#define SEQ_LOAD(O, cc_) do { const size_t cu = (size_t)bh * 64 + (cc_); \
        const bf16_t* mp = MP + (cu * 64 + 16 * mt + fr) * 64 + 8 * fq; O.m0 = *(const bf16x8*)mp; O.m1 = *(const bf16x8*)(mp + 32); \
        const bf16_t* qp = QQ + (cu * 64 + 16 * mt + fr) * 64 + 8 * fq; O.q0 = *(const bf16x8*)qp; O.q1 = *(const bf16x8*)(qp + 32); \
        O.gl = *(const f32x4*)(GLB + cu * 64 + 16 * mt + 4 * fq); \
        const bf16_t* np_ = NTt + (cu * 64 + 16 * ntb + fr) * 64 + 16 * mt + 4 * fq; O.n0 = *(const u32x2*)np_; O.n1 = *(const u32x2*)(np_ + 16 * 64); \
        const bf16_t* yp = YS + (rowb + 64 * (cc_) + 16 * mt + fr) * 1024 + h * 64 + 16 * ntb + 4 * fq; O.y0 = *(const u32x2*)yp; O.y1 = *(const u32x2*)(yp + 16); } while (0)
#define SEQ_STEP(O, cc_) do { const LAS bf16_t* Zc = Zt + ((cc_) & 1) * SLOT; LAS bf16_t* Zn = Zt + (((cc_) + 1) & 1) * SLOT; \
        const LAS bf16_t* z0p = Zc + (16 * ntb + fr) * CP + 8 * fq; const LAS bf16_t* z1p = z0p + 16 * CP; \
        const bf16x8 b00 = *(const LAS bf16x8*)z0p, b01 = *(const LAS bf16x8*)(z0p + 32), b10 = *(const LAS bf16x8*)z1p, b11 = *(const LAS bf16x8*)(z1p + 32); \
        f32x4 a0 = (f32x4){0.f, 0.f, 0.f, 0.f}, a1 = a0, c0 = a0, c1 = a0; \
        a0 = __builtin_amdgcn_mfma_f32_16x16x32_bf16(O.m0, b00, a0, 0, 0, 0); a0 = __builtin_amdgcn_mfma_f32_16x16x32_bf16(O.m1, b01, a0, 0, 0, 0); \
        a1 = __builtin_amdgcn_mfma_f32_16x16x32_bf16(O.m0, b10, a1, 0, 0, 0); a1 = __builtin_amdgcn_mfma_f32_16x16x32_bf16(O.m1, b11, a1, 0, 0, 0); \
        c0 = __builtin_amdgcn_mfma_f32_16x16x32_bf16(b00, O.q0, c0, 0, 0, 0); c0 = __builtin_amdgcn_mfma_f32_16x16x32_bf16(b01, O.q1, c0, 0, 0, 0); \
        c1 = __builtin_amdgcn_mfma_f32_16x16x32_bf16(b10, O.q0, c1, 0, 0, 0); c1 = __builtin_amdgcn_mfma_f32_16x16x32_bf16(b11, O.q1, c1, 0, 0, 0); \
        Z0 = O.gl * Z0 + a0 + (f32x4){lo16(O.n0.x), hi16(O.n0.x), lo16(O.n0.y), hi16(O.n0.y)}; Z1 = O.gl * Z1 + a1 + (f32x4){lo16(O.n1.x), hi16(O.n1.x), lo16(O.n1.y), hi16(O.n1.y)}; \
        { LAS bf16_t* yl = Yb + (((cc_) & 7) * 64 + 16 * mt + fr) * CP + 16 * ntb + 4 * fq; \
          st4_lds(yl, c0 + (f32x4){lo16(O.y0.x), hi16(O.y0.x), lo16(O.y0.y), hi16(O.y0.y)}); st4_lds(yl + 16, c1 + (f32x4){lo16(O.y1.x), hi16(O.y1.x), lo16(O.y1.y), hi16(O.y1.y)}); } \
        st4_lds(Zn + (16 * ntb + fr) * CP + 16 * mt + 4 * fq, Z0); st4_lds(Zn + (16 * ntb + 16 + fr) * CP + 16 * mt + 4 * fq, Z1); \
        LBAR(); \
        if (((cc_) & 7) == 7) { _Pragma("unroll 2") for (int i_ = 0; i_ < 8; ++i_) { const int o_ = F.tid + NTHR * i_, ck_ = o_ >> 9, rw_ = (o_ >> 3) & 63, ch_ = 8 * (o_ & 7); \
            const size_t tr_ = rowb + 64 * ((cc_) - 7 + ck_) + rw_; float y_[8], v_[8], g_[8]; \
            unpk8(*(const LAS u32x4*)(Yb + (ck_ * 64 + rw_) * CP + ch_), y_); unpk8((l == 0) ? *(const u32x4*)(VFc + tr_ * 1024 + h * 64 + ch_) : *(const u32x4*)(RKVc + tr_ * 3072 + 2048 + h * 64 + ch_), v_); unpk8(*(const u32x4*)(G16 + tr_ * 1024 + h * 64 + ch_), g_); \
            const float bs_ = BON[tr_ * 16 + h]; float s_ = 0.f; _Pragma("unroll") for (int q_ = 0; q_ < 8; ++q_) s_ += y_[q_]; s_ = octsum(s_); const float mean_ = s_ * (1.0f / 64.0f); \
            float qq_ = 0.f; _Pragma("unroll") for (int q_ = 0; q_ < 8; ++q_) { const float d_ = y_[q_] - mean_; qq_ += d_ * d_; } qq_ = octsum(qq_); const float rstd_ = 1.0f / sqrtf(qq_ * (1.0f / 64.0f) + GN_EPS); \
            float o8_[8]; _Pragma("unroll") for (int q_ = 0; q_ < 8; ++q_) o8_[q_] = (((y_[q_] - mean_) * rstd_) * gng[q_] + gnb[q_] + bs_ * v_[q_]) * g_[q_]; \
            u32x4 w_; w_.x = pk2(o8_[0], o8_[1]); w_.y = pk2(o8_[2], o8_[3]); w_.z = pk2(o8_[4], o8_[5]); w_.w = pk2(o8_[6], o8_[7]); *(u32x4*)(OG + tr_ * 1024 + h * 64 + ch_) = w_; } LBAR(); } } while (0)
        Ops A, B, C;
        SEQ_LOAD(A, 0); SEQ_LOAD(B, 1);
#pragma unroll 1
        for (int c = 0; c < 63; c += 3) {
            SEQ_LOAD(C, c + 2); SEQ_STEP(A, c);
            SEQ_LOAD(A, c + 3); SEQ_STEP(B, c + 1);
            if (c + 4 < 64) SEQ_LOAD(B, c + 4);
            SEQ_STEP(C, c + 2);
        }
        SEQ_STEP(A, 63);
#undef SEQ_LOAD
#undef SEQ_STEP
    }
}

__device__ __forceinline__ void ld16(const bf16_t* p, float (&o)[16]) {
    const u32x4 a = *(const u32x4*)p, b = *(const u32x4*)(p + 8);
    o[0] = lo16(a.x); o[1] = hi16(a.x); o[2] = lo16(a.y); o[3] = hi16(a.y); o[4] = lo16(a.z); o[5] = hi16(a.z); o[6] = lo16(a.w); o[7] = hi16(a.w);
    o[8] = lo16(b.x); o[9] = hi16(b.x); o[10] = lo16(b.y); o[11] = hi16(b.y); o[12] = lo16(b.z); o[13] = hi16(b.z); o[14] = lo16(b.w); o[15] = hi16(b.w);
}
__device__ __forceinline__ void st16(bf16_t* p, const float (&o)[16]) {
    u32x4 a, b; a.x = pk2(o[0], o[1]); a.y = pk2(o[2], o[3]); a.z = pk2(o[4], o[5]); a.w = pk2(o[6], o[7]); b.x = pk2(o[8], o[9]); b.y = pk2(o[10], o[11]); b.z = pk2(o[12], o[13]); b.w = pk2(o[14], o[15]);
    *(u32x4*)p = a; *(u32x4*)(p + 8) = b;
}
__device__ __forceinline__ void ld16f(const float* p, float (&o)[16]) {
#pragma unroll
    for (int j = 0; j < 4; ++j) { const f32x4 v = *(const f32x4*)(p + 4 * j); o[4 * j] = v[0]; o[4 * j + 1] = v[1]; o[4 * j + 2] = v[2]; o[4 * j + 3] = v[3]; }
}
__device__ __forceinline__ void wkv_post(Frame& F, int l) {
    const InTab in = F.in;
    const bf16_t* RKV = (const bf16_t*)(F.ws + WS_RA); const bf16_t* G16 = (const bf16_t*)(F.ws + WS_RA + 224 * MiB); const float* BON = (const float*)(F.ws + WS_LF);
    const bf16_t* YS = (const bf16_t*)(F.ws + WS_Y16); bf16_t* OG = (bf16_t*)(F.ws + WS_H2);
    const int c0 = 16 * F.lane;
    float gg[16], gb[16];
    ld16f(in[I_GNG] + l * 1024 + c0, gg); ld16f(in[I_GNB] + l * 1024 + c0, gb);
    const int gw = F.bid * NWAVES + F.wave, NGW = F.G * NWAVES;
    for (int t = gw; t < T; t += NGW) {
        float y[16], v[16], g[16];
        ld16(YS + (size_t)t * 1024 + c0, y); ld16(RKV + (size_t)t * 3072 + 2048 + c0, v); ld16(G16 + (size_t)t * 1024 + c0, g);
        const float bs = BON[(size_t)t * 16 + (F.lane >> 2)];
        float s = 0.f;
#pragma unroll
        for (int i = 0; i < 16; ++i) s += y[i];
        s = quadsum(s);
        const float mean = s * (1.0f / 64.0f); float q = 0.f;
#pragma unroll
        for (int i = 0; i < 16; ++i) { const float d = y[i] - mean; q += d * d; }
        q = quadsum(q);
        const float rstd = 1.0f / sqrtf(q * (1.0f / 64.0f) + GN_EPS);
        float o[16];
#pragma unroll
        for (int i = 0; i < 16; ++i) o[i] = (((y[i] - mean) * rstd) * gg[i] + gb[i] + bs * v[i]) * g[i];
        st16(OG + (size_t)t * 1024 + c0, o);
    }
}

__device__ __forceinline__ void kv_post(Frame& F) {
    const InTab in = F.in;
    bf16_t* Kb = (bf16_t*)(F.ws + WS_P); const float* LF = (const float*)(F.ws + WS_LF); float* KBv = (float*)(F.ws + WS_KB);
    const int c0 = 16 * F.lane;
    float kn[16]; ld16f(in[I_KNORM] + (c0 & 63), kn);
    const int gw = F.bid * NWAVES + F.wave, NGW = F.G * NWAVES;
    for (int t = gw; t < T; t += NGW) {
        float k[16]; ld16(Kb + (size_t)t * 1024 + c0, k);
        float s = 0.f;
#pragma unroll
        for (int i = 0; i < 16; ++i) s += k[i] * k[i];
        s = quadsum(s);
        const float rs = 1.0f / sqrtf(s * (1.0f / 64.0f) + QK_EPS);
#pragma unroll
        for (int i = 0; i < 16; ++i) k[i] = k[i] * rs * kn[i];
        st16(Kb + (size_t)t * 1024 + c0, k);
    }
    for (int bh = gw; bh < 128; bh += NGW) {
        const int b = bh >> 4, h = bh & 15; const size_t base = ((size_t)b * SEQ + 64 * F.lane) * 16 + h;
        float s = 0.f;
        for (int i = 0; i < 64; ++i) s += LF[base + (size_t)i * 16];
        float incl = s;
#pragma unroll
        for (int o = 1; o < 64; o <<= 1) { const float n = __shfl_up(incl, o); if (F.lane >= o) incl += n; }
        float run = incl - s;
        float kfirst = 0.f, klast = 0.f;
        for (int i = 0; i < 64; ++i) { run += LF[base + (size_t)i * 16]; const float kbv = -run * LOG2E; KBv[(size_t)bh * SEQ + 64 * F.lane + i] = kbv; if (i == 0) kfirst = kbv; klast = kbv; }
        int* T0 = (int*)(F.ws + WS_T0) + bh * 16;
        for (int qb = 0; qb < 16; ++qb) {
            const float thr = __shfl(kfirst, 4 * qb) - 70.0f;
            const unsigned long long skip = __ballot(klast < thr);
            int t0 = (skip == ~0ull) ? 64 : __builtin_ctzll(~skip); const int nt = 4 * qb + 4;
            t0 &= ~1; if (t0 > nt - 4) t0 = nt - 4;
            if (F.lane == 0) T0[qb] = t0;
        }
    }
}

namespace attn_body {
using bf16=__hip_bfloat16;
using bf16x8=__attribute__((ext_vector_type(8)))short;
using s16x4=__attribute__((ext_vector_type(4)))short;
using f32x16=__attribute__((ext_vector_type(16)))float;
using u32x4=__attribute__((ext_vector_type(4)))unsigned;
constexpr int BATCH=8,NHEAD=16,SEQ=4096,D=64,DM=NHEAD*D;
constexpr int NW=8,QBLK=32,QB=QBLK*NW,KVBLK=64,NQB=SEQ/QB;
constexpr int ATTN_PITCH=DM, ATTN_UNIT_ROWS=QB;
__device__ __forceinline__ int crow(int r,int hi){return (r&3)+8*(r>>2)+4*hi;}
#define SBAR() __builtin_amdgcn_sched_barrier(0)
__device__ __forceinline__ void cmask(f32x16&p0,f32x16&p1,int jb,int qrel,int hi){
  const float NEG=-INFINITY; int kb=64*jb+4*hi;
  #pragma unroll
  for(int r=0;r<16;++r){int kv=kb+(r&3)+8*(r>>2); if(kv>qrel)p0[r]=NEG; if(kv+32>qrel)p1[r]=NEG;}
}

constexpr int NSLOT=3, SLOTB=8192;
constexpr int LDS_K=0, LDS_V=NSLOT*SLOTB, LDS_WS=2*NSLOT*SLOTB, LDS_OST=LDS_WS+NW*64*4, LDS_KBIAS=LDS_OST+NW*4096, LDS_BYTES=LDS_KBIAS+SEQ*4;
constexpr float C2=0.125f*1.4426950408889634f;
__device__ __forceinline__ void glds16(const void*gsrc,unsigned lds_dst){unsigned keep;
  asm volatile("s_mov_b32 %0, m0\n\ts_mov_b32 m0, %2\n\ts_nop 0\n\tglobal_load_lds_dwordx4 %1, off\n\ts_mov_b32 m0, %0":"=&s"(keep):"v"(gsrc),"s"(lds_dst):"memory");}
__device__ __forceinline__ float max3f(float a,float b,float c){float r;asm("v_max3_f32 %0, %1, %2, %3":"=v"(r):"v"(a),"v"(b),"v"(c));return r;}
__device__ __forceinline__ float max2f(float a,float b){float r;asm("v_max_f32_e32 %0, %1, %2":"=v"(r):"v"(a),"v"(b));return r;}
__device__ __forceinline__ float fadd_s(float a,float b){float r;asm("v_add_f32_e32 %0, %1, %2":"=v"(r):"v"(a),"v"(b));return r;}
__device__ __forceinline__ float fsub_s(float a,float b){float r;asm("v_sub_f32_e32 %0, %1, %2":"=v"(r):"v"(a),"v"(b));return r;}
typedef float f32x2_t __attribute__((ext_vector_type(2))); typedef __bf16 bf16x2_t __attribute__((ext_vector_type(2)));
__device__ __forceinline__ unsigned cvtpk_s(float lo,float hi){f32x2_t v={lo,hi};bf16x2_t b=__builtin_convertvector(v,bf16x2_t);return __builtin_bit_cast(unsigned,b);}
#define WAIT_BAR(N) asm volatile("s_waitcnt vmcnt(" #N ") lgkmcnt(0)\n\ts_barrier":::"memory")

__device__ __forceinline__ void qkt(f32x16&p0,f32x16&p1,const char*Kslot,const bf16x8*qr,const f32x16&negm,int r32,int hi){
  const char*kb=Kslot+hi*1024+r32*16;
  #pragma unroll
  for(int d0=0;d0<4;++d0){
    const bf16x8 b0=*reinterpret_cast<const bf16x8*>(kb+d0*2048);
    const bf16x8 b1=*reinterpret_cast<const bf16x8*>(kb+d0*2048+512);
    if(d0==0){p0=__builtin_amdgcn_mfma_f32_32x32x16_bf16(b0,qr[0],negm,0,0,0);p1=__builtin_amdgcn_mfma_f32_32x32x16_bf16(b1,qr[0],negm,0,0,0);}
    else{p0=__builtin_amdgcn_mfma_f32_32x32x16_bf16(b0,qr[d0],p0,0,0,0);p1=__builtin_amdgcn_mfma_f32_32x32x16_bf16(b1,qr[d0],p1,0,0,0);}}
}
typedef __attribute__((address_space(3))) const char* lds_cptr;
typedef short v4i16_t __attribute__((ext_vector_type(4)));
__device__ __forceinline__ void kload8(bf16x8*kf,lds_cptr kp){
  kf[0]=*(const __attribute__((address_space(3))) bf16x8*)(kp);      kf[1]=*(const __attribute__((address_space(3))) bf16x8*)(kp+512);
  kf[2]=*(const __attribute__((address_space(3))) bf16x8*)(kp+2048); kf[3]=*(const __attribute__((address_space(3))) bf16x8*)(kp+2560);
  kf[4]=*(const __attribute__((address_space(3))) bf16x8*)(kp+4096); kf[5]=*(const __attribute__((address_space(3))) bf16x8*)(kp+4608);
  kf[6]=*(const __attribute__((address_space(3))) bf16x8*)(kp+6144); kf[7]=*(const __attribute__((address_space(3))) bf16x8*)(kp+6656);
}
__device__ __forceinline__ void kload2(bf16x8*kf,lds_cptr kp,int j){ kf[2*j]=*(const __attribute__((address_space(3))) bf16x8*)(kp+j*2048); kf[2*j+1]=*(const __attribute__((address_space(3))) bf16x8*)(kp+j*2048+512); }
__device__ __forceinline__ s16x4 vtr(lds_cptr p){ return __builtin_bit_cast(s16x4,__builtin_amdgcn_ds_read_tr16_b64_v4i16((__attribute__((address_space(3))) v4i16_t*)p)); }
__device__ __forceinline__ float rowmax(const f32x16&p0,const f32x16&p1){
  float a=max3f(p0[0],p0[1],p1[0]),b=max3f(p0[2],p0[3],p1[1]);a=max3f(a,p1[2],p1[3]);
  #pragma unroll
  for(int r=4;r<16;r+=4){a=max3f(a,p0[r],p0[r+1]);b=max3f(b,p0[r+2],p0[r+3]);a=max3f(a,p1[r],p1[r+1]);b=max3f(b,p1[r+2],p1[r+3]);}
  const float m=max2f(a,b);
  auto rr=__builtin_amdgcn_permlane32_swap(__float_as_uint(m),__float_as_uint(m),false,false);
  return max2f(__uint_as_float(rr[0]),__uint_as_float(rr[1]));
}
__device__ __forceinline__ void pv(f32x16*o,int vb,bf16x8 pa0,bf16x8 pa1,bf16x8 pa2,bf16x8 pa3){
  #pragma unroll
  for(int d0=0;d0<2;++d0){s16x4 lo[4],hi[4];
    #pragma unroll
    for(int ks=0;ks<4;++ks){
      asm volatile("ds_read_b64_tr_b16 %0,%1 offset:%c2":"=&v"(lo[ks]):"v"(vb),"i"(d0*4096+ks*1024):"memory");
      asm volatile("ds_read_b64_tr_b16 %0,%1 offset:%c2":"=&v"(hi[ks]):"v"(vb),"i"(d0*4096+ks*1024+512):"memory");}
    asm volatile("s_waitcnt lgkmcnt(0)":::"memory");SBAR();
    #define PK(k) (bf16x8){lo[k][0],lo[k][1],lo[k][2],lo[k][3],hi[k][0],hi[k][1],hi[k][2],hi[k][3]}
    o[d0]=__builtin_amdgcn_mfma_f32_32x32x16_bf16(pa0,PK(0),o[d0],0,0,0);
    o[d0]=__builtin_amdgcn_mfma_f32_32x32x16_bf16(pa1,PK(1),o[d0],0,0,0);
    o[d0]=__builtin_amdgcn_mfma_f32_32x32x16_bf16(pa2,PK(2),o[d0],0,0,0);
    o[d0]=__builtin_amdgcn_mfma_f32_32x32x16_bf16(pa3,PK(3),o[d0],0,0,0);
    #undef PK
  }
}

#ifndef ATTN_STORE16
#define ATTN_STORE16(p,v) (*(u32x4*)(p)=(v))
#endif
template<int THRL> __device__ __forceinline__ void attn_unit(int tid,int wid,int b,int h,int qb,int t0,const bf16*Q,const bf16*__restrict__ K,const bf16*__restrict__ V,bf16*O,const bf16*G,const float*kbrow,const float*qnorm,char*shm){
  int lane=tid&63; asm volatile("":"+v"(lane));
  const int r32=lane&31,hi=lane>>5; wid=__builtin_amdgcn_readfirstlane(wid);
  const long rowbase=(long)b*SEQ; const int q0=qb*QB;
  const bf16*Qw=Q+(rowbase+q0+wid*QBLK)*DM+h*D;
  const bf16*Kh=K+(rowbase+(long)t0*KVBLK)*DM+h*D,*Vh=V+(rowbase+(long)t0*KVBLK)*DM+h*D; kbrow+=t0*KVBLK;
  const unsigned lds0=(unsigned)(uintptr_t)shm;
  float*wsf=(float*)(shm+LDS_WS)+wid*64;
  const bf16*ksrc=Kh+(long)lane*DM+wid*8;
  const bf16*vsrc=Vh+(long)(16*(wid&3)+(lane>>2))*DM+(wid>>2)*32+(lane&3)*8;
  const unsigned kdst=lds0+LDS_K+wid*1024, vdst=lds0+LDS_V+wid*1024;
  #define DMA_K(t,slot) glds16(ksrc+(long)(t)*KVBLK*DM,(unsigned)__builtin_amdgcn_readfirstlane(kdst+(slot)))
  #define DMA_V(t,slot) glds16(vsrc+(long)(t)*KVBLK*DM,(unsigned)__builtin_amdgcn_readfirstlane(vdst+(slot)))
  const int vb0=(int)(lds0+LDS_V)+((lane>>4)&1)*32+(lane&3)*8+(4*hi+((lane&15)>>2))*64;
  const char*Kbase=shm+LDS_K; bf16x8 kf[8];
  const lds_cptr shm3=(lds_cptr)shm; const lds_cptr kp0=shm3+LDS_K+hi*1024+r32*16; const lds_cptr vp0=shm3+LDS_V+((lane>>4)&1)*32+(lane&3)*8+(4*hi+((lane&15)>>2))*64;
  const int NT=(q0+QB)/KVBLK-t0;
  typedef float f32x4_t __attribute__((ext_vector_type(4))); typedef __attribute__((address_space(3))) const float* lds_fptr;
  const lds_fptr kbl=(lds_fptr)(shm3+LDS_KBIAS);
  { __attribute__((address_space(3))) f32x4_t* kw=(__attribute__((address_space(3))) f32x4_t*)(shm3+LDS_KBIAS); const f32x4_t* kg=(const f32x4_t*)kbrow;
    for(int i=tid;i<NT*KVBLK/4;i+=NW*64) kw[i]=kg[i]; }
  DMA_K(0,0);DMA_V(0,0);DMA_K(1,SLOTB);
  bf16x8 qr[4];
  #pragma unroll
  for(int d0=0;d0<4;++d0)qr[d0]=*reinterpret_cast<const bf16x8*>(&Qw[(long)r32*DM+d0*16+hi*8]);
  { float qf[4][8]; float ss=0.f;
    #pragma unroll
    for(int d0=0;d0<4;++d0){
      #pragma unroll
      for(int j=0;j<8;++j){ qf[d0][j]=__uint_as_float(((unsigned)(unsigned short)qr[d0][j])<<16); ss+=qf[d0][j]*qf[d0][j]; } }
    { auto rr=__builtin_amdgcn_permlane32_swap(__float_as_uint(ss),__float_as_uint(ss),false,false); ss=__uint_as_float(rr[0])+__uint_as_float(rr[1]); }
    const float qs=C2/sqrtf(ss*(1.0f/64.0f)+1e-6f);
    #pragma unroll
    for(int d0=0;d0<4;++d0){ const float*qn=qnorm+d0*16+hi*8; u32x4 w;
      w[0]=cvtpk_s(qf[d0][0]*qs*qn[0],qf[d0][1]*qs*qn[1]); w[1]=cvtpk_s(qf[d0][2]*qs*qn[2],qf[d0][3]*qs*qn[3]); w[2]=cvtpk_s(qf[d0][4]*qs*qn[4],qf[d0][5]*qs*qn[5]); w[3]=cvtpk_s(qf[d0][6]*qs*qn[6],qf[d0][7]*qs*qn[7]);
      qr[d0]=__builtin_bit_cast(bf16x8,w); } }
  float mhat=0.f,l_reg=0.f;f32x16 o[2];o[0]=f32x16{};o[1]=f32x16{};const f32x16 negm=f32x16{};
  const int qrel=wid*QBLK+r32;
  #define CMASK(P0,P1,t) do{int jb_=(t)-(NT-4); if(jb_>=0)cmask(P0,P1,jb_,qrel,hi);}while(0)
  #define KBIAS(P0,P1,t) do{ const lds_fptr kp_=kbl+64*(t)+4*hi; \
    _Pragma("unroll") for(int g_=0;g_<4;++g_){ const f32x4_t a_=*(const __attribute__((address_space(3))) f32x4_t*)(kp_+8*g_)-mhat, b_=*(const __attribute__((address_space(3))) f32x4_t*)(kp_+32+8*g_)-mhat; \
      _Pragma("unroll") for(int j_=0;j_<4;++j_){ P0[4*g_+j_]+=a_[j_]; P1[4*g_+j_]+=b_[j_]; } } }while(0)
  bool resc=false;
  #define START(P0,P1) do{ const float rm=rowmax(P0,P1); resc=false; \
    { const float dl=rm; mhat=fadd_s(mhat,dl); \
      _Pragma("unroll") for(int r=0;r<16;++r){P0[r]=fsub_s(P0[r],dl);P1[r]=fsub_s(P1[r],dl);} } \
    _Pragma("unroll") for(int r=0;r<16;++r)P0[r]=__builtin_amdgcn_exp2f(P0[r]); }while(0)
  #define RESC() do{ if(resc){ asm volatile("s_waitcnt lgkmcnt(0)":::"memory"); \
      _Pragma("unroll") for(int d_=0;d_<2;++d_) _Pragma("unroll") for(int r=0;r<16;++r)o[d_][r]*=wsf[crow(r,hi)]; } }while(0)
  f32x16 pA0,pA1,pB0,pB1;
  int sl_prev=0,sl_cur=0,sl_next=SLOTB;
  #define ROT() do{sl_prev=sl_cur;sl_cur=sl_next;sl_next=(sl_next==(NSLOT-1)*SLOTB)?0:sl_next+SLOTB;}while(0)
  DMA_K(2,2*SLOTB);
  WAIT_BAR(3);
  qkt(pA0,pA1,Kbase,qr,negm,r32,hi);asm volatile("s_nop 15\n\ts_nop 7":"+v"(pA0),"+v"(pA1));KBIAS(pA0,pA1,0);CMASK(pA0,pA1,0);
  START(pA0,pA1);
  _Pragma("unroll") for(int r=0;r<16;++r)pA1[r]=__builtin_amdgcn_exp2f(pA1[r]);
  WAIT_BAR(0);
  DMA_K(3,0);DMA_V(1,SLOTB);
  ROT();
  kload8(kf,kp0+sl_cur);
  WAIT_BAR(2);
  s16x4 vlo[8],vhi[8]; u32x4 pw0,pw1,pw2,pw3;
  #define PKW(P,B) cvtpk_s(P[B],P[B+1])
  #define PAF(k) __builtin_bit_cast(bf16x8,pw##k)
  #define VFR(i) (bf16x8){vlo[i][0],vlo[i][1],vlo[i][2],vlo[i][3],vhi[i][0],vhi[i][1],vhi[i][2],vhi[i][3]}
  #define PIN(x) asm volatile("":"+v"(x))
  #define MX3(a,b,c) __builtin_fmaxf(__builtin_fmaxf((a),(b)),(c))
  #define GAPA(MF,A0,A1,A2,A3,W0,W1,PW) do{ MF; sacc+=A0; sacc+=A1; sacc+=A2; sacc+=A3; PIN(sacc); W0; W1; PIN(PW); SBAR(); }while(0)
  #define EX(v) __builtin_amdgcn_exp2f(v)
  #define GAPB(MF,X,B) do{ MF; X[B]=EX(X[B]); X[B+1]=EX(X[B+1]); X[B+2]=EX(X[B+2]); X[B+3]=EX(X[B+3]); PIN(X); SBAR(); }while(0)
  #define VRD(i) do{ vlo[i]=vtr(vp_+(((i)>>2)*4096+((i)&3)*1024)); vhi[i]=vtr(vp_+(((i)>>2)*4096+((i)&3)*1024+512)); }while(0)
  #define KRD(G,j) do{ if(G){ kload2(kf,kp0+sl_next,j); SBAR(); } }while(0)
  #define STEP(C0,C1,P0,P1,t,GK,GV,GL) do{ SBAR(); \
    const lds_cptr vp_=vp0+sl_prev; \
    VRD(0); SBAR(); float sacc=(P0[0]+P0[1]); \
    GAPA(C0=__builtin_amdgcn_mfma_f32_32x32x16_bf16(kf[0],qr[0],negm,0,0,0), P0[2],P0[3],P0[4],P0[5],     pw0[0]=PKW(P0,0), pw0[1]=PKW(P0,2), pw0); \
    VRD(4); SBAR(); GAPA(C1=__builtin_amdgcn_mfma_f32_32x32x16_bf16(kf[1],qr[0],negm,0,0,0), P0[6],P0[7],P0[8],P0[9],     pw0[2]=PKW(P0,4), pw0[3]=PKW(P0,6), pw0); \
    VRD(1); SBAR(); GAPA(C0=__builtin_amdgcn_mfma_f32_32x32x16_bf16(kf[2],qr[1],C0,0,0,0),   P0[10],P0[11],P0[12],P0[13], pw1[0]=PKW(P0,8), pw1[1]=PKW(P0,10), pw1); \
    VRD(5); SBAR(); GAPA(C1=__builtin_amdgcn_mfma_f32_32x32x16_bf16(kf[3],qr[1],C1,0,0,0),   P0[14],P0[15],P1[0],P1[1],   pw1[2]=PKW(P0,12),pw1[3]=PKW(P0,14), pw1); \
    VRD(2); SBAR(); GAPA(C0=__builtin_amdgcn_mfma_f32_32x32x16_bf16(kf[4],qr[2],C0,0,0,0),   P1[2],P1[3],P1[4],P1[5],     pw2[0]=PKW(P1,0), pw2[1]=PKW(P1,2), pw2); \
    VRD(6); SBAR(); GAPA(C1=__builtin_amdgcn_mfma_f32_32x32x16_bf16(kf[5],qr[2],C1,0,0,0),   P1[6],P1[7],P1[8],P1[9],     pw2[2]=PKW(P1,4), pw2[3]=PKW(P1,6), pw2); \
    VRD(3); SBAR(); GAPA(C0=__builtin_amdgcn_mfma_f32_32x32x16_bf16(kf[6],qr[3],C0,0,0,0),   P1[10],P1[11],P1[12],P1[13], pw3[0]=PKW(P1,8), pw3[1]=PKW(P1,10), pw3); \
    VRD(7); SBAR(); GAPA(C1=__builtin_amdgcn_mfma_f32_32x32x16_bf16(kf[7],qr[3],C1,0,0,0),   P1[14],P1[15],0.f,0.f,       pw3[2]=PKW(P1,12),pw3[3]=PKW(P1,14), pw3); \
    l_reg+=sacc; \
    if(GK){DMA_K((t)+3,sl_cur);} if(GV){DMA_V((t)+1,sl_next);} \
    KBIAS(C0,C1,t); CMASK(C0,C1,t); \
    { float a=MX3(C0[0],C0[1],C1[0]),b=MX3(C0[2],C0[3],C1[1]); a=MX3(a,C1[2],C1[3]); \
      _Pragma("unroll") for(int r=4;r<16;r+=4){a=MX3(a,C0[r],C0[r+1]);b=MX3(b,C0[r+2],C0[r+3]);a=MX3(a,C1[r],C1[r+1]);b=MX3(b,C1[r+2],C1[r+3]);} \
      float rm=__builtin_fmaxf(a,b); { auto rr=__builtin_amdgcn_permlane32_swap(__float_as_uint(rm),__float_as_uint(rm),false,false); rm=__builtin_fmaxf(__uint_as_float(rr[0]),__uint_as_float(rr[1])); } \
      resc=false; \
      if(__builtin_expect(__any(rm>(float)THRL),0)){ const float dl=__builtin_fmaxf(rm,0.f); mhat+=dl; \
        _Pragma("unroll") for(int r=0;r<16;++r){C0[r]-=dl;C1[r]-=dl;} \
        const float f=__builtin_amdgcn_exp2f(-dl); l_reg*=f; if(hi==0)wsf[r32]=f; resc=true; } } \
    SBAR(); \
    GAPB(o[0]=__builtin_amdgcn_mfma_f32_32x32x16_bf16(PAF(0),VFR(0),o[0],0,0,0), C0,0); \
    GAPB(o[1]=__builtin_amdgcn_mfma_f32_32x32x16_bf16(PAF(0),VFR(4),o[1],0,0,0), C0,4); \
    KRD(GL,0); GAPB(o[0]=__builtin_amdgcn_mfma_f32_32x32x16_bf16(PAF(1),VFR(1),o[0],0,0,0), C0,8); \
    KRD(GL,1); GAPB(o[1]=__builtin_amdgcn_mfma_f32_32x32x16_bf16(PAF(1),VFR(5),o[1],0,0,0), C0,12); \
    KRD(GL,2); GAPB(o[0]=__builtin_amdgcn_mfma_f32_32x32x16_bf16(PAF(2),VFR(2),o[0],0,0,0), C1,0); \
    KRD(GL,3); GAPB(o[1]=__builtin_amdgcn_mfma_f32_32x32x16_bf16(PAF(2),VFR(6),o[1],0,0,0), C1,4); \
    GAPB(o[0]=__builtin_amdgcn_mfma_f32_32x32x16_bf16(PAF(3),VFR(3),o[0],0,0,0), C1,8); \
    GAPB(o[1]=__builtin_amdgcn_mfma_f32_32x32x16_bf16(PAF(3),VFR(7),o[1],0,0,0), C1,12); \
    }while(0)
  int t=1;
  #undef CMASK
  #define CMASK(P0,P1,t) do{}while(0)
  for(;t+5<NT;t+=2){
    STEP(pB0,pB1,pA0,pA1,t,true,true,true);     WAIT_BAR(2); RESC(); ROT();
    STEP(pA0,pA1,pB0,pB1,t+1,true,true,true);   WAIT_BAR(2); RESC(); ROT();
  }
  #undef CMASK
  #define CMASK(P0,P1,t) do{int jb_=(t)-(NT-4); if(jb_>=0)cmask(P0,P1,jb_,qrel,hi);}while(0)
  #define ENDW(tt) do{ if((tt)+3<NT){WAIT_BAR(2);} else if((tt)+2<NT){WAIT_BAR(1);} else {WAIT_BAR(0);} }while(0)
  for(;t+1<NT;t+=2){
    STEP(pB0,pB1,pA0,pA1,t,(t+3<NT),(t+1<NT),(t+1<NT));       ENDW(t);   RESC(); ROT();
    STEP(pA0,pA1,pB0,pB1,t+1,(t+4<NT),(t+2<NT),(t+2<NT));     ENDW(t+1); RESC(); ROT();
  }
  STEP(pB0,pB1,pA0,pA1,NT-1,false,false,false); RESC();
  { float sacc=pB0[0]+pB0[1]; _Pragma("unroll") for(int r=2;r<16;++r)sacc+=pB0[r]; _Pragma("unroll") for(int r=0;r<16;++r)sacc+=pB1[r]; l_reg+=sacc;
    pw0=(u32x4){PKW(pB0,0),PKW(pB0,2),PKW(pB0,4),PKW(pB0,6)};pw1=(u32x4){PKW(pB0,8),PKW(pB0,10),PKW(pB0,12),PKW(pB0,14)};pw2=(u32x4){PKW(pB1,0),PKW(pB1,2),PKW(pB1,4),PKW(pB1,6)};pw3=(u32x4){PKW(pB1,8),PKW(pB1,10),PKW(pB1,12),PKW(pB1,14)};
    SBAR(); pv(o,vb0+sl_cur,PAF(0),PAF(1),PAF(2),PAF(3)); }
  #undef PKW
  #undef PAF
  #undef VFR
  #undef PIN
  #undef MX3
  #undef GAPA
  #undef GAPB
  #undef EX
  #undef VRD
  #undef KRD
  #undef STEP
  #undef ENDW
  {auto rr=__builtin_amdgcn_permlane32_swap(__float_as_uint(l_reg),__float_as_uint(l_reg),false,false);l_reg=__uint_as_float(rr[0])+__uint_as_float(rr[1]);}
  if(hi==0)wsf[32+r32]=l_reg;asm volatile("s_waitcnt lgkmcnt(0)":::"memory");
  float rli[16];
  #pragma unroll
  for(int r=0;r<16;++r)rli[r]=__builtin_amdgcn_rcpf(wsf[32+crow(r,hi)]);
  bf16*Ow=O+(rowbase+q0+wid*QBLK)*DM+h*D;
  { bf16*stg=(bf16*)(shm+LDS_OST)+wid*2048;
    #pragma unroll
    for(int r=0;r<16;++r){const int orow=crow(r,hi);
      #pragma unroll
      for(int d0=0;d0<2;++d0)stg[orow*64+d0*32+r32]=__float2bfloat16(o[d0][r]*rli[r]);}
    asm volatile("s_waitcnt lgkmcnt(0)":::"memory");
    const bf16*Gw=G+(rowbase+q0+wid*QBLK)*DM+h*D;
    #pragma unroll
    for(int i=0;i<4;++i){const int row=i*8+(lane>>3),ch=lane&7; u32x4 v=*(const u32x4*)(stg+row*64+ch*8); const u32x4 g=*(const u32x4*)(Gw+(long)row*DM+ch*8);
      #pragma unroll
      for(int q=0;q<4;++q) v[q]=cvtpk_s(__uint_as_float(v[q]<<16)*__uint_as_float(g[q]<<16),__uint_as_float(v[q]&0xffff0000u)*__uint_as_float(g[q]&0xffff0000u));
      ATTN_STORE16(Ow+(long)row*DM+ch*8,v);} }
  asm volatile("s_waitcnt lgkmcnt(0)\n\ts_barrier":::"memory");
  #undef DMA_K
  #undef DMA_V
  #undef CMASK
  #undef KBIAS
  #undef START
  #undef RESC
  #undef ROT
}
constexpr int ATTN_LDS_BYTES=LDS_BYTES;
struct AttnTensors { const bf16* Q; const bf16* K; const bf16* V; bf16* O; const bf16* G; const float* KB; const float* qnorm; };
template<int THRL=8> __device__ __forceinline__ void attn_phase(int tid,int wid,unsigned*ctr,const int*t0tab,volatile __attribute__((address_space(3))) int*bc,char*lds,const AttnTensors&T){
  for(;;){
    if(tid==0){ const int n_=(int)__hip_atomic_fetch_add(ctr,1u,__ATOMIC_RELAXED,__HIP_MEMORY_SCOPE_AGENT); bc[0]=n_; }
    asm volatile("s_waitcnt vmcnt(0) lgkmcnt(0)\n\ts_barrier":::"memory");
    const int n=__builtin_amdgcn_readfirstlane(bc[0]);
    if(n>=BATCH*NHEAD*NQB) break;
    const int qb=NQB-1-(n>>7), bh=n&127;
    const int t0=__builtin_amdgcn_readfirstlane(t0tab[bh*16+qb]);
    attn_unit<THRL>(tid,wid,bh/NHEAD,bh%NHEAD,qb,t0,T.Q,T.K,T.V,T.O,T.G,T.KB+(long)bh*SEQ,T.qnorm,lds);
  }
}
#undef SBAR
#undef WAIT_BAR
}
__device__ __forceinline__ void attn_simple(Frame& F, int j) {
    const InTab in = F.in;
    const bf16_t* Q = (const bf16_t*)(F.ws + WS_RA); const bf16_t* Gt = (const bf16_t*)(F.ws + WS_RA + 64 * MiB);
    const bf16_t* Kb = (const bf16_t*)(F.ws + WS_P); const bf16_t* Vb = (const bf16_t*)(F.ws + WS_P + 64 * MiB);
    const float* KBv = (const float*)(F.ws + WS_KB); bf16_t* OG = (bf16_t*)(F.ws + WS_H2 + 64 * MiB);
    const float* qn = in[I_QNORM] + j * 64;
    for (int item = F.bid; item < 1024; item += F.G) {
        const int bh = item >> 3, qb = item & 7, b = bh >> 4, h = bh & 15, t = qb * 512 + F.tid;
        const size_t row = (size_t)b * SEQ + t;
        float q[64];
        { const bf16_t* qp = Q + row * 1024 + h * 64; float ss = 0.f;
#pragma unroll
          for (int i = 0; i < 8; ++i) { const u32x4 w = *(const u32x4*)(qp + 8 * i);
              q[8 * i] = lo16(w.x); q[8 * i + 1] = hi16(w.x); q[8 * i + 2] = lo16(w.y); q[8 * i + 3] = hi16(w.y); q[8 * i + 4] = lo16(w.z); q[8 * i + 5] = hi16(w.z); q[8 * i + 6] = lo16(w.w); q[8 * i + 7] = hi16(w.w); }
#pragma unroll
          for (int i = 0; i < 64; ++i) ss += q[i] * q[i];
          const float rs = QC2 / sqrtf(ss * (1.0f / 64.0f) + QK_EPS);
#pragma unroll
          for (int i = 0; i < 64; ++i) q[i] = q[i] * rs * qn[i]; }
        float o[64];
#pragma unroll
        for (int i = 0; i < 64; ++i) o[i] = 0.f;
        float m = -1.0e30f, lsum = 0.f;
        const int smax = qb * 512 + F.wave * 64 + 63;
        const bf16_t* kp = Kb + ((size_t)b * SEQ) * 1024 + h * 64; const bf16_t* vp = Vb + ((size_t)b * SEQ) * 1024 + h * 64;
        const float* kbp = KBv + (size_t)bh * SEQ;
        for (int s = 0; s <= smax; ++s) {
            float dot = 0.f;
#pragma unroll
            for (int i = 0; i < 8; ++i) { const u32x4 w = *(const u32x4*)(kp + (size_t)s * 1024 + 8 * i);
                dot += q[8 * i] * lo16(w.x) + q[8 * i + 1] * hi16(w.x) + q[8 * i + 2] * lo16(w.y) + q[8 * i + 3] * hi16(w.y) + q[8 * i + 4] * lo16(w.z) + q[8 * i + 5] * hi16(w.z) + q[8 * i + 6] * lo16(w.w) + q[8 * i + 7] * hi16(w.w); }
            float x = dot + kbp[s];
            if (s > t) x = -1.0e30f;
            const float mn = fmaxf(m, x), corr = exp2f(m - mn), p = (s > t) ? 0.f : exp2f(x - mn);
            m = mn; lsum = lsum * corr + p;
#pragma unroll
            for (int i = 0; i < 8; ++i) { const u32x4 w = *(const u32x4*)(vp + (size_t)s * 1024 + 8 * i);
                o[8 * i] = o[8 * i] * corr + p * lo16(w.x); o[8 * i + 1] = o[8 * i + 1] * corr + p * hi16(w.x); o[8 * i + 2] = o[8 * i + 2] * corr + p * lo16(w.y); o[8 * i + 3] = o[8 * i + 3] * corr + p * hi16(w.y);
                o[8 * i + 4] = o[8 * i + 4] * corr + p * lo16(w.z); o[8 * i + 5] = o[8 * i + 5] * corr + p * hi16(w.z); o[8 * i + 6] = o[8 * i + 6] * corr + p * lo16(w.w); o[8 * i + 7] = o[8 * i + 7] * corr + p * hi16(w.w); }
        }
        const float il = 1.0f / lsum;
        const bf16_t* gp = Gt + row * 1024 + h * 64; bf16_t* op = OG + row * 1024 + h * 64;
#pragma unroll
        for (int i = 0; i < 8; ++i) { const u32x4 w = *(const u32x4*)(gp + 8 * i); u32x4 r;
            r.x = pk2(o[8 * i] * il * lo16(w.x), o[8 * i + 1] * il * hi16(w.x)); r.y = pk2(o[8 * i + 2] * il * lo16(w.y), o[8 * i + 3] * il * hi16(w.y));
            r.z = pk2(o[8 * i + 4] * il * lo16(w.z), o[8 * i + 5] * il * hi16(w.z)); r.w = pk2(o[8 * i + 6] * il * lo16(w.w), o[8 * i + 7] * il * hi16(w.w));
            *(u32x4*)(op + 8 * i) = r; }
    }
}

__device__ __forceinline__ void attn_fast(Frame& F, int j) {
    typedef attn_body::bf16 abf;
    const attn_body::AttnTensors AT{(const abf*)(F.ws + WS_RA), (const abf*)(F.ws + WS_P), (const abf*)(F.ws + WS_P + 64 * MiB), (abf*)(F.ws + WS_H2 + 64 * MiB), (const abf*)(F.ws + WS_RA + 64 * MiB),
                                    (const float*)(F.ws + WS_KB), F.in[I_QNORM] + j * 64};
    static_assert(attn_body::ATTN_LDS_BYTES <= 131072, "attention LDS");
    attn_body::attn_phase<8>(F.tid, F.wave, (unsigned*)(F.ws + WS_CTL) + CW_ATT + 64 * j, (const int*)(F.ws + WS_T0), (volatile LAS int*)(F.lds + MISC_OFF + 64), F.ldsg, AT);
}
__device__ __forceinline__ void relane(Frame& F) { int l_; asm volatile("v_mbcnt_lo_u32_b32 %0, -1, 0\n\tv_mbcnt_hi_u32_b32 %0, -1, %0" : "=v"(l_)); int w_ = F.wave; asm volatile("" : "+s"(w_)); F.wave = w_; F.lane = l_; F.tid = w_ * 64 + l_;
    GAS unsigned char* p_ = (GAS unsigned char*)F.ws; asm volatile("" : "+s"(p_)); F.ws = (unsigned char*)p_; GAS float* x_ = (GAS float*)F.xs; asm volatile("" : "+s"(x_)); F.xs = (float*)x_; }
#define GRID_BAR() (relane(F), xcd_barrier_fn(bar.bar, bar.x, bar.st, F.tid == 0))
#ifndef ONLY
#define ONLY (-1)
#endif
#ifndef REP_MASK
#define REP_MASK 0
#endif
#define ON(k) (relane(F), (ONLY < 0 || ONLY == (k)))
#define RUN(k, ...) do { for (int rep_ = 0; rep_ < (((REP_MASK >> (k)) & 1) ? 2 : 1); ++rep_) { if (ON(k)) { __VA_ARGS__; } if (REP_MASK) __syncthreads(); } } while (0)
template <int l> __device__ __forceinline__ void layer_body(Frame& F, const XcdBarrier& bar) {
    unsigned char* ws = F.ws;

        if (l < 2) {
#ifdef GPROBE
            { relane(F); SchedRKV S{{T / 256, 12, F.G, F.bid}};
#if GPROBE == 1
              EpiNone E{};
#else
              EpiPriv E{(bf16_t*)(ws + WS_RA), F.bid};
#endif
              gemm_fast(F, (const bf16_t*)(ws + WS_SC), 1024, (const bf16_t*)(ws + WS_RWBIG) + (size_t)l * 3072 * 1024, 1024, S, E); __syncthreads(); }
#endif
            RUN(2, SchedRKV S{{T / 256, 12, F.G, F.bid}}; EpiRKV E{(bf16_t*)(ws + WS_RA), (bf16_t*)(ws + WS_P), l};
              gemm_fast(F, (const bf16_t*)(ws + WS_SC), 1024, (const bf16_t*)(ws + WS_RWBIG) + (size_t)l * 3072 * 1024, 1024, S, E););
            RUN(21, SchedDense S{T / 256, 2, F.G, F.bid}; EpiLA E{(bf16_t*)(ws + WS_RA + 192 * MiB)};
              gemm_fast(F, (const bf16_t*)(ws + WS_H2), RWK, (const bf16_t*)(ws + WS_RWLORA) + (size_t)l * 512 * RWK, RWK, S, E););
            GRID_BAR();
            RUN(3, SchedDense S{T / 256, 4, F.G, F.bid}; EpiPlain E{(bf16_t*)(ws + WS_RA + 224 * MiB), 1024};
              gemm_fast(F, (const bf16_t*)(ws + WS_RA + 192 * MiB) + 128, LAW, (const bf16_t*)(ws + WS_LORA2 + (size_t)l * MiB + L2_G2T), G2K, S, E););
            RUN(4, wkv_chunk_prep<0>(F, l));
#ifdef PREP_PROBE
            relane(F); __syncthreads(); wkv_chunk_prep<PREP_PROBE>(F, l);
#endif
            GRID_BAR();
            RUN(20, wkv_chunk_seq(F, l)); RUN(19, moe_convert(F, l, 128, F.G - 128));
            GRID_BAR();
            RUN(6, SchedDense S{T / 256, 4, F.G, F.bid}; EpiPlain E{(bf16_t*)(ws + WS_Y16), 1024};
              gemm_fast(F, (const bf16_t*)(ws + WS_H2), 1024, (const bf16_t*)(ws + WS_RWWO) + (size_t)l * 1024 * 1024, 1024, S, E););
            GRID_BAR();
        } else {
            const int j = l - 2;
            RUN(7, SchedDense S{T / 256, 8, F.G, F.bid}; EpiSplit2 E{(bf16_t*)(ws + WS_RA), (bf16_t*)(ws + WS_RA + 64 * MiB), 1};
              gemm_fast(F, (const bf16_t*)(ws + WS_H2), 1024, (const bf16_t*)(ws + WS_FXQG) + (size_t)j * 2048 * 1024, 1024, S, E););
            GRID_BAR();
            RUN(19, moe_convert(F, l, F.G - 64, 64));
            RUN(8, attn_fast(F, j));
            GRID_BAR();
            RUN(9, SchedDense S{T / 256, 4, F.G, F.bid}; EpiPlain E{(bf16_t*)(ws + WS_Y16), 1024};
              gemm_fast(F, (const bf16_t*)(ws + WS_H2 + 64 * MiB), 1024, (const bf16_t*)(ws + WS_FXWO) + (size_t)j * 1024 * 1024, 1024, S, E););
            GRID_BAR();
        }
#ifdef TOKA_PROBE
        relane(F); tok_a<true>(F, l); __syncthreads();
#endif
#ifdef BAR_PROBE
        for (int bi_ = 0; bi_ < 5; ++bi_) GRID_BAR();
#endif
        RUN(10, tok_a<false>(F, l));
        GRID_BAR();
        {
            const LAS int* lc = (const LAS int*)(F.lds + MOE_LC_OFF);
            const bf16_t* W1T = (const bf16_t*)(ws + WS_MOE); const bf16_t* W2T = W1T + (size_t)32 * 1024 * 1024;
            relane(F); moe_tables(F, l);
            { SchedMoe S{lc + 96, lc[64], F.G, F.bid, (size_t)1024 * 1024}; moe_rows(F, S); EpiMoe1 E{(bf16_t*)(ws + WS_HM)};
              RUN(12, gemm_fast<EpiMoe1, SchedMoe, true>(F, (const bf16_t*)(ws + WS_H2), 1024, W1T, 1024, S, E, (const LAS int*)(F.lds + MOE_TOKL_OFF))); }
            GRID_BAR();
            { SchedMoe S{lc + 96, lc[64], F.G, F.bid, (size_t)1024 * 512}; EpiPlain E{(bf16_t*)(ws + WS_RA + 144 * MiB), 1024};
              RUN(13, gemm_fast(F, (const bf16_t*)(ws + WS_HM), 512, W2T, 512, S, E)); }
            GRID_BAR();
        }
#ifdef TOKB_PROBE
        relane(F); tok_b<true>(F, l, l == 1 ? 1 : (l == 2 ? 2 : 3)); __syncthreads();
#endif
        RUN(14, tok_b<false>(F, l, l == 1 ? 1 : (l == 2 ? 2 : 3)));
        if (l == 3) return;
        GRID_BAR();
        if (l == 0) { RUN(1, rw_prep(F, 1, false)); GRID_BAR(); }
        if (l == 1) {
            RUN(18, fgate_phase(F));
            RUN(15, SchedDense S{T / 256, 8, F.G, F.bid}; EpiSplit2 E{(bf16_t*)(ws + WS_P), (bf16_t*)(ws + WS_P + 64 * MiB), 0};
              gemm_fast(F, (const bf16_t*)(ws + WS_RA), 1024, (const bf16_t*)(ws + WS_KVW), 1024, S, E););
            GRID_BAR();
            RUN(16, kv_post(F));
            GRID_BAR();
        }
}
__global__ void __launch_bounds__(NTHR, 2) yoco_fwd(Args args) {
    extern __shared__ __attribute__((aligned(16))) unsigned char lds[];
    Frame F;
    F.lds = (LAS unsigned char*)lds; F.ldsg = (char*)lds; F.ws = args.ws; F.xs = args.out; F.in.p = args.in;
    F.tid = threadIdx.x; F.lane = F.tid & 63; F.wave = __builtin_amdgcn_readfirstlane(F.tid >> 6); F.G = gridDim.x; F.bid = blockIdx.x;
    volatile LAS unsigned* MISC = (volatile LAS unsigned*)(F.lds + MISC_OFF);
    if (F.tid < 32) MISC[F.tid] = 0u;
    __syncthreads();
    XcdBarrier bar = xcd_barrier_post((unsigned*)(F.ws + WS_CTL) + CW_BAR, MISC + 8);
    unsigned char* ws = F.ws;
    RUN(0, p0_prologue(F));
    GRID_BAR();
    RUN(1, rw_prep(F, 0, true));
    GRID_BAR();
    layer_body<0>(F, bar); layer_body<1>(F, bar); layer_body<2>(F, bar); layer_body<3>(F, bar);
}

extern "C" void kernel_launch(void* const* d_in, const int* in_sizes, int n_in, void* d_out, int out_size, void* d_ws, size_t ws_size, hipStream_t stream) {
    static int grid = 0;
    if (grid == 0) {
        if (n_in != 40 || out_size != T * D || ws_size < WS_END) { fprintf(stderr, "kernel_launch: unexpected shapes (n_in %d out %d ws %zu)\n", n_in, out_size, ws_size); grid = -1; return; }
        int dev = 0, cus = 0, per_cu = 0;
        if (hipGetDevice(&dev) != hipSuccess || hipDeviceGetAttribute(&cus, hipDeviceAttributeMultiprocessorCount, dev) != hipSuccess) { grid = -1; return; }
        if (hipFuncSetAttribute((const void*)yoco_fwd, hipFuncAttributeMaxDynamicSharedMemorySize, LDS_BYTES) != hipSuccess) { fprintf(stderr, "kernel_launch: hipFuncSetAttribute failed\n"); grid = -1; return; }
        if (hipOccupancyMaxActiveBlocksPerMultiprocessor(&per_cu, (const void*)yoco_fwd, NTHR, LDS_BYTES) != hipSuccess || per_cu < 1) fprintf(stderr, "kernel_launch: occupancy query reports %d\n", per_cu);
        (void)hipGetLastError();
        grid = cus;
        if (grid != 256) { fprintf(stderr, "kernel_launch: built for 256 CUs, found %d\n", cus); grid = -1; return; }
    }
    if (grid < 0) return;
    (void)hipMemsetAsync((char*)d_ws + WS_CTL, 0, CTL_BYTES, stream);
    Args a{};
    for (int i = 0; i < 40; ++i) a.in[i] = (const float*)d_in[i];
    a.out = (float*)d_out; a.ws = (unsigned char*)d_ws; a.ph_lo = 0; a.ph_hi = 0;
    hipLaunchKernelGGL(yoco_fwd, dim3(grid), dim3(NTHR), LDS_BYTES, stream, a);
}
```

```cpp
#include <hip/hip_runtime.h>
#include <cstdio>
#include <cstdint>
#include <hip/hip_bf16.h>
#include <cmath>

#define GAS __attribute__((address_space(1)))
#define LAS __attribute__((address_space(3)))
typedef unsigned short bf16_t;
typedef short bf16x8 __attribute__((ext_vector_type(8)));
typedef float f32x4 __attribute__((ext_vector_type(4)));
typedef float f32x2 __attribute__((ext_vector_type(2)));
typedef unsigned u32x4 __attribute__((ext_vector_type(4)));
typedef unsigned u32x2 __attribute__((ext_vector_type(2)));
typedef GAS unsigned gu32;

constexpr int NB = 8, SEQ = 4096, T = NB * SEQ, D = 1024, NH = 16, HD = 64;
constexpr int NWAVES = 8, NTHR = NWAVES * 64;
constexpr float ALPHA = 1.681792830507429f;
constexpr float LN_EPS = 1e-5f, GN_EPS = 64e-5f, QK_EPS = 1e-6f;
constexpr float LOG2E = 1.4426950408889634f;
constexpr float QC2 = 0.125f * LOG2E;
constexpr int RWK = 2048;
constexpr int LAW = 512;
constexpr int G2K = 256;
constexpr int XS_ROWS = 73728;

constexpr size_t MiB = 1u << 20;
constexpr size_t WS_CTL = 0, CTL_BYTES = 1 * MiB;
constexpr size_t WS_MOD = 1 * MiB;
constexpr size_t WS_KVMOD = WS_MOD + 4 * 8 * 6144 * 4;
constexpr size_t WS_RT = 2 * MiB;
constexpr size_t WS_WF = WS_RT + 768 * 1024;
constexpr size_t WS_KB = 3 * MiB;
constexpr size_t WS_LF = 5 * MiB;
constexpr size_t WS_ASG = 7 * MiB;
constexpr size_t WS_GATE = WS_ASG + 256 * 1024;
constexpr size_t WS_DEST = WS_GATE + 256 * 1024;
constexpr size_t WS_TEXP = WS_DEST + 256 * 1024;
constexpr size_t WS_T0 = WS_TEXP + 4096;
constexpr size_t WS_RWBIG = 16 * MiB;
constexpr size_t WS_RWLORA = 28 * MiB;
constexpr size_t WS_LORA2 = 44 * MiB;
constexpr size_t L2_G2T = 0, L2_W2T = 512 * 1024, L2_A2T = 640 * 1024, L2_V2T = 768 * 1024;
constexpr size_t WS_RWWO = 50 * MiB;
constexpr size_t WS_KVW = 54 * MiB;
constexpr size_t WS_FXQG = 58 * MiB;
constexpr size_t WS_FXWO = 66 * MiB;
constexpr size_t WS_MOE = 72 * MiB;
constexpr size_t WS_SC = 168 * MiB;
constexpr size_t X3S = (size_t)T * 1024;
constexpr size_t WS_XS = WS_SC + 200 * MiB;
constexpr size_t WS_P = 456 * MiB;
constexpr size_t WS_Y16 = 584 * MiB;
constexpr size_t WS_H2 = 648 * MiB;
constexpr size_t WS_RA = 776 * MiB;
constexpr size_t WS_HM = WS_RA;
constexpr size_t WS_TLIST = WS_RA + 80 * MiB;
constexpr size_t WS_END = 1064 * MiB;
constexpr int CW_BAR = 4096;
constexpr int CW_CNT = 16384;
constexpr int CW_ATT = 16640;

constexpr int LDS_BYTES = 147456;
constexpr int MISC_OFF = 131072 + 320;
constexpr int MOE_LC_OFF = MISC_OFF + 256;
constexpr int MOE_TOKL_OFF = MISC_OFF + 2048;
__device__ __forceinline__ float bf2f(unsigned short b) { return __uint_as_float((unsigned)b << 16); }
typedef float f32x2_cv __attribute__((ext_vector_type(2))); typedef __bf16 bf16x2_cv __attribute__((ext_vector_type(2)));
__device__ __forceinline__ unsigned pk2(float lo, float hi) { const f32x2_cv v = {lo, hi}; return __builtin_bit_cast(unsigned, __builtin_convertvector(v, bf16x2_cv)); }
__device__ __forceinline__ unsigned f2bf(float f) { return pk2(f, 0.f) & 0xffffu; }
__device__ __forceinline__ float lo16(unsigned w) { return __uint_as_float(w << 16); }
__device__ __forceinline__ float hi16(unsigned w) { return __uint_as_float(w & 0xffff0000u); }
__device__ __forceinline__ float sigmoidf_(float x) { return __builtin_amdgcn_rcpf(1.0f + __expf(-x)); }
__device__ __forceinline__ float tanhf_(float x) { const float e = __expf(2.0f * x); return 1.0f - 2.0f * __builtin_amdgcn_rcpf(e + 1.0f); }
template <int CTRL> __device__ __forceinline__ float dpp_f(float v) {
    return __builtin_bit_cast(float, __builtin_amdgcn_update_dpp(0, __builtin_bit_cast(int, v), CTRL, 0xF, 0xF, true));
}
__device__ __forceinline__ float wave_sum(float v) {
    v += dpp_f<0xB1>(v); v += dpp_f<0x4E>(v); v += dpp_f<0x141>(v); v += dpp_f<0x140>(v);
    const int vi = __builtin_bit_cast(int, v);
    const float s0 = __builtin_bit_cast(float, __builtin_amdgcn_readlane(vi, 0)), s1 = __builtin_bit_cast(float, __builtin_amdgcn_readlane(vi, 16)), s2 = __builtin_bit_cast(float, __builtin_amdgcn_readlane(vi, 32)), s3 = __builtin_bit_cast(float, __builtin_amdgcn_readlane(vi, 48));
    return (s0 + s1) + (s2 + s3);
}
__device__ __forceinline__ float quadsum(float v) { v += dpp_f<0xB1>(v); v += dpp_f<0x4E>(v); return v; }
__device__ __forceinline__ float rowsum16(float v) { v += dpp_f<0xB1>(v); v += dpp_f<0x4E>(v); v += dpp_f<0x141>(v); v += dpp_f<0x140>(v); return v; }
#define LDS_WAIT() asm volatile("s_waitcnt lgkmcnt(0)" ::: "memory")
#define LBAR() do { asm volatile("s_waitcnt lgkmcnt(0)" ::: "memory"); __builtin_amdgcn_s_barrier(); asm volatile("" ::: "memory"); } while (0)

#define XB_TMO      128
#define XB_XCNT(j)  (256  + 64 * (j))
#define XB_XSUB(j)  (1280 + 64 * (j))
#define XB_XGEN(j)  (2304 + 64 * (j))
#define XB_TOP      3328
#define XB_TOPGEN   3392
#define XCD_BAR_WORDS 3456
#define XB_SPIN_CAP (1u << 22)
__device__ __forceinline__ unsigned xb_ld(unsigned* p)              { return __hip_atomic_load(p, __ATOMIC_RELAXED, __HIP_MEMORY_SCOPE_AGENT); }
__device__ __forceinline__ unsigned xb_add(unsigned* p, unsigned v) { return __hip_atomic_fetch_add(p, v, __ATOMIC_RELAXED, __HIP_MEMORY_SCOPE_AGENT); }
__device__ __forceinline__ unsigned xb_xcc_id() { return (unsigned)__builtin_amdgcn_s_getreg((3 << 11) | 20) & 0xFu; }
#define XB_SPIN(cond, bar) do { unsigned _sp = 0; while (cond) { __builtin_amdgcn_s_sleep(1); \
    if ((++_sp & 255u) == 0u) { if (xb_ld(&(bar)[XB_TMO])) break; if (_sp > XB_SPIN_CAP) { atomicAdd(&(bar)[XB_TMO], 1u); break; } } } } while (0)
struct XcdBarrier { unsigned* bar; unsigned x; volatile LAS unsigned* st; };
__device__ __forceinline__ XcdBarrier xcd_barrier_post(unsigned* bar, volatile LAS unsigned* st) {
    XcdBarrier b; b.bar = bar; b.x = xb_xcc_id(); b.st = st;
    if (threadIdx.x == 0) (void)xb_add(&bar[XB_XCNT(b.x)], 1u);
    return b;
}
__device__ __forceinline__ void xcd_barrier_complete(unsigned* bar, unsigned x, unsigned& nloc, unsigned& nx) {
    const unsigned G = gridDim.x * gridDim.y * gridDim.z;
    unsigned sum, cnt, mine, sp = 0u;
    for (;;) {
        sum = 0u; cnt = 0u; mine = 0u;
#pragma unroll
        for (unsigned j = 0; j < 16; ++j) { const unsigned c = xb_ld(&bar[XB_XCNT(j)]); sum += c; cnt += (c > 0u) ? 1u : 0u; mine = (j == x) ? c : mine; }
        if (sum == G) break;
        __builtin_amdgcn_s_sleep(1);
        if ((++sp & 255u) == 0u) { if (xb_ld(&bar[XB_TMO])) break; if (sp > XB_SPIN_CAP) { atomicAdd(&bar[XB_TMO], 1u); break; } }
    }
    nloc = mine > 0u ? mine : 1u; nx = cnt > 0u ? cnt : 1u;
}
__device__ __forceinline__ void xcd_barrier_fn(unsigned* bar_, unsigned x_, volatile LAS unsigned* st_, bool is_t0) {
    XcdBarrier b; b.bar = bar_; b.x = x_; b.st = st_;
    asm volatile("s_waitcnt vmcnt(0)" ::: "memory");
    __syncthreads();
    if (is_t0) {
        unsigned* bar = b.bar;
        __builtin_amdgcn_s_waitcnt(0);
        unsigned nloc = b.st[0], nx = b.st[1];
        if (nloc == 0u) { xcd_barrier_complete(bar, b.x, nloc, nx); b.st[0] = nloc; b.st[1] = nx; }
        const unsigned old = xb_add(&bar[XB_XSUB(b.x)], 1u);
        const unsigned gen = old / nloc;
        if (old + 1u == (gen + 1u) * nloc) {
            __builtin_amdgcn_fence(__ATOMIC_RELEASE, "agent");
            asm volatile("s_waitcnt vmcnt(0)" ::: "memory");
            const unsigned og = xb_add(&bar[XB_TOP], 1u);
            const unsigned tg = og / nx;
            if (og + 1u == (tg + 1u) * nx) xb_add(&bar[XB_TOPGEN], 1u);
            else XB_SPIN(xb_ld(&bar[XB_TOPGEN]) == tg, bar);
            __builtin_amdgcn_fence(__ATOMIC_ACQUIRE, "agent");
            xb_add(&bar[XB_XGEN(b.x)], 1u);
            asm volatile("s_waitcnt vmcnt(0)" ::: "memory");
        } else {
            XB_SPIN(xb_ld(&bar[XB_XGEN(b.x)]) == gen, bar);
            __builtin_amdgcn_fence(__ATOMIC_ACQUIRE, "agent");
            asm volatile("s_waitcnt vmcnt(0)" ::: "memory");
        }
    }
    __syncthreads();
}

struct Args { const float* in[40]; float* out; unsigned char* ws; int ph_lo, ph_hi; };
struct InTab { const float* const* p; __device__ __forceinline__ const float* operator[](int i) const { return (const float*)(GAS const float*)p[i]; } };
struct Frame {
    LAS unsigned char* lds; char* ldsg;
    unsigned char* ws; float* xs;
    InTab in;
    int tid, lane, wave, G, bid;
};
enum { I_X = 0, I_C, I_ADAW, I_ADAB, I_LNG, I_LNB, I_MU, I_RKV, I_W0, I_W1, I_W2, I_A0, I_A1, I_A2, I_G1, I_G2, I_KK, I_KA, I_RK, I_GNG, I_GNB, I_RWO, I_V0, I_V1, I_V2,
       I_KVADAW, I_KVADAB, I_KVW, I_KVFB, I_KNORM, I_WQG, I_QNORM, I_FWO, I_WGRP, I_BGRP, I_WEXP, I_BEXP, I_WGATE, I_WUP, I_WDOWN };

__device__ __forceinline__ void tr_item(const float* W, int ldw, int K, int k0, int n0, const float* mu, bf16_t* WT, int ldt, int nd0, int kd0, LAS float* scr, int lane) {
    const int kr = lane >> 3, n4 = 4 * (lane & 7);
    f32x4 v[8];
#pragma unroll
    for (int i = 0; i < 8; ++i) { const int k = k0 + kr + 8 * i; v[i] = (k < K) ? *(const f32x4*)(W + (size_t)k * ldw + n0 + n4) : (f32x4){0.f, 0.f, 0.f, 0.f}; }
    if (mu) {
#pragma unroll
        for (int i = 0; i < 8; ++i) { const int k = k0 + kr + 8 * i; v[i] = v[i] * ((k < K) ? mu[k] : 0.f); }
    }
#pragma unroll
    for (int i = 0; i < 8; ++i) { LAS float* d = scr + (kr + 8 * i) * 33 + n4; d[0] = v[i][0]; d[1] = v[i][1]; d[2] = v[i][2]; d[3] = v[i][3]; }
    LDS_WAIT(); asm volatile("" ::: "memory");
    const int c = lane & 7;
#pragma unroll
    for (int j = 0; j < 4; ++j) {
        const int n = (lane >> 3) + 8 * j; const LAS float* s = scr + (8 * c) * 33 + n;
        u32x4 o; o.x = pk2(s[0 * 33], s[1 * 33]); o.y = pk2(s[2 * 33], s[3 * 33]); o.z = pk2(s[4 * 33], s[5 * 33]); o.w = pk2(s[6 * 33], s[7 * 33]);
        *(u32x4*)(WT + (size_t)(nd0 + n) * ldt + kd0 + 8 * c) = o;
    }
    LDS_WAIT(); asm volatile("" ::: "memory");
}
__device__ __forceinline__ void zero_item(bf16_t* WT, int ldt, int r0, int c0, int c1, int lane) {
    const int cpr = (c1 - c0) >> 3, tot = 32 * cpr;
    for (int i = lane; i < tot; i += 64) { const int r = i / cpr, c = i % cpr; *(u32x4*)(WT + (size_t)(r0 + r) * ldt + c0 + 8 * c) = (u32x4){0u, 0u, 0u, 0u}; }
}

__device__ __forceinline__ void p0_prologue(Frame& F) {
    const InTab in = F.in;
    {
        LAS float* cs = (LAS float*)F.lds;
        LAS float* part = (LAS float*)(F.lds + 32768);
        bool did_cs = false;
        for (int it = F.bid; it < 104; it += F.G) {
            if (!did_cs) { for (int i = F.tid; i < 8 * 1024; i += NTHR) { const float v = in[I_C][i]; cs[i] = v / (1.0f + __expf(-v)); } did_cs = true; }
            __syncthreads();
            const float* W; const float* bias; int ldw, j0; float* dst; int dld;
            if (it < 96) { const int l = it / 24; j0 = (it % 24) * 256; W = in[I_ADAW] + (size_t)l * 1024 * 6144; ldw = 6144; bias = in[I_ADAB] + l * 6144; dst = (float*)(F.ws + WS_MOD) + (size_t)l * 8 * 6144; dld = 6144; }
            else { j0 = (it - 96) * 256; W = in[I_KVADAW]; ldw = 2048; bias = in[I_KVADAB]; dst = (float*)(F.ws + WS_KVMOD); dld = 2048; }
            f32x4 acc[8];
#pragma unroll
            for (int b = 0; b < 8; ++b) acc[b] = (f32x4){0.f, 0.f, 0.f, 0.f};
            const int kbeg = F.wave * 128;
#pragma unroll 4
            for (int kk = 0; kk < 128; ++kk) {
                const int k = kbeg + kk;
                const f32x4 w = *(const f32x4*)(W + (size_t)k * ldw + j0 + 4 * F.lane);
#pragma unroll
                for (int b = 0; b < 8; ++b) acc[b] += w * cs[b * 1024 + k];
            }
#pragma unroll
            for (int b = 0; b < 8; ++b) *(LAS f32x4*)(part + (F.wave * 8 + b) * 256 + 4 * F.lane) = acc[b];
            __syncthreads();
            for (int o = F.tid; o < 8 * 256; o += NTHR) {
                const int b = o >> 8, j = o & 255; float s = 0.f;
#pragma unroll
                for (int w = 0; w < 8; ++w) s += part[(w * 8 + b) * 256 + j];
                dst[(size_t)b * dld + j0 + j] = s + bias[j0 + j];
            }
            __syncthreads();
        }
        __syncthreads();
    }
    {
        const int gt = F.bid * NTHR + F.tid, NGT = F.G * NTHR;
        bf16_t* RTH = (bf16_t*)(F.ws + WS_RT); bf16_t* RTL = RTH + 4 * 48 * 1024; bf16_t* WFH = (bf16_t*)(F.ws + WS_WF); bf16_t* WFL = WFH + 16 * 1024;
        for (int i = gt; i < 4 * 48 * 1024; i += NGT) {
            const int l = i / (48 * 1024), r = i % (48 * 1024), c = r / 1024, k = r % 1024;
            const float w = (c < 4) ? in[I_WGRP][((size_t)l * 1024 + k) * 4 + c] : (c < 36 ? in[I_WEXP][((size_t)l * 1024 + k) * 32 + (c - 4)] : 0.f);
            const unsigned h = f2bf(w); RTH[i] = (bf16_t)h; RTL[i] = (bf16_t)f2bf(w - bf2f((unsigned short)h));
        }
        for (int i = gt; i < 16 * 1024; i += NGT) { const int c = i / 1024, k = i % 1024; const float w = in[I_KVW][(size_t)k * 2064 + 2048 + c];
            const unsigned h = f2bf(w); WFH[i] = (bf16_t)h; WFL[i] = (bf16_t)f2bf(w - bf2f((unsigned short)h)); }
    }
    LAS float* scr = (LAS float*)(F.lds + F.wave * 8704);
    const int gw = F.bid * NWAVES + F.wave, NGW = F.G * NWAVES;
    constexpr int N_S1 = 2 * 3 * 512;
    constexpr int N_S2 = 2 * 17 * 32;
    constexpr int N_S3 = 2 * 128;
    constexpr int N_S4 = 2 * 512 + 1024 + 2 * 1024 + 2 * 512;
    constexpr int N_TOT = N_S1 + N_S2 + N_S3 + N_S4;
    for (int it = gw; it < N_TOT; it += NGW) {
        int r = it;
        if (r < N_S1) {
            const int l = r / 1536; r %= 1536; const int p = r / 512; r %= 512; const int kb = r / 32, nb = r % 32;
            tr_item(in[I_RKV] + (size_t)(l * 3 + p) * 1024 * 1024, 1024, 1024, 64 * kb, 32 * nb, nullptr,
                    (bf16_t*)(F.ws + WS_RWBIG) + (size_t)l * 3072 * 1024, 1024, p * 1024 + 32 * nb, 64 * kb, scr, F.lane);
            continue;
        }
        r -= N_S1;
        if (r < N_S2) {
            const int l = r / (17 * 32); r %= (17 * 32); const int nbk = r / 32, sub = r % 32, half = sub / 16, kb = sub % 16;
            if (nbk >= 16) continue;
            bf16_t* WT = (bf16_t*)(F.ws + WS_RWLORA) + (size_t)l * 512 * RWK;
            const float* W = nullptr; int ldw = 0, n0 = 0, mui = 0;
            if (nbk < 2) { W = in[I_W1] + (size_t)l * 1024 * 64; ldw = 64; n0 = 32 * nbk; mui = 1; }
            else if (nbk < 4) { W = in[I_A1] + (size_t)l * 1024 * 64; ldw = 64; n0 = 32 * (nbk - 2); mui = 4; }
            else if (nbk < 9) { W = in[I_G1] + (size_t)l * 1024 * 160; ldw = 160; n0 = 32 * (nbk - 4); mui = 5; }
            else if (nbk == 9 && l == 1) { W = in[I_V1]; ldw = 32; n0 = 0; mui = 3; }
            if (W) tr_item(W, ldw, 1024, 64 * kb, n0, half ? in[I_MU] + (l * 6 + mui) * 1024 : nullptr, WT, RWK, 32 * nbk, half * 1024 + 64 * kb, scr, F.lane);
            else zero_item(WT, RWK, 32 * nbk, half * 1024 + 64 * kb, half * 1024 + 64 * kb + 64, F.lane);
            continue;
        }
        r -= N_S2;
        if (r < N_S3) {
            const int l = r / 128; r %= 128; const int blk = r / 32, nb = r % 32;
            unsigned char* base = F.ws + WS_LORA2 + (size_t)l * MiB;
            if (blk == 0) { tr_item(in[I_W2] + (size_t)l * 64 * 1024, 1024, 64, 0, 32 * nb, nullptr, (bf16_t*)(base + L2_W2T), 64, 32 * nb, 0, scr, F.lane); }
            else if (blk == 1) { tr_item(in[I_A2] + (size_t)l * 64 * 1024, 1024, 64, 0, 32 * nb, nullptr, (bf16_t*)(base + L2_A2T), 64, 32 * nb, 0, scr, F.lane); }
            else if (blk == 2) { for (int kb = 0; kb < 4; ++kb) tr_item(in[I_G2] + (size_t)l * 160 * 1024, 1024, 160, 64 * kb, 32 * nb, nullptr, (bf16_t*)(base + L2_G2T), G2K, 32 * nb, 64 * kb, scr, F.lane); }
            else { if (l == 1) tr_item(in[I_V2], 1024, 32, 0, 32 * nb, nullptr, (bf16_t*)(base + L2_V2T), 64, 32 * nb, 0, scr, F.lane); }
            continue;
        }
        r -= N_S3;
        if (r < N_S4) {
            if (r < 1024) { const int l = r / 512; r %= 512; tr_item(in[I_RWO] + (size_t)l * 1024 * 1024, 1024, 1024, 64 * (r / 32), 32 * (r % 32), nullptr, (bf16_t*)(F.ws + WS_RWWO) + (size_t)l * 1024 * 1024, 1024, 32 * (r % 32), 64 * (r / 32), scr, F.lane); continue; }
            r -= 1024;
            if (r < 1024) { tr_item(in[I_KVW], 2064, 1024, 64 * (r / 64), 32 * (r % 64), nullptr, (bf16_t*)(F.ws + WS_KVW), 1024, 32 * (r % 64), 64 * (r / 64), scr, F.lane); continue; }
            r -= 1024;
            if (r < 2048) { const int j = r / 1024; r %= 1024; tr_item(in[I_WQG] + (size_t)j * 1024 * 2048, 2048, 1024, 64 * (r / 64), 32 * (r % 64), nullptr, (bf16_t*)(F.ws + WS_FXQG) + (size_t)j * 2048 * 1024, 1024, 32 * (r % 64), 64 * (r / 64), scr, F.lane); continue; }
            r -= 2048;
            { const int j = r / 512; r %= 512; tr_item(in[I_FWO] + (size_t)j * 1024 * 1024, 1024, 1024, 64 * (r / 32), 32 * (r % 32), nullptr, (bf16_t*)(F.ws + WS_FXWO) + (size_t)j * 1024 * 1024, 1024, 32 * (r % 32), 64 * (r / 32), scr, F.lane); continue; }
        }
    }
}
__device__ __forceinline__ void moe_convert(Frame& F, int l, int wg0, int nwg) {
    const InTab in = F.in;
    LAS float* scr = (LAS float*)(F.lds + F.wave * 8704);
    if (F.bid < wg0 || F.bid >= wg0 + nwg) return;
    const int gw = (F.bid - wg0) * NWAVES + F.wave, NGW = nwg * NWAVES;
    bf16_t* base = (bf16_t*)(F.ws + WS_MOE);
    const int kr = F.lane >> 3, n4 = 4 * (F.lane & 7), c = F.lane & 7;
#define MC_DECODE(it_, W_, ldw_, k0_, n0_, WT_, ldt_, nd0_, kd0_) do { const int e_ = (it_) / 768; int r_ = (it_) % 768; const int le_ = l * 32 + e_; \
        if (r_ < 512) { const int kb_ = r_ / 32, nb_ = r_ % 32, s_ = (nb_ % 8) / 4; W_ = (s_ ? in[I_WUP] : in[I_WGATE]) + (size_t)le_ * 1024 * 512; ldw_ = 512; k0_ = 64 * kb_; n0_ = 128 * (nb_ / 8) + 32 * (nb_ % 4); \
            WT_ = base + (size_t)e_ * 1024 * 1024; ldt_ = 1024; nd0_ = 32 * nb_; kd0_ = 64 * kb_; } \
        else { r_ -= 512; const int kb_ = r_ / 32, nb_ = r_ % 32; W_ = in[I_WDOWN] + (size_t)le_ * 512 * 1024; ldw_ = 1024; k0_ = 64 * kb_; n0_ = 32 * nb_; \
            WT_ = base + (size_t)32 * 1024 * 1024 + (size_t)e_ * 1024 * 512; ldt_ = 512; nd0_ = 32 * nb_; kd0_ = 64 * kb_; } } while (0)
    f32x4 v[8];
    { int it = gw; if (it < 32 * 768) { const float* W; int ldw, k0, n0; bf16_t* WT; int ldt, nd0, kd0; MC_DECODE(it, W, ldw, k0, n0, WT, ldt, nd0, kd0);
#pragma unroll
        for (int i = 0; i < 8; ++i) v[i] = *(const f32x4*)(W + (size_t)(k0 + kr + 8 * i) * ldw + n0 + n4); (void)WT; (void)ldt; (void)nd0; (void)kd0; } }
    for (int it = gw; it < 32 * 768; it += NGW) {
        const float* W; int ldw, k0, n0; bf16_t* WT; int ldt, nd0, kd0; MC_DECODE(it, W, ldw, k0, n0, WT, ldt, nd0, kd0);
#pragma unroll
        for (int i = 0; i < 8; ++i) { LAS float* d = scr + (kr + 8 * i) * 33 + n4; d[0] = v[i][0]; d[1] = v[i][1]; d[2] = v[i][2]; d[3] = v[i][3]; }
        if (it + NGW < 32 * 768) { const float* Wn; int ldwn, k0n, n0n; bf16_t* WTn; int ldtn, nd0n, kd0n; MC_DECODE(it + NGW, Wn, ldwn, k0n, n0n, WTn, ldtn, nd0n, kd0n);
#pragma unroll
            for (int i = 0; i < 8; ++i) v[i] = *(const f32x4*)(Wn + (size_t)(k0n + kr + 8 * i) * ldwn + n0n + n4); (void)WTn; (void)ldtn; (void)nd0n; (void)kd0n; }
        LDS_WAIT(); asm volatile("" ::: "memory");
#pragma unroll
        for (int j = 0; j < 4; ++j) {
            const int n = (F.lane >> 3) + 8 * j; const LAS float* sp = scr + (8 * c) * 33 + n;
            u32x4 o; o.x = pk2(sp[0 * 33], sp[1 * 33]); o.y = pk2(sp[2 * 33], sp[3 * 33]); o.z = pk2(sp[4 * 33], sp[5 * 33]); o.w = pk2(sp[6 * 33], sp[7 * 33]);
            __builtin_nontemporal_store(o, (u32x4*)(WT + (size_t)(nd0 + n) * ldt + kd0 + 8 * c));
        }
        LDS_WAIT(); asm volatile("" ::: "memory");
    }
#undef MC_DECODE
    __syncthreads();
}

struct Unit { int pm, pn; };
struct SchedDense {
    int nM, nN, G, c;
    __device__ __forceinline__ bool next(int i, Unit& u) const {
        const int nwg = nM * nN; const long L = (long)i * G + c; if (L >= nwg) return false;
        int wgid = (int)L; { const int q = nwg / 8, r = nwg % 8, xcd = wgid % 8, off = wgid / 8; wgid = (xcd < r ? xcd * (q + 1) : r * (q + 1) + (xcd - r) * q) + off; }
        const int nig = 8 * nN, gid = wgid / nig, fm = gid * 8, gsz = (nM - fm) < 8 ? (nM - fm) : 8;
        u.pm = fm + ((wgid % nig) % gsz); u.pn = (wgid % nig) / gsz; return true;
    }
    __device__ __forceinline__ size_t boff(const Unit& u, int K) const { return (size_t)u.pn * 256 * K; }
    __device__ __forceinline__ size_t aoff(const Unit&) const { return 0; }
};
struct SchedRKV : SchedDense {
    __device__ __forceinline__ size_t aoff(const Unit& u) const { return (size_t)(u.pn >> 2) * X3S; }
};
struct SchedMoe {
    const LAS int* tt; int ntiles, G, c; size_t estride;
    __device__ __forceinline__ bool next(int i, Unit& u) const { const long L = (long)i * G + c; if (L >= (long)ntiles * 4) return false; u.pm = (int)(L / 4); u.pn = (int)(L % 4); return true; }
    __device__ __forceinline__ size_t boff(const Unit& u, int K) const { return (size_t)(tt[u.pm] >> 16) * estride + (size_t)u.pn * 256 * K; }
    __device__ __forceinline__ size_t aoff(const Unit&) const { return 0; }
};
template <class Epi, class Sched>
__device__ __forceinline__ void gemm_phase(Frame& F, const bf16_t* A, int lda, const bf16_t* Bt, int K, const Sched& S, const Epi& E) {
    const int wr = F.wave >> 2, wc = F.wave & 3, fr = F.lane & 15, fq = F.lane >> 4;
    Unit u;
    for (int i = 0; S.next(i, u); ++i) {
        const bf16_t* Bb = Bt + S.boff(u, K) + (size_t)(wc * 32 + fr) * K + 8 * fq;
        for (int ai = 0; ai < 2; ++ai) {
            f32x4 acc[2][4][2];
#pragma unroll
            for (int b = 0; b < 2; ++b)
#pragma unroll
                for (int m = 0; m < 4; ++m)
#pragma unroll
                    for (int n = 0; n < 2; ++n) acc[b][m][n] = (f32x4){0.f, 0.f, 0.f, 0.f};
            const bf16_t* Ab = A + (size_t)(u.pm * 256 + ai * 128 + wr * 64 + fr) * lda + 8 * fq;
            for (int k0 = 0; k0 < K; k0 += 32) {
                bf16x8 bfr[2][2], af[4];
#pragma unroll
                for (int b = 0; b < 2; ++b)
#pragma unroll
                    for (int n = 0; n < 2; ++n) bfr[b][n] = *(const bf16x8*)(Bb + (size_t)(b * 128 + n * 16) * K + k0);
#pragma unroll
                for (int m = 0; m < 4; ++m) af[m] = *(const bf16x8*)(Ab + (size_t)(m * 16) * lda + k0);
#pragma unroll
                for (int b = 0; b < 2; ++b)
#pragma unroll
                    for (int m = 0; m < 4; ++m)
#pragma unroll
                        for (int n = 0; n < 2; ++n) acc[b][m][n] = __builtin_amdgcn_mfma_f32_16x16x32_bf16(bfr[b][n], af[m], acc[b][m][n], 0, 0, 0);
            }
            E(acc, ai, u, wr, wc, fr, fq);
        }
    }
}
#define PG8_LAS __attribute__((address_space(3)))
constexpr int BM = 256, BK = 64, HALF = 128, HTB = HALF * BK * 2  , STAGE_BYTES = 8 * HTB;

__host__ __device__ __forceinline__ int lds_byte(int r, int c) { const int st = (r >> 4) * 2 + (c >> 5), rr = r & 15, cc = c & 31, ob = rr * 64 + cc * 2; return st * 1024 + (ob ^ (((ob >> 9) & 1) << 5)); }
__host__ __device__ __forceinline__ void stage_rc(int b, int& R, int& C) { const int st = b / 1024, sb = b % 1024, swz = sb ^ (((sb >> 9) & 1) << 5); R = (st >> 1) * 16 + swz / 64; C = (st & 1) * 32 + (swz % 64) / 2; }
__host__ __device__ __forceinline__ int perm32(int rho) { const int n = rho >> 4, i = rho & 15; return 8 * (i >> 2) + 4 * n + (i & 3); }
template <class Epi, class Sched, bool GATHER = false, bool ALIGN_EPI = true, bool SP2 = true>
__device__ __forceinline__ void gemm_fast(Frame& F, const bf16_t* Ag, int lda, const bf16_t* Btg, int Kin, const Sched& S, const Epi& E, const LAS int* tokL = nullptr) {
    static_assert(!GATHER || SP2, "gather mode is written for the SP2 loop");
    PG8_LAS unsigned char* lds = (PG8_LAS unsigned char*)F.lds;
    const int tid = F.tid, wid = F.wave, lane = F.lane, wr = wid >> 2, wc = wid & 3, fr = lane & 15, fq = lane >> 4;
    int K = Kin; asm volatile("" : "+s"(K));
    const int nt = K / BK;
    unsigned voffA[2], voffB[2];
#pragma unroll
    for (int i = 0; i < 2; ++i) { int R, C; stage_rc(tid * 16 + i * 8192, R, C); const int Rb = (Epi::BCONT ? (R >> 5) * 64 : (R & ~31)) + perm32(R & 31);
        voffA[i] = (unsigned)(R * lda + C) * 2u; voffB[i] = (unsigned)(Rb * K + C) * 2u; }
    const size_t kstep = (size_t)(BK * 2);
    const size_t hstepA = (size_t)HALF * lda * 2, hstep = (size_t)(Epi::BCONT ? 32 : HALF) * K * 2;
    const size_t tstepA = 2 * hstepA;
    const unsigned ldsw = (unsigned)wid * 1024u;
    const int aoff = lds_byte(wr * 64 + fr, fq * 8), boff = lds_byte(wc * 32 + fr, fq * 8);
#define PG8_SA(b, h) (((b) * 2 + (h)) * HTB)
#define PG8_SB(b, h) ((4 + (b) * 2 + (h)) * HTB)
    const unsigned ldsb = (unsigned)__builtin_amdgcn_readfirstlane((int)((unsigned)(size_t)lds + ldsw));
#define PG8_STAGE(bufoff, gbase, voff) do { _Pragma("unroll") for (int _i = 0; _i < 2; ++_i) { unsigned keep_; \
        asm volatile("s_mov_b32 %0, m0\n\ts_mov_b32 m0, %3\n\ts_nop 0\n\tglobal_load_lds_dwordx4 %1, %2\n\ts_mov_b32 m0, %0" : "=&s"(keep_) : "v"((voff)[_i]), "s"((const char*)(gbase)), "s"(ldsb + (unsigned)((bufoff) + _i * 8192)) : "memory"); } } while (0)
    unsigned gcu[2][2] = {{0u, 0u}, {0u, 0u}}, gnx[2][2] = {{0u, 0u}, {0u, 0u}};
#define PG8_GOFS(dst, ord) do { int tl_ = tid; asm volatile("" : "+v"(tl_));   _Pragma("unroll") for (int _h = 0; _h < 2; ++_h) _Pragma("unroll") for (int _i = 0; _i < 2; ++_i) { int R_, C_; stage_rc(tl_ * 16 + _i * 8192, R_, C_); \
        dst[_h][_i] = ((unsigned)tokL[(ord) * 256 + _h * 128 + R_] * (unsigned)lda + (unsigned)C_) * 2u; } } while (0)
#define PG8_STAGE_A(bufoff, gptr, half, usenext) do { if constexpr (GATHER) { unsigned vv_[2]; _Pragma("unroll") for (int _j = 0; _j < 2; ++_j) vv_[_j] = (usenext) ? gnx[half][_j] : gcu[half][_j]; PG8_STAGE(bufoff, gptr, vv_); } \
        else { PG8_STAGE(bufoff, (gptr) + ((half) ? hstepA : (size_t)0), voffA); } } while (0)
#define PG8_LDA(dst, b, h) do { _Pragma("unroll") for (int m = 0; m < 4; ++m) _Pragma("unroll") for (int k = 0; k < 2; ++k) dst[m][k] = *(const PG8_LAS bf16x8*)(lds + PG8_SA(b, h) + aoff + m * 2048 + k * 1024); } while (0)
#define PG8_LDB(dst, b, h) do { _Pragma("unroll") for (int n = 0; n < 2; ++n) _Pragma("unroll") for (int k = 0; k < 2; ++k) dst[n][k] = *(const PG8_LAS bf16x8*)(lds + PG8_SB(b, h) + boff + n * 2048 + k * 1024); } while (0)
#define PG8_MMA(ai, bj, At, Bt) do { __builtin_amdgcn_s_setprio(1); _Pragma("unroll") for (int m = 0; m < 4; ++m) _Pragma("unroll") for (int n = 0; n < 2; ++n) _Pragma("unroll") for (int k = 0; k < 2; ++k) \
        acc[ai][bj][m][n] = __builtin_amdgcn_mfma_f32_16x16x32_bf16(Bt[n][k], At[m][k], acc[ai][bj][m][n], 0, 0, 0); __builtin_amdgcn_s_setprio(0); } while (0)
#define PG8_WAIT_V(n) asm volatile("s_waitcnt vmcnt(" #n ")" ::: "memory")
#define PG8_WAIT_R(rel) do { if (rel) asm volatile("s_waitcnt vmcnt(%0)" :: "n"(8 + Epi::NST) : "memory"); else PG8_WAIT_V(8); } while (0)
#define PG8_WAIT_L(n) asm volatile("s_waitcnt lgkmcnt(" #n ")" ::: "memory")
#define PG8_BAR __builtin_amdgcn_s_barrier()
#define PG8_SCHED __builtin_amdgcn_sched_barrier(0)
    Unit cur, nxt; int ui = 0;
    if (!S.next(0, cur)) return;
    f32x4 acc[2][2][4][2];
#pragma unroll
    for (int a = 0; a < 2; ++a)
#pragma unroll
        for (int b = 0; b < 2; ++b)
#pragma unroll
            for (int m = 0; m < 4; ++m)
#pragma unroll
                for (int n = 0; n < 2; ++n) acc[a][b][m][n] = (f32x4){0.f, 0.f, 0.f, 0.f};
    bf16x8 At[4][2], B0[2][2], B1[2][2];
    const char* cA = GATHER ? (const char*)Ag : (const char*)Ag + 2 * S.aoff(cur) + (size_t)cur.pm * tstepA; const char* cB = (const char*)Btg + 2 * S.boff(cur, K);
    if constexpr (GATHER) PG8_GOFS(gcu, 0);
    if constexpr (SP2) {
        PG8_STAGE(PG8_SB(0, 0), cB, voffB); PG8_STAGE(PG8_SB(0, 1), cB + hstep, voffB); PG8_STAGE_A(PG8_SA(0, 0), cA, 0, false); PG8_STAGE_A(PG8_SA(0, 1), cA, 1, false);
        if (wr == 1) PG8_BAR;
        PG8_WAIT_V(2); PG8_BAR;
        PG8_STAGE(PG8_SB(1, 0), cB + kstep, voffB); PG8_STAGE_A(PG8_SA(1, 0), cA + kstep, 0, false); PG8_STAGE(PG8_SB(1, 1), cB + hstep + kstep, voffB);
        PG8_WAIT_V(6); PG8_BAR;
    } else {
        PG8_STAGE(PG8_SB(0, 0), cB, voffB); PG8_STAGE(PG8_SA(0, 0), cA, voffA); PG8_STAGE(PG8_SB(0, 1), cB + hstep, voffB); PG8_STAGE(PG8_SA(0, 1), cA + hstepA, voffA);
        if (wr == 1) PG8_BAR;
        PG8_WAIT_V(4); PG8_BAR;
        PG8_STAGE(PG8_SB(1, 0), cB + kstep, voffB); PG8_STAGE(PG8_SA(1, 0), cA + kstep, voffA); PG8_STAGE(PG8_SB(1, 1), cB + hstep + kstep, voffB);
        PG8_WAIT_V(6); PG8_BAR;
    }
    for (;;) {
        const bool has_next = S.next(ui + 1, nxt);
        const char* nA = GATHER ? cA : (has_next ? (const char*)Ag + 2 * S.aoff(nxt) + (size_t)nxt.pm * tstepA : cA);
        if constexpr (GATHER) { if (has_next) PG8_GOFS(gnx, ui + 1); else { gnx[0][0] = gcu[0][0]; gnx[0][1] = gcu[0][1]; gnx[1][0] = gcu[1][0]; gnx[1][1] = gcu[1][1]; } } const char* nB = has_next ? (const char*)Btg + 2 * S.boff(nxt, K) : cB;
#define PG8_ITER(WAITA, ST11) do { \
            const bool last = (t == nt - 2); \
            const char* a1 = cA + (size_t)(t + 1) * kstep;                                             \
            const char* a2 = last ? nA : cA + (size_t)(t + 2) * kstep; const char* b2 = last ? nB : cB + (size_t)(t + 2) * kstep;     \
            const char* a3 = a2 + kstep; const char* b3 = b2 + kstep;                                \
              \
            PG8_LDB(B0, 0, 0); PG8_LDB(B1, 0, 1); PG8_SCHED; PG8_LDA(At, 0, 0); ST11; \
            WAITA; PG8_WAIT_L(0); PG8_BAR; PG8_MMA(0, 0, At, B0); PG8_MMA(0, 1, At, B1); PG8_BAR; PG8_SCHED; \
              \
            PG8_LDA(At, 0, 1); PG8_STAGE(PG8_SB(0, 0), b2, voffB); PG8_STAGE(PG8_SB(0, 1), b2 + hstep, voffB); PG8_STAGE_A(PG8_SA(0, 0), a2, 0, last); \
            WAITA; PG8_WAIT_L(0); PG8_BAR; PG8_MMA(1, 0, At, B0); PG8_MMA(1, 1, At, B1); PG8_BAR; PG8_SCHED; \
              \
            PG8_LDB(B0, 1, 0); PG8_LDB(B1, 1, 1); PG8_SCHED; PG8_LDA(At, 1, 0); PG8_STAGE_A(PG8_SA(0, 1), a2, 1, last); \
            WAITA; PG8_WAIT_L(0); PG8_BAR; PG8_MMA(0, 0, At, B0); PG8_MMA(0, 1, At, B1); PG8_BAR; PG8_SCHED; \
              \
            PG8_LDA(At, 1, 1); PG8_STAGE(PG8_SB(1, 0), b3, voffB); PG8_STAGE(PG8_SB(1, 1), b3 + hstep, voffB); PG8_STAGE_A(PG8_SA(1, 0), a3, 0, last); \
            PG8_WAIT_V(8); PG8_WAIT_L(0); PG8_BAR; PG8_MMA(1, 0, At, B0); PG8_MMA(1, 1, At, B1); PG8_BAR; PG8_SCHED; } while (0)
        int t = 0;
        if (ui > 0) { PG8_ITER(asm volatile("s_waitcnt vmcnt(%0)" :: "n"(8 + Epi::NST) : "memory"), (void)0); t = 2; }
        for (; t < nt; t += 2) PG8_ITER(PG8_WAIT_V(8), PG8_STAGE_A(PG8_SA(1, 1), a1, 1, false));
#undef PG8_ITER
        if constexpr (SP2) { if (has_next) PG8_STAGE_A(PG8_SA(1, 1), nA + kstep, 1, true); }
        if constexpr (ALIGN_EPI) { if (wr == 0) PG8_BAR; }
        { int fr_ = fr, fq_ = fq; asm volatile("" : "+v"(fr_), "+v"(fq_)); E(acc[0], 0, cur, wr, wc, fr_, fq_); E(acc[1], 1, cur, wr, wc, fr_, fq_); }
        if (!has_next) break;
#pragma unroll
        for (int a = 0; a < 2; ++a)
#pragma unroll
            for (int b = 0; b < 2; ++b)
#pragma unroll
                for (int m = 0; m < 4; ++m)
#pragma unroll
                    for (int n = 0; n < 2; ++n) acc[a][b][m][n] = (f32x4){0.f, 0.f, 0.f, 0.f};
        cur = nxt; cA = nA; cB = nB; ++ui;
        if constexpr (GATHER) { gcu[0][0] = gnx[0][0]; gcu[0][1] = gnx[0][1]; gcu[1][0] = gnx[1][0]; gcu[1][1] = gnx[1][1]; }
        if constexpr (ALIGN_EPI) { if (wr == 1) PG8_BAR; }
    }
    PG8_WAIT_V(0);
    if constexpr (!ALIGN_EPI) { if (wr == 0) PG8_BAR; }
    PG8_BAR;
#undef PG8_SA
#undef PG8_SB
#undef PG8_STAGE
#undef PG8_LDA
#undef PG8_GOFS
#undef PG8_STAGE_A
#undef PG8_LDB
#undef PG8_MMA
#undef PG8_WAIT_V
#undef PG8_WAIT_R
#undef PG8_WAIT_L
#undef PG8_BAR
#undef PG8_SCHED
}
__device__ __forceinline__ void st_bf16x4(bf16_t* p, f32x4 v) { u32x2 w; w.x = pk2(v[0], v[1]); w.y = pk2(v[2], v[3]); *(u32x2*)p = w; }
__device__ __forceinline__ f32x4 ld_bf16x4(const bf16_t* p) { const u32x2 w = *(const u32x2*)p; return (f32x4){lo16(w.x), hi16(w.x), lo16(w.y), hi16(w.y)}; }
__device__ __forceinline__ u32x4 pk8(f32x4 a, f32x4 b) { u32x4 w; w.x = pk2(a[0], a[1]); w.y = pk2(a[2], a[3]); w.z = pk2(b[0], b[1]); w.w = pk2(b[2], b[3]); return w; }
__device__ __forceinline__ u32x4 bperm4(int idx, u32x4 w) { u32x4 r; r.x = (unsigned)__builtin_amdgcn_ds_bpermute(idx, (int)w.x); r.y = (unsigned)__builtin_amdgcn_ds_bpermute(idx, (int)w.y); r.z = (unsigned)__builtin_amdgcn_ds_bpermute(idx, (int)w.z); r.w = (unsigned)__builtin_amdgcn_ds_bpermute(idx, (int)w.w); return r; }
#define EPI_LOOP(ACT, ...) do { const int L_ = fq * 16 + fr, r3_ = L_ >> 3, p3_ = L_ & 7, src4_ = (((p3_ & 3) << 4) | r3_) << 2; const bool hi_ = (p3_ & 4) != 0; \
    _Pragma("unroll") for (int m = 0; m < 4; ++m) { u32x4 wb_[2]; \
        _Pragma("unroll") for (int bj = 0; bj < 2; ++bj) { const int colt0 = wc * 64 + bj * 32 + fq * 8; f32x4 v0 = acc[bj][m][0], v1 = acc[bj][m][1]; (void)colt0; ACT; wb_[bj] = pk8(v0, v1); } \
        _Pragma("unroll") for (int h = 0; h < 2; ++h) { const int row = u.pm * 256 + ai * 128 + wr * 64 + m * 16 + h * 8 + r3_, colt = wc * 64 + p3_ * 8; \
            const u32x4 wa_ = bperm4(src4_ + h * 32, wb_[0]), wc_ = bperm4(src4_ + h * 32, wb_[1]); u32x4 w; w.x = hi_ ? wc_.x : wa_.x; w.y = hi_ ? wc_.y : wa_.y; w.z = hi_ ? wc_.z : wa_.z; w.w = hi_ ? wc_.w : wa_.w; \
            __VA_ARGS__ } asm volatile("" ::: "memory"); } } while (0)

struct EpiPlain {
    bf16_t* O; int ldc; static constexpr int NST = 16; static constexpr bool BCONT = true;
    __device__ __forceinline__ void operator()(const f32x4 (&acc)[2][4][2], int ai, const Unit& u, int wr, int wc, int fr, int fq) const {
        EPI_LOOP(, { __builtin_nontemporal_store(w, (u32x4*)(O + (size_t)row * ldc + u.pn * 256 + colt)); });
    }
};
struct EpiNone { static constexpr int NST = 0; static constexpr bool BCONT = true;
    __device__ __forceinline__ void operator()(const f32x4 (&acc)[2][4][2], int ai, const Unit& u, int wr, int wc, int fr, int fq) const {
        _Pragma("unroll") for (int m = 0; m < 4; ++m) _Pragma("unroll") for (int bj = 0; bj < 2; ++bj) asm volatile("" :: "v"(acc[bj][m][0]), "v"(acc[bj][m][1])); }
};
struct EpiPriv { bf16_t* base; int bid; static constexpr int NST = 16; static constexpr bool BCONT = true;
    __device__ __forceinline__ void operator()(const f32x4 (&acc)[2][4][2], int ai, const Unit& u, int wr, int wc, int fr, int fq) const {
        EPI_LOOP(, { __builtin_nontemporal_store(w, (u32x4*)(base + (size_t)bid * 65536 + (size_t)(row - u.pm * 256) * 256 + colt)); });
    }
};
struct EpiRKV {
    bf16_t* RKV; bf16_t* VF; int l; static constexpr int NST = 16; static constexpr bool BCONT = true;
    __device__ __forceinline__ void operator()(const f32x4 (&acc)[2][4][2], int ai, const Unit& u, int wr, int wc, int fr, int fq) const {
        const bool vf = (l == 0) && (u.pn >= 8);
        EPI_LOOP(, { if (vf) __builtin_nontemporal_store(w, (u32x4*)(VF + (size_t)row * 1024 + (u.pn - 8) * 256 + colt)); else __builtin_nontemporal_store(w, (u32x4*)(RKV + (size_t)row * 3072 + u.pn * 256 + colt)); });
    }
};
struct EpiLA {
    bf16_t* LA; static constexpr int NST = 16; static constexpr bool BCONT = true;
    __device__ __forceinline__ void operator()(const f32x4 (&acc)[2][4][2], int ai, const Unit& u, int wr, int wc, int fr, int fq) const {
        EPI_LOOP({ const int c = u.pn * 256 + colt0;
            if (c < 64) { _Pragma("unroll") for (int q = 0; q < 4; ++q) { v0[q] = tanhf_(v0[q]); v1[q] = tanhf_(v1[q]); } }
            else if (c >= 128 && c < 288) { _Pragma("unroll") for (int q = 0; q < 4; ++q) { v0[q] = sigmoidf_(v0[q]); v1[q] = sigmoidf_(v1[q]); } } },
            { __builtin_nontemporal_store(w, (u32x4*)(LA + (size_t)row * LAW + u.pn * 256 + colt)); });
    }
};
struct EpiSplit2 {
    bf16_t* O0; bf16_t* O1; int sig1; static constexpr int NST = 16; static constexpr bool BCONT = true;
    __device__ __forceinline__ void operator()(const f32x4 (&acc)[2][4][2], int ai, const Unit& u, int wr, int wc, int fr, int fq) const {
        if (u.pn < 4) { EPI_LOOP(, { __builtin_nontemporal_store(w, (u32x4*)(O0 + (size_t)row * 1024 + u.pn * 256 + colt)); }); }
        else { EPI_LOOP({ if (sig1) { _Pragma("unroll") for (int q = 0; q < 4; ++q) { v0[q] = sigmoidf_(v0[q]); v1[q] = sigmoidf_(v1[q]); } } }, { __builtin_nontemporal_store(w, (u32x4*)(O1 + (size_t)row * 1024 + (u.pn - 4) * 256 + colt)); }); }
    }
};
struct EpiMoe1 {
    bf16_t* HM; static constexpr int NST = 8; static constexpr bool BCONT = false;
    __device__ __forceinline__ void operator()(const f32x4 (&acc)[2][4][2], int ai, const Unit& u, int wr, int wc, int fr, int fq) const {
        const int L_ = fq * 16 + fr, src4_ = (((L_ & 3) << 4) | (L_ >> 2)) << 2, r2_ = L_ >> 2, p2_ = L_ & 3;
#pragma unroll
            for (int m = 0; m < 4; ++m) { const int row = u.pm * 256 + ai * 128 + wr * 64 + m * 16 + r2_; f32x4 o[2];
#pragma unroll
                for (int n = 0; n < 2; ++n) { const f32x4 g = acc[0][m][n], up = acc[1][m][n];
#pragma unroll
                    for (int q = 0; q < 4; ++q) o[n][q] = g[q] * sigmoidf_(g[q]) * up[q]; }
                u32x4 w = pk8(o[0], o[1]); w.x = (unsigned)__builtin_amdgcn_ds_bpermute(src4_, (int)w.x); w.y = (unsigned)__builtin_amdgcn_ds_bpermute(src4_, (int)w.y); w.z = (unsigned)__builtin_amdgcn_ds_bpermute(src4_, (int)w.z); w.w = (unsigned)__builtin_amdgcn_ds_bpermute(src4_, (int)w.w);
                __builtin_nontemporal_store(w, (u32x4*)(HM + (size_t)row * 512 + u.pn * 128 + wc * 32 + p2_ * 8)); }
    }
};

struct Row { f32x4 v[4]; };
__device__ __forceinline__ Row ld_row_f32(const float* p, int lane) { Row r;
#pragma unroll
    for (int j = 0; j < 4; ++j) r.v[j] = *(const f32x4*)(p + 256 * j + 4 * lane); return r; }
__device__ __forceinline__ void st_row_f32(float* p, int lane, const Row& r) {
#pragma unroll
    for (int j = 0; j < 4; ++j) __builtin_nontemporal_store(r.v[j], (f32x4*)(p + 256 * j + 4 * lane)); }
__device__ __forceinline__ Row ld_row_bf16(const bf16_t* p, int lane) { Row r;
#pragma unroll
    for (int j = 0; j < 4; ++j) r.v[j] = ld_bf16x4(p + 256 * j + 4 * lane); return r; }
__device__ __forceinline__ void st_row_bf16(bf16_t* p, int lane, const Row& r) {
#pragma unroll
    for (int j = 0; j < 4; ++j) { u32x2 w; w.x = pk2(r.v[j][0], r.v[j][1]); w.y = pk2(r.v[j][2], r.v[j][3]); __builtin_nontemporal_store(w, (u32x2*)(p + 256 * j + 4 * lane)); } }
__device__ __forceinline__ Row row_ln(const Row& u, const Row& g, const Row& b) {
    float s = 0.f;
#pragma unroll
    for (int j = 0; j < 4; ++j) s += (u.v[j][0] + u.v[j][1]) + (u.v[j][2] + u.v[j][3]);
    const float mean = wave_sum(s) * (1.0f / 1024.0f); float q = 0.f; Row d;
#pragma unroll
    for (int j = 0; j < 4; ++j) { d.v[j] = u.v[j] - mean; q += (d.v[j][0] * d.v[j][0] + d.v[j][1] * d.v[j][1]) + (d.v[j][2] * d.v[j][2] + d.v[j][3] * d.v[j][3]); }
    const float rstd = 1.0f / sqrtf(wave_sum(q) * (1.0f / 1024.0f) + LN_EPS); Row o;
#pragma unroll
    for (int j = 0; j < 4; ++j) o.v[j] = d.v[j] * rstd * g.v[j] + b.v[j];
    return o;
}
__device__ __forceinline__ float row_dot(const Row& a, const float* w, int lane) {
    float s = 0.f;
#pragma unroll
    for (int j = 0; j < 4; ++j) { const f32x4 x = *(const f32x4*)(w + 256 * j + 4 * lane); s += (a.v[j][0] * x[0] + a.v[j][1] * x[1]) + (a.v[j][2] * x[2] + a.v[j][3] * x[3]); }
    return s;
}

constexpr int APITCH = 1032;
template <int NCB>
__device__ __forceinline__ void skinny_mfma(Frame& F, const LAS bf16_t* AH, const LAS bf16_t* AL, const bf16_t* BH, const bf16_t* BL, LAS float* part) {
    const int fr = F.lane & 15, fq = F.lane >> 4;
    f32x4 acc[NCB];
#pragma unroll
    for (int cb = 0; cb < NCB; ++cb) acc[cb] = (f32x4){0.f, 0.f, 0.f, 0.f};
#pragma unroll
    for (int kb = 0; kb < 4; ++kb) {
        const int k0 = 128 * F.wave + 32 * kb + 8 * fq;
        const bf16x8 ah = *(const LAS bf16x8*)(AH + fr * APITCH + k0), al = *(const LAS bf16x8*)(AL + fr * APITCH + k0);
#pragma unroll
        for (int cb = 0; cb < NCB; ++cb) {
            const bf16x8 bh = *(const bf16x8*)(BH + (size_t)(cb * 16 + fr) * 1024 + k0), bl = *(const bf16x8*)(BL + (size_t)(cb * 16 + fr) * 1024 + k0);
            acc[cb] = __builtin_amdgcn_mfma_f32_16x16x32_bf16(bh, ah, acc[cb], 0, 0, 0);
            acc[cb] = __builtin_amdgcn_mfma_f32_16x16x32_bf16(bl, ah, acc[cb], 0, 0, 0);
            acc[cb] = __builtin_amdgcn_mfma_f32_16x16x32_bf16(bh, al, acc[cb], 0, 0, 0);
        }
    }
#pragma unroll
    for (int cb = 0; cb < NCB; ++cb) *(LAS f32x4*)(part + (F.wave * 16 + fr) * 48 + cb * 16 + 4 * fq) = acc[cb];
}
template <int NCB> struct SkB { bf16x8 h[4][NCB], l[4][NCB]; };
template <int NCB>
__device__ __forceinline__ void skinny_loadB(Frame& F, const bf16_t* BH, const bf16_t* BL, SkB<NCB>& B) {
    int ln_ = F.lane; asm volatile("" : "+v"(ln_));
    const int fr = ln_ & 15, fq = ln_ >> 4;
#pragma unroll
    for (int kb = 0; kb < 4; ++kb) { const int k0 = 128 * F.wave + 32 * kb + 8 * fq;
#pragma unroll
        for (int cb = 0; cb < NCB; ++cb) { B.h[kb][cb] = *(const bf16x8*)(BH + (size_t)(cb * 16 + fr) * 1024 + k0); B.l[kb][cb] = *(const bf16x8*)(BL + (size_t)(cb * 16 + fr) * 1024 + k0); } }
}
template <int NCB>
__device__ __forceinline__ void skinny_mma(Frame& F, const LAS bf16_t* AH, const LAS bf16_t* AL, const SkB<NCB>& B, LAS float* part) {
    const int fr = F.lane & 15, fq = F.lane >> 4;
    f32x4 acc[NCB];
#pragma unroll
    for (int cb = 0; cb < NCB; ++cb) acc[cb] = (f32x4){0.f, 0.f, 0.f, 0.f};
#pragma unroll
    for (int kb = 0; kb < 4; ++kb) {
        const int k0 = 128 * F.wave + 32 * kb + 8 * fq;
        const bf16x8 ah = *(const LAS bf16x8*)(AH + fr * APITCH + k0), al = *(const LAS bf16x8*)(AL + fr * APITCH + k0);
#pragma unroll
        for (int cb = 0; cb < NCB; ++cb) {
            acc[cb] = __builtin_amdgcn_mfma_f32_16x16x32_bf16(B.h[kb][cb], ah, acc[cb], 0, 0, 0);
            acc[cb] = __builtin_amdgcn_mfma_f32_16x16x32_bf16(B.l[kb][cb], ah, acc[cb], 0, 0, 0);
            acc[cb] = __builtin_amdgcn_mfma_f32_16x16x32_bf16(B.h[kb][cb], al, acc[cb], 0, 0, 0);
        }
    }
#pragma unroll
    for (int cb = 0; cb < NCB; ++cb) *(LAS f32x4*)(part + (F.wave * 16 + fr) * 48 + cb * 16 + 4 * fq) = acc[cb];
}
struct RowPk { u32x2 v[4]; };
__device__ __forceinline__ RowPk ld_row_pk(const bf16_t* p, int lane) { RowPk r;
#pragma unroll
    for (int j = 0; j < 4; ++j) r.v[j] = *(const u32x2*)(p + 256 * j + 4 * lane); return r; }
__device__ __forceinline__ Row unpk_row(const RowPk& p) { Row r;
#pragma unroll
    for (int j = 0; j < 4; ++j) r.v[j] = (f32x4){lo16(p.v[j].x), hi16(p.v[j].x), lo16(p.v[j].y), hi16(p.v[j].y)}; return r; }
typedef _Float16 h16x2 __attribute__((ext_vector_type(2)));
__device__ __forceinline__ unsigned pkh2(float lo, float hi) { return __builtin_bit_cast(unsigned, __builtin_amdgcn_cvt_pkrtz(lo, hi)); }
__device__ __forceinline__ Row unpk_row_h(const RowPk& p) { Row r;
#pragma unroll
    for (int j = 0; j < 4; ++j) { const unsigned wx = p.v[j].x, wy = p.v[j].y;
        const h16x2 a = __builtin_bit_cast(h16x2, wx), b = __builtin_bit_cast(h16x2, wy); r.v[j] = (f32x4){(float)a[0], (float)a[1], (float)b[0], (float)b[1]}; } return r; }
__device__ __forceinline__ void st_row_h(bf16_t* p, int lane, const Row& r) {
#pragma unroll
    for (int j = 0; j < 4; ++j) { u32x2 w; w.x = pkh2(r.v[j][0], r.v[j][1]); w.y = pkh2(r.v[j][2], r.v[j][3]); __builtin_nontemporal_store(w, (u32x2*)(p + 256 * j + 4 * lane)); } }
__device__ __forceinline__ RowPk split_row(const Row& h, LAS bf16_t* ah, LAS bf16_t* al, int lane) { RowPk hp;
#pragma unroll
    for (int j = 0; j < 4; ++j) { unsigned hb[4], lb[4];
#pragma unroll
        for (int q = 0; q < 4; ++q) { hb[q] = f2bf(h.v[j][q]); lb[q] = f2bf(h.v[j][q] - __uint_as_float(hb[q] << 16)); }
        hp.v[j].x = hb[0] | (hb[1] << 16); hp.v[j].y = hb[2] | (hb[3] << 16);
        *(LAS u32x2*)(ah + 256 * j + 4 * lane) = hp.v[j]; u32x2 lw; lw.x = lb[0] | (lb[1] << 16); lw.y = lb[2] | (lb[3] << 16); *(LAS u32x2*)(al + 256 * j + 4 * lane) = lw; }
    return hp; }

template <bool DRY = false>
__device__ __forceinline__ void tok_a(Frame& F, int l) {
    const InTab in = F.in;
    const bf16_t* Y16 = (const bf16_t*)(F.ws + WS_Y16); bf16_t* Hb = (bf16_t*)(F.ws + WS_H2); bf16_t* XS = (bf16_t*)(F.ws + WS_XS);
    const bf16_t* RTH = (const bf16_t*)(F.ws + WS_RT) + (size_t)l * 48 * 1024; const bf16_t* RTL = RTH + (size_t)4 * 48 * 1024;
    float* gates = (float*)(F.ws + WS_GATE); int* asg = (int*)(F.ws + WS_ASG);
    LAS unsigned* lcnt = (LAS unsigned*)F.lds;
    LAS unsigned* ltab = (LAS unsigned*)(F.lds + 1024);
    LAS float* lgt = (LAS float*)(F.lds + 2048);
    LAS float* part = (LAS float*)(F.lds + 8192);
    LAS bf16_t* AH = (LAS bf16_t*)(F.lds + 32768); LAS bf16_t* AL = AH + 16 * APITCH;
    const Row lng = ld_row_f32(in[I_LNG] + (size_t)(l * 2 + 0) * 1024, F.lane), lnb = ld_row_f32(in[I_LNB] + (size_t)(l * 2 + 0) * 1024, F.lane);
    LAS f32x4* MODL = (LAS f32x4*)(F.lds + 98816);
    for (int blk = F.bid; blk < T / 128; blk += F.G) {
        if (F.tid < 64) lcnt[F.tid] = 0u;
        const int tb = blk * 128, b = tb / SEQ;
        const float* mod = (const float*)(F.ws + WS_MOD) + ((size_t)l * 8 + b) * 6144;
        if (F.wave < 3) {
#pragma unroll
            for (int j = 0; j < 4; ++j) MODL[(F.wave * 4 + j) * 64 + F.lane] = *(const f32x4*)(mod + (2 + F.wave) * 1024 + 256 * j + 4 * F.lane); }
        LBAR();
#define GT_(j) MODL[(0 * 4 + (j)) * 64 + F.lane]
#define SHF_(j) MODL[(1 * 4 + (j)) * 64 + F.lane]
#define SCF_(j) MODL[(2 * 4 + (j)) * 64 + F.lane]
        float rb0, rb1;
        { const int c0_ = F.tid % 48, c1_ = (F.tid + NTHR) % 48; rb0 = (c0_ < 4) ? in[I_BGRP][l * 4 + c0_] : (c0_ < 36 ? in[I_BEXP][l * 32 + (c0_ - 4)] : 0.f); rb1 = (c1_ < 4) ? in[I_BGRP][l * 4 + c1_] : (c1_ < 36 ? in[I_BEXP][l * 32 + (c1_ - 4)] : 0.f); }
        RowPk xr[2], yr[2];
#pragma unroll
        for (int q = 0; q < 2; ++q) { const int t = tb + 2 * F.wave + q; xr[q] = ld_row_pk(XS + (size_t)t * 1024, F.lane); yr[q] = ld_row_pk(Y16 + (size_t)t * 1024, F.lane); }
        SkB<3> SB; skinny_loadB<3>(F, RTH, RTL, SB);
        for (int r = 0; r < 8; ++r) {
#pragma unroll
            for (int q = 0; q < 2; ++q) {
                const int i = 2 * F.wave + q, t = tb + 16 * r + i;
                const Row y = unpk_row(yr[q]), xq = unpk_row_h(xr[q]); Row u;
#pragma unroll
                for (int j = 0; j < 4; ++j) u.v[j] = ALPHA * xq.v[j] + (1.0f + GT_(j)) * y.v[j];
                const Row x1 = row_ln(u, lng, lnb);
                if (!DRY) st_row_h(XS + (size_t)t * 1024, F.lane, x1);
                Row h;
#pragma unroll
                for (int j = 0; j < 4; ++j) h.v[j] = x1.v[j] * (1.0f + SCF_(j)) + SHF_(j);
                const RowPk hp = split_row(h, AH + i * APITCH, AL + i * APITCH, F.lane);
#pragma unroll
                for (int j = 0; j < 4; ++j) { if (!DRY) __builtin_nontemporal_store(hp.v[j], (u32x2*)(Hb + (size_t)t * 1024 + 256 * j + 4 * F.lane)); }
            }
#if defined(TOKA_PROBE) && TOKA_PROBE == 2
            if (DRY) { if (r < 7) {
#pragma unroll
                for (int q = 0; q < 2; ++q) { const int t = tb + 16 * (r + 1) + 2 * F.wave + q; xr[q] = ld_row_pk(XS + (size_t)t * 1024, F.lane); yr[q] = ld_row_pk(Y16 + (size_t)t * 1024, F.lane); } }
                LBAR(); continue; }
#endif
            if (r < 7) {
#pragma unroll
                for (int q = 0; q < 2; ++q) { const int t = tb + 16 * (r + 1) + 2 * F.wave + q; xr[q] = ld_row_pk(XS + (size_t)t * 1024, F.lane); yr[q] = ld_row_pk(Y16 + (size_t)t * 1024, F.lane); }
            }
            LBAR();
            skinny_mma<3>(F, AH, AL, SB, part);
            LBAR();
#pragma unroll
            for (int oo = 0; oo < 2; ++oo) { const int o = F.tid + NTHR * oo; if (o < 16 * 48) { const int i = o / 48, c = o % 48; float sm = 0.f;
#pragma unroll
                for (int w = 0; w < 8; ++w) sm += part[(w * 16 + i) * 48 + c];
                lgt[o] = sm + (oo ? rb1 : rb0); } }
            LBAR();
            if (F.tid < 16) {
                const int i = F.tid, t = tb + 16 * r + i; const LAS float* lg = lgt + i * 48;
                const f32x4 lg4 = *(const LAS f32x4*)lg;
                int gs = 0; float gm = lg4[0];
#pragma unroll
                for (int c = 1; c < 4; ++c) if (lg4[c] > gm) { gm = lg4[c]; gs = c; }
                float den = 0.f;
#pragma unroll
                for (int c = 0; c < 4; ++c) den += __expf(lg4[c] - gm);
                const float pg = 1.0f / den;
                const f32x4 le0 = *(const LAS f32x4*)(lg + 4 + gs * 8), le1 = *(const LAS f32x4*)(lg + 8 + gs * 8);
                const float le[8] = {le0[0], le0[1], le0[2], le0[3], le1[0], le1[1], le1[2], le1[3]};
                int i0 = 0; float m0 = le[0];
#pragma unroll
                for (int c = 1; c < 8; ++c) if (le[c] > m0) { m0 = le[c]; i0 = c; }
                int i1 = -1; float m1 = -3.0e38f;
#pragma unroll
                for (int c = 0; c < 8; ++c) if (c != i0 && le[c] > m1) { m1 = le[c]; i1 = c; }
                const float a = __expf(m1 - m0), g0 = pg / (1.0f + a), g1 = pg * a / (1.0f + a);
                const int e0 = gs * 8 + i0, e1 = gs * 8 + i1;
                const unsigned r0 = atomicAdd((unsigned*)&lcnt[e0], 1u), r1 = atomicAdd((unsigned*)&lcnt[e1], 1u);
                ltab[(16 * r + i) * 2] = ((unsigned)e0 << 24) | r0; ltab[(16 * r + i) * 2 + 1] = ((unsigned)e1 << 24) | r1;
                if (!DRY) { gates[(size_t)t * 2] = g0; gates[(size_t)t * 2 + 1] = g1; }
            }
        }
        LBAR();
        if (F.tid < 32) lcnt[32 + F.tid] = DRY ? 0u : __hip_atomic_fetch_add((unsigned*)(F.ws + WS_CTL) + CW_CNT + l * 32 + F.tid, lcnt[F.tid], __ATOMIC_RELAXED, __HIP_MEMORY_SCOPE_AGENT);
        LBAR();
        if (F.tid < 256 && !DRY) { const unsigned w = ltab[F.tid]; const unsigned e = w >> 24; const unsigned rk = (w & 0xffffffu) + lcnt[32 + e]; asg[(size_t)tb * 2 + F.tid] = (int)((e << 24) | rk);
            ((int*)(F.ws + WS_TLIST))[(size_t)e * 65536 + rk] = tb + (F.tid >> 1); }
        LBAR();
    }
}
#undef GT_
#undef SHF_
#undef SCF_
__device__ __forceinline__ void fgate_phase(Frame& F) {
    const InTab in = F.in;
    const bf16_t* WFH = (const bf16_t*)(F.ws + WS_WF); const bf16_t* WFL = WFH + 16 * 1024; float* LF = (float*)(F.ws + WS_LF); const bf16_t* XS = (const bf16_t*)(F.ws + WS_XS);
    LAS float* part = (LAS float*)(F.lds + 8192);
    LAS bf16_t* AH = (LAS bf16_t*)(F.lds + 32768); LAS bf16_t* AL = AH + 16 * APITCH;
    for (int blk = F.bid; blk < T / 128; blk += F.G) {
        const int tb = blk * 128, b = tb / SEQ;
        const float* kvm = (const float*)(F.ws + WS_KVMOD) + (size_t)b * 2048;
        const Row ksh = ld_row_f32(kvm, F.lane), ksc = ld_row_f32(kvm + 1024, F.lane);
        RowPk xr[2];
#pragma unroll
        for (int q = 0; q < 2; ++q) xr[q] = ld_row_pk(XS + (size_t)(tb + 2 * F.wave + q) * 1024, F.lane);
        SkB<1> SBF; skinny_loadB<1>(F, WFH, WFL, SBF);
        LBAR();
        for (int r = 0; r < 8; ++r) {
#pragma unroll
            for (int q = 0; q < 2; ++q) { const int i = 2 * F.wave + q; Row hk; const Row xq = unpk_row_h(xr[q]);
#pragma unroll
                for (int j = 0; j < 4; ++j) hk.v[j] = xq.v[j] * (1.0f + ksc.v[j]) + ksh.v[j];
                (void)split_row(hk, AH + i * APITCH, AL + i * APITCH, F.lane); }
            if (r < 7) {
#pragma unroll
                for (int q = 0; q < 2; ++q) xr[q] = ld_row_pk(XS + (size_t)(tb + 16 * (r + 1) + 2 * F.wave + q) * 1024, F.lane);
            }
            LBAR();
            skinny_mma<1>(F, AH, AL, SBF, part);
            LBAR();
            if (F.tid < 256) { const int i = F.tid >> 4, c = F.tid & 15; float sm = 0.f;
#pragma unroll
                for (int w = 0; w < 8; ++w) sm += part[(w * 16 + i) * 48 + c];
                const float z = sm + in[I_KVFB][c]; LF[(size_t)(tb + 16 * r + i) * 16 + c] = fminf(z, 0.f) - log1pf(__expf(-fabsf(z))); }
        }
        LBAR();
    }
}

template <bool DRY = false>
__device__ __forceinline__ void tok_b(Frame& F, int l, int next) {
    const InTab in = F.in;
    bf16_t* Hb = (bf16_t*)(F.ws + WS_H2); bf16_t* HK = (bf16_t*)(F.ws + WS_RA); bf16_t* XS = (bf16_t*)(F.ws + WS_XS);
    const bf16_t* YM = (const bf16_t*)(F.ws + WS_RA + 144 * MiB);
    const int* asg = (const int*)(F.ws + WS_ASG); const float* gates = (const float*)(F.ws + WS_GATE); const LAS int* lc = (const LAS int*)(F.lds + MOE_LC_OFF);
    const Row lng = ld_row_f32(in[I_LNG] + (size_t)(l * 2 + 1) * 1024, F.lane), lnb = ld_row_f32(in[I_LNB] + (size_t)(l * 2 + 1) * 1024, F.lane);
    const int gw = F.bid * NWAVES + F.wave, NGW = F.G * NWAVES;
    for (int run = gw; run < T / 8; run += NGW) {
        const int t0 = run * 8, b = t0 / SEQ;
        const Row gt = ld_row_f32((const float*)(F.ws + WS_MOD) + ((size_t)l * 8 + b) * 6144 + 5 * 1024, F.lane);
        Row shm, scm;
        if (next < 3) { const float* modn = (const float*)(F.ws + WS_MOD) + ((size_t)(l + 1) * 8 + b) * 6144; shm = ld_row_f32(modn, F.lane); scm = ld_row_f32(modn + 1024, F.lane); }
        else { shm = Row{}; scm = Row{}; }
        int dmine = 0; float gmine = 0.f;
        if (F.lane < 16) { const unsigned a = (unsigned)asg[(size_t)t0 * 2 + F.lane]; dmine = lc[32 + (a >> 24)] + (int)(a & 0xffffffu); gmine = gates[(size_t)t0 * 2 + F.lane]; }
        RowPk xc = ld_row_pk(XS + (size_t)t0 * 1024, F.lane);
        RowPk y0c = ld_row_pk(YM + (size_t)__shfl(dmine, 0) * 1024, F.lane), y1c = ld_row_pk(YM + (size_t)__shfl(dmine, 1) * 1024, F.lane);
        for (int tt = 0; tt < 8; ++tt) {
            const int t = t0 + tt, tn = (tt < 7) ? tt + 1 : tt;
            const RowPk xn = ld_row_pk(XS + (size_t)(t0 + tn) * 1024, F.lane);
            const RowPk y0n = ld_row_pk(YM + (size_t)__shfl(dmine, 2 * tn) * 1024, F.lane), y1n = ld_row_pk(YM + (size_t)__shfl(dmine, 2 * tn + 1) * 1024, F.lane);
            const float g0 = __shfl(gmine, 2 * tt), g1 = __shfl(gmine, 2 * tt + 1);
            const Row y0 = unpk_row(y0c), y1 = unpk_row(y1c), xq = unpk_row_h(xc); Row u;
#pragma unroll
            for (int j = 0; j < 4; ++j) u.v[j] = ALPHA * xq.v[j] + (1.0f + gt.v[j]) * (g0 * y0.v[j] + g1 * y1.v[j]);
            const Row x2 = row_ln(u, lng, lnb);
            if (!DRY) { if (l == 3) st_row_f32(F.xs + (size_t)t * 1024, F.lane, x2); else st_row_h(XS + (size_t)t * 1024, F.lane, x2); } else asm volatile("" :: "v"(x2.v[0]), "v"(x2.v[1]), "v"(x2.v[2]), "v"(x2.v[3]));
            if (next != 3) {
                Row h;
#pragma unroll
                for (int j = 0; j < 4; ++j) h.v[j] = x2.v[j] * (1.0f + scm.v[j]) + shm.v[j];
                if (!DRY) st_row_bf16(Hb + (size_t)t * 1024, F.lane, h); else asm volatile("" :: "v"(h.v[0]), "v"(h.v[3]));
                if (next == 1) {
                    const float* kvm = (const float*)(F.ws + WS_KVMOD) + (size_t)b * 2048;
                    const Row ksh = ld_row_f32(kvm, F.lane), ksc = ld_row_f32(kvm + 1024, F.lane); Row hk;
#pragma unroll
                    for (int j = 0; j < 4; ++j) hk.v[j] = x2.v[j] * (1.0f + ksc.v[j]) + ksh.v[j];
                    if (!DRY) st_row_bf16(HK + (size_t)t * 1024, F.lane, hk); else asm volatile("" :: "v"(hk.v[0]), "v"(hk.v[3]));
                }
            }
            xc = xn; y0c = y0n; y1c = y1n;
        }
    }
}

__device__ __forceinline__ void rw_prep(Frame& F, int ln, bool from_input) {
    bf16_t* Hb = (bf16_t*)(F.ws + WS_H2); bf16_t* X3 = (bf16_t*)(F.ws + WS_SC);
    const float* src = F.in[I_X]; bf16_t* XS = (bf16_t*)(F.ws + WS_XS);
    const float* mu = F.in[I_MU] + (size_t)ln * 6 * 1024;
    const Row mur = ld_row_f32(mu, F.lane), muk = ld_row_f32(mu + 2 * 1024, F.lane), muv = ld_row_f32(mu + 3 * 1024, F.lane);
    const int gw = F.bid * NWAVES + F.wave, NGW = F.G * NWAVES;
    for (int run = gw; run < T / 8; run += NGW) {
        const int t0 = run * 8, b = t0 / SEQ;
        const float* modn = (const float*)(F.ws + WS_MOD) + ((size_t)ln * 8 + b) * 6144;
        const Row shm = ld_row_f32(modn, F.lane), scm = ld_row_f32(modn + 1024, F.lane);
        Row hprev;
#pragma unroll
        for (int j = 0; j < 4; ++j) hprev.v[j] = (f32x4){0.f, 0.f, 0.f, 0.f};
        if ((t0 % SEQ) != 0) {
            const Row xp = from_input ? ld_row_f32(src + (size_t)(t0 - 1) * 1024, F.lane) : unpk_row_h(ld_row_pk(XS + (size_t)(t0 - 1) * 1024, F.lane));
#pragma unroll
            for (int j = 0; j < 4; ++j) hprev.v[j] = xp.v[j] * (1.0f + scm.v[j]) + shm.v[j];
        }
        Row xc = Row{}; RowPk xcp = RowPk{};
        if (from_input) xc = ld_row_f32(src + (size_t)t0 * 1024, F.lane); else xcp = ld_row_pk(XS + (size_t)t0 * 1024, F.lane);
        for (int tt = 0; tt < 8; ++tt) {
            const int t = t0 + tt, tnx = t0 + (tt < 7 ? tt + 1 : tt);
            const Row x = from_input ? xc : unpk_row_h(xcp);
            if (from_input) xc = ld_row_f32(src + (size_t)tnx * 1024, F.lane); else xcp = ld_row_pk(XS + (size_t)tnx * 1024, F.lane);
            if (from_input) st_row_h(XS + (size_t)t * 1024, F.lane, x);
            Row h, xx, xr, xk, xv;
#pragma unroll
            for (int j = 0; j < 4; ++j) { h.v[j] = x.v[j] * (1.0f + scm.v[j]) + shm.v[j]; xx.v[j] = hprev.v[j] - h.v[j];
                xr.v[j] = h.v[j] + xx.v[j] * mur.v[j]; xk.v[j] = h.v[j] + xx.v[j] * muk.v[j]; xv.v[j] = h.v[j] + xx.v[j] * muv.v[j]; }
            st_row_bf16(Hb + (size_t)t * 2048, F.lane, h); st_row_bf16(Hb + (size_t)t * 2048 + 1024, F.lane, xx);
            st_row_bf16(X3 + (size_t)t * 1024, F.lane, xr); st_row_bf16(X3 + X3S + (size_t)t * 1024, F.lane, xk); st_row_bf16(X3 + 2 * X3S + (size_t)t * 1024, F.lane, xv);
            hprev = h;
        }
    }
}

__device__ __forceinline__ void moe_tables(Frame& F, int l) {
    LAS int* lc = (LAS int*)(F.lds + MOE_LC_OFF);
    const unsigned* cnt = (const unsigned*)(F.ws + WS_CTL) + CW_CNT + l * 32;
    if (F.tid == 0) {
        int acc = 0, ntt = 0;
        for (int e = 0; e < 32; ++e) { const int c = (int)__hip_atomic_load(cnt + e, __ATOMIC_RELAXED, __HIP_MEMORY_SCOPE_AGENT); lc[e] = c; lc[32 + e] = acc; const int nt = (c + 255) >> 8;
            for (int i = 0; i < nt; ++i) lc[96 + ntt + i] = (e << 16) | i;
            ntt += nt; acc += nt << 8; }
        lc[64] = ntt;
    }
    __syncthreads();
}
template <class Sched> __device__ __forceinline__ void moe_rows(Frame& F, const Sched& S) {
    const LAS int* lc = (const LAS int*)(F.lds + MOE_LC_OFF); LAS int* tokL = (LAS int*)(F.lds + MOE_TOKL_OFF); const int* tlist = (const int*)(F.ws + WS_TLIST);
    Unit u;
    for (int i = 0; i < 6 && S.next(i, u); ++i) {
        if (F.tid < 256) { const int ek = lc[96 + u.pm], e = ek >> 16, rank = ((ek & 0xffff) << 8) + F.tid;
            tokL[i * 256 + F.tid] = tlist[(size_t)e * 65536 + (rank < lc[e] ? rank : 0)]; }
    }
    __syncthreads();
}

__device__ __forceinline__ float octsum(float v) { v += dpp_f<0xB1>(v); v += dpp_f<0x4E>(v); v += dpp_f<0x141>(v); return v; }
constexpr int CP = 72, SLOT = 64 * CP;
#define PX(r_, c_) ((r_) * 64 + (((((c_) >> 3) ^ (((r_) >> 1) & 7))) << 3) + ((c_) & 7))
constexpr size_t WS_MP = WS_SC, WS_QQ = WS_SC + 64 * MiB, WS_NT = WS_SC + 128 * MiB, WS_GL = WS_SC + 192 * MiB;
template <bool SWAP> __device__ __forceinline__ f32x4 tile_mm(const LAS bf16_t* Ap, const LAS bf16_t* Bp, int fr, int fq) {
    const int o0 = PX(fr, 8 * fq), o1 = PX(fr, 8 * fq + 32);
    const bf16x8 a0 = *(const LAS bf16x8*)(Ap + o0), a1 = *(const LAS bf16x8*)(Ap + o1);
    const bf16x8 b0 = *(const LAS bf16x8*)(Bp + o0), b1 = *(const LAS bf16x8*)(Bp + o1);
    f32x4 acc = (f32x4){0.f, 0.f, 0.f, 0.f};
    if (!SWAP) { acc = __builtin_amdgcn_mfma_f32_16x16x32_bf16(a0, b0, acc, 0, 0, 0); acc = __builtin_amdgcn_mfma_f32_16x16x32_bf16(a1, b1, acc, 0, 0, 0); }
    else       { acc = __builtin_amdgcn_mfma_f32_16x16x32_bf16(b0, a0, acc, 0, 0, 0); acc = __builtin_amdgcn_mfma_f32_16x16x32_bf16(b1, a1, acc, 0, 0, 0); }
    return acc;
}
__device__ __forceinline__ void ld8f(const float* p, float (&o)[8]) { const f32x4 a = *(const f32x4*)p, b = *(const f32x4*)(p + 4); o[0] = a[0]; o[1] = a[1]; o[2] = a[2]; o[3] = a[3]; o[4] = b[0]; o[5] = b[1]; o[6] = b[2]; o[7] = b[3]; }
__device__ __forceinline__ void st4_lds(LAS bf16_t* p, f32x4 v) { u32x2 w; w.x = pk2(v[0], v[1]); w.y = pk2(v[2], v[3]); *(LAS u32x2*)p = w; }
__device__ __forceinline__ f32x4 ld4_lds(const LAS bf16_t* p) { const u32x2 w = *(const LAS u32x2*)p; return (f32x4){lo16(w.x), hi16(w.x), lo16(w.y), hi16(w.y)}; }
__device__ __forceinline__ void unpk8(const u32x4 w, float (&o)[8]) { o[0] = lo16(w.x); o[1] = hi16(w.x); o[2] = lo16(w.y); o[3] = hi16(w.y); o[4] = lo16(w.z); o[5] = hi16(w.z); o[6] = lo16(w.w); o[7] = hi16(w.w); }
__device__ __forceinline__ void st8_lds(LAS bf16_t* p, const float (&o)[8]) { u32x4 w; w.x = pk2(o[0], o[1]); w.y = pk2(o[2], o[3]); w.z = pk2(o[4], o[5]); w.w = pk2(o[6], o[7]); *(LAS u32x4*)p = w; }

template <int PROBE = 0>
__device__ __forceinline__ void wkv_chunk_prep(Frame& F, int l) {
    const InTab in = F.in;
    const bf16_t* RKV = (const bf16_t*)(F.ws + WS_RA);
    bf16_t* YS = (bf16_t*)(F.ws + WS_Y16); bf16_t* MP = (bf16_t*)(F.ws + WS_MP); bf16_t* QQ = (bf16_t*)(F.ws + WS_QQ); bf16_t* NTt = (bf16_t*)(F.ws + WS_NT); float* GLB = (float*)(F.ws + WS_GL);
    LAS bf16_t* L0 = (LAS bf16_t*)F.lds;
#define SL(n) (L0 + (n) * 4096)
    LAS float* WLs = (LAS float*)(F.lds + 8 * 8192);
    LAS float* SEG = WLs + 64 * 65;
    const int pt = F.tid >> 3, pc0 = 8 * (F.tid & 7);
    const bf16_t* LAg = (const bf16_t*)(F.ws + WS_RA + 192 * MiB); const bf16_t* VFg = (const bf16_t*)(F.ws + WS_P); float* BON = (float*)(F.ws + WS_LF);
    const bf16_t* W2T = (const bf16_t*)(F.ws + WS_LORA2 + (size_t)l * MiB + L2_W2T); const bf16_t* A2T = (const bf16_t*)(F.ws + WS_LORA2 + (size_t)l * MiB + L2_A2T); const bf16_t* V2T = (const bf16_t*)(F.ws + WS_LORA2 + (size_t)l * MiB + L2_V2T);
    u32x4 gr, gk, gv, glw, gla, glv, gvf, gw2, ga2, gv2;
#define PREP_LOAD(uu) do { const int bh_ = (uu) >> 6, c_ = (uu) & 63; const size_t row = (size_t)(bh_ >> 4) * SEQ + 64 * c_ + pt; const int hh = (bh_ & 15) * 64, hc = hh + pc0; \
        gr = *(const u32x4*)(RKV + row * 3072 + hc); gk = *(const u32x4*)(RKV + row * 3072 + 1024 + hc); gv = (l == 0) ? *(const u32x4*)(VFg + row * 1024 + hc) : *(const u32x4*)(RKV + row * 3072 + 2048 + hc); \
        glw = *(const u32x4*)(LAg + row * LAW + pc0); gla = *(const u32x4*)(LAg + row * LAW + 64 + pc0); \
        gw2 = *(const u32x4*)(W2T + (size_t)(hh + pt) * 64 + pc0); ga2 = *(const u32x4*)(A2T + (size_t)(hh + pt) * 64 + pc0); \
        if (l == 1) { glv = *(const u32x4*)(LAg + row * LAW + 288 + (pc0 & 31)); gvf = *(const u32x4*)(VFg + row * 1024 + hc); gv2 = *(const u32x4*)(V2T + (size_t)(hh + pt) * 64 + pc0); } } while (0)
    glv = (u32x4){0u, 0u, 0u, 0u}; gvf = glv; gv2 = glv;
    if (F.bid < 128 * 64) PREP_LOAD(F.bid);
    for (int u = F.bid; u < 128 * 64; u += F.G) {
        const int bh = u >> 6, c = u & 63, b = bh >> 4, h = bh & 15;
        const size_t row0 = (size_t)b * SEQ + 64 * c;
        int ln_ = F.lane; asm volatile("" : "+v"(ln_));
        const int fr = ln_ & 15, fq = ln_ >> 4;
        *(LAS u32x4*)(SL(0) + PX(pt, pc0)) = glw; *(LAS u32x4*)(SL(1) + PX(pt, pc0)) = gla; *(LAS u32x4*)(SL(3) + PX(pt, pc0)) = gw2; *(LAS u32x4*)(SL(4) + PX(pt, pc0)) = ga2;
        if (l == 1) { *(LAS u32x4*)(SL(2) + PX(pt, pc0)) = (pc0 < 32) ? glv : (u32x4){0u, 0u, 0u, 0u}; *(LAS u32x4*)(SL(5) + PX(pt, pc0)) = gv2; }
        LBAR();
        {
            f32x4 zw[2], za[2], zv[2];
#pragma unroll
            for (int i = 0; i < 2; ++i) { const int tile = F.wave + 8 * i, mt = tile >> 2, nt = tile & 3;
                zw[i] = tile_mm<false>(SL(0) + 16 * mt * 64, SL(3) + 16 * nt * 64, fr, fq);
                za[i] = tile_mm<true>(SL(1) + 16 * mt * 64, SL(4) + 16 * nt * 64, fr, fq);
                if (l == 1) zv[i] = tile_mm<true>(SL(2) + 16 * mt * 64, SL(5) + 16 * nt * 64, fr, fq); }
#pragma unroll
            for (int i = 0; i < 2; ++i) { const int tile = F.wave + 8 * i, mt = tile >> 2, nt = tile & 3; const int rr = 16 * mt + fr, cc = 16 * nt + 4 * fq;
                const float w0s = in[I_W0][l * 1024 + h * 64 + 16 * nt + fr]; const f32x4 a0v = *(const f32x4*)(in[I_A0] + l * 1024 + h * 64 + cc); f32x4 av, wh, wlo;
#pragma unroll
                for (int q = 0; q < 4; ++q) { const float wl_ = -0.6065306597126334f * sigmoidf_(zw[i][q] + w0s); wh[q] = bf2f((unsigned short)f2bf(wl_)); wlo[q] = wl_ - wh[q]; av[q] = sigmoidf_(za[i][q] + a0v[q]); }
                st4_lds(SL(11) + PX(16 * nt + fr, 16 * mt + 4 * fq), wh); st4_lds(SL(12) + PX(16 * nt + fr, 16 * mt + 4 * fq), wlo);
                st4_lds(SL(6) + PX(rr, cc), av);
                if (l == 1) { const f32x4 v0v = *(const f32x4*)(in[I_V0] + h * 64 + cc); f32x4 sv;
#pragma unroll
                    for (int q = 0; q < 4; ++q) sv[q] = sigmoidf_(zv[i][q] + v0v[q]);
                    st4_lds(SL(7) + PX(rr, cc), sv); } }
        }
        LBAR();
        float r[8], k[8], v[8], a[8];
        unpk8(gr, r); unpk8(gk, k); unpk8(gv, v); unpk8(*(const LAS u32x4*)(SL(6) + PX(pt, pc0)), a);
        if (l == 1) { float sv[8], vf[8]; unpk8(*(const LAS u32x4*)(SL(7) + PX(pt, pc0)), sv); unpk8(gvf, vf);
#pragma unroll
            for (int q = 0; q < 8; ++q) v[q] = bf2f((unsigned short)f2bf(v[q] + (vf[q] - v[q]) * sv[q]));
            if (PROBE == 0) { u32x4 w; w.x = pk2(v[0], v[1]); w.y = pk2(v[2], v[3]); w.z = pk2(v[4], v[5]); w.w = pk2(v[6], v[7]); *(u32x4*)((bf16_t*)RKV + (row0 + pt) * 3072 + 2048 + h * 64 + pc0) = w; } }
        {
            f32x4 cs[2];
#pragma unroll
            for (int i = 0; i < 2; ++i) { const int tile = F.wave + 8 * i, mt = tile >> 2, nt = tile & 3;
                bf16x8 l0, l1;
#pragma unroll
                for (int e = 0; e < 8; ++e) { l0[e] = (short)((8 * fq + e <= 16 * mt + fr) ? 0x3F80 : 0); l1[e] = (short)((32 + 8 * fq + e <= 16 * mt + fr) ? 0x3F80 : 0); }
                const int c0_ = PX(16 * nt + fr, 8 * fq), c1_ = PX(16 * nt + fr, 8 * fq + 32); const LAS bf16_t* bh = SL(11); const LAS bf16_t* bl = SL(12);
                f32x4 acc = (f32x4){0.f, 0.f, 0.f, 0.f};
                acc = __builtin_amdgcn_mfma_f32_16x16x32_bf16(*(const LAS bf16x8*)(bh + c0_), l0, acc, 0, 0, 0); acc = __builtin_amdgcn_mfma_f32_16x16x32_bf16(*(const LAS bf16x8*)(bh + c1_), l1, acc, 0, 0, 0);
                acc = __builtin_amdgcn_mfma_f32_16x16x32_bf16(*(const LAS bf16x8*)(bl + c0_), l0, acc, 0, 0, 0); acc = __builtin_amdgcn_mfma_f32_16x16x32_bf16(*(const LAS bf16x8*)(bl + c1_), l1, acc, 0, 0, 0);
                cs[i] = acc; }
#pragma unroll
            for (int i = 0; i < 2; ++i) { const int tile = F.wave + 8 * i, mt = tile >> 2, nt = tile & 3; const int rr = 16 * mt + fr, cc = 16 * nt + 4 * fq;
#pragma unroll
                for (int q = 0; q < 4; ++q) WLs[rr * 65 + cc + q] = cs[i][q]; }
        }
        LBAR();
        {
            float kkw[8], kaw[8], rkw[8]; ld8f(in[I_KK] + l * 1024 + h * 64 + pc0, kkw); ld8f(in[I_KA] + l * 1024 + h * 64 + pc0, kaw); ld8f(in[I_RK] + l * 1024 + h * 64 + pc0, rkw);
            float kr[8], ss = 0.f, bs = 0.f;
#pragma unroll
            for (int q = 0; q < 8; ++q) { kr[q] = k[q] * kkw[q]; ss += kr[q] * kr[q]; }
            ss = octsum(ss);
            const float inv = 1.0f / fmaxf(sqrtf(ss), 1e-12f);
            float At[8], Rt[8], Bt[8], Kt[8], Bb[8], Kb[8], gl[8];
#pragma unroll
            for (int q = 0; q < 8; ++q) {
                const float cum = WLs[pt * 65 + pc0 + q], cl = WLs[63 * 65 + pc0 + q], cex = (pt > 0) ? WLs[(pt - 1) * 65 + pc0 + q] : 0.f;
                const float e_in = __expf(cum), e_ex = __expf(cex), e_ng = __expf(-cum); gl[q] = __expf(cl);
                const float kk = kr[q] * inv, kp = k[q] * (1.0f + (a[q] - 1.0f) * kaw[q]); bs += r[q] * kp * rkw[q];
                At[q] = -kk * e_ex; Rt[q] = r[q] * e_in; Bt[q] = kk * a[q] * e_ng; Kt[q] = kp * e_ng; Bb[q] = Bt[q] * gl[q]; Kb[q] = Kt[q] * gl[q];
            }
            st8_lds(SL(0) + PX(pt, pc0), At); st8_lds(SL(1) + PX(pt, pc0), Rt); st8_lds(SL(2) + PX(pt, pc0), Bt); st8_lds(SL(3) + PX(pt, pc0), Kt);
            st8_lds(SL(11) + PX(pt, pc0), v); st8_lds(SL(12) + PX(pt, pc0), Bb); st8_lds(SL(13) + PX(pt, pc0), Kb);
            bs = octsum(bs); if ((F.tid & 7) == 0 && PROBE == 0) BON[(row0 + pt) * 16 + h] = bs;
            if (pt == 0 && PROBE == 0) { float* g = GLB + (size_t)u * 64 + pc0; *(f32x4*)g = (f32x4){gl[0], gl[1], gl[2], gl[3]}; *(f32x4*)(g + 4) = (f32x4){gl[4], gl[5], gl[6], gl[7]}; }
        }
        LBAR();
        {
            const int j = F.tid & 63, t0 = 8 * (F.tid >> 6);
#define TRANSP(src, dst) do { float e[8]; _Pragma("unroll") for (int q = 0; q < 8; ++q) e[q] = bf2f(SL(src)[PX(t0 + q, j)]); st8_lds(SL(dst) + PX(j, t0), e); } while (0)
            TRANSP(0, 6); TRANSP(12, 7); TRANSP(13, 5); TRANSP(11, 4);
#undef TRANSP
            if (u + F.G < 128 * 64) PREP_LOAD(u + F.G);
        }
        LBAR();
        if (PROBE == 1) continue;
        {
            f32x4 acc[8];
#pragma unroll
            for (int i = 0; i < 8; ++i) acc[i] = tile_mm<true>(SL(0) + 16 * i * 64, SL(2) + 16 * F.wave * 64, fr, fq);
            const int nt = F.wave, sq0 = (nt & 3) * 16 + 4 * fq;
#pragma unroll
            for (int i = 0; i < 8; ++i) {
                const int mt = i, tq = (mt & 3) * 16 + fr; f32x4 o;
#pragma unroll
                for (int q = 0; q < 4; ++q) { const int sq = sq0 + q; const bool keep = (mt < 4) ? (sq < tq) : (sq <= tq); o[q] = keep ? acc[i][q] : 0.f; }
                LAS bf16_t* dst = (mt < 4) ? ((nt < 4) ? SL(8) : SL(10)) : ((nt < 4) ? SL(11) : SL(12));
                st4_lds(dst + PX(tq, sq0), o);
                if (mt < 4 && nt < 4) {
#pragma unroll
                    for (int q = 0; q < 4; ++q) SL(9)[PX(sq0 + q, tq)] = (bf16_t)f2bf(o[q]); }
            }
        }
        LBAR();
        {
            f32x4 x[2], y1[2], nk[2];
#pragma unroll
            for (int i = 0; i < 2; ++i) { const int tile = F.wave + 8 * i, mt = tile >> 2, nt = tile & 3;
                x[i] = tile_mm<false>(SL(10) + 16 * mt * 64, SL(4) + 16 * nt * 64, fr, fq);
                y1[i] = tile_mm<true>(SL(12) + 16 * mt * 64, SL(4) + 16 * nt * 64, fr, fq);
                nk[i] = tile_mm<false>(SL(5) + 16 * mt * 64, SL(4) + 16 * nt * 64, fr, fq); }
#pragma unroll
            for (int i = 0; i < 2; ++i) { const int tile = F.wave + 8 * i, mt = tile >> 2, nt = tile & 3;
                st4_lds(SL(2) + PX(16 * nt + fr, 16 * mt + 4 * fq), x[i]);
                st4_lds(SL(3) + PX(16 * mt + fr, 16 * nt + 4 * fq), y1[i]);
                st4_lds(SL(0) + PX(16 * nt + fr, 16 * mt + 4 * fq), nk[i]); }
        }
        LBAR();
        if (PROBE == 2) continue;
#define NEU_SQ(Xn, Xt, On, Ot, WANT_NAT) do { f32x4 s_[2]; \
            _Pragma("unroll") for (int i = 0; i < 2; ++i) { const int tile = F.wave + 8 * i, mt = tile >> 2, nt = tile & 3; s_[i] = tile_mm<true>(SL(Xn) + 16 * mt * 64, SL(Xt) + 16 * nt * 64, fr, fq); } \
            _Pragma("unroll") for (int i = 0; i < 2; ++i) { const int tile = F.wave + 8 * i, mt = tile >> 2, nt = tile & 3; \
                if (WANT_NAT) st4_lds(SL(On) + PX(16 * mt + fr, 16 * nt + 4 * fq), s_[i]); \
                _Pragma("unroll") for (int q = 0; q < 4; ++q) SL(Ot)[PX(16 * nt + 4 * fq + q, 16 * mt + fr)] = (bf16_t)f2bf(s_[i][q]); } } while (0)
#define NEU_PR(Ti, Yt, To) do { f32x4 p_[2]; \
            _Pragma("unroll") for (int i = 0; i < 2; ++i) { const int tile = F.wave + 8 * i, mt = tile >> 2, nt = tile & 3; \
                p_[i] = tile_mm<true>(SL(Ti) + 16 * mt * 64, SL(Yt) + 16 * nt * 64, fr, fq) + ld4_lds(SL(Ti) + PX(16 * mt + fr, 16 * nt + 4 * fq)); } \
            _Pragma("unroll") for (int i = 0; i < 2; ++i) { const int tile = F.wave + 8 * i, mt = tile >> 2, nt = tile & 3; st4_lds(SL(To) + PX(16 * mt + fr, 16 * nt + 4 * fq), p_[i]); } } while (0)
#define NEU_BOTH(Ti, Yt, To, Xn, Xt, On, Ot, WANT_NAT) do { f32x4 p_[2], s_[2]; \
            _Pragma("unroll") for (int i = 0; i < 2; ++i) { const int tile = F.wave + 8 * i, mt = tile >> 2, nt = tile & 3; \
                p_[i] = tile_mm<true>(SL(Ti) + 16 * mt * 64, SL(Yt) + 16 * nt * 64, fr, fq) + ld4_lds(SL(Ti) + PX(16 * mt + fr, 16 * nt + 4 * fq)); \
                s_[i] = tile_mm<true>(SL(Xn) + 16 * mt * 64, SL(Xt) + 16 * nt * 64, fr, fq); } \
            _Pragma("unroll") for (int i = 0; i < 2; ++i) { const int tile = F.wave + 8 * i, mt = tile >> 2, nt = tile & 3; \
                st4_lds(SL(To) + PX(16 * mt + fr, 16 * nt + 4 * fq), p_[i]); \
                if (WANT_NAT) st4_lds(SL(On) + PX(16 * mt + fr, 16 * nt + 4 * fq), s_[i]); \
                _Pragma("unroll") for (int q = 0; q < 4; ++q) SL(Ot)[PX(16 * nt + 4 * fq + q, 16 * mt + fr)] = (bf16_t)f2bf(s_[i][q]); } } while (0)
        NEU_SQ(8, 9, 10, 12, true);
        LBAR();
        {
            f32x4 p_[2];
#pragma unroll
            for (int i = 0; i < 2; ++i) { const int tile = F.wave + 8 * i, mt = tile >> 2, nt = tile & 3; const int rr = 16 * mt + fr, cc = 16 * nt + 4 * fq;
                p_[i] = tile_mm<true>(SL(8) + 16 * mt * 64, SL(12) + 16 * nt * 64, fr, fq) + ld4_lds(SL(8) + PX(rr, cc)) + ld4_lds(SL(10) + PX(rr, cc));
#pragma unroll
                for (int q = 0; q < 4; ++q) if (cc + q == rr) p_[i][q] += 1.0f; }
            NEU_SQ(10, 12, 5, 13, true);
#pragma unroll
            for (int i = 0; i < 2; ++i) { const int tile = F.wave + 8 * i, mt = tile >> 2, nt = tile & 3; st4_lds(SL(4) + PX(16 * mt + fr, 16 * nt + 4 * fq), p_[i]); }
        }
        LBAR();
        NEU_BOTH(4, 13, 8, 5, 13, 9, 10, true);
        LBAR();
        NEU_BOTH(8, 10, 4, 9, 10, 5, 12, true);
        LBAR();
        NEU_BOTH(4, 12, 8, 5, 12, 5, 13, false);
        LBAR();
        NEU_PR(8, 13, 4);
        LBAR();
#undef NEU_SQ
#undef NEU_PR
#undef NEU_BOTH
        if (PROBE == 3) continue;
        {
            f32x4 p[2], u0[2];
#pragma unroll
            for (int i = 0; i < 2; ++i) { const int tile = F.wave + 8 * i, mt = tile >> 2, nt = tile & 3;
                p[i] = tile_mm<false>(SL(4) + 16 * mt * 64, SL(6) + 16 * nt * 64, fr, fq);
                u0[i] = tile_mm<false>(SL(4) + 16 * mt * 64, SL(2) + 16 * nt * 64, fr, fq); }
#pragma unroll
            for (int i = 0; i < 2; ++i) { const int tile = F.wave + 8 * i, mt = tile >> 2, nt = tile & 3;
                st4_lds(SL(9) + PX(16 * nt + fr, 16 * mt + 4 * fq), p[i]); st4_lds(SL(10) + PX(16 * nt + fr, 16 * mt + 4 * fq), u0[i]); }
        }
        LBAR();
        {
            f32x4 qv[2], y0[2], mp[2], ntv[2];
#pragma unroll
            for (int i = 0; i < 2; ++i) { const int tile = F.wave + 8 * i, mt = tile >> 2, nt = tile & 3; const int rr = 16 * mt + fr, cc = 16 * nt + 4 * fq, ri = 16 * nt + fr, cj = 16 * mt + 4 * fq;
                qv[i] = tile_mm<true>(SL(11) + 16 * mt * 64, SL(9) + 16 * nt * 64, fr, fq) + ld4_lds(SL(1) + PX(rr, cc));
                y0[i] = tile_mm<true>(SL(11) + 16 * mt * 64, SL(10) + 16 * nt * 64, fr, fq) + ld4_lds(SL(3) + PX(rr, cc));
                mp[i] = tile_mm<true>(SL(7) + 16 * mt * 64, SL(9) + 16 * nt * 64, fr, fq);
                ntv[i] = tile_mm<false>(SL(7) + 16 * mt * 64, SL(10) + 16 * nt * 64, fr, fq) + ld4_lds(SL(0) + PX(ri, cj)); }
#pragma unroll
            for (int i = 0; i < 2; ++i) { const int tile = F.wave + 8 * i, mt = tile >> 2, nt = tile & 3; const int rr = 16 * mt + fr, cc = 16 * nt + 4 * fq, ri = 16 * nt + fr, cj = 16 * mt + 4 * fq;
                st4_lds(SL(5) + PX(rr, cc), qv[i]); st4_lds(SL(8) + PX(rr, cc), y0[i]); st4_lds(SL(12) + PX(rr, cc), mp[i]); st4_lds(SL(13) + PX(ri, cj), ntv[i]); }
        }
        LBAR();
        if (PROBE == 0) {
            const int rw = F.tid >> 3, ch = 8 * (F.tid & 7);
            __builtin_nontemporal_store(*(const LAS u32x4*)(SL(5) + PX(rw, ch)), (u32x4*)(QQ + ((size_t)u * 64 + rw) * 64 + ch));
            __builtin_nontemporal_store(*(const LAS u32x4*)(SL(12) + PX(rw, ch)), (u32x4*)(MP + ((size_t)u * 64 + rw) * 64 + ch));
            __builtin_nontemporal_store(*(const LAS u32x4*)(SL(13) + PX(rw, ch)), (u32x4*)(NTt + ((size_t)u * 64 + rw) * 64 + ch));
            __builtin_nontemporal_store(*(const LAS u32x4*)(SL(8) + PX(rw, ch)), (u32x4*)(YS + (row0 + rw) * 1024 + h * 64 + ch));
        }
        LBAR();
    }
#undef PREP_LOAD
#undef SL
}

__device__ __forceinline__ void wkv_chunk_seq(Frame& F, int l) {
    bf16_t* YS = (bf16_t*)(F.ws + WS_Y16); const bf16_t* MP = (const bf16_t*)(F.ws + WS_MP); const bf16_t* QQ = (const bf16_t*)(F.ws + WS_QQ); const bf16_t* NTt = (const bf16_t*)(F.ws + WS_NT); const float* GLB = (const float*)(F.ws + WS_GL);
    LAS bf16_t* Zt = (LAS bf16_t*)F.lds;
    const bf16_t* RKVc = (const bf16_t*)(F.ws + WS_RA); const bf16_t* VFc = (const bf16_t*)(F.ws + WS_P); const bf16_t* G16 = (const bf16_t*)(F.ws + WS_RA + 224 * MiB); const float* BON = (const float*)(F.ws + WS_LF); bf16_t* OG = (bf16_t*)(F.ws + WS_H2);
    LAS bf16_t* Yb = Zt + 2 * SLOT;
    const int fr = F.lane & 15, fq = F.lane >> 4, mt = F.wave >> 1, ntb = 2 * (F.wave & 1);
    struct Ops { bf16x8 m0, m1, q0, q1; f32x4 gl; u32x2 n0, n1, y0, y1; };
    for (int item = F.bid; item < 128; item += F.G) {
        const int bh = item, b = bh >> 4, h = bh & 15; const size_t rowb = (size_t)b * SEQ;
        float gng[8], gnb[8]; ld8f(F.in[I_GNG] + l * 1024 + h * 64 + 8 * (F.tid & 7), gng); ld8f(F.in[I_GNB] + l * 1024 + h * 64 + 8 * (F.tid & 7), gnb);
        for (int i = F.tid; i < 2 * SLOT / 2; i += NTHR) ((LAS unsigned*)Zt)[i] = 0u;
        f32x4 Z0 = (f32x4){0.f, 0.f, 0.f, 0.f}, Z1 = Z0;
        LBAR();
#define SEQ_LOAD(O, cc_) do { const size_t cu = (size_t)bh * 64 + (cc_); \
        const bf16_t* mp = MP + (cu * 64 + 16 * mt + fr) * 64 + 8 * fq; O.m0 = *(const bf16x8*)mp; O.m1 = *(const bf16x8*)(mp + 32); \
        const bf16_t* qp = QQ + (cu * 64 + 16 * mt + fr) * 64 + 8 * fq; O.q0 = *(const bf16x8*)qp; O.q1 = *(const bf16x8*)(qp + 32); \
        O.gl = *(const f32x4*)(GLB + cu * 64 + 16 * mt + 4 * fq); \
        const bf16_t* np_ = NTt + (cu * 64 + 16 * ntb + fr) * 64 + 16 * mt + 4 * fq; O.n0 = *(const u32x2*)np_; O.n1 = *(const u32x2*)(np_ + 16 * 64); \
        const bf16_t* yp = YS + (rowb + 64 * (cc_) + 16 * mt + fr) * 1024 + h * 64 + 16 * ntb + 4 * fq; O.y0 = *(const u32x2*)yp; O.y1 = *(const u32x2*)(yp + 16); } while (0)
#define SEQ_STEP(O, cc_) do { const LAS bf16_t* Zc = Zt + ((cc_) & 1) * SLOT; LAS bf16_t* Zn = Zt + (((cc_) + 1) & 1) * SLOT; \
        const LAS bf16_t* z0p = Zc + (16 * ntb + fr) * CP + 8 * fq; const LAS bf16_t* z1p = z0p + 16 * CP; \
        const bf16x8 b00 = *(const LAS bf16x8*)z0p, b01 = *(const LAS bf16x8*)(z0p + 32), b10 = *(const LAS bf16x8*)z1p, b11 = *(const LAS bf16x8*)(z1p + 32); \
        f32x4 a0 = (f32x4){0.f, 0.f, 0.f, 0.f}, a1 = a0, c0 = a0, c1 = a0; \
        a0 = __builtin_amdgcn_mfma_f32_16x16x32_bf16(O.m0, b00, a0, 0, 0, 0); a0 = __builtin_amdgcn_mfma_f32_16x16x32_bf16(O.m1, b01, a0, 0, 0, 0); \
        a1 = __builtin_amdgcn_mfma_f32_16x16x32_bf16(O.m0, b10, a1, 0, 0, 0); a1 = __builtin_amdgcn_mfma_f32_16x16x32_bf16(O.m1, b11, a1, 0, 0, 0); \
        c0 = __builtin_amdgcn_mfma_f32_16x16x32_bf16(b00, O.q0, c0, 0, 0, 0); c0 = __builtin_amdgcn_mfma_f32_16x16x32_bf16(b01, O.q1, c0, 0, 0, 0); \
        c1 = __builtin_amdgcn_mfma_f32_16x16x32_bf16(b10, O.q0, c1, 0, 0, 0); c1 = __builtin_amdgcn_mfma_f32_16x16x32_bf16(b11, O.q1, c1, 0, 0, 0); \
        Z0 = O.gl * Z0 + a0 + (f32x4){lo16(O.n0.x), hi16(O.n0.x), lo16(O.n0.y), hi16(O.n0.y)}; Z1 = O.gl * Z1 + a1 + (f32x4){lo16(O.n1.x), hi16(O.n1.x), lo16(O.n1.y), hi16(O.n1.y)}; \
        { LAS bf16_t* yl = Yb + (((cc_) & 7) * 64 + 16 * mt + fr) * CP + 16 * ntb + 4 * fq; \
          st4_lds(yl, c0 + (f32x4){lo16(O.y0.x), hi16(O.y0.x), lo16(O.y0.y), hi16(O.y0.y)}); st4_lds(yl + 16, c1 + (f32x4){lo16(O.y1.x), hi16(O.y1.x), lo16(O.y1.y), hi16(O.y1.y)}); } \
        st4_lds(Zn + (16 * ntb + fr) * CP + 16 * mt + 4 * fq, Z0); st4_lds(Zn + (16 * ntb + 16 + fr) * CP + 16 * mt + 4 * fq, Z1); \
        LBAR(); \
        if (((cc_) & 7) == 7) { _Pragma("unroll 2") for (int i_ = 0; i_ < 8; ++i_) { const int o_ = F.tid + NTHR * i_, ck_ = o_ >> 9, rw_ = (o_ >> 3) & 63, ch_ = 8 * (o_ & 7); \
            const size_t tr_ = rowb + 64 * ((cc_) - 7 + ck_) + rw_; float y_[8], v_[8], g_[8]; \
            unpk8(*(const LAS u32x4*)(Yb + (ck_ * 64 + rw_) * CP + ch_), y_); unpk8((l == 0) ? *(const u32x4*)(VFc + tr_ * 1024 + h * 64 + ch_) : *(const u32x4*)(RKVc + tr_ * 3072 + 2048 + h * 64 + ch_), v_); unpk8(*(const u32x4*)(G16 + tr_ * 1024 + h * 64 + ch_), g_); \
            const float bs_ = BON[tr_ * 16 + h]; float s_ = 0.f; _Pragma("unroll") for (int q_ = 0; q_ < 8; ++q_) s_ += y_[q_]; s_ = octsum(s_); const float mean_ = s_ * (1.0f / 64.0f); \
            float qq_ = 0.f; _Pragma("unroll") for (int q_ = 0; q_ < 8; ++q_) { const float d_ = y_[q_] - mean_; qq_ += d_ * d_; } qq_ = octsum(qq_); const float rstd_ = 1.0f / sqrtf(qq_ * (1.0f / 64.0f) + GN_EPS); \
            float o8_[8]; _Pragma("unroll") for (int q_ = 0; q_ < 8; ++q_) o8_[q_] = (((y_[q_] - mean_) * rstd_) * gng[q_] + gnb[q_] + bs_ * v_[q_]) * g_[q_]; \
            u32x4 w_; w_.x = pk2(o8_[0], o8_[1]); w_.y = pk2(o8_[2], o8_[3]); w_.z = pk2(o8_[4], o8_[5]); w_.w = pk2(o8_[6], o8_[7]); __builtin_nontemporal_store(w_, (u32x4*)(OG + tr_ * 1024 + h * 64 + ch_)); } LBAR(); } } while (0)
        Ops A, B, C;
        SEQ_LOAD(A, 0); SEQ_LOAD(B, 1);
#pragma unroll 1
        for (int c = 0; c < 63; c += 3) {
            SEQ_LOAD(C, c + 2); SEQ_STEP(A, c);
            SEQ_LOAD(A, c + 3); SEQ_STEP(B, c + 1);
            if (c + 4 < 64) SEQ_LOAD(B, c + 4);
            SEQ_STEP(C, c + 2);
        }
        SEQ_STEP(A, 63);
#undef SEQ_LOAD
#undef SEQ_STEP
    }
}

__device__ __forceinline__ void ld16(const bf16_t* p, float (&o)[16]) {
    const u32x4 a = *(const u32x4*)p, b = *(const u32x4*)(p + 8);
    o[0] = lo16(a.x); o[1] = hi16(a.x); o[2] = lo16(a.y); o[3] = hi16(a.y); o[4] = lo16(a.z); o[5] = hi16(a.z); o[6] = lo16(a.w); o[7] = hi16(a.w);
    o[8] = lo16(b.x); o[9] = hi16(b.x); o[10] = lo16(b.y); o[11] = hi16(b.y); o[12] = lo16(b.z); o[13] = hi16(b.z); o[14] = lo16(b.w); o[15] = hi16(b.w);
}
__device__ __forceinline__ void st16(bf16_t* p, const float (&o)[16]) {
    u32x4 a, b; a.x = pk2(o[0], o[1]); a.y = pk2(o[2], o[3]); a.z = pk2(o[4], o[5]); a.w = pk2(o[6], o[7]); b.x = pk2(o[8], o[9]); b.y = pk2(o[10], o[11]); b.z = pk2(o[12], o[13]); b.w = pk2(o[14], o[15]);
    *(u32x4*)p = a; *(u32x4*)(p + 8) = b;
}
__device__ __forceinline__ void ld16f(const float* p, float (&o)[16]) {
#pragma unroll
    for (int j = 0; j < 4; ++j) { const f32x4 v = *(const f32x4*)(p + 4 * j); o[4 * j] = v[0]; o[4 * j + 1] = v[1]; o[4 * j + 2] = v[2]; o[4 * j + 3] = v[3]; }
}
__device__ __forceinline__ void wkv_post(Frame& F, int l) {
    const InTab in = F.in;
    const bf16_t* RKV = (const bf16_t*)(F.ws + WS_RA); const bf16_t* G16 = (const bf16_t*)(F.ws + WS_RA + 224 * MiB); const float* BON = (const float*)(F.ws + WS_LF);
    const bf16_t* YS = (const bf16_t*)(F.ws + WS_Y16); bf16_t* OG = (bf16_t*)(F.ws + WS_H2);
    const int c0 = 16 * F.lane;
    float gg[16], gb[16];
    ld16f(in[I_GNG] + l * 1024 + c0, gg); ld16f(in[I_GNB] + l * 1024 + c0, gb);
    const int gw = F.bid * NWAVES + F.wave, NGW = F.G * NWAVES;
    for (int t = gw; t < T; t += NGW) {
        float y[16], v[16], g[16];
        ld16(YS + (size_t)t * 1024 + c0, y); ld16(RKV + (size_t)t * 3072 + 2048 + c0, v); ld16(G16 + (size_t)t * 1024 + c0, g);
        const float bs = BON[(size_t)t * 16 + (F.lane >> 2)];
        float s = 0.f;
#pragma unroll
        for (int i = 0; i < 16; ++i) s += y[i];
        s = quadsum(s);
        const float mean = s * (1.0f / 64.0f); float q = 0.f;
#pragma unroll
        for (int i = 0; i < 16; ++i) { const float d = y[i] - mean; q += d * d; }
        q = quadsum(q);
        const float rstd = 1.0f / sqrtf(q * (1.0f / 64.0f) + GN_EPS);
        float o[16];
#pragma unroll
        for (int i = 0; i < 16; ++i) o[i] = (((y[i] - mean) * rstd) * gg[i] + gb[i] + bs * v[i]) * g[i];
        st16(OG + (size_t)t * 1024 + c0, o);
    }
}

__device__ __forceinline__ void kv_post(Frame& F) {
    const InTab in = F.in;
    bf16_t* Kb = (bf16_t*)(F.ws + WS_P); const float* LF = (const float*)(F.ws + WS_LF); float* KBv = (float*)(F.ws + WS_KB);
    const int c0 = 16 * F.lane;
    float kn[16]; ld16f(in[I_KNORM] + (c0 & 63), kn);
    const int gw = F.bid * NWAVES + F.wave, NGW = F.G * NWAVES;
    for (int t = gw; t < T; t += NGW) {
        float k[16]; ld16(Kb + (size_t)t * 1024 + c0, k);
        float s = 0.f;
#pragma unroll
        for (int i = 0; i < 16; ++i) s += k[i] * k[i];
        s = quadsum(s);
        const float rs = 1.0f / sqrtf(s * (1.0f / 64.0f) + QK_EPS);
#pragma unroll
        for (int i = 0; i < 16; ++i) k[i] = k[i] * rs * kn[i];
        st16(Kb + (size_t)t * 1024 + c0, k);
    }
    for (int bh = gw; bh < 128; bh += NGW) {
        const int b = bh >> 4, h = bh & 15; const size_t base = ((size_t)b * SEQ + 64 * F.lane) * 16 + h;
        float s = 0.f;
        for (int i = 0; i < 64; ++i) s += LF[base + (size_t)i * 16];
        float incl = s;
#pragma unroll
        for (int o = 1; o < 64; o <<= 1) { const float n = __shfl_up(incl, o); if (F.lane >= o) incl += n; }
        float run = incl - s;
        float kfirst = 0.f, klast = 0.f;
        for (int i = 0; i < 64; ++i) { run += LF[base + (size_t)i * 16]; const float kbv = -run * LOG2E; KBv[(size_t)bh * SEQ + 64 * F.lane + i] = kbv; if (i == 0) kfirst = kbv; klast = kbv; }
        int* T0 = (int*)(F.ws + WS_T0) + bh * 16;
        for (int qb = 0; qb < 16; ++qb) {
            const float thr = __shfl(kfirst, 4 * qb) - 70.0f;
            const unsigned long long skip = __ballot(klast < thr);
            int t0 = (skip == ~0ull) ? 64 : __builtin_ctzll(~skip); const int nt = 4 * qb + 4;
            t0 &= ~1; if (t0 > nt - 4) t0 = nt - 4;
            if (F.lane == 0) T0[qb] = t0;
        }
    }
}

namespace attn_body {
using bf16=__hip_bfloat16;
using bf16x8=__attribute__((ext_vector_type(8)))short;
using s16x4=__attribute__((ext_vector_type(4)))short;
using f32x16=__attribute__((ext_vector_type(16)))float;
using u32x4=__attribute__((ext_vector_type(4)))unsigned;
constexpr int BATCH=8,NHEAD=16,SEQ=4096,D=64,DM=NHEAD*D;
constexpr int NW=8,QBLK=32,QB=QBLK*NW,KVBLK=64,NQB=SEQ/QB;
constexpr int ATTN_PITCH=DM, ATTN_UNIT_ROWS=QB;
__device__ __forceinline__ int crow(int r,int hi){return (r&3)+8*(r>>2)+4*hi;}
#define SBAR() __builtin_amdgcn_sched_barrier(0)
__device__ __forceinline__ void cmask(f32x16&p0,f32x16&p1,int jb,int qrel,int hi){
  const float NEG=-INFINITY; int kb=64*jb+4*hi;
  #pragma unroll
  for(int r=0;r<16;++r){int kv=kb+(r&3)+8*(r>>2); if(kv>qrel)p0[r]=NEG; if(kv+32>qrel)p1[r]=NEG;}
}

constexpr int NSLOT=3, SLOTB=8192;
constexpr int LDS_K=0, LDS_V=NSLOT*SLOTB, LDS_WS=2*NSLOT*SLOTB, LDS_OST=LDS_WS+NW*64*4, LDS_KBIAS=LDS_OST+NW*4096, LDS_BYTES=LDS_KBIAS+SEQ*4;
constexpr float C2=0.125f*1.4426950408889634f;
__device__ __forceinline__ void glds16(const void*gsrc,unsigned lds_dst){unsigned keep;
  asm volatile("s_mov_b32 %0, m0\n\ts_mov_b32 m0, %2\n\ts_nop 0\n\tglobal_load_lds_dwordx4 %1, off\n\ts_mov_b32 m0, %0":"=&s"(keep):"v"(gsrc),"s"(lds_dst):"memory");}
__device__ __forceinline__ float max3f(float a,float b,float c){float r;asm("v_max3_f32 %0, %1, %2, %3":"=v"(r):"v"(a),"v"(b),"v"(c));return r;}
__device__ __forceinline__ float max2f(float a,float b){float r;asm("v_max_f32_e32 %0, %1, %2":"=v"(r):"v"(a),"v"(b));return r;}
__device__ __forceinline__ float fadd_s(float a,float b){float r;asm("v_add_f32_e32 %0, %1, %2":"=v"(r):"v"(a),"v"(b));return r;}
__device__ __forceinline__ float fsub_s(float a,float b){float r;asm("v_sub_f32_e32 %0, %1, %2":"=v"(r):"v"(a),"v"(b));return r;}
typedef float f32x2_t __attribute__((ext_vector_type(2))); typedef __bf16 bf16x2_t __attribute__((ext_vector_type(2)));
__device__ __forceinline__ unsigned cvtpk_s(float lo,float hi){f32x2_t v={lo,hi};bf16x2_t b=__builtin_convertvector(v,bf16x2_t);return __builtin_bit_cast(unsigned,b);}
#define WAIT_BAR(N) asm volatile("s_waitcnt vmcnt(" #N ") lgkmcnt(0)\n\ts_barrier":::"memory")

__device__ __forceinline__ void qkt(f32x16&p0,f32x16&p1,const char*Kslot,const bf16x8*qr,const f32x16&negm,int r32,int hi){
  const char*kb=Kslot+hi*1024+r32*16;
  #pragma unroll
  for(int d0=0;d0<4;++d0){
    const bf16x8 b0=*reinterpret_cast<const bf16x8*>(kb+d0*2048);
    const bf16x8 b1=*reinterpret_cast<const bf16x8*>(kb+d0*2048+512);
    if(d0==0){p0=__builtin_amdgcn_mfma_f32_32x32x16_bf16(b0,qr[0],negm,0,0,0);p1=__builtin_amdgcn_mfma_f32_32x32x16_bf16(b1,qr[0],negm,0,0,0);}
    else{p0=__builtin_amdgcn_mfma_f32_32x32x16_bf16(b0,qr[d0],p0,0,0,0);p1=__builtin_amdgcn_mfma_f32_32x32x16_bf16(b1,qr[d0],p1,0,0,0);}}
}
typedef __attribute__((address_space(3))) const char* lds_cptr;
typedef short v4i16_t __attribute__((ext_vector_type(4)));
__device__ __forceinline__ void kload8(bf16x8*kf,lds_cptr kp){
  kf[0]=*(const __attribute__((address_space(3))) bf16x8*)(kp);      kf[1]=*(const __attribute__((address_space(3))) bf16x8*)(kp+512);
  kf[2]=*(const __attribute__((address_space(3))) bf16x8*)(kp+2048); kf[3]=*(const __attribute__((address_space(3))) bf16x8*)(kp+2560);
  kf[4]=*(const __attribute__((address_space(3))) bf16x8*)(kp+4096); kf[5]=*(const __attribute__((address_space(3))) bf16x8*)(kp+4608);
  kf[6]=*(const __attribute__((address_space(3))) bf16x8*)(kp+6144); kf[7]=*(const __attribute__((address_space(3))) bf16x8*)(kp+6656);
}
__device__ __forceinline__ void kload2(bf16x8*kf,lds_cptr kp,int j){ kf[2*j]=*(const __attribute__((address_space(3))) bf16x8*)(kp+j*2048); kf[2*j+1]=*(const __attribute__((address_space(3))) bf16x8*)(kp+j*2048+512); }
__device__ __forceinline__ s16x4 vtr(lds_cptr p){ return __builtin_bit_cast(s16x4,__builtin_amdgcn_ds_read_tr16_b64_v4i16((__attribute__((address_space(3))) v4i16_t*)p)); }
__device__ __forceinline__ float rowmax(const f32x16&p0,const f32x16&p1){
  float a=max3f(p0[0],p0[1],p1[0]),b=max3f(p0[2],p0[3],p1[1]);a=max3f(a,p1[2],p1[3]);
  #pragma unroll
  for(int r=4;r<16;r+=4){a=max3f(a,p0[r],p0[r+1]);b=max3f(b,p0[r+2],p0[r+3]);a=max3f(a,p1[r],p1[r+1]);b=max3f(b,p1[r+2],p1[r+3]);}
  const float m=max2f(a,b);
  auto rr=__builtin_amdgcn_permlane32_swap(__float_as_uint(m),__float_as_uint(m),false,false);
  return max2f(__uint_as_float(rr[0]),__uint_as_float(rr[1]));
}
__device__ __forceinline__ void pv(f32x16*o,int vb,bf16x8 pa0,bf16x8 pa1,bf16x8 pa2,bf16x8 pa3){
  #pragma unroll
  for(int d0=0;d0<2;++d0){s16x4 lo[4],hi[4];
    #pragma unroll
    for(int ks=0;ks<4;++ks){
      asm volatile("ds_read_b64_tr_b16 %0,%1 offset:%c2":"=&v"(lo[ks]):"v"(vb),"i"(d0*4096+ks*1024):"memory");
      asm volatile("ds_read_b64_tr_b16 %0,%1 offset:%c2":"=&v"(hi[ks]):"v"(vb),"i"(d0*4096+ks*1024+512):"memory");}
    asm volatile("s_waitcnt lgkmcnt(0)":::"memory");SBAR();
    #define PK(k) (bf16x8){lo[k][0],lo[k][1],lo[k][2],lo[k][3],hi[k][0],hi[k][1],hi[k][2],hi[k][3]}
    o[d0]=__builtin_amdgcn_mfma_f32_32x32x16_bf16(pa0,PK(0),o[d0],0,0,0);
    o[d0]=__builtin_amdgcn_mfma_f32_32x32x16_bf16(pa1,PK(1),o[d0],0,0,0);
    o[d0]=__builtin_amdgcn_mfma_f32_32x32x16_bf16(pa2,PK(2),o[d0],0,0,0);
    o[d0]=__builtin_amdgcn_mfma_f32_32x32x16_bf16(pa3,PK(3),o[d0],0,0,0);
    #undef PK
  }
}

#ifndef ATTN_STORE16
#define ATTN_STORE16(p,v) (*(u32x4*)(p)=(v))
#endif
template<int THRL> __device__ __forceinline__ void attn_unit(int tid,int wid,int b,int h,int qb,int t0,const bf16*Q,const bf16*__restrict__ K,const bf16*__restrict__ V,bf16*O,const bf16*G,const float*kbrow,const float*qnorm,char*shm){
  int lane=tid&63; asm volatile("":"+v"(lane));
  const int r32=lane&31,hi=lane>>5; wid=__builtin_amdgcn_readfirstlane(wid);
  const long rowbase=(long)b*SEQ; const int q0=qb*QB;
  const bf16*Qw=Q+(rowbase+q0+wid*QBLK)*DM+h*D;
  const bf16*Kh=K+(rowbase+(long)t0*KVBLK)*DM+h*D,*Vh=V+(rowbase+(long)t0*KVBLK)*DM+h*D; kbrow+=t0*KVBLK;
  const unsigned lds0=(unsigned)(uintptr_t)shm;
  float*wsf=(float*)(shm+LDS_WS)+wid*64;
  const bf16*ksrc=Kh+(long)lane*DM+wid*8;
  const bf16*vsrc=Vh+(long)(16*(wid&3)+(lane>>2))*DM+(wid>>2)*32+(lane&3)*8;
  const unsigned kdst=lds0+LDS_K+wid*1024, vdst=lds0+LDS_V+wid*1024;
  #define DMA_K(t,slot) glds16(ksrc+(long)(t)*KVBLK*DM,(unsigned)__builtin_amdgcn_readfirstlane(kdst+(slot)))
  #define DMA_V(t,slot) glds16(vsrc+(long)(t)*KVBLK*DM,(unsigned)__builtin_amdgcn_readfirstlane(vdst+(slot)))
  const int vb0=(int)(lds0+LDS_V)+((lane>>4)&1)*32+(lane&3)*8+(4*hi+((lane&15)>>2))*64;
  const char*Kbase=shm+LDS_K; bf16x8 kf[8];
  const lds_cptr shm3=(lds_cptr)shm; const lds_cptr kp0=shm3+LDS_K+hi*1024+r32*16; const lds_cptr vp0=shm3+LDS_V+((lane>>4)&1)*32+(lane&3)*8+(4*hi+((lane&15)>>2))*64;
  const int NT=(q0+QB)/KVBLK-t0;
  typedef float f32x4_t __attribute__((ext_vector_type(4))); typedef __attribute__((address_space(3))) const float* lds_fptr;
  const lds_fptr kbl=(lds_fptr)(shm3+LDS_KBIAS);
  { __attribute__((address_space(3))) f32x4_t* kw=(__attribute__((address_space(3))) f32x4_t*)(shm3+LDS_KBIAS); const f32x4_t* kg=(const f32x4_t*)kbrow;
    for(int i=tid;i<NT*KVBLK/4;i+=NW*64) kw[i]=kg[i]; }
  DMA_K(0,0);DMA_V(0,0);DMA_K(1,SLOTB);
  bf16x8 qr[4];
  #pragma unroll
  for(int d0=0;d0<4;++d0)qr[d0]=*reinterpret_cast<const bf16x8*>(&Qw[(long)r32*DM+d0*16+hi*8]);
  { float qf[4][8]; float ss=0.f;
    #pragma unroll
    for(int d0=0;d0<4;++d0){
      #pragma unroll
      for(int j=0;j<8;++j){ qf[d0][j]=__uint_as_float(((unsigned)(unsigned short)qr[d0][j])<<16); ss+=qf[d0][j]*qf[d0][j]; } }
    { auto rr=__builtin_amdgcn_permlane32_swap(__float_as_uint(ss),__float_as_uint(ss),false,false); ss=__uint_as_float(rr[0])+__uint_as_float(rr[1]); }
    const float qs=C2/sqrtf(ss*(1.0f/64.0f)+1e-6f);
    #pragma unroll
    for(int d0=0;d0<4;++d0){ const float*qn=qnorm+d0*16+hi*8; u32x4 w;
      w[0]=cvtpk_s(qf[d0][0]*qs*qn[0],qf[d0][1]*qs*qn[1]); w[1]=cvtpk_s(qf[d0][2]*qs*qn[2],qf[d0][3]*qs*qn[3]); w[2]=cvtpk_s(qf[d0][4]*qs*qn[4],qf[d0][5]*qs*qn[5]); w[3]=cvtpk_s(qf[d0][6]*qs*qn[6],qf[d0][7]*qs*qn[7]);
      qr[d0]=__builtin_bit_cast(bf16x8,w); } }
  float mhat=0.f,l_reg=0.f;f32x16 o[2];o[0]=f32x16{};o[1]=f32x16{};const f32x16 negm=f32x16{};
  const int qrel=wid*QBLK+r32;
  #define CMASK(P0,P1,t) do{int jb_=(t)-(NT-4); if(jb_>=0)cmask(P0,P1,jb_,qrel,hi);}while(0)
  #define KBIAS(P0,P1,t) do{ const lds_fptr kp_=kbl+64*(t)+4*hi; \
    _Pragma("unroll") for(int g_=0;g_<4;++g_){ const f32x4_t a_=*(const __attribute__((address_space(3))) f32x4_t*)(kp_+8*g_)-mhat, b_=*(const __attribute__((address_space(3))) f32x4_t*)(kp_+32+8*g_)-mhat; \
      _Pragma("unroll") for(int j_=0;j_<4;++j_){ P0[4*g_+j_]+=a_[j_]; P1[4*g_+j_]+=b_[j_]; } } }while(0)
  bool resc=false;
  #define START(P0,P1) do{ const float rm=rowmax(P0,P1); resc=false; \
    { const float dl=rm; mhat=fadd_s(mhat,dl); \
      _Pragma("unroll") for(int r=0;r<16;++r){P0[r]=fsub_s(P0[r],dl);P1[r]=fsub_s(P1[r],dl);} } \
    _Pragma("unroll") for(int r=0;r<16;++r)P0[r]=__builtin_amdgcn_exp2f(P0[r]); }while(0)
  #define RESC() do{ if(resc){ asm volatile("s_waitcnt lgkmcnt(0)":::"memory"); \
      _Pragma("unroll") for(int d_=0;d_<2;++d_) _Pragma("unroll") for(int r=0;r<16;++r)o[d_][r]*=wsf[crow(r,hi)]; } }while(0)
  f32x16 pA0,pA1,pB0,pB1;
  int sl_prev=0,sl_cur=0,sl_next=SLOTB;
  #define ROT() do{sl_prev=sl_cur;sl_cur=sl_next;sl_next=(sl_next==(NSLOT-1)*SLOTB)?0:sl_next+SLOTB;}while(0)
  DMA_K(2,2*SLOTB);
  WAIT_BAR(3);
  qkt(pA0,pA1,Kbase,qr,negm,r32,hi);asm volatile("s_nop 15\n\ts_nop 7":"+v"(pA0),"+v"(pA1));KBIAS(pA0,pA1,0);CMASK(pA0,pA1,0);
  START(pA0,pA1);
  _Pragma("unroll") for(int r=0;r<16;++r)pA1[r]=__builtin_amdgcn_exp2f(pA1[r]);
  WAIT_BAR(0);
  DMA_K(3,0);DMA_V(1,SLOTB);
  ROT();
  kload8(kf,kp0+sl_cur);
  WAIT_BAR(2);
  s16x4 vlo[8],vhi[8]; u32x4 pw0,pw1,pw2,pw3;
  #define PKW(P,B) cvtpk_s(P[B],P[B+1])
  #define PAF(k) __builtin_bit_cast(bf16x8,pw##k)
  #define VFR(i) (bf16x8){vlo[i][0],vlo[i][1],vlo[i][2],vlo[i][3],vhi[i][0],vhi[i][1],vhi[i][2],vhi[i][3]}
  #define PIN(x) asm volatile("":"+v"(x))
  #define MX3(a,b,c) __builtin_fmaxf(__builtin_fmaxf((a),(b)),(c))
  #define GAPA(MF,A0,A1,A2,A3,W0,W1,PW) do{ MF; sacc+=A0; sacc+=A1; sacc+=A2; sacc+=A3; PIN(sacc); W0; W1; PIN(PW); SBAR(); }while(0)
  #define EX(v) __builtin_amdgcn_exp2f(v)
  #define GAPB(MF,X,B) do{ MF; X[B]=EX(X[B]); X[B+1]=EX(X[B+1]); X[B+2]=EX(X[B+2]); X[B+3]=EX(X[B+3]); PIN(X); SBAR(); }while(0)
  #define VRD(i) do{ vlo[i]=vtr(vp_+(((i)>>2)*4096+((i)&3)*1024)); vhi[i]=vtr(vp_+(((i)>>2)*4096+((i)&3)*1024+512)); }while(0)
  #define KRD(G,j) do{ if(G){ kload2(kf,kp0+sl_next,j); SBAR(); } }while(0)
  #define STEP(C0,C1,P0,P1,t,GK,GV,GL) do{ SBAR(); \
    const lds_cptr vp_=vp0+sl_prev; \
    VRD(0); SBAR(); float sacc=(P0[0]+P0[1]); \
    GAPA(C0=__builtin_amdgcn_mfma_f32_32x32x16_bf16(kf[0],qr[0],negm,0,0,0), P0[2],P0[3],P0[4],P0[5],     pw0[0]=PKW(P0,0), pw0[1]=PKW(P0,2), pw0); \
    VRD(4); SBAR(); GAPA(C1=__builtin_amdgcn_mfma_f32_32x32x16_bf16(kf[1],qr[0],negm,0,0,0), P0[6],P0[7],P0[8],P0[9],     pw0[2]=PKW(P0,4), pw0[3]=PKW(P0,6), pw0); \
    VRD(1); SBAR(); GAPA(C0=__builtin_amdgcn_mfma_f32_32x32x16_bf16(kf[2],qr[1],C0,0,0,0),   P0[10],P0[11],P0[12],P0[13], pw1[0]=PKW(P0,8), pw1[1]=PKW(P0,10), pw1); \
    VRD(5); SBAR(); GAPA(C1=__builtin_amdgcn_mfma_f32_32x32x16_bf16(kf[3],qr[1],C1,0,0,0),   P0[14],P0[15],P1[0],P1[1],   pw1[2]=PKW(P0,12),pw1[3]=PKW(P0,14), pw1); \
    VRD(2); SBAR(); GAPA(C0=__builtin_amdgcn_mfma_f32_32x32x16_bf16(kf[4],qr[2],C0,0,0,0),   P1[2],P1[3],P1[4],P1[5],     pw2[0]=PKW(P1,0), pw2[1]=PKW(P1,2), pw2); \
    VRD(6); SBAR(); GAPA(C1=__builtin_amdgcn_mfma_f32_32x32x16_bf16(kf[5],qr[2],C1,0,0,0),   P1[6],P1[7],P1[8],P1[9],     pw2[2]=PKW(P1,4), pw2[3]=PKW(P1,6), pw2); \
    VRD(3); SBAR(); GAPA(C0=__builtin_amdgcn_mfma_f32_32x32x16_bf16(kf[6],qr[3],C0,0,0,0),   P1[10],P1[11],P1[12],P1[13], pw3[0]=PKW(P1,8), pw3[1]=PKW(P1,10), pw3); \
    VRD(7); SBAR(); GAPA(C1=__builtin_amdgcn_mfma_f32_32x32x16_bf16(kf[7],qr[3],C1,0,0,0),   P1[14],P1[15],0.f,0.f,       pw3[2]=PKW(P1,12),pw3[3]=PKW(P1,14), pw3); \
    l_reg+=sacc; \
    if(GK){DMA_K((t)+3,sl_cur);} if(GV){DMA_V((t)+1,sl_next);} \
    KBIAS(C0,C1,t); CMASK(C0,C1,t); \
    { float a=MX3(C0[0],C0[1],C1[0]),b=MX3(C0[2],C0[3],C1[1]); a=MX3(a,C1[2],C1[3]); \
      _Pragma("unroll") for(int r=4;r<16;r+=4){a=MX3(a,C0[r],C0[r+1]);b=MX3(b,C0[r+2],C0[r+3]);a=MX3(a,C1[r],C1[r+1]);b=MX3(b,C1[r+2],C1[r+3]);} \
      float rm=__builtin_fmaxf(a,b); { auto rr=__builtin_amdgcn_permlane32_swap(__float_as_uint(rm),__float_as_uint(rm),false,false); rm=__builtin_fmaxf(__uint_as_float(rr[0]),__uint_as_float(rr[1])); } \
      resc=false; \
      if(__builtin_expect(__any(rm>(float)THRL),0)){ const float dl=__builtin_fmaxf(rm,0.f); mhat+=dl; \
        _Pragma("unroll") for(int r=0;r<16;++r){C0[r]-=dl;C1[r]-=dl;} \
        const float f=__builtin_amdgcn_exp2f(-dl); l_reg*=f; if(hi==0)wsf[r32]=f; resc=true; } } \
    SBAR(); \
    GAPB(o[0]=__builtin_amdgcn_mfma_f32_32x32x16_bf16(PAF(0),VFR(0),o[0],0,0,0), C0,0); \
    GAPB(o[1]=__builtin_amdgcn_mfma_f32_32x32x16_bf16(PAF(0),VFR(4),o[1],0,0,0), C0,4); \
    KRD(GL,0); GAPB(o[0]=__builtin_amdgcn_mfma_f32_32x32x16_bf16(PAF(1),VFR(1),o[0],0,0,0), C0,8); \
    KRD(GL,1); GAPB(o[1]=__builtin_amdgcn_mfma_f32_32x32x16_bf16(PAF(1),VFR(5),o[1],0,0,0), C0,12); \
    KRD(GL,2); GAPB(o[0]=__builtin_amdgcn_mfma_f32_32x32x16_bf16(PAF(2),VFR(2),o[0],0,0,0), C1,0); \
    KRD(GL,3); GAPB(o[1]=__builtin_amdgcn_mfma_f32_32x32x16_bf16(PAF(2),VFR(6),o[1],0,0,0), C1,4); \
    GAPB(o[0]=__builtin_amdgcn_mfma_f32_32x32x16_bf16(PAF(3),VFR(3),o[0],0,0,0), C1,8); \
    GAPB(o[1]=__builtin_amdgcn_mfma_f32_32x32x16_bf16(PAF(3),VFR(7),o[1],0,0,0), C1,12); \
    }while(0)
  int t=1;
  #undef CMASK
  #define CMASK(P0,P1,t) do{}while(0)
  for(;t+5<NT;t+=2){
    STEP(pB0,pB1,pA0,pA1,t,true,true,true);     WAIT_BAR(2); RESC(); ROT();
    STEP(pA0,pA1,pB0,pB1,t+1,true,true,true);   WAIT_BAR(2); RESC(); ROT();
  }
  #undef CMASK
  #define CMASK(P0,P1,t) do{int jb_=(t)-(NT-4); if(jb_>=0)cmask(P0,P1,jb_,qrel,hi);}while(0)
  #define ENDW(tt) do{ if((tt)+3<NT){WAIT_BAR(2);} else if((tt)+2<NT){WAIT_BAR(1);} else {WAIT_BAR(0);} }while(0)
  for(;t+1<NT;t+=2){
    STEP(pB0,pB1,pA0,pA1,t,(t+3<NT),(t+1<NT),(t+1<NT));       ENDW(t);   RESC(); ROT();
    STEP(pA0,pA1,pB0,pB1,t+1,(t+4<NT),(t+2<NT),(t+2<NT));     ENDW(t+1); RESC(); ROT();
  }
  STEP(pB0,pB1,pA0,pA1,NT-1,false,false,false); RESC();
  { float sacc=pB0[0]+pB0[1]; _Pragma("unroll") for(int r=2;r<16;++r)sacc+=pB0[r]; _Pragma("unroll") for(int r=0;r<16;++r)sacc+=pB1[r]; l_reg+=sacc;
    pw0=(u32x4){PKW(pB0,0),PKW(pB0,2),PKW(pB0,4),PKW(pB0,6)};pw1=(u32x4){PKW(pB0,8),PKW(pB0,10),PKW(pB0,12),PKW(pB0,14)};pw2=(u32x4){PKW(pB1,0),PKW(pB1,2),PKW(pB1,4),PKW(pB1,6)};pw3=(u32x4){PKW(pB1,8),PKW(pB1,10),PKW(pB1,12),PKW(pB1,14)};
    SBAR(); pv(o,vb0+sl_cur,PAF(0),PAF(1),PAF(2),PAF(3)); }
  #undef PKW
  #undef PAF
  #undef VFR
  #undef PIN
  #undef MX3
  #undef GAPA
  #undef GAPB
  #undef EX
  #undef VRD
  #undef KRD
  #undef STEP
  #undef ENDW
  {auto rr=__builtin_amdgcn_permlane32_swap(__float_as_uint(l_reg),__float_as_uint(l_reg),false,false);l_reg=__uint_as_float(rr[0])+__uint_as_float(rr[1]);}
  if(hi==0)wsf[32+r32]=l_reg;asm volatile("s_waitcnt lgkmcnt(0)":::"memory");
  float rli[16];
  #pragma unroll
  for(int r=0;r<16;++r)rli[r]=__builtin_amdgcn_rcpf(wsf[32+crow(r,hi)]);
  bf16*Ow=O+(rowbase+q0+wid*QBLK)*DM+h*D;
  { bf16*stg=(bf16*)(shm+LDS_OST)+wid*2048;
    #pragma unroll
    for(int r=0;r<16;++r){const int orow=crow(r,hi);
      #pragma unroll
      for(int d0=0;d0<2;++d0)stg[orow*64+d0*32+r32]=__float2bfloat16(o[d0][r]*rli[r]);}
    asm volatile("s_waitcnt lgkmcnt(0)":::"memory");
    const bf16*Gw=G+(rowbase+q0+wid*QBLK)*DM+h*D;
    #pragma unroll
    for(int i=0;i<4;++i){const int row=i*8+(lane>>3),ch=lane&7; u32x4 v=*(const u32x4*)(stg+row*64+ch*8); const u32x4 g=*(const u32x4*)(Gw+(long)row*DM+ch*8);
      #pragma unroll
      for(int q=0;q<4;++q) v[q]=cvtpk_s(__uint_as_float(v[q]<<16)*__uint_as_float(g[q]<<16),__uint_as_float(v[q]&0xffff0000u)*__uint_as_float(g[q]&0xffff0000u));
      ATTN_STORE16(Ow+(long)row*DM+ch*8,v);} }
  asm volatile("s_waitcnt lgkmcnt(0)\n\ts_barrier":::"memory");
  #undef DMA_K
  #undef DMA_V
  #undef CMASK
  #undef KBIAS
  #undef START
  #undef RESC
  #undef ROT
}
constexpr int ATTN_LDS_BYTES=LDS_BYTES;
struct AttnTensors { const bf16* Q; const bf16* K; const bf16* V; bf16* O; const bf16* G; const float* KB; const float* qnorm; };
template<int THRL=8> __device__ __forceinline__ void attn_phase(int tid,int wid,unsigned*ctr,const int*t0tab,volatile __attribute__((address_space(3))) int*bc,char*lds,const AttnTensors&T){
  for(;;){
    if(tid==0){ const int n_=(int)__hip_atomic_fetch_add(ctr,1u,__ATOMIC_RELAXED,__HIP_MEMORY_SCOPE_AGENT); bc[0]=n_; }
    asm volatile("s_waitcnt vmcnt(0) lgkmcnt(0)\n\ts_barrier":::"memory");
    const int n=__builtin_amdgcn_readfirstlane(bc[0]);
    if(n>=BATCH*NHEAD*NQB) break;
    const int qb=NQB-1-(n>>7), bh=n&127;
    const int t0=__builtin_amdgcn_readfirstlane(t0tab[bh*16+qb]);
    attn_unit<THRL>(tid,wid,bh/NHEAD,bh%NHEAD,qb,t0,T.Q,T.K,T.V,T.O,T.G,T.KB+(long)bh*SEQ,T.qnorm,lds);
  }
}
#undef SBAR
#undef WAIT_BAR
}
__device__ __forceinline__ void attn_simple(Frame& F, int j) {
    const InTab in = F.in;
    const bf16_t* Q = (const bf16_t*)(F.ws + WS_RA); const bf16_t* Gt = (const bf16_t*)(F.ws + WS_RA + 64 * MiB);
    const bf16_t* Kb = (const bf16_t*)(F.ws + WS_P); const bf16_t* Vb = (const bf16_t*)(F.ws + WS_P + 64 * MiB);
    const float* KBv = (const float*)(F.ws + WS_KB); bf16_t* OG = (bf16_t*)(F.ws + WS_H2 + 64 * MiB);
    const float* qn = in[I_QNORM] + j * 64;
    for (int item = F.bid; item < 1024; item += F.G) {
        const int bh = item >> 3, qb = item & 7, b = bh >> 4, h = bh & 15, t = qb * 512 + F.tid;
        const size_t row = (size_t)b * SEQ + t;
        float q[64];
        { const bf16_t* qp = Q + row * 1024 + h * 64; float ss = 0.f;
#pragma unroll
          for (int i = 0; i < 8; ++i) { const u32x4 w = *(const u32x4*)(qp + 8 * i);
              q[8 * i] = lo16(w.x); q[8 * i + 1] = hi16(w.x); q[8 * i + 2] = lo16(w.y); q[8 * i + 3] = hi16(w.y); q[8 * i + 4] = lo16(w.z); q[8 * i + 5] = hi16(w.z); q[8 * i + 6] = lo16(w.w); q[8 * i + 7] = hi16(w.w); }
#pragma unroll
          for (int i = 0; i < 64; ++i) ss += q[i] * q[i];
          const float rs = QC2 / sqrtf(ss * (1.0f / 64.0f) + QK_EPS);
#pragma unroll
          for (int i = 0; i < 64; ++i) q[i] = q[i] * rs * qn[i]; }
        float o[64];
#pragma unroll
        for (int i = 0; i < 64; ++i) o[i] = 0.f;
        float m = -1.0e30f, lsum = 0.f;
        const int smax = qb * 512 + F.wave * 64 + 63;
        const bf16_t* kp = Kb + ((size_t)b * SEQ) * 1024 + h * 64; const bf16_t* vp = Vb + ((size_t)b * SEQ) * 1024 + h * 64;
        const float* kbp = KBv + (size_t)bh * SEQ;
        for (int s = 0; s <= smax; ++s) {
            float dot = 0.f;
#pragma unroll
            for (int i = 0; i < 8; ++i) { const u32x4 w = *(const u32x4*)(kp + (size_t)s * 1024 + 8 * i);
                dot += q[8 * i] * lo16(w.x) + q[8 * i + 1] * hi16(w.x) + q[8 * i + 2] * lo16(w.y) + q[8 * i + 3] * hi16(w.y) + q[8 * i + 4] * lo16(w.z) + q[8 * i + 5] * hi16(w.z) + q[8 * i + 6] * lo16(w.w) + q[8 * i + 7] * hi16(w.w); }
            float x = dot + kbp[s];
            if (s > t) x = -1.0e30f;
            const float mn = fmaxf(m, x), corr = exp2f(m - mn), p = (s > t) ? 0.f : exp2f(x - mn);
            m = mn; lsum = lsum * corr + p;
#pragma unroll
            for (int i = 0; i < 8; ++i) { const u32x4 w = *(const u32x4*)(vp + (size_t)s * 1024 + 8 * i);
                o[8 * i] = o[8 * i] * corr + p * lo16(w.x); o[8 * i + 1] = o[8 * i + 1] * corr + p * hi16(w.x); o[8 * i + 2] = o[8 * i + 2] * corr + p * lo16(w.y); o[8 * i + 3] = o[8 * i + 3] * corr + p * hi16(w.y);
                o[8 * i + 4] = o[8 * i + 4] * corr + p * lo16(w.z); o[8 * i + 5] = o[8 * i + 5] * corr + p * hi16(w.z); o[8 * i + 6] = o[8 * i + 6] * corr + p * lo16(w.w); o[8 * i + 7] = o[8 * i + 7] * corr + p * hi16(w.w); }
        }
        const float il = 1.0f / lsum;
        const bf16_t* gp = Gt + row * 1024 + h * 64; bf16_t* op = OG + row * 1024 + h * 64;
#pragma unroll
        for (int i = 0; i < 8; ++i) { const u32x4 w = *(const u32x4*)(gp + 8 * i); u32x4 r;
            r.x = pk2(o[8 * i] * il * lo16(w.x), o[8 * i + 1] * il * hi16(w.x)); r.y = pk2(o[8 * i + 2] * il * lo16(w.y), o[8 * i + 3] * il * hi16(w.y));
            r.z = pk2(o[8 * i + 4] * il * lo16(w.z), o[8 * i + 5] * il * hi16(w.z)); r.w = pk2(o[8 * i + 6] * il * lo16(w.w), o[8 * i + 7] * il * hi16(w.w));
            *(u32x4*)(op + 8 * i) = r; }
    }
}

__device__ __forceinline__ void attn_fast(Frame& F, int j) {
    typedef attn_body::bf16 abf;
    const attn_body::AttnTensors AT{(const abf*)(F.ws + WS_RA), (const abf*)(F.ws + WS_P), (const abf*)(F.ws + WS_P + 64 * MiB), (abf*)(F.ws + WS_H2 + 64 * MiB), (const abf*)(F.ws + WS_RA + 64 * MiB),
                                    (const float*)(F.ws + WS_KB), F.in[I_QNORM] + j * 64};
    static_assert(attn_body::ATTN_LDS_BYTES <= 131072, "attention LDS");
    attn_body::attn_phase<8>(F.tid, F.wave, (unsigned*)(F.ws + WS_CTL) + CW_ATT + 64 * j, (const int*)(F.ws + WS_T0), (volatile LAS int*)(F.lds + MISC_OFF + 64), F.ldsg, AT);
}
__device__ __forceinline__ void relane(Frame& F) { int l_; asm volatile("v_mbcnt_lo_u32_b32 %0, -1, 0\n\tv_mbcnt_hi_u32_b32 %0, -1, %0" : "=v"(l_)); int w_ = F.wave; asm volatile("" : "+s"(w_)); F.wave = w_; F.lane = l_; F.tid = w_ * 64 + l_;
    GAS unsigned char* p_ = (GAS unsigned char*)F.ws; asm volatile("" : "+s"(p_)); F.ws = (unsigned char*)p_; GAS float* x_ = (GAS float*)F.xs; asm volatile("" : "+s"(x_)); F.xs = (float*)x_; }
#define GRID_BAR() (relane(F), xcd_barrier_fn(bar.bar, bar.x, bar.st, F.tid == 0))
#ifndef ONLY
#define ONLY (-1)
#endif
#ifndef REP_MASK
#define REP_MASK 0
#endif
#define ON(k) (relane(F), (ONLY < 0 || ONLY == (k)))
#define RUN(k, ...) do { for (int rep_ = 0; rep_ < (((REP_MASK >> (k)) & 1) ? 2 : 1); ++rep_) { if (ON(k)) { __VA_ARGS__; } if (REP_MASK) __syncthreads(); } } while (0)
template <int l> __device__ __forceinline__ void layer_body(Frame& F, const XcdBarrier& bar) {
    unsigned char* ws = F.ws;

        if (l < 2) {
#ifdef GPROBE
            { relane(F); SchedRKV S{{T / 256, 12, F.G, F.bid}};
#if GPROBE == 1
              EpiNone E{};
#else
              EpiPriv E{(bf16_t*)(ws + WS_RA), F.bid};
#endif
              gemm_fast(F, (const bf16_t*)(ws + WS_SC), 1024, (const bf16_t*)(ws + WS_RWBIG) + (size_t)l * 3072 * 1024, 1024, S, E); __syncthreads(); }
#endif
            RUN(2, SchedRKV S{{T / 256, 12, F.G, F.bid}}; EpiRKV E{(bf16_t*)(ws + WS_RA), (bf16_t*)(ws + WS_P), l};
              gemm_fast(F, (const bf16_t*)(ws + WS_SC), 1024, (const bf16_t*)(ws + WS_RWBIG) + (size_t)l * 3072 * 1024, 1024, S, E););
            RUN(21, SchedDense S{T / 256, 2, F.G, F.bid}; EpiLA E{(bf16_t*)(ws + WS_RA + 192 * MiB)};
              gemm_fast(F, (const bf16_t*)(ws + WS_H2), RWK, (const bf16_t*)(ws + WS_RWLORA) + (size_t)l * 512 * RWK, RWK, S, E););
            GRID_BAR();
            RUN(3, SchedDense S{T / 256, 4, F.G, F.bid}; EpiPlain E{(bf16_t*)(ws + WS_RA + 224 * MiB), 1024};
              gemm_fast(F, (const bf16_t*)(ws + WS_RA + 192 * MiB) + 128, LAW, (const bf16_t*)(ws + WS_LORA2 + (size_t)l * MiB + L2_G2T), G2K, S, E););
            RUN(4, wkv_chunk_prep<0>(F, l));
#ifdef PREP_PROBE
            relane(F); __syncthreads(); wkv_chunk_prep<PREP_PROBE>(F, l);
#endif
            GRID_BAR();
            RUN(20, wkv_chunk_seq(F, l)); RUN(19, moe_convert(F, l, 128, F.G - 128));
            GRID_BAR();
            RUN(6, SchedDense S{T / 256, 4, F.G, F.bid}; EpiPlain E{(bf16_t*)(ws + WS_Y16), 1024};
              gemm_fast(F, (const bf16_t*)(ws + WS_H2), 1024, (const bf16_t*)(ws + WS_RWWO) + (size_t)l * 1024 * 1024, 1024, S, E););
            GRID_BAR();
        } else {
            const int j = l - 2;
            RUN(7, SchedDense S{T / 256, 8, F.G, F.bid}; EpiSplit2 E{(bf16_t*)(ws + WS_RA), (bf16_t*)(ws + WS_RA + 64 * MiB), 1};
              gemm_fast(F, (const bf16_t*)(ws + WS_H2), 1024, (const bf16_t*)(ws + WS_FXQG) + (size_t)j * 2048 * 1024, 1024, S, E););
            GRID_BAR();
            RUN(19, moe_convert(F, l, F.G - 64, 64));
            RUN(8, attn_fast(F, j));
            GRID_BAR();
            RUN(9, SchedDense S{T / 256, 4, F.G, F.bid}; EpiPlain E{(bf16_t*)(ws + WS_Y16), 1024};
              gemm_fast(F, (const bf16_t*)(ws + WS_H2 + 64 * MiB), 1024, (const bf16_t*)(ws + WS_FXWO) + (size_t)j * 1024 * 1024, 1024, S, E););
            GRID_BAR();
        }
#ifdef TOKA_PROBE
        relane(F); tok_a<true>(F, l); __syncthreads();
#endif
#ifdef BAR_PROBE
        for (int bi_ = 0; bi_ < 5; ++bi_) GRID_BAR();
#endif
        RUN(10, tok_a<false>(F, l));
        GRID_BAR();
        {
            const LAS int* lc = (const LAS int*)(F.lds + MOE_LC_OFF);
            const bf16_t* W1T = (const bf16_t*)(ws + WS_MOE); const bf16_t* W2T = W1T + (size_t)32 * 1024 * 1024;
            relane(F); moe_tables(F, l);
            { SchedMoe S{lc + 96, lc[64], F.G, F.bid, (size_t)1024 * 1024}; moe_rows(F, S); EpiMoe1 E{(bf16_t*)(ws + WS_HM)};
              RUN(12, gemm_fast<EpiMoe1, SchedMoe, true>(F, (const bf16_t*)(ws + WS_H2), 1024, W1T, 1024, S, E, (const LAS int*)(F.lds + MOE_TOKL_OFF))); }
            GRID_BAR();
            { SchedMoe S{lc + 96, lc[64], F.G, F.bid, (size_t)1024 * 512}; EpiPlain E{(bf16_t*)(ws + WS_RA + 144 * MiB), 1024};
              RUN(13, gemm_fast(F, (const bf16_t*)(ws + WS_HM), 512, W2T, 512, S, E)); }
            GRID_BAR();
        }
#ifdef TOKB_PROBE
        relane(F); tok_b<true>(F, l, l == 1 ? 1 : (l == 2 ? 2 : 3)); __syncthreads();
#endif
        RUN(14, tok_b<false>(F, l, l == 1 ? 1 : (l == 2 ? 2 : 3)));
        if (l == 3) return;
        GRID_BAR();
        if (l == 0) { RUN(1, rw_prep(F, 1, false)); GRID_BAR(); }
        if (l == 1) {
            RUN(18, fgate_phase(F));
            RUN(15, SchedDense S{T / 256, 8, F.G, F.bid}; EpiSplit2 E{(bf16_t*)(ws + WS_P), (bf16_t*)(ws + WS_P + 64 * MiB), 0};
              gemm_fast(F, (const bf16_t*)(ws + WS_RA), 1024, (const bf16_t*)(ws + WS_KVW), 1024, S, E););
            GRID_BAR();
            RUN(16, kv_post(F));
            GRID_BAR();
        }
}
__global__ void __launch_bounds__(NTHR, 2) yoco_fwd(Args args) {
    extern __shared__ __attribute__((aligned(16))) unsigned char lds[];
    Frame F;
    F.lds = (LAS unsigned char*)lds; F.ldsg = (char*)lds; F.ws = args.ws; F.xs = args.out; F.in.p = args.in;
    F.tid = threadIdx.x; F.lane = F.tid & 63; F.wave = __builtin_amdgcn_readfirstlane(F.tid >> 6); F.G = gridDim.x; F.bid = blockIdx.x;
    volatile LAS unsigned* MISC = (volatile LAS unsigned*)(F.lds + MISC_OFF);
    if (F.tid < 32) MISC[F.tid] = 0u;
    __syncthreads();
    XcdBarrier bar = xcd_barrier_post((unsigned*)(F.ws + WS_CTL) + CW_BAR, MISC + 8);
    unsigned char* ws = F.ws;
    RUN(0, p0_prologue(F));
    GRID_BAR();
    RUN(1, rw_prep(F, 0, true));
    GRID_BAR();
    layer_body<0>(F, bar); layer_body<1>(F, bar); layer_body<2>(F, bar); layer_body<3>(F, bar);
}

extern "C" void kernel_launch(void* const* d_in, const int* in_sizes, int n_in, void* d_out, int out_size, void* d_ws, size_t ws_size, hipStream_t stream) {
    static int grid = 0;
    if (grid == 0) {
        if (n_in != 40 || out_size != T * D || ws_size < WS_END) { fprintf(stderr, "kernel_launch: unexpected shapes (n_in %d out %d ws %zu)\n", n_in, out_size, ws_size); grid = -1; return; }
        int dev = 0, cus = 0, per_cu = 0;
        if (hipGetDevice(&dev) != hipSuccess || hipDeviceGetAttribute(&cus, hipDeviceAttributeMultiprocessorCount, dev) != hipSuccess) { grid = -1; return; }
        if (hipFuncSetAttribute((const void*)yoco_fwd, hipFuncAttributeMaxDynamicSharedMemorySize, LDS_BYTES) != hipSuccess) { fprintf(stderr, "kernel_launch: hipFuncSetAttribute failed\n"); grid = -1; return; }
        if (hipOccupancyMaxActiveBlocksPerMultiprocessor(&per_cu, (const void*)yoco_fwd, NTHR, LDS_BYTES) != hipSuccess || per_cu < 1) fprintf(stderr, "kernel_launch: occupancy query reports %d\n", per_cu);
        (void)hipGetLastError();
        grid = cus;
        if (grid != 256) { fprintf(stderr, "kernel_launch: built for 256 CUs, found %d\n", cus); grid = -1; return; }
    }
    if (grid < 0) return;
    (void)hipMemsetAsync((char*)d_ws + WS_CTL, 0, CTL_BYTES, stream);
    Args a{};
    for (int i = 0; i < 40; ++i) a.in[i] = (const float*)d_in[i];
    a.out = (float*)d_out; a.ws = (unsigned char*)d_ws; a.ph_lo = 0; a.ph_hi = 0;
    hipLaunchKernelGGL(yoco_fwd, dim3(grid), dim3(NTHR), LDS_BYTES, stream, a);
}
```

```cpp
#include <hip/hip_runtime.h>
#include <cstdio>
#include <cstdint>
#include <hip/hip_bf16.h>
#include <cmath>

#define GAS __attribute__((address_space(1)))
#define LAS __attribute__((address_space(3)))
typedef unsigned short bf16_t;
typedef short bf16x8 __attribute__((ext_vector_type(8)));
typedef float f32x4 __attribute__((ext_vector_type(4)));
typedef float f32x2 __attribute__((ext_vector_type(2)));
typedef unsigned u32x4 __attribute__((ext_vector_type(4)));
typedef unsigned u32x2 __attribute__((ext_vector_type(2)));
typedef GAS unsigned gu32;

constexpr int NB = 8, SEQ = 4096, T = NB * SEQ, D = 1024, NH = 16, HD = 64;
constexpr int NWAVES = 8, NTHR = NWAVES * 64;
constexpr float ALPHA = 1.681792830507429f;
constexpr float LN_EPS = 1e-5f, GN_EPS = 64e-5f, QK_EPS = 1e-6f;
constexpr float LOG2E = 1.4426950408889634f;
constexpr float QC2 = 0.125f * LOG2E;
constexpr int RWK = 2048;
constexpr int LAW = 512;
constexpr int G2K = 256;
constexpr int XS_ROWS = 73728;

constexpr size_t MiB = 1u << 20;
constexpr size_t WS_CTL = 0, CTL_BYTES = 1 * MiB;
constexpr size_t WS_MOD = 1 * MiB;
constexpr size_t WS_KVMOD = WS_MOD + 4 * 8 * 6144 * 4;
constexpr size_t WS_RT = 2 * MiB;
constexpr size_t WS_WF = WS_RT + 768 * 1024;
constexpr size_t WS_KB = 3 * MiB;
constexpr size_t WS_LF = 5 * MiB;
constexpr size_t WS_ASG = 7 * MiB;
constexpr size_t WS_GATE = WS_ASG + 256 * 1024;
constexpr size_t WS_DEST = WS_GATE + 256 * 1024;
constexpr size_t WS_TEXP = WS_DEST + 256 * 1024;
constexpr size_t WS_T0 = WS_TEXP + 4096;
constexpr size_t WS_RWBIG = 16 * MiB;
constexpr size_t WS_RWLORA = 28 * MiB;
constexpr size_t WS_LORA2 = 44 * MiB;
constexpr size_t L2_G2T = 0, L2_W2T = 512 * 1024, L2_A2T = 640 * 1024, L2_V2T = 768 * 1024;
constexpr size_t WS_RWWO = 50 * MiB;
constexpr size_t WS_KVW = 54 * MiB;
constexpr size_t WS_FXQG = 58 * MiB;
constexpr size_t WS_FXWO = 66 * MiB;
constexpr size_t WS_MOE = 72 * MiB;
constexpr size_t WS_SC = 168 * MiB;
constexpr size_t X3S = (size_t)T * 1024;
constexpr size_t WS_XS = WS_SC + 200 * MiB;
constexpr size_t WS_P = 456 * MiB;
constexpr size_t WS_Y16 = 584 * MiB;
constexpr size_t WS_H2 = 648 * MiB;
constexpr size_t WS_RA = 776 * MiB;
constexpr size_t WS_HM = WS_RA;
constexpr size_t WS_TLIST = WS_RA + 80 * MiB;
constexpr size_t WS_END = 1064 * MiB;
constexpr int CW_BAR = 4096;
constexpr int CW_CNT = 16384;
constexpr int CW_ATT = 16640;

constexpr int LDS_BYTES = 147456;
constexpr int MISC_OFF = 131072 + 320;
constexpr int MOE_LC_OFF = MISC_OFF + 256;
constexpr int MOE_TOKL_OFF = MISC_OFF + 2048;
__device__ __forceinline__ float bf2f(unsigned short b) { return __uint_as_float((unsigned)b << 16); }
typedef float f32x2_cv __attribute__((ext_vector_type(2))); typedef __bf16 bf16x2_cv __attribute__((ext_vector_type(2)));
__device__ __forceinline__ unsigned pk2(float lo, float hi) { const f32x2_cv v = {lo, hi}; return __builtin_bit_cast(unsigned, __builtin_convertvector(v, bf16x2_cv)); }
__device__ __forceinline__ unsigned f2bf(float f) { return pk2(f, 0.f) & 0xffffu; }
__device__ __forceinline__ float lo16(unsigned w) { return __uint_as_float(w << 16); }
__device__ __forceinline__ float hi16(unsigned w) { return __uint_as_float(w & 0xffff0000u); }
__device__ __forceinline__ float sigmoidf_(float x) { return __builtin_amdgcn_rcpf(1.0f + __expf(-x)); }
__device__ __forceinline__ float tanhf_(float x) { const float e = __expf(2.0f * x); return 1.0f - 2.0f * __builtin_amdgcn_rcpf(e + 1.0f); }
template <int CTRL> __device__ __forceinline__ float dpp_f(float v) {
    return __builtin_bit_cast(float, __builtin_amdgcn_update_dpp(0, __builtin_bit_cast(int, v), CTRL, 0xF, 0xF, true));
}
__device__ __forceinline__ float wave_sum(float v) {
    v += dpp_f<0xB1>(v); v += dpp_f<0x4E>(v); v += dpp_f<0x141>(v); v += dpp_f<0x140>(v);
    const int vi = __builtin_bit_cast(int, v);
    const float s0 = __builtin_bit_cast(float, __builtin_amdgcn_readlane(vi, 0)), s1 = __builtin_bit_cast(float, __builtin_amdgcn_readlane(vi, 16)), s2 = __builtin_bit_cast(float, __builtin_amdgcn_readlane(vi, 32)), s3 = __builtin_bit_cast(float, __builtin_amdgcn_readlane(vi, 48));
    return (s0 + s1) + (s2 + s3);
}
__device__ __forceinline__ float quadsum(float v) { v += dpp_f<0xB1>(v); v += dpp_f<0x4E>(v); return v; }
__device__ __forceinline__ float rowsum16(float v) { v += dpp_f<0xB1>(v); v += dpp_f<0x4E>(v); v += dpp_f<0x141>(v); v += dpp_f<0x140>(v); return v; }
#define LDS_WAIT() asm volatile("s_waitcnt lgkmcnt(0)" ::: "memory")
#define LBAR() do { asm volatile("s_waitcnt lgkmcnt(0)" ::: "memory"); __builtin_amdgcn_s_barrier(); asm volatile("" ::: "memory"); } while (0)

#define XB_TMO      128
#define XB_XCNT(j)  (256  + 64 * (j))
#define XB_XSUB(j)  (1280 + 64 * (j))
#define XB_XGEN(j)  (2304 + 64 * (j))
#define XB_TOP      3328
#define XB_TOPGEN   3392
#define XCD_BAR_WORDS 3456
#define XB_SPIN_CAP (1u << 22)
__device__ __forceinline__ unsigned xb_ld(unsigned* p)              { return __hip_atomic_load(p, __ATOMIC_RELAXED, __HIP_MEMORY_SCOPE_AGENT); }
__device__ __forceinline__ unsigned xb_add(unsigned* p, unsigned v) { return __hip_atomic_fetch_add(p, v, __ATOMIC_RELAXED, __HIP_MEMORY_SCOPE_AGENT); }
__device__ __forceinline__ unsigned xb_xcc_id() { return (unsigned)__builtin_amdgcn_s_getreg((3 << 11) | 20) & 0xFu; }
#define XB_SPIN(cond, bar) do { unsigned _sp = 0; while (cond) { __builtin_amdgcn_s_sleep(1); \
    if ((++_sp & 255u) == 0u) { if (xb_ld(&(bar)[XB_TMO])) break; if (_sp > XB_SPIN_CAP) { atomicAdd(&(bar)[XB_TMO], 1u); break; } } } } while (0)
struct XcdBarrier { unsigned* bar; unsigned x; volatile LAS unsigned* st; };
__device__ __forceinline__ XcdBarrier xcd_barrier_post(unsigned* bar, volatile LAS unsigned* st) {
    XcdBarrier b; b.bar = bar; b.x = xb_xcc_id(); b.st = st;
    if (threadIdx.x == 0) (void)xb_add(&bar[XB_XCNT(b.x)], 1u);
    return b;
}
__device__ __forceinline__ void xcd_barrier_complete(unsigned* bar, unsigned x, unsigned& nloc, unsigned& nx) {
    const unsigned G = gridDim.x * gridDim.y * gridDim.z;
    unsigned sum, cnt, mine, sp = 0u;
    for (;;) {
        sum = 0u; cnt = 0u; mine = 0u;
#pragma unroll
        for (unsigned j = 0; j < 16; ++j) { const unsigned c = xb_ld(&bar[XB_XCNT(j)]); sum += c; cnt += (c > 0u) ? 1u : 0u; mine = (j == x) ? c : mine; }
        if (sum == G) break;
        __builtin_amdgcn_s_sleep(1);
        if ((++sp & 255u) == 0u) { if (xb_ld(&bar[XB_TMO])) break; if (sp > XB_SPIN_CAP) { atomicAdd(&bar[XB_TMO], 1u); break; } }
    }
    nloc = mine > 0u ? mine : 1u; nx = cnt > 0u ? cnt : 1u;
}
__device__ __forceinline__ void xcd_barrier_fn(unsigned* bar_, unsigned x_, volatile LAS unsigned* st_, bool is_t0) {
    XcdBarrier b; b.bar = bar_; b.x = x_; b.st = st_;
    asm volatile("s_waitcnt vmcnt(0)" ::: "memory");
    __syncthreads();
    if (is_t0) {
        unsigned* bar = b.bar;
        __builtin_amdgcn_s_waitcnt(0);
        unsigned nloc = b.st[0], nx = b.st[1];
        if (nloc == 0u) { xcd_barrier_complete(bar, b.x, nloc, nx); b.st[0] = nloc; b.st[1] = nx; }
        const unsigned old = xb_add(&bar[XB_XSUB(b.x)], 1u);
        const unsigned gen = old / nloc;
        if (old + 1u == (gen + 1u) * nloc) {
            __builtin_amdgcn_fence(__ATOMIC_RELEASE, "agent");
            asm volatile("s_waitcnt vmcnt(0)" ::: "memory");
            const unsigned og = xb_add(&bar[XB_TOP], 1u);
            const unsigned tg = og / nx;
            if (og + 1u == (tg + 1u) * nx) xb_add(&bar[XB_TOPGEN], 1u);
            else XB_SPIN(xb_ld(&bar[XB_TOPGEN]) == tg, bar);
            __builtin_amdgcn_fence(__ATOMIC_ACQUIRE, "agent");
            xb_add(&bar[XB_XGEN(b.x)], 1u);
            asm volatile("s_waitcnt vmcnt(0)" ::: "memory");
        } else {
            XB_SPIN(xb_ld(&bar[XB_XGEN(b.x)]) == gen, bar);
            __builtin_amdgcn_fence(__ATOMIC_ACQUIRE, "agent");
            asm volatile("s_waitcnt vmcnt(0)" ::: "memory");
        }
    }
    __syncthreads();
}

struct Args { const float* in[40]; float* out; unsigned char* ws; int ph_lo, ph_hi; };
struct InTab { const float* const* p; __device__ __forceinline__ const float* operator[](int i) const { return (const float*)(GAS const float*)p[i]; } };
struct Frame {
    LAS unsigned char* lds; char* ldsg;
    unsigned char* ws; float* xs;
    InTab in;
    int tid, lane, wave, G, bid;
};
enum { I_X = 0, I_C, I_ADAW, I_ADAB, I_LNG, I_LNB, I_MU, I_RKV, I_W0, I_W1, I_W2, I_A0, I_A1, I_A2, I_G1, I_G2, I_KK, I_KA, I_RK, I_GNG, I_GNB, I_RWO, I_V0, I_V1, I_V2,
       I_KVADAW, I_KVADAB, I_KVW, I_KVFB, I_KNORM, I_WQG, I_QNORM, I_FWO, I_WGRP, I_BGRP, I_WEXP, I_BEXP, I_WGATE, I_WUP, I_WDOWN };

__device__ __forceinline__ void tr_item(const float* W, int ldw, int K, int k0, int n0, const float* mu, bf16_t* WT, int ldt, int nd0, int kd0, LAS float* scr, int lane) {
    const int kr = lane >> 3, n4 = 4 * (lane & 7);
    f32x4 v[8];
#pragma unroll
    for (int i = 0; i < 8; ++i) { const int k = k0 + kr + 8 * i; v[i] = (k < K) ? *(const f32x4*)(W + (size_t)k * ldw + n0 + n4) : (f32x4){0.f, 0.f, 0.f, 0.f}; }
    if (mu) {
#pragma unroll
        for (int i = 0; i < 8; ++i) { const int k = k0 + kr + 8 * i; v[i] = v[i] * ((k < K) ? mu[k] : 0.f); }
    }
#pragma unroll
    for (int i = 0; i < 8; ++i) { LAS float* d = scr + (kr + 8 * i) * 33 + n4; d[0] = v[i][0]; d[1] = v[i][1]; d[2] = v[i][2]; d[3] = v[i][3]; }
    LDS_WAIT(); asm volatile("" ::: "memory");
    const int c = lane & 7;
#pragma unroll
    for (int j = 0; j < 4; ++j) {
        const int n = (lane >> 3) + 8 * j; const LAS float* s = scr + (8 * c) * 33 + n;
        u32x4 o; o.x = pk2(s[0 * 33], s[1 * 33]); o.y = pk2(s[2 * 33], s[3 * 33]); o.z = pk2(s[4 * 33], s[5 * 33]); o.w = pk2(s[6 * 33], s[7 * 33]);
        *(u32x4*)(WT + (size_t)(nd0 + n) * ldt + kd0 + 8 * c) = o;
    }
    LDS_WAIT(); asm volatile("" ::: "memory");
}
__device__ __forceinline__ void zero_item(bf16_t* WT, int ldt, int r0, int c0, int c1, int lane) {
    const int cpr = (c1 - c0) >> 3, tot = 32 * cpr;
    for (int i = lane; i < tot; i += 64) { const int r = i / cpr, c = i % cpr; *(u32x4*)(WT + (size_t)(r0 + r) * ldt + c0 + 8 * c) = (u32x4){0u, 0u, 0u, 0u}; }
}

__device__ __forceinline__ void p0_prologue(Frame& F) {
    const InTab in = F.in;
    {
        LAS float* cs = (LAS float*)F.lds;
        LAS float* part = (LAS float*)(F.lds + 32768);
        bool did_cs = false;
        for (int it = F.bid; it < 104; it += F.G) {
            if (!did_cs) { for (int i = F.tid; i < 8 * 1024; i += NTHR) { const float v = in[I_C][i]; cs[i] = v / (1.0f + __expf(-v)); } did_cs = true; }
            __syncthreads();
            const float* W; const float* bias; int ldw, j0; float* dst; int dld;
            if (it < 96) { const int l = it / 24; j0 = (it % 24) * 256; W = in[I_ADAW] + (size_t)l * 1024 * 6144; ldw = 6144; bias = in[I_ADAB] + l * 6144; dst = (float*)(F.ws + WS_MOD) + (size_t)l * 8 * 6144; dld = 6144; }
            else { j0 = (it - 96) * 256; W = in[I_KVADAW]; ldw = 2048; bias = in[I_KVADAB]; dst = (float*)(F.ws + WS_KVMOD); dld = 2048; }
            f32x4 acc[8];
#pragma unroll
            for (int b = 0; b < 8; ++b) acc[b] = (f32x4){0.f, 0.f, 0.f, 0.f};
            const int kbeg = F.wave * 128;
#pragma unroll 4
            for (int kk = 0; kk < 128; ++kk) {
                const int k = kbeg + kk;
                const f32x4 w = *(const f32x4*)(W + (size_t)k * ldw + j0 + 4 * F.lane);
#pragma unroll
                for (int b = 0; b < 8; ++b) acc[b] += w * cs[b * 1024 + k];
            }
#pragma unroll
            for (int b = 0; b < 8; ++b) *(LAS f32x4*)(part + (F.wave * 8 + b) * 256 + 4 * F.lane) = acc[b];
            __syncthreads();
            for (int o = F.tid; o < 8 * 256; o += NTHR) {
                const int b = o >> 8, j = o & 255; float s = 0.f;
#pragma unroll
                for (int w = 0; w < 8; ++w) s += part[(w * 8 + b) * 256 + j];
                dst[(size_t)b * dld + j0 + j] = s + bias[j0 + j];
            }
            __syncthreads();
        }
        __syncthreads();
    }
    {
        const int gt = F.bid * NTHR + F.tid, NGT = F.G * NTHR;
        bf16_t* RTH = (bf16_t*)(F.ws + WS_RT); bf16_t* RTL = RTH + 4 * 48 * 1024; bf16_t* WFH = (bf16_t*)(F.ws + WS_WF); bf16_t* WFL = WFH + 16 * 1024;
        for (int i = gt; i < 4 * 48 * 1024; i += NGT) {
            const int l = i / (48 * 1024), r = i % (48 * 1024), c = r / 1024, k = r % 1024;
            const float w = (c < 4) ? in[I_WGRP][((size_t)l * 1024 + k) * 4 + c] : (c < 36 ? in[I_WEXP][((size_t)l * 1024 + k) * 32 + (c - 4)] : 0.f);
            const unsigned h = f2bf(w); RTH[i] = (bf16_t)h; RTL[i] = (bf16_t)f2bf(w - bf2f((unsigned short)h));
        }
        for (int i = gt; i < 16 * 1024; i += NGT) { const int c = i / 1024, k = i % 1024; const float w = in[I_KVW][(size_t)k * 2064 + 2048 + c];
            const unsigned h = f2bf(w); WFH[i] = (bf16_t)h; WFL[i] = (bf16_t)f2bf(w - bf2f((unsigned short)h)); }
    }
    LAS float* scr = (LAS float*)(F.lds + F.wave * 8704);
    const int gw = F.bid * NWAVES + F.wave, NGW = F.G * NWAVES;
    constexpr int N_S1 = 2 * 3 * 512;
    constexpr int N_S2 = 2 * 17 * 32;
    constexpr int N_S3 = 2 * 128;
    constexpr int N_S4 = 2 * 512 + 1024 + 2 * 1024 + 2 * 512;
    constexpr int N_TOT = N_S1 + N_S2 + N_S3 + N_S4;
    for (int it = gw; it < N_TOT; it += NGW) {
        int r = it;
        if (r < N_S1) {
            const int l = r / 1536; r %= 1536; const int p = r / 512; r %= 512; const int kb = r / 32, nb = r % 32;
            tr_item(in[I_RKV] + (size_t)(l * 3 + p) * 1024 * 1024, 1024, 1024, 64 * kb, 32 * nb, nullptr,
                    (bf16_t*)(F.ws + WS_RWBIG) + (size_t)l * 3072 * 1024, 1024, p * 1024 + 32 * nb, 64 * kb, scr, F.lane);
            continue;
        }
        r -= N_S1;
        if (r < N_S2) {
            const int l = r / (17 * 32); r %= (17 * 32); const int nbk = r / 32, sub = r % 32, half = sub / 16, kb = sub % 16;
            if (nbk >= 16) continue;
            bf16_t* WT = (bf16_t*)(F.ws + WS_RWLORA) + (size_t)l * 512 * RWK;
            const float* W = nullptr; int ldw = 0, n0 = 0, mui = 0;
            if (nbk < 2) { W = in[I_W1] + (size_t)l * 1024 * 64; ldw = 64; n0 = 32 * nbk; mui = 1; }
            else if (nbk < 4) { W = in[I_A1] + (size_t)l * 1024 * 64; ldw = 64; n0 = 32 * (nbk - 2); mui = 4; }
            else if (nbk < 9) { W = in[I_G1] + (size_t)l * 1024 * 160; ldw = 160; n0 = 32 * (nbk - 4); mui = 5; }
            else if (nbk == 9 && l == 1) { W = in[I_V1]; ldw = 32; n0 = 0; mui = 3; }
            if (W) tr_item(W, ldw, 1024, 64 * kb, n0, half ? in[I_MU] + (l * 6 + mui) * 1024 : nullptr, WT, RWK, 32 * nbk, half * 1024 + 64 * kb, scr, F.lane);
            else zero_item(WT, RWK, 32 * nbk, half * 1024 + 64 * kb, half * 1024 + 64 * kb + 64, F.lane);
            continue;
        }
        r -= N_S2;
        if (r < N_S3) {
            const int l = r / 128; r %= 128; const int blk = r / 32, nb = r % 32;
            unsigned char* base = F.ws + WS_LORA2 + (size_t)l * MiB;
            if (blk == 0) { tr_item(in[I_W2] + (size_t)l * 64 * 1024, 1024, 64, 0, 32 * nb, nullptr, (bf16_t*)(base + L2_W2T), 64, 32 * nb, 0, scr, F.lane); }
            else if (blk == 1) { tr_item(in[I_A2] + (size_t)l * 64 * 1024, 1024, 64, 0, 32 * nb, nullptr, (bf16_t*)(base + L2_A2T), 64, 32 * nb, 0, scr, F.lane); }
            else if (blk == 2) { for (int kb = 0; kb < 4; ++kb) tr_item(in[I_G2] + (size_t)l * 160 * 1024, 1024, 160, 64 * kb, 32 * nb, nullptr, (bf16_t*)(base + L2_G2T), G2K, 32 * nb, 64 * kb, scr, F.lane); }
            else { if (l == 1) tr_item(in[I_V2], 1024, 32, 0, 32 * nb, nullptr, (bf16_t*)(base + L2_V2T), 64, 32 * nb, 0, scr, F.lane); }
            continue;
        }
        r -= N_S3;
        if (r < N_S4) {
            if (r < 1024) { const int l = r / 512; r %= 512; tr_item(in[I_RWO] + (size_t)l * 1024 * 1024, 1024, 1024, 64 * (r / 32), 32 * (r % 32), nullptr, (bf16_t*)(F.ws + WS_RWWO) + (size_t)l * 1024 * 1024, 1024, 32 * (r % 32), 64 * (r / 32), scr, F.lane); continue; }
            r -= 1024;
            if (r < 1024) { tr_item(in[I_KVW], 2064, 1024, 64 * (r / 64), 32 * (r % 64), nullptr, (bf16_t*)(F.ws + WS_KVW), 1024, 32 * (r % 64), 64 * (r / 64), scr, F.lane); continue; }
            r -= 1024;
            if (r < 2048) { const int j = r / 1024; r %= 1024; tr_item(in[I_WQG] + (size_t)j * 1024 * 2048, 2048, 1024, 64 * (r / 64), 32 * (r % 64), nullptr, (bf16_t*)(F.ws + WS_FXQG) + (size_t)j * 2048 * 1024, 1024, 32 * (r % 64), 64 * (r / 64), scr, F.lane); continue; }
            r -= 2048;
            { const int j = r / 512; r %= 512; tr_item(in[I_FWO] + (size_t)j * 1024 * 1024, 1024, 1024, 64 * (r / 32), 32 * (r % 32), nullptr, (bf16_t*)(F.ws + WS_FXWO) + (size_t)j * 1024 * 1024, 1024, 32 * (r % 32), 64 * (r / 32), scr, F.lane); continue; }
        }
    }
}
__device__ __forceinline__ void moe_convert(Frame& F, int l, int wg0, int nwg) {
    const InTab in = F.in;
    LAS float* scr = (LAS float*)(F.lds + F.wave * 8704);
    if (F.bid < wg0 || F.bid >= wg0 + nwg) return;
    const int gw = (F.bid - wg0) * NWAVES + F.wave, NGW = nwg * NWAVES;
    bf16_t* base = (bf16_t*)(F.ws + WS_MOE);
    const int kr = F.lane >> 3, n4 = 4 * (F.lane & 7), c = F.lane & 7;
#define MC_DECODE(it_, W_, ldw_, k0_, n0_, WT_, ldt_, nd0_, kd0_) do { const int e_ = (it_) / 768; int r_ = (it_) % 768; const int le_ = l * 32 + e_; \
        if (r_ < 512) { const int kb_ = r_ / 32, nb_ = r_ % 32, s_ = (nb_ % 8) / 4; W_ = (s_ ? in[I_WUP] : in[I_WGATE]) + (size_t)le_ * 1024 * 512; ldw_ = 512; k0_ = 64 * kb_; n0_ = 128 * (nb_ / 8) + 32 * (nb_ % 4); \
            WT_ = base + (size_t)e_ * 1024 * 1024; ldt_ = 1024; nd0_ = 32 * nb_; kd0_ = 64 * kb_; } \
        else { r_ -= 512; const int kb_ = r_ / 32, nb_ = r_ % 32; W_ = in[I_WDOWN] + (size_t)le_ * 512 * 1024; ldw_ = 1024; k0_ = 64 * kb_; n0_ = 32 * nb_; \
            WT_ = base + (size_t)32 * 1024 * 1024 + (size_t)e_ * 1024 * 512; ldt_ = 512; nd0_ = 32 * nb_; kd0_ = 64 * kb_; } } while (0)
    f32x4 v[8];
    { int it = gw; if (it < 32 * 768) { const float* W; int ldw, k0, n0; bf16_t* WT; int ldt, nd0, kd0; MC_DECODE(it, W, ldw, k0, n0, WT, ldt, nd0, kd0);
#pragma unroll
        for (int i = 0; i < 8; ++i) v[i] = *(const f32x4*)(W + (size_t)(k0 + kr + 8 * i) * ldw + n0 + n4); (void)WT; (void)ldt; (void)nd0; (void)kd0; } }
    for (int it = gw; it < 32 * 768; it += NGW) {
        const float* W; int ldw, k0, n0; bf16_t* WT; int ldt, nd0, kd0; MC_DECODE(it, W, ldw, k0, n0, WT, ldt, nd0, kd0);
#pragma unroll
        for (int i = 0; i < 8; ++i) { LAS float* d = scr + (kr + 8 * i) * 33 + n4; d[0] = v[i][0]; d[1] = v[i][1]; d[2] = v[i][2]; d[3] = v[i][3]; }
        if (it + NGW < 32 * 768) { const float* Wn; int ldwn, k0n, n0n; bf16_t* WTn; int ldtn, nd0n, kd0n; MC_DECODE(it + NGW, Wn, ldwn, k0n, n0n, WTn, ldtn, nd0n, kd0n);
#pragma unroll
            for (int i = 0; i < 8; ++i) v[i] = *(const f32x4*)(Wn + (size_t)(k0n + kr + 8 * i) * ldwn + n0n + n4); (void)WTn; (void)ldtn; (void)nd0n; (void)kd0n; }
        LDS_WAIT(); asm volatile("" ::: "memory");
#pragma unroll
        for (int j = 0; j < 4; ++j) {
            const int n = (F.lane >> 3) + 8 * j; const LAS float* sp = scr + (8 * c) * 33 + n;
            u32x4 o; o.x = pk2(sp[0 * 33], sp[1 * 33]); o.y = pk2(sp[2 * 33], sp[3 * 33]); o.z = pk2(sp[4 * 33], sp[5 * 33]); o.w = pk2(sp[6 * 33], sp[7 * 33]);
            __builtin_nontemporal_store(o, (u32x4*)(WT + (size_t)(nd0 + n) * ldt + kd0 + 8 * c));
        }
        LDS_WAIT(); asm volatile("" ::: "memory");
    }
#undef MC_DECODE
    __syncthreads();
}

struct Unit { int pm, pn; };
struct SchedDense {
    int nM, nN, G, c;
    __device__ __forceinline__ bool next(int i, Unit& u) const {
        const int nwg = nM * nN; const long L = (long)i * G + c; if (L >= nwg) return false;
        int wgid = (int)L; { const int q = nwg / 8, r = nwg % 8, xcd = wgid % 8, off = wgid / 8; wgid = (xcd < r ? xcd * (q + 1) : r * (q + 1) + (xcd - r) * q) + off; }
        const int nig = 8 * nN, gid = wgid / nig, fm = gid * 8, gsz = (nM - fm) < 8 ? (nM - fm) : 8;
        u.pm = fm + ((wgid % nig) % gsz); u.pn = (wgid % nig) / gsz; return true;
    }
    __device__ __forceinline__ size_t boff(const Unit& u, int K) const { return (size_t)u.pn * 256 * K; }
    __device__ __forceinline__ size_t aoff(const Unit&) const { return 0; }
};
struct SchedRKV : SchedDense {
    __device__ __forceinline__ size_t aoff(const Unit& u) const { return (size_t)(u.pn >> 2) * X3S; }
};
struct SchedMoe {
    const LAS int* tt; int ntiles, G, c; size_t estride;
    __device__ __forceinline__ bool next(int i, Unit& u) const { const long L = (long)i * G + c; if (L >= (long)ntiles * 4) return false; u.pm = (int)(L / 4); u.pn = (int)(L % 4); return true; }
    __device__ __forceinline__ size_t boff(const Unit& u, int K) const { return (size_t)(tt[u.pm] >> 16) * estride + (size_t)u.pn * 256 * K; }
    __device__ __forceinline__ size_t aoff(const Unit&) const { return 0; }
};
template <class Epi, class Sched>
__device__ __forceinline__ void gemm_phase(Frame& F, const bf16_t* A, int lda, const bf16_t* Bt, int K, const Sched& S, const Epi& E) {
    const int wr = F.wave >> 2, wc = F.wave & 3, fr = F.lane & 15, fq = F.lane >> 4;
    Unit u;
    for (int i = 0; S.next(i, u); ++i) {
        const bf16_t* Bb = Bt + S.boff(u, K) + (size_t)(wc * 32 + fr) * K + 8 * fq;
        for (int ai = 0; ai < 2; ++ai) {
            f32x4 acc[2][4][2];
#pragma unroll
            for (int b = 0; b < 2; ++b)
#pragma unroll
                for (int m = 0; m < 4; ++m)
#pragma unroll
                    for (int n = 0; n < 2; ++n) acc[b][m][n] = (f32x4){0.f, 0.f, 0.f, 0.f};
            const bf16_t* Ab = A + (size_t)(u.pm * 256 + ai * 128 + wr * 64 + fr) * lda + 8 * fq;
            for (int k0 = 0; k0 < K; k0 += 32) {
                bf16x8 bfr[2][2], af[4];
#pragma unroll
                for (int b = 0; b < 2; ++b)
#pragma unroll
                    for (int n = 0; n < 2; ++n) bfr[b][n] = *(const bf16x8*)(Bb + (size_t)(b * 128 + n * 16) * K + k0);
#pragma unroll
                for (int m = 0; m < 4; ++m) af[m] = *(const bf16x8*)(Ab + (size_t)(m * 16) * lda + k0);
#pragma unroll
                for (int b = 0; b < 2; ++b)
#pragma unroll
                    for (int m = 0; m < 4; ++m)
#pragma unroll
                        for (int n = 0; n < 2; ++n) acc[b][m][n] = __builtin_amdgcn_mfma_f32_16x16x32_bf16(bfr[b][n], af[m], acc[b][m][n], 0, 0, 0);
            }
            E(acc, ai, u, wr, wc, fr, fq);
        }
    }
}
#define PG8_LAS __attribute__((address_space(3)))
constexpr int BM = 256, BK = 64, HALF = 128, HTB = HALF * BK * 2  , STAGE_BYTES = 8 * HTB;

__host__ __device__ __forceinline__ int lds_byte(int r, int c) { const int st = (r >> 4) * 2 + (c >> 5), rr = r & 15, cc = c & 31, ob = rr * 64 + cc * 2; return st * 1024 + (ob ^ (((ob >> 9) & 1) << 5)); }
__host__ __device__ __forceinline__ void stage_rc(int b, int& R, int& C) { const int st = b / 1024, sb = b % 1024, swz = sb ^ (((sb >> 9) & 1) << 5); R = (st >> 1) * 16 + swz / 64; C = (st & 1) * 32 + (swz % 64) / 2; }
__host__ __device__ __forceinline__ int perm32(int rho) { const int n = rho >> 4, i = rho & 15; return 8 * (i >> 2) + 4 * n + (i & 3); }
template <class Epi, class Sched, bool GATHER = false, bool ALIGN_EPI = true, bool SP2 = true>
__device__ __forceinline__ void gemm_fast(Frame& F, const bf16_t* Ag, int lda, const bf16_t* Btg, int Kin, const Sched& S, const Epi& E, const LAS int* tokL = nullptr) {
    static_assert(!GATHER || SP2, "gather mode is written for the SP2 loop");
    PG8_LAS unsigned char* lds = (PG8_LAS unsigned char*)F.lds;
    const int tid = F.tid, wid = F.wave, lane = F.lane, wr = wid >> 2, wc = wid & 3, fr = lane & 15, fq = lane >> 4;
    int K = Kin; asm volatile("" : "+s"(K));
    const int nt = K / BK;
    unsigned voffA[2], voffB[2];
#pragma unroll
    for (int i = 0; i < 2; ++i) { int R, C; stage_rc(tid * 16 + i * 8192, R, C); const int Rb = (Epi::BCONT ? (R >> 5) * 64 : (R & ~31)) + perm32(R & 31);
        voffA[i] = (unsigned)(R * lda + C) * 2u; voffB[i] = (unsigned)(Rb * K + C) * 2u; }
    const size_t kstep = (size_t)(BK * 2);
    const size_t hstepA = (size_t)HALF * lda * 2, hstep = (size_t)(Epi::BCONT ? 32 : HALF) * K * 2;
    const size_t tstepA = 2 * hstepA;
    const unsigned ldsw = (unsigned)wid * 1024u;
    const int aoff = lds_byte(wr * 64 + fr, fq * 8), boff = lds_byte(wc * 32 + fr, fq * 8);
#define PG8_SA(b, h) (((b) * 2 + (h)) * HTB)
#define PG8_SB(b, h) ((4 + (b) * 2 + (h)) * HTB)
    const unsigned ldsb = (unsigned)__builtin_amdgcn_readfirstlane((int)((unsigned)(size_t)lds + ldsw));
#define PG8_STAGE(bufoff, gbase, voff) do { _Pragma("unroll") for (int _i = 0; _i < 2; ++_i) { unsigned keep_; \
        asm volatile("s_mov_b32 %0, m0\n\ts_mov_b32 m0, %3\n\ts_nop 0\n\tglobal_load_lds_dwordx4 %1, %2\n\ts_mov_b32 m0, %0" : "=&s"(keep_) : "v"((voff)[_i]), "s"((const char*)(gbase)), "s"(ldsb + (unsigned)((bufoff) + _i * 8192)) : "memory"); } } while (0)
    unsigned gcu[2][2] = {{0u, 0u}, {0u, 0u}}, gnx[2][2] = {{0u, 0u}, {0u, 0u}};
#define PG8_GOFS(dst, ord) do { int tl_ = tid; asm volatile("" : "+v"(tl_));   _Pragma("unroll") for (int _h = 0; _h < 2; ++_h) _Pragma("unroll") for (int _i = 0; _i < 2; ++_i) { int R_, C_; stage_rc(tl_ * 16 + _i * 8192, R_, C_); \
        dst[_h][_i] = ((unsigned)tokL[(ord) * 256 + _h * 128 + R_] * (unsigned)lda + (unsigned)C_) * 2u; } } while (0)
#define PG8_STAGE_A(bufoff, gptr, half, usenext) do { if constexpr (GATHER) { unsigned vv_[2]; _Pragma("unroll") for (int _j = 0; _j < 2; ++_j) vv_[_j] = (usenext) ? gnx[half][_j] : gcu[half][_j]; PG8_STAGE(bufoff, gptr, vv_); } \
        else { PG8_STAGE(bufoff, (gptr) + ((half) ? hstepA : (size_t)0), voffA); } } while (0)
#define PG8_LDA(dst, b, h) do { _Pragma("unroll") for (int m = 0; m < 4; ++m) _Pragma("unroll") for (int k = 0; k < 2; ++k) dst[m][k] = *(const PG8_LAS bf16x8*)(lds + PG8_SA(b, h) + aoff + m * 2048 + k * 1024); } while (0)
#define PG8_LDB(dst, b, h) do { _Pragma("unroll") for (int n = 0; n < 2; ++n) _Pragma("unroll") for (int k = 0; k < 2; ++k) dst[n][k] = *(const PG8_LAS bf16x8*)(lds + PG8_SB(b, h) + boff + n * 2048 + k * 1024); } while (0)
#define PG8_MMA(ai, bj, At, Bt) do { __builtin_amdgcn_s_setprio(1); _Pragma("unroll") for (int m = 0; m < 4; ++m) _Pragma("unroll") for (int n = 0; n < 2; ++n) _Pragma("unroll") for (int k = 0; k < 2; ++k) \
        acc[ai][bj][m][n] = __builtin_amdgcn_mfma_f32_16x16x32_bf16(Bt[n][k], At[m][k], acc[ai][bj][m][n], 0, 0, 0); __builtin_amdgcn_s_setprio(0); } while (0)
#define PG8_WAIT_V(n) asm volatile("s_waitcnt vmcnt(" #n ")" ::: "memory")
#define PG8_WAIT_R(rel) do { if (rel) asm volatile("s_waitcnt vmcnt(%0)" :: "n"(8 + Epi::NST) : "memory"); else PG8_WAIT_V(8); } while (0)
#define PG8_WAIT_L(n) asm volatile("s_waitcnt lgkmcnt(" #n ")" ::: "memory")
#define PG8_BAR __builtin_amdgcn_s_barrier()
#define PG8_SCHED __builtin_amdgcn_sched_barrier(0)
    Unit cur, nxt; int ui = 0;
    if (!S.next(0, cur)) return;
    f32x4 acc[2][2][4][2];
#pragma unroll
    for (int a = 0; a < 2; ++a)
#pragma unroll
        for (int b = 0; b < 2; ++b)
#pragma unroll
            for (int m = 0; m < 4; ++m)
#pragma unroll
                for (int n = 0; n < 2; ++n) acc[a][b][m][n] = (f32x4){0.f, 0.f, 0.f, 0.f};
    bf16x8 At[4][2], B0[2][2], B1[2][2];
    const char* cA = GATHER ? (const char*)Ag : (const char*)Ag + 2 * S.aoff(cur) + (size_t)cur.pm * tstepA; const char* cB = (const char*)Btg + 2 * S.boff(cur, K);
    if constexpr (GATHER) PG8_GOFS(gcu, 0);
    if constexpr (SP2) {
        PG8_STAGE(PG8_SB(0, 0), cB, voffB); PG8_STAGE(PG8_SB(0, 1), cB + hstep, voffB); PG8_STAGE_A(PG8_SA(0, 0), cA, 0, false); PG8_STAGE_A(PG8_SA(0, 1), cA, 1, false);
        if (wr == 1) PG8_BAR;
        PG8_WAIT_V(2); PG8_BAR;
        PG8_STAGE(PG8_SB(1, 0), cB + kstep, voffB); PG8_STAGE_A(PG8_SA(1, 0), cA + kstep, 0, false); PG8_STAGE(PG8_SB(1, 1), cB + hstep + kstep, voffB);
        PG8_WAIT_V(6); PG8_BAR;
    } else {
        PG8_STAGE(PG8_SB(0, 0), cB, voffB); PG8_STAGE(PG8_SA(0, 0), cA, voffA); PG8_STAGE(PG8_SB(0, 1), cB + hstep, voffB); PG8_STAGE(PG8_SA(0, 1), cA + hstepA, voffA);
        if (wr == 1) PG8_BAR;
        PG8_WAIT_V(4); PG8_BAR;
        PG8_STAGE(PG8_SB(1, 0), cB + kstep, voffB); PG8_STAGE(PG8_SA(1, 0), cA + kstep, voffA); PG8_STAGE(PG8_SB(1, 1), cB + hstep + kstep, voffB);
        PG8_WAIT_V(6); PG8_BAR;
    }
    for (;;) {
        const bool has_next = S.next(ui + 1, nxt);
        const char* nA = GATHER ? cA : (has_next ? (const char*)Ag + 2 * S.aoff(nxt) + (size_t)nxt.pm * tstepA : cA);
        if constexpr (GATHER) { if (has_next) PG8_GOFS(gnx, ui + 1); else { gnx[0][0] = gcu[0][0]; gnx[0][1] = gcu[0][1]; gnx[1][0] = gcu[1][0]; gnx[1][1] = gcu[1][1]; } } const char* nB = has_next ? (const char*)Btg + 2 * S.boff(nxt, K) : cB;
#define PG8_ITER(WAITA, ST11) do { \
            const bool last = (t == nt - 2); \
            const char* a1 = cA + (size_t)(t + 1) * kstep;                                             \
            const char* a2 = last ? nA : cA + (size_t)(t + 2) * kstep; const char* b2 = last ? nB : cB + (size_t)(t + 2) * kstep;     \
            const char* a3 = a2 + kstep; const char* b3 = b2 + kstep;                                \
              \
            PG8_LDB(B0, 0, 0); PG8_LDB(B1, 0, 1); PG8_SCHED; PG8_LDA(At, 0, 0); ST11; \
            WAITA; PG8_WAIT_L(0); PG8_BAR; PG8_MMA(0, 0, At, B0); PG8_MMA(0, 1, At, B1); PG8_BAR; PG8_SCHED; \
              \
            PG8_LDA(At, 0, 1); PG8_STAGE(PG8_SB(0, 0), b2, voffB); PG8_STAGE(PG8_SB(0, 1), b2 + hstep, voffB); PG8_STAGE_A(PG8_SA(0, 0), a2, 0, last); \
            WAITA; PG8_WAIT_L(0); PG8_BAR; PG8_MMA(1, 0, At, B0); PG8_MMA(1, 1, At, B1); PG8_BAR; PG8_SCHED; \
              \
            PG8_LDB(B0, 1, 0); PG8_LDB(B1, 1, 1); PG8_SCHED; PG8_LDA(At, 1, 0); PG8_STAGE_A(PG8_SA(0, 1), a2, 1, last); \
            WAITA; PG8_WAIT_L(0); PG8_BAR; PG8_MMA(0, 0, At, B0); PG8_MMA(0, 1, At, B1); PG8_BAR; PG8_SCHED; \
              \
            PG8_LDA(At, 1, 1); PG8_STAGE(PG8_SB(1, 0), b3, voffB); PG8_STAGE(PG8_SB(1, 1), b3 + hstep, voffB); PG8_STAGE_A(PG8_SA(1, 0), a3, 0, last); \
            PG8_WAIT_V(8); PG8_WAIT_L(0); PG8_BAR; PG8_MMA(1, 0, At, B0); PG8_MMA(1, 1, At, B1); PG8_BAR; PG8_SCHED; } while (0)
        int t = 0;
        if (ui > 0) { PG8_ITER(asm volatile("s_waitcnt vmcnt(%0)" :: "n"(8 + Epi::NST) : "memory"), (void)0); t = 2; }
        for (; t < nt; t += 2) PG8_ITER(PG8_WAIT_V(8), PG8_STAGE_A(PG8_SA(1, 1), a1, 1, false));
#undef PG8_ITER
        if constexpr (SP2) { if (has_next) PG8_STAGE_A(PG8_SA(1, 1), nA + kstep, 1, true); }
        if constexpr (ALIGN_EPI) { if (wr == 0) PG8_BAR; }
        { int fr_ = fr, fq_ = fq; asm volatile("" : "+v"(fr_), "+v"(fq_)); E(acc[0], 0, cur, wr, wc, fr_, fq_); E(acc[1], 1, cur, wr, wc, fr_, fq_); }
        if (!has_next) break;
#pragma unroll
        for (int a = 0; a < 2; ++a)
#pragma unroll
            for (int b = 0; b < 2; ++b)
#pragma unroll
                for (int m = 0; m < 4; ++m)
#pragma unroll
                    for (int n = 0; n < 2; ++n) acc[a][b][m][n] = (f32x4){0.f, 0.f, 0.f, 0.f};
        cur = nxt; cA = nA; cB = nB; ++ui;
        if constexpr (GATHER) { gcu[0][0] = gnx[0][0]; gcu[0][1] = gnx[0][1]; gcu[1][0] = gnx[1][0]; gcu[1][1] = gnx[1][1]; }
        if constexpr (ALIGN_EPI) { if (wr == 1) PG8_BAR; }
    }
    PG8_WAIT_V(0);
    if constexpr (!ALIGN_EPI) { if (wr == 0) PG8_BAR; }
    PG8_BAR;
#undef PG8_SA
#undef PG8_SB
#undef PG8_STAGE
#undef PG8_LDA
#undef PG8_GOFS
#undef PG8_STAGE_A
#undef PG8_LDB
#undef PG8_MMA
#undef PG8_WAIT_V
#undef PG8_WAIT_R
#undef PG8_WAIT_L
#undef PG8_BAR
#undef PG8_SCHED
}
__device__ __forceinline__ void st_bf16x4(bf16_t* p, f32x4 v) { u32x2 w; w.x = pk2(v[0], v[1]); w.y = pk2(v[2], v[3]); *(u32x2*)p = w; }
__device__ __forceinline__ f32x4 ld_bf16x4(const bf16_t* p) { const u32x2 w = *(const u32x2*)p; return (f32x4){lo16(w.x), hi16(w.x), lo16(w.y), hi16(w.y)}; }
__device__ __forceinline__ u32x4 pk8(f32x4 a, f32x4 b) { u32x4 w; w.x = pk2(a[0], a[1]); w.y = pk2(a[2], a[3]); w.z = pk2(b[0], b[1]); w.w = pk2(b[2], b[3]); return w; }
__device__ __forceinline__ u32x4 bperm4(int idx, u32x4 w) { u32x4 r; r.x = (unsigned)__builtin_amdgcn_ds_bpermute(idx, (int)w.x); r.y = (unsigned)__builtin_amdgcn_ds_bpermute(idx, (int)w.y); r.z = (unsigned)__builtin_amdgcn_ds_bpermute(idx, (int)w.z); r.w = (unsigned)__builtin_amdgcn_ds_bpermute(idx, (int)w.w); return r; }
#define EPI_LOOP(ACT, ...) do { const int L_ = fq * 16 + fr, r3_ = L_ >> 3, p3_ = L_ & 7, src4_ = (((p3_ & 3) << 4) | r3_) << 2; const bool hi_ = (p3_ & 4) != 0; \
    _Pragma("unroll") for (int m = 0; m < 4; ++m) { u32x4 wb_[2]; \
        _Pragma("unroll") for (int bj = 0; bj < 2; ++bj) { const int colt0 = wc * 64 + bj * 32 + fq * 8; f32x4 v0 = acc[bj][m][0], v1 = acc[bj][m][1]; (void)colt0; ACT; wb_[bj] = pk8(v0, v1); } \
        _Pragma("unroll") for (int h = 0; h < 2; ++h) { const int row = u.pm * 256 + ai * 128 + wr * 64 + m * 16 + h * 8 + r3_, colt = wc * 64 + p3_ * 8; \
            const u32x4 wa_ = bperm4(src4_ + h * 32, wb_[0]), wc_ = bperm4(src4_ + h * 32, wb_[1]); u32x4 w; w.x = hi_ ? wc_.x : wa_.x; w.y = hi_ ? wc_.y : wa_.y; w.z = hi_ ? wc_.z : wa_.z; w.w = hi_ ? wc_.w : wa_.w; \
            __VA_ARGS__ } asm volatile("" ::: "memory"); } } while (0)

struct EpiPlain {
    bf16_t* O; int ldc; static constexpr int NST = 16; static constexpr bool BCONT = true;
    __device__ __forceinline__ void operator()(const f32x4 (&acc)[2][4][2], int ai, const Unit& u, int wr, int wc, int fr, int fq) const {
        EPI_LOOP(, { __builtin_nontemporal_store(w, (u32x4*)(O + (size_t)row * ldc + u.pn * 256 + colt)); });
    }
};
struct EpiNone { static constexpr int NST = 0; static constexpr bool BCONT = true;
    __device__ __forceinline__ void operator()(const f32x4 (&acc)[2][4][2], int ai, const Unit& u, int wr, int wc, int fr, int fq) const {
        _Pragma("unroll") for (int m = 0; m < 4; ++m) _Pragma("unroll") for (int bj = 0; bj < 2; ++bj) asm volatile("" :: "v"(acc[bj][m][0]), "v"(acc[bj][m][1])); }
};
struct EpiPriv { bf16_t* base; int bid; static constexpr int NST = 16; static constexpr bool BCONT = true;
    __device__ __forceinline__ void operator()(const f32x4 (&acc)[2][4][2], int ai, const Unit& u, int wr, int wc, int fr, int fq) const {
        EPI_LOOP(, { __builtin_nontemporal_store(w, (u32x4*)(base + (size_t)bid * 65536 + (size_t)(row - u.pm * 256) * 256 + colt)); });
    }
};
struct EpiRKV {
    bf16_t* RKV; bf16_t* VF; int l; static constexpr int NST = 16; static constexpr bool BCONT = true;
    __device__ __forceinline__ void operator()(const f32x4 (&acc)[2][4][2], int ai, const Unit& u, int wr, int wc, int fr, int fq) const {
        const bool vf = (l == 0) && (u.pn >= 8);
        EPI_LOOP(, { if (vf) __builtin_nontemporal_store(w, (u32x4*)(VF + (size_t)row * 1024 + (u.pn - 8) * 256 + colt)); else __builtin_nontemporal_store(w, (u32x4*)(RKV + (size_t)row * 3072 + u.pn * 256 + colt)); });
    }
};
struct EpiLA {
    bf16_t* LA; static constexpr int NST = 16; static constexpr bool BCONT = true;
    __device__ __forceinline__ void operator()(const f32x4 (&acc)[2][4][2], int ai, const Unit& u, int wr, int wc, int fr, int fq) const {
        EPI_LOOP({ const int c = u.pn * 256 + colt0;
            if (c < 64) { _Pragma("unroll") for (int q = 0; q < 4; ++q) { v0[q] = tanhf_(v0[q]); v1[q] = tanhf_(v1[q]); } }
            else if (c >= 128 && c < 288) { _Pragma("unroll") for (int q = 0; q < 4; ++q) { v0[q] = sigmoidf_(v0[q]); v1[q] = sigmoidf_(v1[q]); } } },
            { __builtin_nontemporal_store(w, (u32x4*)(LA + (size_t)row * LAW + u.pn * 256 + colt)); });
    }
};
struct EpiSplit2 {
    bf16_t* O0; bf16_t* O1; int sig1; static constexpr int NST = 16; static constexpr bool BCONT = true;
    __device__ __forceinline__ void operator()(const f32x4 (&acc)[2][4][2], int ai, const Unit& u, int wr, int wc, int fr, int fq) const {
        if (u.pn < 4) { EPI_LOOP(, { __builtin_nontemporal_store(w, (u32x4*)(O0 + (size_t)row * 1024 + u.pn * 256 + colt)); }); }
        else { EPI_LOOP({ if (sig1) { _Pragma("unroll") for (int q = 0; q < 4; ++q) { v0[q] = sigmoidf_(v0[q]); v1[q] = sigmoidf_(v1[q]); } } }, { __builtin_nontemporal_store(w, (u32x4*)(O1 + (size_t)row * 1024 + (u.pn - 4) * 256 + colt)); }); }
    }
};
struct EpiMoe1 {
    bf16_t* HM; static constexpr int NST = 8; static constexpr bool BCONT = false;
    __device__ __forceinline__ void operator()(const f32x4 (&acc)[2][4][2], int ai, const Unit& u, int wr, int wc, int fr, int fq) const {
        const int L_ = fq * 16 + fr, src4_ = (((L_ & 3) << 4) | (L_ >> 2)) << 2, r2_ = L_ >> 2, p2_ = L_ & 3;
#pragma unroll
            for (int m = 0; m < 4; ++m) { const int row = u.pm * 256 + ai * 128 + wr * 64 + m * 16 + r2_; f32x4 o[2];
#pragma unroll
                for (int n = 0; n < 2; ++n) { const f32x4 g = acc[0][m][n], up = acc[1][m][n];
#pragma unroll
                    for (int q = 0; q < 4; ++q) o[n][q] = g[q] * sigmoidf_(g[q]) * up[q]; }
                u32x4 w = pk8(o[0], o[1]); w.x = (unsigned)__builtin_amdgcn_ds_bpermute(src4_, (int)w.x); w.y = (unsigned)__builtin_amdgcn_ds_bpermute(src4_, (int)w.y); w.z = (unsigned)__builtin_amdgcn_ds_bpermute(src4_, (int)w.z); w.w = (unsigned)__builtin_amdgcn_ds_bpermute(src4_, (int)w.w);
                __builtin_nontemporal_store(w, (u32x4*)(HM + (size_t)row * 512 + u.pn * 128 + wc * 32 + p2_ * 8)); }
    }
};

struct Row { f32x4 v[4]; };
__device__ __forceinline__ Row ld_row_f32(const float* p, int lane) { Row r;
#pragma unroll
    for (int j = 0; j < 4; ++j) r.v[j] = *(const f32x4*)(p + 256 * j + 4 * lane); return r; }
__device__ __forceinline__ void st_row_f32(float* p, int lane, const Row& r) {
#pragma unroll
    for (int j = 0; j < 4; ++j) __builtin_nontemporal_store(r.v[j], (f32x4*)(p + 256 * j + 4 * lane)); }
__device__ __forceinline__ Row ld_row_bf16(const bf16_t* p, int lane) { Row r;
#pragma unroll
    for (int j = 0; j < 4; ++j) r.v[j] = ld_bf16x4(p + 256 * j + 4 * lane); return r; }
__device__ __forceinline__ void st_row_bf16(bf16_t* p, int lane, const Row& r) {
#pragma unroll
    for (int j = 0; j < 4; ++j) { u32x2 w; w.x = pk2(r.v[j][0], r.v[j][1]); w.y = pk2(r.v[j][2], r.v[j][3]); __builtin_nontemporal_store(w, (u32x2*)(p + 256 * j + 4 * lane)); } }
__device__ __forceinline__ Row row_ln(const Row& u, const Row& g, const Row& b) {
    float s = 0.f;
#pragma unroll
    for (int j = 0; j < 4; ++j) s += (u.v[j][0] + u.v[j][1]) + (u.v[j][2] + u.v[j][3]);
    const float mean = wave_sum(s) * (1.0f / 1024.0f); float q = 0.f; Row d;
#pragma unroll
    for (int j = 0; j < 4; ++j) { d.v[j] = u.v[j] - mean; q += (d.v[j][0] * d.v[j][0] + d.v[j][1] * d.v[j][1]) + (d.v[j][2] * d.v[j][2] + d.v[j][3] * d.v[j][3]); }
    const float rstd = 1.0f / sqrtf(wave_sum(q) * (1.0f / 1024.0f) + LN_EPS); Row o;
#pragma unroll
    for (int j = 0; j < 4; ++j) o.v[j] = d.v[j] * rstd * g.v[j] + b.v[j];
    return o;
}
__device__ __forceinline__ float row_dot(const Row& a, const float* w, int lane) {
    float s = 0.f;
#pragma unroll
    for (int j = 0; j < 4; ++j) { const f32x4 x = *(const f32x4*)(w + 256 * j + 4 * lane); s += (a.v[j][0] * x[0] + a.v[j][1] * x[1]) + (a.v[j][2] * x[2] + a.v[j][3] * x[3]); }
    return s;
}

constexpr int APITCH = 1032;
template <int NCB>
__device__ __forceinline__ void skinny_mfma(Frame& F, const LAS bf16_t* AH, const LAS bf16_t* AL, const bf16_t* BH, const bf16_t* BL, LAS float* part) {
    const int fr = F.lane & 15, fq = F.lane >> 4;
    f32x4 acc[NCB];
#pragma unroll
    for (int cb = 0; cb < NCB; ++cb) acc[cb] = (f32x4){0.f, 0.f, 0.f, 0.f};
#pragma unroll
    for (int kb = 0; kb < 4; ++kb) {
        const int k0 = 128 * F.wave + 32 * kb + 8 * fq;
        const bf16x8 ah = *(const LAS bf16x8*)(AH + fr * APITCH + k0), al = *(const LAS bf16x8*)(AL + fr * APITCH + k0);
#pragma unroll
        for (int cb = 0; cb < NCB; ++cb) {
            const bf16x8 bh = *(const bf16x8*)(BH + (size_t)(cb * 16 + fr) * 1024 + k0), bl = *(const bf16x8*)(BL + (size_t)(cb * 16 + fr) * 1024 + k0);
            acc[cb] = __builtin_amdgcn_mfma_f32_16x16x32_bf16(bh, ah, acc[cb], 0, 0, 0);
            acc[cb] = __builtin_amdgcn_mfma_f32_16x16x32_bf16(bl, ah, acc[cb], 0, 0, 0);
            acc[cb] = __builtin_amdgcn_mfma_f32_16x16x32_bf16(bh, al, acc[cb], 0, 0, 0);
        }
    }
#pragma unroll
    for (int cb = 0; cb < NCB; ++cb) *(LAS f32x4*)(part + (F.wave * 16 + fr) * 48 + cb * 16 + 4 * fq) = acc[cb];
}
template <int NCB> struct SkB { bf16x8 h[4][NCB], l[4][NCB]; };
template <int NCB>
__device__ __forceinline__ void skinny_loadB(Frame& F, const bf16_t* BH, const bf16_t* BL, SkB<NCB>& B) {
    int ln_ = F.lane; asm volatile("" : "+v"(ln_));
    const int fr = ln_ & 15, fq = ln_ >> 4;
#pragma unroll
    for (int kb = 0; kb < 4; ++kb) { const int k0 = 128 * F.wave + 32 * kb + 8 * fq;
#pragma unroll
        for (int cb = 0; cb < NCB; ++cb) { B.h[kb][cb] = *(const bf16x8*)(BH + (size_t)(cb * 16 + fr) * 1024 + k0); B.l[kb][cb] = *(const bf16x8*)(BL + (size_t)(cb * 16 + fr) * 1024 + k0); } }
}
template <int NCB>
__device__ __forceinline__ void skinny_mma(Frame& F, const LAS bf16_t* AH, const LAS bf16_t* AL, const SkB<NCB>& B, LAS float* part) {
    const int fr = F.lane & 15, fq = F.lane >> 4;
    f32x4 acc[NCB];
#pragma unroll
    for (int cb = 0; cb < NCB; ++cb) acc[cb] = (f32x4){0.f, 0.f, 0.f, 0.f};
#pragma unroll
    for (int kb = 0; kb < 4; ++kb) {
        const int k0 = 128 * F.wave + 32 * kb + 8 * fq;
        const bf16x8 ah = *(const LAS bf16x8*)(AH + fr * APITCH + k0), al = *(const LAS bf16x8*)(AL + fr * APITCH + k0);
#pragma unroll
        for (int cb = 0; cb < NCB; ++cb) {
            acc[cb] = __builtin_amdgcn_mfma_f32_16x16x32_bf16(B.h[kb][cb], ah, acc[cb], 0, 0, 0);
            acc[cb] = __builtin_amdgcn_mfma_f32_16x16x32_bf16(B.l[kb][cb], ah, acc[cb], 0, 0, 0);
            acc[cb] = __builtin_amdgcn_mfma_f32_16x16x32_bf16(B.h[kb][cb], al, acc[cb], 0, 0, 0);
        }
    }
#pragma unroll
    for (int cb = 0; cb < NCB; ++cb) *(LAS f32x4*)(part + (F.wave * 16 + fr) * 48 + cb * 16 + 4 * fq) = acc[cb];
}
struct RowPk { u32x2 v[4]; };
__device__ __forceinline__ RowPk ld_row_pk(const bf16_t* p, int lane) { RowPk r;
#pragma unroll
    for (int j = 0; j < 4; ++j) r.v[j] = *(const u32x2*)(p + 256 * j + 4 * lane); return r; }
__device__ __forceinline__ Row unpk_row(const RowPk& p) { Row r;
#pragma unroll
    for (int j = 0; j < 4; ++j) r.v[j] = (f32x4){lo16(p.v[j].x), hi16(p.v[j].x), lo16(p.v[j].y), hi16(p.v[j].y)}; return r; }
typedef _Float16 h16x2 __attribute__((ext_vector_type(2)));
__device__ __forceinline__ unsigned pkh2(float lo, float hi) { return __builtin_bit_cast(unsigned, __builtin_amdgcn_cvt_pkrtz(lo, hi)); }
__device__ __forceinline__ Row unpk_row_h(const RowPk& p) { Row r;
#pragma unroll
    for (int j = 0; j < 4; ++j) { const unsigned wx = p.v[j].x, wy = p.v[j].y;
        const h16x2 a = __builtin_bit_cast(h16x2, wx), b = __builtin_bit_cast(h16x2, wy); r.v[j] = (f32x4){(float)a[0], (float)a[1], (float)b[0], (float)b[1]}; } return r; }
__device__ __forceinline__ void st_row_h(bf16_t* p, int lane, const Row& r) {
#pragma unroll
    for (int j = 0; j < 4; ++j) { u32x2 w; w.x = pkh2(r.v[j][0], r.v[j][1]); w.y = pkh2(r.v[j][2], r.v[j][3]); __builtin_nontemporal_store(w, (u32x2*)(p + 256 * j + 4 * lane)); } }
__device__ __forceinline__ RowPk split_row(const Row& h, LAS bf16_t* ah, LAS bf16_t* al, int lane) { RowPk hp;
#pragma unroll
    for (int j = 0; j < 4; ++j) { unsigned hb[4], lb[4];
#pragma unroll
        for (int q = 0; q < 4; ++q) { hb[q] = f2bf(h.v[j][q]); lb[q] = f2bf(h.v[j][q] - __uint_as_float(hb[q] << 16)); }
        hp.v[j].x = hb[0] | (hb[1] << 16); hp.v[j].y = hb[2] | (hb[3] << 16);
        *(LAS u32x2*)(ah + 256 * j + 4 * lane) = hp.v[j]; u32x2 lw; lw.x = lb[0] | (lb[1] << 16); lw.y = lb[2] | (lb[3] << 16); *(LAS u32x2*)(al + 256 * j + 4 * lane) = lw; }
    return hp; }

template <bool DRY = false>
__device__ __forceinline__ void tok_a(Frame& F, int l) {
    const InTab in = F.in;
    const bf16_t* Y16 = (const bf16_t*)(F.ws + WS_Y16); bf16_t* Hb = (bf16_t*)(F.ws + WS_H2); bf16_t* XS = (bf16_t*)(F.ws + WS_XS);
    const bf16_t* RTH = (const bf16_t*)(F.ws + WS_RT) + (size_t)l * 48 * 1024; const bf16_t* RTL = RTH + (size_t)4 * 48 * 1024;
    float* gates = (float*)(F.ws + WS_GATE); int* asg = (int*)(F.ws + WS_ASG);
    LAS unsigned* lcnt = (LAS unsigned*)F.lds;
    LAS unsigned* ltab = (LAS unsigned*)(F.lds + 1024);
    LAS float* lgt = (LAS float*)(F.lds + 2048);
    LAS float* part = (LAS float*)(F.lds + 8192);
    LAS bf16_t* AH = (LAS bf16_t*)(F.lds + 32768); LAS bf16_t* AL = AH + 16 * APITCH;
    const Row lng = ld_row_f32(in[I_LNG] + (size_t)(l * 2 + 0) * 1024, F.lane), lnb = ld_row_f32(in[I_LNB] + (size_t)(l * 2 + 0) * 1024, F.lane);
    LAS f32x4* MODL = (LAS f32x4*)(F.lds + 98816);
    for (int blk = F.bid; blk < T / 128; blk += F.G) {
        if (F.tid < 64) lcnt[F.tid] = 0u;
        const int tb = blk * 128, b = tb / SEQ;
        const float* mod = (const float*)(F.ws + WS_MOD) + ((size_t)l * 8 + b) * 6144;
        if (F.wave < 3) {
#pragma unroll
            for (int j = 0; j < 4; ++j) MODL[(F.wave * 4 + j) * 64 + F.lane] = *(const f32x4*)(mod + (2 + F.wave) * 1024 + 256 * j + 4 * F.lane); }
        LBAR();
#define GT_(j) MODL[(0 * 4 + (j)) * 64 + F.lane]
#define SHF_(j) MODL[(1 * 4 + (j)) * 64 + F.lane]
#define SCF_(j) MODL[(2 * 4 + (j)) * 64 + F.lane]
        float rb0, rb1;
        { const int c0_ = F.tid % 48, c1_ = (F.tid + NTHR) % 48; rb0 = (c0_ < 4) ? in[I_BGRP][l * 4 + c0_] : (c0_ < 36 ? in[I_BEXP][l * 32 + (c0_ - 4)] : 0.f); rb1 = (c1_ < 4) ? in[I_BGRP][l * 4 + c1_] : (c1_ < 36 ? in[I_BEXP][l * 32 + (c1_ - 4)] : 0.f); }
        RowPk xr[2], yr[2];
#pragma unroll
        for (int q = 0; q < 2; ++q) { const int t = tb + 2 * F.wave + q; xr[q] = ld_row_pk(XS + (size_t)t * 1024, F.lane); yr[q] = ld_row_pk(Y16 + (size_t)t * 1024, F.lane); }
        SkB<3> SB; skinny_loadB<3>(F, RTH, RTL, SB);
        for (int r = 0; r < 8; ++r) {
#pragma unroll
            for (int q = 0; q < 2; ++q) {
                const int i = 2 * F.wave + q, t = tb + 16 * r + i;
                const Row y = unpk_row(yr[q]), xq = unpk_row_h(xr[q]); Row u;
#pragma unroll
                for (int j = 0; j < 4; ++j) u.v[j] = ALPHA * xq.v[j] + (1.0f + GT_(j)) * y.v[j];
                const Row x1 = row_ln(u, lng, lnb);
                if (!DRY) st_row_h(XS + (size_t)t * 1024, F.lane, x1);
                Row h;
#pragma unroll
                for (int j = 0; j < 4; ++j) h.v[j] = x1.v[j] * (1.0f + SCF_(j)) + SHF_(j);
                const RowPk hp = split_row(h, AH + i * APITCH, AL + i * APITCH, F.lane);
#pragma unroll
                for (int j = 0; j < 4; ++j) { if (!DRY) __builtin_nontemporal_store(hp.v[j], (u32x2*)(Hb + (size_t)t * 1024 + 256 * j + 4 * F.lane)); }
            }
#if defined(TOKA_PROBE) && TOKA_PROBE == 2
            if (DRY) { if (r < 7) {
#pragma unroll
                for (int q = 0; q < 2; ++q) { const int t = tb + 16 * (r + 1) + 2 * F.wave + q; xr[q] = ld_row_pk(XS + (size_t)t * 1024, F.lane); yr[q] = ld_row_pk(Y16 + (size_t)t * 1024, F.lane); } }
                LBAR(); continue; }
#endif
            if (r < 7) {
#pragma unroll
                for (int q = 0; q < 2; ++q) { const int t = tb + 16 * (r + 1) + 2 * F.wave + q; xr[q] = ld_row_pk(XS + (size_t)t * 1024, F.lane); yr[q] = ld_row_pk(Y16 + (size_t)t * 1024, F.lane); }
            }
            LBAR();
            skinny_mma<3>(F, AH, AL, SB, part);
            LBAR();
#pragma unroll
            for (int oo = 0; oo < 2; ++oo) { const int o = F.tid + NTHR * oo; if (o < 16 * 48) { const int i = o / 48, c = o % 48; float sm = 0.f;
#pragma unroll
                for (int w = 0; w < 8; ++w) sm += part[(w * 16 + i) * 48 + c];
                lgt[o] = sm + (oo ? rb1 : rb0); } }
            LBAR();
            if (F.tid < 16) {
                const int i = F.tid, t = tb + 16 * r + i; const LAS float* lg = lgt + i * 48;
                const f32x4 lg4 = *(const LAS f32x4*)lg;
                int gs = 0; float gm = lg4[0];
#pragma unroll
                for (int c = 1; c < 4; ++c) if (lg4[c] > gm) { gm = lg4[c]; gs = c; }
                float den = 0.f;
#pragma unroll
                for (int c = 0; c < 4; ++c) den += __expf(lg4[c] - gm);
                const float pg = 1.0f / den;
                const f32x4 le0 = *(const LAS f32x4*)(lg + 4 + gs * 8), le1 = *(const LAS f32x4*)(lg + 8 + gs * 8);
                const float le[8] = {le0[0], le0[1], le0[2], le0[3], le1[0], le1[1], le1[2], le1[3]};
                int i0 = 0; float m0 = le[0];
#pragma unroll
                for (int c = 1; c < 8; ++c) if (le[c] > m0) { m0 = le[c]; i0 = c; }
                int i1 = -1; float m1 = -3.0e38f;
#pragma unroll
                for (int c = 0; c < 8; ++c) if (c != i0 && le[c] > m1) { m1 = le[c]; i1 = c; }
                const float a = __expf(m1 - m0), g0 = pg / (1.0f + a), g1 = pg * a / (1.0f + a);
                const int e0 = gs * 8 + i0, e1 = gs * 8 + i1;
                const unsigned r0 = atomicAdd((unsigned*)&lcnt[e0], 1u), r1 = atomicAdd((unsigned*)&lcnt[e1], 1u);
                ltab[(16 * r + i) * 2] = ((unsigned)e0 << 24) | r0; ltab[(16 * r + i) * 2 + 1] = ((unsigned)e1 << 24) | r1;
                if (!DRY) { gates[(size_t)t * 2] = g0; gates[(size_t)t * 2 + 1] = g1; }
            }
        }
        LBAR();
        if (F.tid < 32) lcnt[32 + F.tid] = DRY ? 0u : __hip_atomic_fetch_add((unsigned*)(F.ws + WS_CTL) + CW_CNT + l * 32 + F.tid, lcnt[F.tid], __ATOMIC_RELAXED, __HIP_MEMORY_SCOPE_AGENT);
        LBAR();
        if (F.tid < 256 && !DRY) { const unsigned w = ltab[F.tid]; const unsigned e = w >> 24; const unsigned rk = (w & 0xffffffu) + lcnt[32 + e]; asg[(size_t)tb * 2 + F.tid] = (int)((e << 24) | rk);
            ((int*)(F.ws + WS_TLIST))[(size_t)e * 65536 + rk] = tb + (F.tid >> 1); }
        LBAR();
    }
}
#undef GT_
#undef SHF_
#undef SCF_
__device__ __forceinline__ void fgate_phase(Frame& F) {
    const InTab in = F.in;
    const bf16_t* WFH = (const bf16_t*)(F.ws + WS_WF); const bf16_t* WFL = WFH + 16 * 1024; float* LF = (float*)(F.ws + WS_LF); const bf16_t* XS = (const bf16_t*)(F.ws + WS_XS);
    LAS float* part = (LAS float*)(F.lds + 8192);
    LAS bf16_t* AH = (LAS bf16_t*)(F.lds + 32768); LAS bf16_t* AL = AH + 16 * APITCH;
    for (int blk = F.bid; blk < T / 128; blk += F.G) {
        const int tb = blk * 128, b = tb / SEQ;
        const float* kvm = (const float*)(F.ws + WS_KVMOD) + (size_t)b * 2048;
        const Row ksh = ld_row_f32(kvm, F.lane), ksc = ld_row_f32(kvm + 1024, F.lane);
        RowPk xr[2];
#pragma unroll
        for (int q = 0; q < 2; ++q) xr[q] = ld_row_pk(XS + (size_t)(tb + 2 * F.wave + q) * 1024, F.lane);
        SkB<1> SBF; skinny_loadB<1>(F, WFH, WFL, SBF);
        LBAR();
        for (int r = 0; r < 8; ++r) {
#pragma unroll
            for (int q = 0; q < 2; ++q) { const int i = 2 * F.wave + q; Row hk; const Row xq = unpk_row_h(xr[q]);
#pragma unroll
                for (int j = 0; j < 4; ++j) hk.v[j] = xq.v[j] * (1.0f + ksc.v[j]) + ksh.v[j];
                (void)split_row(hk, AH + i * APITCH, AL + i * APITCH, F.lane); }
            if (r < 7) {
#pragma unroll
                for (int q = 0; q < 2; ++q) xr[q] = ld_row_pk(XS + (size_t)(tb + 16 * (r + 1) + 2 * F.wave + q) * 1024, F.lane);
            }
            LBAR();
            skinny_mma<1>(F, AH, AL, SBF, part);
            LBAR();
            if (F.tid < 256) { const int i = F.tid >> 4, c = F.tid & 15; float sm = 0.f;
#pragma unroll
                for (int w = 0; w < 8; ++w) sm += part[(w * 16 + i) * 48 + c];
                const float z = sm + in[I_KVFB][c]; LF[(size_t)(tb + 16 * r + i) * 16 + c] = fminf(z, 0.f) - log1pf(__expf(-fabsf(z))); }
        }
        LBAR();
    }
}

template <bool DRY = false>
__device__ __forceinline__ void tok_b(Frame& F, int l, int next) {
    const InTab in = F.in;
    bf16_t* Hb = (bf16_t*)(F.ws + WS_H2); bf16_t* HK = (bf16_t*)(F.ws + WS_RA); bf16_t* XS = (bf16_t*)(F.ws + WS_XS);
    const bf16_t* YM = (const bf16_t*)(F.ws + WS_RA + 144 * MiB);
    const int* asg = (const int*)(F.ws + WS_ASG); const float* gates = (const float*)(F.ws + WS_GATE); const LAS int* lc = (const LAS int*)(F.lds + MOE_LC_OFF);
    const Row lng = ld_row_f32(in[I_LNG] + (size_t)(l * 2 + 1) * 1024, F.lane), lnb = ld_row_f32(in[I_LNB] + (size_t)(l * 2 + 1) * 1024, F.lane);
    const int gw = F.bid * NWAVES + F.wave, NGW = F.G * NWAVES;
    for (int run = gw; run < T / 8; run += NGW) {
        const int t0 = run * 8, b = t0 / SEQ;
        const Row gt = ld_row_f32((const float*)(F.ws + WS_MOD) + ((size_t)l * 8 + b) * 6144 + 5 * 1024, F.lane);
        Row shm, scm;
        if (next < 3) { const float* modn = (const float*)(F.ws + WS_MOD) + ((size_t)(l + 1) * 8 + b) * 6144; shm = ld_row_f32(modn, F.lane); scm = ld_row_f32(modn + 1024, F.lane); }
        else { shm = Row{}; scm = Row{}; }
        int dmine = 0; float gmine = 0.f;
        if (F.lane < 16) { const unsigned a = (unsigned)asg[(size_t)t0 * 2 + F.lane]; dmine = lc[32 + (a >> 24)] + (int)(a & 0xffffffu); gmine = gates[(size_t)t0 * 2 + F.lane]; }
        RowPk xc = ld_row_pk(XS + (size_t)t0 * 1024, F.lane);
        RowPk y0c = ld_row_pk(YM + (size_t)__shfl(dmine, 0) * 1024, F.lane), y1c = ld_row_pk(YM + (size_t)__shfl(dmine, 1) * 1024, F.lane);
        for (int tt = 0; tt < 8; ++tt) {
            const int t = t0 + tt, tn = (tt < 7) ? tt + 1 : tt;
            const RowPk xn = ld_row_pk(XS + (size_t)(t0 + tn) * 1024, F.lane);
            const RowPk y0n = ld_row_pk(YM + (size_t)__shfl(dmine, 2 * tn) * 1024, F.lane), y1n = ld_row_pk(YM + (size_t)__shfl(dmine, 2 * tn + 1) * 1024, F.lane);
            const float g0 = __shfl(gmine, 2 * tt), g1 = __shfl(gmine, 2 * tt + 1);
            const Row y0 = unpk_row(y0c), y1 = unpk_row(y1c), xq = unpk_row_h(xc); Row u;
#pragma unroll
            for (int j = 0; j < 4; ++j) u.v[j] = ALPHA * xq.v[j] + (1.0f + gt.v[j]) * (g0 * y0.v[j] + g1 * y1.v[j]);
            const Row x2 = row_ln(u, lng, lnb);
            if (!DRY) { if (l == 3) st_row_f32(F.xs + (size_t)t * 1024, F.lane, x2); else st_row_h(XS + (size_t)t * 1024, F.lane, x2); } else asm volatile("" :: "v"(x2.v[0]), "v"(x2.v[1]), "v"(x2.v[2]), "v"(x2.v[3]));
            if (next != 3) {
                Row h;
#pragma unroll
                for (int j = 0; j < 4; ++j) h.v[j] = x2.v[j] * (1.0f + scm.v[j]) + shm.v[j];
                if (!DRY) st_row_bf16(Hb + (size_t)t * 1024, F.lane, h); else asm volatile("" :: "v"(h.v[0]), "v"(h.v[3]));
                if (next == 1) {
                    const float* kvm = (const float*)(F.ws + WS_KVMOD) + (size_t)b * 2048;
                    const Row ksh = ld_row_f32(kvm, F.lane), ksc = ld_row_f32(kvm + 1024, F.lane); Row hk;
#pragma unroll
                    for (int j = 0; j < 4; ++j) hk.v[j] = x2.v[j] * (1.0f + ksc.v[j]) + ksh.v[j];
                    if (!DRY) st_row_bf16(HK + (size_t)t * 1024, F.lane, hk); else asm volatile("" :: "v"(hk.v[0]), "v"(hk.v[3]));
                }
            }
            xc = xn; y0c = y0n; y1c = y1n;
        }
    }
}

__device__ __forceinline__ void rw_prep(Frame& F, int ln, bool from_input) {
    bf16_t* Hb = (bf16_t*)(F.ws + WS_H2); bf16_t* X3 = (bf16_t*)(F.ws + WS_SC);
    const float* src = F.in[I_X]; bf16_t* XS = (bf16_t*)(F.ws + WS_XS);
    const float* mu = F.in[I_MU] + (size_t)ln * 6 * 1024;
    const Row mur = ld_row_f32(mu, F.lane), muk = ld_row_f32(mu + 2 * 1024, F.lane), muv = ld_row_f32(mu + 3 * 1024, F.lane);
    const int gw = F.bid * NWAVES + F.wave, NGW = F.G * NWAVES;
    for (int run = gw; run < T / 8; run += NGW) {
        const int t0 = run * 8, b = t0 / SEQ;
        const float* modn = (const float*)(F.ws + WS_MOD) + ((size_t)ln * 8 + b) * 6144;
        const Row shm = ld_row_f32(modn, F.lane), scm = ld_row_f32(modn + 1024, F.lane);
        Row hprev;
#pragma unroll
        for (int j = 0; j < 4; ++j) hprev.v[j] = (f32x4){0.f, 0.f, 0.f, 0.f};
        if ((t0 % SEQ) != 0) {
            const Row xp = from_input ? ld_row_f32(src + (size_t)(t0 - 1) * 1024, F.lane) : unpk_row_h(ld_row_pk(XS + (size_t)(t0 - 1) * 1024, F.lane));
#pragma unroll
            for (int j = 0; j < 4; ++j) hprev.v[j] = xp.v[j] * (1.0f + scm.v[j]) + shm.v[j];
        }
        Row xc = Row{}; RowPk xcp = RowPk{};
        if (from_input) xc = ld_row_f32(src + (size_t)t0 * 1024, F.lane); else xcp = ld_row_pk(XS + (size_t)t0 * 1024, F.lane);
        for (int tt = 0; tt < 8; ++tt) {
            const int t = t0 + tt, tnx = t0 + (tt < 7 ? tt + 1 : tt);
            const Row x = from_input ? xc : unpk_row_h(xcp);
            if (from_input) xc = ld_row_f32(src + (size_t)tnx * 1024, F.lane); else xcp = ld_row_pk(XS + (size_t)tnx * 1024, F.lane);
            if (from_input) st_row_h(XS + (size_t)t * 1024, F.lane, x);
            Row h, xx, xr, xk, xv;
#pragma unroll
            for (int j = 0; j < 4; ++j) { h.v[j] = x.v[j] * (1.0f + scm.v[j]) + shm.v[j]; xx.v[j] = hprev.v[j] - h.v[j];
                xr.v[j] = h.v[j] + xx.v[j] * mur.v[j]; xk.v[j] = h.v[j] + xx.v[j] * muk.v[j]; xv.v[j] = h.v[j] + xx.v[j] * muv.v[j]; }
            st_row_bf16(Hb + (size_t)t * 2048, F.lane, h); st_row_bf16(Hb + (size_t)t * 2048 + 1024, F.lane, xx);
            st_row_bf16(X3 + (size_t)t * 1024, F.lane, xr); st_row_bf16(X3 + X3S + (size_t)t * 1024, F.lane, xk); st_row_bf16(X3 + 2 * X3S + (size_t)t * 1024, F.lane, xv);
            hprev = h;
        }
    }
}

__device__ __forceinline__ void moe_tables(Frame& F, int l) {
    LAS int* lc = (LAS int*)(F.lds + MOE_LC_OFF);
    const unsigned* cnt = (const unsigned*)(F.ws + WS_CTL) + CW_CNT + l * 32;
    if (F.tid == 0) {
        int acc = 0, ntt = 0;
        for (int e = 0; e < 32; ++e) { const int c = (int)__hip_atomic_load(cnt + e, __ATOMIC_RELAXED, __HIP_MEMORY_SCOPE_AGENT); lc[e] = c; lc[32 + e] = acc; const int nt = (c + 255) >> 8;
            for (int i = 0; i < nt; ++i) lc[96 + ntt + i] = (e << 16) | i;
            ntt += nt; acc += nt << 8; }
        lc[64] = ntt;
    }
    __syncthreads();
}
template <class Sched> __device__ __forceinline__ void moe_rows(Frame& F, const Sched& S) {
    const LAS int* lc = (const LAS int*)(F.lds + MOE_LC_OFF); LAS int* tokL = (LAS int*)(F.lds + MOE_TOKL_OFF); const int* tlist = (const int*)(F.ws + WS_TLIST);
    Unit u;
    for (int i = 0; i < 6 && S.next(i, u); ++i) {
        if (F.tid < 256) { const int ek = lc[96 + u.pm], e = ek >> 16, rank = ((ek & 0xffff) << 8) + F.tid;
            tokL[i * 256 + F.tid] = tlist[(size_t)e * 65536 + (rank < lc[e] ? rank : 0)]; }
    }
    __syncthreads();
}

__device__ __forceinline__ float octsum(float v) { v += dpp_f<0xB1>(v); v += dpp_f<0x4E>(v); v += dpp_f<0x141>(v); return v; }
constexpr int CP = 72, SLOT = 64 * CP;
#define PX(r_, c_) ((r_) * 64 + (((((c_) >> 3) ^ (((r_) >> 1) & 7))) << 3) + ((c_) & 7))
constexpr size_t WS_MP = WS_SC, WS_QQ = WS_SC + 64 * MiB, WS_NT = WS_SC + 128 * MiB, WS_GL = WS_SC + 192 * MiB;
template <bool SWAP> __device__ __forceinline__ f32x4 tile_mm(const LAS bf16_t* Ap, const LAS bf16_t* Bp, int fr, int fq) {
    const int o0 = PX(fr, 8 * fq), o1 = PX(fr, 8 * fq + 32);
    const bf16x8 a0 = *(const LAS bf16x8*)(Ap + o0), a1 = *(const LAS bf16x8*)(Ap + o1);
    const bf16x8 b0 = *(const LAS bf16x8*)(Bp + o0), b1 = *(const LAS bf16x8*)(Bp + o1);
    f32x4 acc = (f32x4){0.f, 0.f, 0.f, 0.f};
    if (!SWAP) { acc = __builtin_amdgcn_mfma_f32_16x16x32_bf16(a0, b0, acc, 0, 0, 0); acc = __builtin_amdgcn_mfma_f32_16x16x32_bf16(a1, b1, acc, 0, 0, 0); }
    else       { acc = __builtin_amdgcn_mfma_f32_16x16x32_bf16(b0, a0, acc, 0, 0, 0); acc = __builtin_amdgcn_mfma_f32_16x16x32_bf16(b1, a1, acc, 0, 0, 0); }
    return acc;
}
__device__ __forceinline__ void ld8f(const float* p, float (&o)[8]) { const f32x4 a = *(const f32x4*)p, b = *(const f32x4*)(p + 4); o[0] = a[0]; o[1] = a[1]; o[2] = a[2]; o[3] = a[3]; o[4] = b[0]; o[5] = b[1]; o[6] = b[2]; o[7] = b[3]; }
__device__ __forceinline__ void st4_lds(LAS bf16_t* p, f32x4 v) { u32x2 w; w.x = pk2(v[0], v[1]); w.y = pk2(v[2], v[3]); *(LAS u32x2*)p = w; }
__device__ __forceinline__ f32x4 ld4_lds(const LAS bf16_t* p) { const u32x2 w = *(const LAS u32x2*)p; return (f32x4){lo16(w.x), hi16(w.x), lo16(w.y), hi16(w.y)}; }
__device__ __forceinline__ void unpk8(const u32x4 w, float (&o)[8]) { o[0] = lo16(w.x); o[1] = hi16(w.x); o[2] = lo16(w.y); o[3] = hi16(w.y); o[4] = lo16(w.z); o[5] = hi16(w.z); o[6] = lo16(w.w); o[7] = hi16(w.w); }
__device__ __forceinline__ void st8_lds(LAS bf16_t* p, const float (&o)[8]) { u32x4 w; w.x = pk2(o[0], o[1]); w.y = pk2(o[2], o[3]); w.z = pk2(o[4], o[5]); w.w = pk2(o[6], o[7]); *(LAS u32x4*)p = w; }

template <int PROBE = 0>
__device__ __forceinline__ void wkv_chunk_prep(Frame& F, int l) {
    const InTab in = F.in;
    const bf16_t* RKV = (const bf16_t*)(F.ws + WS_RA);
    bf16_t* YS = (bf16_t*)(F.ws + WS_Y16); bf16_t* MP = (bf16_t*)(F.ws + WS_MP); bf16_t* QQ = (bf16_t*)(F.ws + WS_QQ); bf16_t* NTt = (bf16_t*)(F.ws + WS_NT); float* GLB = (float*)(F.ws + WS_GL);
    LAS bf16_t* L0 = (LAS bf16_t*)F.lds;
#define SL(n) (L0 + (n) * 4096)
    LAS float* WLs = (LAS float*)(F.lds + 8 * 8192);
    LAS float* HC = WLs + 64 * 68;
    const int pt = F.tid >> 3, pc0 = 8 * (F.tid & 7);
    const bf16_t* LAg = (const bf16_t*)(F.ws + WS_RA + 192 * MiB); const bf16_t* VFg = (const bf16_t*)(F.ws + WS_P); float* BON = (float*)(F.ws + WS_LF);
    const bf16_t* W2T = (const bf16_t*)(F.ws + WS_LORA2 + (size_t)l * MiB + L2_W2T); const bf16_t* A2T = (const bf16_t*)(F.ws + WS_LORA2 + (size_t)l * MiB + L2_A2T); const bf16_t* V2T = (const bf16_t*)(F.ws + WS_LORA2 + (size_t)l * MiB + L2_V2T);
    u32x4 gr, gk, gv, glw, gla, glv, gvf, gw2, ga2, gv2;
#define PREP_LOAD(uu) do { const int bh_ = (uu) >> 6, c_ = (uu) & 63; const size_t row = (size_t)(bh_ >> 4) * SEQ + 64 * c_ + pt; const int hh = (bh_ & 15) * 64, hc = hh + pc0; \
        gr = *(const u32x4*)(RKV + row * 3072 + hc); gk = *(const u32x4*)(RKV + row * 3072 + 1024 + hc); gv = (l == 0) ? *(const u32x4*)(VFg + row * 1024 + hc) : *(const u32x4*)(RKV + row * 3072 + 2048 + hc); \
        glw = *(const u32x4*)(LAg + row * LAW + pc0); gla = *(const u32x4*)(LAg + row * LAW + 64 + pc0); \
        gw2 = *(const u32x4*)(W2T + (size_t)(hh + pt) * 64 + pc0); ga2 = *(const u32x4*)(A2T + (size_t)(hh + pt) * 64 + pc0); \
        if (l == 1) { glv = *(const u32x4*)(LAg + row * LAW + 288 + (pc0 & 31)); gvf = *(const u32x4*)(VFg + row * 1024 + hc); gv2 = *(const u32x4*)(V2T + (size_t)(hh + pt) * 64 + pc0); } \
        if (F.tid < 96) { const int vec_ = F.tid >> 4; const float* hp_ = (vec_ == 0) ? in[I_W0] + l * 1024 : (vec_ == 1) ? in[I_A0] + l * 1024 : (vec_ == 2) ? in[I_V0] : (vec_ == 3) ? in[I_KK] + l * 1024 : (vec_ == 4) ? in[I_KA] + l * 1024 : in[I_RK] + l * 1024; \
            ghc = *(const f32x4*)(hp_ + hh + 4 * (F.tid & 15)); } } while (0)
    glv = (u32x4){0u, 0u, 0u, 0u}; gvf = glv; gv2 = glv;
    f32x4 ghc = (f32x4){0.f, 0.f, 0.f, 0.f};
    if (F.bid < 128 * 64) PREP_LOAD(F.bid);
    for (int u = F.bid; u < 128 * 64; u += F.G) {
        const int bh = u >> 6, c = u & 63, b = bh >> 4, h = bh & 15;
        const size_t row0 = (size_t)b * SEQ + 64 * c;
        int ln_ = F.lane; asm volatile("" : "+v"(ln_));
        const int fr = ln_ & 15, fq = ln_ >> 4;
        *(LAS u32x4*)(SL(0) + PX(pt, pc0)) = glw; *(LAS u32x4*)(SL(1) + PX(pt, pc0)) = gla; *(LAS u32x4*)(SL(3) + PX(pt, pc0)) = gw2; *(LAS u32x4*)(SL(4) + PX(pt, pc0)) = ga2;
        if (l == 1) { *(LAS u32x4*)(SL(2) + PX(pt, pc0)) = (pc0 < 32) ? glv : (u32x4){0u, 0u, 0u, 0u}; *(LAS u32x4*)(SL(5) + PX(pt, pc0)) = gv2; }
        if (F.tid < 96) *(LAS f32x4*)(HC + (F.tid >> 4) * 64 + 4 * (F.tid & 15)) = ghc;
        LBAR();
        {
            f32x4 zw[2], za[2], zv[2];
#pragma unroll
            for (int i = 0; i < 2; ++i) { const int tile = F.wave + 8 * i, mt = tile >> 2, nt = tile & 3;
                zw[i] = tile_mm<false>(SL(0) + 16 * mt * 64, SL(3) + 16 * nt * 64, fr, fq);
                za[i] = tile_mm<true>(SL(1) + 16 * mt * 64, SL(4) + 16 * nt * 64, fr, fq);
                if (l == 1) zv[i] = tile_mm<true>(SL(2) + 16 * mt * 64, SL(5) + 16 * nt * 64, fr, fq); }
#pragma unroll
            for (int i = 0; i < 2; ++i) { const int tile = F.wave + 8 * i, mt = tile >> 2, nt = tile & 3; const int rr = 16 * mt + fr, cc = 16 * nt + 4 * fq;
                const float w0s = HC[16 * nt + fr]; const f32x4 a0v = *(const LAS f32x4*)(HC + 64 + cc); f32x4 av, wh, wlo;
#pragma unroll
                for (int q = 0; q < 4; ++q) { const float wl_ = -0.6065306597126334f * sigmoidf_(zw[i][q] + w0s); wh[q] = bf2f((unsigned short)f2bf(wl_)); wlo[q] = wl_ - wh[q]; av[q] = sigmoidf_(za[i][q] + a0v[q]); }
                st4_lds(SL(11) + PX(16 * nt + fr, 16 * mt + 4 * fq), wh); st4_lds(SL(12) + PX(16 * nt + fr, 16 * mt + 4 * fq), wlo);
                st4_lds(SL(6) + PX(rr, cc), av);
                if (l == 1) { const f32x4 v0v = *(const LAS f32x4*)(HC + 128 + cc); f32x4 sv;
#pragma unroll
                    for (int q = 0; q < 4; ++q) sv[q] = sigmoidf_(zv[i][q] + v0v[q]);
                    st4_lds(SL(7) + PX(rr, cc), sv); } }
        }
        LBAR();
        float r[8], k[8], v[8], a[8];
        unpk8(gr, r); unpk8(gk, k); unpk8(gv, v); unpk8(*(const LAS u32x4*)(SL(6) + PX(pt, pc0)), a);
        if (l == 1) { float sv[8], vf[8]; unpk8(*(const LAS u32x4*)(SL(7) + PX(pt, pc0)), sv); unpk8(gvf, vf);
#pragma unroll
            for (int q = 0; q < 8; ++q) v[q] = bf2f((unsigned short)f2bf(v[q] + (vf[q] - v[q]) * sv[q]));
            if (PROBE == 0) { u32x4 w; w.x = pk2(v[0], v[1]); w.y = pk2(v[2], v[3]); w.z = pk2(v[4], v[5]); w.w = pk2(v[6], v[7]); *(u32x4*)((bf16_t*)RKV + (row0 + pt) * 3072 + 2048 + h * 64 + pc0) = w; } }
        {
            f32x4 cs[2];
#pragma unroll
            for (int i = 0; i < 2; ++i) { const int tile = F.wave + 8 * i, mt = tile >> 2, nt = tile & 3;
                bf16x8 l0, l1;
#pragma unroll
                for (int e = 0; e < 8; ++e) { l0[e] = (short)((8 * fq + e <= 16 * mt + fr) ? 0x3F80 : 0); l1[e] = (short)((32 + 8 * fq + e <= 16 * mt + fr) ? 0x3F80 : 0); }
                const int c0_ = PX(16 * nt + fr, 8 * fq), c1_ = PX(16 * nt + fr, 8 * fq + 32); const LAS bf16_t* bh = SL(11); const LAS bf16_t* bl = SL(12);
                f32x4 acc = (f32x4){0.f, 0.f, 0.f, 0.f};
                acc = __builtin_amdgcn_mfma_f32_16x16x32_bf16(*(const LAS bf16x8*)(bh + c0_), l0, acc, 0, 0, 0); acc = __builtin_amdgcn_mfma_f32_16x16x32_bf16(*(const LAS bf16x8*)(bh + c1_), l1, acc, 0, 0, 0);
                acc = __builtin_amdgcn_mfma_f32_16x16x32_bf16(*(const LAS bf16x8*)(bl + c0_), l0, acc, 0, 0, 0); acc = __builtin_amdgcn_mfma_f32_16x16x32_bf16(*(const LAS bf16x8*)(bl + c1_), l1, acc, 0, 0, 0);
                cs[i] = acc; }
#pragma unroll
            for (int i = 0; i < 2; ++i) { const int tile = F.wave + 8 * i, mt = tile >> 2, nt = tile & 3; const int rr = 16 * mt + fr, cc = 16 * nt + 4 * fq;
                *(LAS f32x4*)(WLs + rr * 68 + cc) = cs[i]; }
        }
        LBAR();
        {
            float kkw[8], kaw[8], rkw[8], cumv[8], clv[8], cexv[8];
#pragma unroll
            for (int q4 = 0; q4 < 2; ++q4) { const f32x4 a_ = *(const LAS f32x4*)(HC + 192 + pc0 + 4 * q4), b_ = *(const LAS f32x4*)(HC + 256 + pc0 + 4 * q4), c_ = *(const LAS f32x4*)(HC + 320 + pc0 + 4 * q4);
                const f32x4 d_ = *(const LAS f32x4*)(WLs + pt * 68 + pc0 + 4 * q4), e_ = *(const LAS f32x4*)(WLs + 63 * 68 + pc0 + 4 * q4), f_ = (pt > 0) ? *(const LAS f32x4*)(WLs + (pt - 1) * 68 + pc0 + 4 * q4) : (f32x4){0.f, 0.f, 0.f, 0.f};
#pragma unroll
                for (int q = 0; q < 4; ++q) { kkw[4 * q4 + q] = a_[q]; kaw[4 * q4 + q] = b_[q]; rkw[4 * q4 + q] = c_[q]; cumv[4 * q4 + q] = d_[q]; clv[4 * q4 + q] = e_[q]; cexv[4 * q4 + q] = f_[q]; } }
            float kr[8], ss = 0.f, bs = 0.f;
#pragma unroll
            for (int q = 0; q < 8; ++q) { kr[q] = k[q] * kkw[q]; ss += kr[q] * kr[q]; }
            ss = octsum(ss);
            const float inv = 1.0f / fmaxf(sqrtf(ss), 1e-12f);
            float At[8], Rt[8], Bt[8], Kt[8], Bb[8], Kb[8], gl[8];
#pragma unroll
            for (int q = 0; q < 8; ++q) {
                const float cum = cumv[q], cl = clv[q], cex = cexv[q];
                const float e_in = __expf(cum), e_ex = __expf(cex), e_ng = __expf(-cum); gl[q] = __expf(cl);
                const float kk = kr[q] * inv, kp = k[q] * (1.0f + (a[q] - 1.0f) * kaw[q]); bs += r[q] * kp * rkw[q];
                At[q] = -kk * e_ex; Rt[q] = r[q] * e_in; Bt[q] = kk * a[q] * e_ng; Kt[q] = kp * e_ng; Bb[q] = Bt[q] * gl[q]; Kb[q] = Kt[q] * gl[q];
            }
            st8_lds(SL(0) + PX(pt, pc0), At); st8_lds(SL(1) + PX(pt, pc0), Rt); st8_lds(SL(2) + PX(pt, pc0), Bt); st8_lds(SL(3) + PX(pt, pc0), Kt);
            st8_lds(SL(11) + PX(pt, pc0), v); st8_lds(SL(12) + PX(pt, pc0), Bb); st8_lds(SL(13) + PX(pt, pc0), Kb);
            bs = octsum(bs); if ((F.tid & 7) == 0 && PROBE == 0) BON[(row0 + pt) * 16 + h] = bs;
            if (pt == 0 && PROBE == 0) { float* g = GLB + (size_t)u * 64 + pc0; *(f32x4*)g = (f32x4){gl[0], gl[1], gl[2], gl[3]}; *(f32x4*)(g + 4) = (f32x4){gl[4], gl[5], gl[6], gl[7]}; }
        }
        LBAR();
        {
            const int j = F.tid & 63, t0 = 8 * (F.tid >> 6);
#define TRANSP(src, dst) do { float e[8]; _Pragma("unroll") for (int q = 0; q < 8; ++q) e[q] = bf2f(SL(src)[PX(t0 + q, j)]); st8_lds(SL(dst) + PX(j, t0), e); } while (0)
            TRANSP(0, 6); TRANSP(12, 7); TRANSP(13, 5); TRANSP(11, 4);
#undef TRANSP
            if (u + F.G < 128 * 64) PREP_LOAD(u + F.G);
        }
        LBAR();
        if (PROBE == 1) continue;
        {
            f32x4 acc[8];
#pragma unroll
            for (int i = 0; i < 8; ++i) acc[i] = tile_mm<true>(SL(0) + 16 * i * 64, SL(2) + 16 * F.wave * 64, fr, fq);
            const int nt = F.wave, sq0 = (nt & 3) * 16 + 4 * fq;
#pragma unroll
            for (int i = 0; i < 8; ++i) {
                const int mt = i, tq = (mt & 3) * 16 + fr; f32x4 o;
#pragma unroll
                for (int q = 0; q < 4; ++q) { const int sq = sq0 + q; const bool keep = (mt < 4) ? (sq < tq) : (sq <= tq); o[q] = keep ? acc[i][q] : 0.f; }
                LAS bf16_t* dst = (mt < 4) ? ((nt < 4) ? SL(8) : SL(10)) : ((nt < 4) ? SL(11) : SL(12));
                st4_lds(dst + PX(tq, sq0), o);
                if (mt < 4 && nt < 4) {
#pragma unroll
                    for (int q = 0; q < 4; ++q) SL(9)[PX(sq0 + q, tq)] = (bf16_t)f2bf(o[q]); }
            }
        }
        LBAR();
        {
            f32x4 x[2], y1[2], nk[2];
#pragma unroll
            for (int i = 0; i < 2; ++i) { const int tile = F.wave + 8 * i, mt = tile >> 2, nt = tile & 3;
                x[i] = tile_mm<false>(SL(10) + 16 * mt * 64, SL(4) + 16 * nt * 64, fr, fq);
                y1[i] = tile_mm<true>(SL(12) + 16 * mt * 64, SL(4) + 16 * nt * 64, fr, fq);
                nk[i] = tile_mm<false>(SL(5) + 16 * mt * 64, SL(4) + 16 * nt * 64, fr, fq); }
#pragma unroll
            for (int i = 0; i < 2; ++i) { const int tile = F.wave + 8 * i, mt = tile >> 2, nt = tile & 3;
                st4_lds(SL(2) + PX(16 * nt + fr, 16 * mt + 4 * fq), x[i]);
                st4_lds(SL(3) + PX(16 * mt + fr, 16 * nt + 4 * fq), y1[i]);
                st4_lds(SL(0) + PX(16 * nt + fr, 16 * mt + 4 * fq), nk[i]); }
        }
        LBAR();
        if (PROBE == 2) continue;
#define NEU_SQ(Xn, Xt, On, Ot, WANT_NAT) do { f32x4 s_[2]; \
            _Pragma("unroll") for (int i = 0; i < 2; ++i) { const int tile = F.wave + 8 * i, mt = tile >> 2, nt = tile & 3; s_[i] = tile_mm<true>(SL(Xn) + 16 * mt * 64, SL(Xt) + 16 * nt * 64, fr, fq); } \
            _Pragma("unroll") for (int i = 0; i < 2; ++i) { const int tile = F.wave + 8 * i, mt = tile >> 2, nt = tile & 3; \
                if (WANT_NAT) st4_lds(SL(On) + PX(16 * mt + fr, 16 * nt + 4 * fq), s_[i]); \
                _Pragma("unroll") for (int q = 0; q < 4; ++q) SL(Ot)[PX(16 * nt + 4 * fq + q, 16 * mt + fr)] = (bf16_t)f2bf(s_[i][q]); } } while (0)
#define NEU_PR(Ti, Yt, To) do { f32x4 p_[2]; \
            _Pragma("unroll") for (int i = 0; i < 2; ++i) { const int tile = F.wave + 8 * i, mt = tile >> 2, nt = tile & 3; \
                p_[i] = tile_mm<true>(SL(Ti) + 16 * mt * 64, SL(Yt) + 16 * nt * 64, fr, fq) + ld4_lds(SL(Ti) + PX(16 * mt + fr, 16 * nt + 4 * fq)); } \
            _Pragma("unroll") for (int i = 0; i < 2; ++i) { const int tile = F.wave + 8 * i, mt = tile >> 2, nt = tile & 3; st4_lds(SL(To) + PX(16 * mt + fr, 16 * nt + 4 * fq), p_[i]); } } while (0)
#define NEU_BOTH(Ti, Yt, To, Xn, Xt, On, Ot, WANT_NAT) do { f32x4 p_[2], s_[2]; \
            _Pragma("unroll") for (int i = 0; i < 2; ++i) { const int tile = F.wave + 8 * i, mt = tile >> 2, nt = tile & 3; \
                p_[i] = tile_mm<true>(SL(Ti) + 16 * mt * 64, SL(Yt) + 16 * nt * 64, fr, fq) + ld4_lds(SL(Ti) + PX(16 * mt + fr, 16 * nt + 4 * fq)); \
                s_[i] = tile_mm<true>(SL(Xn) + 16 * mt * 64, SL(Xt) + 16 * nt * 64, fr, fq); } \
            _Pragma("unroll") for (int i = 0; i < 2; ++i) { const int tile = F.wave + 8 * i, mt = tile >> 2, nt = tile & 3; \
                st4_lds(SL(To) + PX(16 * mt + fr, 16 * nt + 4 * fq), p_[i]); \
                if (WANT_NAT) st4_lds(SL(On) + PX(16 * mt + fr, 16 * nt + 4 * fq), s_[i]); \
                _Pragma("unroll") for (int q = 0; q < 4; ++q) SL(Ot)[PX(16 * nt + 4 * fq + q, 16 * mt + fr)] = (bf16_t)f2bf(s_[i][q]); } } while (0)
        NEU_SQ(8, 9, 10, 12, true);
        LBAR();
        {
            f32x4 p_[2];
#pragma unroll
            for (int i = 0; i < 2; ++i) { const int tile = F.wave + 8 * i, mt = tile >> 2, nt = tile & 3; const int rr = 16 * mt + fr, cc = 16 * nt + 4 * fq;
                p_[i] = tile_mm<true>(SL(8) + 16 * mt * 64, SL(12) + 16 * nt * 64, fr, fq) + ld4_lds(SL(8) + PX(rr, cc)) + ld4_lds(SL(10) + PX(rr, cc));
#pragma unroll
                for (int q = 0; q < 4; ++q) if (cc + q == rr) p_[i][q] += 1.0f; }
            NEU_SQ(10, 12, 5, 13, true);
#pragma unroll
            for (int i = 0; i < 2; ++i) { const int tile = F.wave + 8 * i, mt = tile >> 2, nt = tile & 3; st4_lds(SL(4) + PX(16 * mt + fr, 16 * nt + 4 * fq), p_[i]); }
        }
        LBAR();
        NEU_BOTH(4, 13, 8, 5, 13, 9, 10, true);
        LBAR();
        NEU_BOTH(8, 10, 4, 9, 10, 5, 12, true);
        LBAR();
        NEU_BOTH(4, 12, 8, 5, 12, 5, 13, false);
        LBAR();
        NEU_PR(8, 13, 4);
        LBAR();
#undef NEU_SQ
#undef NEU_PR
#undef NEU_BOTH
        if (PROBE == 3) continue;
        {
            f32x4 p[2], u0[2];
#pragma unroll
            for (int i = 0; i < 2; ++i) { const int tile = F.wave + 8 * i, mt = tile >> 2, nt = tile & 3;
                p[i] = tile_mm<false>(SL(4) + 16 * mt * 64, SL(6) + 16 * nt * 64, fr, fq);
                u0[i] = tile_mm<false>(SL(4) + 16 * mt * 64, SL(2) + 16 * nt * 64, fr, fq); }
#pragma unroll
            for (int i = 0; i < 2; ++i) { const int tile = F.wave + 8 * i, mt = tile >> 2, nt = tile & 3;
                st4_lds(SL(9) + PX(16 * nt + fr, 16 * mt + 4 * fq), p[i]); st4_lds(SL(10) + PX(16 * nt + fr, 16 * mt + 4 * fq), u0[i]); }
        }
        LBAR();
        {
            f32x4 qv[2], y0[2], mp[2], ntv[2];
#pragma unroll
            for (int i = 0; i < 2; ++i) { const int tile = F.wave + 8 * i, mt = tile >> 2, nt = tile & 3; const int rr = 16 * mt + fr, cc = 16 * nt + 4 * fq, ri = 16 * nt + fr, cj = 16 * mt + 4 * fq;
                qv[i] = tile_mm<true>(SL(11) + 16 * mt * 64, SL(9) + 16 * nt * 64, fr, fq) + ld4_lds(SL(1) + PX(rr, cc));
                y0[i] = tile_mm<true>(SL(11) + 16 * mt * 64, SL(10) + 16 * nt * 64, fr, fq) + ld4_lds(SL(3) + PX(rr, cc));
                mp[i] = tile_mm<true>(SL(7) + 16 * mt * 64, SL(9) + 16 * nt * 64, fr, fq);
                ntv[i] = tile_mm<false>(SL(7) + 16 * mt * 64, SL(10) + 16 * nt * 64, fr, fq) + ld4_lds(SL(0) + PX(ri, cj)); }
#pragma unroll
            for (int i = 0; i < 2; ++i) { const int tile = F.wave + 8 * i, mt = tile >> 2, nt = tile & 3; const int rr = 16 * mt + fr, cc = 16 * nt + 4 * fq, ri = 16 * nt + fr, cj = 16 * mt + 4 * fq;
                st4_lds(SL(5) + PX(rr, cc), qv[i]); st4_lds(SL(8) + PX(rr, cc), y0[i]); st4_lds(SL(12) + PX(rr, cc), mp[i]); st4_lds(SL(13) + PX(ri, cj), ntv[i]); }
        }
        LBAR();
        if (PROBE == 0) {
            const int rw = F.tid >> 3, ch = 8 * (F.tid & 7);
            __builtin_nontemporal_store(*(const LAS u32x4*)(SL(5) + PX(rw, ch)), (u32x4*)(QQ + ((size_t)u * 64 + rw) * 64 + ch));
            __builtin_nontemporal_store(*(const LAS u32x4*)(SL(12) + PX(rw, ch)), (u32x4*)(MP + ((size_t)u * 64 + rw) * 64 + ch));
            __builtin_nontemporal_store(*(const LAS u32x4*)(SL(13) + PX(rw, ch)), (u32x4*)(NTt + ((size_t)u * 64 + rw) * 64 + ch));
            __builtin_nontemporal_store(*(const LAS u32x4*)(SL(8) + PX(rw, ch)), (u32x4*)(YS + (row0 + rw) * 1024 + h * 64 + ch));
        }
        LBAR();
    }
#undef PREP_LOAD
#undef SL
}

__device__ __forceinline__ void wkv_chunk_seq(Frame& F, int l) {
    bf16_t* YS = (bf16_t*)(F.ws + WS_Y16); const bf16_t* MP = (const bf16_t*)(F.ws + WS_MP); const bf16_t* QQ = (const bf16_t*)(F.ws + WS_QQ); const bf16_t* NTt = (const bf16_t*)(F.ws + WS_NT); const float* GLB = (const float*)(F.ws + WS_GL);
    LAS bf16_t* Zt = (LAS bf16_t*)F.lds;
    const bf16_t* RKVc = (const bf16_t*)(F.ws + WS_RA); const bf16_t* VFc = (const bf16_t*)(F.ws + WS_P); const bf16_t* G16 = (const bf16_t*)(F.ws + WS_RA + 224 * MiB); const float* BON = (const float*)(F.ws + WS_LF); bf16_t* OG = (bf16_t*)(F.ws + WS_H2);
    LAS bf16_t* Yb = Zt + 2 * SLOT;
    const int fr = F.lane & 15, fq = F.lane >> 4, mt = F.wave >> 1, ntb = 2 * (F.wave & 1);
    struct Ops { bf16x8 m0, m1, q0, q1; f32x4 gl; u32x2 n0, n1, y0, y1; };
    for (int item = F.bid; item < 128; item += F.G) {
        const int bh = item, b = bh >> 4, h = bh & 15; const size_t rowb = (size_t)b * SEQ;
        float gng[8], gnb[8]; ld8f(F.in[I_GNG] + l * 1024 + h * 64 + 8 * (F.tid & 7), gng); ld8f(F.in[I_GNB] + l * 1024 + h * 64 + 8 * (F.tid & 7), gnb);
        for (int i = F.tid; i < 2 * SLOT / 2; i += NTHR) ((LAS unsigned*)Zt)[i] = 0u;
        f32x4 Z0 = (f32x4){0.f, 0.f, 0.f, 0.f}, Z1 = Z0;
        LBAR();
#define SEQ_LOAD(O, cc_) do { const size_t cu = (size_t)bh * 64 + (cc_); \
        const bf16_t* mp = MP + (cu * 64 + 16 * mt + fr) * 64 + 8 * fq; O.m0 = *(const bf16x8*)mp; O.m1 = *(const bf16x8*)(mp + 32); \
        const bf16_t* qp = QQ + (cu * 64 + 16 * mt + fr) * 64 + 8 * fq; O.q0 = *(const bf16x8*)qp; O.q1 = *(const bf16x8*)(qp + 32); \
        O.gl = *(const f32x4*)(GLB + cu * 64 + 16 * mt + 4 * fq); \
        const bf16_t* np_ = NTt + (cu * 64 + 16 * ntb + fr) * 64 + 16 * mt + 4 * fq; O.n0 = *(const u32x2*)np_; O.n1 = *(const u32x2*)(np_ + 16 * 64); \
        const bf16_t* yp = YS + (rowb + 64 * (cc_) + 16 * mt + fr) * 1024 + h * 64 + 16 * ntb + 4 * fq; O.y0 = *(const u32x2*)yp; O.y1 = *(const u32x2*)(yp + 16); } while (0)
#define SEQ_STEP(O, cc_) do { const LAS bf16_t* Zc = Zt + ((cc_) & 1) * SLOT; LAS bf16_t* Zn = Zt + (((cc_) + 1) & 1) * SLOT; \
        const LAS bf16_t* z0p = Zc + (16 * ntb + fr) * CP + 8 * fq; const LAS bf16_t* z1p = z0p + 16 * CP; \
        const bf16x8 b00 = *(const LAS bf16x8*)z0p, b01 = *(const LAS bf16x8*)(z0p + 32), b10 = *(const LAS bf16x8*)z1p, b11 = *(const LAS bf16x8*)(z1p + 32); \
        f32x4 a0 = (f32x4){0.f, 0.f, 0.f, 0.f}, a1 = a0, c0 = a0, c1 = a0; \
        a0 = __builtin_amdgcn_mfma_f32_16x16x32_bf16(O.m0, b00, a0, 0, 0, 0); a0 = __builtin_amdgcn_mfma_f32_16x16x32_bf16(O.m1, b01, a0, 0, 0, 0); \
        a1 = __builtin_amdgcn_mfma_f32_16x16x32_bf16(O.m0, b10, a1, 0, 0, 0); a1 = __builtin_amdgcn_mfma_f32_16x16x32_bf16(O.m1, b11, a1, 0, 0, 0); \
        c0 = __builtin_amdgcn_mfma_f32_16x16x32_bf16(b00, O.q0, c0, 0, 0, 0); c0 = __builtin_amdgcn_mfma_f32_16x16x32_bf16(b01, O.q1, c0, 0, 0, 0); \
        c1 = __builtin_amdgcn_mfma_f32_16x16x32_bf16(b10, O.q0, c1, 0, 0, 0); c1 = __builtin_amdgcn_mfma_f32_16x16x32_bf16(b11, O.q1, c1, 0, 0, 0); \
        Z0 = O.gl * Z0 + a0 + (f32x4){lo16(O.n0.x), hi16(O.n0.x), lo16(O.n0.y), hi16(O.n0.y)}; Z1 = O.gl * Z1 + a1 + (f32x4){lo16(O.n1.x), hi16(O.n1.x), lo16(O.n1.y), hi16(O.n1.y)}; \
        { LAS bf16_t* yl = Yb + (((cc_) & 7) * 64 + 16 * mt + fr) * CP + 16 * ntb + 4 * fq; \
          st4_lds(yl, c0 + (f32x4){lo16(O.y0.x), hi16(O.y0.x), lo16(O.y0.y), hi16(O.y0.y)}); st4_lds(yl + 16, c1 + (f32x4){lo16(O.y1.x), hi16(O.y1.x), lo16(O.y1.y), hi16(O.y1.y)}); } \
        st4_lds(Zn + (16 * ntb + fr) * CP + 16 * mt + 4 * fq, Z0); st4_lds(Zn + (16 * ntb + 16 + fr) * CP + 16 * mt + 4 * fq, Z1); \
        LBAR(); \
        if (((cc_) & 7) == 7) { _Pragma("unroll 2") for (int i_ = 0; i_ < 8; ++i_) { const int o_ = F.tid + NTHR * i_, ck_ = o_ >> 9, rw_ = (o_ >> 3) & 63, ch_ = 8 * (o_ & 7); \
            const size_t tr_ = rowb + 64 * ((cc_) - 7 + ck_) + rw_; float y_[8], v_[8], g_[8]; \
            unpk8(*(const LAS u32x4*)(Yb + (ck_ * 64 + rw_) * CP + ch_), y_); unpk8((l == 0) ? *(const u32x4*)(VFc + tr_ * 1024 + h * 64 + ch_) : *(const u32x4*)(RKVc + tr_ * 3072 + 2048 + h * 64 + ch_), v_); unpk8(*(const u32x4*)(G16 + tr_ * 1024 + h * 64 + ch_), g_); \
            const float bs_ = BON[tr_ * 16 + h]; float s_ = 0.f; _Pragma("unroll") for (int q_ = 0; q_ < 8; ++q_) s_ += y_[q_]; s_ = octsum(s_); const float mean_ = s_ * (1.0f / 64.0f); \
            float qq_ = 0.f; _Pragma("unroll") for (int q_ = 0; q_ < 8; ++q_) { const float d_ = y_[q_] - mean_; qq_ += d_ * d_; } qq_ = octsum(qq_); const float rstd_ = 1.0f / sqrtf(qq_ * (1.0f / 64.0f) + GN_EPS); \
            float o8_[8]; _Pragma("unroll") for (int q_ = 0; q_ < 8; ++q_) o8_[q_] = (((y_[q_] - mean_) * rstd_) * gng[q_] + gnb[q_] + bs_ * v_[q_]) * g_[q_]; \
            u32x4 w_; w_.x = pk2(o8_[0], o8_[1]); w_.y = pk2(o8_[2], o8_[3]); w_.z = pk2(o8_[4], o8_[5]); w_.w = pk2(o8_[6], o8_[7]); __builtin_nontemporal_store(w_, (u32x4*)(OG + tr_ * 1024 + h * 64 + ch_)); } LBAR(); } } while (0)
        Ops A, B, C;
        SEQ_LOAD(A, 0); SEQ_LOAD(B, 1);
#pragma unroll 1
        for (int c = 0; c < 63; c += 3) {
            SEQ_LOAD(C, c + 2); SEQ_STEP(A, c);
            SEQ_LOAD(A, c + 3); SEQ_STEP(B, c + 1);
            if (c + 4 < 64) SEQ_LOAD(B, c + 4);
            SEQ_STEP(C, c + 2);
        }
        SEQ_STEP(A, 63);
#undef SEQ_LOAD
#undef SEQ_STEP
    }
}

__device__ __forceinline__ void ld16(const bf16_t* p, float (&o)[16]) {
    const u32x4 a = *(const u32x4*)p, b = *(const u32x4*)(p + 8);
    o[0] = lo16(a.x); o[1] = hi16(a.x); o[2] = lo16(a.y); o[3] = hi16(a.y); o[4] = lo16(a.z); o[5] = hi16(a.z); o[6] = lo16(a.w); o[7] = hi16(a.w);
    o[8] = lo16(b.x); o[9] = hi16(b.x); o[10] = lo16(b.y); o[11] = hi16(b.y); o[12] = lo16(b.z); o[13] = hi16(b.z); o[14] = lo16(b.w); o[15] = hi16(b.w);
}
__device__ __forceinline__ void st16(bf16_t* p, const float (&o)[16]) {
    u32x4 a, b; a.x = pk2(o[0], o[1]); a.y = pk2(o[2], o[3]); a.z = pk2(o[4], o[5]); a.w = pk2(o[6], o[7]); b.x = pk2(o[8], o[9]); b.y = pk2(o[10], o[11]); b.z = pk2(o[12], o[13]); b.w = pk2(o[14], o[15]);
    *(u32x4*)p = a; *(u32x4*)(p + 8) = b;
}
__device__ __forceinline__ void ld16f(const float* p, float (&o)[16]) {
#pragma unroll
    for (int j = 0; j < 4; ++j) { const f32x4 v = *(const f32x4*)(p + 4 * j); o[4 * j] = v[0]; o[4 * j + 1] = v[1]; o[4 * j + 2] = v[2]; o[4 * j + 3] = v[3]; }
}
__device__ __forceinline__ void wkv_post(Frame& F, int l) {
    const InTab in = F.in;
    const bf16_t* RKV = (const bf16_t*)(F.ws + WS_RA); const bf16_t* G16 = (const bf16_t*)(F.ws + WS_RA + 224 * MiB); const float* BON = (const float*)(F.ws + WS_LF);
    const bf16_t* YS = (const bf16_t*)(F.ws + WS_Y16); bf16_t* OG = (bf16_t*)(F.ws + WS_H2);
    const int c0 = 16 * F.lane;
    float gg[16], gb[16];
    ld16f(in[I_GNG] + l * 1024 + c0, gg); ld16f(in[I_GNB] + l * 1024 + c0, gb);
    const int gw = F.bid * NWAVES + F.wave, NGW = F.G * NWAVES;
    for (int t = gw; t < T; t += NGW) {
        float y[16], v[16], g[16];
        ld16(YS + (size_t)t * 1024 + c0, y); ld16(RKV + (size_t)t * 3072 + 2048 + c0, v); ld16(G16 + (size_t)t * 1024 + c0, g);
        const float bs = BON[(size_t)t * 16 + (F.lane >> 2)];
        float s = 0.f;
#pragma unroll
        for (int i = 0; i < 16; ++i) s += y[i];
        s = quadsum(s);
        const float mean = s * (1.0f / 64.0f); float q = 0.f;
#pragma unroll
        for (int i = 0; i < 16; ++i) { const float d = y[i] - mean; q += d * d; }
        q = quadsum(q);
        const float rstd = 1.0f / sqrtf(q * (1.0f / 64.0f) + GN_EPS);
        float o[16];
#pragma unroll
        for (int i = 0; i < 16; ++i) o[i] = (((y[i] - mean) * rstd) * gg[i] + gb[i] + bs * v[i]) * g[i];
        st16(OG + (size_t)t * 1024 + c0, o);
    }
}

__device__ __forceinline__ void kv_post(Frame& F) {
    const InTab in = F.in;
    bf16_t* Kb = (bf16_t*)(F.ws + WS_P); const float* LF = (const float*)(F.ws + WS_LF); float* KBv = (float*)(F.ws + WS_KB);
    const int c0 = 16 * F.lane;
    float kn[16]; ld16f(in[I_KNORM] + (c0 & 63), kn);
    const int gw = F.bid * NWAVES + F.wave, NGW = F.G * NWAVES;
    for (int t = gw; t < T; t += NGW) {
        float k[16]; ld16(Kb + (size_t)t * 1024 + c0, k);
        float s = 0.f;
#pragma unroll
        for (int i = 0; i < 16; ++i) s += k[i] * k[i];
        s = quadsum(s);
        const float rs = 1.0f / sqrtf(s * (1.0f / 64.0f) + QK_EPS);
#pragma unroll
        for (int i = 0; i < 16; ++i) k[i] = k[i] * rs * kn[i];
        st16(Kb + (size_t)t * 1024 + c0, k);
    }
    for (int bh = gw; bh < 128; bh += NGW) {
        const int b = bh >> 4, h = bh & 15; const size_t base = ((size_t)b * SEQ + 64 * F.lane) * 16 + h;
        float s = 0.f;
        for (int i = 0; i < 64; ++i) s += LF[base + (size_t)i * 16];
        float incl = s;
#pragma unroll
        for (int o = 1; o < 64; o <<= 1) { const float n = __shfl_up(incl, o); if (F.lane >= o) incl += n; }
        float run = incl - s;
        float kfirst = 0.f, klast = 0.f;
        for (int i = 0; i < 64; ++i) { run += LF[base + (size_t)i * 16]; const float kbv = -run * LOG2E; KBv[(size_t)bh * SEQ + 64 * F.lane + i] = kbv; if (i == 0) kfirst = kbv; klast = kbv; }
        int* T0 = (int*)(F.ws + WS_T0) + bh * 16;
        for (int qb = 0; qb < 16; ++qb) {
            const float thr = __shfl(kfirst, 4 * qb) - 70.0f;
            const unsigned long long skip = __ballot(klast < thr);
            int t0 = (skip == ~0ull) ? 64 : __builtin_ctzll(~skip); const int nt = 4 * qb + 4;
            t0 &= ~1; if (t0 > nt - 4) t0 = nt - 4;
            if (F.lane == 0) T0[qb] = t0;
        }
    }
}

namespace attn_body {
using bf16=__hip_bfloat16;
using bf16x8=__attribute__((ext_vector_type(8)))short;
using s16x4=__attribute__((ext_vector_type(4)))short;
using f32x16=__attribute__((ext_vector_type(16)))float;
using u32x4=__attribute__((ext_vector_type(4)))unsigned;
constexpr int BATCH=8,NHEAD=16,SEQ=4096,D=64,DM=NHEAD*D;
constexpr int NW=8,QBLK=32,QB=QBLK*NW,KVBLK=64,NQB=SEQ/QB;
constexpr int ATTN_PITCH=DM, ATTN_UNIT_ROWS=QB;
__device__ __forceinline__ int crow(int r,int hi){return (r&3)+8*(r>>2)+4*hi;}
#define SBAR() __builtin_amdgcn_sched_barrier(0)
__device__ __forceinline__ void cmask(f32x16&p0,f32x16&p1,int jb,int qrel,int hi){
  const float NEG=-INFINITY; int kb=64*jb+4*hi;
  #pragma unroll
  for(int r=0;r<16;++r){int kv=kb+(r&3)+8*(r>>2); if(kv>qrel)p0[r]=NEG; if(kv+32>qrel)p1[r]=NEG;}
}

constexpr int NSLOT=3, SLOTB=8192;
constexpr int LDS_K=0, LDS_V=NSLOT*SLOTB, LDS_WS=2*NSLOT*SLOTB, LDS_OST=LDS_WS+NW*64*4, LDS_KBIAS=LDS_OST+NW*4096, LDS_BYTES=LDS_KBIAS+SEQ*4;
constexpr float C2=0.125f*1.4426950408889634f;
__device__ __forceinline__ void glds16(const void*gsrc,unsigned lds_dst){unsigned keep;
  asm volatile("s_mov_b32 %0, m0\n\ts_mov_b32 m0, %2\n\ts_nop 0\n\tglobal_load_lds_dwordx4 %1, off\n\ts_mov_b32 m0, %0":"=&s"(keep):"v"(gsrc),"s"(lds_dst):"memory");}
__device__ __forceinline__ float max3f(float a,float b,float c){float r;asm("v_max3_f32 %0, %1, %2, %3":"=v"(r):"v"(a),"v"(b),"v"(c));return r;}
__device__ __forceinline__ float max2f(float a,float b){float r;asm("v_max_f32_e32 %0, %1, %2":"=v"(r):"v"(a),"v"(b));return r;}
__device__ __forceinline__ float fadd_s(float a,float b){float r;asm("v_add_f32_e32 %0, %1, %2":"=v"(r):"v"(a),"v"(b));return r;}
__device__ __forceinline__ float fsub_s(float a,float b){float r;asm("v_sub_f32_e32 %0, %1, %2":"=v"(r):"v"(a),"v"(b));return r;}
typedef float f32x2_t __attribute__((ext_vector_type(2))); typedef __bf16 bf16x2_t __attribute__((ext_vector_type(2)));
__device__ __forceinline__ unsigned cvtpk_s(float lo,float hi){f32x2_t v={lo,hi};bf16x2_t b=__builtin_convertvector(v,bf16x2_t);return __builtin_bit_cast(unsigned,b);}
#define WAIT_BAR(N) asm volatile("s_waitcnt vmcnt(" #N ") lgkmcnt(0)\n\ts_barrier":::"memory")

__device__ __forceinline__ void qkt(f32x16&p0,f32x16&p1,const char*Kslot,const bf16x8*qr,const f32x16&negm,int r32,int hi){
  const char*kb=Kslot+hi*1024+r32*16;
  #pragma unroll
  for(int d0=0;d0<4;++d0){
    const bf16x8 b0=*reinterpret_cast<const bf16x8*>(kb+d0*2048);
    const bf16x8 b1=*reinterpret_cast<const bf16x8*>(kb+d0*2048+512);
    if(d0==0){p0=__builtin_amdgcn_mfma_f32_32x32x16_bf16(b0,qr[0],negm,0,0,0);p1=__builtin_amdgcn_mfma_f32_32x32x16_bf16(b1,qr[0],negm,0,0,0);}
    else{p0=__builtin_amdgcn_mfma_f32_32x32x16_bf16(b0,qr[d0],p0,0,0,0);p1=__builtin_amdgcn_mfma_f32_32x32x16_bf16(b1,qr[d0],p1,0,0,0);}}
}
typedef __attribute__((address_space(3))) const char* lds_cptr;
typedef short v4i16_t __attribute__((ext_vector_type(4)));
__device__ __forceinline__ void kload8(bf16x8*kf,lds_cptr kp){
  kf[0]=*(const __attribute__((address_space(3))) bf16x8*)(kp);      kf[1]=*(const __attribute__((address_space(3))) bf16x8*)(kp+512);
  kf[2]=*(const __attribute__((address_space(3))) bf16x8*)(kp+2048); kf[3]=*(const __attribute__((address_space(3))) bf16x8*)(kp+2560);
  kf[4]=*(const __attribute__((address_space(3))) bf16x8*)(kp+4096); kf[5]=*(const __attribute__((address_space(3))) bf16x8*)(kp+4608);
  kf[6]=*(const __attribute__((address_space(3))) bf16x8*)(kp+6144); kf[7]=*(const __attribute__((address_space(3))) bf16x8*)(kp+6656);
}
__device__ __forceinline__ void kload2(bf16x8*kf,lds_cptr kp,int j){ kf[2*j]=*(const __attribute__((address_space(3))) bf16x8*)(kp+j*2048); kf[2*j+1]=*(const __attribute__((address_space(3))) bf16x8*)(kp+j*2048+512); }
__device__ __forceinline__ s16x4 vtr(lds_cptr p){ return __builtin_bit_cast(s16x4,__builtin_amdgcn_ds_read_tr16_b64_v4i16((__attribute__((address_space(3))) v4i16_t*)p)); }
__device__ __forceinline__ float rowmax(const f32x16&p0,const f32x16&p1){
  float a=max3f(p0[0],p0[1],p1[0]),b=max3f(p0[2],p0[3],p1[1]);a=max3f(a,p1[2],p1[3]);
  #pragma unroll
  for(int r=4;r<16;r+=4){a=max3f(a,p0[r],p0[r+1]);b=max3f(b,p0[r+2],p0[r+3]);a=max3f(a,p1[r],p1[r+1]);b=max3f(b,p1[r+2],p1[r+3]);}
  const float m=max2f(a,b);
  auto rr=__builtin_amdgcn_permlane32_swap(__float_as_uint(m),__float_as_uint(m),false,false);
  return max2f(__uint_as_float(rr[0]),__uint_as_float(rr[1]));
}
__device__ __forceinline__ void pv(f32x16*o,int vb,bf16x8 pa0,bf16x8 pa1,bf16x8 pa2,bf16x8 pa3){
  #pragma unroll
  for(int d0=0;d0<2;++d0){s16x4 lo[4],hi[4];
    #pragma unroll
    for(int ks=0;ks<4;++ks){
      asm volatile("ds_read_b64_tr_b16 %0,%1 offset:%c2":"=&v"(lo[ks]):"v"(vb),"i"(d0*4096+ks*1024):"memory");
      asm volatile("ds_read_b64_tr_b16 %0,%1 offset:%c2":"=&v"(hi[ks]):"v"(vb),"i"(d0*4096+ks*1024+512):"memory");}
    asm volatile("s_waitcnt lgkmcnt(0)":::"memory");SBAR();
    #define PK(k) (bf16x8){lo[k][0],lo[k][1],lo[k][2],lo[k][3],hi[k][0],hi[k][1],hi[k][2],hi[k][3]}
    o[d0]=__builtin_amdgcn_mfma_f32_32x32x16_bf16(pa0,PK(0),o[d0],0,0,0);
    o[d0]=__builtin_amdgcn_mfma_f32_32x32x16_bf16(pa1,PK(1),o[d0],0,0,0);
    o[d0]=__builtin_amdgcn_mfma_f32_32x32x16_bf16(pa2,PK(2),o[d0],0,0,0);
    o[d0]=__builtin_amdgcn_mfma_f32_32x32x16_bf16(pa3,PK(3),o[d0],0,0,0);
    #undef PK
  }
}

#ifndef ATTN_STORE16
#define ATTN_STORE16(p,v) (*(u32x4*)(p)=(v))
#endif
template<int THRL> __device__ __forceinline__ void attn_unit(int tid,int wid,int b,int h,int qb,int t0,const bf16*Q,const bf16*__restrict__ K,const bf16*__restrict__ V,bf16*O,const bf16*G,const float*kbrow,const float*qnorm,char*shm){
  int lane=tid&63; asm volatile("":"+v"(lane));
  const int r32=lane&31,hi=lane>>5; wid=__builtin_amdgcn_readfirstlane(wid);
  const long rowbase=(long)b*SEQ; const int q0=qb*QB;
  const bf16*Qw=Q+(rowbase+q0+wid*QBLK)*DM+h*D;
  const bf16*Kh=K+(rowbase+(long)t0*KVBLK)*DM+h*D,*Vh=V+(rowbase+(long)t0*KVBLK)*DM+h*D; kbrow+=t0*KVBLK;
  const unsigned lds0=(unsigned)(uintptr_t)shm;
  float*wsf=(float*)(shm+LDS_WS)+wid*64;
  const bf16*ksrc=Kh+(long)lane*DM+wid*8;
  const bf16*vsrc=Vh+(long)(16*(wid&3)+(lane>>2))*DM+(wid>>2)*32+(lane&3)*8;
  const unsigned kdst=lds0+LDS_K+wid*1024, vdst=lds0+LDS_V+wid*1024;
  #define DMA_K(t,slot) glds16(ksrc+(long)(t)*KVBLK*DM,(unsigned)__builtin_amdgcn_readfirstlane(kdst+(slot)))
  #define DMA_V(t,slot) glds16(vsrc+(long)(t)*KVBLK*DM,(unsigned)__builtin_amdgcn_readfirstlane(vdst+(slot)))
  const int vb0=(int)(lds0+LDS_V)+((lane>>4)&1)*32+(lane&3)*8+(4*hi+((lane&15)>>2))*64;
  const char*Kbase=shm+LDS_K; bf16x8 kf[8];
  const lds_cptr shm3=(lds_cptr)shm; const lds_cptr kp0=shm3+LDS_K+hi*1024+r32*16; const lds_cptr vp0=shm3+LDS_V+((lane>>4)&1)*32+(lane&3)*8+(4*hi+((lane&15)>>2))*64;
  const int NT=(q0+QB)/KVBLK-t0;
  typedef float f32x4_t __attribute__((ext_vector_type(4))); typedef __attribute__((address_space(3))) const float* lds_fptr;
  const lds_fptr kbl=(lds_fptr)(shm3+LDS_KBIAS);
  { __attribute__((address_space(3))) f32x4_t* kw=(__attribute__((address_space(3))) f32x4_t*)(shm3+LDS_KBIAS); const f32x4_t* kg=(const f32x4_t*)kbrow;
    for(int i=tid;i<NT*KVBLK/4;i+=NW*64) kw[i]=kg[i]; }
  DMA_K(0,0);DMA_V(0,0);DMA_K(1,SLOTB);
  bf16x8 qr[4];
  #pragma unroll
  for(int d0=0;d0<4;++d0)qr[d0]=*reinterpret_cast<const bf16x8*>(&Qw[(long)r32*DM+d0*16+hi*8]);
  { float qf[4][8]; float ss=0.f;
    #pragma unroll
    for(int d0=0;d0<4;++d0){
      #pragma unroll
      for(int j=0;j<8;++j){ qf[d0][j]=__uint_as_float(((unsigned)(unsigned short)qr[d0][j])<<16); ss+=qf[d0][j]*qf[d0][j]; } }
    { auto rr=__builtin_amdgcn_permlane32_swap(__float_as_uint(ss),__float_as_uint(ss),false,false); ss=__uint_as_float(rr[0])+__uint_as_float(rr[1]); }
    const float qs=C2/sqrtf(ss*(1.0f/64.0f)+1e-6f);
    #pragma unroll
    for(int d0=0;d0<4;++d0){ const float*qn=qnorm+d0*16+hi*8; u32x4 w;
      w[0]=cvtpk_s(qf[d0][0]*qs*qn[0],qf[d0][1]*qs*qn[1]); w[1]=cvtpk_s(qf[d0][2]*qs*qn[2],qf[d0][3]*qs*qn[3]); w[2]=cvtpk_s(qf[d0][4]*qs*qn[4],qf[d0][5]*qs*qn[5]); w[3]=cvtpk_s(qf[d0][6]*qs*qn[6],qf[d0][7]*qs*qn[7]);
      qr[d0]=__builtin_bit_cast(bf16x8,w); } }
  float mhat=0.f,l_reg=0.f;f32x16 o[2];o[0]=f32x16{};o[1]=f32x16{};const f32x16 negm=f32x16{};
  const int qrel=wid*QBLK+r32;
  #define CMASK(P0,P1,t) do{int jb_=(t)-(NT-4); if(jb_>=0)cmask(P0,P1,jb_,qrel,hi);}while(0)
  #define KBIAS(P0,P1,t) do{ const lds_fptr kp_=kbl+64*(t)+4*hi; \
    _Pragma("unroll") for(int g_=0;g_<4;++g_){ const f32x4_t a_=*(const __attribute__((address_space(3))) f32x4_t*)(kp_+8*g_)-mhat, b_=*(const __attribute__((address_space(3))) f32x4_t*)(kp_+32+8*g_)-mhat; \
      _Pragma("unroll") for(int j_=0;j_<4;++j_){ P0[4*g_+j_]+=a_[j_]; P1[4*g_+j_]+=b_[j_]; } } }while(0)
  bool resc=false;
  #define START(P0,P1) do{ const float rm=rowmax(P0,P1); resc=false; \
    { const float dl=rm; mhat=fadd_s(mhat,dl); \
      _Pragma("unroll") for(int r=0;r<16;++r){P0[r]=fsub_s(P0[r],dl);P1[r]=fsub_s(P1[r],dl);} } \
    _Pragma("unroll") for(int r=0;r<16;++r)P0[r]=__builtin_amdgcn_exp2f(P0[r]); }while(0)
  #define RESC() do{ if(resc){ asm volatile("s_waitcnt lgkmcnt(0)":::"memory"); \
      _Pragma("unroll") for(int d_=0;d_<2;++d_) _Pragma("unroll") for(int r=0;r<16;++r)o[d_][r]*=wsf[crow(r,hi)]; } }while(0)
  f32x16 pA0,pA1,pB0,pB1;
  int sl_prev=0,sl_cur=0,sl_next=SLOTB;
  #define ROT() do{sl_prev=sl_cur;sl_cur=sl_next;sl_next=(sl_next==(NSLOT-1)*SLOTB)?0:sl_next+SLOTB;}while(0)
  DMA_K(2,2*SLOTB);
  WAIT_BAR(3);
  qkt(pA0,pA1,Kbase,qr,negm,r32,hi);asm volatile("s_nop 15\n\ts_nop 7":"+v"(pA0),"+v"(pA1));KBIAS(pA0,pA1,0);CMASK(pA0,pA1,0);
  START(pA0,pA1);
  _Pragma("unroll") for(int r=0;r<16;++r)pA1[r]=__builtin_amdgcn_exp2f(pA1[r]);
  WAIT_BAR(0);
  DMA_K(3,0);DMA_V(1,SLOTB);
  ROT();
  kload8(kf,kp0+sl_cur);
  WAIT_BAR(2);
  s16x4 vlo[8],vhi[8]; u32x4 pw0,pw1,pw2,pw3;
  #define PKW(P,B) cvtpk_s(P[B],P[B+1])
  #define PAF(k) __builtin_bit_cast(bf16x8,pw##k)
  #define VFR(i) (bf16x8){vlo[i][0],vlo[i][1],vlo[i][2],vlo[i][3],vhi[i][0],vhi[i][1],vhi[i][2],vhi[i][3]}
  #define PIN(x) asm volatile("":"+v"(x))
  #define MX3(a,b,c) __builtin_fmaxf(__builtin_fmaxf((a),(b)),(c))
  #define GAPA(MF,A0,A1,A2,A3,W0,W1,PW) do{ MF; sacc+=A0; sacc+=A1; sacc+=A2; sacc+=A3; PIN(sacc); W0; W1; PIN(PW); SBAR(); }while(0)
  #define EX(v) __builtin_amdgcn_exp2f(v)
  #define GAPB(MF,X,B) do{ MF; X[B]=EX(X[B]); X[B+1]=EX(X[B+1]); X[B+2]=EX(X[B+2]); X[B+3]=EX(X[B+3]); PIN(X); SBAR(); }while(0)
  #define VRD(i) do{ vlo[i]=vtr(vp_+(((i)>>2)*4096+((i)&3)*1024)); vhi[i]=vtr(vp_+(((i)>>2)*4096+((i)&3)*1024+512)); }while(0)
  #define KRD(G,j) do{ if(G){ kload2(kf,kp0+sl_next,j); SBAR(); } }while(0)
  #define STEP(C0,C1,P0,P1,t,GK,GV,GL) do{ SBAR(); \
    const lds_cptr vp_=vp0+sl_prev; \
    VRD(0); SBAR(); float sacc=(P0[0]+P0[1]); \
    GAPA(C0=__builtin_amdgcn_mfma_f32_32x32x16_bf16(kf[0],qr[0],negm,0,0,0), P0[2],P0[3],P0[4],P0[5],     pw0[0]=PKW(P0,0), pw0[1]=PKW(P0,2), pw0); \
    VRD(4); SBAR(); GAPA(C1=__builtin_amdgcn_mfma_f32_32x32x16_bf16(kf[1],qr[0],negm,0,0,0), P0[6],P0[7],P0[8],P0[9],     pw0[2]=PKW(P0,4), pw0[3]=PKW(P0,6), pw0); \
    VRD(1); SBAR(); GAPA(C0=__builtin_amdgcn_mfma_f32_32x32x16_bf16(kf[2],qr[1],C0,0,0,0),   P0[10],P0[11],P0[12],P0[13], pw1[0]=PKW(P0,8), pw1[1]=PKW(P0,10), pw1); \
    VRD(5); SBAR(); GAPA(C1=__builtin_amdgcn_mfma_f32_32x32x16_bf16(kf[3],qr[1],C1,0,0,0),   P0[14],P0[15],P1[0],P1[1],   pw1[2]=PKW(P0,12),pw1[3]=PKW(P0,14), pw1); \
    VRD(2); SBAR(); GAPA(C0=__builtin_amdgcn_mfma_f32_32x32x16_bf16(kf[4],qr[2],C0,0,0,0),   P1[2],P1[3],P1[4],P1[5],     pw2[0]=PKW(P1,0), pw2[1]=PKW(P1,2), pw2); \
    VRD(6); SBAR(); GAPA(C1=__builtin_amdgcn_mfma_f32_32x32x16_bf16(kf[5],qr[2],C1,0,0,0),   P1[6],P1[7],P1[8],P1[9],     pw2[2]=PKW(P1,4), pw2[3]=PKW(P1,6), pw2); \
    VRD(3); SBAR(); GAPA(C0=__builtin_amdgcn_mfma_f32_32x32x16_bf16(kf[6],qr[3],C0,0,0,0),   P1[10],P1[11],P1[12],P1[13], pw3[0]=PKW(P1,8), pw3[1]=PKW(P1,10), pw3); \
    VRD(7); SBAR(); GAPA(C1=__builtin_amdgcn_mfma_f32_32x32x16_bf16(kf[7],qr[3],C1,0,0,0),   P1[14],P1[15],0.f,0.f,       pw3[2]=PKW(P1,12),pw3[3]=PKW(P1,14), pw3); \
    l_reg+=sacc; \
    if(GK){DMA_K((t)+3,sl_cur);} if(GV){DMA_V((t)+1,sl_next);} \
    KBIAS(C0,C1,t); CMASK(C0,C1,t); \
    { float a=MX3(C0[0],C0[1],C1[0]),b=MX3(C0[2],C0[3],C1[1]); a=MX3(a,C1[2],C1[3]); \
      _Pragma("unroll") for(int r=4;r<16;r+=4){a=MX3(a,C0[r],C0[r+1]);b=MX3(b,C0[r+2],C0[r+3]);a=MX3(a,C1[r],C1[r+1]);b=MX3(b,C1[r+2],C1[r+3]);} \
      float rm=__builtin_fmaxf(a,b); { auto rr=__builtin_amdgcn_permlane32_swap(__float_as_uint(rm),__float_as_uint(rm),false,false); rm=__builtin_fmaxf(__uint_as_float(rr[0]),__uint_as_float(rr[1])); } \
      resc=false; \
      if(__builtin_expect(__any(rm>(float)THRL),0)){ const float dl=__builtin_fmaxf(rm,0.f); mhat+=dl; \
        _Pragma("unroll") for(int r=0;r<16;++r){C0[r]-=dl;C1[r]-=dl;} \
        const float f=__builtin_amdgcn_exp2f(-dl); l_reg*=f; if(hi==0)wsf[r32]=f; resc=true; } } \
    SBAR(); \
    GAPB(o[0]=__builtin_amdgcn_mfma_f32_32x32x16_bf16(PAF(0),VFR(0),o[0],0,0,0), C0,0); \
    GAPB(o[1]=__builtin_amdgcn_mfma_f32_32x32x16_bf16(PAF(0),VFR(4),o[1],0,0,0), C0,4); \
    KRD(GL,0); GAPB(o[0]=__builtin_amdgcn_mfma_f32_32x32x16_bf16(PAF(1),VFR(1),o[0],0,0,0), C0,8); \
    KRD(GL,1); GAPB(o[1]=__builtin_amdgcn_mfma_f32_32x32x16_bf16(PAF(1),VFR(5),o[1],0,0,0), C0,12); \
    KRD(GL,2); GAPB(o[0]=__builtin_amdgcn_mfma_f32_32x32x16_bf16(PAF(2),VFR(2),o[0],0,0,0), C1,0); \
    KRD(GL,3); GAPB(o[1]=__builtin_amdgcn_mfma_f32_32x32x16_bf16(PAF(2),VFR(6),o[1],0,0,0), C1,4); \
    GAPB(o[0]=__builtin_amdgcn_mfma_f32_32x32x16_bf16(PAF(3),VFR(3),o[0],0,0,0), C1,8); \
    GAPB(o[1]=__builtin_amdgcn_mfma_f32_32x32x16_bf16(PAF(3),VFR(7),o[1],0,0,0), C1,12); \
    }while(0)
  int t=1;
  #undef CMASK
  #define CMASK(P0,P1,t) do{}while(0)
  for(;t+5<NT;t+=2){
    STEP(pB0,pB1,pA0,pA1,t,true,true,true);     WAIT_BAR(2); RESC(); ROT();
    STEP(pA0,pA1,pB0,pB1,t+1,true,true,true);   WAIT_BAR(2); RESC(); ROT();
  }
  #undef CMASK
  #define CMASK(P0,P1,t) do{int jb_=(t)-(NT-4); if(jb_>=0)cmask(P0,P1,jb_,qrel,hi);}while(0)
  #define ENDW(tt) do{ if((tt)+3<NT){WAIT_BAR(2);} else if((tt)+2<NT){WAIT_BAR(1);} else {WAIT_BAR(0);} }while(0)
  for(;t+1<NT;t+=2){
    STEP(pB0,pB1,pA0,pA1,t,(t+3<NT),(t+1<NT),(t+1<NT));       ENDW(t);   RESC(); ROT();
    STEP(pA0,pA1,pB0,pB1,t+1,(t+4<NT),(t+2<NT),(t+2<NT));     ENDW(t+1); RESC(); ROT();
  }
  STEP(pB0,pB1,pA0,pA1,NT-1,false,false,false); RESC();
  { float sacc=pB0[0]+pB0[1]; _Pragma("unroll") for(int r=2;r<16;++r)sacc+=pB0[r]; _Pragma("unroll") for(int r=0;r<16;++r)sacc+=pB1[r]; l_reg+=sacc;
    pw0=(u32x4){PKW(pB0,0),PKW(pB0,2),PKW(pB0,4),PKW(pB0,6)};pw1=(u32x4){PKW(pB0,8),PKW(pB0,10),PKW(pB0,12),PKW(pB0,14)};pw2=(u32x4){PKW(pB1,0),PKW(pB1,2),PKW(pB1,4),PKW(pB1,6)};pw3=(u32x4){PKW(pB1,8),PKW(pB1,10),PKW(pB1,12),PKW(pB1,14)};
    SBAR(); pv(o,vb0+sl_cur,PAF(0),PAF(1),PAF(2),PAF(3)); }
  #undef PKW
  #undef PAF
  #undef VFR
  #undef PIN
  #undef MX3
  #undef GAPA
  #undef GAPB
  #undef EX
  #undef VRD
  #undef KRD
  #undef STEP
  #undef ENDW
  {auto rr=__builtin_amdgcn_permlane32_swap(__float_as_uint(l_reg),__float_as_uint(l_reg),false,false);l_reg=__uint_as_float(rr[0])+__uint_as_float(rr[1]);}
  if(hi==0)wsf[32+r32]=l_reg;asm volatile("s_waitcnt lgkmcnt(0)":::"memory");
  float rli[16];
  #pragma unroll
  for(int r=0;r<16;++r)rli[r]=__builtin_amdgcn_rcpf(wsf[32+crow(r,hi)]);
  bf16*Ow=O+(rowbase+q0+wid*QBLK)*DM+h*D;
  { bf16*stg=(bf16*)(shm+LDS_OST)+wid*2048;
    #pragma unroll
    for(int r=0;r<16;++r){const int orow=crow(r,hi);
      #pragma unroll
      for(int d0=0;d0<2;++d0)stg[orow*64+d0*32+r32]=__float2bfloat16(o[d0][r]*rli[r]);}
    asm volatile("s_waitcnt lgkmcnt(0)":::"memory");
    const bf16*Gw=G+(rowbase+q0+wid*QBLK)*DM+h*D;
    #pragma unroll
    for(int i=0;i<4;++i){const int row=i*8+(lane>>3),ch=lane&7; u32x4 v=*(const u32x4*)(stg+row*64+ch*8); const u32x4 g=*(const u32x4*)(Gw+(long)row*DM+ch*8);
      #pragma unroll
      for(int q=0;q<4;++q) v[q]=cvtpk_s(__uint_as_float(v[q]<<16)*__uint_as_float(g[q]<<16),__uint_as_float(v[q]&0xffff0000u)*__uint_as_float(g[q]&0xffff0000u));
      ATTN_STORE16(Ow+(long)row*DM+ch*8,v);} }
  asm volatile("s_waitcnt lgkmcnt(0)\n\ts_barrier":::"memory");
  #undef DMA_K
  #undef DMA_V
  #undef CMASK
  #undef KBIAS
  #undef START
  #undef RESC
  #undef ROT
}
constexpr int ATTN_LDS_BYTES=LDS_BYTES;
struct AttnTensors { const bf16* Q; const bf16* K; const bf16* V; bf16* O; const bf16* G; const float* KB; const float* qnorm; };
template<int THRL=8> __device__ __forceinline__ void attn_phase(int tid,int wid,unsigned*ctr,const int*t0tab,volatile __attribute__((address_space(3))) int*bc,char*lds,const AttnTensors&T){
  for(;;){
    if(tid==0){ const int n_=(int)__hip_atomic_fetch_add(ctr,1u,__ATOMIC_RELAXED,__HIP_MEMORY_SCOPE_AGENT); bc[0]=n_; }
    asm volatile("s_waitcnt vmcnt(0) lgkmcnt(0)\n\ts_barrier":::"memory");
    const int n=__builtin_amdgcn_readfirstlane(bc[0]);
    if(n>=BATCH*NHEAD*NQB) break;
    const int qb=NQB-1-(n>>7), bh=n&127;
    const int t0=__builtin_amdgcn_readfirstlane(t0tab[bh*16+qb]);
    attn_unit<THRL>(tid,wid,bh/NHEAD,bh%NHEAD,qb,t0,T.Q,T.K,T.V,T.O,T.G,T.KB+(long)bh*SEQ,T.qnorm,lds);
  }
}
#undef SBAR
#undef WAIT_BAR
}
__device__ __forceinline__ void attn_simple(Frame& F, int j) {
    const InTab in = F.in;
    const bf16_t* Q = (const bf16_t*)(F.ws + WS_RA); const bf16_t* Gt = (const bf16_t*)(F.ws + WS_RA + 64 * MiB);
    const bf16_t* Kb = (const bf16_t*)(F.ws + WS_P); const bf16_t* Vb = (const bf16_t*)(F.ws + WS_P + 64 * MiB);
    const float* KBv = (const float*)(F.ws + WS_KB); bf16_t* OG = (bf16_t*)(F.ws + WS_H2 + 64 * MiB);
    const float* qn = in[I_QNORM] + j * 64;
    for (int item = F.bid; item < 1024; item += F.G) {
        const int bh = item >> 3, qb = item & 7, b = bh >> 4, h = bh & 15, t = qb * 512 + F.tid;
        const size_t row = (size_t)b * SEQ + t;
        float q[64];
        { const bf16_t* qp = Q + row * 1024 + h * 64; float ss = 0.f;
#pragma unroll
          for (int i = 0; i < 8; ++i) { const u32x4 w = *(const u32x4*)(qp + 8 * i);
              q[8 * i] = lo16(w.x); q[8 * i + 1] = hi16(w.x); q[8 * i + 2] = lo16(w.y); q[8 * i + 3] = hi16(w.y); q[8 * i + 4] = lo16(w.z); q[8 * i + 5] = hi16(w.z); q[8 * i + 6] = lo16(w.w); q[8 * i + 7] = hi16(w.w); }
#pragma unroll
          for (int i = 0; i < 64; ++i) ss += q[i] * q[i];
          const float rs = QC2 / sqrtf(ss * (1.0f / 64.0f) + QK_EPS);
#pragma unroll
          for (int i = 0; i < 64; ++i) q[i] = q[i] * rs * qn[i]; }
        float o[64];
#pragma unroll
        for (int i = 0; i < 64; ++i) o[i] = 0.f;
        float m = -1.0e30f, lsum = 0.f;
        const int smax = qb * 512 + F.wave * 64 + 63;
        const bf16_t* kp = Kb + ((size_t)b * SEQ) * 1024 + h * 64; const bf16_t* vp = Vb + ((size_t)b * SEQ) * 1024 + h * 64;
        const float* kbp = KBv + (size_t)bh * SEQ;
        for (int s = 0; s <= smax; ++s) {
            float dot = 0.f;
#pragma unroll
            for (int i = 0; i < 8; ++i) { const u32x4 w = *(const u32x4*)(kp + (size_t)s * 1024 + 8 * i);
                dot += q[8 * i] * lo16(w.x) + q[8 * i + 1] * hi16(w.x) + q[8 * i + 2] * lo16(w.y) + q[8 * i + 3] * hi16(w.y) + q[8 * i + 4] * lo16(w.z) + q[8 * i + 5] * hi16(w.z) + q[8 * i + 6] * lo16(w.w) + q[8 * i + 7] * hi16(w.w); }
            float x = dot + kbp[s];
            if (s > t) x = -1.0e30f;
            const float mn = fmaxf(m, x), corr = exp2f(m - mn), p = (s > t) ? 0.f : exp2f(x - mn);
            m = mn; lsum = lsum * corr + p;
#pragma unroll
            for (int i = 0; i < 8; ++i) { const u32x4 w = *(const u32x4*)(vp + (size_t)s * 1024 + 8 * i);
                o[8 * i] = o[8 * i] * corr + p * lo16(w.x); o[8 * i + 1] = o[8 * i + 1] * corr + p * hi16(w.x); o[8 * i + 2] = o[8 * i + 2] * corr + p * lo16(w.y); o[8 * i + 3] = o[8 * i + 3] * corr + p * hi16(w.y);
                o[8 * i + 4] = o[8 * i + 4] * corr + p * lo16(w.z); o[8 * i + 5] = o[8 * i + 5] * corr + p * hi16(w.z); o[8 * i + 6] = o[8 * i + 6] * corr + p * lo16(w.w); o[8 * i + 7] = o[8 * i + 7] * corr + p * hi16(w.w); }
        }
        const float il = 1.0f / lsum;
        const bf16_t* gp = Gt + row * 1024 + h * 64; bf16_t* op = OG + row * 1024 + h * 64;
#pragma unroll
        for (int i = 0; i < 8; ++i) { const u32x4 w = *(const u32x4*)(gp + 8 * i); u32x4 r;
            r.x = pk2(o[8 * i] * il * lo16(w.x), o[8 * i + 1] * il * hi16(w.x)); r.y = pk2(o[8 * i + 2] * il * lo16(w.y), o[8 * i + 3] * il * hi16(w.y));
            r.z = pk2(o[8 * i + 4] * il * lo16(w.z), o[8 * i + 5] * il * hi16(w.z)); r.w = pk2(o[8 * i + 6] * il * lo16(w.w), o[8 * i + 7] * il * hi16(w.w));
            *(u32x4*)(op + 8 * i) = r; }
    }
}

__device__ __forceinline__ void attn_fast(Frame& F, int j) {
    typedef attn_body::bf16 abf;
    const attn_body::AttnTensors AT{(const abf*)(F.ws + WS_RA), (const abf*)(F.ws + WS_P), (const abf*)(F.ws + WS_P + 64 * MiB), (abf*)(F.ws + WS_H2 + 64 * MiB), (const abf*)(F.ws + WS_RA + 64 * MiB),
                                    (const float*)(F.ws + WS_KB), F.in[I_QNORM] + j * 64};
    static_assert(attn_body::ATTN_LDS_BYTES <= 131072, "attention LDS");
    attn_body::attn_phase<8>(F.tid, F.wave, (unsigned*)(F.ws + WS_CTL) + CW_ATT + 64 * j, (const int*)(F.ws + WS_T0), (volatile LAS int*)(F.lds + MISC_OFF + 64), F.ldsg, AT);
}
__device__ __forceinline__ void relane(Frame& F) { int l_; asm volatile("v_mbcnt_lo_u32_b32 %0, -1, 0\n\tv_mbcnt_hi_u32_b32 %0, -1, %0" : "=v"(l_)); int w_ = F.wave; asm volatile("" : "+s"(w_)); F.wave = w_; F.lane = l_; F.tid = w_ * 64 + l_;
    GAS unsigned char* p_ = (GAS unsigned char*)F.ws; asm volatile("" : "+s"(p_)); F.ws = (unsigned char*)p_; GAS float* x_ = (GAS float*)F.xs; asm volatile("" : "+s"(x_)); F.xs = (float*)x_; }
#define GRID_BAR() (relane(F), xcd_barrier_fn(bar.bar, bar.x, bar.st, F.tid == 0))
#ifndef ONLY
#define ONLY (-1)
#endif
#ifndef REP_MASK
#define REP_MASK 0
#endif
#define ON(k) (relane(F), (ONLY < 0 || ONLY == (k)))
#define RUN(k, ...) do { for (int rep_ = 0; rep_ < (((REP_MASK >> (k)) & 1) ? 2 : 1); ++rep_) { if (ON(k)) { __VA_ARGS__; } if (REP_MASK) __syncthreads(); } } while (0)
template <int l> __device__ __forceinline__ void layer_body(Frame& F, const XcdBarrier& bar) {
    unsigned char* ws = F.ws;

        if (l < 2) {
#ifdef GPROBE
            { relane(F); SchedRKV S{{T / 256, 12, F.G, F.bid}};
#if GPROBE == 1
              EpiNone E{};
#else
              EpiPriv E{(bf16_t*)(ws + WS_RA), F.bid};
#endif
              gemm_fast(F, (const bf16_t*)(ws + WS_SC), 1024, (const bf16_t*)(ws + WS_RWBIG) + (size_t)l * 3072 * 1024, 1024, S, E); __syncthreads(); }
#endif
            RUN(2, SchedRKV S{{T / 256, 12, F.G, F.bid}}; EpiRKV E{(bf16_t*)(ws + WS_RA), (bf16_t*)(ws + WS_P), l};
              gemm_fast(F, (const bf16_t*)(ws + WS_SC), 1024, (const bf16_t*)(ws + WS_RWBIG) + (size_t)l * 3072 * 1024, 1024, S, E););
            RUN(21, SchedDense S{T / 256, 2, F.G, F.bid}; EpiLA E{(bf16_t*)(ws + WS_RA + 192 * MiB)};
              gemm_fast(F, (const bf16_t*)(ws + WS_H2), RWK, (const bf16_t*)(ws + WS_RWLORA) + (size_t)l * 512 * RWK, RWK, S, E););
            GRID_BAR();
            RUN(3, SchedDense S{T / 256, 4, F.G, F.bid}; EpiPlain E{(bf16_t*)(ws + WS_RA + 224 * MiB), 1024};
              gemm_fast(F, (const bf16_t*)(ws + WS_RA + 192 * MiB) + 128, LAW, (const bf16_t*)(ws + WS_LORA2 + (size_t)l * MiB + L2_G2T), G2K, S, E););
            RUN(4, wkv_chunk_prep<0>(F, l));
#ifdef PREP_PROBE
            relane(F); __syncthreads(); wkv_chunk_prep<PREP_PROBE>(F, l);
#endif
            GRID_BAR();
            RUN(20, wkv_chunk_seq(F, l)); RUN(19, moe_convert(F, l, 128, F.G - 128));
            GRID_BAR();
            RUN(6, SchedDense S{T / 256, 4, F.G, F.bid}; EpiPlain E{(bf16_t*)(ws + WS_Y16), 1024};
              gemm_fast(F, (const bf16_t*)(ws + WS_H2), 1024, (const bf16_t*)(ws + WS_RWWO) + (size_t)l * 1024 * 1024, 1024, S, E););
            GRID_BAR();
        } else {
            const int j = l - 2;
            RUN(7, SchedDense S{T / 256, 8, F.G, F.bid}; EpiSplit2 E{(bf16_t*)(ws + WS_RA), (bf16_t*)(ws + WS_RA + 64 * MiB), 1};
              gemm_fast(F, (const bf16_t*)(ws + WS_H2), 1024, (const bf16_t*)(ws + WS_FXQG) + (size_t)j * 2048 * 1024, 1024, S, E););
            GRID_BAR();
            RUN(19, moe_convert(F, l, F.G - 64, 64));
            RUN(8, attn_fast(F, j));
            GRID_BAR();
            RUN(9, SchedDense S{T / 256, 4, F.G, F.bid}; EpiPlain E{(bf16_t*)(ws + WS_Y16), 1024};
              gemm_fast(F, (const bf16_t*)(ws + WS_H2 + 64 * MiB), 1024, (const bf16_t*)(ws + WS_FXWO) + (size_t)j * 1024 * 1024, 1024, S, E););
            GRID_BAR();
        }
#ifdef TOKA_PROBE
        relane(F); tok_a<true>(F, l); __syncthreads();
#endif
#ifdef BAR_PROBE
        for (int bi_ = 0; bi_ < 5; ++bi_) GRID_BAR();
#endif
        RUN(10, tok_a<false>(F, l));
        GRID_BAR();
        {
            const LAS int* lc = (const LAS int*)(F.lds + MOE_LC_OFF);
            const bf16_t* W1T = (const bf16_t*)(ws + WS_MOE); const bf16_t* W2T = W1T + (size_t)32 * 1024 * 1024;
            relane(F); moe_tables(F, l);
            { SchedMoe S{lc + 96, lc[64], F.G, F.bid, (size_t)1024 * 1024}; moe_rows(F, S); EpiMoe1 E{(bf16_t*)(ws + WS_HM)};
              RUN(12, gemm_fast<EpiMoe1, SchedMoe, true>(F, (const bf16_t*)(ws + WS_H2), 1024, W1T, 1024, S, E, (const LAS int*)(F.lds + MOE_TOKL_OFF))); }
            GRID_BAR();
            { SchedMoe S{lc + 96, lc[64], F.G, F.bid, (size_t)1024 * 512}; EpiPlain E{(bf16_t*)(ws + WS_RA + 144 * MiB), 1024};
              RUN(13, gemm_fast(F, (const bf16_t*)(ws + WS_HM), 512, W2T, 512, S, E)); }
            GRID_BAR();
        }
#ifdef TOKB_PROBE
        relane(F); tok_b<true>(F, l, l == 1 ? 1 : (l == 2 ? 2 : 3)); __syncthreads();
#endif
        RUN(14, tok_b<false>(F, l, l == 1 ? 1 : (l == 2 ? 2 : 3)));
        if (l == 3) return;
        GRID_BAR();
        if (l == 0) { RUN(1, rw_prep(F, 1, false)); GRID_BAR(); }
        if (l == 1) {
            RUN(18, fgate_phase(F));
            RUN(15, SchedDense S{T / 256, 8, F.G, F.bid}; EpiSplit2 E{(bf16_t*)(ws + WS_P), (bf16_t*)(ws + WS_P + 64 * MiB), 0};
              gemm_fast(F, (const bf16_t*)(ws + WS_RA), 1024, (const bf16_t*)(ws + WS_KVW), 1024, S, E););
            GRID_BAR();
            RUN(16, kv_post(F));
            GRID_BAR();
        }
}
__global__ void __launch_bounds__(NTHR, 2) yoco_fwd(Args args) {
    extern __shared__ __attribute__((aligned(16))) unsigned char lds[];
    Frame F;
    F.lds = (LAS unsigned char*)lds; F.ldsg = (char*)lds; F.ws = args.ws; F.xs = args.out; F.in.p = args.in;
    F.tid = threadIdx.x; F.lane = F.tid & 63; F.wave = __builtin_amdgcn_readfirstlane(F.tid >> 6); F.G = gridDim.x; F.bid = blockIdx.x;
    volatile LAS unsigned* MISC = (volatile LAS unsigned*)(F.lds + MISC_OFF);
    if (F.tid < 32) MISC[F.tid] = 0u;
    __syncthreads();
    XcdBarrier bar = xcd_barrier_post((unsigned*)(F.ws + WS_CTL) + CW_BAR, MISC + 8);
    unsigned char* ws = F.ws;
    RUN(0, p0_prologue(F));
    GRID_BAR();
    RUN(1, rw_prep(F, 0, true));
    GRID_BAR();
    layer_body<0>(F, bar); layer_body<1>(F, bar); layer_body<2>(F, bar); layer_body<3>(F, bar);
}

extern "C" void kernel_launch(void* const* d_in, const int* in_sizes, int n_in, void* d_out, int out_size, void* d_ws, size_t ws_size, hipStream_t stream) {
    static int grid = 0;
    if (grid == 0) {
        if (n_in != 40 || out_size != T * D || ws_size < WS_END) { fprintf(stderr, "kernel_launch: unexpected shapes (n_in %d out %d ws %zu)\n", n_in, out_size, ws_size); grid = -1; return; }
        int dev = 0, cus = 0, per_cu = 0;
        if (hipGetDevice(&dev) != hipSuccess || hipDeviceGetAttribute(&cus, hipDeviceAttributeMultiprocessorCount, dev) != hipSuccess) { grid = -1; return; }
        if (hipFuncSetAttribute((const void*)yoco_fwd, hipFuncAttributeMaxDynamicSharedMemorySize, LDS_BYTES) != hipSuccess) { fprintf(stderr, "kernel_launch: hipFuncSetAttribute failed\n"); grid = -1; return; }
        if (hipOccupancyMaxActiveBlocksPerMultiprocessor(&per_cu, (const void*)yoco_fwd, NTHR, LDS_BYTES) != hipSuccess || per_cu < 1) fprintf(stderr, "kernel_launch: occupancy query reports %d\n", per_cu);
        (void)hipGetLastError();
        grid = cus;
        if (grid != 256) { fprintf(stderr, "kernel_launch: built for 256 CUs, found %d\n", cus); grid = -1; return; }
    }
    if (grid < 0) return;
    (void)hipMemsetAsync((char*)d_ws + WS_CTL, 0, CTL_BYTES, stream);
    Args a{};
    for (int i = 0; i < 40; ++i) a.in[i] = (const float*)d_in[i];
    a.out = (float*)d_out; a.ws = (unsigned char*)d_ws; a.ph_lo = 0; a.ph_hi = 0;
    hipLaunchKernelGGL(yoco_fwd, dim3(grid), dim3(NTHR), LDS_BYTES, stream, a);
}
```

```cpp
#include <hip/hip_runtime.h>
#include <cstdio>
#include <cstdint>
#include <hip/hip_bf16.h>
#include <cmath>

#define GAS __attribute__((address_space(1)))
#define LAS __attribute__((address_space(3)))
typedef unsigned short bf16_t;
typedef short bf16x8 __attribute__((ext_vector_type(8)));
typedef float f32x4 __attribute__((ext_vector_type(4)));
typedef float f32x2 __attribute__((ext_vector_type(2)));
typedef unsigned u32x4 __attribute__((ext_vector_type(4)));
typedef unsigned u32x2 __attribute__((ext_vector_type(2)));
typedef GAS unsigned gu32;

constexpr int NB = 8, SEQ = 4096, T = NB * SEQ, D = 1024, NH = 16, HD = 64;
constexpr int NWAVES = 8, NTHR = NWAVES * 64;
constexpr float ALPHA = 1.681792830507429f;
constexpr float LN_EPS = 1e-5f, GN_EPS = 64e-5f, QK_EPS = 1e-6f;
constexpr float LOG2E = 1.4426950408889634f;
constexpr float QC2 = 0.125f * LOG2E;
constexpr int RWK = 2048;
constexpr int LAW = 512;
constexpr int G2K = 256;
constexpr int XS_ROWS = 73728;

constexpr size_t MiB = 1u << 20;
constexpr size_t WS_CTL = 0, CTL_BYTES = 1 * MiB;
constexpr size_t WS_MOD = 1 * MiB;
constexpr size_t WS_KVMOD = WS_MOD + 4 * 8 * 6144 * 4;
constexpr size_t WS_RT = 2 * MiB;
constexpr size_t WS_WF = WS_RT + 768 * 1024;
constexpr size_t WS_KB = 3 * MiB;
constexpr size_t WS_LF = 5 * MiB;
constexpr size_t WS_ASG = 7 * MiB;
constexpr size_t WS_GATE = WS_ASG + 256 * 1024;
constexpr size_t WS_DEST = WS_GATE + 256 * 1024;
constexpr size_t WS_TEXP = WS_DEST + 256 * 1024;
constexpr size_t WS_T0 = WS_TEXP + 4096;
constexpr size_t WS_RWBIG = 16 * MiB;
constexpr size_t WS_RWLORA = 28 * MiB;
constexpr size_t WS_LORA2 = 44 * MiB;
constexpr size_t L2_G2T = 0, L2_W2T = 512 * 1024, L2_A2T = 640 * 1024, L2_V2T = 768 * 1024;
constexpr size_t WS_RWWO = 50 * MiB;
constexpr size_t WS_KVW = 54 * MiB;
constexpr size_t WS_FXQG = 58 * MiB;
constexpr size_t WS_FXWO = 66 * MiB;
constexpr size_t WS_MOE = 72 * MiB;
constexpr size_t WS_SC = 168 * MiB;
constexpr size_t X3S = (size_t)T * 1024;
constexpr size_t WS_XS = WS_SC + 200 * MiB;
constexpr size_t WS_P = 456 * MiB;
constexpr size_t WS_Y16 = 584 * MiB;
constexpr size_t WS_H2 = 648 * MiB;
constexpr size_t WS_RA = 776 * MiB;
constexpr size_t WS_HM = WS_RA;
constexpr size_t WS_TLIST = WS_RA + 80 * MiB;
constexpr size_t WS_END = 1064 * MiB;
constexpr int CW_BAR = 4096;
constexpr int CW_CNT = 16384;
constexpr int CW_ATT = 16640;

constexpr int LDS_BYTES = 147456;
constexpr int MISC_OFF = 131072 + 320;
constexpr int MOE_LC_OFF = MISC_OFF + 256;
constexpr int MOE_TOKL_OFF = MISC_OFF + 2048;
__device__ __forceinline__ float bf2f(unsigned short b) { return __uint_as_float((unsigned)b << 16); }
typedef float f32x2_cv __attribute__((ext_vector_type(2))); typedef __bf16 bf16x2_cv __attribute__((ext_vector_type(2)));
__device__ __forceinline__ unsigned pk2(float lo, float hi) { const f32x2_cv v = {lo, hi}; return __builtin_bit_cast(unsigned, __builtin_convertvector(v, bf16x2_cv)); }
__device__ __forceinline__ unsigned f2bf(float f) { return pk2(f, 0.f) & 0xffffu; }
__device__ __forceinline__ float lo16(unsigned w) { return __uint_as_float(w << 16); }
__device__ __forceinline__ float hi16(unsigned w) { return __uint_as_float(w & 0xffff0000u); }
__device__ __forceinline__ float sigmoidf_(float x) { return __builtin_amdgcn_rcpf(1.0f + __expf(-x)); }
__device__ __forceinline__ float tanhf_(float x) { const float e = __expf(2.0f * x); return 1.0f - 2.0f * __builtin_amdgcn_rcpf(e + 1.0f); }
template <int CTRL> __device__ __forceinline__ float dpp_f(float v) {
    return __builtin_bit_cast(float, __builtin_amdgcn_update_dpp(0, __builtin_bit_cast(int, v), CTRL, 0xF, 0xF, true));
}
__device__ __forceinline__ float wave_sum(float v) {
    v += dpp_f<0xB1>(v); v += dpp_f<0x4E>(v); v += dpp_f<0x141>(v); v += dpp_f<0x140>(v);
    const int vi = __builtin_bit_cast(int, v);
    const float s0 = __builtin_bit_cast(float, __builtin_amdgcn_readlane(vi, 0)), s1 = __builtin_bit_cast(float, __builtin_amdgcn_readlane(vi, 16)), s2 = __builtin_bit_cast(float, __builtin_amdgcn_readlane(vi, 32)), s3 = __builtin_bit_cast(float, __builtin_amdgcn_readlane(vi, 48));
    return (s0 + s1) + (s2 + s3);
}
__device__ __forceinline__ float quadsum(float v) { v += dpp_f<0xB1>(v); v += dpp_f<0x4E>(v); return v; }
__device__ __forceinline__ float rowsum16(float v) { v += dpp_f<0xB1>(v); v += dpp_f<0x4E>(v); v += dpp_f<0x141>(v); v += dpp_f<0x140>(v); return v; }
#define LDS_WAIT() asm volatile("s_waitcnt lgkmcnt(0)" ::: "memory")
#define LBAR() do { asm volatile("s_waitcnt lgkmcnt(0)" ::: "memory"); __builtin_amdgcn_s_barrier(); asm volatile("" ::: "memory"); } while (0)

#define XB_TMO      128
#define XB_XCNT(j)  (256  + 64 * (j))
#define XB_XSUB(j)  (1280 + 64 * (j))
#define XB_XGEN(j)  (2304 + 64 * (j))
#define XB_TOP      3328
#define XB_TOPGEN   3392
#define XCD_BAR_WORDS 3456
#define XB_SPIN_CAP (1u << 22)
__device__ __forceinline__ unsigned xb_ld(unsigned* p)              { return __hip_atomic_load(p, __ATOMIC_RELAXED, __HIP_MEMORY_SCOPE_AGENT); }
__device__ __forceinline__ unsigned xb_add(unsigned* p, unsigned v) { return __hip_atomic_fetch_add(p, v, __ATOMIC_RELAXED, __HIP_MEMORY_SCOPE_AGENT); }
__device__ __forceinline__ unsigned xb_xcc_id() { return (unsigned)__builtin_amdgcn_s_getreg((3 << 11) | 20) & 0xFu; }
#define XB_SPIN(cond, bar) do { unsigned _sp = 0; while (cond) { __builtin_amdgcn_s_sleep(1); \
    if ((++_sp & 255u) == 0u) { if (xb_ld(&(bar)[XB_TMO])) break; if (_sp > XB_SPIN_CAP) { atomicAdd(&(bar)[XB_TMO], 1u); break; } } } } while (0)
struct XcdBarrier { unsigned* bar; unsigned x; volatile LAS unsigned* st; };
__device__ __forceinline__ XcdBarrier xcd_barrier_post(unsigned* bar, volatile LAS unsigned* st) {
    XcdBarrier b; b.bar = bar; b.x = xb_xcc_id(); b.st = st;
    if (threadIdx.x == 0) (void)xb_add(&bar[XB_XCNT(b.x)], 1u);
    return b;
}
__device__ __forceinline__ void xcd_barrier_complete(unsigned* bar, unsigned x, unsigned& nloc, unsigned& nx) {
    const unsigned G = gridDim.x * gridDim.y * gridDim.z;
    unsigned sum, cnt, mine, sp = 0u;
    for (;;) {
        sum = 0u; cnt = 0u; mine = 0u;
#pragma unroll
        for (unsigned j = 0; j < 16; ++j) { const unsigned c = xb_ld(&bar[XB_XCNT(j)]); sum += c; cnt += (c > 0u) ? 1u : 0u; mine = (j == x) ? c : mine; }
        if (sum == G) break;
        __builtin_amdgcn_s_sleep(1);
        if ((++sp & 255u) == 0u) { if (xb_ld(&bar[XB_TMO])) break; if (sp > XB_SPIN_CAP) { atomicAdd(&bar[XB_TMO], 1u); break; } }
    }
    nloc = mine > 0u ? mine : 1u; nx = cnt > 0u ? cnt : 1u;
}
__device__ __forceinline__ void xcd_barrier_fn(unsigned* bar_, unsigned x_, volatile LAS unsigned* st_, bool is_t0) {
    XcdBarrier b; b.bar = bar_; b.x = x_; b.st = st_;
    asm volatile("s_waitcnt vmcnt(0)" ::: "memory");
    __syncthreads();
    if (is_t0) {
        unsigned* bar = b.bar;
        __builtin_amdgcn_s_waitcnt(0);
        unsigned nloc = b.st[0], nx = b.st[1];
        if (nloc == 0u) { xcd_barrier_complete(bar, b.x, nloc, nx); b.st[0] = nloc; b.st[1] = nx; }
        const unsigned old = xb_add(&bar[XB_XSUB(b.x)], 1u);
        const unsigned gen = old / nloc;
        if (old + 1u == (gen + 1u) * nloc) {
            __builtin_amdgcn_fence(__ATOMIC_RELEASE, "agent");
            asm volatile("s_waitcnt vmcnt(0)" ::: "memory");
            const unsigned og = xb_add(&bar[XB_TOP], 1u);
            const unsigned tg = og / nx;
            if (og + 1u == (tg + 1u) * nx) xb_add(&bar[XB_TOPGEN], 1u);
            else XB_SPIN(xb_ld(&bar[XB_TOPGEN]) == tg, bar);
            __builtin_amdgcn_fence(__ATOMIC_ACQUIRE, "agent");
            xb_add(&bar[XB_XGEN(b.x)], 1u);
            asm volatile("s_waitcnt vmcnt(0)" ::: "memory");
        } else {
            XB_SPIN(xb_ld(&bar[XB_XGEN(b.x)]) == gen, bar);
            __builtin_amdgcn_fence(__ATOMIC_ACQUIRE, "agent");
            asm volatile("s_waitcnt vmcnt(0)" ::: "memory");
        }
    }
    __syncthreads();
}

struct Args { const float* in[40]; float* out; unsigned char* ws; int ph_lo, ph_hi; };
struct InTab { const float* const* p; __device__ __forceinline__ const float* operator[](int i) const { return (const float*)(GAS const float*)p[i]; } };
struct Frame {
    LAS unsigned char* lds; char* ldsg;
    unsigned char* ws; float* xs;
    InTab in;
    int tid, lane, wave, G, bid;
};
enum { I_X = 0, I_C, I_ADAW, I_ADAB, I_LNG, I_LNB, I_MU, I_RKV, I_W0, I_W1, I_W2, I_A0, I_A1, I_A2, I_G1, I_G2, I_KK, I_KA, I_RK, I_GNG, I_GNB, I_RWO, I_V0, I_V1, I_V2,
       I_KVADAW, I_KVADAB, I_KVW, I_KVFB, I_KNORM, I_WQG, I_QNORM, I_FWO, I_WGRP, I_BGRP, I_WEXP, I_BEXP, I_WGATE, I_WUP, I_WDOWN };

__device__ __forceinline__ void tr_item(const float* W, int ldw, int K, int k0, int n0, const float* mu, bf16_t* WT, int ldt, int nd0, int kd0, LAS float* scr, int lane) {
    const int kr = lane >> 3, n4 = 4 * (lane & 7);
    f32x4 v[8];
#pragma unroll
    for (int i = 0; i < 8; ++i) { const int k = k0 + kr + 8 * i; v[i] = (k < K) ? *(const f32x4*)(W + (size_t)k * ldw + n0 + n4) : (f32x4){0.f, 0.f, 0.f, 0.f}; }
    if (mu) {
#pragma unroll
        for (int i = 0; i < 8; ++i) { const int k = k0 + kr + 8 * i; v[i] = v[i] * ((k < K) ? mu[k] : 0.f); }
    }
#pragma unroll
    for (int i = 0; i < 8; ++i) { LAS float* d = scr + (kr + 8 * i) * 33 + n4; d[0] = v[i][0]; d[1] = v[i][1]; d[2] = v[i][2]; d[3] = v[i][3]; }
    LDS_WAIT(); asm volatile("" ::: "memory");
    const int c = lane & 7;
#pragma unroll
    for (int j = 0; j < 4; ++j) {
        const int n = (lane >> 3) + 8 * j; const LAS float* s = scr + (8 * c) * 33 + n;
        u32x4 o; o.x = pk2(s[0 * 33], s[1 * 33]); o.y = pk2(s[2 * 33], s[3 * 33]); o.z = pk2(s[4 * 33], s[5 * 33]); o.w = pk2(s[6 * 33], s[7 * 33]);
        *(u32x4*)(WT + (size_t)(nd0 + n) * ldt + kd0 + 8 * c) = o;
    }
    LDS_WAIT(); asm volatile("" ::: "memory");
}
__device__ __forceinline__ void zero_item(bf16_t* WT, int ldt, int r0, int c0, int c1, int lane) {
    const int cpr = (c1 - c0) >> 3, tot = 32 * cpr;
    for (int i = lane; i < tot; i += 64) { const int r = i / cpr, c = i % cpr; *(u32x4*)(WT + (size_t)(r0 + r) * ldt + c0 + 8 * c) = (u32x4){0u, 0u, 0u, 0u}; }
}

__device__ __forceinline__ void p0_prologue(Frame& F) {
    const InTab in = F.in;
    {
        LAS float* cs = (LAS float*)F.lds;
        LAS float* part = (LAS float*)(F.lds + 32768);
        bool did_cs = false;
        for (int it = F.bid; it < 104; it += F.G) {
            if (!did_cs) { for (int i = F.tid; i < 8 * 1024; i += NTHR) { const float v = in[I_C][i]; cs[i] = v / (1.0f + __expf(-v)); } did_cs = true; }
            __syncthreads();
            const float* W; const float* bias; int ldw, j0; float* dst; int dld;
            if (it < 96) { const int l = it / 24; j0 = (it % 24) * 256; W = in[I_ADAW] + (size_t)l * 1024 * 6144; ldw = 6144; bias = in[I_ADAB] + l * 6144; dst = (float*)(F.ws + WS_MOD) + (size_t)l * 8 * 6144; dld = 6144; }
            else { j0 = (it - 96) * 256; W = in[I_KVADAW]; ldw = 2048; bias = in[I_KVADAB]; dst = (float*)(F.ws + WS_KVMOD); dld = 2048; }
            f32x4 acc[8];
#pragma unroll
            for (int b = 0; b < 8; ++b) acc[b] = (f32x4){0.f, 0.f, 0.f, 0.f};
            const int kbeg = F.wave * 128;
#pragma unroll 4
            for (int kk = 0; kk < 128; ++kk) {
                const int k = kbeg + kk;
                const f32x4 w = *(const f32x4*)(W + (size_t)k * ldw + j0 + 4 * F.lane);
#pragma unroll
                for (int b = 0; b < 8; ++b) acc[b] += w * cs[b * 1024 + k];
            }
#pragma unroll
            for (int b = 0; b < 8; ++b) *(LAS f32x4*)(part + (F.wave * 8 + b) * 256 + 4 * F.lane) = acc[b];
            __syncthreads();
            for (int o = F.tid; o < 8 * 256; o += NTHR) {
                const int b = o >> 8, j = o & 255; float s = 0.f;
#pragma unroll
                for (int w = 0; w < 8; ++w) s += part[(w * 8 + b) * 256 + j];
                dst[(size_t)b * dld + j0 + j] = s + bias[j0 + j];
            }
            __syncthreads();
        }
        __syncthreads();
    }
    {
        const int gt = F.bid * NTHR + F.tid, NGT = F.G * NTHR;
        bf16_t* RTH = (bf16_t*)(F.ws + WS_RT); bf16_t* RTL = RTH + 4 * 48 * 1024; bf16_t* WFH = (bf16_t*)(F.ws + WS_WF); bf16_t* WFL = WFH + 16 * 1024;
        for (int i = gt; i < 4 * 48 * 1024; i += NGT) {
            const int l = i / (48 * 1024), r = i % (48 * 1024), c = r / 1024, k = r % 1024;
            const float w = (c < 4) ? in[I_WGRP][((size_t)l * 1024 + k) * 4 + c] : (c < 36 ? in[I_WEXP][((size_t)l * 1024 + k) * 32 + (c - 4)] : 0.f);
            const unsigned h = f2bf(w); RTH[i] = (bf16_t)h; RTL[i] = (bf16_t)f2bf(w - bf2f((unsigned short)h));
        }
        for (int i = gt; i < 16 * 1024; i += NGT) { const int c = i / 1024, k = i % 1024; const float w = in[I_KVW][(size_t)k * 2064 + 2048 + c];
            const unsigned h = f2bf(w); WFH[i] = (bf16_t)h; WFL[i] = (bf16_t)f2bf(w - bf2f((unsigned short)h)); }
    }
    LAS float* scr = (LAS float*)(F.lds + F.wave * 8704);
    const int gw = F.bid * NWAVES + F.wave, NGW = F.G * NWAVES;
    constexpr int N_S1 = 2 * 3 * 512;
    constexpr int N_S2 = 2 * 17 * 32;
    constexpr int N_S3 = 2 * 128;
    constexpr int N_S4 = 2 * 512 + 1024 + 2 * 1024 + 2 * 512;
    constexpr int N_TOT = N_S1 + N_S2 + N_S3 + N_S4;
    for (int it = gw; it < N_TOT; it += NGW) {
        int r = it;
        if (r < N_S1) {
            const int l = r / 1536; r %= 1536; const int p = r / 512; r %= 512; const int kb = r / 32, nb = r % 32;
            tr_item(in[I_RKV] + (size_t)(l * 3 + p) * 1024 * 1024, 1024, 1024, 64 * kb, 32 * nb, nullptr,
                    (bf16_t*)(F.ws + WS_RWBIG) + (size_t)l * 3072 * 1024, 1024, p * 1024 + 32 * nb, 64 * kb, scr, F.lane);
            continue;
        }
        r -= N_S1;
        if (r < N_S2) {
            const int l = r / (17 * 32); r %= (17 * 32); const int nbk = r / 32, sub = r % 32, half = sub / 16, kb = sub % 16;
            if (nbk >= 16) continue;
            bf16_t* WT = (bf16_t*)(F.ws + WS_RWLORA) + (size_t)l * 512 * RWK;
            const float* W = nullptr; int ldw = 0, n0 = 0, mui = 0;
            if (nbk < 2) { W = in[I_W1] + (size_t)l * 1024 * 64; ldw = 64; n0 = 32 * nbk; mui = 1; }
            else if (nbk < 4) { W = in[I_A1] + (size_t)l * 1024 * 64; ldw = 64; n0 = 32 * (nbk - 2); mui = 4; }
            else if (nbk < 9) { W = in[I_G1] + (size_t)l * 1024 * 160; ldw = 160; n0 = 32 * (nbk - 4); mui = 5; }
            else if (nbk == 9 && l == 1) { W = in[I_V1]; ldw = 32; n0 = 0; mui = 3; }
            if (W) tr_item(W, ldw, 1024, 64 * kb, n0, half ? in[I_MU] + (l * 6 + mui) * 1024 : nullptr, WT, RWK, 32 * nbk, half * 1024 + 64 * kb, scr, F.lane);
            else zero_item(WT, RWK, 32 * nbk, half * 1024 + 64 * kb, half * 1024 + 64 * kb + 64, F.lane);
            continue;
        }
        r -= N_S2;
        if (r < N_S3) {
            const int l = r / 128; r %= 128; const int blk = r / 32, nb = r % 32;
            unsigned char* base = F.ws + WS_LORA2 + (size_t)l * MiB;
            if (blk == 0) { tr_item(in[I_W2] + (size_t)l * 64 * 1024, 1024, 64, 0, 32 * nb, nullptr, (bf16_t*)(base + L2_W2T), 64, 32 * nb, 0, scr, F.lane); }
            else if (blk == 1) { tr_item(in[I_A2] + (size_t)l * 64 * 1024, 1024, 64, 0, 32 * nb, nullptr, (bf16_t*)(base + L2_A2T), 64, 32 * nb, 0, scr, F.lane); }
            else if (blk == 2) { for (int kb = 0; kb < 4; ++kb) tr_item(in[I_G2] + (size_t)l * 160 * 1024, 1024, 160, 64 * kb, 32 * nb, nullptr, (bf16_t*)(base + L2_G2T), G2K, 32 * nb, 64 * kb, scr, F.lane); }
            else { if (l == 1) tr_item(in[I_V2], 1024, 32, 0, 32 * nb, nullptr, (bf16_t*)(base + L2_V2T), 64, 32 * nb, 0, scr, F.lane); }
            continue;
        }
        r -= N_S3;
        if (r < N_S4) {
            if (r < 1024) { const int l = r / 512; r %= 512; tr_item(in[I_RWO] + (size_t)l * 1024 * 1024, 1024, 1024, 64 * (r / 32), 32 * (r % 32), nullptr, (bf16_t*)(F.ws + WS_RWWO) + (size_t)l * 1024 * 1024, 1024, 32 * (r % 32), 64 * (r / 32), scr, F.lane); continue; }
            r -= 1024;
            if (r < 1024) { tr_item(in[I_KVW], 2064, 1024, 64 * (r / 64), 32 * (r % 64), nullptr, (bf16_t*)(F.ws + WS_KVW), 1024, 32 * (r % 64), 64 * (r / 64), scr, F.lane); continue; }
            r -= 1024;
            if (r < 2048) { const int j = r / 1024; r %= 1024; tr_item(in[I_WQG] + (size_t)j * 1024 * 2048, 2048, 1024, 64 * (r / 64), 32 * (r % 64), nullptr, (bf16_t*)(F.ws + WS_FXQG) + (size_t)j * 2048 * 1024, 1024, 32 * (r % 64), 64 * (r / 64), scr, F.lane); continue; }
            r -= 2048;
            { const int j = r / 512; r %= 512; tr_item(in[I_FWO] + (size_t)j * 1024 * 1024, 1024, 1024, 64 * (r / 32), 32 * (r % 32), nullptr, (bf16_t*)(F.ws + WS_FXWO) + (size_t)j * 1024 * 1024, 1024, 32 * (r % 32), 64 * (r / 32), scr, F.lane); continue; }
        }
    }
}
__device__ __forceinline__ void moe_convert(Frame& F, int l, int wg0, int nwg) {
    const InTab in = F.in;
    LAS float* scr = (LAS float*)(F.lds + F.wave * 8704);
    if (F.bid < wg0 || F.bid >= wg0 + nwg) return;
    const int gw = (F.bid - wg0) * NWAVES + F.wave, NGW = nwg * NWAVES;
    bf16_t* base = (bf16_t*)(F.ws + WS_MOE);
    const int kr = F.lane >> 3, n4 = 4 * (F.lane & 7), c = F.lane & 7;
#define MC_DECODE(it_, W_, ldw_, k0_, n0_, WT_, ldt_, nd0_, kd0_) do { const int e_ = (it_) / 768; int r_ = (it_) % 768; const int le_ = l * 32 + e_; \
        if (r_ < 512) { const int kb_ = r_ / 32, nb_ = r_ % 32, s_ = (nb_ % 8) / 4; W_ = (s_ ? in[I_WUP] : in[I_WGATE]) + (size_t)le_ * 1024 * 512; ldw_ = 512; k0_ = 64 * kb_; n0_ = 128 * (nb_ / 8) + 32 * (nb_ % 4); \
            WT_ = base + (size_t)e_ * 1024 * 1024; ldt_ = 1024; nd0_ = 32 * nb_; kd0_ = 64 * kb_; } \
        else { r_ -= 512; const int kb_ = r_ / 32, nb_ = r_ % 32; W_ = in[I_WDOWN] + (size_t)le_ * 512 * 1024; ldw_ = 1024; k0_ = 64 * kb_; n0_ = 32 * nb_; \
            WT_ = base + (size_t)32 * 1024 * 1024 + (size_t)e_ * 1024 * 512; ldt_ = 512; nd0_ = 32 * nb_; kd0_ = 64 * kb_; } } while (0)
    f32x4 v[8];
    { int it = gw; if (it < 32 * 768) { const float* W; int ldw, k0, n0; bf16_t* WT; int ldt, nd0, kd0; MC_DECODE(it, W, ldw, k0, n0, WT, ldt, nd0, kd0);
#pragma unroll
        for (int i = 0; i < 8; ++i) v[i] = *(const f32x4*)(W + (size_t)(k0 + kr + 8 * i) * ldw + n0 + n4); (void)WT; (void)ldt; (void)nd0; (void)kd0; } }
    for (int it = gw; it < 32 * 768; it += NGW) {
        const float* W; int ldw, k0, n0; bf16_t* WT; int ldt, nd0, kd0; MC_DECODE(it, W, ldw, k0, n0, WT, ldt, nd0, kd0);
#pragma unroll
        for (int i = 0; i < 8; ++i) { LAS float* d = scr + (kr + 8 * i) * 33 + n4; d[0] = v[i][0]; d[1] = v[i][1]; d[2] = v[i][2]; d[3] = v[i][3]; }
        if (it + NGW < 32 * 768) { const float* Wn; int ldwn, k0n, n0n; bf16_t* WTn; int ldtn, nd0n, kd0n; MC_DECODE(it + NGW, Wn, ldwn, k0n, n0n, WTn, ldtn, nd0n, kd0n);
#pragma unroll
            for (int i = 0; i < 8; ++i) v[i] = *(const f32x4*)(Wn + (size_t)(k0n + kr + 8 * i) * ldwn + n0n + n4); (void)WTn; (void)ldtn; (void)nd0n; (void)kd0n; }
        LDS_WAIT(); asm volatile("" ::: "memory");
#pragma unroll
        for (int j = 0; j < 4; ++j) {
            const int n = (F.lane >> 3) + 8 * j; const LAS float* sp = scr + (8 * c) * 33 + n;
            u32x4 o; o.x = pk2(sp[0 * 33], sp[1 * 33]); o.y = pk2(sp[2 * 33], sp[3 * 33]); o.z = pk2(sp[4 * 33], sp[5 * 33]); o.w = pk2(sp[6 * 33], sp[7 * 33]);
            __builtin_nontemporal_store(o, (u32x4*)(WT + (size_t)(nd0 + n) * ldt + kd0 + 8 * c));
        }
        LDS_WAIT(); asm volatile("" ::: "memory");
    }
#undef MC_DECODE
    __syncthreads();
}

struct Unit { int pm, pn; };
struct SchedDense {
    int nM, nN, G, c;
    __device__ __forceinline__ bool next(int i, Unit& u) const {
        const int nwg = nM * nN; const long L = (long)i * G + c; if (L >= nwg) return false;
        int wgid = (int)L; { const int q = nwg / 8, r = nwg % 8, xcd = wgid % 8, off = wgid / 8; wgid = (xcd < r ? xcd * (q + 1) : r * (q + 1) + (xcd - r) * q) + off; }
        const int nig = 8 * nN, gid = wgid / nig, fm = gid * 8, gsz = (nM - fm) < 8 ? (nM - fm) : 8;
        u.pm = fm + ((wgid % nig) % gsz); u.pn = (wgid % nig) / gsz; return true;
    }
    __device__ __forceinline__ size_t boff(const Unit& u, int K) const { return (size_t)u.pn * 256 * K; }
    __device__ __forceinline__ size_t aoff(const Unit&) const { return 0; }
};
struct SchedRKV : SchedDense {
    __device__ __forceinline__ size_t aoff(const Unit& u) const { return (size_t)(u.pn >> 2) * X3S; }
};
struct SchedMoe {
    const LAS int* tt; int ntiles, G, c; size_t estride;
    __device__ __forceinline__ bool next(int i, Unit& u) const { const long L = (long)i * G + c; if (L >= (long)ntiles * 4) return false; u.pm = (int)(L / 4); u.pn = (int)(L % 4); return true; }
    __device__ __forceinline__ size_t boff(const Unit& u, int K) const { return (size_t)(tt[u.pm] >> 16) * estride + (size_t)u.pn * 256 * K; }
    __device__ __forceinline__ size_t aoff(const Unit&) const { return 0; }
};
template <class Epi, class Sched>
__device__ __forceinline__ void gemm_phase(Frame& F, const bf16_t* A, int lda, const bf16_t* Bt, int K, const Sched& S, const Epi& E) {
    const int wr = F.wave >> 2, wc = F.wave & 3, fr = F.lane & 15, fq = F.lane >> 4;
    Unit u;
    for (int i = 0; S.next(i, u); ++i) {
        const bf16_t* Bb = Bt + S.boff(u, K) + (size_t)(wc * 32 + fr) * K + 8 * fq;
        for (int ai = 0; ai < 2; ++ai) {
            f32x4 acc[2][4][2];
#pragma unroll
            for (int b = 0; b < 2; ++b)
#pragma unroll
                for (int m = 0; m < 4; ++m)
#pragma unroll
                    for (int n = 0; n < 2; ++n) acc[b][m][n] = (f32x4){0.f, 0.f, 0.f, 0.f};
            const bf16_t* Ab = A + (size_t)(u.pm * 256 + ai * 128 + wr * 64 + fr) * lda + 8 * fq;
            for (int k0 = 0; k0 < K; k0 += 32) {
                bf16x8 bfr[2][2], af[4];
#pragma unroll
                for (int b = 0; b < 2; ++b)
#pragma unroll
                    for (int n = 0; n < 2; ++n) bfr[b][n] = *(const bf16x8*)(Bb + (size_t)(b * 128 + n * 16) * K + k0);
#pragma unroll
                for (int m = 0; m < 4; ++m) af[m] = *(const bf16x8*)(Ab + (size_t)(m * 16) * lda + k0);
#pragma unroll
                for (int b = 0; b < 2; ++b)
#pragma unroll
                    for (int m = 0; m < 4; ++m)
#pragma unroll
                        for (int n = 0; n < 2; ++n) acc[b][m][n] = __builtin_amdgcn_mfma_f32_16x16x32_bf16(bfr[b][n], af[m], acc[b][m][n], 0, 0, 0);
            }
            E(acc, ai, u, wr, wc, fr, fq);
        }
    }
}
#define PG8_LAS __attribute__((address_space(3)))
constexpr int BM = 256, BK = 64, HALF = 128, HTB = HALF * BK * 2  , STAGE_BYTES = 8 * HTB;

__host__ __device__ __forceinline__ int lds_byte(int r, int c) { const int st = (r >> 4) * 2 + (c >> 5), rr = r & 15, cc = c & 31, ob = rr * 64 + cc * 2; return st * 1024 + (ob ^ (((ob >> 9) & 1) << 5)); }
__host__ __device__ __forceinline__ void stage_rc(int b, int& R, int& C) { const int st = b / 1024, sb = b % 1024, swz = sb ^ (((sb >> 9) & 1) << 5); R = (st >> 1) * 16 + swz / 64; C = (st & 1) * 32 + (swz % 64) / 2; }
__host__ __device__ __forceinline__ int perm32(int rho) { const int n = rho >> 4, i = rho & 15; return 8 * (i >> 2) + 4 * n + (i & 3); }
template <class Epi, class Sched, bool GATHER = false, bool ALIGN_EPI = true, bool SP2 = true>
__device__ __forceinline__ void gemm_fast(Frame& F, const bf16_t* Ag, int lda, const bf16_t* Btg, int Kin, const Sched& S, const Epi& E, const LAS int* tokL = nullptr) {
    static_assert(!GATHER || SP2, "gather mode is written for the SP2 loop");
    PG8_LAS unsigned char* lds = (PG8_LAS unsigned char*)F.lds;
    const int tid = F.tid, wid = F.wave, lane = F.lane, wr = wid >> 2, wc = wid & 3, fr = lane & 15, fq = lane >> 4;
    int K = Kin; asm volatile("" : "+s"(K));
    const int nt = K / BK;
    unsigned voffA[2], voffB[2];
#pragma unroll
    for (int i = 0; i < 2; ++i) { int R, C; stage_rc(tid * 16 + i * 8192, R, C); const int Rb = (Epi::BCONT ? (R >> 5) * 64 : (R & ~31)) + perm32(R & 31);
        voffA[i] = (unsigned)(R * lda + C) * 2u; voffB[i] = (unsigned)(Rb * K + C) * 2u; }
    const size_t kstep = (size_t)(BK * 2);
    const size_t hstepA = (size_t)HALF * lda * 2, hstep = (size_t)(Epi::BCONT ? 32 : HALF) * K * 2;
    const size_t tstepA = 2 * hstepA;
    const unsigned ldsw = (unsigned)wid * 1024u;
    const int aoff = lds_byte(wr * 64 + fr, fq * 8), boff = lds_byte(wc * 32 + fr, fq * 8);
#define PG8_SA(b, h) (((b) * 2 + (h)) * HTB)
#define PG8_SB(b, h) ((4 + (b) * 2 + (h)) * HTB)
    const unsigned ldsb = (unsigned)__builtin_amdgcn_readfirstlane((int)((unsigned)(size_t)lds + ldsw));
#define PG8_STAGE(bufoff, gbase, voff) do { _Pragma("unroll") for (int _i = 0; _i < 2; ++_i) { unsigned keep_; \
        asm volatile("s_mov_b32 %0, m0\n\ts_mov_b32 m0, %3\n\ts_nop 0\n\tglobal_load_lds_dwordx4 %1, %2\n\ts_mov_b32 m0, %0" : "=&s"(keep_) : "v"((voff)[_i]), "s"((const char*)(gbase)), "s"(ldsb + (unsigned)((bufoff) + _i * 8192)) : "memory"); } } while (0)
    unsigned gcu[2][2] = {{0u, 0u}, {0u, 0u}}, gnx[2][2] = {{0u, 0u}, {0u, 0u}};
#define PG8_GOFS(dst, ord) do { int tl_ = tid; asm volatile("" : "+v"(tl_));   _Pragma("unroll") for (int _h = 0; _h < 2; ++_h) _Pragma("unroll") for (int _i = 0; _i < 2; ++_i) { int R_, C_; stage_rc(tl_ * 16 + _i * 8192, R_, C_); \
        dst[_h][_i] = ((unsigned)tokL[(ord) * 256 + _h * 128 + R_] * (unsigned)lda + (unsigned)C_) * 2u; } } while (0)
#define PG8_STAGE_A(bufoff, gptr, half, usenext) do { if constexpr (GATHER) { unsigned vv_[2]; _Pragma("unroll") for (int _j = 0; _j < 2; ++_j) vv_[_j] = (usenext) ? gnx[half][_j] : gcu[half][_j]; PG8_STAGE(bufoff, gptr, vv_); } \
        else { PG8_STAGE(bufoff, (gptr) + ((half) ? hstepA : (size_t)0), voffA); } } while (0)
#define PG8_LDA(dst, b, h) do { _Pragma("unroll") for (int m = 0; m < 4; ++m) _Pragma("unroll") for (int k = 0; k < 2; ++k) dst[m][k] = *(const PG8_LAS bf16x8*)(lds + PG8_SA(b, h) + aoff + m * 2048 + k * 1024); } while (0)
#define PG8_LDB(dst, b, h) do { _Pragma("unroll") for (int n = 0; n < 2; ++n) _Pragma("unroll") for (int k = 0; k < 2; ++k) dst[n][k] = *(const PG8_LAS bf16x8*)(lds + PG8_SB(b, h) + boff + n * 2048 + k * 1024); } while (0)
#define PG8_MMA(ai, bj, At, Bt) do { __builtin_amdgcn_s_setprio(1); _Pragma("unroll") for (int m = 0; m < 4; ++m) _Pragma("unroll") for (int n = 0; n < 2; ++n) _Pragma("unroll") for (int k = 0; k < 2; ++k) \
        acc[ai][bj][m][n] = __builtin_amdgcn_mfma_f32_16x16x32_bf16(Bt[n][k], At[m][k], acc[ai][bj][m][n], 0, 0, 0); __builtin_amdgcn_s_setprio(0); } while (0)
#define PG8_WAIT_V(n) asm volatile("s_waitcnt vmcnt(" #n ")" ::: "memory")
#define PG8_WAIT_R(rel) do { if (rel) asm volatile("s_waitcnt vmcnt(%0)" :: "n"(8 + Epi::NST) : "memory"); else PG8_WAIT_V(8); } while (0)
#define PG8_WAIT_L(n) asm volatile("s_waitcnt lgkmcnt(" #n ")" ::: "memory")
#define PG8_BAR __builtin_amdgcn_s_barrier()
#define PG8_SCHED __builtin_amdgcn_sched_barrier(0)
    Unit cur, nxt; int ui = 0;
    if (!S.next(0, cur)) return;
    f32x4 acc[2][2][4][2];
#pragma unroll
    for (int a = 0; a < 2; ++a)
#pragma unroll
        for (int b = 0; b < 2; ++b)
#pragma unroll
            for (int m = 0; m < 4; ++m)
#pragma unroll
                for (int n = 0; n < 2; ++n) acc[a][b][m][n] = (f32x4){0.f, 0.f, 0.f, 0.f};
    bf16x8 At[4][2], B0[2][2], B1[2][2];
    const char* cA = GATHER ? (const char*)Ag : (const char*)Ag + 2 * S.aoff(cur) + (size_t)cur.pm * tstepA; const char* cB = (const char*)Btg + 2 * S.boff(cur, K);
    if constexpr (GATHER) PG8_GOFS(gcu, 0);
    if constexpr (SP2) {
        PG8_STAGE(PG8_SB(0, 0), cB, voffB); PG8_STAGE(PG8_SB(0, 1), cB + hstep, voffB); PG8_STAGE_A(PG8_SA(0, 0), cA, 0, false); PG8_STAGE_A(PG8_SA(0, 1), cA, 1, false);
        if (wr == 1) PG8_BAR;
        PG8_WAIT_V(2); PG8_BAR;
        PG8_STAGE(PG8_SB(1, 0), cB + kstep, voffB); PG8_STAGE_A(PG8_SA(1, 0), cA + kstep, 0, false); PG8_STAGE(PG8_SB(1, 1), cB + hstep + kstep, voffB);
        PG8_WAIT_V(6); PG8_BAR;
    } else {
        PG8_STAGE(PG8_SB(0, 0), cB, voffB); PG8_STAGE(PG8_SA(0, 0), cA, voffA); PG8_STAGE(PG8_SB(0, 1), cB + hstep, voffB); PG8_STAGE(PG8_SA(0, 1), cA + hstepA, voffA);
        if (wr == 1) PG8_BAR;
        PG8_WAIT_V(4); PG8_BAR;
        PG8_STAGE(PG8_SB(1, 0), cB + kstep, voffB); PG8_STAGE(PG8_SA(1, 0), cA + kstep, voffA); PG8_STAGE(PG8_SB(1, 1), cB + hstep + kstep, voffB);
        PG8_WAIT_V(6); PG8_BAR;
    }
    for (;;) {
        const bool has_next = S.next(ui + 1, nxt);
        const char* nA = GATHER ? cA : (has_next ? (const char*)Ag + 2 * S.aoff(nxt) + (size_t)nxt.pm * tstepA : cA);
        if constexpr (GATHER) { if (has_next) PG8_GOFS(gnx, ui + 1); else { gnx[0][0] = gcu[0][0]; gnx[0][1] = gcu[0][1]; gnx[1][0] = gcu[1][0]; gnx[1][1] = gcu[1][1]; } } const char* nB = has_next ? (const char*)Btg + 2 * S.boff(nxt, K) : cB;
#define PG8_ITER(WAITA, ST11) do { \
            const bool last = (t == nt - 2); \
            const char* a1 = cA + (size_t)(t + 1) * kstep;                                             \
            const char* a2 = last ? nA : cA + (size_t)(t + 2) * kstep; const char* b2 = last ? nB : cB + (size_t)(t + 2) * kstep;     \
            const char* a3 = a2 + kstep; const char* b3 = b2 + kstep;                                \
              \
            PG8_LDB(B0, 0, 0); PG8_LDB(B1, 0, 1); PG8_SCHED; PG8_LDA(At, 0, 0); ST11; \
            WAITA; PG8_WAIT_L(0); PG8_BAR; PG8_MMA(0, 0, At, B0); PG8_MMA(0, 1, At, B1); PG8_BAR; PG8_SCHED; \
              \
            PG8_LDA(At, 0, 1); PG8_STAGE(PG8_SB(0, 0), b2, voffB); PG8_STAGE(PG8_SB(0, 1), b2 + hstep, voffB); PG8_STAGE_A(PG8_SA(0, 0), a2, 0, last); \
            WAITA; PG8_WAIT_L(0); PG8_BAR; PG8_MMA(1, 0, At, B0); PG8_MMA(1, 1, At, B1); PG8_BAR; PG8_SCHED; \
              \
            PG8_LDB(B0, 1, 0); PG8_LDB(B1, 1, 1); PG8_SCHED; PG8_LDA(At, 1, 0); PG8_STAGE_A(PG8_SA(0, 1), a2, 1, last); \
            WAITA; PG8_WAIT_L(0); PG8_BAR; PG8_MMA(0, 0, At, B0); PG8_MMA(0, 1, At, B1); PG8_BAR; PG8_SCHED; \
              \
            PG8_LDA(At, 1, 1); PG8_STAGE(PG8_SB(1, 0), b3, voffB); PG8_STAGE(PG8_SB(1, 1), b3 + hstep, voffB); PG8_STAGE_A(PG8_SA(1, 0), a3, 0, last); \
            PG8_WAIT_V(8); PG8_WAIT_L(0); PG8_BAR; PG8_MMA(1, 0, At, B0); PG8_MMA(1, 1, At, B1); PG8_BAR; PG8_SCHED; } while (0)
        int t = 0;
        if (ui > 0) { PG8_ITER(asm volatile("s_waitcnt vmcnt(%0)" :: "n"(8 + Epi::NST) : "memory"), (void)0); t = 2; }
        for (; t < nt; t += 2) PG8_ITER(PG8_WAIT_V(8), PG8_STAGE_A(PG8_SA(1, 1), a1, 1, false));
#undef PG8_ITER
        if constexpr (SP2) { if (has_next) PG8_STAGE_A(PG8_SA(1, 1), nA + kstep, 1, true); }
        if constexpr (ALIGN_EPI) { if (wr == 0) PG8_BAR; }
        { int fr_ = fr, fq_ = fq; asm volatile("" : "+v"(fr_), "+v"(fq_)); E(acc[0], 0, cur, wr, wc, fr_, fq_); E(acc[1], 1, cur, wr, wc, fr_, fq_); }
        if (!has_next) break;
#pragma unroll
        for (int a = 0; a < 2; ++a)
#pragma unroll
            for (int b = 0; b < 2; ++b)
#pragma unroll
                for (int m = 0; m < 4; ++m)
#pragma unroll
                    for (int n = 0; n < 2; ++n) acc[a][b][m][n] = (f32x4){0.f, 0.f, 0.f, 0.f};
        cur = nxt; cA = nA; cB = nB; ++ui;
        if constexpr (GATHER) { gcu[0][0] = gnx[0][0]; gcu[0][1] = gnx[0][1]; gcu[1][0] = gnx[1][0]; gcu[1][1] = gnx[1][1]; }
        if constexpr (ALIGN_EPI) { if (wr == 1) PG8_BAR; }
    }
    PG8_WAIT_V(0);
    if constexpr (!ALIGN_EPI) { if (wr == 0) PG8_BAR; }
    PG8_BAR;
#undef PG8_SA
#undef PG8_SB
#undef PG8_STAGE
#undef PG8_LDA
#undef PG8_GOFS
#undef PG8_STAGE_A
#undef PG8_LDB
#undef PG8_MMA
#undef PG8_WAIT_V
#undef PG8_WAIT_R
#undef PG8_WAIT_L
#undef PG8_BAR
#undef PG8_SCHED
}
__device__ __forceinline__ void st_bf16x4(bf16_t* p, f32x4 v) { u32x2 w; w.x = pk2(v[0], v[1]); w.y = pk2(v[2], v[3]); *(u32x2*)p = w; }
__device__ __forceinline__ f32x4 ld_bf16x4(const bf16_t* p) { const u32x2 w = *(const u32x2*)p; return (f32x4){lo16(w.x), hi16(w.x), lo16(w.y), hi16(w.y)}; }
__device__ __forceinline__ u32x4 pk8(f32x4 a, f32x4 b) { u32x4 w; w.x = pk2(a[0], a[1]); w.y = pk2(a[2], a[3]); w.z = pk2(b[0], b[1]); w.w = pk2(b[2], b[3]); return w; }
__device__ __forceinline__ u32x4 bperm4(int idx, u32x4 w) { u32x4 r; r.x = (unsigned)__builtin_amdgcn_ds_bpermute(idx, (int)w.x); r.y = (unsigned)__builtin_amdgcn_ds_bpermute(idx, (int)w.y); r.z = (unsigned)__builtin_amdgcn_ds_bpermute(idx, (int)w.z); r.w = (unsigned)__builtin_amdgcn_ds_bpermute(idx, (int)w.w); return r; }
#define EPI_LOOP(ACT, ...) do { const int L_ = fq * 16 + fr, r3_ = L_ >> 3, p3_ = L_ & 7, src4_ = (((p3_ & 3) << 4) | r3_) << 2; const bool hi_ = (p3_ & 4) != 0; \
    _Pragma("unroll") for (int m = 0; m < 4; ++m) { u32x4 wb_[2]; \
        _Pragma("unroll") for (int bj = 0; bj < 2; ++bj) { const int colt0 = wc * 64 + bj * 32 + fq * 8; f32x4 v0 = acc[bj][m][0], v1 = acc[bj][m][1]; (void)colt0; ACT; wb_[bj] = pk8(v0, v1); } \
        _Pragma("unroll") for (int h = 0; h < 2; ++h) { const int row = u.pm * 256 + ai * 128 + wr * 64 + m * 16 + h * 8 + r3_, colt = wc * 64 + p3_ * 8; \
            const u32x4 wa_ = bperm4(src4_ + h * 32, wb_[0]), wc_ = bperm4(src4_ + h * 32, wb_[1]); u32x4 w; w.x = hi_ ? wc_.x : wa_.x; w.y = hi_ ? wc_.y : wa_.y; w.z = hi_ ? wc_.z : wa_.z; w.w = hi_ ? wc_.w : wa_.w; \
            __VA_ARGS__ } asm volatile("" ::: "memory"); } } while (0)

struct EpiPlain {
    bf16_t* O; int ldc; static constexpr int NST = 16; static constexpr bool BCONT = true;
    __device__ __forceinline__ void operator()(const f32x4 (&acc)[2][4][2], int ai, const Unit& u, int wr, int wc, int fr, int fq) const {
        EPI_LOOP(, { __builtin_nontemporal_store(w, (u32x4*)(O + (size_t)row * ldc + u.pn * 256 + colt)); });
    }
};
struct EpiNone { static constexpr int NST = 0; static constexpr bool BCONT = true;
    __device__ __forceinline__ void operator()(const f32x4 (&acc)[2][4][2], int ai, const Unit& u, int wr, int wc, int fr, int fq) const {
        _Pragma("unroll") for (int m = 0; m < 4; ++m) _Pragma("unroll") for (int bj = 0; bj < 2; ++bj) asm volatile("" :: "v"(acc[bj][m][0]), "v"(acc[bj][m][1])); }
};
struct EpiPriv { bf16_t* base; int bid; static constexpr int NST = 16; static constexpr bool BCONT = true;
    __device__ __forceinline__ void operator()(const f32x4 (&acc)[2][4][2], int ai, const Unit& u, int wr, int wc, int fr, int fq) const {
        EPI_LOOP(, { __builtin_nontemporal_store(w, (u32x4*)(base + (size_t)bid * 65536 + (size_t)(row - u.pm * 256) * 256 + colt)); });
    }
};
struct EpiRKV {
    bf16_t* RKV; bf16_t* VF; int l; static constexpr int NST = 16; static constexpr bool BCONT = true;
    __device__ __forceinline__ void operator()(const f32x4 (&acc)[2][4][2], int ai, const Unit& u, int wr, int wc, int fr, int fq) const {
        const bool vf = (l == 0) && (u.pn >= 8);
        EPI_LOOP(, { if (vf) __builtin_nontemporal_store(w, (u32x4*)(VF + (size_t)row * 1024 + (u.pn - 8) * 256 + colt)); else __builtin_nontemporal_store(w, (u32x4*)(RKV + (size_t)row * 3072 + u.pn * 256 + colt)); });
    }
};
struct EpiLA {
    bf16_t* LA; static constexpr int NST = 16; static constexpr bool BCONT = true;
    __device__ __forceinline__ void operator()(const f32x4 (&acc)[2][4][2], int ai, const Unit& u, int wr, int wc, int fr, int fq) const {
        EPI_LOOP({ const int c = u.pn * 256 + colt0;
            if (c < 64) { _Pragma("unroll") for (int q = 0; q < 4; ++q) { v0[q] = tanhf_(v0[q]); v1[q] = tanhf_(v1[q]); } }
            else if (c >= 128 && c < 288) { _Pragma("unroll") for (int q = 0; q < 4; ++q) { v0[q] = sigmoidf_(v0[q]); v1[q] = sigmoidf_(v1[q]); } } },
            { __builtin_nontemporal_store(w, (u32x4*)(LA + (size_t)row * LAW + u.pn * 256 + colt)); });
    }
};
struct EpiSplit2 {
    bf16_t* O0; bf16_t* O1; int sig1; static constexpr int NST = 16; static constexpr bool BCONT = true;
    __device__ __forceinline__ void operator()(const f32x4 (&acc)[2][4][2], int ai, const Unit& u, int wr, int wc, int fr, int fq) const {
        if (u.pn < 4) { EPI_LOOP(, { __builtin_nontemporal_store(w, (u32x4*)(O0 + (size_t)row * 1024 + u.pn * 256 + colt)); }); }
        else { EPI_LOOP({ if (sig1) { _Pragma("unroll") for (int q = 0; q < 4; ++q) { v0[q] = sigmoidf_(v0[q]); v1[q] = sigmoidf_(v1[q]); } } }, { __builtin_nontemporal_store(w, (u32x4*)(O1 + (size_t)row * 1024 + (u.pn - 4) * 256 + colt)); }); }
    }
};
struct EpiMoe1 {
    bf16_t* HM; static constexpr int NST = 8; static constexpr bool BCONT = false;
    __device__ __forceinline__ void operator()(const f32x4 (&acc)[2][4][2], int ai, const Unit& u, int wr, int wc, int fr, int fq) const {
        const int L_ = fq * 16 + fr, src4_ = (((L_ & 3) << 4) | (L_ >> 2)) << 2, r2_ = L_ >> 2, p2_ = L_ & 3;
#pragma unroll
            for (int m = 0; m < 4; ++m) { const int row = u.pm * 256 + ai * 128 + wr * 64 + m * 16 + r2_; f32x4 o[2];
#pragma unroll
                for (int n = 0; n < 2; ++n) { const f32x4 g = acc[0][m][n], up = acc[1][m][n];
#pragma unroll
                    for (int q = 0; q < 4; ++q) o[n][q] = g[q] * sigmoidf_(g[q]) * up[q]; }
                u32x4 w = pk8(o[0], o[1]); w.x = (unsigned)__builtin_amdgcn_ds_bpermute(src4_, (int)w.x); w.y = (unsigned)__builtin_amdgcn_ds_bpermute(src4_, (int)w.y); w.z = (unsigned)__builtin_amdgcn_ds_bpermute(src4_, (int)w.z); w.w = (unsigned)__builtin_amdgcn_ds_bpermute(src4_, (int)w.w);
                __builtin_nontemporal_store(w, (u32x4*)(HM + (size_t)row * 512 + u.pn * 128 + wc * 32 + p2_ * 8)); }
    }
};

struct Row { f32x4 v[4]; };
__device__ __forceinline__ Row ld_row_f32(const float* p, int lane) { Row r;
#pragma unroll
    for (int j = 0; j < 4; ++j) r.v[j] = *(const f32x4*)(p + 256 * j + 4 * lane); return r; }
__device__ __forceinline__ void st_row_f32(float* p, int lane, const Row& r) {
#pragma unroll
    for (int j = 0; j < 4; ++j) __builtin_nontemporal_store(r.v[j], (f32x4*)(p + 256 * j + 4 * lane)); }
__device__ __forceinline__ Row ld_row_bf16(const bf16_t* p, int lane) { Row r;
#pragma unroll
    for (int j = 0; j < 4; ++j) r.v[j] = ld_bf16x4(p + 256 * j + 4 * lane); return r; }
__device__ __forceinline__ void st_row_bf16(bf16_t* p, int lane, const Row& r) {
#pragma unroll
    for (int j = 0; j < 4; ++j) { u32x2 w; w.x = pk2(r.v[j][0], r.v[j][1]); w.y = pk2(r.v[j][2], r.v[j][3]); __builtin_nontemporal_store(w, (u32x2*)(p + 256 * j + 4 * lane)); } }
__device__ __forceinline__ Row row_ln(const Row& u, const Row& g, const Row& b) {
    float s = 0.f;
#pragma unroll
    for (int j = 0; j < 4; ++j) s += (u.v[j][0] + u.v[j][1]) + (u.v[j][2] + u.v[j][3]);
    const float mean = wave_sum(s) * (1.0f / 1024.0f); float q = 0.f; Row d;
#pragma unroll
    for (int j = 0; j < 4; ++j) { d.v[j] = u.v[j] - mean; q += (d.v[j][0] * d.v[j][0] + d.v[j][1] * d.v[j][1]) + (d.v[j][2] * d.v[j][2] + d.v[j][3] * d.v[j][3]); }
    const float rstd = 1.0f / sqrtf(wave_sum(q) * (1.0f / 1024.0f) + LN_EPS); Row o;
#pragma unroll
    for (int j = 0; j < 4; ++j) o.v[j] = d.v[j] * rstd * g.v[j] + b.v[j];
    return o;
}
__device__ __forceinline__ float row_dot(const Row& a, const float* w, int lane) {
    float s = 0.f;
#pragma unroll
    for (int j = 0; j < 4; ++j) { const f32x4 x = *(const f32x4*)(w + 256 * j + 4 * lane); s += (a.v[j][0] * x[0] + a.v[j][1] * x[1]) + (a.v[j][2] * x[2] + a.v[j][3] * x[3]); }
    return s;
}

constexpr int APITCH = 1032;
template <int NCB>
__device__ __forceinline__ void skinny_mfma(Frame& F, const LAS bf16_t* AH, const LAS bf16_t* AL, const bf16_t* BH, const bf16_t* BL, LAS float* part) {
    const int fr = F.lane & 15, fq = F.lane >> 4;
    f32x4 acc[NCB];
#pragma unroll
    for (int cb = 0; cb < NCB; ++cb) acc[cb] = (f32x4){0.f, 0.f, 0.f, 0.f};
#pragma unroll
    for (int kb = 0; kb < 4; ++kb) {
        const int k0 = 128 * F.wave + 32 * kb + 8 * fq;
        const bf16x8 ah = *(const LAS bf16x8*)(AH + fr * APITCH + k0), al = *(const LAS bf16x8*)(AL + fr * APITCH + k0);
#pragma unroll
        for (int cb = 0; cb < NCB; ++cb) {
            const bf16x8 bh = *(const bf16x8*)(BH + (size_t)(cb * 16 + fr) * 1024 + k0), bl = *(const bf16x8*)(BL + (size_t)(cb * 16 + fr) * 1024 + k0);
            acc[cb] = __builtin_amdgcn_mfma_f32_16x16x32_bf16(bh, ah, acc[cb], 0, 0, 0);
            acc[cb] = __builtin_amdgcn_mfma_f32_16x16x32_bf16(bl, ah, acc[cb], 0, 0, 0);
            acc[cb] = __builtin_amdgcn_mfma_f32_16x16x32_bf16(bh, al, acc[cb], 0, 0, 0);
        }
    }
#pragma unroll
    for (int cb = 0; cb < NCB; ++cb) *(LAS f32x4*)(part + (F.wave * 16 + fr) * 48 + cb * 16 + 4 * fq) = acc[cb];
}
template <int NCB> struct SkB { bf16x8 h[4][NCB], l[4][NCB]; };
template <int NCB>
__device__ __forceinline__ void skinny_loadB(Frame& F, const bf16_t* BH, const bf16_t* BL, SkB<NCB>& B) {
    int ln_ = F.lane; asm volatile("" : "+v"(ln_));
    const int fr = ln_ & 15, fq = ln_ >> 4;
#pragma unroll
    for (int kb = 0; kb < 4; ++kb) { const int k0 = 128 * F.wave + 32 * kb + 8 * fq;
#pragma unroll
        for (int cb = 0; cb < NCB; ++cb) { B.h[kb][cb] = *(const bf16x8*)(BH + (size_t)(cb * 16 + fr) * 1024 + k0); B.l[kb][cb] = *(const bf16x8*)(BL + (size_t)(cb * 16 + fr) * 1024 + k0); } }
}
template <int NCB>
__device__ __forceinline__ void skinny_mma(Frame& F, const LAS bf16_t* AH, const LAS bf16_t* AL, const SkB<NCB>& B, LAS float* part) {
    const int fr = F.lane & 15, fq = F.lane >> 4;
    f32x4 acc[NCB];
#pragma unroll
    for (int cb = 0; cb < NCB; ++cb) acc[cb] = (f32x4){0.f, 0.f, 0.f, 0.f};
#pragma unroll
    for (int kb = 0; kb < 4; ++kb) {
        const int k0 = 128 * F.wave + 32 * kb + 8 * fq;
        const bf16x8 ah = *(const LAS bf16x8*)(AH + fr * APITCH + k0), al = *(const LAS bf16x8*)(AL + fr * APITCH + k0);
#pragma unroll
        for (int cb = 0; cb < NCB; ++cb) {
            acc[cb] = __builtin_amdgcn_mfma_f32_16x16x32_bf16(B.h[kb][cb], ah, acc[cb], 0, 0, 0);
            acc[cb] = __builtin_amdgcn_mfma_f32_16x16x32_bf16(B.l[kb][cb], ah, acc[cb], 0, 0, 0);
            acc[cb] = __builtin_amdgcn_mfma_f32_16x16x32_bf16(B.h[kb][cb], al, acc[cb], 0, 0, 0);
        }
    }
#pragma unroll
    for (int cb = 0; cb < NCB; ++cb) *(LAS f32x4*)(part + (F.wave * 16 + fr) * 48 + cb * 16 + 4 * fq) = acc[cb];
}
struct RowPk { u32x2 v[4]; };
__device__ __forceinline__ RowPk ld_row_pk(const bf16_t* p, int lane) { RowPk r;
#pragma unroll
    for (int j = 0; j < 4; ++j) r.v[j] = *(const u32x2*)(p + 256 * j + 4 * lane); return r; }
__device__ __forceinline__ Row unpk_row(const RowPk& p) { Row r;
#pragma unroll
    for (int j = 0; j < 4; ++j) r.v[j] = (f32x4){lo16(p.v[j].x), hi16(p.v[j].x), lo16(p.v[j].y), hi16(p.v[j].y)}; return r; }
typedef _Float16 h16x2 __attribute__((ext_vector_type(2)));
__device__ __forceinline__ unsigned pkh2(float lo, float hi) { return __builtin_bit_cast(unsigned, __builtin_amdgcn_cvt_pkrtz(lo, hi)); }
__device__ __forceinline__ Row unpk_row_h(const RowPk& p) { Row r;
#pragma unroll
    for (int j = 0; j < 4; ++j) { const unsigned wx = p.v[j].x, wy = p.v[j].y;
        const h16x2 a = __builtin_bit_cast(h16x2, wx), b = __builtin_bit_cast(h16x2, wy); r.v[j] = (f32x4){(float)a[0], (float)a[1], (float)b[0], (float)b[1]}; } return r; }
__device__ __forceinline__ void st_row_h(bf16_t* p, int lane, const Row& r) {
#pragma unroll
    for (int j = 0; j < 4; ++j) { u32x2 w; w.x = pkh2(r.v[j][0], r.v[j][1]); w.y = pkh2(r.v[j][2], r.v[j][3]); __builtin_nontemporal_store(w, (u32x2*)(p + 256 * j + 4 * lane)); } }
__device__ __forceinline__ RowPk split_row(const Row& h, LAS bf16_t* ah, LAS bf16_t* al, int lane) { RowPk hp;
#pragma unroll
    for (int j = 0; j < 4; ++j) { unsigned hb[4], lb[4];
#pragma unroll
        for (int q = 0; q < 4; ++q) { hb[q] = f2bf(h.v[j][q]); lb[q] = f2bf(h.v[j][q] - __uint_as_float(hb[q] << 16)); }
        hp.v[j].x = hb[0] | (hb[1] << 16); hp.v[j].y = hb[2] | (hb[3] << 16);
        *(LAS u32x2*)(ah + 256 * j + 4 * lane) = hp.v[j]; u32x2 lw; lw.x = lb[0] | (lb[1] << 16); lw.y = lb[2] | (lb[3] << 16); *(LAS u32x2*)(al + 256 * j + 4 * lane) = lw; }
    return hp; }

template <bool DRY = false>
__device__ __forceinline__ void tok_a(Frame& F, int l) {
    const InTab in = F.in;
    const bf16_t* Y16 = (const bf16_t*)(F.ws + WS_Y16); bf16_t* Hb = (bf16_t*)(F.ws + WS_H2); bf16_t* XS = (bf16_t*)(F.ws + WS_XS);
    const bf16_t* RTH = (const bf16_t*)(F.ws + WS_RT) + (size_t)l * 48 * 1024; const bf16_t* RTL = RTH + (size_t)4 * 48 * 1024;
    float* gates = (float*)(F.ws + WS_GATE); int* asg = (int*)(F.ws + WS_ASG);
    LAS unsigned* lcnt = (LAS unsigned*)F.lds;
    LAS unsigned* ltab = (LAS unsigned*)(F.lds + 1024);
    LAS float* lgt = (LAS float*)(F.lds + 2048);
    LAS float* part = (LAS float*)(F.lds + 8192);
    LAS bf16_t* AH = (LAS bf16_t*)(F.lds + 32768); LAS bf16_t* AL = AH + 16 * APITCH;
    const Row lng = ld_row_f32(in[I_LNG] + (size_t)(l * 2 + 0) * 1024, F.lane), lnb = ld_row_f32(in[I_LNB] + (size_t)(l * 2 + 0) * 1024, F.lane);
    LAS f32x4* MODL = (LAS f32x4*)(F.lds + 98816);
    for (int blk = F.bid; blk < T / 128; blk += F.G) {
        if (F.tid < 64) lcnt[F.tid] = 0u;
        const int tb = blk * 128, b = tb / SEQ;
        const float* mod = (const float*)(F.ws + WS_MOD) + ((size_t)l * 8 + b) * 6144;
        if (F.wave < 3) {
#pragma unroll
            for (int j = 0; j < 4; ++j) MODL[(F.wave * 4 + j) * 64 + F.lane] = *(const f32x4*)(mod + (2 + F.wave) * 1024 + 256 * j + 4 * F.lane); }
        LBAR();
#define GT_(j) MODL[(0 * 4 + (j)) * 64 + F.lane]
#define SHF_(j) MODL[(1 * 4 + (j)) * 64 + F.lane]
#define SCF_(j) MODL[(2 * 4 + (j)) * 64 + F.lane]
        float rb0, rb1;
        { const int c0_ = F.tid % 48, c1_ = (F.tid + NTHR) % 48; rb0 = (c0_ < 4) ? in[I_BGRP][l * 4 + c0_] : (c0_ < 36 ? in[I_BEXP][l * 32 + (c0_ - 4)] : 0.f); rb1 = (c1_ < 4) ? in[I_BGRP][l * 4 + c1_] : (c1_ < 36 ? in[I_BEXP][l * 32 + (c1_ - 4)] : 0.f); }
        RowPk xr[2], yr[2];
#pragma unroll
        for (int q = 0; q < 2; ++q) { const int t = tb + 2 * F.wave + q; xr[q] = ld_row_pk(XS + (size_t)t * 1024, F.lane); yr[q] = ld_row_pk(Y16 + (size_t)t * 1024, F.lane); }
        SkB<3> SB; skinny_loadB<3>(F, RTH, RTL, SB);
        for (int r = 0; r < 8; ++r) {
#pragma unroll
            for (int q = 0; q < 2; ++q) {
                const int i = 2 * F.wave + q, t = tb + 16 * r + i;
                const Row y = unpk_row(yr[q]), xq = unpk_row_h(xr[q]); Row u;
#pragma unroll
                for (int j = 0; j < 4; ++j) u.v[j] = ALPHA * xq.v[j] + (1.0f + GT_(j)) * y.v[j];
                const Row x1 = row_ln(u, lng, lnb);
                if (!DRY) st_row_h(XS + (size_t)t * 1024, F.lane, x1);
                Row h;
#pragma unroll
                for (int j = 0; j < 4; ++j) h.v[j] = x1.v[j] * (1.0f + SCF_(j)) + SHF_(j);
                const RowPk hp = split_row(h, AH + i * APITCH, AL + i * APITCH, F.lane);
#pragma unroll
                for (int j = 0; j < 4; ++j) { if (!DRY) __builtin_nontemporal_store(hp.v[j], (u32x2*)(Hb + (size_t)t * 1024 + 256 * j + 4 * F.lane)); }
            }
#if defined(TOKA_PROBE) && TOKA_PROBE == 2
            if (DRY) { if (r < 7) {
#pragma unroll
                for (int q = 0; q < 2; ++q) { const int t = tb + 16 * (r + 1) + 2 * F.wave + q; xr[q] = ld_row_pk(XS + (size_t)t * 1024, F.lane); yr[q] = ld_row_pk(Y16 + (size_t)t * 1024, F.lane); } }
                LBAR(); continue; }
#endif
            if (r < 7) {
#pragma unroll
                for (int q = 0; q < 2; ++q) { const int t = tb + 16 * (r + 1) + 2 * F.wave + q; xr[q] = ld_row_pk(XS + (size_t)t * 1024, F.lane); yr[q] = ld_row_pk(Y16 + (size_t)t * 1024, F.lane); }
            }
            LBAR();
            skinny_mma<3>(F, AH, AL, SB, part);
            LBAR();
#pragma unroll
            for (int oo = 0; oo < 2; ++oo) { const int o = F.tid + NTHR * oo; if (o < 16 * 48) { const int i = o / 48, c = o % 48; float sm = 0.f;
#pragma unroll
                for (int w = 0; w < 8; ++w) sm += part[(w * 16 + i) * 48 + c];
                lgt[o] = sm + (oo ? rb1 : rb0); } }
            LBAR();
            if (F.tid < 16) {
                const int i = F.tid, t = tb + 16 * r + i; const LAS float* lg = lgt + i * 48;
                const f32x4 lg4 = *(const LAS f32x4*)lg;
                int gs = 0; float gm = lg4[0];
#pragma unroll
                for (int c = 1; c < 4; ++c) if (lg4[c] > gm) { gm = lg4[c]; gs = c; }
                float den = 0.f;
#pragma unroll
                for (int c = 0; c < 4; ++c) den += __expf(lg4[c] - gm);
                const float pg = 1.0f / den;
                const f32x4 le0 = *(const LAS f32x4*)(lg + 4 + gs * 8), le1 = *(const LAS f32x4*)(lg + 8 + gs * 8);
                const float le[8] = {le0[0], le0[1], le0[2], le0[3], le1[0], le1[1], le1[2], le1[3]};
                int i0 = 0; float m0 = le[0];
#pragma unroll
                for (int c = 1; c < 8; ++c) if (le[c] > m0) { m0 = le[c]; i0 = c; }
                int i1 = -1; float m1 = -3.0e38f;
#pragma unroll
                for (int c = 0; c < 8; ++c) if (c != i0 && le[c] > m1) { m1 = le[c]; i1 = c; }
                const float a = __expf(m1 - m0), g0 = pg / (1.0f + a), g1 = pg * a / (1.0f + a);
                const int e0 = gs * 8 + i0, e1 = gs * 8 + i1;
                const unsigned r0 = atomicAdd((unsigned*)&lcnt[e0], 1u), r1 = atomicAdd((unsigned*)&lcnt[e1], 1u);
                ltab[(16 * r + i) * 2] = ((unsigned)e0 << 24) | r0; ltab[(16 * r + i) * 2 + 1] = ((unsigned)e1 << 24) | r1;
                if (!DRY) { gates[(size_t)t * 2] = g0; gates[(size_t)t * 2 + 1] = g1; }
            }
        }
        LBAR();
        if (F.tid < 32) lcnt[32 + F.tid] = DRY ? 0u : __hip_atomic_fetch_add((unsigned*)(F.ws + WS_CTL) + CW_CNT + l * 32 + F.tid, lcnt[F.tid], __ATOMIC_RELAXED, __HIP_MEMORY_SCOPE_AGENT);
        LBAR();
        if (F.tid < 256 && !DRY) { const unsigned w = ltab[F.tid]; const unsigned e = w >> 24; const unsigned rk = (w & 0xffffffu) + lcnt[32 + e]; asg[(size_t)tb * 2 + F.tid] = (int)((e << 24) | rk);
            ((int*)(F.ws + WS_TLIST))[(size_t)e * 65536 + rk] = tb + (F.tid >> 1); }
        LBAR();
    }
}
#undef GT_
#undef SHF_
#undef SCF_
__device__ __forceinline__ void fgate_phase(Frame& F) {
    const InTab in = F.in;
    const bf16_t* WFH = (const bf16_t*)(F.ws + WS_WF); const bf16_t* WFL = WFH + 16 * 1024; float* LF = (float*)(F.ws + WS_LF); const bf16_t* XS = (const bf16_t*)(F.ws + WS_XS);
    LAS float* part = (LAS float*)(F.lds + 8192);
    LAS bf16_t* AH = (LAS bf16_t*)(F.lds + 32768); LAS bf16_t* AL = AH + 16 * APITCH;
    for (int blk = F.bid; blk < T / 128; blk += F.G) {
        const int tb = blk * 128, b = tb / SEQ;
        const float* kvm = (const float*)(F.ws + WS_KVMOD) + (size_t)b * 2048;
        const Row ksh = ld_row_f32(kvm, F.lane), ksc = ld_row_f32(kvm + 1024, F.lane);
        RowPk xr[2];
#pragma unroll
        for (int q = 0; q < 2; ++q) xr[q] = ld_row_pk(XS + (size_t)(tb + 2 * F.wave + q) * 1024, F.lane);
        SkB<1> SBF; skinny_loadB<1>(F, WFH, WFL, SBF);
        LBAR();
        for (int r = 0; r < 8; ++r) {
#pragma unroll
            for (int q = 0; q < 2; ++q) { const int i = 2 * F.wave + q; Row hk; const Row xq = unpk_row_h(xr[q]);
#pragma unroll
                for (int j = 0; j < 4; ++j) hk.v[j] = xq.v[j] * (1.0f + ksc.v[j]) + ksh.v[j];
                (void)split_row(hk, AH + i * APITCH, AL + i * APITCH, F.lane); }
            if (r < 7) {
#pragma unroll
                for (int q = 0; q < 2; ++q) xr[q] = ld_row_pk(XS + (size_t)(tb + 16 * (r + 1) + 2 * F.wave + q) * 1024, F.lane);
            }
            LBAR();
            skinny_mma<1>(F, AH, AL, SBF, part);
            LBAR();
            if (F.tid < 256) { const int i = F.tid >> 4, c = F.tid & 15; float sm = 0.f;
#pragma unroll
                for (int w = 0; w < 8; ++w) sm += part[(w * 16 + i) * 48 + c];
                const float z = sm + in[I_KVFB][c]; LF[(size_t)(tb + 16 * r + i) * 16 + c] = fminf(z, 0.f) - log1pf(__expf(-fabsf(z))); }
        }
        LBAR();
    }
}

template <bool DRY = false>
__device__ __forceinline__ void tok_b(Frame& F, int l, int next) {
    const InTab in = F.in;
    bf16_t* Hb = (bf16_t*)(F.ws + WS_H2); bf16_t* HK = (bf16_t*)(F.ws + WS_RA); bf16_t* XS = (bf16_t*)(F.ws + WS_XS);
    const bf16_t* YM = (const bf16_t*)(F.ws + WS_RA + 144 * MiB);
    const int* asg = (const int*)(F.ws + WS_ASG); const float* gates = (const float*)(F.ws + WS_GATE); const LAS int* lc = (const LAS int*)(F.lds + MOE_LC_OFF);
    const Row lng = ld_row_f32(in[I_LNG] + (size_t)(l * 2 + 1) * 1024, F.lane), lnb = ld_row_f32(in[I_LNB] + (size_t)(l * 2 + 1) * 1024, F.lane);
    const int gw = F.bid * NWAVES + F.wave, NGW = F.G * NWAVES;
    for (int run = gw; run < T / 8; run += NGW) {
        const int t0 = run * 8, b = t0 / SEQ;
        const Row gt = ld_row_f32((const float*)(F.ws + WS_MOD) + ((size_t)l * 8 + b) * 6144 + 5 * 1024, F.lane);
        Row shm, scm;
        if (next < 3) { const float* modn = (const float*)(F.ws + WS_MOD) + ((size_t)(l + 1) * 8 + b) * 6144; shm = ld_row_f32(modn, F.lane); scm = ld_row_f32(modn + 1024, F.lane); }
        else { shm = Row{}; scm = Row{}; }
        int dmine = 0; float gmine = 0.f;
        if (F.lane < 16) { const unsigned a = (unsigned)asg[(size_t)t0 * 2 + F.lane]; dmine = lc[32 + (a >> 24)] + (int)(a & 0xffffffu); gmine = gates[(size_t)t0 * 2 + F.lane]; }
        RowPk xc = ld_row_pk(XS + (size_t)t0 * 1024, F.lane);
        RowPk y0c = ld_row_pk(YM + (size_t)__shfl(dmine, 0) * 1024, F.lane), y1c = ld_row_pk(YM + (size_t)__shfl(dmine, 1) * 1024, F.lane);
        for (int tt = 0; tt < 8; ++tt) {
            const int t = t0 + tt, tn = (tt < 7) ? tt + 1 : tt;
            const RowPk xn = ld_row_pk(XS + (size_t)(t0 + tn) * 1024, F.lane);
            const RowPk y0n = ld_row_pk(YM + (size_t)__shfl(dmine, 2 * tn) * 1024, F.lane), y1n = ld_row_pk(YM + (size_t)__shfl(dmine, 2 * tn + 1) * 1024, F.lane);
            const float g0 = __shfl(gmine, 2 * tt), g1 = __shfl(gmine, 2 * tt + 1);
            const Row y0 = unpk_row(y0c), y1 = unpk_row(y1c), xq = unpk_row_h(xc); Row u;
#pragma unroll
            for (int j = 0; j < 4; ++j) u.v[j] = ALPHA * xq.v[j] + (1.0f + gt.v[j]) * (g0 * y0.v[j] + g1 * y1.v[j]);
            const Row x2 = row_ln(u, lng, lnb);
            if (!DRY) { if (l == 3) st_row_f32(F.xs + (size_t)t * 1024, F.lane, x2); else st_row_h(XS + (size_t)t * 1024, F.lane, x2); } else asm volatile("" :: "v"(x2.v[0]), "v"(x2.v[1]), "v"(x2.v[2]), "v"(x2.v[3]));
            if (next != 3) {
                Row h;
#pragma unroll
                for (int j = 0; j < 4; ++j) h.v[j] = x2.v[j] * (1.0f + scm.v[j]) + shm.v[j];
                if (!DRY) st_row_bf16(Hb + (size_t)t * 1024, F.lane, h); else asm volatile("" :: "v"(h.v[0]), "v"(h.v[3]));
                if (next == 1) {
                    const float* kvm = (const float*)(F.ws + WS_KVMOD) + (size_t)b * 2048;
                    const Row ksh = ld_row_f32(kvm, F.lane), ksc = ld_row_f32(kvm + 1024, F.lane); Row hk;
#pragma unroll
                    for (int j = 0; j < 4; ++j) hk.v[j] = x2.v[j] * (1.0f + ksc.v[j]) + ksh.v[j];
                    if (!DRY) st_row_bf16(HK + (size_t)t * 1024, F.lane, hk); else asm volatile("" :: "v"(hk.v[0]), "v"(hk.v[3]));
                }
            }
            xc = xn; y0c = y0n; y1c = y1n;
        }
    }
}

__device__ __forceinline__ void rw_prep(Frame& F, int ln, bool from_input) {
    bf16_t* Hb = (bf16_t*)(F.ws + WS_H2); bf16_t* X3 = (bf16_t*)(F.ws + WS_SC);
    const float* src = F.in[I_X]; bf16_t* XS = (bf16_t*)(F.ws + WS_XS);
    const float* mu = F.in[I_MU] + (size_t)ln * 6 * 1024;
    const Row mur = ld_row_f32(mu, F.lane), muk = ld_row_f32(mu + 2 * 1024, F.lane), muv = ld_row_f32(mu + 3 * 1024, F.lane);
    const int gw = F.bid * NWAVES + F.wave, NGW = F.G * NWAVES;
    for (int run = gw; run < T / 8; run += NGW) {
        const int t0 = run * 8, b = t0 / SEQ;
        const float* modn = (const float*)(F.ws + WS_MOD) + ((size_t)ln * 8 + b) * 6144;
        const Row shm = ld_row_f32(modn, F.lane), scm = ld_row_f32(modn + 1024, F.lane);
        Row hprev;
#pragma unroll
        for (int j = 0; j < 4; ++j) hprev.v[j] = (f32x4){0.f, 0.f, 0.f, 0.f};
        if ((t0 % SEQ) != 0) {
            const Row xp = from_input ? ld_row_f32(src + (size_t)(t0 - 1) * 1024, F.lane) : unpk_row_h(ld_row_pk(XS + (size_t)(t0 - 1) * 1024, F.lane));
#pragma unroll
            for (int j = 0; j < 4; ++j) hprev.v[j] = xp.v[j] * (1.0f + scm.v[j]) + shm.v[j];
        }
        Row xc = Row{}; RowPk xcp = RowPk{};
        if (from_input) xc = ld_row_f32(src + (size_t)t0 * 1024, F.lane); else xcp = ld_row_pk(XS + (size_t)t0 * 1024, F.lane);
        for (int tt = 0; tt < 8; ++tt) {
            const int t = t0 + tt, tnx = t0 + (tt < 7 ? tt + 1 : tt);
            const Row x = from_input ? xc : unpk_row_h(xcp);
            if (from_input) xc = ld_row_f32(src + (size_t)tnx * 1024, F.lane); else xcp = ld_row_pk(XS + (size_t)tnx * 1024, F.lane);
            if (from_input) st_row_h(XS + (size_t)t * 1024, F.lane, x);
            Row h, xx, xr, xk, xv;
#pragma unroll
            for (int j = 0; j < 4; ++j) { h.v[j] = x.v[j] * (1.0f + scm.v[j]) + shm.v[j]; xx.v[j] = hprev.v[j] - h.v[j];
                xr.v[j] = h.v[j] + xx.v[j] * mur.v[j]; xk.v[j] = h.v[j] + xx.v[j] * muk.v[j]; xv.v[j] = h.v[j] + xx.v[j] * muv.v[j]; }
            st_row_bf16(Hb + (size_t)t * 2048, F.lane, h); st_row_bf16(Hb + (size_t)t * 2048 + 1024, F.lane, xx);
            st_row_bf16(X3 + (size_t)t * 1024, F.lane, xr); st_row_bf16(X3 + X3S + (size_t)t * 1024, F.lane, xk); st_row_bf16(X3 + 2 * X3S + (size_t)t * 1024, F.lane, xv);
            hprev = h;
        }
    }
}

__device__ __forceinline__ void moe_tables(Frame& F, int l) {
    LAS int* lc = (LAS int*)(F.lds + MOE_LC_OFF);
    const unsigned* cnt = (const unsigned*)(F.ws + WS_CTL) + CW_CNT + l * 32;
    if (F.tid == 0) {
        int acc = 0, ntt = 0;
        for (int e = 0; e < 32; ++e) { const int c = (int)__hip_atomic_load(cnt + e, __ATOMIC_RELAXED, __HIP_MEMORY_SCOPE_AGENT); lc[e] = c; lc[32 + e] = acc; const int nt = (c + 255) >> 8;
            for (int i = 0; i < nt; ++i) lc[96 + ntt + i] = (e << 16) | i;
            ntt += nt; acc += nt << 8; }
        lc[64] = ntt;
    }
    __syncthreads();
}
template <class Sched> __device__ __forceinline__ void moe_rows(Frame& F, const Sched& S) {
    const LAS int* lc = (const LAS int*)(F.lds + MOE_LC_OFF); LAS int* tokL = (LAS int*)(F.lds + MOE_TOKL_OFF); const int* tlist = (const int*)(F.ws + WS_TLIST);
    Unit u;
    for (int i = 0; i < 6 && S.next(i, u); ++i) {
        if (F.tid < 256) { const int ek = lc[96 + u.pm], e = ek >> 16, rank = ((ek & 0xffff) << 8) + F.tid;
            tokL[i * 256 + F.tid] = tlist[(size_t)e * 65536 + (rank < lc[e] ? rank : 0)]; }
    }
    __syncthreads();
}

__device__ __forceinline__ float octsum(float v) { v += dpp_f<0xB1>(v); v += dpp_f<0x4E>(v); v += dpp_f<0x141>(v); return v; }
constexpr int CP = 72, SLOT = 64 * CP;
#define PX(r_, c_) ((r_) * 64 + (((((c_) >> 3) ^ (((r_) >> 1) & 7))) << 3) + ((c_) & 7))
constexpr size_t WS_MP = WS_SC, WS_QQ = WS_SC + 64 * MiB, WS_NT = WS_SC + 128 * MiB, WS_GL = WS_SC + 192 * MiB;
template <bool SWAP> __device__ __forceinline__ f32x4 tile_mm(const LAS bf16_t* Ap, const LAS bf16_t* Bp, int fr, int fq) {
    const int o0 = PX(fr, 8 * fq), o1 = PX(fr, 8 * fq + 32);
    const bf16x8 a0 = *(const LAS bf16x8*)(Ap + o0), a1 = *(const LAS bf16x8*)(Ap + o1);
    const bf16x8 b0 = *(const LAS bf16x8*)(Bp + o0), b1 = *(const LAS bf16x8*)(Bp + o1);
    f32x4 acc = (f32x4){0.f, 0.f, 0.f, 0.f};
    if (!SWAP) { acc = __builtin_amdgcn_mfma_f32_16x16x32_bf16(a0, b0, acc, 0, 0, 0); acc = __builtin_amdgcn_mfma_f32_16x16x32_bf16(a1, b1, acc, 0, 0, 0); }
    else       { acc = __builtin_amdgcn_mfma_f32_16x16x32_bf16(b0, a0, acc, 0, 0, 0); acc = __builtin_amdgcn_mfma_f32_16x16x32_bf16(b1, a1, acc, 0, 0, 0); }
    return acc;
}
__device__ __forceinline__ void ld8f(const float* p, float (&o)[8]) { const f32x4 a = *(const f32x4*)p, b = *(const f32x4*)(p + 4); o[0] = a[0]; o[1] = a[1]; o[2] = a[2]; o[3] = a[3]; o[4] = b[0]; o[5] = b[1]; o[6] = b[2]; o[7] = b[3]; }
__device__ __forceinline__ void st4_lds(LAS bf16_t* p, f32x4 v) { u32x2 w; w.x = pk2(v[0], v[1]); w.y = pk2(v[2], v[3]); *(LAS u32x2*)p = w; }
__device__ __forceinline__ f32x4 ld4_lds(const LAS bf16_t* p) { const u32x2 w = *(const LAS u32x2*)p; return (f32x4){lo16(w.x), hi16(w.x), lo16(w.y), hi16(w.y)}; }
__device__ __forceinline__ void unpk8(const u32x4 w, float (&o)[8]) { o[0] = lo16(w.x); o[1] = hi16(w.x); o[2] = lo16(w.y); o[3] = hi16(w.y); o[4] = lo16(w.z); o[5] = hi16(w.z); o[6] = lo16(w.w); o[7] = hi16(w.w); }
__device__ __forceinline__ void st8_lds(LAS bf16_t* p, const float (&o)[8]) { u32x4 w; w.x = pk2(o[0], o[1]); w.y = pk2(o[2], o[3]); w.z = pk2(o[4], o[5]); w.w = pk2(o[6], o[7]); *(LAS u32x4*)p = w; }

template <int PROBE = 0>
__device__ __forceinline__ void wkv_chunk_prep(Frame& F, int l) {
    const InTab in = F.in;
    const bf16_t* RKV = (const bf16_t*)(F.ws + WS_RA);
    bf16_t* YS = (bf16_t*)(F.ws + WS_Y16); bf16_t* MP = (bf16_t*)(F.ws + WS_MP); bf16_t* QQ = (bf16_t*)(F.ws + WS_QQ); bf16_t* NTt = (bf16_t*)(F.ws + WS_NT); float* GLB = (float*)(F.ws + WS_GL);
    LAS bf16_t* L0 = (LAS bf16_t*)F.lds;
#define SL(n) (L0 + (n) * 4096)
    LAS float* WLs = (LAS float*)(F.lds + 8 * 8192);
    LAS float* HC = WLs + 64 * 68;
    const int pt = F.tid >> 3, pc0 = 8 * (F.tid & 7);
    const bf16_t* LAg = (const bf16_t*)(F.ws + WS_RA + 192 * MiB); const bf16_t* VFg = (const bf16_t*)(F.ws + WS_P); float* BON = (float*)(F.ws + WS_LF);
    const bf16_t* W2T = (const bf16_t*)(F.ws + WS_LORA2 + (size_t)l * MiB + L2_W2T); const bf16_t* A2T = (const bf16_t*)(F.ws + WS_LORA2 + (size_t)l * MiB + L2_A2T); const bf16_t* V2T = (const bf16_t*)(F.ws + WS_LORA2 + (size_t)l * MiB + L2_V2T);
    u32x4 gr, gk, gv, glw, gla, glv, gvf, gw2, ga2, gv2;
#define PREP_LOAD(uu) do { const int bh_ = (uu) >> 6, c_ = (uu) & 63; const size_t row = (size_t)(bh_ >> 4) * SEQ + 64 * c_ + pt; const int hh = (bh_ & 15) * 64, hc = hh + pc0; \
        gr = *(const u32x4*)(RKV + row * 3072 + hc); gk = *(const u32x4*)(RKV + row * 3072 + 1024 + hc); gv = (l == 0) ? *(const u32x4*)(VFg + row * 1024 + hc) : *(const u32x4*)(RKV + row * 3072 + 2048 + hc); \
        glw = *(const u32x4*)(LAg + row * LAW + pc0); gla = *(const u32x4*)(LAg + row * LAW + 64 + pc0); \
        gw2 = *(const u32x4*)(W2T + (size_t)(hh + pt) * 64 + pc0); ga2 = *(const u32x4*)(A2T + (size_t)(hh + pt) * 64 + pc0); \
        if (l == 1) { glv = *(const u32x4*)(LAg + row * LAW + 288 + (pc0 & 31)); gvf = *(const u32x4*)(VFg + row * 1024 + hc); gv2 = *(const u32x4*)(V2T + (size_t)(hh + pt) * 64 + pc0); } \
        if (F.tid < 96) { const int vec_ = F.tid >> 4; const float* hp_ = (vec_ == 0) ? in[I_W0] + l * 1024 : (vec_ == 1) ? in[I_A0] + l * 1024 : (vec_ == 2) ? in[I_V0] : (vec_ == 3) ? in[I_KK] + l * 1024 : (vec_ == 4) ? in[I_KA] + l * 1024 : in[I_RK] + l * 1024; \
            ghc = *(const f32x4*)(hp_ + hh + 4 * (F.tid & 15)); } } while (0)
    glv = (u32x4){0u, 0u, 0u, 0u}; gvf = glv; gv2 = glv;
    f32x4 ghc = (f32x4){0.f, 0.f, 0.f, 0.f};
    if (F.bid < 128 * 64) PREP_LOAD(F.bid);
    for (int u = F.bid; u < 128 * 64; u += F.G) {
        const int bh = u >> 6, c = u & 63, b = bh >> 4, h = bh & 15;
        const size_t row0 = (size_t)b * SEQ + 64 * c;
        int ln_ = F.lane; asm volatile("" : "+v"(ln_));
        const int fr = ln_ & 15, fq = ln_ >> 4;
        *(LAS u32x4*)(SL(0) + PX(pt, pc0)) = glw; *(LAS u32x4*)(SL(1) + PX(pt, pc0)) = gla; *(LAS u32x4*)(SL(3) + PX(pt, pc0)) = gw2; *(LAS u32x4*)(SL(4) + PX(pt, pc0)) = ga2;
        if (l == 1) { *(LAS u32x4*)(SL(2) + PX(pt, pc0)) = (pc0 < 32) ? glv : (u32x4){0u, 0u, 0u, 0u}; *(LAS u32x4*)(SL(5) + PX(pt, pc0)) = gv2; }
        if (F.tid < 96) *(LAS f32x4*)(HC + (F.tid >> 4) * 64 + 4 * (F.tid & 15)) = ghc;
        LBAR();
        {
            f32x4 zw[2], za[2], zv[2];
#pragma unroll
            for (int i = 0; i < 2; ++i) { const int tile = F.wave + 8 * i, mt = tile >> 2, nt = tile & 3;
                zw[i] = tile_mm<false>(SL(0) + 16 * mt * 64, SL(3) + 16 * nt * 64, fr, fq);
                za[i] = tile_mm<true>(SL(1) + 16 * mt * 64, SL(4) + 16 * nt * 64, fr, fq);
                if (l == 1) zv[i] = tile_mm<true>(SL(2) + 16 * mt * 64, SL(5) + 16 * nt * 64, fr, fq); }
#pragma unroll
            for (int i = 0; i < 2; ++i) { const int tile = F.wave + 8 * i, mt = tile >> 2, nt = tile & 3; const int rr = 16 * mt + fr, cc = 16 * nt + 4 * fq;
                const float w0s = HC[16 * nt + fr]; const f32x4 a0v = *(const LAS f32x4*)(HC + 64 + cc); f32x4 av, wh, wlo;
#pragma unroll
                for (int q = 0; q < 4; ++q) { const float wl_ = -0.6065306597126334f * sigmoidf_(zw[i][q] + w0s); wh[q] = bf2f((unsigned short)f2bf(wl_)); wlo[q] = wl_ - wh[q]; av[q] = sigmoidf_(za[i][q] + a0v[q]); }
                st4_lds(SL(11) + PX(16 * nt + fr, 16 * mt + 4 * fq), wh); st4_lds(SL(12) + PX(16 * nt + fr, 16 * mt + 4 * fq), wlo);
                st4_lds(SL(6) + PX(rr, cc), av);
                if (l == 1) { const f32x4 v0v = *(const LAS f32x4*)(HC + 128 + cc); f32x4 sv;
#pragma unroll
                    for (int q = 0; q < 4; ++q) sv[q] = sigmoidf_(zv[i][q] + v0v[q]);
                    st4_lds(SL(7) + PX(rr, cc), sv); } }
        }
        LBAR();
        float r[8], k[8], v[8], a[8];
        unpk8(gr, r); unpk8(gk, k); unpk8(gv, v); unpk8(*(const LAS u32x4*)(SL(6) + PX(pt, pc0)), a);
        if (l == 1) { float sv[8], vf[8]; unpk8(*(const LAS u32x4*)(SL(7) + PX(pt, pc0)), sv); unpk8(gvf, vf);
#pragma unroll
            for (int q = 0; q < 8; ++q) v[q] = bf2f((unsigned short)f2bf(v[q] + (vf[q] - v[q]) * sv[q]));
            if (PROBE == 0) { u32x4 w; w.x = pk2(v[0], v[1]); w.y = pk2(v[2], v[3]); w.z = pk2(v[4], v[5]); w.w = pk2(v[6], v[7]); *(u32x4*)((bf16_t*)RKV + (row0 + pt) * 3072 + 2048 + h * 64 + pc0) = w; } }
        {
            f32x4 cs[2];
#pragma unroll
            for (int i = 0; i < 2; ++i) { const int tile = F.wave + 8 * i, mt = tile >> 2, nt = tile & 3;
                bf16x8 l0, l1;
#pragma unroll
                for (int e = 0; e < 8; ++e) { l0[e] = (short)((8 * fq + e <= 16 * mt + fr) ? 0x3F80 : 0); l1[e] = (short)((32 + 8 * fq + e <= 16 * mt + fr) ? 0x3F80 : 0); }
                const int c0_ = PX(16 * nt + fr, 8 * fq), c1_ = PX(16 * nt + fr, 8 * fq + 32); const LAS bf16_t* bh = SL(11); const LAS bf16_t* bl = SL(12);
                f32x4 acc = (f32x4){0.f, 0.f, 0.f, 0.f};
                acc = __builtin_amdgcn_mfma_f32_16x16x32_bf16(*(const LAS bf16x8*)(bh + c0_), l0, acc, 0, 0, 0); acc = __builtin_amdgcn_mfma_f32_16x16x32_bf16(*(const LAS bf16x8*)(bh + c1_), l1, acc, 0, 0, 0);
                acc = __builtin_amdgcn_mfma_f32_16x16x32_bf16(*(const LAS bf16x8*)(bl + c0_), l0, acc, 0, 0, 0); acc = __builtin_amdgcn_mfma_f32_16x16x32_bf16(*(const LAS bf16x8*)(bl + c1_), l1, acc, 0, 0, 0);
                cs[i] = acc; }
#pragma unroll
            for (int i = 0; i < 2; ++i) { const int tile = F.wave + 8 * i, mt = tile >> 2, nt = tile & 3; const int rr = 16 * mt + fr, cc = 16 * nt + 4 * fq;
                *(LAS f32x4*)(WLs + rr * 68 + cc) = cs[i]; }
        }
        LBAR();
        {
            float kkw[8], kaw[8], rkw[8], cumv[8], clv[8], cexv[8];
#pragma unroll
            for (int q4 = 0; q4 < 2; ++q4) { const f32x4 a_ = *(const LAS f32x4*)(HC + 192 + pc0 + 4 * q4), b_ = *(const LAS f32x4*)(HC + 256 + pc0 + 4 * q4), c_ = *(const LAS f32x4*)(HC + 320 + pc0 + 4 * q4);
                const f32x4 d_ = *(const LAS f32x4*)(WLs + pt * 68 + pc0 + 4 * q4), e_ = *(const LAS f32x4*)(WLs + 63 * 68 + pc0 + 4 * q4), f_ = (pt > 0) ? *(const LAS f32x4*)(WLs + (pt - 1) * 68 + pc0 + 4 * q4) : (f32x4){0.f, 0.f, 0.f, 0.f};
#pragma unroll
                for (int q = 0; q < 4; ++q) { kkw[4 * q4 + q] = a_[q]; kaw[4 * q4 + q] = b_[q]; rkw[4 * q4 + q] = c_[q]; cumv[4 * q4 + q] = d_[q]; clv[4 * q4 + q] = e_[q]; cexv[4 * q4 + q] = f_[q]; } }
            float kr[8], ss = 0.f, bs = 0.f;
#pragma unroll
            for (int q = 0; q < 8; ++q) { kr[q] = k[q] * kkw[q]; ss += kr[q] * kr[q]; }
            ss = octsum(ss);
            const float inv = 1.0f / fmaxf(sqrtf(ss), 1e-12f);
            float At[8], Rt[8], Bt[8], Kt[8], Bb[8], Kb[8], gl[8];
#pragma unroll
            for (int q = 0; q < 8; ++q) {
                const float cum = cumv[q], cl = clv[q], cex = cexv[q];
                const float e_in = __expf(cum), e_ex = __expf(cex), e_ng = __expf(-cum); gl[q] = __expf(cl);
                const float kk = kr[q] * inv, kp = k[q] * (1.0f + (a[q] - 1.0f) * kaw[q]); bs += r[q] * kp * rkw[q];
                At[q] = -kk * e_ex; Rt[q] = r[q] * e_in; Bt[q] = kk * a[q] * e_ng; Kt[q] = kp * e_ng; Bb[q] = Bt[q] * gl[q]; Kb[q] = Kt[q] * gl[q];
            }
            st8_lds(SL(0) + PX(pt, pc0), At); st8_lds(SL(1) + PX(pt, pc0), Rt); st8_lds(SL(2) + PX(pt, pc0), Bt); st8_lds(SL(3) + PX(pt, pc0), Kt);
            st8_lds(SL(11) + PX(pt, pc0), v); st8_lds(SL(12) + PX(pt, pc0), Bb); st8_lds(SL(13) + PX(pt, pc0), Kb);
            bs = octsum(bs); if ((F.tid & 7) == 0 && PROBE == 0) BON[(row0 + pt) * 16 + h] = bs;
            if (pt == 0 && PROBE == 0) { float* g = GLB + (size_t)u * 64 + pc0; *(f32x4*)g = (f32x4){gl[0], gl[1], gl[2], gl[3]}; *(f32x4*)(g + 4) = (f32x4){gl[4], gl[5], gl[6], gl[7]}; }
        }
        LBAR();
        {
            const int j = F.tid & 63, t0 = 8 * (F.tid >> 6);
#define TRANSP(src, dst) do { float e[8]; _Pragma("unroll") for (int q = 0; q < 8; ++q) e[q] = bf2f(SL(src)[PX(t0 + q, j)]); st8_lds(SL(dst) + PX(j, t0), e); } while (0)
            TRANSP(0, 6); TRANSP(12, 7); TRANSP(13, 5); TRANSP(11, 4);
#undef TRANSP
            if (u + F.G < 128 * 64) PREP_LOAD(u + F.G);
        }
        LBAR();
        if (PROBE == 1) continue;
        {
            f32x4 acc[8];
#pragma unroll
            for (int i = 0; i < 8; ++i) acc[i] = tile_mm<true>(SL(0) + 16 * i * 64, SL(2) + 16 * F.wave * 64, fr, fq);
            const int nt = F.wave, sq0 = (nt & 3) * 16 + 4 * fq;
#pragma unroll
            for (int i = 0; i < 8; ++i) {
                const int mt = i, tq = (mt & 3) * 16 + fr; f32x4 o;
#pragma unroll
                for (int q = 0; q < 4; ++q) { const int sq = sq0 + q; const bool keep = (mt < 4) ? (sq < tq) : (sq <= tq); o[q] = keep ? acc[i][q] : 0.f; }
                LAS bf16_t* dst = (mt < 4) ? ((nt < 4) ? SL(8) : SL(10)) : ((nt < 4) ? SL(11) : SL(12));
                st4_lds(dst + PX(tq, sq0), o);
                if (mt < 4 && nt < 4) {
#pragma unroll
                    for (int q = 0; q < 4; ++q) SL(9)[PX(sq0 + q, tq)] = (bf16_t)f2bf(o[q]); }
            }
        }
        LBAR();
        {
            f32x4 x[2], y1[2], nk[2];
#pragma unroll
            for (int i = 0; i < 2; ++i) { const int tile = F.wave + 8 * i, mt = tile >> 2, nt = tile & 3;
                x[i] = tile_mm<false>(SL(10) + 16 * mt * 64, SL(4) + 16 * nt * 64, fr, fq);
                y1[i] = tile_mm<true>(SL(12) + 16 * mt * 64, SL(4) + 16 * nt * 64, fr, fq);
                nk[i] = tile_mm<false>(SL(5) + 16 * mt * 64, SL(4) + 16 * nt * 64, fr, fq); }
#pragma unroll
            for (int i = 0; i < 2; ++i) { const int tile = F.wave + 8 * i, mt = tile >> 2, nt = tile & 3;
                st4_lds(SL(2) + PX(16 * nt + fr, 16 * mt + 4 * fq), x[i]);
                st4_lds(SL(3) + PX(16 * mt + fr, 16 * nt + 4 * fq), y1[i]);
                st4_lds(SL(0) + PX(16 * nt + fr, 16 * mt + 4 * fq), nk[i]); }
        }
        LBAR();
        if (PROBE == 2) continue;
#define NEU_SQ(Xn, Xt, On, Ot, WANT_NAT) do { f32x4 s_[2]; \
            _Pragma("unroll") for (int i = 0; i < 2; ++i) { const int tile = F.wave + 8 * i, mt = tile >> 2, nt = tile & 3; s_[i] = tile_mm<true>(SL(Xn) + 16 * mt * 64, SL(Xt) + 16 * nt * 64, fr, fq); } \
            _Pragma("unroll") for (int i = 0; i < 2; ++i) { const int tile = F.wave + 8 * i, mt = tile >> 2, nt = tile & 3; \
                if (WANT_NAT) st4_lds(SL(On) + PX(16 * mt + fr, 16 * nt + 4 * fq), s_[i]); \
                _Pragma("unroll") for (int q = 0; q < 4; ++q) SL(Ot)[PX(16 * nt + 4 * fq + q, 16 * mt + fr)] = (bf16_t)f2bf(s_[i][q]); } } while (0)
#define NEU_PR(Ti, Yt, To) do { f32x4 p_[2]; \
            _Pragma("unroll") for (int i = 0; i < 2; ++i) { const int tile = F.wave + 8 * i, mt = tile >> 2, nt = tile & 3; \
                p_[i] = tile_mm<true>(SL(Ti) + 16 * mt * 64, SL(Yt) + 16 * nt * 64, fr, fq) + ld4_lds(SL(Ti) + PX(16 * mt + fr, 16 * nt + 4 * fq)); } \
            _Pragma("unroll") for (int i = 0; i < 2; ++i) { const int tile = F.wave + 8 * i, mt = tile >> 2, nt = tile & 3; st4_lds(SL(To) + PX(16 * mt + fr, 16 * nt + 4 * fq), p_[i]); } } while (0)
#define NEU_BOTH(Ti, Yt, To, Xn, Xt, On, Ot, WANT_NAT) do { f32x4 p_[2], s_[2]; \
            _Pragma("unroll") for (int i = 0; i < 2; ++i) { const int tile = F.wave + 8 * i, mt = tile >> 2, nt = tile & 3; \
                p_[i] = tile_mm<true>(SL(Ti) + 16 * mt * 64, SL(Yt) + 16 * nt * 64, fr, fq) + ld4_lds(SL(Ti) + PX(16 * mt + fr, 16 * nt + 4 * fq)); \
                s_[i] = tile_mm<true>(SL(Xn) + 16 * mt * 64, SL(Xt) + 16 * nt * 64, fr, fq); } \
            _Pragma("unroll") for (int i = 0; i < 2; ++i) { const int tile = F.wave + 8 * i, mt = tile >> 2, nt = tile & 3; \
                st4_lds(SL(To) + PX(16 * mt + fr, 16 * nt + 4 * fq), p_[i]); \
                if (WANT_NAT) st4_lds(SL(On) + PX(16 * mt + fr, 16 * nt + 4 * fq), s_[i]); \
                _Pragma("unroll") for (int q = 0; q < 4; ++q) SL(Ot)[PX(16 * nt + 4 * fq + q, 16 * mt + fr)] = (bf16_t)f2bf(s_[i][q]); } } while (0)
        NEU_SQ(8, 9, 10, 12, true);
        LBAR();
        {
            f32x4 p_[2];
#pragma unroll
            for (int i = 0; i < 2; ++i) { const int tile = F.wave + 8 * i, mt = tile >> 2, nt = tile & 3; const int rr = 16 * mt + fr, cc = 16 * nt + 4 * fq;
                p_[i] = tile_mm<true>(SL(8) + 16 * mt * 64, SL(12) + 16 * nt * 64, fr, fq) + ld4_lds(SL(8) + PX(rr, cc)) + ld4_lds(SL(10) + PX(rr, cc));
#pragma unroll
                for (int q = 0; q < 4; ++q) if (cc + q == rr) p_[i][q] += 1.0f; }
            NEU_SQ(10, 12, 5, 13, true);
#pragma unroll
            for (int i = 0; i < 2; ++i) { const int tile = F.wave + 8 * i, mt = tile >> 2, nt = tile & 3; st4_lds(SL(4) + PX(16 * mt + fr, 16 * nt + 4 * fq), p_[i]); }
        }
        LBAR();
        NEU_BOTH(4, 13, 8, 5, 13, 9, 10, true);
        LBAR();
        NEU_BOTH(8, 10, 4, 9, 10, 5, 12, true);
        LBAR();
        NEU_BOTH(4, 12, 8, 5, 12, 5, 13, false);
        LBAR();
        NEU_PR(8, 13, 4);
        LBAR();
#undef NEU_SQ
#undef NEU_PR
#undef NEU_BOTH
        if (PROBE == 3) continue;
        {
            f32x4 p[2], u0[2];
#pragma unroll
            for (int i = 0; i < 2; ++i) { const int tile = F.wave + 8 * i, mt = tile >> 2, nt = tile & 3;
                p[i] = tile_mm<false>(SL(4) + 16 * mt * 64, SL(6) + 16 * nt * 64, fr, fq);
                u0[i] = tile_mm<false>(SL(4) + 16 * mt * 64, SL(2) + 16 * nt * 64, fr, fq); }
#pragma unroll
            for (int i = 0; i < 2; ++i) { const int tile = F.wave + 8 * i, mt = tile >> 2, nt = tile & 3;
                st4_lds(SL(9) + PX(16 * nt + fr, 16 * mt + 4 * fq), p[i]); st4_lds(SL(10) + PX(16 * nt + fr, 16 * mt + 4 * fq), u0[i]); }
        }
        LBAR();
        {
            f32x4 qv[2], y0[2], mp[2], ntv[2];
#pragma unroll
            for (int i = 0; i < 2; ++i) { const int tile = F.wave + 8 * i, mt = tile >> 2, nt = tile & 3; const int rr = 16 * mt + fr, cc = 16 * nt + 4 * fq, ri = 16 * nt + fr, cj = 16 * mt + 4 * fq;
                qv[i] = tile_mm<true>(SL(11) + 16 * mt * 64, SL(9) + 16 * nt * 64, fr, fq) + ld4_lds(SL(1) + PX(rr, cc));
                y0[i] = tile_mm<true>(SL(11) + 16 * mt * 64, SL(10) + 16 * nt * 64, fr, fq) + ld4_lds(SL(3) + PX(rr, cc));
                mp[i] = tile_mm<true>(SL(7) + 16 * mt * 64, SL(9) + 16 * nt * 64, fr, fq);
                ntv[i] = tile_mm<false>(SL(7) + 16 * mt * 64, SL(10) + 16 * nt * 64, fr, fq) + ld4_lds(SL(0) + PX(ri, cj)); }
#pragma unroll
            for (int i = 0; i < 2; ++i) { const int tile = F.wave + 8 * i, mt = tile >> 2, nt = tile & 3; const int rr = 16 * mt + fr, cc = 16 * nt + 4 * fq, ri = 16 * nt + fr, cj = 16 * mt + 4 * fq;
                st4_lds(SL(5) + PX(rr, cc), qv[i]); st4_lds(SL(8) + PX(rr, cc), y0[i]); st4_lds(SL(12) + PX(rr, cc), mp[i]); st4_lds(SL(13) + PX(ri, cj), ntv[i]); }
        }
        LBAR();
        if (PROBE == 0) {
            const int rw = F.tid >> 3, ch = 8 * (F.tid & 7);
            __builtin_nontemporal_store(*(const LAS u32x4*)(SL(5) + PX(rw, ch)), (u32x4*)(QQ + ((size_t)u * 64 + rw) * 64 + ch));
            __builtin_nontemporal_store(*(const LAS u32x4*)(SL(12) + PX(rw, ch)), (u32x4*)(MP + ((size_t)u * 64 + rw) * 64 + ch));
            __builtin_nontemporal_store(*(const LAS u32x4*)(SL(13) + PX(rw, ch)), (u32x4*)(NTt + ((size_t)u * 64 + rw) * 64 + ch));
            __builtin_nontemporal_store(*(const LAS u32x4*)(SL(8) + PX(rw, ch)), (u32x4*)(YS + (row0 + rw) * 1024 + h * 64 + ch));
        }
        LBAR();
    }
#undef PREP_LOAD
#undef SL
}

__device__ __forceinline__ void wkv_chunk_seq(Frame& F, int l) {
    bf16_t* YS = (bf16_t*)(F.ws + WS_Y16); const bf16_t* MP = (const bf16_t*)(F.ws + WS_MP); const bf16_t* QQ = (const bf16_t*)(F.ws + WS_QQ); const bf16_t* NTt = (const bf16_t*)(F.ws + WS_NT); const float* GLB = (const float*)(F.ws + WS_GL);
    LAS bf16_t* Zt = (LAS bf16_t*)F.lds;
    const bf16_t* RKVc = (const bf16_t*)(F.ws + WS_RA); const bf16_t* VFc = (const bf16_t*)(F.ws + WS_P); const bf16_t* G16 = (const bf16_t*)(F.ws + WS_RA + 224 * MiB); const float* BON = (const float*)(F.ws + WS_LF); bf16_t* OG = (bf16_t*)(F.ws + WS_H2);
    LAS bf16_t* Yb = Zt + 2 * SLOT;
    const int fr = F.lane & 15, fq = F.lane >> 4, mt = F.wave >> 1, ntb = 2 * (F.wave & 1);
    struct Ops { bf16x8 m0, m1, q0, q1; f32x4 gl; u32x2 n0, n1, y0, y1; };
    for (int item = F.bid; item < 128; item += F.G) {
        const int bh = item, b = bh >> 4, h = bh & 15; const size_t rowb = (size_t)b * SEQ;
        float gng[8], gnb[8]; ld8f(F.in[I_GNG] + l * 1024 + h * 64 + 8 * (F.tid & 7), gng); ld8f(F.in[I_GNB] + l * 1024 + h * 64 + 8 * (F.tid & 7), gnb);
        for (int i = F.tid; i < 2 * SLOT / 2; i += NTHR) ((LAS unsigned*)Zt)[i] = 0u;
        f32x4 Z0 = (f32x4){0.f, 0.f, 0.f, 0.f}, Z1 = Z0;
        LBAR();
#define SEQ_LOAD(O, cc_) do { const size_t cu = (size_t)bh * 64 + (cc_); \
        const bf16_t* mp = MP + (cu * 64 + 16 * mt + fr) * 64 + 8 * fq; O.m0 = *(const bf16x8*)mp; O.m1 = *(const bf16x8*)(mp + 32); \
        const bf16_t* qp = QQ + (cu * 64 + 16 * mt + fr) * 64 + 8 * fq; O.q0 = *(const bf16x8*)qp; O.q1 = *(const bf16x8*)(qp + 32); \
        O.gl = *(const f32x4*)(GLB + cu * 64 + 16 * mt + 4 * fq); \
        const bf16_t* np_ = NTt + (cu * 64 + 16 * ntb + fr) * 64 + 16 * mt + 4 * fq; O.n0 = *(const u32x2*)np_; O.n1 = *(const u32x2*)(np_ + 16 * 64); \
        const bf16_t* yp = YS + (rowb + 64 * (cc_) + 16 * mt + fr) * 1024 + h * 64 + 16 * ntb + 4 * fq; O.y0 = *(const u32x2*)yp; O.y1 = *(const u32x2*)(yp + 16); } while (0)
#define SEQ_STEP(O, cc_) do { const LAS bf16_t* Zc = Zt + ((cc_) & 1) * SLOT; LAS bf16_t* Zn = Zt + (((cc_) + 1) & 1) * SLOT; \
        const LAS bf16_t* z0p = Zc + (16 * ntb + fr) * CP + 8 * fq; const LAS bf16_t* z1p = z0p + 16 * CP; \
        const bf16x8 b00 = *(const LAS bf16x8*)z0p, b01 = *(const LAS bf16x8*)(z0p + 32), b10 = *(const LAS bf16x8*)z1p, b11 = *(const LAS bf16x8*)(z1p + 32); \
        f32x4 a0 = (f32x4){0.f, 0.f, 0.f, 0.f}, a1 = a0, c0 = a0, c1 = a0; \
        a0 = __builtin_amdgcn_mfma_f32_16x16x32_bf16(O.m0, b00, a0, 0, 0, 0); a0 = __builtin_amdgcn_mfma_f32_16x16x32_bf16(O.m1, b01, a0, 0, 0, 0); \
        a1 = __builtin_amdgcn_mfma_f32_16x16x32_bf16(O.m0, b10, a1, 0, 0, 0); a1 = __builtin_amdgcn_mfma_f32_16x16x32_bf16(O.m1, b11, a1, 0, 0, 0); \
        c0 = __builtin_amdgcn_mfma_f32_16x16x32_bf16(b00, O.q0, c0, 0, 0, 0); c0 = __builtin_amdgcn_mfma_f32_16x16x32_bf16(b01, O.q1, c0, 0, 0, 0); \
        c1 = __builtin_amdgcn_mfma_f32_16x16x32_bf16(b10, O.q0, c1, 0, 0, 0); c1 = __builtin_amdgcn_mfma_f32_16x16x32_bf16(b11, O.q1, c1, 0, 0, 0); \
        Z0 = O.gl * Z0 + a0 + (f32x4){lo16(O.n0.x), hi16(O.n0.x), lo16(O.n0.y), hi16(O.n0.y)}; Z1 = O.gl * Z1 + a1 + (f32x4){lo16(O.n1.x), hi16(O.n1.x), lo16(O.n1.y), hi16(O.n1.y)}; \
        { LAS bf16_t* yl = Yb + (((cc_) & 7) * 64 + 16 * mt + fr) * CP + 16 * ntb + 4 * fq; \
          st4_lds(yl, c0 + (f32x4){lo16(O.y0.x), hi16(O.y0.x), lo16(O.y0.y), hi16(O.y0.y)}); st4_lds(yl + 16, c1 + (f32x4){lo16(O.y1.x), hi16(O.y1.x), lo16(O.y1.y), hi16(O.y1.y)}); } \
        st4_lds(Zn + (16 * ntb + fr) * CP + 16 * mt + 4 * fq, Z0); st4_lds(Zn + (16 * ntb + 16 + fr) * CP + 16 * mt + 4 * fq, Z1); \
        LBAR(); \
        if (((cc_) & 7) == 7) { _Pragma("unroll 2") for (int i_ = 0; i_ < 8; ++i_) { const int o_ = F.tid + NTHR * i_, ck_ = o_ >> 9, rw_ = (o_ >> 3) & 63, ch_ = 8 * (o_ & 7); \
            const size_t tr_ = rowb + 64 * ((cc_) - 7 + ck_) + rw_; float y_[8], v_[8], g_[8]; \
            unpk8(*(const LAS u32x4*)(Yb + (ck_ * 64 + rw_) * CP + ch_), y_); unpk8((l == 0) ? *(const u32x4*)(VFc + tr_ * 1024 + h * 64 + ch_) : *(const u32x4*)(RKVc + tr_ * 3072 + 2048 + h * 64 + ch_), v_); unpk8(*(const u32x4*)(G16 + tr_ * 1024 + h * 64 + ch_), g_); \
            const float bs_ = BON[tr_ * 16 + h]; float s_ = 0.f; _Pragma("unroll") for (int q_ = 0; q_ < 8; ++q_) s_ += y_[q_]; s_ = octsum(s_); const float mean_ = s_ * (1.0f / 64.0f); \
            float qq_ = 0.f; _Pragma("unroll") for (int q_ = 0; q_ < 8; ++q_) { const float d_ = y_[q_] - mean_; qq_ += d_ * d_; } qq_ = octsum(qq_); const float rstd_ = 1.0f / sqrtf(qq_ * (1.0f / 64.0f) + GN_EPS); \
            float o8_[8]; _Pragma("unroll") for (int q_ = 0; q_ < 8; ++q_) o8_[q_] = (((y_[q_] - mean_) * rstd_) * gng[q_] + gnb[q_] + bs_ * v_[q_]) * g_[q_]; \
            u32x4 w_; w_.x = pk2(o8_[0], o8_[1]); w_.y = pk2(o8_[2], o8_[3]); w_.z = pk2(o8_[4], o8_[5]); w_.w = pk2(o8_[6], o8_[7]); __builtin_nontemporal_store(w_, (u32x4*)(OG + tr_ * 1024 + h * 64 + ch_)); } LBAR(); } } while (0)
        Ops A, B, C;
        SEQ_LOAD(A, 0); SEQ_LOAD(B, 1);
#pragma unroll 1
        for (int c = 0; c < 63; c += 3) {
            SEQ_LOAD(C, c + 2); SEQ_STEP(A, c);
            SEQ_LOAD(A, c + 3); SEQ_STEP(B, c + 1);
            if (c + 4 < 64) SEQ_LOAD(B, c + 4);
            SEQ_STEP(C, c + 2);
        }
        SEQ_STEP(A, 63);
#undef SEQ_LOAD
#undef SEQ_STEP
    }
}

__device__ __forceinline__ void ld16(const bf16_t* p, float (&o)[16]) {
    const u32x4 a = *(const u32x4*)p, b = *(const u32x4*)(p + 8);
    o[0] = lo16(a.x); o[1] = hi16(a.x); o[2] = lo16(a.y); o[3] = hi16(a.y); o[4] = lo16(a.z); o[5] = hi16(a.z); o[6] = lo16(a.w); o[7] = hi16(a.w);
    o[8] = lo16(b.x); o[9] = hi16(b.x); o[10] = lo16(b.y); o[11] = hi16(b.y); o[12] = lo16(b.z); o[13] = hi16(b.z); o[14] = lo16(b.w); o[15] = hi16(b.w);
}
__device__ __forceinline__ void st16(bf16_t* p, const float (&o)[16]) {
    u32x4 a, b; a.x = pk2(o[0], o[1]); a.y = pk2(o[2], o[3]); a.z = pk2(o[4], o[5]); a.w = pk2(o[6], o[7]); b.x = pk2(o[8], o[9]); b.y = pk2(o[10], o[11]); b.z = pk2(o[12], o[13]); b.w = pk2(o[14], o[15]);
    *(u32x4*)p = a; *(u32x4*)(p + 8) = b;
}
__device__ __forceinline__ void ld16f(const float* p, float (&o)[16]) {
#pragma unroll
    for (int j = 0; j < 4; ++j) { const f32x4 v = *(const f32x4*)(p + 4 * j); o[4 * j] = v[0]; o[4 * j + 1] = v[1]; o[4 * j + 2] = v[2]; o[4 * j + 3] = v[3]; }
}
__device__ __forceinline__ void wkv_post(Frame& F, int l) {
    const InTab in = F.in;
    const bf16_t* RKV = (const bf16_t*)(F.ws + WS_RA); const bf16_t* G16 = (const bf16_t*)(F.ws + WS_RA + 224 * MiB); const float* BON = (const float*)(F.ws + WS_LF);
    const bf16_t* YS = (const bf16_t*)(F.ws + WS_Y16); bf16_t* OG = (bf16_t*)(F.ws + WS_H2);
    const int c0 = 16 * F.lane;
    float gg[16], gb[16];
    ld16f(in[I_GNG] + l * 1024 + c0, gg); ld16f(in[I_GNB] + l * 1024 + c0, gb);
    const int gw = F.bid * NWAVES + F.wave, NGW = F.G * NWAVES;
    for (int t = gw; t < T; t += NGW) {
        float y[16], v[16], g[16];
        ld16(YS + (size_t)t * 1024 + c0, y); ld16(RKV + (size_t)t * 3072 + 2048 + c0, v); ld16(G16 + (size_t)t * 1024 + c0, g);
        const float bs = BON[(size_t)t * 16 + (F.lane >> 2)];
        float s = 0.f;
#pragma unroll
        for (int i = 0; i < 16; ++i) s += y[i];
        s = quadsum(s);
        const float mean = s * (1.0f / 64.0f); float q = 0.f;
#pragma unroll
        for (int i = 0; i < 16; ++i) { const float d = y[i] - mean; q += d * d; }
        q = quadsum(q);
        const float rstd = 1.0f / sqrtf(q * (1.0f / 64.0f) + GN_EPS);
        float o[16];
#pragma unroll
        for (int i = 0; i < 16; ++i) o[i] = (((y[i] - mean) * rstd) * gg[i] + gb[i] + bs * v[i]) * g[i];
        st16(OG + (size_t)t * 1024 + c0, o);
    }
}

__device__ __forceinline__ void kv_post(Frame& F) {
    const InTab in = F.in;
    bf16_t* Kb = (bf16_t*)(F.ws + WS_P); const float* LF = (const float*)(F.ws + WS_LF); float* KBv = (float*)(F.ws + WS_KB);
    const int c0 = 16 * F.lane;
    float kn[16]; ld16f(in[I_KNORM] + (c0 & 63), kn);
    const int gw = F.bid * NWAVES + F.wave, NGW = F.G * NWAVES;
    float kq[16];
#pragma unroll
    for (int i = 0; i < 16; ++i) kq[i] = 0.f;
    if (gw < T) ld16(Kb + (size_t)gw * 1024 + c0, kq);
    for (int t = gw; t < T; t += NGW) {
        float k[16];
#pragma unroll
        for (int i = 0; i < 16; ++i) k[i] = kq[i];
        if (t + NGW < T) ld16(Kb + (size_t)(t + NGW) * 1024 + c0, kq);
        float s = 0.f;
#pragma unroll
        for (int i = 0; i < 16; ++i) s += k[i] * k[i];
        s = quadsum(s);
        const float rs = 1.0f / sqrtf(s * (1.0f / 64.0f) + QK_EPS);
#pragma unroll
        for (int i = 0; i < 16; ++i) k[i] = k[i] * rs * kn[i];
        st16(Kb + (size_t)t * 1024 + c0, k);
    }
    for (int bh = (F.wave == 0) ? F.bid : 128; bh < 128; bh += F.G) {
        const int b = bh >> 4, h = bh & 15; const size_t base = ((size_t)b * SEQ + 64 * F.lane) * 16 + h;
        float s = 0.f;
        for (int i = 0; i < 64; ++i) s += LF[base + (size_t)i * 16];
        float incl = s;
#pragma unroll
        for (int o = 1; o < 64; o <<= 1) { const float n = __shfl_up(incl, o); if (F.lane >= o) incl += n; }
        float run = incl - s;
        float kfirst = 0.f, klast = 0.f;
        for (int i = 0; i < 64; ++i) { run += LF[base + (size_t)i * 16]; const float kbv = -run * LOG2E; KBv[(size_t)bh * SEQ + 64 * F.lane + i] = kbv; if (i == 0) kfirst = kbv; klast = kbv; }
        int* T0 = (int*)(F.ws + WS_T0) + bh * 16;
        for (int qb = 0; qb < 16; ++qb) {
            const float thr = __shfl(kfirst, 4 * qb) - 70.0f;
            const unsigned long long skip = __ballot(klast < thr);
            int t0 = (skip == ~0ull) ? 64 : __builtin_ctzll(~skip); const int nt = 4 * qb + 4;
            t0 &= ~1; if (t0 > nt - 4) t0 = nt - 4;
            if (F.lane == 0) T0[qb] = t0;
        }
    }
}

namespace attn_body {
using bf16=__hip_bfloat16;
using bf16x8=__attribute__((ext_vector_type(8)))short;
using s16x4=__attribute__((ext_vector_type(4)))short;
using f32x16=__attribute__((ext_vector_type(16)))float;
using u32x4=__attribute__((ext_vector_type(4)))unsigned;
constexpr int BATCH=8,NHEAD=16,SEQ=4096,D=64,DM=NHEAD*D;
constexpr int NW=8,QBLK=32,QB=QBLK*NW,KVBLK=64,NQB=SEQ/QB;
constexpr int ATTN_PITCH=DM, ATTN_UNIT_ROWS=QB;
__device__ __forceinline__ int crow(int r,int hi){return (r&3)+8*(r>>2)+4*hi;}
#define SBAR() __builtin_amdgcn_sched_barrier(0)
__device__ __forceinline__ void cmask(f32x16&p0,f32x16&p1,int jb,int qrel,int hi){
  const float NEG=-INFINITY; int kb=64*jb+4*hi;
  #pragma unroll
  for(int r=0;r<16;++r){int kv=kb+(r&3)+8*(r>>2); if(kv>qrel)p0[r]=NEG; if(kv+32>qrel)p1[r]=NEG;}
}

constexpr int NSLOT=3, SLOTB=8192;
constexpr int LDS_K=0, LDS_V=NSLOT*SLOTB, LDS_WS=2*NSLOT*SLOTB, LDS_OST=LDS_WS+NW*64*4, LDS_KBIAS=LDS_OST+NW*4096, LDS_BYTES=LDS_KBIAS+SEQ*4;
constexpr float C2=0.125f*1.4426950408889634f;
__device__ __forceinline__ void glds16(const void*gsrc,unsigned lds_dst){unsigned keep;
  asm volatile("s_mov_b32 %0, m0\n\ts_mov_b32 m0, %2\n\ts_nop 0\n\tglobal_load_lds_dwordx4 %1, off\n\ts_mov_b32 m0, %0":"=&s"(keep):"v"(gsrc),"s"(lds_dst):"memory");}
__device__ __forceinline__ float max3f(float a,float b,float c){float r;asm("v_max3_f32 %0, %1, %2, %3":"=v"(r):"v"(a),"v"(b),"v"(c));return r;}
__device__ __forceinline__ float max2f(float a,float b){float r;asm("v_max_f32_e32 %0, %1, %2":"=v"(r):"v"(a),"v"(b));return r;}
__device__ __forceinline__ float fadd_s(float a,float b){float r;asm("v_add_f32_e32 %0, %1, %2":"=v"(r):"v"(a),"v"(b));return r;}
__device__ __forceinline__ float fsub_s(float a,float b){float r;asm("v_sub_f32_e32 %0, %1, %2":"=v"(r):"v"(a),"v"(b));return r;}
typedef float f32x2_t __attribute__((ext_vector_type(2))); typedef __bf16 bf16x2_t __attribute__((ext_vector_type(2)));
__device__ __forceinline__ unsigned cvtpk_s(float lo,float hi){f32x2_t v={lo,hi};bf16x2_t b=__builtin_convertvector(v,bf16x2_t);return __builtin_bit_cast(unsigned,b);}
#define WAIT_BAR(N) asm volatile("s_waitcnt vmcnt(" #N ") lgkmcnt(0)\n\ts_barrier":::"memory")

__device__ __forceinline__ void qkt(f32x16&p0,f32x16&p1,const char*Kslot,const bf16x8*qr,const f32x16&negm,int r32,int hi){
  const char*kb=Kslot+hi*1024+r32*16;
  #pragma unroll
  for(int d0=0;d0<4;++d0){
    const bf16x8 b0=*reinterpret_cast<const bf16x8*>(kb+d0*2048);
    const bf16x8 b1=*reinterpret_cast<const bf16x8*>(kb+d0*2048+512);
    if(d0==0){p0=__builtin_amdgcn_mfma_f32_32x32x16_bf16(b0,qr[0],negm,0,0,0);p1=__builtin_amdgcn_mfma_f32_32x32x16_bf16(b1,qr[0],negm,0,0,0);}
    else{p0=__builtin_amdgcn_mfma_f32_32x32x16_bf16(b0,qr[d0],p0,0,0,0);p1=__builtin_amdgcn_mfma_f32_32x32x16_bf16(b1,qr[d0],p1,0,0,0);}}
}
typedef __attribute__((address_space(3))) const char* lds_cptr;
typedef short v4i16_t __attribute__((ext_vector_type(4)));
__device__ __forceinline__ void kload8(bf16x8*kf,lds_cptr kp){
  kf[0]=*(const __attribute__((address_space(3))) bf16x8*)(kp);      kf[1]=*(const __attribute__((address_space(3))) bf16x8*)(kp+512);
  kf[2]=*(const __attribute__((address_space(3))) bf16x8*)(kp+2048); kf[3]=*(const __attribute__((address_space(3))) bf16x8*)(kp+2560);
  kf[4]=*(const __attribute__((address_space(3))) bf16x8*)(kp+4096); kf[5]=*(const __attribute__((address_space(3))) bf16x8*)(kp+4608);
  kf[6]=*(const __attribute__((address_space(3))) bf16x8*)(kp+6144); kf[7]=*(const __attribute__((address_space(3))) bf16x8*)(kp+6656);
}
__device__ __forceinline__ void kload2(bf16x8*kf,lds_cptr kp,int j){ kf[2*j]=*(const __attribute__((address_space(3))) bf16x8*)(kp+j*2048); kf[2*j+1]=*(const __attribute__((address_space(3))) bf16x8*)(kp+j*2048+512); }
__device__ __forceinline__ s16x4 vtr(lds_cptr p){ return __builtin_bit_cast(s16x4,__builtin_amdgcn_ds_read_tr16_b64_v4i16((__attribute__((address_space(3))) v4i16_t*)p)); }
__device__ __forceinline__ float rowmax(const f32x16&p0,const f32x16&p1){
  float a=max3f(p0[0],p0[1],p1[0]),b=max3f(p0[2],p0[3],p1[1]);a=max3f(a,p1[2],p1[3]);
  #pragma unroll
  for(int r=4;r<16;r+=4){a=max3f(a,p0[r],p0[r+1]);b=max3f(b,p0[r+2],p0[r+3]);a=max3f(a,p1[r],p1[r+1]);b=max3f(b,p1[r+2],p1[r+3]);}
  const float m=max2f(a,b);
  auto rr=__builtin_amdgcn_permlane32_swap(__float_as_uint(m),__float_as_uint(m),false,false);
  return max2f(__uint_as_float(rr[0]),__uint_as_float(rr[1]));
}
__device__ __forceinline__ void pv(f32x16*o,int vb,bf16x8 pa0,bf16x8 pa1,bf16x8 pa2,bf16x8 pa3){
  #pragma unroll
  for(int d0=0;d0<2;++d0){s16x4 lo[4],hi[4];
    #pragma unroll
    for(int ks=0;ks<4;++ks){
      asm volatile("ds_read_b64_tr_b16 %0,%1 offset:%c2":"=&v"(lo[ks]):"v"(vb),"i"(d0*4096+ks*1024):"memory");
      asm volatile("ds_read_b64_tr_b16 %0,%1 offset:%c2":"=&v"(hi[ks]):"v"(vb),"i"(d0*4096+ks*1024+512):"memory");}
    asm volatile("s_waitcnt lgkmcnt(0)":::"memory");SBAR();
    #define PK(k) (bf16x8){lo[k][0],lo[k][1],lo[k][2],lo[k][3],hi[k][0],hi[k][1],hi[k][2],hi[k][3]}
    o[d0]=__builtin_amdgcn_mfma_f32_32x32x16_bf16(pa0,PK(0),o[d0],0,0,0);
    o[d0]=__builtin_amdgcn_mfma_f32_32x32x16_bf16(pa1,PK(1),o[d0],0,0,0);
    o[d0]=__builtin_amdgcn_mfma_f32_32x32x16_bf16(pa2,PK(2),o[d0],0,0,0);
    o[d0]=__builtin_amdgcn_mfma_f32_32x32x16_bf16(pa3,PK(3),o[d0],0,0,0);
    #undef PK
  }
}

#ifndef ATTN_STORE16
#define ATTN_STORE16(p,v) (*(u32x4*)(p)=(v))
#endif
template<int THRL> __device__ __forceinline__ void attn_unit(int tid,int wid,int b,int h,int qb,int t0,const bf16*Q,const bf16*__restrict__ K,const bf16*__restrict__ V,bf16*O,const bf16*G,const float*kbrow,const float*qnorm,char*shm){
  int lane=tid&63; asm volatile("":"+v"(lane));
  const int r32=lane&31,hi=lane>>5; wid=__builtin_amdgcn_readfirstlane(wid);
  const long rowbase=(long)b*SEQ; const int q0=qb*QB;
  const bf16*Qw=Q+(rowbase+q0+wid*QBLK)*DM+h*D;
  const bf16*Kh=K+(rowbase+(long)t0*KVBLK)*DM+h*D,*Vh=V+(rowbase+(long)t0*KVBLK)*DM+h*D; kbrow+=t0*KVBLK;
  const unsigned lds0=(unsigned)(uintptr_t)shm;
  float*wsf=(float*)(shm+LDS_WS)+wid*64;
  const bf16*ksrc=Kh+(long)lane*DM+wid*8;
  const bf16*vsrc=Vh+(long)(16*(wid&3)+(lane>>2))*DM+(wid>>2)*32+(lane&3)*8;
  const unsigned kdst=lds0+LDS_K+wid*1024, vdst=lds0+LDS_V+wid*1024;
  #define DMA_K(t,slot) glds16(ksrc+(long)(t)*KVBLK*DM,(unsigned)__builtin_amdgcn_readfirstlane(kdst+(slot)))
  #define DMA_V(t,slot) glds16(vsrc+(long)(t)*KVBLK*DM,(unsigned)__builtin_amdgcn_readfirstlane(vdst+(slot)))
  const int vb0=(int)(lds0+LDS_V)+((lane>>4)&1)*32+(lane&3)*8+(4*hi+((lane&15)>>2))*64;
  const char*Kbase=shm+LDS_K; bf16x8 kf[8];
  const lds_cptr shm3=(lds_cptr)shm; const lds_cptr kp0=shm3+LDS_K+hi*1024+r32*16; const lds_cptr vp0=shm3+LDS_V+((lane>>4)&1)*32+(lane&3)*8+(4*hi+((lane&15)>>2))*64;
  const int NT=(q0+QB)/KVBLK-t0;
  typedef float f32x4_t __attribute__((ext_vector_type(4))); typedef __attribute__((address_space(3))) const float* lds_fptr;
  const lds_fptr kbl=(lds_fptr)(shm3+LDS_KBIAS);
  { __attribute__((address_space(3))) f32x4_t* kw=(__attribute__((address_space(3))) f32x4_t*)(shm3+LDS_KBIAS); const f32x4_t* kg=(const f32x4_t*)kbrow;
    for(int i=tid;i<NT*KVBLK/4;i+=NW*64) kw[i]=kg[i]; }
  DMA_K(0,0);DMA_V(0,0);DMA_K(1,SLOTB);
  bf16x8 qr[4];
  #pragma unroll
  for(int d0=0;d0<4;++d0)qr[d0]=*reinterpret_cast<const bf16x8*>(&Qw[(long)r32*DM+d0*16+hi*8]);
  { float qf[4][8]; float ss=0.f;
    #pragma unroll
    for(int d0=0;d0<4;++d0){
      #pragma unroll
      for(int j=0;j<8;++j){ qf[d0][j]=__uint_as_float(((unsigned)(unsigned short)qr[d0][j])<<16); ss+=qf[d0][j]*qf[d0][j]; } }
    { auto rr=__builtin_amdgcn_permlane32_swap(__float_as_uint(ss),__float_as_uint(ss),false,false); ss=__uint_as_float(rr[0])+__uint_as_float(rr[1]); }
    const float qs=C2/sqrtf(ss*(1.0f/64.0f)+1e-6f);
    #pragma unroll
    for(int d0=0;d0<4;++d0){ const float*qn=qnorm+d0*16+hi*8; u32x4 w;
      w[0]=cvtpk_s(qf[d0][0]*qs*qn[0],qf[d0][1]*qs*qn[1]); w[1]=cvtpk_s(qf[d0][2]*qs*qn[2],qf[d0][3]*qs*qn[3]); w[2]=cvtpk_s(qf[d0][4]*qs*qn[4],qf[d0][5]*qs*qn[5]); w[3]=cvtpk_s(qf[d0][6]*qs*qn[6],qf[d0][7]*qs*qn[7]);
      qr[d0]=__builtin_bit_cast(bf16x8,w); } }
  float mhat=0.f,l_reg=0.f;f32x16 o[2];o[0]=f32x16{};o[1]=f32x16{};const f32x16 negm=f32x16{};
  const int qrel=wid*QBLK+r32;
  #define CMASK(P0,P1,t) do{int jb_=(t)-(NT-4); if(jb_>=0)cmask(P0,P1,jb_,qrel,hi);}while(0)
  #define KBIAS(P0,P1,t) do{ const lds_fptr kp_=kbl+64*(t)+4*hi; \
    _Pragma("unroll") for(int g_=0;g_<4;++g_){ const f32x4_t a_=*(const __attribute__((address_space(3))) f32x4_t*)(kp_+8*g_)-mhat, b_=*(const __attribute__((address_space(3))) f32x4_t*)(kp_+32+8*g_)-mhat; \
      _Pragma("unroll") for(int j_=0;j_<4;++j_){ P0[4*g_+j_]+=a_[j_]; P1[4*g_+j_]+=b_[j_]; } } }while(0)
  bool resc=false;
  #define START(P0,P1) do{ const float rm=rowmax(P0,P1); resc=false; \
    { const float dl=rm; mhat=fadd_s(mhat,dl); \
      _Pragma("unroll") for(int r=0;r<16;++r){P0[r]=fsub_s(P0[r],dl);P1[r]=fsub_s(P1[r],dl);} } \
    _Pragma("unroll") for(int r=0;r<16;++r)P0[r]=__builtin_amdgcn_exp2f(P0[r]); }while(0)
  #define RESC() do{ if(resc){ asm volatile("s_waitcnt lgkmcnt(0)":::"memory"); \
      _Pragma("unroll") for(int d_=0;d_<2;++d_) _Pragma("unroll") for(int r=0;r<16;++r)o[d_][r]*=wsf[crow(r,hi)]; } }while(0)
  f32x16 pA0,pA1,pB0,pB1;
  int sl_prev=0,sl_cur=0,sl_next=SLOTB;
  #define ROT() do{sl_prev=sl_cur;sl_cur=sl_next;sl_next=(sl_next==(NSLOT-1)*SLOTB)?0:sl_next+SLOTB;}while(0)
  DMA_K(2,2*SLOTB);
  WAIT_BAR(3);
  qkt(pA0,pA1,Kbase,qr,negm,r32,hi);asm volatile("s_nop 15\n\ts_nop 7":"+v"(pA0),"+v"(pA1));KBIAS(pA0,pA1,0);CMASK(pA0,pA1,0);
  START(pA0,pA1);
  _Pragma("unroll") for(int r=0;r<16;++r)pA1[r]=__builtin_amdgcn_exp2f(pA1[r]);
  WAIT_BAR(0);
  DMA_K(3,0);DMA_V(1,SLOTB);
  ROT();
  kload8(kf,kp0+sl_cur);
  WAIT_BAR(2);
  s16x4 vlo[8],vhi[8]; u32x4 pw0,pw1,pw2,pw3;
  #define PKW(P,B) cvtpk_s(P[B],P[B+1])
  #define PAF(k) __builtin_bit_cast(bf16x8,pw##k)
  #define VFR(i) (bf16x8){vlo[i][0],vlo[i][1],vlo[i][2],vlo[i][3],vhi[i][0],vhi[i][1],vhi[i][2],vhi[i][3]}
  #define PIN(x) asm volatile("":"+v"(x))
  #define MX3(a,b,c) __builtin_fmaxf(__builtin_fmaxf((a),(b)),(c))
  #define GAPA(MF,A0,A1,A2,A3,W0,W1,PW) do{ MF; sacc+=A0; sacc+=A1; sacc+=A2; sacc+=A3; PIN(sacc); W0; W1; PIN(PW); SBAR(); }while(0)
  #define EX(v) __builtin_amdgcn_exp2f(v)
  #define GAPB(MF,X,B) do{ MF; X[B]=EX(X[B]); X[B+1]=EX(X[B+1]); X[B+2]=EX(X[B+2]); X[B+3]=EX(X[B+3]); PIN(X); SBAR(); }while(0)
  #define VRD(i) do{ vlo[i]=vtr(vp_+(((i)>>2)*4096+((i)&3)*1024)); vhi[i]=vtr(vp_+(((i)>>2)*4096+((i)&3)*1024+512)); }while(0)
  #define KRD(G,j) do{ if(G){ kload2(kf,kp0+sl_next,j); SBAR(); } }while(0)
  #define STEP(C0,C1,P0,P1,t,GK,GV,GL) do{ SBAR(); \
    const lds_cptr vp_=vp0+sl_prev; \
    VRD(0); SBAR(); float sacc=(P0[0]+P0[1]); \
    GAPA(C0=__builtin_amdgcn_mfma_f32_32x32x16_bf16(kf[0],qr[0],negm,0,0,0), P0[2],P0[3],P0[4],P0[5],     pw0[0]=PKW(P0,0), pw0[1]=PKW(P0,2), pw0); \
    VRD(4); SBAR(); GAPA(C1=__builtin_amdgcn_mfma_f32_32x32x16_bf16(kf[1],qr[0],negm,0,0,0), P0[6],P0[7],P0[8],P0[9],     pw0[2]=PKW(P0,4), pw0[3]=PKW(P0,6), pw0); \
    VRD(1); SBAR(); GAPA(C0=__builtin_amdgcn_mfma_f32_32x32x16_bf16(kf[2],qr[1],C0,0,0,0),   P0[10],P0[11],P0[12],P0[13], pw1[0]=PKW(P0,8), pw1[1]=PKW(P0,10), pw1); \
    VRD(5); SBAR(); GAPA(C1=__builtin_amdgcn_mfma_f32_32x32x16_bf16(kf[3],qr[1],C1,0,0,0),   P0[14],P0[15],P1[0],P1[1],   pw1[2]=PKW(P0,12),pw1[3]=PKW(P0,14), pw1); \
    VRD(2); SBAR(); GAPA(C0=__builtin_amdgcn_mfma_f32_32x32x16_bf16(kf[4],qr[2],C0,0,0,0),   P1[2],P1[3],P1[4],P1[5],     pw2[0]=PKW(P1,0), pw2[1]=PKW(P1,2), pw2); \
    VRD(6); SBAR(); GAPA(C1=__builtin_amdgcn_mfma_f32_32x32x16_bf16(kf[5],qr[2],C1,0,0,0),   P1[6],P1[7],P1[8],P1[9],     pw2[2]=PKW(P1,4), pw2[3]=PKW(P1,6), pw2); \
    VRD(3); SBAR(); GAPA(C0=__builtin_amdgcn_mfma_f32_32x32x16_bf16(kf[6],qr[3],C0,0,0,0),   P1[10],P1[11],P1[12],P1[13], pw3[0]=PKW(P1,8), pw3[1]=PKW(P1,10), pw3); \
    VRD(7); SBAR(); GAPA(C1=__builtin_amdgcn_mfma_f32_32x32x16_bf16(kf[7],qr[3],C1,0,0,0),   P1[14],P1[15],0.f,0.f,       pw3[2]=PKW(P1,12),pw3[3]=PKW(P1,14), pw3); \
    l_reg+=sacc; \
    if(GK){DMA_K((t)+3,sl_cur);} if(GV){DMA_V((t)+1,sl_next);} \
    KBIAS(C0,C1,t); CMASK(C0,C1,t); \
    { float a=MX3(C0[0],C0[1],C1[0]),b=MX3(C0[2],C0[3],C1[1]); a=MX3(a,C1[2],C1[3]); \
      _Pragma("unroll") for(int r=4;r<16;r+=4){a=MX3(a,C0[r],C0[r+1]);b=MX3(b,C0[r+2],C0[r+3]);a=MX3(a,C1[r],C1[r+1]);b=MX3(b,C1[r+2],C1[r+3]);} \
      float rm=__builtin_fmaxf(a,b); { auto rr=__builtin_amdgcn_permlane32_swap(__float_as_uint(rm),__float_as_uint(rm),false,false); rm=__builtin_fmaxf(__uint_as_float(rr[0]),__uint_as_float(rr[1])); } \
      resc=false; \
      if(__builtin_expect(__any(rm>(float)THRL),0)){ const float dl=__builtin_fmaxf(rm,0.f); mhat+=dl; \
        _Pragma("unroll") for(int r=0;r<16;++r){C0[r]-=dl;C1[r]-=dl;} \
        const float f=__builtin_amdgcn_exp2f(-dl); l_reg*=f; if(hi==0)wsf[r32]=f; resc=true; } } \
    SBAR(); \
    GAPB(o[0]=__builtin_amdgcn_mfma_f32_32x32x16_bf16(PAF(0),VFR(0),o[0],0,0,0), C0,0); \
    GAPB(o[1]=__builtin_amdgcn_mfma_f32_32x32x16_bf16(PAF(0),VFR(4),o[1],0,0,0), C0,4); \
    KRD(GL,0); GAPB(o[0]=__builtin_amdgcn_mfma_f32_32x32x16_bf16(PAF(1),VFR(1),o[0],0,0,0), C0,8); \
    KRD(GL,1); GAPB(o[1]=__builtin_amdgcn_mfma_f32_32x32x16_bf16(PAF(1),VFR(5),o[1],0,0,0), C0,12); \
    KRD(GL,2); GAPB(o[0]=__builtin_amdgcn_mfma_f32_32x32x16_bf16(PAF(2),VFR(2),o[0],0,0,0), C1,0); \
    KRD(GL,3); GAPB(o[1]=__builtin_amdgcn_mfma_f32_32x32x16_bf16(PAF(2),VFR(6),o[1],0,0,0), C1,4); \
    GAPB(o[0]=__builtin_amdgcn_mfma_f32_32x32x16_bf16(PAF(3),VFR(3),o[0],0,0,0), C1,8); \
    GAPB(o[1]=__builtin_amdgcn_mfma_f32_32x32x16_bf16(PAF(3),VFR(7),o[1],0,0,0), C1,12); \
    }while(0)
  int t=1;
  #undef CMASK
  #define CMASK(P0,P1,t) do{}while(0)
  for(;t+5<NT;t+=2){
    STEP(pB0,pB1,pA0,pA1,t,true,true,true);     WAIT_BAR(2); RESC(); ROT();
    STEP(pA0,pA1,pB0,pB1,t+1,true,true,true);   WAIT_BAR(2); RESC(); ROT();
  }
  #undef CMASK
  #define CMASK(P0,P1,t) do{int jb_=(t)-(NT-4); if(jb_>=0)cmask(P0,P1,jb_,qrel,hi);}while(0)
  #define ENDW(tt) do{ if((tt)+3<NT){WAIT_BAR(2);} else if((tt)+2<NT){WAIT_BAR(1);} else {WAIT_BAR(0);} }while(0)
  for(;t+1<NT;t+=2){
    STEP(pB0,pB1,pA0,pA1,t,(t+3<NT),(t+1<NT),(t+1<NT));       ENDW(t);   RESC(); ROT();
    STEP(pA0,pA1,pB0,pB1,t+1,(t+4<NT),(t+2<NT),(t+2<NT));     ENDW(t+1); RESC(); ROT();
  }
  STEP(pB0,pB1,pA0,pA1,NT-1,false,false,false); RESC();
  { float sacc=pB0[0]+pB0[1]; _Pragma("unroll") for(int r=2;r<16;++r)sacc+=pB0[r]; _Pragma("unroll") for(int r=0;r<16;++r)sacc+=pB1[r]; l_reg+=sacc;
    pw0=(u32x4){PKW(pB0,0),PKW(pB0,2),PKW(pB0,4),PKW(pB0,6)};pw1=(u32x4){PKW(pB0,8),PKW(pB0,10),PKW(pB0,12),PKW(pB0,14)};pw2=(u32x4){PKW(pB1,0),PKW(pB1,2),PKW(pB1,4),PKW(pB1,6)};pw3=(u32x4){PKW(pB1,8),PKW(pB1,10),PKW(pB1,12),PKW(pB1,14)};
    SBAR(); pv(o,vb0+sl_cur,PAF(0),PAF(1),PAF(2),PAF(3)); }
  #undef PKW
  #undef PAF
  #undef VFR
  #undef PIN
  #undef MX3
  #undef GAPA
  #undef GAPB
  #undef EX
  #undef VRD
  #undef KRD
  #undef STEP
  #undef ENDW
  {auto rr=__builtin_amdgcn_permlane32_swap(__float_as_uint(l_reg),__float_as_uint(l_reg),false,false);l_reg=__uint_as_float(rr[0])+__uint_as_float(rr[1]);}
  if(hi==0)wsf[32+r32]=l_reg;asm volatile("s_waitcnt lgkmcnt(0)":::"memory");
  float rli[16];
  #pragma unroll
  for(int r=0;r<16;++r)rli[r]=__builtin_amdgcn_rcpf(wsf[32+crow(r,hi)]);
  bf16*Ow=O+(rowbase+q0+wid*QBLK)*DM+h*D;
  { bf16*stg=(bf16*)(shm+LDS_OST)+wid*2048;
    #pragma unroll
    for(int r=0;r<16;++r){const int orow=crow(r,hi);
      #pragma unroll
      for(int d0=0;d0<2;++d0)stg[orow*64+d0*32+r32]=__float2bfloat16(o[d0][r]*rli[r]);}
    asm volatile("s_waitcnt lgkmcnt(0)":::"memory");
    const bf16*Gw=G+(rowbase+q0+wid*QBLK)*DM+h*D;
    #pragma unroll
    for(int i=0;i<4;++i){const int row=i*8+(lane>>3),ch=lane&7; u32x4 v=*(const u32x4*)(stg+row*64+ch*8); const u32x4 g=*(const u32x4*)(Gw+(long)row*DM+ch*8);
      #pragma unroll
      for(int q=0;q<4;++q) v[q]=cvtpk_s(__uint_as_float(v[q]<<16)*__uint_as_float(g[q]<<16),__uint_as_float(v[q]&0xffff0000u)*__uint_as_float(g[q]&0xffff0000u));
      ATTN_STORE16(Ow+(long)row*DM+ch*8,v);} }
  asm volatile("s_waitcnt lgkmcnt(0)\n\ts_barrier":::"memory");
  #undef DMA_K
  #undef DMA_V
  #undef CMASK
  #undef KBIAS
  #undef START
  #undef RESC
  #undef ROT
}
constexpr int ATTN_LDS_BYTES=LDS_BYTES;
struct AttnTensors { const bf16* Q; const bf16* K; const bf16* V; bf16* O; const bf16* G; const float* KB; const float* qnorm; };
template<int THRL=8> __device__ __forceinline__ void attn_phase(int tid,int wid,unsigned*ctr,const int*t0tab,volatile __attribute__((address_space(3))) int*bc,char*lds,const AttnTensors&T){
  for(;;){
    if(tid==0){ const int n_=(int)__hip_atomic_fetch_add(ctr,1u,__ATOMIC_RELAXED,__HIP_MEMORY_SCOPE_AGENT); bc[0]=n_; }
    asm volatile("s_waitcnt vmcnt(0) lgkmcnt(0)\n\ts_barrier":::"memory");
    const int n=__builtin_amdgcn_readfirstlane(bc[0]);
    if(n>=BATCH*NHEAD*NQB) break;
    const int qb=NQB-1-(n>>7), bh=n&127;
    const int t0=__builtin_amdgcn_readfirstlane(t0tab[bh*16+qb]);
    attn_unit<THRL>(tid,wid,bh/NHEAD,bh%NHEAD,qb,t0,T.Q,T.K,T.V,T.O,T.G,T.KB+(long)bh*SEQ,T.qnorm,lds);
  }
}
#undef SBAR
#undef WAIT_BAR
}
__device__ __forceinline__ void attn_simple(Frame& F, int j) {
    const InTab in = F.in;
    const bf16_t* Q = (const bf16_t*)(F.ws + WS_RA); const bf16_t* Gt = (const bf16_t*)(F.ws + WS_RA + 64 * MiB);
    const bf16_t* Kb = (const bf16_t*)(F.ws + WS_P); const bf16_t* Vb = (const bf16_t*)(F.ws + WS_P + 64 * MiB);
    const float* KBv = (const float*)(F.ws + WS_KB); bf16_t* OG = (bf16_t*)(F.ws + WS_H2 + 64 * MiB);
    const float* qn = in[I_QNORM] + j * 64;
    for (int item = F.bid; item < 1024; item += F.G) {
        const int bh = item >> 3, qb = item & 7, b = bh >> 4, h = bh & 15, t = qb * 512 + F.tid;
        const size_t row = (size_t)b * SEQ + t;
        float q[64];
        { const bf16_t* qp = Q + row * 1024 + h * 64; float ss = 0.f;
#pragma unroll
          for (int i = 0; i < 8; ++i) { const u32x4 w = *(const u32x4*)(qp + 8 * i);
              q[8 * i] = lo16(w.x); q[8 * i + 1] = hi16(w.x); q[8 * i + 2] = lo16(w.y); q[8 * i + 3] = hi16(w.y); q[8 * i + 4] = lo16(w.z); q[8 * i + 5] = hi16(w.z); q[8 * i + 6] = lo16(w.w); q[8 * i + 7] = hi16(w.w); }
#pragma unroll
          for (int i = 0; i < 64; ++i) ss += q[i] * q[i];
          const float rs = QC2 / sqrtf(ss * (1.0f / 64.0f) + QK_EPS);
#pragma unroll
          for (int i = 0; i < 64; ++i) q[i] = q[i] * rs * qn[i]; }
        float o[64];
#pragma unroll
        for (int i = 0; i < 64; ++i) o[i] = 0.f;
        float m = -1.0e30f, lsum = 0.f;
        const int smax = qb * 512 + F.wave * 64 + 63;
        const bf16_t* kp = Kb + ((size_t)b * SEQ) * 1024 + h * 64; const bf16_t* vp = Vb + ((size_t)b * SEQ) * 1024 + h * 64;
        const float* kbp = KBv + (size_t)bh * SEQ;
        for (int s = 0; s <= smax; ++s) {
            float dot = 0.f;
#pragma unroll
            for (int i = 0; i < 8; ++i) { const u32x4 w = *(const u32x4*)(kp + (size_t)s * 1024 + 8 * i);
                dot += q[8 * i] * lo16(w.x) + q[8 * i + 1] * hi16(w.x) + q[8 * i + 2] * lo16(w.y) + q[8 * i + 3] * hi16(w.y) + q[8 * i + 4] * lo16(w.z) + q[8 * i + 5] * hi16(w.z) + q[8 * i + 6] * lo16(w.w) + q[8 * i + 7] * hi16(w.w); }
            float x = dot + kbp[s];
            if (s > t) x = -1.0e30f;
            const float mn = fmaxf(m, x), corr = exp2f(m - mn), p = (s > t) ? 0.f : exp2f(x - mn);
            m = mn; lsum = lsum * corr + p;
#pragma unroll
            for (int i = 0; i < 8; ++i) { const u32x4 w = *(const u32x4*)(vp + (size_t)s * 1024 + 8 * i);
                o[8 * i] = o[8 * i] * corr + p * lo16(w.x); o[8 * i + 1] = o[8 * i + 1] * corr + p * hi16(w.x); o[8 * i + 2] = o[8 * i + 2] * corr + p * lo16(w.y); o[8 * i + 3] = o[8 * i + 3] * corr + p * hi16(w.y);
                o[8 * i + 4] = o[8 * i + 4] * corr + p * lo16(w.z); o[8 * i + 5] = o[8 * i + 5] * corr + p * hi16(w.z); o[8 * i + 6] = o[8 * i + 6] * corr + p * lo16(w.w); o[8 * i + 7] = o[8 * i + 7] * corr + p * hi16(w.w); }
        }
        const float il = 1.0f / lsum;
        const bf16_t* gp = Gt + row * 1024 + h * 64; bf16_t* op = OG + row * 1024 + h * 64;
#pragma unroll
        for (int i = 0; i < 8; ++i) { const u32x4 w = *(const u32x4*)(gp + 8 * i); u32x4 r;
            r.x = pk2(o[8 * i] * il * lo16(w.x), o[8 * i + 1] * il * hi16(w.x)); r.y = pk2(o[8 * i + 2] * il * lo16(w.y), o[8 * i + 3] * il * hi16(w.y));
            r.z = pk2(o[8 * i + 4] * il * lo16(w.z), o[8 * i + 5] * il * hi16(w.z)); r.w = pk2(o[8 * i + 6] * il * lo16(w.w), o[8 * i + 7] * il * hi16(w.w));
            *(u32x4*)(op + 8 * i) = r; }
    }
}

__device__ __forceinline__ void attn_fast(Frame& F, int j) {
    typedef attn_body::bf16 abf;
    const attn_body::AttnTensors AT{(const abf*)(F.ws + WS_RA), (const abf*)(F.ws + WS_P), (const abf*)(F.ws + WS_P + 64 * MiB), (abf*)(F.ws + WS_H2 + 64 * MiB), (const abf*)(F.ws + WS_RA + 64 * MiB),
                                    (const float*)(F.ws + WS_KB), F.in[I_QNORM] + j * 64};
    static_assert(attn_body::ATTN_LDS_BYTES <= 131072, "attention LDS");
    attn_body::attn_phase<8>(F.tid, F.wave, (unsigned*)(F.ws + WS_CTL) + CW_ATT + 64 * j, (const int*)(F.ws + WS_T0), (volatile LAS int*)(F.lds + MISC_OFF + 64), F.ldsg, AT);
}
__device__ __forceinline__ void relane(Frame& F) { int l_; asm volatile("v_mbcnt_lo_u32_b32 %0, -1, 0\n\tv_mbcnt_hi_u32_b32 %0, -1, %0" : "=v"(l_)); int w_ = F.wave; asm volatile("" : "+s"(w_)); F.wave = w_; F.lane = l_; F.tid = w_ * 64 + l_;
    GAS unsigned char* p_ = (GAS unsigned char*)F.ws; asm volatile("" : "+s"(p_)); F.ws = (unsigned char*)p_; GAS float* x_ = (GAS float*)F.xs; asm volatile("" : "+s"(x_)); F.xs = (float*)x_; }
#define GRID_BAR() (relane(F), xcd_barrier_fn(bar.bar, bar.x, bar.st, F.tid == 0))
#ifndef ONLY
#define ONLY (-1)
#endif
#ifndef REP_MASK
#define REP_MASK 0
#endif
#define ON(k) (relane(F), (ONLY < 0 || ONLY == (k)))
#define RUN(k, ...) do { for (int rep_ = 0; rep_ < (((REP_MASK >> (k)) & 1) ? 2 : 1); ++rep_) { if (ON(k)) { __VA_ARGS__; } if (REP_MASK) __syncthreads(); } } while (0)
template <int l> __device__ __forceinline__ void layer_body(Frame& F, const XcdBarrier& bar) {
    unsigned char* ws = F.ws;

        if (l < 2) {
#ifdef GPROBE
            { relane(F); SchedRKV S{{T / 256, 12, F.G, F.bid}};
#if GPROBE == 1
              EpiNone E{};
#else
              EpiPriv E{(bf16_t*)(ws + WS_RA), F.bid};
#endif
              gemm_fast(F, (const bf16_t*)(ws + WS_SC), 1024, (const bf16_t*)(ws + WS_RWBIG) + (size_t)l * 3072 * 1024, 1024, S, E); __syncthreads(); }
#endif
            RUN(2, SchedRKV S{{T / 256, 12, F.G, F.bid}}; EpiRKV E{(bf16_t*)(ws + WS_RA), (bf16_t*)(ws + WS_P), l};
              gemm_fast(F, (const bf16_t*)(ws + WS_SC), 1024, (const bf16_t*)(ws + WS_RWBIG) + (size_t)l * 3072 * 1024, 1024, S, E););
            RUN(21, SchedDense S{T / 256, 2, F.G, F.bid}; EpiLA E{(bf16_t*)(ws + WS_RA + 192 * MiB)};
              gemm_fast(F, (const bf16_t*)(ws + WS_H2), RWK, (const bf16_t*)(ws + WS_RWLORA) + (size_t)l * 512 * RWK, RWK, S, E););
            GRID_BAR();
            RUN(3, SchedDense S{T / 256, 4, F.G, F.bid}; EpiPlain E{(bf16_t*)(ws + WS_RA + 224 * MiB), 1024};
              gemm_fast(F, (const bf16_t*)(ws + WS_RA + 192 * MiB) + 128, LAW, (const bf16_t*)(ws + WS_LORA2 + (size_t)l * MiB + L2_G2T), G2K, S, E););
            RUN(4, wkv_chunk_prep<0>(F, l));
#ifdef PREP_PROBE
            relane(F); __syncthreads(); wkv_chunk_prep<PREP_PROBE>(F, l);
#endif
            GRID_BAR();
            RUN(20, wkv_chunk_seq(F, l)); RUN(19, moe_convert(F, l, 128, F.G - 128));
            GRID_BAR();
            RUN(6, SchedDense S{T / 256, 4, F.G, F.bid}; EpiPlain E{(bf16_t*)(ws + WS_Y16), 1024};
              gemm_fast(F, (const bf16_t*)(ws + WS_H2), 1024, (const bf16_t*)(ws + WS_RWWO) + (size_t)l * 1024 * 1024, 1024, S, E););
            GRID_BAR();
        } else {
            const int j = l - 2;
            RUN(7, SchedDense S{T / 256, 8, F.G, F.bid}; EpiSplit2 E{(bf16_t*)(ws + WS_RA), (bf16_t*)(ws + WS_RA + 64 * MiB), 1};
              gemm_fast(F, (const bf16_t*)(ws + WS_H2), 1024, (const bf16_t*)(ws + WS_FXQG) + (size_t)j * 2048 * 1024, 1024, S, E););
            GRID_BAR();
            RUN(19, moe_convert(F, l, F.G - 64, 64));
            RUN(8, attn_fast(F, j));
            GRID_BAR();
            RUN(9, SchedDense S{T / 256, 4, F.G, F.bid}; EpiPlain E{(bf16_t*)(ws + WS_Y16), 1024};
              gemm_fast(F, (const bf16_t*)(ws + WS_H2 + 64 * MiB), 1024, (const bf16_t*)(ws + WS_FXWO) + (size_t)j * 1024 * 1024, 1024, S, E););
            GRID_BAR();
        }
#ifdef TOKA_PROBE
        relane(F); tok_a<true>(F, l); __syncthreads();
#endif
#ifdef BAR_PROBE
        for (int bi_ = 0; bi_ < 5; ++bi_) GRID_BAR();
#endif
        RUN(10, tok_a<false>(F, l));
        GRID_BAR();
        {
            const LAS int* lc = (const LAS int*)(F.lds + MOE_LC_OFF);
            const bf16_t* W1T = (const bf16_t*)(ws + WS_MOE); const bf16_t* W2T = W1T + (size_t)32 * 1024 * 1024;
            relane(F); moe_tables(F, l);
            { SchedMoe S{lc + 96, lc[64], F.G, F.bid, (size_t)1024 * 1024}; moe_rows(F, S); EpiMoe1 E{(bf16_t*)(ws + WS_HM)};
              RUN(12, gemm_fast<EpiMoe1, SchedMoe, true>(F, (const bf16_t*)(ws + WS_H2), 1024, W1T, 1024, S, E, (const LAS int*)(F.lds + MOE_TOKL_OFF))); }
            GRID_BAR();
            { SchedMoe S{lc + 96, lc[64], F.G, F.bid, (size_t)1024 * 512}; EpiPlain E{(bf16_t*)(ws + WS_RA + 144 * MiB), 1024};
              RUN(13, gemm_fast(F, (const bf16_t*)(ws + WS_HM), 512, W2T, 512, S, E)); }
            GRID_BAR();
        }
#ifdef TOKB_PROBE
        relane(F); tok_b<true>(F, l, l == 1 ? 1 : (l == 2 ? 2 : 3)); __syncthreads();
#endif
        RUN(14, tok_b<false>(F, l, l == 1 ? 1 : (l == 2 ? 2 : 3)));
        if (l == 3) return;
        GRID_BAR();
        if (l == 0) { RUN(1, rw_prep(F, 1, false)); GRID_BAR(); }
        if (l == 1) {
            RUN(18, fgate_phase(F));
            RUN(15, SchedDense S{T / 256, 8, F.G, F.bid}; EpiSplit2 E{(bf16_t*)(ws + WS_P), (bf16_t*)(ws + WS_P + 64 * MiB), 0};
              gemm_fast(F, (const bf16_t*)(ws + WS_RA), 1024, (const bf16_t*)(ws + WS_KVW), 1024, S, E););
            GRID_BAR();
            RUN(16, kv_post(F));
            GRID_BAR();
        }
}
__global__ void __launch_bounds__(NTHR, 2) yoco_fwd(Args args) {
    extern __shared__ __attribute__((aligned(16))) unsigned char lds[];
    Frame F;
    F.lds = (LAS unsigned char*)lds; F.ldsg = (char*)lds; F.ws = args.ws; F.xs = args.out; F.in.p = args.in;
    F.tid = threadIdx.x; F.lane = F.tid & 63; F.wave = __builtin_amdgcn_readfirstlane(F.tid >> 6); F.G = gridDim.x; F.bid = blockIdx.x;
    volatile LAS unsigned* MISC = (volatile LAS unsigned*)(F.lds + MISC_OFF);
    if (F.tid < 32) MISC[F.tid] = 0u;
    __syncthreads();
    XcdBarrier bar = xcd_barrier_post((unsigned*)(F.ws + WS_CTL) + CW_BAR, MISC + 8);
    unsigned char* ws = F.ws;
    RUN(0, p0_prologue(F));
    GRID_BAR();
    RUN(1, rw_prep(F, 0, true));
    GRID_BAR();
    layer_body<0>(F, bar); layer_body<1>(F, bar); layer_body<2>(F, bar); layer_body<3>(F, bar);
}

extern "C" void kernel_launch(void* const* d_in, const int* in_sizes, int n_in, void* d_out, int out_size, void* d_ws, size_t ws_size, hipStream_t stream) {
    static int grid = 0;
    if (grid == 0) {
        if (n_in != 40 || out_size != T * D || ws_size < WS_END) { fprintf(stderr, "kernel_launch: unexpected shapes (n_in %d out %d ws %zu)\n", n_in, out_size, ws_size); grid = -1; return; }
        int dev = 0, cus = 0, per_cu = 0;
        if (hipGetDevice(&dev) != hipSuccess || hipDeviceGetAttribute(&cus, hipDeviceAttributeMultiprocessorCount, dev) != hipSuccess) { grid = -1; return; }
        if (hipFuncSetAttribute((const void*)yoco_fwd, hipFuncAttributeMaxDynamicSharedMemorySize, LDS_BYTES) != hipSuccess) { fprintf(stderr, "kernel_launch: hipFuncSetAttribute failed\n"); grid = -1; return; }
        if (hipOccupancyMaxActiveBlocksPerMultiprocessor(&per_cu, (const void*)yoco_fwd, NTHR, LDS_BYTES) != hipSuccess || per_cu < 1) fprintf(stderr, "kernel_launch: occupancy query reports %d\n", per_cu);
        (void)hipGetLastError();
        grid = cus;
        if (grid != 256) { fprintf(stderr, "kernel_launch: built for 256 CUs, found %d\n", cus); grid = -1; return; }
    }
    if (grid < 0) return;
    (void)hipMemsetAsync((char*)d_ws + WS_CTL, 0, CTL_BYTES, stream);
    Args a{};
    for (int i = 0; i < 40; ++i) a.in[i] = (const float*)d_in[i];
    a.out = (float*)d_out; a.ws = (unsigned char*)d_ws; a.ph_lo = 0; a.ph_hi = 0;
    hipLaunchKernelGGL(yoco_fwd, dim3(grid), dim3(NTHR), LDS_BYTES, stream, a);
}
```
